# Optimizing an MI355X kernel written in HIP

```python
import math
import numpy as np
import jax
import jax.numpy as jnp
from jax import lax

D_MODEL = 1024
BATCH = 4
SEQ = 4096
DEPTH = 2

HEAD_DIM = 64
N_MIXERS = 4
GROUP_WIDTH = D_MODEL // N_MIXERS
N_HEADS = GROUP_WIDTH // HEAD_DIM
ROPE_THETA = 10000.0
EPS = 1e-6
Q_BLOCK = 128
NEG_INF = -1e30

NSA_CMP_LEN = 32
NSA_CMP_STRIDE = 16
NSA_SLC_LEN = 64
NSA_TOP_N = 16
NSA_WINDOW = 512
NSA_FORCED_LOCAL = 2

DIFF_HALF = HEAD_DIM // 2

MLSTM_CHUNK = 64
MLSTM_CONV = 4

DILATED_PATTERNS = ((128, 1), (512, 4), (2048, 16))
DILATED_PAD = 2048

D_FF = ((8 * D_MODEL + 3 * 256 - 1) // (3 * 256)) * 256

IN_SPLITS = (
    GROUP_WIDTH,
    HEAD_DIM, HEAD_DIM,
    HEAD_DIM, HEAD_DIM,
    HEAD_DIM, HEAD_DIM,
    3 * N_HEADS,
    GROUP_WIDTH, GROUP_WIDTH, GROUP_WIDTH,
    GROUP_WIDTH, GROUP_WIDTH,
    N_HEADS, N_HEADS, GROUP_WIDTH,
    GROUP_WIDTH, GROUP_WIDTH, GROUP_WIDTH,
)
D_IN = sum(IN_SPLITS)

kernel_name = 'hybrid_nsa_diff_mlstm_dilated_trunk'


def rmsnorm(x, g):
    xf = x.astype(jnp.float32)
    y = xf * lax.rsqrt(jnp.mean(xf * xf, axis=-1, keepdims=True) + EPS)
    return (y * g.astype(jnp.float32)).astype(x.dtype)


def rope_tables(seq, dim):
    inv = 1.0 / (ROPE_THETA ** (jnp.arange(0, dim, 2, dtype=jnp.float32) / dim))
    ang = jnp.arange(seq, dtype=jnp.float32)[:, None] * inv[None, :]
    return jnp.cos(ang), jnp.sin(ang)


def apply_rope(x, cos, sin):
    shape = (cos.shape[0],) + (1,) * (x.ndim - 3) + (cos.shape[1],)
    c, s = cos.reshape(shape), sin.reshape(shape)
    xf = x.astype(jnp.float32)
    half = x.shape[-1] // 2
    x1, x2 = xf[..., :half], xf[..., half:]
    return jnp.concatenate([x1 * c - x2 * s, x1 * s + x2 * c], axis=-1).astype(x.dtype)


def masked_softmax(s, mask, return_lse=False):
    s = jnp.where(mask, s.astype(jnp.float32), NEG_INF)
    m = jnp.max(s, axis=-1, keepdims=True)
    e = jnp.where(mask, jnp.exp(s - m), 0.0)
    z = jnp.sum(e, axis=-1, keepdims=True)
    z_safe = jnp.where(z > 0, z, 1.0)
    p = e / z_safe
    if return_lse:
        return p, (m + jnp.log(z_safe))[..., 0]
    return p


def sweep_query_blocks(fn, seq):
    out = lax.map(fn, jnp.arange(seq // Q_BLOCK) * Q_BLOCK)
    out = jnp.moveaxis(out, 0, 1)
    return out.reshape((out.shape[0], seq) + out.shape[3:])


def nsa_mixer(q, k_cmp, v_cmp, k_slc, v_slc, k_win, v_win, gate_pre, cmp_pos, cmp_w, cos, sin):
    bsz, seq = q.shape[0], q.shape[1]
    scale = HEAD_DIM ** -0.5
    t_pos = jnp.arange(seq)

    n_cmp = (seq - NSA_CMP_LEN) // NSA_CMP_STRIDE + 1
    blk_idx = np.arange(n_cmp)[:, None] * NSA_CMP_STRIDE + np.arange(NSA_CMP_LEN)[None, :]

    def compress(t, pos_emb, w):
        blocks = t[:, blk_idx] + pos_emb
        return blocks.reshape(bsz, n_cmp, NSA_CMP_LEN * HEAD_DIM) @ w

    kc = compress(k_cmp, cmp_pos[0], cmp_w[0])
    vc = compress(v_cmp, cmp_pos[1], cmp_w[1])
    cmp_end = jnp.arange(n_cmp) * NSA_CMP_STRIDE + NSA_CMP_LEN - 1
    cmp_mask = cmp_end[None, :] <= t_pos[:, None]
    p_cmp = masked_softmax(jnp.einsum('bshd,bnd->bhsn', q, kc) * scale, cmp_mask)
    o_cmp = jnp.einsum('bhsn,bnd->bshd', p_cmp.astype(vc.dtype), vc)

    n_slc = seq // NSA_SLC_LEN
    top_n = min(NSA_TOP_N, n_slc)
    ratio_s, ratio_c = NSA_SLC_LEN // NSA_CMP_STRIDE, NSA_CMP_LEN // NSA_CMP_STRIDE
    jj = np.arange(n_slc)[:, None, None]
    src = ratio_s * jj - np.arange(ratio_s)[None, :, None] - np.arange(ratio_c)[None, None, :]
    ok = (src >= 0) & (src < n_cmp)
    cmp_to_slc = np.zeros((n_cmp, n_slc), np.float32)
    np.add.at(cmp_to_slc, (np.where(ok, src, 0), np.broadcast_to(jj, src.shape)), ok.astype(np.float32))
    importance = jnp.einsum('bhsn,nj->bsj', p_cmp, jnp.asarray(cmp_to_slc))
    blk = jnp.arange(n_slc)[None, :]
    cur = (t_pos // NSA_SLC_LEN)[:, None]
    forced = (blk == 0) | ((blk <= cur) & (blk > cur - NSA_FORCED_LOCAL))
    score = jnp.where(blk > cur, -1.0e6, jnp.where(forced, 1.0e6, importance))
    _, sel_idx = lax.top_k(score, top_n)
    sel_valid = sel_idx <= cur[None]

    q_rot = apply_rope(q, cos, sin)
    ks = apply_rope(k_slc, cos, sin).reshape(bsz, n_slc, NSA_SLC_LEN, HEAD_DIM)
    vs = v_slc.reshape(bsz, n_slc, NSA_SLC_LEN, HEAD_DIM)
    pad = ((0, 0), (NSA_WINDOW, 0), (0, 0))
    kw = jnp.pad(apply_rope(k_win, cos, sin), pad)
    vw = jnp.pad(v_win, pad)
    b_idx = jnp.arange(bsz)[:, None, None]
    n_sel_keys = top_n * NSA_SLC_LEN

    def block(s0):
        qb = lax.dynamic_slice_in_dim(q_rot, s0, Q_BLOCK, axis=1)
        tq = s0 + jnp.arange(Q_BLOCK)
        idx = lax.dynamic_slice_in_dim(sel_idx, s0, Q_BLOCK, axis=1)
        valid = lax.dynamic_slice_in_dim(sel_valid, s0, Q_BLOCK, axis=1)
        kg = ks[b_idx, idx].reshape(bsz, Q_BLOCK, n_sel_keys, HEAD_DIM)
        vg = vs[b_idx, idx].reshape(bsz, Q_BLOCK, n_sel_keys, HEAD_DIM)
        kpos = (idx[..., None] * NSA_SLC_LEN + jnp.arange(NSA_SLC_LEN)).reshape(bsz, Q_BLOCK, n_sel_keys)
        kvalid = jnp.repeat(valid, NSA_SLC_LEN, axis=-1) & (kpos <= tq[None, :, None])
        p = masked_softmax(jnp.einsum('bqhd,bqkd->bhqk', qb, kg) * scale, kvalid[:, None])
        o_slc = jnp.einsum('bhqk,bqkd->bqhd', p.astype(vg.dtype), vg)
        kwb = lax.dynamic_slice_in_dim(kw, s0, NSA_WINDOW + Q_BLOCK, axis=1)
        vwb = lax.dynamic_slice_in_dim(vw, s0, NSA_WINDOW + Q_BLOCK, axis=1)
        wpos = s0 - NSA_WINDOW + jnp.arange(NSA_WINDOW + Q_BLOCK)
        wmask = (wpos[None, :] <= tq[:, None]) & (wpos[None, :] > tq[:, None] - NSA_WINDOW) & (wpos[None, :] >= 0)
        p = masked_softmax(jnp.einsum('bqhd,bkd->bhqk', qb, kwb) * scale, wmask)
        o_win = jnp.einsum('bhqk,bkd->bqhd', p.astype(vwb.dtype), vwb)
        return jnp.stack([o_slc, o_win], axis=2)

    o_sw = sweep_query_blocks(block, seq)
    g = jax.nn.sigmoid(gate_pre.astype(jnp.float32)).reshape(bsz, seq, 3, N_HEADS, 1).astype(q.dtype)
    o = g[:, :, 0] * o_cmp + g[:, :, 1] * o_sw[:, :, 0] + g[:, :, 2] * o_sw[:, :, 1]
    return o.reshape(bsz, seq, GROUP_WIDTH)


def diff_mixer(q, k, v, lam_vecs, sub_g, lam_init, cos, sin):
    bsz, seq = q.shape[0], q.shape[1]
    q = apply_rope(q, cos, sin)
    k = apply_rope(k, cos, sin)
    lv = lam_vecs.astype(jnp.float32)
    lam = jnp.exp(jnp.sum(lv[0] * lv[1])) - jnp.exp(jnp.sum(lv[2] * lv[3])) + lam_init
    scale = DIFF_HALF ** -0.5
    kpos = jnp.arange(seq)

    def block(s0):
        qb = lax.dynamic_slice_in_dim(q, s0, Q_BLOCK, axis=1)
        tq = s0 + jnp.arange(Q_BLOCK)
        s = jnp.einsum('bqhcd,bkhcd->bhcqk', qb, k) * scale
        p = masked_softmax(s, kpos[None, :] <= tq[:, None])
        a = p[:, :, 0] - lam * p[:, :, 1]
        return jnp.einsum('bhqk,bkhd->bqhd', a.astype(v.dtype), v)

    o = sweep_query_blocks(block, seq)
    o = rmsnorm(o, sub_g) * (1.0 - lam_init)
    return o.reshape(bsz, seq, GROUP_WIDTH)


def mlstm_mixer(u, v, i_pre, f_pre, o_pre, conv_w, conv_b, wq, wk, gate_b, head_g):
    bsz, seq = u.shape[0], u.shape[1]
    f32 = jnp.float32
    uc = lax.conv_general_dilated(u, conv_w[:, None, :], window_strides=(1,),
                                  padding=[(MLSTM_CONV - 1, 0)],
                                  dimension_numbers=('NWC', 'WIO', 'NWC'),
                                  feature_group_count=GROUP_WIDTH) + conv_b
    uc = jax.nn.silu(uc).reshape(bsz, seq, N_HEADS, HEAD_DIM)
    q = jnp.einsum('bshd,hde->bhse', uc, wq).astype(f32)
    k = jnp.einsum('bshd,hde->bhse', uc, wk).astype(f32) * (HEAD_DIM ** -0.5)
    vv = v.reshape(bsz, seq, N_HEADS, HEAD_DIM).transpose(0, 2, 1, 3).astype(f32)
    gb = gate_b.astype(f32)
    ig = (i_pre.astype(f32) + gb[0]).transpose(0, 2, 1)
    lf = jax.nn.log_sigmoid(f_pre.astype(f32) + gb[1]).transpose(0, 2, 1)

    nc, L = seq // MLSTM_CHUNK, MLSTM_CHUNK
    q = q.reshape(bsz, N_HEADS, nc, L, HEAD_DIM)
    k = k.reshape(bsz, N_HEADS, nc, L, HEAD_DIM)
    vv = vv.reshape(bsz, N_HEADS, nc, L, HEAD_DIM)
    ig = ig.reshape(bsz, N_HEADS, nc, L)
    b = jnp.cumsum(lf.reshape(bsz, N_HEADS, nc, L), axis=-1)
    causal = jnp.tril(jnp.ones((L, L), dtype=bool))
    dmat = jnp.where(causal, b[..., :, None] - b[..., None, :] + ig[..., None, :], NEG_INF)

    a = b[..., -1]
    g_end = a[..., None] - b + ig
    m_loc = jnp.max(g_end, axis=-1)
    w_end = jnp.exp(g_end - m_loc[..., None])
    c_loc = jnp.einsum('bhcl,bhclv,bhclk->bhcvk', w_end, vv, k)
    n_loc = jnp.einsum('bhcl,bhclk->bhck', w_end, k)

    def step(carry, xs):
        c_st, n_st, m_st = carry
        a_c, m_l, c_l, n_l = xs
        m_new = jnp.maximum(a_c + m_st, m_l)
        decay = jnp.exp(a_c + m_st - m_new)
        fresh = jnp.exp(m_l - m_new)
        c_new = decay[..., None, None] * c_st + fresh[..., None, None] * c_l
        n_new = decay[..., None] * n_st + fresh[..., None] * n_l
        return (c_new, n_new, m_new), (c_st, n_st, m_st)

    init = (jnp.zeros((bsz, N_HEADS, HEAD_DIM, HEAD_DIM), f32),
            jnp.zeros((bsz, N_HEADS, HEAD_DIM), f32),
            jnp.zeros((bsz, N_HEADS), f32))
    xs = (jnp.moveaxis(a, 2, 0), jnp.moveaxis(m_loc, 2, 0),
          jnp.moveaxis(c_loc, 2, 0), jnp.moveaxis(n_loc, 2, 0))
    _, (c_in, n_in, m_in) = lax.scan(step, init, xs)
    c_in = jnp.moveaxis(c_in, 0, 2)
    n_in = jnp.moveaxis(n_in, 0, 2)
    m_in = jnp.moveaxis(m_in, 0, 2)

    inter = b + m_in[..., None]
    m_t = jnp.maximum(inter, jnp.max(dmat, axis=-1))
    e_inter = jnp.exp(inter - m_t)
    s_qk = jnp.einsum('bhctd,bhcsd->bhcts', q, k) * jnp.exp(dmat - m_t[..., None])
    num = (e_inter[..., None] * jnp.einsum('bhcvk,bhctk->bhctv', c_in, q)
           + jnp.einsum('bhcts,bhcsv->bhctv', s_qk, vv))
    den = e_inter * jnp.einsum('bhck,bhctk->bhct', n_in, q) + jnp.sum(s_qk, axis=-1)
    h = num / jnp.maximum(jnp.abs(den), jnp.exp(-m_t))[..., None]
    h = h.reshape(bsz, N_HEADS, seq, HEAD_DIM).transpose(0, 2, 1, 3)
    h = rmsnorm(h, head_g.reshape(N_HEADS, HEAD_DIM))
    h = h * jax.nn.sigmoid(o_pre.astype(f32)).reshape(bsz, seq, N_HEADS, HEAD_DIM)
    return h.reshape(bsz, seq, GROUP_WIDTH).astype(u.dtype)


def dilated_mixer(q, k, v, cos, sin):
    bsz, seq = q.shape[0], q.shape[1]
    q = apply_rope(q, cos, sin)
    k = apply_rope(k, cos, sin)
    pad = ((0, 0), (DILATED_PAD, 0), (0, 0), (0, 0))
    kp, vp = jnp.pad(k, pad), jnp.pad(v, pad)
    scale = HEAD_DIM ** -0.5

    def block(s0):
        qb = lax.dynamic_slice_in_dim(q, s0, Q_BLOCK, axis=1)
        tq = s0 + jnp.arange(Q_BLOCK)
        kseg = lax.dynamic_slice_in_dim(kp, s0, DILATED_PAD + Q_BLOCK, axis=1)
        vseg = lax.dynamic_slice_in_dim(vp, s0, DILATED_PAD + Q_BLOCK, axis=1)
        outs, lses = [], []
        for window, dil in DILATED_PATTERNS:
            n_keys = window // dil + 1
            rel = np.arange(Q_BLOCK)[:, None] + DILATED_PAD - np.arange(n_keys)[None, :] * dil
            kg, vg = kseg[:, rel], vseg[:, rel]
            kpos = tq[:, None] - jnp.arange(n_keys)[None, :] * dil
            s = jnp.einsum('bqhd,bqjhd->bhqj', qb, kg) * scale
            p, lse = masked_softmax(s, kpos >= 0, return_lse=True)
            outs.append(jnp.einsum('bhqj,bqjhd->bqhd', p.astype(vg.dtype), vg))
            lses.append(jnp.transpose(lse, (0, 2, 1)))
        alpha = jax.nn.softmax(jnp.stack(lses, axis=0), axis=0)
        return jnp.einsum('gbqh,gbqhd->bqhd', alpha.astype(q.dtype), jnp.stack(outs, axis=0))

    o = sweep_query_blocks(block, seq)
    return o.reshape(bsz, seq, GROUP_WIDTH)


def setup_inputs(seed: int = 0) -> dict:
    key = jax.random.key(seed)
    k = jax.random.split(key, 20)
    f32 = jnp.float32

    def normal(kk, shape, scale):
        return jax.random.normal(kk, shape, f32) * scale

    def gain(kk, shape):
        return 1.0 + 0.02 * jax.random.normal(kk, shape, f32)

    forget_bias = jnp.linspace(3.0, 6.0, N_HEADS, dtype=f32)
    mlstm_gate_b = jnp.stack([normal(k[10], (DEPTH, N_HEADS), 0.1),
                              forget_bias + normal(k[11], (DEPTH, N_HEADS), 0.1)], axis=1)
    return {
        'x': normal(k[0], (BATCH, SEQ, D_MODEL), 1.0),
        'norm_mix': gain(k[1], (DEPTH, D_MODEL)),
        'w_in': normal(k[2], (DEPTH, D_MODEL, D_IN), D_MODEL ** -0.5),
        'nsa_cmp_pos': normal(k[3], (DEPTH, 2, NSA_CMP_LEN, HEAD_DIM), 0.1),
        'nsa_cmp_w': normal(k[4], (DEPTH, 2, NSA_CMP_LEN * HEAD_DIM, HEAD_DIM), (NSA_CMP_LEN * HEAD_DIM) ** -0.5),
        'diff_lambda': normal(k[5], (DEPTH, 4, DIFF_HALF), 0.1),
        'diff_norm': gain(k[6], (DEPTH, HEAD_DIM)),
        'mlstm_conv_w': normal(k[7], (DEPTH, MLSTM_CONV, GROUP_WIDTH), MLSTM_CONV ** -0.5),
        'mlstm_conv_b': normal(k[8], (DEPTH, GROUP_WIDTH), 0.02),
        'mlstm_wq': normal(k[9], (DEPTH, N_HEADS, HEAD_DIM, HEAD_DIM), HEAD_DIM ** -0.5),
        'mlstm_wk': normal(k[12], (DEPTH, N_HEADS, HEAD_DIM, HEAD_DIM), HEAD_DIM ** -0.5),
        'mlstm_gate_b': mlstm_gate_b,
        'mlstm_norm': gain(k[13], (DEPTH, GROUP_WIDTH)),
        'w_out': normal(k[14], (DEPTH, D_MODEL, D_MODEL), D_MODEL ** -0.5),
        'norm_ffn': gain(k[15], (DEPTH, D_MODEL)),
        'w_gate': normal(k[16], (DEPTH, D_MODEL, D_FF), D_MODEL ** -0.5),
        'w_up': normal(k[17], (DEPTH, D_MODEL, D_FF), D_MODEL ** -0.5),
        'w_down': normal(k[18], (DEPTH, D_FF, D_MODEL), D_FF ** -0.5),
        'norm_final': gain(k[19], (D_MODEL,)),
    }


def reference(x, norm_mix, w_in, nsa_cmp_pos, nsa_cmp_w, diff_lambda, diff_norm,
              mlstm_conv_w, mlstm_conv_b, mlstm_wq, mlstm_wk, mlstm_gate_b, mlstm_norm,
              w_out, norm_ffn, w_gate, w_up, w_down, norm_final):
    bsz, seq, _ = x.shape
    cos64, sin64 = rope_tables(seq, HEAD_DIM)
    cos32, sin32 = rope_tables(seq, DIFF_HALF)
    offsets = [int(o) for o in np.cumsum(IN_SPLITS)[:-1]]

    def heads(t):
        return t.reshape(bsz, seq, N_HEADS, HEAD_DIM)

    for layer in range(DEPTH):
        h = rmsnorm(x, norm_mix[layer])
        z = h @ w_in[layer]
        (a_q, a_kc, a_vc, a_ks, a_vs, a_kw, a_vw, a_g,
         b_q, b_k, b_v, c_u, c_v, c_i, c_f, c_o, d_q, d_k, d_v) = jnp.split(z, offsets, axis=-1)
        o_a = nsa_mixer(heads(a_q), a_kc, a_vc, a_ks, a_vs, a_kw, a_vw, a_g,
                        nsa_cmp_pos[layer], nsa_cmp_w[layer], cos64, sin64)
        lam_init = 0.8 - 0.6 * math.exp(-0.3 * layer)
        o_b = diff_mixer(b_q.reshape(bsz, seq, N_HEADS, 2, DIFF_HALF),
                         b_k.reshape(bsz, seq, N_HEADS, 2, DIFF_HALF), heads(b_v),
                         diff_lambda[layer], diff_norm[layer], lam_init, cos32, sin32)
        o_c = mlstm_mixer(c_u, c_v, c_i, c_f, c_o, mlstm_conv_w[layer], mlstm_conv_b[layer],
                          mlstm_wq[layer], mlstm_wk[layer], mlstm_gate_b[layer], mlstm_norm[layer])
        o_d = dilated_mixer(heads(d_q), heads(d_k), heads(d_v), cos64, sin64)
        x = x + jnp.concatenate([o_a, o_b, o_c, o_d], axis=-1) @ w_out[layer]
        h = rmsnorm(x, norm_ffn[layer])
        x = x + (jax.nn.silu(h @ w_gate[layer]) * (h @ w_up[layer])) @ w_down[layer]
    return rmsnorm(x, norm_final)
```

```cpp
#include <hip/hip_runtime.h>
#include <hip/hip_cooperative_groups.h>
#include <cstdio>
#include <cstdint>
namespace cg = cooperative_groups;
namespace pg8 {
#define PG8_LAS __attribute__((address_space(3)))
typedef unsigned short bf16_t;
typedef short bf16x8 __attribute__((ext_vector_type(8)));
typedef float f32x4 __attribute__((ext_vector_type(4)));
typedef unsigned u32x4 __attribute__((ext_vector_type(4)));
constexpr int BM = 256, BK = 64, HALF = 128, HTB = HALF * BK * 2  , STAGE_BYTES = 8 * HTB, NXCD = 8, WGM = 8;

__host__ __device__ __forceinline__ int lds_byte(int r, int c) { const int st = (r >> 4) * 2 + (c >> 5), rr = r & 15, cc = c & 31, ob = rr * 64 + cc * 2; return st * 1024 + (ob ^ (((ob >> 9) & 1) << 5)); }
__host__ __device__ __forceinline__ void stage_rc(int b, int& R, int& C) { const int st = b / 1024, sb = b % 1024, swz = sb ^ (((sb >> 9) & 1) << 5); R = (st >> 1) * 16 + swz / 64; C = (st & 1) * 32 + (swz % 64) / 2; }
__host__ __device__ __forceinline__ int perm32(int rho) { const int n = rho >> 4, i = rho & 15; return 8 * (i >> 2) + 4 * n + (i & 3); }

struct Unit { int pm, pn; };
struct Gemm { const bf16_t* A; const bf16_t* Bt; int M, N, K; };

struct StaticOrder {
    int nM, nN, nwg, G, c;
    __host__ __device__ void init(int M, int N, int G_, int c_) { nM = M / BM; nN = N / BM; nwg = nM * nN; G = G_; c = c_; }
    __host__ __device__ bool next(int i, Unit& u) const {
        const long L = (long)i * G + c; if (L >= nwg) return false;
        int wgid = (int)L; { const int q = nwg / NXCD, r = nwg % NXCD, xcd = wgid % NXCD, off = wgid / NXCD; wgid = (xcd < r ? xcd * (q + 1) : r * (q + 1) + (xcd - r) * q) + off; }
        const int nig = WGM * nN, gid = wgid / nig, fm = gid * WGM, gsz = (nM - fm) < WGM ? (nM - fm) : WGM;
        u.pm = fm + ((wgid % nig) % gsz); u.pn = (wgid % nig) / gsz; return true;
    }
    __device__ __forceinline__ void a_ready(const Unit&) const {}
    __device__ __forceinline__ void done(const Unit&) const {}
};

__device__ __forceinline__ unsigned cvt_pk_bf16(float lo, float hi) { unsigned r; asm volatile("v_cvt_pk_bf16_f32 %0, %1, %2" : "=v"(r) : "v"(lo), "v"(hi)); return r; }
typedef float f32x2 __attribute__((ext_vector_type(2)));
struct EpiZ {
    static constexpr bool PERM = true, AFTER_DRAIN = false;
    bf16_t* O; int ldc;
    __device__ __forceinline__ void operator()(const f32x4 (&acc)[2][2][4][2], const Unit& u, int wr, int wc, int fr, int fq) const {
        const int row0 = u.pm * BM + wr * 64 + fr, col0 = u.pn * BM + wc * 32 + 8 * fq;
#pragma unroll
        for (int ai = 0; ai < 2; ++ai)
#pragma unroll
            for (int m = 0; m < 4; ++m) { bf16_t* rowp = O + (size_t)(row0 + ai * HALF + m * 16) * ldc + col0;
#pragma unroll
                for (int bj = 0; bj < 2; ++bj) { const f32x4 v0 = acc[ai][bj][m][0], v1 = acc[ai][bj][m][1];
                    u32x4 w; w.x = cvt_pk_bf16(v0[0], v0[1]); w.y = cvt_pk_bf16(v0[2], v0[3]); w.z = cvt_pk_bf16(v1[0], v1[1]); w.w = cvt_pk_bf16(v1[2], v1[3]);
                    *(u32x4*)(rowp + bj * HALF) = w; } }
    }
};
struct EpiRes {
    static constexpr bool PERM = false, AFTER_DRAIN = false;
    const float* base; float* out; int ldc;
    __device__ __forceinline__ void operator()(const f32x4 (&acc)[2][2][4][2], const Unit& u, int wr, int wc, int fr, int fq) const {
        const int row0 = u.pm * BM + wr * 64 + fr, col0 = u.pn * BM + wc * 32 + 4 * fq;
#pragma unroll
        for (int ai = 0; ai < 2; ++ai)
#pragma unroll
            for (int m = 0; m < 4; ++m) { const size_t off = (size_t)(row0 + ai * HALF + m * 16) * ldc + col0;
#pragma unroll
                for (int bj = 0; bj < 2; ++bj)
#pragma unroll
                    for (int n = 0; n < 2; ++n) { const size_t p = off + bj * HALF + n * 16; const f32x4 b = *(const f32x4*)(base + p); *(f32x4*)(out + p) = b + acc[ai][bj][m][n]; } }
    }
};
struct EpiSwiGLU {
    static constexpr bool PERM = true, AFTER_DRAIN = false;
    bf16_t* O; int ldc;
    __device__ __forceinline__ void operator()(const f32x4 (&acc)[2][2][4][2], const Unit& u, int wr, int wc, int fr, int fq) const {
        const int row0 = u.pm * BM + wr * 64 + fr, col0 = u.pn * HALF + wc * 32 + 8 * fq;
#pragma unroll
        for (int ai = 0; ai < 2; ++ai)
#pragma unroll
            for (int m = 0; m < 4; ++m) { bf16_t* rowp = O + (size_t)(row0 + ai * HALF + m * 16) * ldc + col0;
                float r[8];
#pragma unroll
                for (int n = 0; n < 2; ++n)
#pragma unroll
                    for (int j = 0; j < 4; ++j) { const float g = acc[ai][0][m][n][j], up = acc[ai][1][m][n][j]; r[4 * n + j] = g * __builtin_amdgcn_rcpf(1.0f + __expf(-g)) * up; }
                u32x4 w; w.x = cvt_pk_bf16(r[0], r[1]); w.y = cvt_pk_bf16(r[2], r[3]); w.z = cvt_pk_bf16(r[4], r[5]); w.w = cvt_pk_bf16(r[6], r[7]);
                *(u32x4*)rowp = w; }
    }
};
template <class Epi, class Sched, bool ALIGN_EPI = false, bool SP2 = false>
__device__ __forceinline__ void gemm_phase(PG8_LAS unsigned char* lds, const Gemm g, const Sched& S, const Epi& E) {
    int tid_ = threadIdx.x; asm volatile("" : "+v"(tid_));
    const int tid = tid_, wid = __builtin_amdgcn_readfirstlane(tid >> 6), lane = tid & 63, wr = wid >> 2, wc = wid & 3, fr = lane & 15, fq = lane >> 4;
    const int K = g.K, nt = K / BK;
    unsigned voffA[2], voffB[2];
#pragma unroll
    for (int i = 0; i < 2; ++i) { int R, C; stage_rc(tid * 16 + i * 8192, R, C); const int Rb = Epi::PERM ? ((R & ~31) + perm32(R & 31)) : R;
        voffA[i] = (unsigned)(R * K + C) * 2u; voffB[i] = (unsigned)(Rb * K + C) * 2u; }
    const size_t kstep = (size_t)(BK * 2);
    const size_t hstep = (size_t)HALF * K * 2;
    const size_t tstep = 2 * hstep;
    const unsigned ldsw = (unsigned)wid * 1024u;
    const int aoff = lds_byte(wr * 64 + fr, fq * 8), boff = lds_byte(wc * 32 + fr, fq * 8);
#define PG8_SA(b, h) (((b) * 2 + (h)) * HTB)
#define PG8_SB(b, h) ((4 + (b) * 2 + (h)) * HTB)
#define PG8_STAGE(bufoff, gbase, voff) do { _Pragma("unroll") for (int _i = 0; _i < 2; ++_i) \
        __builtin_amdgcn_global_load_lds((const unsigned*)((const char*)(gbase) + (voff)[_i]), (PG8_LAS unsigned*)(lds + (bufoff) + ldsw + _i * 8192), 16, 0, 0); } while (0)
#define PG8_LDA(dst, b, h) do { _Pragma("unroll") for (int m = 0; m < 4; ++m) _Pragma("unroll") for (int k = 0; k < 2; ++k) dst[m][k] = *(const PG8_LAS bf16x8*)(lds + PG8_SA(b, h) + aoff + m * 2048 + k * 1024); } while (0)
#define PG8_LDB(dst, b, h) do { _Pragma("unroll") for (int n = 0; n < 2; ++n) _Pragma("unroll") for (int k = 0; k < 2; ++k) dst[n][k] = *(const PG8_LAS bf16x8*)(lds + PG8_SB(b, h) + boff + n * 2048 + k * 1024); } while (0)
#define PG8_MMA(ai, bj, At, Bt) do { __builtin_amdgcn_s_setprio(1); _Pragma("unroll") for (int m = 0; m < 4; ++m) _Pragma("unroll") for (int n = 0; n < 2; ++n) _Pragma("unroll") for (int k = 0; k < 2; ++k) \
        acc[ai][bj][m][n] = __builtin_amdgcn_mfma_f32_16x16x32_bf16(Bt[n][k], At[m][k], acc[ai][bj][m][n], 0, 0, 0); __builtin_amdgcn_s_setprio(0); } while (0)
#define PG8_WAIT_V(n) asm volatile("s_waitcnt vmcnt(" #n ")" ::: "memory")
#define PG8_WAIT_L(n) asm volatile("s_waitcnt lgkmcnt(" #n ")" ::: "memory")
#define PG8_BAR __builtin_amdgcn_s_barrier()
#define PG8_SCHED __builtin_amdgcn_sched_barrier(0)
    Unit cur, nxt; int ui = 0;
    if (!S.next(0, cur)) return;
    f32x4 acc[2][2][4][2];
#pragma unroll
    for (int a = 0; a < 2; ++a)
#pragma unroll
        for (int b = 0; b < 2; ++b)
#pragma unroll
            for (int m = 0; m < 4; ++m)
#pragma unroll
                for (int n = 0; n < 2; ++n) acc[a][b][m][n] = (f32x4){0.f, 0.f, 0.f, 0.f};
    bf16x8 At[4][2], B0[2][2], B1[2][2];
    const char* cA = (const char*)g.A + (size_t)cur.pm * tstep; const char* cB = (const char*)g.Bt + (size_t)cur.pn * tstep;
    S.a_ready(cur);
    if constexpr (SP2) {
        PG8_STAGE(PG8_SB(0, 0), cB, voffB); PG8_STAGE(PG8_SB(0, 1), cB + hstep, voffB); PG8_STAGE(PG8_SA(0, 0), cA, voffA); PG8_STAGE(PG8_SA(0, 1), cA + hstep, voffA);
        if (wr == 1) PG8_BAR;
        PG8_WAIT_V(2); PG8_BAR;
        PG8_STAGE(PG8_SB(1, 0), cB + kstep, voffB); PG8_STAGE(PG8_SA(1, 0), cA + kstep, voffA); PG8_STAGE(PG8_SB(1, 1), cB + hstep + kstep, voffB);
        PG8_WAIT_V(6); PG8_BAR;
    } else {
        PG8_STAGE(PG8_SB(0, 0), cB, voffB); PG8_STAGE(PG8_SA(0, 0), cA, voffA); PG8_STAGE(PG8_SB(0, 1), cB + hstep, voffB); PG8_STAGE(PG8_SA(0, 1), cA + hstep, voffA);
        if (wr == 1) PG8_BAR;
        PG8_WAIT_V(4); PG8_BAR;
        PG8_STAGE(PG8_SB(1, 0), cB + kstep, voffB); PG8_STAGE(PG8_SA(1, 0), cA + kstep, voffA); PG8_STAGE(PG8_SB(1, 1), cB + hstep + kstep, voffB);
        PG8_WAIT_V(6); PG8_BAR;
    }
    for (;;) {
        const bool has_next = S.next(ui + 1, nxt);
        const char* nA = has_next ? (const char*)g.A + (size_t)nxt.pm * tstep : cA; const char* nB = has_next ? (const char*)g.Bt + (size_t)nxt.pn * tstep : cB;
        for (int t = 0; t < nt; t += 2) {
            const bool last = (t == nt - 2);
            const char* a1 = cA + (size_t)(t + 1) * kstep;
            const char* a2 = last ? nA : cA + (size_t)(t + 2) * kstep; const char* b2 = last ? nB : cB + (size_t)(t + 2) * kstep;
            const char* a3 = a2 + kstep; const char* b3 = b2 + kstep;
            if (last && has_next) S.a_ready(nxt);
            if constexpr (SP2) {
            PG8_LDB(B0, 0, 0); PG8_LDB(B1, 0, 1); PG8_SCHED; PG8_LDA(At, 0, 0); PG8_STAGE(PG8_SA(1, 1), a1 + hstep, voffA);
            PG8_WAIT_V(8); PG8_WAIT_L(0); PG8_BAR; PG8_MMA(0, 0, At, B0); PG8_MMA(0, 1, At, B1); PG8_BAR; PG8_SCHED;
            PG8_LDA(At, 0, 1); PG8_STAGE(PG8_SB(0, 0), b2, voffB); PG8_STAGE(PG8_SB(0, 1), b2 + hstep, voffB); PG8_STAGE(PG8_SA(0, 0), a2, voffA);
            PG8_WAIT_V(8); PG8_WAIT_L(0); PG8_BAR; PG8_MMA(1, 0, At, B0); PG8_MMA(1, 1, At, B1); PG8_BAR; PG8_SCHED;
            PG8_LDB(B0, 1, 0); PG8_LDB(B1, 1, 1); PG8_SCHED; PG8_LDA(At, 1, 0); PG8_STAGE(PG8_SA(0, 1), a2 + hstep, voffA);
            PG8_WAIT_V(8); PG8_WAIT_L(0); PG8_BAR; PG8_MMA(0, 0, At, B0); PG8_MMA(0, 1, At, B1); PG8_BAR; PG8_SCHED;
            PG8_LDA(At, 1, 1); PG8_STAGE(PG8_SB(1, 0), b3, voffB); PG8_STAGE(PG8_SB(1, 1), b3 + hstep, voffB); PG8_STAGE(PG8_SA(1, 0), a3, voffA);
            PG8_WAIT_V(8); PG8_WAIT_L(0); PG8_BAR; PG8_MMA(1, 0, At, B0); PG8_MMA(1, 1, At, B1); PG8_BAR; PG8_SCHED;
            } else {
            PG8_LDB(B0, 0, 0); PG8_SCHED; PG8_LDA(At, 0, 0); PG8_STAGE(PG8_SA(1, 1), a1 + hstep, voffA);
            PG8_WAIT_L(8); PG8_BAR; PG8_WAIT_L(0); PG8_MMA(0, 0, At, B0); PG8_BAR; PG8_SCHED;
            PG8_LDB(B1, 0, 1); PG8_STAGE(PG8_SB(0, 0), b2, voffB);
            PG8_BAR; PG8_WAIT_L(0); PG8_MMA(0, 1, At, B1); PG8_BAR;
            PG8_LDA(At, 0, 1); PG8_STAGE(PG8_SA(0, 0), a2, voffA);
            PG8_BAR; PG8_WAIT_L(0); PG8_MMA(1, 0, At, B0); PG8_BAR; PG8_SCHED;
            PG8_STAGE(PG8_SB(0, 1), b2 + hstep, voffB);
            PG8_WAIT_V(6); PG8_BAR; PG8_MMA(1, 1, At, B1); PG8_BAR;
            PG8_LDB(B0, 1, 0); PG8_SCHED; PG8_LDA(At, 1, 0); PG8_STAGE(PG8_SA(0, 1), a2 + hstep, voffA);
            PG8_WAIT_L(8); PG8_BAR; PG8_WAIT_L(0); PG8_MMA(0, 0, At, B0); PG8_BAR; PG8_SCHED;
            PG8_LDB(B1, 1, 1); PG8_STAGE(PG8_SB(1, 0), b3, voffB);
            PG8_BAR; PG8_WAIT_L(0); PG8_MMA(0, 1, At, B1); PG8_BAR;
            PG8_LDA(At, 1, 1); PG8_STAGE(PG8_SA(1, 0), a3, voffA);
            PG8_BAR; PG8_WAIT_L(0); PG8_MMA(1, 0, At, B0); PG8_BAR; PG8_SCHED;
            PG8_STAGE(PG8_SB(1, 1), b3 + hstep, voffB);
            PG8_WAIT_V(6); PG8_BAR; PG8_MMA(1, 1, At, B1); PG8_BAR;
            }
        }
        if constexpr (ALIGN_EPI) { if (wr == 0) PG8_BAR; }
        if constexpr (!Epi::AFTER_DRAIN) { E(acc, cur, wr, wc, fr, fq); S.done(cur); }
        if (!has_next) break;
#pragma unroll
        for (int a = 0; a < 2; ++a)
#pragma unroll
            for (int b = 0; b < 2; ++b)
#pragma unroll
                for (int m = 0; m < 4; ++m)
#pragma unroll
                    for (int n = 0; n < 2; ++n) acc[a][b][m][n] = (f32x4){0.f, 0.f, 0.f, 0.f};
        cur = nxt; cA = nA; cB = nB; ++ui;
        if constexpr (ALIGN_EPI) { if (wr == 1) PG8_BAR; }
    }
    PG8_WAIT_V(0);
    if constexpr (!ALIGN_EPI) { if (wr == 0) PG8_BAR; }
    PG8_BAR;
    if constexpr (Epi::AFTER_DRAIN) { E.fused(acc, cur, wr, wc, fr, fq, lds, wid, lane); S.done(cur); }
#undef PG8_SA
#undef PG8_SB
#undef PG8_STAGE
#undef PG8_LDA
#undef PG8_LDB
#undef PG8_MMA
#undef PG8_WAIT_V
#undef PG8_WAIT_L
#undef PG8_BAR
#undef PG8_SCHED
}
}

constexpr int NB = 4, SEQ = 4096, T = NB * SEQ, DM = 1024, DIN = 2964, DINP = 3072, DFF = 2816, DEPTH = 2;
constexpr int NWAVES = 8, NTHREADS = 512;
constexpr float EPS = 1e-6f;
constexpr int ZAQ = 0, ZKC = 256, ZVC = 320, ZKS = 384, ZVS = 448, ZKW = 512, ZVW = 576, ZBQ = 640, ZBK = 896, ZBV = 1152,
              ZCU = 1408, ZCV = 1664, ZCO = 1920, ZDQ = 2176, ZDK = 2432, ZDV = 2688, ZAG = 2944, ZCI = 2956, ZCF = 2960;
__host__ __device__ __forceinline__ int zsrc(int n) {
    if (n < 640) return n;
    if (n < 1920) return n + 12;
    if (n < 2944) return n + 20;
    if (n < 2956) return n - 2944 + 640;
    if (n < 2960) return n - 2956 + 1932;
    if (n < 2964) return n - 2960 + 1936;
    return -1;
}
constexpr size_t MiB = 1u << 20;
constexpr size_t WS_CTL = 0, CTL_ZERO_BYTES = 1 * MiB;
constexpr size_t WS_WIN = 2 * MiB, WS_WOUT = 8 * MiB, WS_WGU = 10 * MiB, WS_WD = 21 * MiB;
constexpr size_t WS_ROPE64 = 27 * MiB, WS_ROPE32 = 28 * MiB;
constexpr size_t WS_KC = 29 * MiB, WS_VC = WS_KC + 256 * 1024;
constexpr size_t WS_SEL = WS_VC + 256 * 1024;
constexpr size_t WS_BCUM = 30 * MiB, WS_IG = WS_BCUM + 256 * 1024, WS_NLOC = WS_IG + 256 * 1024;
constexpr size_t WS_ACH = WS_NLOC + 256 * 1024, WS_MLOC = WS_ACH + 4096, WS_MIN = WS_MLOC + 4096;
constexpr size_t WS_H = 32 * MiB;
constexpr size_t WS_Z = 64 * MiB;
constexpr size_t WS_AQR = 160 * MiB, WS_OCMP = 168 * MiB, WS_DPART = 176 * MiB;
constexpr size_t WS_MQ = 200 * MiB, WS_MK = 216 * MiB, WS_CLOC = 232 * MiB, WS_END = 248 * MiB;
constexpr int CW_BAR = 4096;
constexpr int CW_Q = 16384;
constexpr int RING_BYTES = 131072, LDSCTL_OFF = RING_BYTES, MISC_OFF = LDSCTL_OFF + 320, LDS_BYTES = 147456;

#define GAS __attribute__((address_space(1)))
#define LAS __attribute__((address_space(3)))
typedef unsigned short bf16;
typedef unsigned v4u __attribute__((ext_vector_type(4)));
typedef unsigned v2u __attribute__((ext_vector_type(2)));
typedef float f32x4 __attribute__((ext_vector_type(4)));
typedef float f32x2 __attribute__((ext_vector_type(2)));
#define LDS_WAIT() asm volatile("s_waitcnt lgkmcnt(0)" ::: "memory")
#define VM_WAIT() asm volatile("s_waitcnt vmcnt(0)" ::: "memory")
__device__ __forceinline__ unsigned f2bf(float f) { unsigned u = __builtin_bit_cast(unsigned, f); return (u + 0x7fffu + ((u >> 16) & 1u)) >> 16; }
__device__ __forceinline__ unsigned pk2(float lo, float hi) { return f2bf(lo) | (f2bf(hi) << 16); }
__device__ __forceinline__ float bf2f(bf16 u) { return __uint_as_float(((unsigned)u) << 16); }
__device__ __forceinline__ float bflo(unsigned w) { return __uint_as_float(w << 16); }
__device__ __forceinline__ float bfhi(unsigned w) { return __uint_as_float(w & 0xffff0000u); }
__device__ __forceinline__ float wave_sum(float v) {
#pragma unroll
    for (int o = 1; o < 64; o <<= 1) v += __shfl_xor(v, o);
    return v;
}
__device__ __forceinline__ float wave_max(float v) {
#pragma unroll
    for (int o = 1; o < 64; o <<= 1) v = fmaxf(v, __shfl_xor(v, o));
    return v;
}
__device__ __forceinline__ float sigmoidf_(float x) { return 1.0f / (1.0f + __expf(-x)); }
#define XB_TMO      128
#define XB_XCNT(j)  (256  + 64 * (j))
#define XB_XSUB(j)  (1280 + 64 * (j))
#define XB_XGEN(j)  (2304 + 64 * (j))
#define XB_TOP      3328
#define XB_TOPGEN   3392
#define XCD_BAR_WORDS 3456
#define XB_SPIN_CAP (1u << 18)

__device__ __forceinline__ unsigned xb_ld(unsigned* p)              { return __hip_atomic_load(p, __ATOMIC_RELAXED, __HIP_MEMORY_SCOPE_AGENT); }
__device__ __forceinline__ unsigned xb_add(unsigned* p, unsigned v) { return __hip_atomic_fetch_add(p, v, __ATOMIC_RELAXED, __HIP_MEMORY_SCOPE_AGENT); }
__device__ __forceinline__ unsigned xb_xcc_id() { return (unsigned)__builtin_amdgcn_s_getreg((3 << 11) | 20) & 0xFu; }
#define XB_SPIN(cond, bar) do { unsigned _sp = 0; while (cond) { __builtin_amdgcn_s_sleep(1); \
    if ((++_sp & 255u) == 0u) { if (xb_ld(&(bar)[XB_TMO])) break; if (_sp > XB_SPIN_CAP) { atomicAdd(&(bar)[XB_TMO], 1u); break; } } } } while (0)

struct XcdBarrier {
    unsigned* bar; unsigned x;
    volatile LAS unsigned* st;
};

__device__ __forceinline__ XcdBarrier xcd_barrier_post(unsigned* bar, volatile LAS unsigned* st) {
    XcdBarrier b; b.bar = bar; b.x = xb_xcc_id(); b.st = st;
    if (threadIdx.x == 0) (void)xb_add(&bar[XB_XCNT(b.x)], 1u);
    return b;
}
__device__ __forceinline__ void xcd_barrier_complete(unsigned* bar, unsigned x, unsigned& nloc, unsigned& nx) {
    const unsigned G = gridDim.x * gridDim.y * gridDim.z;
    unsigned sum, cnt, mine, sp = 0u;
    for (;;) {
        sum = 0u; cnt = 0u; mine = 0u;
#pragma unroll 1
        for (unsigned j = 0; j < 16; ++j) { const unsigned c = xb_ld(&bar[XB_XCNT(j)]); sum += c; cnt += (c > 0u) ? 1u : 0u; mine = (j == x) ? c : mine; }
        if (sum == G) break;
        __builtin_amdgcn_s_sleep(1);
        if ((++sp & 255u) == 0u) { if (xb_ld(&bar[XB_TMO])) break; if (sp > XB_SPIN_CAP) { atomicAdd(&bar[XB_TMO], 1u); break; } }
    }
    nloc = mine > 0u ? mine : 1u; nx = cnt > 0u ? cnt : 1u;
}

__device__ __forceinline__ void xcd_barrier(const XcdBarrier& b) {
    asm volatile("s_waitcnt vmcnt(0)" ::: "memory");
    __syncthreads();
    if (threadIdx.x == 0) {
        unsigned* bar = b.bar;
        __builtin_amdgcn_s_waitcnt(0);
        unsigned nloc = b.st[0], nx = b.st[1];
        if (nloc == 0u) { xcd_barrier_complete(bar, b.x, nloc, nx); b.st[0] = nloc; b.st[1] = nx; }
        const unsigned old = xb_add(&bar[XB_XSUB(b.x)], 1u);
        const unsigned gen = old / nloc;
        if (old + 1u == (gen + 1u) * nloc) {
            __builtin_amdgcn_fence(__ATOMIC_RELEASE, "agent");
            asm volatile("s_waitcnt vmcnt(0)" ::: "memory");
            const unsigned og = xb_add(&bar[XB_TOP], 1u);
            const unsigned tg = og / nx;
            if (og + 1u == (tg + 1u) * nx) xb_add(&bar[XB_TOPGEN], 1u);
            else XB_SPIN(xb_ld(&bar[XB_TOPGEN]) == tg, bar);
            __builtin_amdgcn_fence(__ATOMIC_ACQUIRE, "agent");
            xb_add(&bar[XB_XGEN(b.x)], 1u);
            asm volatile("s_waitcnt vmcnt(0)" ::: "memory");
        } else {
            XB_SPIN(xb_ld(&bar[XB_XGEN(b.x)]) == gen, bar);
            __builtin_amdgcn_fence(__ATOMIC_ACQUIRE, "agent");
            asm volatile("s_waitcnt vmcnt(0)" ::: "memory");
        }
    }
    __syncthreads();
}

struct Args { const float* in[19]; float* out; unsigned char* ws; float inv64[32]; float inv32[16]; };
struct Frame {
    unsigned char* lds;
    LAS unsigned char* lds3;
    volatile LAS unsigned* MISC;
    unsigned* ctl;
    unsigned char* ws;
    int tid, lane, wave, G, gw, ngw;
};
#define PHASE_IDS(F) do { int t_ = threadIdx.x; asm volatile("" : "+v"(t_)); (F).tid = t_; (F).lane = t_ & 63; (F).wave = __builtin_amdgcn_readfirstlane(t_ >> 6); (F).gw = blockIdx.x * NWAVES + (F).wave; } while (0)


__device__ __forceinline__ void transpose_item(const float* W, int K, int N, int srccol  , bf16* WT, int n0, int k0, float* scr, int lane) {
#pragma unroll 8
    for (int i = 0; i < 32; ++i) { const int kk = 2 * i + (lane >> 5); scr[kk * 33 + (lane & 31)] = srccol >= 0 ? W[(size_t)(k0 + kk) * N + srccol] : 0.f; }
    LDS_WAIT(); asm volatile("" ::: "memory");
    const int c = lane & 7;
#pragma unroll
    for (int j = 0; j < 4; ++j) { const int n = (lane >> 3) + 8 * j; const float* s = scr + (8 * c) * 33 + n;
        v4u o; o.x = pk2(s[0 * 33], s[1 * 33]); o.y = pk2(s[2 * 33], s[3 * 33]); o.z = pk2(s[4 * 33], s[5 * 33]); o.w = pk2(s[6 * 33], s[7 * 33]);
        *(v4u*)(WT + (size_t)(n0 + n) * K + k0 + 8 * c) = o; }
    LDS_WAIT(); asm volatile("" ::: "memory");
}
__device__ __forceinline__ void convert_weights(Frame& F, const Args& a, int layer) {
    PHASE_IDS(F);
    float* scr = (float*)(F.lds + F.wave * 16384);
    const float* w_in = a.in[2] + (size_t)layer * DM * DIN; const float* w_out = a.in[13] + (size_t)layer * DM * DM;
    const float* w_gate = a.in[15] + (size_t)layer * DM * DFF; const float* w_up = a.in[16] + (size_t)layer * DM * DFF; const float* w_down = a.in[17] + (size_t)layer * DFF * DM;
    bf16* WIN = (bf16*)(F.ws + WS_WIN); bf16* WOUT = (bf16*)(F.ws + WS_WOUT); bf16* WGU = (bf16*)(F.ws + WS_WGU); bf16* WD = (bf16*)(F.ws + WS_WD);
    constexpr int I_IN = (DM / 64) * (DINP / 32), I_OUT = (DM / 64) * (DM / 32), I_GU = (DM / 64) * (2 * DFF / 32), I_D = (DFF / 64) * (DM / 32);
    constexpr int NITEMS = I_IN + I_OUT + I_GU + I_D;
    for (int it = F.gw; it < NITEMS; it += F.ngw) {
        int r = it; const int l31 = F.lane & 31;
        if (r < I_IN) { const int nblk = DINP / 32, kb = r / nblk, nb = r % nblk; transpose_item(w_in, DM, DIN, zsrc(nb * 32 + l31), WIN, nb * 32, kb * 64, scr, F.lane); continue; } r -= I_IN;
        if (r < I_OUT) { const int nblk = DM / 32, kb = r / nblk, nb = r % nblk; transpose_item(w_out, DM, DM, nb * 32 + l31, WOUT, nb * 32, kb * 64, scr, F.lane); continue; } r -= I_OUT;
        if (r < I_GU) { const int nblk = 2 * DFF / 32, kb = r / nblk, nb = r % nblk, n0 = nb * 32, pn = n0 >> 8, w = n0 & 255;
            transpose_item(w < 128 ? w_gate : w_up, DM, DFF, 128 * pn + (w & 127) + l31, WGU, n0, kb * 64, scr, F.lane); continue; } r -= I_GU;
        { const int nblk = DM / 32, kb = r / nblk, nb = r % nblk; transpose_item(w_down, DFF, DM, nb * 32 + l31, WD, nb * 32, kb * 64, scr, F.lane); }
    }
}
__device__ __forceinline__ void sincos_d(float ang, float& c, float& s) {
    const double a = (double)ang; const double q = __builtin_rint(a * 0.63661977236758134308); const double r = a - q * 1.57079632679489661923; const double r2 = r * r;
    double sp = -1.0 / 39916800.0; sp = sp * r2 + 1.0 / 362880.0; sp = sp * r2 - 1.0 / 5040.0; sp = sp * r2 + 1.0 / 120.0; sp = sp * r2 - 1.0 / 6.0; sp = sp * r2 + 1.0; sp *= r;
    double cp = 1.0 / 479001600.0; cp = cp * r2 - 1.0 / 3628800.0; cp = cp * r2 + 1.0 / 40320.0; cp = cp * r2 - 1.0 / 720.0; cp = cp * r2 + 1.0 / 24.0; cp = cp * r2 - 0.5; cp = cp * r2 + 1.0;
    const int n = ((int)q) & 3; const double cc = (n == 0) ? cp : (n == 1) ? -sp : (n == 2) ? -cp : sp; const double ss = (n == 0) ? sp : (n == 1) ? cp : (n == 2) ? -sp : -cp;
    c = (float)cc; s = (float)ss;
}
__device__ __forceinline__ void build_rope(Frame& F, const Args& a) {
    PHASE_IDS(F);
    f32x2* R64 = (f32x2*)(F.ws + WS_ROPE64); f32x2* R32 = (f32x2*)(F.ws + WS_ROPE32);
    const int gt = F.gw * 64 + F.lane, ngt = F.ngw * 64;
    for (int i = gt; i < SEQ * 48; i += ngt) { const int pos = i / 48, j = i % 48; float c, s;
        if (j < 32) { sincos_d((float)pos * a.inv64[j], c, s); R64[pos * 32 + j] = (f32x2){c, s}; }
        else { sincos_d((float)pos * a.inv32[j - 32], c, s); R32[pos * 16 + (j - 32)] = (f32x2){c, s}; } }
}
__device__ __forceinline__ void norm_rows_bf16(Frame& F, const float* X, const float* g, bf16* H) {
    PHASE_IDS(F);
    for (int row = F.gw; row < T; row += F.ngw) {
        const f32x4* xr = (const f32x4*)(X + (size_t)row * DM) + F.lane; f32x4 v[4]; float ss = 0.f;
#pragma unroll
        for (int j = 0; j < 4; ++j) { v[j] = xr[64 * j]; ss += (v[j].x * v[j].x + v[j].y * v[j].y) + (v[j].z * v[j].z + v[j].w * v[j].w); }
        const float r = 1.0f / sqrtf(wave_sum(ss) * (1.0f / DM) + EPS);
        v2u* o = (v2u*)(H + (size_t)row * DM) + F.lane;
#pragma unroll
        for (int j = 0; j < 4; ++j) { const f32x4 gg = ((const f32x4*)g)[64 * j + F.lane]; v2u w; w.x = pk2(v[j].x * r * gg.x, v[j].y * r * gg.y); w.y = pk2(v[j].z * r * gg.z, v[j].w * r * gg.w); o[64 * j] = w; }
    }
}
__device__ __forceinline__ void norm_rows_f32_inplace(Frame& F, float* X, const float* g) {
    PHASE_IDS(F);
    for (int row = F.gw; row < T; row += F.ngw) {
        f32x4* xr = (f32x4*)(X + (size_t)row * DM) + F.lane; f32x4 v[4]; float ss = 0.f;
#pragma unroll
        for (int j = 0; j < 4; ++j) { v[j] = xr[64 * j]; ss += (v[j].x * v[j].x + v[j].y * v[j].y) + (v[j].z * v[j].z + v[j].w * v[j].w); }
        const float r = 1.0f / sqrtf(wave_sum(ss) * (1.0f / DM) + EPS);
#pragma unroll
        for (int j = 0; j < 4; ++j) { const f32x4 gg = ((const f32x4*)g)[64 * j + F.lane]; xr[64 * j] = v[j] * r * gg; }
    }
}

__device__ __forceinline__ void prep_rope(Frame& F) {
    PHASE_IDS(F);
    bf16* Z = (bf16*)(F.ws + WS_Z); bf16* AQR = (bf16*)(F.ws + WS_AQR);
    const f32x2* R64 = (const f32x2*)(F.ws + WS_ROPE64); const f32x2* R32 = (const f32x2*)(F.ws + WS_ROPE32);
    for (int row = F.gw; row < T; row += F.ngw) {
        const int pos = row & (SEQ - 1); bf16* zr = Z + (size_t)row * DINP; bf16* qr = AQR + (size_t)row * 256;
#pragma unroll 1
        for (int it = 0; it < 11; ++it) {
            const int u = 2 * it + (F.lane >> 5), p = F.lane & 31;
            int base; bool d32 = false; bf16* dst = zr;
            if (u < 4) { base = ZAQ + 64 * u; dst = qr - ZAQ; }
            else if (u == 4) base = ZKS; else if (u == 5) base = ZKW;
            else if (u < 10) { base = ZBQ + 64 * (u - 6); d32 = true; } else if (u < 14) { base = ZBK + 64 * (u - 10); d32 = true; }
            else if (u < 18) base = ZDQ + 64 * (u - 14); else base = ZDK + 64 * (u - 18);
            int c1, c2; f32x2 cs;
            if (d32) { const int comp = p >> 4, i = p & 15; c1 = base + 32 * comp + i; c2 = c1 + 16; cs = R32[pos * 16 + i]; }
            else { c1 = base + p; c2 = c1 + 32; cs = R64[pos * 32 + p]; }
            const float x1 = bf2f(zr[c1]), x2 = bf2f(zr[c2]);
            dst[c1] = (bf16)f2bf(x1 * cs.x - x2 * cs.y); dst[c2] = (bf16)f2bf(x1 * cs.y + x2 * cs.x);
        }
    }
}
__device__ __forceinline__ void prep_compress(Frame& F, const Args& a, int layer) {
    PHASE_IDS(F);
    const bf16* Z = (const bf16*)(F.ws + WS_Z);
    for (int it = F.gw; it < NB * 2 * 64; it += F.ngw) {
        const int b = it >> 7, br = (it >> 6) & 1, n0 = (it & 63) * 4;
        const float* pos = a.in[3] + ((size_t)layer * 2 + br) * 2048; const float* w = a.in[4] + ((size_t)layer * 2 + br) * 2048 * 64;
        const int zc = br ? ZVC : ZKC; float acc[4] = {0.f, 0.f, 0.f, 0.f};
        for (int l = 0; l < 32; ++l) {
#pragma unroll 4
            for (int d = 0; d < 64; ++d) { const float wv = w[(size_t)(l * 64 + d) * 64 + F.lane], pv = pos[l * 64 + d];
#pragma unroll
                for (int i = 0; i < 4; ++i) { int tok = 16 * (n0 + i) + l; tok = tok < SEQ ? tok : SEQ - 1; acc[i] += (bf2f(Z[(size_t)(b * SEQ + tok) * DINP + zc + d]) + pv) * wv; } }
        }
        float* O = (float*)(F.ws + (br ? WS_VC : WS_KC)) + (size_t)b * 256 * 64;
#pragma unroll
        for (int i = 0; i < 4; ++i) O[(n0 + i) * 64 + F.lane] = (n0 + i < 255) ? acc[i] : 0.f;
    }
}
__device__ __forceinline__ float log_sigmoid_(float x) { return x >= 0.f ? -log1pf(__expf(-x)) : x - log1pf(__expf(x)); }
__device__ __forceinline__ void prep_mlstm(Frame& F, const Args& a, int layer) {
    PHASE_IDS(F);
    const bf16* Z = (const bf16*)(F.ws + WS_Z);
    float* L = (float*)F.lds; float* UC = L; float* QS = L + 4224; float* KS = L + 8448; float* VS = L + 12672; float* WQ = L + 16896; float* WK = L + 21120; float* WE = L + 25344;
    const float* convw = a.in[7] + (size_t)layer * 4 * 256; const float* convb = a.in[8] + (size_t)layer * 256;
    const float* gb = a.in[11] + (size_t)layer * 8;
    float* MQ = (float*)(F.ws + WS_MQ); float* MK = (float*)(F.ws + WS_MK); float* CLOC = (float*)(F.ws + WS_CLOC); float* NLOC = (float*)(F.ws + WS_NLOC);
    float* BCUM = (float*)(F.ws + WS_BCUM); float* IG = (float*)(F.ws + WS_IG); float* ACH = (float*)(F.ws + WS_ACH); float* MLOC = (float*)(F.ws + WS_MLOC);
    for (int it = blockIdx.x; it < 1024; it += F.G) {
        const int bh = it >> 6, c = it & 63, b = bh >> 2, h = bh & 3, t0 = c * 64; const size_t row0 = (size_t)b * SEQ + t0;
        const float* wq = a.in[9] + ((size_t)layer * 4 + h) * 4096; const float* wk = a.in[10] + ((size_t)layer * 4 + h) * 4096;
        __syncthreads();
        for (int i = F.tid; i < 4096; i += NTHREADS) { const int l = i >> 6, d = i & 63, ch = h * 64 + d; float s = convb[ch];
#pragma unroll
            for (int j = 0; j < 4; ++j) { const int t = t0 + l - 3 + j; if (t >= 0) s += convw[j * 256 + ch] * bf2f(Z[((size_t)b * SEQ + t) * DINP + ZCU + ch]); }
            UC[l * 65 + d] = s * sigmoidf_(s); VS[i] = bf2f(Z[(row0 + l) * DINP + ZCV + ch]); WQ[i] = wq[i]; WK[i] = wk[i]; }
        if (F.wave == 0) { const int l = F.lane; const size_t row = row0 + l;
            const float ig = bf2f(Z[row * DINP + ZCI + h]) + gb[h]; float bc = log_sigmoid_(bf2f(Z[row * DINP + ZCF + h]) + gb[4 + h]);
#pragma unroll
            for (int o = 1; o < 64; o <<= 1) { const float v = __shfl_up(bc, o); if (l >= o) bc += v; }
            const float ach = __shfl(bc, 63); const float ge = ach - bc + ig; const float ml = wave_max(ge);
            WE[l] = __expf(ge - ml); BCUM[row * 4 + h] = bc; IG[row * 4 + h] = ig; if (l == 0) { ACH[it] = ach; MLOC[it] = ml; } }
        __syncthreads();
        { const int l = F.tid >> 3, eg = (F.tid & 7) * 8; float qa[8], ka[8];
#pragma unroll
            for (int i = 0; i < 8; ++i) { qa[i] = 0.f; ka[i] = 0.f; }
            for (int d = 0; d < 64; ++d) { const float u = UC[l * 65 + d];
#pragma unroll
                for (int i = 0; i < 8; ++i) { qa[i] += u * WQ[d * 64 + eg + i]; ka[i] += u * WK[d * 64 + eg + i]; } }
#pragma unroll
            for (int i = 0; i < 8; ++i) { ka[i] *= 0.125f; QS[l * 64 + eg + i] = qa[i]; KS[l * 64 + eg + i] = ka[i];
                MQ[(row0 + l) * 256 + h * 64 + eg + i] = qa[i]; MK[(row0 + l) * 256 + h * 64 + eg + i] = ka[i]; } }
        __syncthreads();
        { const int v = F.tid >> 3, kg = (F.tid & 7) * 8; float acc[8];
#pragma unroll
            for (int i = 0; i < 8; ++i) acc[i] = 0.f;
            for (int l = 0; l < 64; ++l) { const float wv = WE[l] * VS[l * 64 + v];
#pragma unroll
                for (int i = 0; i < 8; ++i) acc[i] += wv * KS[l * 64 + kg + i]; }
#pragma unroll
            for (int i = 0; i < 8; ++i) CLOC[(size_t)it * 4096 + v * 64 + kg + i] = acc[i];
            if (F.tid < 64) { float n = 0.f; for (int l = 0; l < 64; ++l) n += WE[l] * KS[l * 64 + F.tid]; NLOC[it * 64 + F.tid] = n; } }
    }
    __syncthreads();
}

__device__ __forceinline__ void ld8(const bf16* p, float* o) { const v4u w = *(const v4u*)p; o[0] = bflo(w.x); o[1] = bfhi(w.x); o[2] = bflo(w.y); o[3] = bfhi(w.y); o[4] = bflo(w.z); o[5] = bfhi(w.z); o[6] = bflo(w.w); o[7] = bfhi(w.w); }
template <int DK> __device__ __forceinline__ void load_q(const bf16* p, float (&q)[64]) {
#pragma unroll
    for (int g = 0; g < DK / 8; ++g) ld8(p + 8 * g, &q[8 * g]);
}
template <int DK> __device__ __forceinline__ float dot_qk(const float (&q)[64], const bf16* kp) {
    float s = 0.f;
#pragma unroll
    for (int g = 0; g < DK / 8; ++g) { float k[8]; ld8(kp + 8 * g, k);
#pragma unroll
        for (int i = 0; i < 8; ++i) s += q[8 * g + i] * k[i]; }
    return s;
}
__device__ __forceinline__ void attn_upd(float s, const bf16* vp, float& m, float& l, float (&o)[64]) {
    const float mn = fmaxf(m, s), c = __expf(m - mn), p = __expf(s - mn);
    l = l * c + p;
#pragma unroll
    for (int g = 0; g < 8; ++g) { float v[8]; ld8(vp + 8 * g, v);
#pragma unroll
        for (int i = 0; i < 8; ++i) o[8 * g + i] = o[8 * g + i] * c + p * v[i]; }
    m = mn;
}
__device__ __forceinline__ float reduce_scatter64(float (&o)[64], int lane) {
#pragma unroll
    for (int i = 0; i < 32; ++i) { const bool hi = lane & 32; const float send = hi ? o[i] : o[i + 32], keep = hi ? o[i + 32] : o[i]; o[i] = keep + __shfl_xor(send, 32); }
#pragma unroll
    for (int i = 0; i < 16; ++i) { const bool hi = lane & 16; const float send = hi ? o[i] : o[i + 16], keep = hi ? o[i + 16] : o[i]; o[i] = keep + __shfl_xor(send, 16); }
#pragma unroll
    for (int i = 0; i < 8; ++i) { const bool hi = lane & 8; const float send = hi ? o[i] : o[i + 8], keep = hi ? o[i + 8] : o[i]; o[i] = keep + __shfl_xor(send, 8); }
#pragma unroll
    for (int i = 0; i < 4; ++i) { const bool hi = lane & 4; const float send = hi ? o[i] : o[i + 4], keep = hi ? o[i + 4] : o[i]; o[i] = keep + __shfl_xor(send, 4); }
#pragma unroll
    for (int i = 0; i < 2; ++i) { const bool hi = lane & 2; const float send = hi ? o[i] : o[i + 2], keep = hi ? o[i + 2] : o[i]; o[i] = keep + __shfl_xor(send, 2); }
    { const bool hi = lane & 1; const float send = hi ? o[0] : o[1], keep = hi ? o[1] : o[0]; o[0] = keep + __shfl_xor(send, 1); }
    return o[0];
}
__device__ __forceinline__ float attn_fin(float m, float l, float (&o)[64], int lane) {
    const float M = wave_max(m); const float c = (m == -INFINITY) ? 0.f : __expf(m - M);
    const float L = wave_sum(l * c);
#pragma unroll
    for (int d = 0; d < 64; ++d) o[d] *= c;
    const float v = reduce_scatter64(o, lane);
    return L > 0.f ? v / L : 0.f;
}
__device__ __forceinline__ int bal_t(int tt) { return tt < 2048 ? tt : 6143 - tt; }

__device__ __forceinline__ void ph_cmp_topk(Frame& F) {
    PHASE_IDS(F);
    const bf16* Z = (const bf16*)(F.ws + WS_Z); const float* KC = (const float*)(F.ws + WS_KC); const float* VC = (const float*)(F.ws + WS_VC);
    bf16* OCMP = (bf16*)(F.ws + WS_OCMP); unsigned long long* SEL = (unsigned long long*)(F.ws + WS_SEL);
    float* ps = (float*)(F.lds + F.wave * 2048);
    for (int idx = F.gw; idx < T; idx += F.ngw) {
        const int b = idx >> 12, t = bal_t(idx & 4095), row = b * SEQ + t, lane = F.lane;
        const int nvalid = t >= 31 ? ((t - 31) >> 4) + 1 : 0;
        float psum[4] = {0.f, 0.f, 0.f, 0.f};
        const float* kcb = KC + (size_t)b * 256 * 64; const float* vcb = VC + (size_t)b * 256 * 64;
#pragma unroll 1
        for (int h = 0; h < 4; ++h) {
            float q[64]; load_q<64>(Z + (size_t)row * DINP + ZAQ + 64 * h, q);
            float s[4]; float mx = -INFINITY;
#pragma unroll
            for (int k = 0; k < 4; ++k) { const int n = lane + 64 * k; float acc = 0.f;
                if (n < nvalid) { const f32x4* kp = (const f32x4*)(kcb + n * 64);
#pragma unroll
                    for (int g = 0; g < 16; ++g) { const f32x4 kv = kp[g]; acc += q[4 * g] * kv.x + q[4 * g + 1] * kv.y + q[4 * g + 2] * kv.z + q[4 * g + 3] * kv.w; }
                    s[k] = acc * 0.125f; } else s[k] = -INFINITY;
                mx = fmaxf(mx, s[k]); }
            mx = wave_max(mx);
            float e[4], es = 0.f;
#pragma unroll
            for (int k = 0; k < 4; ++k) { e[k] = (lane + 64 * k < nvalid) ? __expf(s[k] - mx) : 0.f; es += e[k]; }
            es = wave_sum(es); const float inv = es > 0.f ? 1.0f / es : 0.f;
            float o[64];
#pragma unroll
            for (int d = 0; d < 64; ++d) o[d] = 0.f;
#pragma unroll
            for (int k = 0; k < 4; ++k) { const float p = e[k] * inv; psum[k] += p; const int n = lane + 64 * k;
                if (n < nvalid) { const f32x4* vp = (const f32x4*)(vcb + n * 64);
#pragma unroll
                    for (int g = 0; g < 16; ++g) { const f32x4 vv = vp[g]; o[4 * g] += p * vv.x; o[4 * g + 1] += p * vv.y; o[4 * g + 2] += p * vv.z; o[4 * g + 3] += p * vv.w; } } }
            const float od = reduce_scatter64(o, lane);
            OCMP[(size_t)row * 256 + 64 * h + lane] = (bf16)f2bf(od);
        }
#pragma unroll
        for (int k = 0; k < 4; ++k) ps[lane + 64 * k] = psum[k];
        LDS_WAIT(); asm volatile("" ::: "memory");
        const int j = lane, cur = t >> 6; float imp = ps[4 * j];
        if (j > 0) imp += 2.f * (ps[4 * j - 1] + ps[4 * j - 2] + ps[4 * j - 3]) + ps[4 * j - 4];
        LDS_WAIT(); asm volatile("" ::: "memory");
        const bool forced = (j == 0) || (j <= cur && j > cur - 2);
        const float sc = (j > cur) ? -1.0e6f : (forced ? 1.0e6f : imp);
        int rank = 0;
#pragma unroll 8
        for (int i = 0; i < 64; ++i) { const float si = __shfl(sc, i); rank += (si > sc || (si == sc && i < j)) ? 1 : 0; }
        const unsigned long long mask = __ballot(rank < 16 && j <= cur);
        if (lane == 0) SEL[row] = mask;
    }
}
__device__ __forceinline__ float diff_comp(const bf16* Z, int b, int h, int t, int comp, size_t row, float scale, int lane) {
    float q[64]; load_q<32>(Z + row * DINP + ZBQ + 64 * h + 32 * comp, q);
    float m = -INFINITY, l = 0.f, o[64];
#pragma unroll
    for (int d = 0; d < 64; ++d) o[d] = 0.f;
    for (int kp = lane; kp <= t; kp += 64) { const bf16* kr = Z + ((size_t)b * SEQ + kp) * DINP;
        const float s = dot_qk<32>(q, kr + ZBK + 64 * h + 32 * comp) * scale; attn_upd(s, kr + ZBV + 64 * h, m, l, o); }
    return attn_fin(m, l, o, lane);
}
__device__ __forceinline__ void ph_diff(Frame& F, const Args& a, int layer) {
    PHASE_IDS(F);
    const bf16* Z = (const bf16*)(F.ws + WS_Z); bf16* AO = (bf16*)(F.ws + WS_H);
    const float* lv = a.in[5] + (size_t)layer * 128; const float* sg = a.in[6] + (size_t)layer * 64;
    const float lam_init = 0.8f - 0.6f * expf(-0.3f * (float)layer);
    float l01 = 0.f, l23 = 0.f; if (F.lane < 32) { l01 = lv[F.lane] * lv[32 + F.lane]; l23 = lv[64 + F.lane] * lv[96 + F.lane]; }
    const float lam = expf(wave_sum(l01)) - expf(wave_sum(l23)) + lam_init;
    const float scale = 0.17677669529663687f;
    for (int idx = F.gw; idx < T * 4; idx += F.ngw) {
        const int bh = idx >> 12, b = bh >> 2, h = bh & 3, t = bal_t(idx & 4095), lane = F.lane; const size_t row = (size_t)b * SEQ + t;
        const float val0 = diff_comp(Z, b, h, t, 0, row, scale, lane), val1 = diff_comp(Z, b, h, t, 1, row, scale, lane);
        const float hd = val0 - lam * val1; const float ss = wave_sum(hd * hd);
        const float y = hd * (1.0f / sqrtf(ss * (1.0f / 64.0f) + EPS)) * sg[lane] * (1.0f - lam_init);
        AO[row * DM + 256 + 64 * h + lane] = (bf16)f2bf(y);
    }
}
__device__ __forceinline__ void ph_dilated(Frame& F) {
    PHASE_IDS(F);
    const bf16* Z = (const bf16*)(F.ws + WS_Z); bf16* AO = (bf16*)(F.ws + WS_H);
    for (int idx = F.gw; idx < T * 4; idx += F.ngw) {
        const int bh = idx >> 12, b = bh >> 2, h = bh & 3, t = idx & 4095, lane = F.lane; const size_t row = (size_t)b * SEQ + t;
        float q[64]; load_q<64>(Z + row * DINP + ZDQ + 64 * h, q);
        float m = -INFINITY, l = 0.f, o[64];
#pragma unroll
        for (int d = 0; d < 64; ++d) o[d] = 0.f;
#pragma unroll 1
        for (int k = 0; k < 7; ++k) { const int i = lane + 64 * k; const int g = i / 129, j = i - g * 129; const int dil = (g == 0) ? 1 : (g == 1) ? 4 : 16; const int kp = t - j * dil;
            if (i < 387 && kp >= 0) { const bf16* kr = Z + ((size_t)b * SEQ + kp) * DINP; const float s = dot_qk<64>(q, kr + ZDK + 64 * h) * 0.125f; attn_upd(s, kr + ZDV + 64 * h, m, l, o); } }
        const float v = attn_fin(m, l, o, lane);
        AO[row * DM + 768 + 64 * h + lane] = (bf16)f2bf(v);
    }
}
__device__ __forceinline__ void ph_mlstm_scan(Frame& F) {
    PHASE_IDS(F);
    float* CLOC = (float*)(F.ws + WS_CLOC); float* NLOC = (float*)(F.ws + WS_NLOC);
    const float* ACH = (const float*)(F.ws + WS_ACH); const float* MLOC = (const float*)(F.ws + WS_MLOC); float* MIN = (float*)(F.ws + WS_MIN);
    for (int it = blockIdx.x; it < 64; it += F.G) {
        const int bh = it >> 2, qt = it & 3; const int e0 = qt * 1024 + F.tid * 2;
        float c0 = 0.f, c1 = 0.f, nst = 0.f, mst = 0.f;
        for (int c = 0; c < 64; ++c) {
            const int ci = bh * 64 + c; const float ac = ACH[ci], ml = MLOC[ci];
            float* cp = CLOC + (size_t)ci * 4096 + e0; const f32x2 cl = *(const f32x2*)cp;
            const float mn = fmaxf(ac + mst, ml), decay = __expf(ac + mst - mn), fresh = __expf(ml - mn);
            *(f32x2*)cp = (f32x2){c0, c1}; c0 = decay * c0 + fresh * cl.x; c1 = decay * c1 + fresh * cl.y;
            if (qt == 0 && F.tid < 64) { const float nl = NLOC[ci * 64 + F.tid]; NLOC[ci * 64 + F.tid] = nst; nst = decay * nst + fresh * nl; if (F.tid == 0) MIN[ci] = mst; }
            mst = mn;
        }
    }
}

__device__ __forceinline__ void ph_nsa_sw(Frame& F) {
    PHASE_IDS(F);
    const bf16* Z = (const bf16*)(F.ws + WS_Z); const bf16* AQR = (const bf16*)(F.ws + WS_AQR); const bf16* OCMP = (const bf16*)(F.ws + WS_OCMP);
    const unsigned long long* SEL = (const unsigned long long*)(F.ws + WS_SEL); bf16* AO = (bf16*)(F.ws + WS_H);
    for (int idx = F.gw; idx < T * 4; idx += F.ngw) {
        const int bh = idx >> 12, b = bh >> 2, h = bh & 3, t = bal_t(idx & 4095), lane = F.lane; const size_t row = (size_t)b * SEQ + t;
        float q[64]; load_q<64>(AQR + row * 256 + 64 * h, q);
        const unsigned long long mk = SEL[row]; unsigned mlo = __builtin_amdgcn_readfirstlane((unsigned)mk), mhi = __builtin_amdgcn_readfirstlane((unsigned)(mk >> 32));
        float m = -INFINITY, l = 0.f, o[64];
#pragma unroll
        for (int d = 0; d < 64; ++d) o[d] = 0.f;
#pragma unroll 1
        for (int j = 0; j < 64; ++j) { const unsigned bit = (j < 32) ? (mlo >> j) & 1u : (mhi >> (j - 32)) & 1u; if (!bit) continue;
            const int kp = 64 * j + lane; if (kp <= t) { const bf16* kr = Z + ((size_t)b * SEQ + kp) * DINP; const float s = dot_qk<64>(q, kr + ZKS) * 0.125f; attn_upd(s, kr + ZVS, m, l, o); } }
        const float oslc = attn_fin(m, l, o, lane);
        m = -INFINITY; l = 0.f;
#pragma unroll
        for (int d = 0; d < 64; ++d) o[d] = 0.f;
#pragma unroll 1
        for (int k = 0; k < 8; ++k) { const int kp = t - 511 + lane + 64 * k;
            if (kp >= 0) { const bf16* kr = Z + ((size_t)b * SEQ + kp) * DINP; const float s = dot_qk<64>(q, kr + ZKW) * 0.125f; attn_upd(s, kr + ZVW, m, l, o); } }
        const float owin = attn_fin(m, l, o, lane);
        const bf16* zr = Z + row * DINP + ZAG; const float g0 = sigmoidf_(bf2f(zr[h])), g1 = sigmoidf_(bf2f(zr[4 + h])), g2 = sigmoidf_(bf2f(zr[8 + h]));
        const float out = g0 * bf2f(OCMP[row * 256 + 64 * h + lane]) + g1 * oslc + g2 * owin;
        AO[row * DM + 64 * h + lane] = (bf16)f2bf(out);
    }
}
__device__ __forceinline__ void ph_mlstm_out(Frame& F, const Args& a, int layer) {
    PHASE_IDS(F);
    const bf16* Z = (const bf16*)(F.ws + WS_Z); bf16* AO = (bf16*)(F.ws + WS_H);
    const float* MQ = (const float*)(F.ws + WS_MQ); const float* MK = (const float*)(F.ws + WS_MK); const float* CIN = (const float*)(F.ws + WS_CLOC); const float* NIN = (const float*)(F.ws + WS_NLOC);
    const float* BCUM = (const float*)(F.ws + WS_BCUM); const float* IG = (const float*)(F.ws + WS_IG); const float* MIN = (const float*)(F.ws + WS_MIN);
    const float* hg = a.in[12] + (size_t)layer * 256;
    float* L = (float*)F.lds; float* QS = L; float* KS = L + 4224; float* VS = L + 8448; float* CS = L + 12672; float* SS = L + 16896;
    float* NI = L + 21120; float* BC = NI + 64; float* IGS = BC + 64; float* MT = IGS + 64; float* EI = MT + 64;
    for (int it = blockIdx.x; it < 1024; it += F.G) {
        const int bh = it >> 6, c = it & 63, b = bh >> 2, h = bh & 3; const size_t row0 = (size_t)b * SEQ + c * 64;
        __syncthreads();
        for (int i = F.tid; i < 4096; i += NTHREADS) { const int l = i >> 6, d = i & 63; const size_t g = (row0 + l) * 256 + h * 64 + d;
            QS[l * 65 + d] = MQ[g]; KS[l * 65 + d] = MK[g]; VS[l * 65 + d] = bf2f(Z[(row0 + l) * DINP + ZCV + h * 64 + d]); CS[l * 65 + d] = CIN[(size_t)it * 4096 + i]; }
        if (F.wave == 0) { const int l = F.lane; const float bc = BCUM[(row0 + l) * 4 + h], ig = IG[(row0 + l) * 4 + h], mi = MIN[it];
            NI[l] = NIN[it * 64 + l]; BC[l] = bc; IGS[l] = ig;
            float pm = ig - bc;
#pragma unroll
            for (int o = 1; o < 64; o <<= 1) { const float v = __shfl_up(pm, o); if (l >= o) pm = fmaxf(pm, v); }
            const float inter = bc + mi, mt = fmaxf(inter, bc + pm); MT[l] = mt; EI[l] = __expf(inter - mt); }
        __syncthreads();
        { const int t = F.tid >> 3, sg = (F.tid & 7) * 8; const float bt = BC[t], mt = MT[t];
#pragma unroll 1
            for (int i = 0; i < 8; ++i) { const int s = sg + i; float v = 0.f;
                if (s <= t) { float dp = 0.f;
#pragma unroll 16
                    for (int d = 0; d < 64; ++d) dp += QS[t * 65 + d] * KS[s * 65 + d];
                    v = dp * __expf(bt - BC[s] + IGS[s] - mt); }
                SS[t * 65 + s] = v; } }
        __syncthreads();
        { const int t = F.tid >> 3, vg = (F.tid & 7) * 8; float num[8]; const float ei = EI[t];
#pragma unroll
            for (int i = 0; i < 8; ++i) num[i] = 0.f;
            float nq = 0.f, ssum = 0.f;
            for (int k = 0; k < 64; ++k) { const float qv = QS[t * 65 + k]; nq += NI[k] * qv;
#pragma unroll
                for (int i = 0; i < 8; ++i) num[i] += CS[(vg + i) * 65 + k] * qv; }
#pragma unroll
            for (int i = 0; i < 8; ++i) num[i] *= ei;
            for (int s = 0; s < 64; ++s) { const float sv = SS[t * 65 + s]; ssum += sv;
#pragma unroll
                for (int i = 0; i < 8; ++i) num[i] += sv * VS[s * 65 + vg + i]; }
            const float den = ei * nq + ssum; const float dn = fmaxf(fabsf(den), __expf(-MT[t])); const float rd = 1.0f / dn;
            float sq = 0.f;
#pragma unroll
            for (int i = 0; i < 8; ++i) { num[i] *= rd; sq += num[i] * num[i]; }
            sq += __shfl_xor(sq, 1); sq += __shfl_xor(sq, 2); sq += __shfl_xor(sq, 4);
            const float rn = 1.0f / sqrtf(sq * (1.0f / 64.0f) + EPS); const size_t row = row0 + t;
            unsigned w[4];
#pragma unroll
            for (int i = 0; i < 8; i += 2) { const int ch = h * 64 + vg + i;
                const float y0 = num[i] * rn * hg[ch] * sigmoidf_(bf2f(Z[row * DINP + ZCO + ch])), y1 = num[i + 1] * rn * hg[ch + 1] * sigmoidf_(bf2f(Z[row * DINP + ZCO + ch + 1]));
                w[i >> 1] = pk2(y0, y1); }
            *(v4u*)(AO + row * DM + 512 + h * 64 + vg) = (v4u){w[0], w[1], w[2], w[3]}; }
    }
    __syncthreads();
}

constexpr int NPHASE = 9 * DEPTH + 1;
#ifndef PH_LO
#define PH_LO 0
#endif
#ifndef PH_HI
#define PH_HI NPHASE
#endif
#define IN(k) (PH_LO <= (k) && (k) < PH_HI)
#define SEAM(k) do { if (IN(k) && IN((k) + 1)) { if ((k) == PH_LO) cg::this_grid().sync(); xcd_barrier(bar); } } while (0)
template <int layer> __device__ __forceinline__ void run_layer(Frame& F, const Args& args, const XcdBarrier& bar) {
    float* XR = args.out;
    bf16* H = (bf16*)(F.ws + WS_H); bf16* Z = (bf16*)(F.ws + WS_Z);
    bf16* WIN = (bf16*)(F.ws + WS_WIN); bf16* WOUT = (bf16*)(F.ws + WS_WOUT); bf16* WGU = (bf16*)(F.ws + WS_WGU); bf16* WD = (bf16*)(F.ws + WS_WD);

        const int P = 9 * layer;
        if (IN(P + 0)) {
            convert_weights(F, args, layer);
            if (layer == 0) build_rope(F, args);
            norm_rows_bf16(F, layer == 0 ? args.in[0] : XR, args.in[1] + (size_t)layer * DM, H);
        }
        SEAM(P + 0);
        if (IN(P + 1)) {
            pg8::Gemm g{H, WIN, T, DINP, DM}; pg8::StaticOrder S; S.init(T, DINP, F.G, (int)blockIdx.x); pg8::EpiZ E{Z, DINP};
            pg8::gemm_phase<pg8::EpiZ, pg8::StaticOrder, true, true>(F.lds3, g, S, E);
        }
        SEAM(P + 1);
        if (IN(P + 2)) {
#ifndef NO_C1
 prep_mlstm(F, args, layer);
#endif
#ifndef NO_C2
 prep_compress(F, args, layer);
#endif
#ifndef NO_C3
 prep_rope(F);
#endif
 }
        SEAM(P + 2);
        if (IN(P + 3)) {
#ifndef NO_D1
 ph_mlstm_scan(F);
#endif
#ifndef NO_D2
 ph_diff(F, args, layer);
#endif
#ifndef NO_D3
 ph_cmp_topk(F);
#endif
#ifndef NO_D4
 ph_dilated(F);
#endif
 }
        SEAM(P + 3);
        if (IN(P + 4)) {
#ifndef NO_E1
 ph_nsa_sw(F);
#endif
#ifndef NO_E2
 ph_mlstm_out(F, args, layer);
#endif
 }
        SEAM(P + 4);
        if (IN(P + 5)) {
            pg8::Gemm g{H, WOUT, T, DM, DM}; pg8::StaticOrder S; S.init(T, DM, F.G, (int)blockIdx.x); pg8::EpiRes E{layer == 0 ? args.in[0] : XR, XR, DM};
            pg8::gemm_phase<pg8::EpiRes, pg8::StaticOrder, true, true>(F.lds3, g, S, E);
        }
        SEAM(P + 5);
        if (IN(P + 6)) norm_rows_bf16(F, XR, args.in[14] + (size_t)layer * DM, H);
        SEAM(P + 6);
        if (IN(P + 7)) {
            pg8::Gemm g{H, WGU, T, 2 * DFF, DM}; pg8::StaticOrder S; S.init(T, 2 * DFF, F.G, (int)blockIdx.x); pg8::EpiSwiGLU E{Z, DFF};
            pg8::gemm_phase<pg8::EpiSwiGLU, pg8::StaticOrder, true, true>(F.lds3, g, S, E);
        }
        SEAM(P + 7);
        if (IN(P + 8)) {
            pg8::Gemm g{Z, WD, T, DM, DFF}; pg8::StaticOrder S; S.init(T, DM, F.G, (int)blockIdx.x); pg8::EpiRes E{XR, XR, DM};
            pg8::gemm_phase<pg8::EpiRes, pg8::StaticOrder, true, true>(F.lds3, g, S, E);
        }
        SEAM(P + 8);
    }
__global__ void __launch_bounds__(NTHREADS, 2) fwd_kernel(Args args) {
    extern __shared__ __attribute__((aligned(16))) unsigned char lds[];
    Frame F;
    F.lds = lds; F.lds3 = (LAS unsigned char*)lds; F.MISC = (volatile LAS unsigned*)(F.lds3 + MISC_OFF);
    F.tid = threadIdx.x; F.lane = F.tid & 63; F.wave = __builtin_amdgcn_readfirstlane(F.tid >> 6);
    F.G = gridDim.x; F.gw = blockIdx.x * NWAVES + F.wave; F.ngw = F.G * NWAVES;
    F.ws = args.ws; F.ctl = (unsigned*)(args.ws + WS_CTL);
    for (int u = F.tid; u < (LDS_BYTES - LDSCTL_OFF) / 4; u += NTHREADS) ((LAS unsigned*)(F.lds3 + LDSCTL_OFF))[u] = 0u;
    __syncthreads();
    XcdBarrier bar = xcd_barrier_post(F.ctl + CW_BAR, F.MISC + 8);
    run_layer<0>(F, args, bar);
    run_layer<1>(F, args, bar);
    if (IN(9 * DEPTH)) norm_rows_f32_inplace(F, args.out, args.in[18]);
#undef IN
#undef SEAM
}

extern "C" void kernel_launch(void* const* d_in, const int* in_sizes, int n_in, void* d_out, int out_size, void* d_ws, size_t ws_size, hipStream_t stream) {
    static int grid = 0;
    if (grid == 0) {
        if (n_in != 19 || in_sizes[0] != T * DM || out_size != T * DM || ws_size < WS_END) { fprintf(stderr, "kernel_launch: unexpected shapes (n_in %d, in0 %d, out %d, ws %zu); nothing launched\n", n_in, n_in > 0 ? in_sizes[0] : -1, out_size, ws_size); grid = -1; return; }
        int dev = 0, cus = 0, per_cu = 0;
        if (hipGetDevice(&dev) != hipSuccess || hipDeviceGetAttribute(&cus, hipDeviceAttributeMultiprocessorCount, dev) != hipSuccess) { grid = -1; return; }
        if (hipFuncSetAttribute((const void*)fwd_kernel, hipFuncAttributeMaxDynamicSharedMemorySize, LDS_BYTES) != hipSuccess) { fprintf(stderr, "kernel_launch: hipFuncSetAttribute failed\n"); grid = -1; return; }
        if (hipOccupancyMaxActiveBlocksPerMultiprocessor(&per_cu, (const void*)fwd_kernel, NTHREADS, LDS_BYTES) != hipSuccess || per_cu < 1) { fprintf(stderr, "kernel_launch: note: occupancy query says %d blocks per CU\n", per_cu); (void)hipGetLastError(); }
        grid = cus;
    }
    if (grid < 0) return;
    if (hipMemsetAsync((char*)d_ws + WS_CTL, 0, CTL_ZERO_BYTES, stream) != hipSuccess) { fprintf(stderr, "kernel_launch: memset failed\n"); return; }
    Args a{};
    for (int i = 0; i < 19; ++i) a.in[i] = (const float*)d_in[i];
    a.out = (float*)d_out; a.ws = (unsigned char*)d_ws;
    for (int i = 0; i < 32; ++i) a.inv64[i] = 1.0f / powf(10000.0f, (float)(2 * i) / 64.0f);
    for (int i = 0; i < 16; ++i) a.inv32[i] = 1.0f / powf(10000.0f, (float)(2 * i) / 32.0f);
    void* params[] = {&a};
    const hipError_t le = hipLaunchCooperativeKernel((const void*)fwd_kernel, dim3(grid), dim3(NTHREADS), params, LDS_BYTES, stream);
    if (le != hipSuccess) fprintf(stderr, "kernel_launch: cooperative launch failed: %s (grid %d)\n", hipGetErrorName(le), grid);
}
```

```cpp
#include <hip/hip_runtime.h>
#include <hip/hip_cooperative_groups.h>
#include <cstdio>
#include <cstdint>
namespace cg = cooperative_groups;
namespace pg8 {
#define PG8_LAS __attribute__((address_space(3)))
typedef unsigned short bf16_t;
typedef short bf16x8 __attribute__((ext_vector_type(8)));
typedef float f32x4 __attribute__((ext_vector_type(4)));
typedef unsigned u32x4 __attribute__((ext_vector_type(4)));
constexpr int BM = 256, BK = 64, HALF = 128, HTB = HALF * BK * 2  , STAGE_BYTES = 8 * HTB, NXCD = 8, WGM = 8;

__host__ __device__ __forceinline__ int lds_byte(int r, int c) { const int st = (r >> 4) * 2 + (c >> 5), rr = r & 15, cc = c & 31, ob = rr * 64 + cc * 2; return st * 1024 + (ob ^ (((ob >> 9) & 1) << 5)); }
__host__ __device__ __forceinline__ void stage_rc(int b, int& R, int& C) { const int st = b / 1024, sb = b % 1024, swz = sb ^ (((sb >> 9) & 1) << 5); R = (st >> 1) * 16 + swz / 64; C = (st & 1) * 32 + (swz % 64) / 2; }
__host__ __device__ __forceinline__ int perm32(int rho) { const int n = rho >> 4, i = rho & 15; return 8 * (i >> 2) + 4 * n + (i & 3); }

struct Unit { int pm, pn; };
struct Gemm { const bf16_t* A; const bf16_t* Bt; int M, N, K; };

struct StaticOrder {
    int nM, nN, nwg, G, c;
    __host__ __device__ void init(int M, int N, int G_, int c_) { nM = M / BM; nN = N / BM; nwg = nM * nN; G = G_; c = c_; }
    __host__ __device__ bool next(int i, Unit& u) const {
        const long L = (long)i * G + c; if (L >= nwg) return false;
        int wgid = (int)L; { const int q = nwg / NXCD, r = nwg % NXCD, xcd = wgid % NXCD, off = wgid / NXCD; wgid = (xcd < r ? xcd * (q + 1) : r * (q + 1) + (xcd - r) * q) + off; }
        const int nig = WGM * nN, gid = wgid / nig, fm = gid * WGM, gsz = (nM - fm) < WGM ? (nM - fm) : WGM;
        u.pm = fm + ((wgid % nig) % gsz); u.pn = (wgid % nig) / gsz; return true;
    }
    __device__ __forceinline__ void a_ready(const Unit&) const {}
    __device__ __forceinline__ void done(const Unit&) const {}
};

__device__ __forceinline__ unsigned cvt_pk_bf16(float lo, float hi) { unsigned r; asm volatile("v_cvt_pk_bf16_f32 %0, %1, %2" : "=v"(r) : "v"(lo), "v"(hi)); return r; }
typedef float f32x2 __attribute__((ext_vector_type(2)));
struct EpiZ {
    static constexpr bool PERM = true, AFTER_DRAIN = false;
    bf16_t* O; int ldc;
    __device__ __forceinline__ void operator()(const f32x4 (&acc)[2][2][4][2], const Unit& u, int wr, int wc, int fr, int fq) const {
        const int row0 = u.pm * BM + wr * 64 + fr, col0 = u.pn * BM + wc * 32 + 8 * fq;
#pragma unroll
        for (int ai = 0; ai < 2; ++ai)
#pragma unroll
            for (int m = 0; m < 4; ++m) { bf16_t* rowp = O + (size_t)(row0 + ai * HALF + m * 16) * ldc + col0;
#pragma unroll
                for (int bj = 0; bj < 2; ++bj) { const f32x4 v0 = acc[ai][bj][m][0], v1 = acc[ai][bj][m][1];
                    u32x4 w; w.x = cvt_pk_bf16(v0[0], v0[1]); w.y = cvt_pk_bf16(v0[2], v0[3]); w.z = cvt_pk_bf16(v1[0], v1[1]); w.w = cvt_pk_bf16(v1[2], v1[3]);
                    *(u32x4*)(rowp + bj * HALF) = w; } }
    }
};
struct EpiRes {
    static constexpr bool PERM = false, AFTER_DRAIN = false;
    const float* base; float* out; int ldc;
    __device__ __forceinline__ void operator()(const f32x4 (&acc)[2][2][4][2], const Unit& u, int wr, int wc, int fr, int fq) const {
        const int row0 = u.pm * BM + wr * 64 + fr, col0 = u.pn * BM + wc * 32 + 4 * fq;
#pragma unroll
        for (int ai = 0; ai < 2; ++ai)
#pragma unroll
            for (int m = 0; m < 4; ++m) { const size_t off = (size_t)(row0 + ai * HALF + m * 16) * ldc + col0;
#pragma unroll
                for (int bj = 0; bj < 2; ++bj)
#pragma unroll
                    for (int n = 0; n < 2; ++n) { const size_t p = off + bj * HALF + n * 16; const f32x4 b = *(const f32x4*)(base + p); *(f32x4*)(out + p) = b + acc[ai][bj][m][n]; } }
    }
};
struct EpiSwiGLU {
    static constexpr bool PERM = true, AFTER_DRAIN = false;
    bf16_t* O; int ldc;
    __device__ __forceinline__ void operator()(const f32x4 (&acc)[2][2][4][2], const Unit& u, int wr, int wc, int fr, int fq) const {
        const int row0 = u.pm * BM + wr * 64 + fr, col0 = u.pn * HALF + wc * 32 + 8 * fq;
#pragma unroll
        for (int ai = 0; ai < 2; ++ai)
#pragma unroll
            for (int m = 0; m < 4; ++m) { bf16_t* rowp = O + (size_t)(row0 + ai * HALF + m * 16) * ldc + col0;
                float r[8];
#pragma unroll
                for (int n = 0; n < 2; ++n)
#pragma unroll
                    for (int j = 0; j < 4; ++j) { const float g = acc[ai][0][m][n][j], up = acc[ai][1][m][n][j]; r[4 * n + j] = g * __builtin_amdgcn_rcpf(1.0f + __expf(-g)) * up; }
                u32x4 w; w.x = cvt_pk_bf16(r[0], r[1]); w.y = cvt_pk_bf16(r[2], r[3]); w.z = cvt_pk_bf16(r[4], r[5]); w.w = cvt_pk_bf16(r[6], r[7]);
                *(u32x4*)rowp = w; }
    }
};
template <class Epi, class Sched, bool ALIGN_EPI = false, bool SP2 = false>
__device__ __forceinline__ void gemm_phase(PG8_LAS unsigned char* lds, const Gemm g, const Sched& S, const Epi& E) {
    int tid_ = threadIdx.x; asm volatile("" : "+v"(tid_));
    const int tid = tid_, wid = __builtin_amdgcn_readfirstlane(tid >> 6), lane = tid & 63, wr = wid >> 2, wc = wid & 3, fr = lane & 15, fq = lane >> 4;
    const int K = g.K, nt = K / BK;
    unsigned voffA[2], voffB[2];
#pragma unroll
    for (int i = 0; i < 2; ++i) { int R, C; stage_rc(tid * 16 + i * 8192, R, C); const int Rb = Epi::PERM ? ((R & ~31) + perm32(R & 31)) : R;
        voffA[i] = (unsigned)(R * K + C) * 2u; voffB[i] = (unsigned)(Rb * K + C) * 2u; }
    const size_t kstep = (size_t)(BK * 2);
    const size_t hstep = (size_t)HALF * K * 2;
    const size_t tstep = 2 * hstep;
    const unsigned ldsw = (unsigned)wid * 1024u;
    const int aoff = lds_byte(wr * 64 + fr, fq * 8), boff = lds_byte(wc * 32 + fr, fq * 8);
#define PG8_SA(b, h) (((b) * 2 + (h)) * HTB)
#define PG8_SB(b, h) ((4 + (b) * 2 + (h)) * HTB)
#define PG8_STAGE(bufoff, gbase, voff) do { _Pragma("unroll") for (int _i = 0; _i < 2; ++_i) \
        __builtin_amdgcn_global_load_lds((const unsigned*)((const char*)(gbase) + (voff)[_i]), (PG8_LAS unsigned*)(lds + (bufoff) + ldsw + _i * 8192), 16, 0, 0); } while (0)
#define PG8_LDA(dst, b, h) do { _Pragma("unroll") for (int m = 0; m < 4; ++m) _Pragma("unroll") for (int k = 0; k < 2; ++k) dst[m][k] = *(const PG8_LAS bf16x8*)(lds + PG8_SA(b, h) + aoff + m * 2048 + k * 1024); } while (0)
#define PG8_LDB(dst, b, h) do { _Pragma("unroll") for (int n = 0; n < 2; ++n) _Pragma("unroll") for (int k = 0; k < 2; ++k) dst[n][k] = *(const PG8_LAS bf16x8*)(lds + PG8_SB(b, h) + boff + n * 2048 + k * 1024); } while (0)
#define PG8_MMA(ai, bj, At, Bt) do { __builtin_amdgcn_s_setprio(1); _Pragma("unroll") for (int m = 0; m < 4; ++m) _Pragma("unroll") for (int n = 0; n < 2; ++n) _Pragma("unroll") for (int k = 0; k < 2; ++k) \
        acc[ai][bj][m][n] = __builtin_amdgcn_mfma_f32_16x16x32_bf16(Bt[n][k], At[m][k], acc[ai][bj][m][n], 0, 0, 0); __builtin_amdgcn_s_setprio(0); } while (0)
#define PG8_WAIT_V(n) asm volatile("s_waitcnt vmcnt(" #n ")" ::: "memory")
#define PG8_WAIT_L(n) asm volatile("s_waitcnt lgkmcnt(" #n ")" ::: "memory")
#define PG8_BAR __builtin_amdgcn_s_barrier()
#define PG8_SCHED __builtin_amdgcn_sched_barrier(0)
    Unit cur, nxt; int ui = 0;
    if (!S.next(0, cur)) return;
    f32x4 acc[2][2][4][2];
#pragma unroll
    for (int a = 0; a < 2; ++a)
#pragma unroll
        for (int b = 0; b < 2; ++b)
#pragma unroll
            for (int m = 0; m < 4; ++m)
#pragma unroll
                for (int n = 0; n < 2; ++n) acc[a][b][m][n] = (f32x4){0.f, 0.f, 0.f, 0.f};
    bf16x8 At[4][2], B0[2][2], B1[2][2];
    const char* cA = (const char*)g.A + (size_t)cur.pm * tstep; const char* cB = (const char*)g.Bt + (size_t)cur.pn * tstep;
    S.a_ready(cur);
    if constexpr (SP2) {
        PG8_STAGE(PG8_SB(0, 0), cB, voffB); PG8_STAGE(PG8_SB(0, 1), cB + hstep, voffB); PG8_STAGE(PG8_SA(0, 0), cA, voffA); PG8_STAGE(PG8_SA(0, 1), cA + hstep, voffA);
        if (wr == 1) PG8_BAR;
        PG8_WAIT_V(2); PG8_BAR;
        PG8_STAGE(PG8_SB(1, 0), cB + kstep, voffB); PG8_STAGE(PG8_SA(1, 0), cA + kstep, voffA); PG8_STAGE(PG8_SB(1, 1), cB + hstep + kstep, voffB);
        PG8_WAIT_V(6); PG8_BAR;
    } else {
        PG8_STAGE(PG8_SB(0, 0), cB, voffB); PG8_STAGE(PG8_SA(0, 0), cA, voffA); PG8_STAGE(PG8_SB(0, 1), cB + hstep, voffB); PG8_STAGE(PG8_SA(0, 1), cA + hstep, voffA);
        if (wr == 1) PG8_BAR;
        PG8_WAIT_V(4); PG8_BAR;
        PG8_STAGE(PG8_SB(1, 0), cB + kstep, voffB); PG8_STAGE(PG8_SA(1, 0), cA + kstep, voffA); PG8_STAGE(PG8_SB(1, 1), cB + hstep + kstep, voffB);
        PG8_WAIT_V(6); PG8_BAR;
    }
    for (;;) {
        const bool has_next = S.next(ui + 1, nxt);
        const char* nA = has_next ? (const char*)g.A + (size_t)nxt.pm * tstep : cA; const char* nB = has_next ? (const char*)g.Bt + (size_t)nxt.pn * tstep : cB;
        for (int t = 0; t < nt; t += 2) {
            const bool last = (t == nt - 2);
            const char* a1 = cA + (size_t)(t + 1) * kstep;
            const char* a2 = last ? nA : cA + (size_t)(t + 2) * kstep; const char* b2 = last ? nB : cB + (size_t)(t + 2) * kstep;
            const char* a3 = a2 + kstep; const char* b3 = b2 + kstep;
            if (last && has_next) S.a_ready(nxt);
            if constexpr (SP2) {
            PG8_LDB(B0, 0, 0); PG8_LDB(B1, 0, 1); PG8_SCHED; PG8_LDA(At, 0, 0); PG8_STAGE(PG8_SA(1, 1), a1 + hstep, voffA);
            PG8_WAIT_V(8); PG8_WAIT_L(0); PG8_BAR; PG8_MMA(0, 0, At, B0); PG8_MMA(0, 1, At, B1); PG8_BAR; PG8_SCHED;
            PG8_LDA(At, 0, 1); PG8_STAGE(PG8_SB(0, 0), b2, voffB); PG8_STAGE(PG8_SB(0, 1), b2 + hstep, voffB); PG8_STAGE(PG8_SA(0, 0), a2, voffA);
            PG8_WAIT_V(8); PG8_WAIT_L(0); PG8_BAR; PG8_MMA(1, 0, At, B0); PG8_MMA(1, 1, At, B1); PG8_BAR; PG8_SCHED;
            PG8_LDB(B0, 1, 0); PG8_LDB(B1, 1, 1); PG8_SCHED; PG8_LDA(At, 1, 0); PG8_STAGE(PG8_SA(0, 1), a2 + hstep, voffA);
            PG8_WAIT_V(8); PG8_WAIT_L(0); PG8_BAR; PG8_MMA(0, 0, At, B0); PG8_MMA(0, 1, At, B1); PG8_BAR; PG8_SCHED;
            PG8_LDA(At, 1, 1); PG8_STAGE(PG8_SB(1, 0), b3, voffB); PG8_STAGE(PG8_SB(1, 1), b3 + hstep, voffB); PG8_STAGE(PG8_SA(1, 0), a3, voffA);
            PG8_WAIT_V(8); PG8_WAIT_L(0); PG8_BAR; PG8_MMA(1, 0, At, B0); PG8_MMA(1, 1, At, B1); PG8_BAR; PG8_SCHED;
            } else {
            PG8_LDB(B0, 0, 0); PG8_SCHED; PG8_LDA(At, 0, 0); PG8_STAGE(PG8_SA(1, 1), a1 + hstep, voffA);
            PG8_WAIT_L(8); PG8_BAR; PG8_WAIT_L(0); PG8_MMA(0, 0, At, B0); PG8_BAR; PG8_SCHED;
            PG8_LDB(B1, 0, 1); PG8_STAGE(PG8_SB(0, 0), b2, voffB);
            PG8_BAR; PG8_WAIT_L(0); PG8_MMA(0, 1, At, B1); PG8_BAR;
            PG8_LDA(At, 0, 1); PG8_STAGE(PG8_SA(0, 0), a2, voffA);
            PG8_BAR; PG8_WAIT_L(0); PG8_MMA(1, 0, At, B0); PG8_BAR; PG8_SCHED;
            PG8_STAGE(PG8_SB(0, 1), b2 + hstep, voffB);
            PG8_WAIT_V(6); PG8_BAR; PG8_MMA(1, 1, At, B1); PG8_BAR;
            PG8_LDB(B0, 1, 0); PG8_SCHED; PG8_LDA(At, 1, 0); PG8_STAGE(PG8_SA(0, 1), a2 + hstep, voffA);
            PG8_WAIT_L(8); PG8_BAR; PG8_WAIT_L(0); PG8_MMA(0, 0, At, B0); PG8_BAR; PG8_SCHED;
            PG8_LDB(B1, 1, 1); PG8_STAGE(PG8_SB(1, 0), b3, voffB);
            PG8_BAR; PG8_WAIT_L(0); PG8_MMA(0, 1, At, B1); PG8_BAR;
            PG8_LDA(At, 1, 1); PG8_STAGE(PG8_SA(1, 0), a3, voffA);
            PG8_BAR; PG8_WAIT_L(0); PG8_MMA(1, 0, At, B0); PG8_BAR; PG8_SCHED;
            PG8_STAGE(PG8_SB(1, 1), b3 + hstep, voffB);
            PG8_WAIT_V(6); PG8_BAR; PG8_MMA(1, 1, At, B1); PG8_BAR;
            }
        }
        if constexpr (ALIGN_EPI) { if (wr == 0) PG8_BAR; }
        if constexpr (!Epi::AFTER_DRAIN) { E(acc, cur, wr, wc, fr, fq); S.done(cur); }
        if (!has_next) break;
#pragma unroll
        for (int a = 0; a < 2; ++a)
#pragma unroll
            for (int b = 0; b < 2; ++b)
#pragma unroll
                for (int m = 0; m < 4; ++m)
#pragma unroll
                    for (int n = 0; n < 2; ++n) acc[a][b][m][n] = (f32x4){0.f, 0.f, 0.f, 0.f};
        cur = nxt; cA = nA; cB = nB; ++ui;
        if constexpr (ALIGN_EPI) { if (wr == 1) PG8_BAR; }
    }
    PG8_WAIT_V(0);
    if constexpr (!ALIGN_EPI) { if (wr == 0) PG8_BAR; }
    PG8_BAR;
    if constexpr (Epi::AFTER_DRAIN) { E.fused(acc, cur, wr, wc, fr, fq, lds, wid, lane); S.done(cur); }
#undef PG8_SA
#undef PG8_SB
#undef PG8_STAGE
#undef PG8_LDA
#undef PG8_LDB
#undef PG8_MMA
#undef PG8_WAIT_V
#undef PG8_WAIT_L
#undef PG8_BAR
#undef PG8_SCHED
}
}

constexpr int NB = 4, SEQ = 4096, T = NB * SEQ, DM = 1024, DIN = 2964, DINP = 3072, DFF = 2816, DEPTH = 2;
constexpr int NWAVES = 8, NTHREADS = 512;
constexpr float EPS = 1e-6f;
constexpr int ZAQ = 0, ZKC = 256, ZVC = 320, ZKS = 384, ZVS = 448, ZKW = 512, ZVW = 576, ZBQ = 640, ZBK = 896, ZBV = 1152,
              ZCU = 1408, ZCV = 1664, ZCO = 1920, ZDQ = 2176, ZDK = 2432, ZDV = 2688, ZAG = 2944, ZCI = 2956, ZCF = 2960;
__host__ __device__ __forceinline__ int zsrc(int n) {
    if (n < 640) return n;
    if (n < 1920) return n + 12;
    if (n < 2944) return n + 20;
    if (n < 2956) return n - 2944 + 640;
    if (n < 2960) return n - 2956 + 1932;
    if (n < 2964) return n - 2960 + 1936;
    return -1;
}
constexpr size_t MiB = 1u << 20;
constexpr size_t WS_CTL = 0, CTL_ZERO_BYTES = 1 * MiB;
constexpr size_t WS_WIN = 2 * MiB, WS_WOUT = 8 * MiB, WS_WGU = 10 * MiB, WS_WD = 21 * MiB;
constexpr size_t WS_ROPE64 = 27 * MiB, WS_ROPE32 = 28 * MiB;
constexpr size_t WS_KC = 29 * MiB, WS_VC = WS_KC + 256 * 1024;
constexpr size_t WS_SEL = WS_VC + 256 * 1024;
constexpr size_t WS_BCUM = 30 * MiB, WS_IG = WS_BCUM + 256 * 1024, WS_NLOC = WS_IG + 256 * 1024;
constexpr size_t WS_ACH = WS_NLOC + 256 * 1024, WS_MLOC = WS_ACH + 4096, WS_MIN = WS_MLOC + 4096;
constexpr size_t WS_DLSE = 31 * MiB;
constexpr size_t WS_H = 32 * MiB;
constexpr size_t WS_Z = 64 * MiB;
constexpr size_t WS_AQR = 160 * MiB, WS_OCMP = 168 * MiB, WS_DPART = 176 * MiB;
constexpr size_t WS_MQ = 200 * MiB, WS_MK = 216 * MiB, WS_CLOC = 232 * MiB, WS_END = 248 * MiB;
constexpr int CW_BAR = 4096;
constexpr int CW_Q = 16384;
constexpr int RING_BYTES = 131072, LDSCTL_OFF = RING_BYTES, MISC_OFF = LDSCTL_OFF + 320, LDS_BYTES = 147456;

#define GAS __attribute__((address_space(1)))
#define LAS __attribute__((address_space(3)))
typedef unsigned short bf16;
typedef unsigned v4u __attribute__((ext_vector_type(4)));
typedef unsigned v2u __attribute__((ext_vector_type(2)));
typedef float f32x4 __attribute__((ext_vector_type(4)));
typedef float f32x2 __attribute__((ext_vector_type(2)));
#define LDS_WAIT() asm volatile("s_waitcnt lgkmcnt(0)" ::: "memory")
#define VM_WAIT() asm volatile("s_waitcnt vmcnt(0)" ::: "memory")
__device__ __forceinline__ unsigned f2bf(float f) { unsigned u = __builtin_bit_cast(unsigned, f); return (u + 0x7fffu + ((u >> 16) & 1u)) >> 16; }
__device__ __forceinline__ unsigned pk2(float lo, float hi) { return f2bf(lo) | (f2bf(hi) << 16); }
__device__ __forceinline__ float bf2f(bf16 u) { return __uint_as_float(((unsigned)u) << 16); }
__device__ __forceinline__ float bflo(unsigned w) { return __uint_as_float(w << 16); }
__device__ __forceinline__ float bfhi(unsigned w) { return __uint_as_float(w & 0xffff0000u); }
__device__ __forceinline__ float wave_sum(float v) {
#pragma unroll
    for (int o = 1; o < 64; o <<= 1) v += __shfl_xor(v, o);
    return v;
}
__device__ __forceinline__ float wave_max(float v) {
#pragma unroll
    for (int o = 1; o < 64; o <<= 1) v = fmaxf(v, __shfl_xor(v, o));
    return v;
}
__device__ __forceinline__ float sigmoidf_(float x) { return 1.0f / (1.0f + __expf(-x)); }
#define XB_TMO      128
#define XB_XCNT(j)  (256  + 64 * (j))
#define XB_XSUB(j)  (1280 + 64 * (j))
#define XB_XGEN(j)  (2304 + 64 * (j))
#define XB_TOP      3328
#define XB_TOPGEN   3392
#define XCD_BAR_WORDS 3456
#define XB_SPIN_CAP (1u << 18)

__device__ __forceinline__ unsigned xb_ld(unsigned* p)              { return __hip_atomic_load(p, __ATOMIC_RELAXED, __HIP_MEMORY_SCOPE_AGENT); }
__device__ __forceinline__ unsigned xb_add(unsigned* p, unsigned v) { return __hip_atomic_fetch_add(p, v, __ATOMIC_RELAXED, __HIP_MEMORY_SCOPE_AGENT); }
__device__ __forceinline__ unsigned xb_xcc_id() { return (unsigned)__builtin_amdgcn_s_getreg((3 << 11) | 20) & 0xFu; }
#define XB_SPIN(cond, bar) do { unsigned _sp = 0; while (cond) { __builtin_amdgcn_s_sleep(1); \
    if ((++_sp & 255u) == 0u) { if (xb_ld(&(bar)[XB_TMO])) break; if (_sp > XB_SPIN_CAP) { atomicAdd(&(bar)[XB_TMO], 1u); break; } } } } while (0)

struct XcdBarrier {
    unsigned* bar; unsigned x;
    volatile LAS unsigned* st;
};

__device__ __forceinline__ XcdBarrier xcd_barrier_post(unsigned* bar, volatile LAS unsigned* st) {
    XcdBarrier b; b.bar = bar; b.x = xb_xcc_id(); b.st = st;
    if (threadIdx.x == 0) (void)xb_add(&bar[XB_XCNT(b.x)], 1u);
    return b;
}
__device__ __forceinline__ void xcd_barrier_complete(unsigned* bar, unsigned x, unsigned& nloc, unsigned& nx) {
    const unsigned G = gridDim.x * gridDim.y * gridDim.z;
    unsigned sum, cnt, mine, sp = 0u;
    for (;;) {
        sum = 0u; cnt = 0u; mine = 0u;
#pragma unroll 1
        for (unsigned j = 0; j < 16; ++j) { const unsigned c = xb_ld(&bar[XB_XCNT(j)]); sum += c; cnt += (c > 0u) ? 1u : 0u; mine = (j == x) ? c : mine; }
        if (sum == G) break;
        __builtin_amdgcn_s_sleep(1);
        if ((++sp & 255u) == 0u) { if (xb_ld(&bar[XB_TMO])) break; if (sp > XB_SPIN_CAP) { atomicAdd(&bar[XB_TMO], 1u); break; } }
    }
    nloc = mine > 0u ? mine : 1u; nx = cnt > 0u ? cnt : 1u;
}

__device__ __forceinline__ void xcd_barrier(const XcdBarrier& b) {
    asm volatile("s_waitcnt vmcnt(0)" ::: "memory");
    __syncthreads();
    if (threadIdx.x == 0) {
        unsigned* bar = b.bar;
        __builtin_amdgcn_s_waitcnt(0);
        unsigned nloc = b.st[0], nx = b.st[1];
        if (nloc == 0u) { xcd_barrier_complete(bar, b.x, nloc, nx); b.st[0] = nloc; b.st[1] = nx; }
        const unsigned old = xb_add(&bar[XB_XSUB(b.x)], 1u);
        const unsigned gen = old / nloc;
        if (old + 1u == (gen + 1u) * nloc) {
            __builtin_amdgcn_fence(__ATOMIC_RELEASE, "agent");
            asm volatile("s_waitcnt vmcnt(0)" ::: "memory");
            const unsigned og = xb_add(&bar[XB_TOP], 1u);
            const unsigned tg = og / nx;
            if (og + 1u == (tg + 1u) * nx) xb_add(&bar[XB_TOPGEN], 1u);
            else XB_SPIN(xb_ld(&bar[XB_TOPGEN]) == tg, bar);
            __builtin_amdgcn_fence(__ATOMIC_ACQUIRE, "agent");
            xb_add(&bar[XB_XGEN(b.x)], 1u);
            asm volatile("s_waitcnt vmcnt(0)" ::: "memory");
        } else {
            XB_SPIN(xb_ld(&bar[XB_XGEN(b.x)]) == gen, bar);
            __builtin_amdgcn_fence(__ATOMIC_ACQUIRE, "agent");
            asm volatile("s_waitcnt vmcnt(0)" ::: "memory");
        }
    }
    __syncthreads();
}

struct Args { const float* in[19]; float* out; unsigned char* ws; float inv64[32]; float inv32[16]; };
struct Frame {
    unsigned char* lds;
    LAS unsigned char* lds3;
    volatile LAS unsigned* MISC;
    unsigned* ctl;
    unsigned char* ws;
    int tid, lane, wave, G, gw, ngw;
};
#define PHASE_IDS(F) do { int t_ = threadIdx.x; asm volatile("" : "+v"(t_)); (F).tid = t_; (F).lane = t_ & 63; (F).wave = __builtin_amdgcn_readfirstlane(t_ >> 6); (F).gw = blockIdx.x * NWAVES + (F).wave; } while (0)


__device__ __forceinline__ void transpose_item(const float* W, int K, int N, int srccol  , bf16* WT, int n0, int k0, float* scr, int lane) {
#pragma unroll 8
    for (int i = 0; i < 32; ++i) { const int kk = 2 * i + (lane >> 5); scr[kk * 33 + (lane & 31)] = srccol >= 0 ? W[(size_t)(k0 + kk) * N + srccol] : 0.f; }
    LDS_WAIT(); asm volatile("" ::: "memory");
    const int c = lane & 7;
#pragma unroll
    for (int j = 0; j < 4; ++j) { const int n = (lane >> 3) + 8 * j; const float* s = scr + (8 * c) * 33 + n;
        v4u o; o.x = pk2(s[0 * 33], s[1 * 33]); o.y = pk2(s[2 * 33], s[3 * 33]); o.z = pk2(s[4 * 33], s[5 * 33]); o.w = pk2(s[6 * 33], s[7 * 33]);
        *(v4u*)(WT + (size_t)(n0 + n) * K + k0 + 8 * c) = o; }
    LDS_WAIT(); asm volatile("" ::: "memory");
}
__device__ __forceinline__ void convert_weights(Frame& F, const Args& a, int layer) {
    PHASE_IDS(F);
    float* scr = (float*)(F.lds + F.wave * 16384);
    const float* w_in = a.in[2] + (size_t)layer * DM * DIN; const float* w_out = a.in[13] + (size_t)layer * DM * DM;
    const float* w_gate = a.in[15] + (size_t)layer * DM * DFF; const float* w_up = a.in[16] + (size_t)layer * DM * DFF; const float* w_down = a.in[17] + (size_t)layer * DFF * DM;
    bf16* WIN = (bf16*)(F.ws + WS_WIN); bf16* WOUT = (bf16*)(F.ws + WS_WOUT); bf16* WGU = (bf16*)(F.ws + WS_WGU); bf16* WD = (bf16*)(F.ws + WS_WD);
    constexpr int I_IN = (DM / 64) * (DINP / 32), I_OUT = (DM / 64) * (DM / 32), I_GU = (DM / 64) * (2 * DFF / 32), I_D = (DFF / 64) * (DM / 32);
    constexpr int NITEMS = I_IN + I_OUT + I_GU + I_D;
    for (int it = F.gw; it < NITEMS; it += F.ngw) {
        int r = it; const int l31 = F.lane & 31;
        if (r < I_IN) { const int nblk = DINP / 32, kb = r / nblk, nb = r % nblk; transpose_item(w_in, DM, DIN, zsrc(nb * 32 + l31), WIN, nb * 32, kb * 64, scr, F.lane); continue; } r -= I_IN;
        if (r < I_OUT) { const int nblk = DM / 32, kb = r / nblk, nb = r % nblk; transpose_item(w_out, DM, DM, nb * 32 + l31, WOUT, nb * 32, kb * 64, scr, F.lane); continue; } r -= I_OUT;
        if (r < I_GU) { const int nblk = 2 * DFF / 32, kb = r / nblk, nb = r % nblk, n0 = nb * 32, pn = n0 >> 8, w = n0 & 255;
            transpose_item(w < 128 ? w_gate : w_up, DM, DFF, 128 * pn + (w & 127) + l31, WGU, n0, kb * 64, scr, F.lane); continue; } r -= I_GU;
        { const int nblk = DM / 32, kb = r / nblk, nb = r % nblk; transpose_item(w_down, DFF, DM, nb * 32 + l31, WD, nb * 32, kb * 64, scr, F.lane); }
    }
}
__device__ __forceinline__ void sincos_d(float ang, float& c, float& s) {
    const double a = (double)ang; const double q = __builtin_rint(a * 0.63661977236758134308); const double r = a - q * 1.57079632679489661923; const double r2 = r * r;
    double sp = -1.0 / 39916800.0; sp = sp * r2 + 1.0 / 362880.0; sp = sp * r2 - 1.0 / 5040.0; sp = sp * r2 + 1.0 / 120.0; sp = sp * r2 - 1.0 / 6.0; sp = sp * r2 + 1.0; sp *= r;
    double cp = 1.0 / 479001600.0; cp = cp * r2 - 1.0 / 3628800.0; cp = cp * r2 + 1.0 / 40320.0; cp = cp * r2 - 1.0 / 720.0; cp = cp * r2 + 1.0 / 24.0; cp = cp * r2 - 0.5; cp = cp * r2 + 1.0;
    const int n = ((int)q) & 3; const double cc = (n == 0) ? cp : (n == 1) ? -sp : (n == 2) ? -cp : sp; const double ss = (n == 0) ? sp : (n == 1) ? cp : (n == 2) ? -sp : -cp;
    c = (float)cc; s = (float)ss;
}
__device__ __forceinline__ void build_rope(Frame& F, const Args& a) {
    PHASE_IDS(F);
    f32x2* R64 = (f32x2*)(F.ws + WS_ROPE64); f32x2* R32 = (f32x2*)(F.ws + WS_ROPE32);
    const int gt = F.gw * 64 + F.lane, ngt = F.ngw * 64;
    for (int i = gt; i < SEQ * 48; i += ngt) { const int pos = i / 48, j = i % 48; float c, s;
        if (j < 32) { sincos_d((float)pos * a.inv64[j], c, s); R64[pos * 32 + j] = (f32x2){c, s}; }
        else { sincos_d((float)pos * a.inv32[j - 32], c, s); R32[pos * 16 + (j - 32)] = (f32x2){c, s}; } }
}
__device__ __forceinline__ void norm_rows_bf16(Frame& F, const float* X, const float* g, bf16* H) {
    PHASE_IDS(F);
    for (int row = F.gw; row < T; row += F.ngw) {
        const f32x4* xr = (const f32x4*)(X + (size_t)row * DM) + F.lane; f32x4 v[4]; float ss = 0.f;
#pragma unroll
        for (int j = 0; j < 4; ++j) { v[j] = xr[64 * j]; ss += (v[j].x * v[j].x + v[j].y * v[j].y) + (v[j].z * v[j].z + v[j].w * v[j].w); }
        const float r = 1.0f / sqrtf(wave_sum(ss) * (1.0f / DM) + EPS);
        v2u* o = (v2u*)(H + (size_t)row * DM) + F.lane;
#pragma unroll
        for (int j = 0; j < 4; ++j) { const f32x4 gg = ((const f32x4*)g)[64 * j + F.lane]; v2u w; w.x = pk2(v[j].x * r * gg.x, v[j].y * r * gg.y); w.y = pk2(v[j].z * r * gg.z, v[j].w * r * gg.w); o[64 * j] = w; }
    }
}
__device__ __forceinline__ void norm_rows_f32_inplace(Frame& F, float* X, const float* g) {
    PHASE_IDS(F);
    for (int row = F.gw; row < T; row += F.ngw) {
        f32x4* xr = (f32x4*)(X + (size_t)row * DM) + F.lane; f32x4 v[4]; float ss = 0.f;
#pragma unroll
        for (int j = 0; j < 4; ++j) { v[j] = xr[64 * j]; ss += (v[j].x * v[j].x + v[j].y * v[j].y) + (v[j].z * v[j].z + v[j].w * v[j].w); }
        const float r = 1.0f / sqrtf(wave_sum(ss) * (1.0f / DM) + EPS);
#pragma unroll
        for (int j = 0; j < 4; ++j) { const f32x4 gg = ((const f32x4*)g)[64 * j + F.lane]; xr[64 * j] = v[j] * r * gg; }
    }
}

__device__ __forceinline__ void prep_rope(Frame& F) {
    PHASE_IDS(F);
    bf16* Z = (bf16*)(F.ws + WS_Z); bf16* AQR = (bf16*)(F.ws + WS_AQR);
    const f32x2* R64 = (const f32x2*)(F.ws + WS_ROPE64); const f32x2* R32 = (const f32x2*)(F.ws + WS_ROPE32);
    for (int row = F.gw; row < T; row += F.ngw) {
        const int pos = row & (SEQ - 1); bf16* zr = Z + (size_t)row * DINP; bf16* qr = AQR + (size_t)row * 256;
#pragma unroll 1
        for (int it = 0; it < 11; ++it) {
            const int u = 2 * it + (F.lane >> 5), p = F.lane & 31;
            int base; bool d32 = false; bf16* dst = zr;
            if (u < 4) { base = ZAQ + 64 * u; dst = qr - ZAQ; }
            else if (u == 4) base = ZKS; else if (u == 5) base = ZKW;
            else if (u < 10) { base = ZBQ + 64 * (u - 6); d32 = true; } else if (u < 14) { base = ZBK + 64 * (u - 10); d32 = true; }
            else if (u < 18) base = ZDQ + 64 * (u - 14); else base = ZDK + 64 * (u - 18);
            int c1, c2; f32x2 cs;
            if (d32) { const int comp = p >> 4, i = p & 15; c1 = base + 32 * comp + i; c2 = c1 + 16; cs = R32[pos * 16 + i]; }
            else { c1 = base + p; c2 = c1 + 32; cs = R64[pos * 32 + p]; }
            const float x1 = bf2f(zr[c1]), x2 = bf2f(zr[c2]);
            dst[c1] = (bf16)f2bf(x1 * cs.x - x2 * cs.y); dst[c2] = (bf16)f2bf(x1 * cs.y + x2 * cs.x);
        }
    }
}
__device__ __forceinline__ void prep_compress(Frame& F, const Args& a, int layer) {
    PHASE_IDS(F);
    const bf16* Z = (const bf16*)(F.ws + WS_Z);
    for (int it = F.gw; it < NB * 2 * 64; it += F.ngw) {
        const int b = it >> 7, br = (it >> 6) & 1, n0 = (it & 63) * 4;
        const float* pos = a.in[3] + ((size_t)layer * 2 + br) * 2048; const float* w = a.in[4] + ((size_t)layer * 2 + br) * 2048 * 64;
        const int zc = br ? ZVC : ZKC; float acc[4] = {0.f, 0.f, 0.f, 0.f};
        for (int l = 0; l < 32; ++l) {
#pragma unroll 4
            for (int d = 0; d < 64; ++d) { const float wv = w[(size_t)(l * 64 + d) * 64 + F.lane], pv = pos[l * 64 + d];
#pragma unroll
                for (int i = 0; i < 4; ++i) { int tok = 16 * (n0 + i) + l; tok = tok < SEQ ? tok : SEQ - 1; acc[i] += (bf2f(Z[(size_t)(b * SEQ + tok) * DINP + zc + d]) + pv) * wv; } }
        }
        float* O = (float*)(F.ws + (br ? WS_VC : WS_KC)) + (size_t)b * 256 * 64;
#pragma unroll
        for (int i = 0; i < 4; ++i) O[(n0 + i) * 64 + F.lane] = (n0 + i < 255) ? acc[i] : 0.f;
    }
}
__device__ __forceinline__ float log_sigmoid_(float x) { return x >= 0.f ? -log1pf(__expf(-x)) : x - log1pf(__expf(x)); }
__device__ __forceinline__ void prep_mlstm(Frame& F, const Args& a, int layer) {
    PHASE_IDS(F);
    const bf16* Z = (const bf16*)(F.ws + WS_Z);
    float* L = (float*)F.lds; float* UC = L; float* QS = L + 4224; float* KS = L + 8448; float* VS = L + 12672; float* WQ = L + 16896; float* WK = L + 21120; float* WE = L + 25344;
    const float* convw = a.in[7] + (size_t)layer * 4 * 256; const float* convb = a.in[8] + (size_t)layer * 256;
    const float* gb = a.in[11] + (size_t)layer * 8;
    float* MQ = (float*)(F.ws + WS_MQ); float* MK = (float*)(F.ws + WS_MK); float* CLOC = (float*)(F.ws + WS_CLOC); float* NLOC = (float*)(F.ws + WS_NLOC);
    float* BCUM = (float*)(F.ws + WS_BCUM); float* IG = (float*)(F.ws + WS_IG); float* ACH = (float*)(F.ws + WS_ACH); float* MLOC = (float*)(F.ws + WS_MLOC);
    for (int it = blockIdx.x; it < 1024; it += F.G) {
        const int bh = it >> 6, c = it & 63, b = bh >> 2, h = bh & 3, t0 = c * 64; const size_t row0 = (size_t)b * SEQ + t0;
        const float* wq = a.in[9] + ((size_t)layer * 4 + h) * 4096; const float* wk = a.in[10] + ((size_t)layer * 4 + h) * 4096;
        __syncthreads();
        for (int i = F.tid; i < 4096; i += NTHREADS) { const int l = i >> 6, d = i & 63, ch = h * 64 + d; float s = convb[ch];
#pragma unroll
            for (int j = 0; j < 4; ++j) { const int t = t0 + l - 3 + j; if (t >= 0) s += convw[j * 256 + ch] * bf2f(Z[((size_t)b * SEQ + t) * DINP + ZCU + ch]); }
            UC[l * 65 + d] = s * sigmoidf_(s); VS[i] = bf2f(Z[(row0 + l) * DINP + ZCV + ch]); WQ[i] = wq[i]; WK[i] = wk[i]; }
        if (F.wave == 0) { const int l = F.lane; const size_t row = row0 + l;
            const float ig = bf2f(Z[row * DINP + ZCI + h]) + gb[h]; float bc = log_sigmoid_(bf2f(Z[row * DINP + ZCF + h]) + gb[4 + h]);
#pragma unroll
            for (int o = 1; o < 64; o <<= 1) { const float v = __shfl_up(bc, o); if (l >= o) bc += v; }
            const float ach = __shfl(bc, 63); const float ge = ach - bc + ig; const float ml = wave_max(ge);
            WE[l] = __expf(ge - ml); BCUM[row * 4 + h] = bc; IG[row * 4 + h] = ig; if (l == 0) { ACH[it] = ach; MLOC[it] = ml; } }
        __syncthreads();
        { const int l = F.tid >> 3, eg = (F.tid & 7) * 8; float qa[8], ka[8];
#pragma unroll
            for (int i = 0; i < 8; ++i) { qa[i] = 0.f; ka[i] = 0.f; }
            for (int d = 0; d < 64; ++d) { const float u = UC[l * 65 + d];
#pragma unroll
                for (int i = 0; i < 8; ++i) { qa[i] += u * WQ[d * 64 + eg + i]; ka[i] += u * WK[d * 64 + eg + i]; } }
#pragma unroll
            for (int i = 0; i < 8; ++i) { ka[i] *= 0.125f; QS[l * 64 + eg + i] = qa[i]; KS[l * 64 + eg + i] = ka[i];
                MQ[(row0 + l) * 256 + h * 64 + eg + i] = qa[i]; MK[(row0 + l) * 256 + h * 64 + eg + i] = ka[i]; } }
        __syncthreads();
        { const int v = F.tid >> 3, kg = (F.tid & 7) * 8; float acc[8];
#pragma unroll
            for (int i = 0; i < 8; ++i) acc[i] = 0.f;
            for (int l = 0; l < 64; ++l) { const float wv = WE[l] * VS[l * 64 + v];
#pragma unroll
                for (int i = 0; i < 8; ++i) acc[i] += wv * KS[l * 64 + kg + i]; }
#pragma unroll
            for (int i = 0; i < 8; ++i) CLOC[(size_t)it * 4096 + v * 64 + kg + i] = acc[i];
            if (F.tid < 64) { float n = 0.f; for (int l = 0; l < 64; ++l) n += WE[l] * KS[l * 64 + F.tid]; NLOC[it * 64 + F.tid] = n; } }
    }
    __syncthreads();
}

__device__ __forceinline__ void ld8(const bf16* p, float* o) { const v4u w = *(const v4u*)p; o[0] = bflo(w.x); o[1] = bfhi(w.x); o[2] = bflo(w.y); o[3] = bfhi(w.y); o[4] = bflo(w.z); o[5] = bfhi(w.z); o[6] = bflo(w.w); o[7] = bfhi(w.w); }
template <int DK> __device__ __forceinline__ void load_q(const bf16* p, float (&q)[64]) {
#pragma unroll
    for (int g = 0; g < DK / 8; ++g) ld8(p + 8 * g, &q[8 * g]);
}
template <int DK> __device__ __forceinline__ float dot_qk(const float (&q)[64], const bf16* kp) {
    float s = 0.f;
#pragma unroll
    for (int g = 0; g < DK / 8; ++g) { float k[8]; ld8(kp + 8 * g, k);
#pragma unroll
        for (int i = 0; i < 8; ++i) s += q[8 * g + i] * k[i]; }
    return s;
}
__device__ __forceinline__ void attn_upd(float s, const bf16* vp, float& m, float& l, float (&o)[64]) {
    const float mn = fmaxf(m, s), c = __expf(m - mn), p = __expf(s - mn);
    l = l * c + p;
#pragma unroll
    for (int g = 0; g < 8; ++g) { float v[8]; ld8(vp + 8 * g, v);
#pragma unroll
        for (int i = 0; i < 8; ++i) o[8 * g + i] = o[8 * g + i] * c + p * v[i]; }
    m = mn;
}
__device__ __forceinline__ float reduce_scatter64(float (&o)[64], int lane) {
#pragma unroll
    for (int i = 0; i < 32; ++i) { const bool hi = lane & 32; const float send = hi ? o[i] : o[i + 32], keep = hi ? o[i + 32] : o[i]; o[i] = keep + __shfl_xor(send, 32); }
#pragma unroll
    for (int i = 0; i < 16; ++i) { const bool hi = lane & 16; const float send = hi ? o[i] : o[i + 16], keep = hi ? o[i + 16] : o[i]; o[i] = keep + __shfl_xor(send, 16); }
#pragma unroll
    for (int i = 0; i < 8; ++i) { const bool hi = lane & 8; const float send = hi ? o[i] : o[i + 8], keep = hi ? o[i + 8] : o[i]; o[i] = keep + __shfl_xor(send, 8); }
#pragma unroll
    for (int i = 0; i < 4; ++i) { const bool hi = lane & 4; const float send = hi ? o[i] : o[i + 4], keep = hi ? o[i + 4] : o[i]; o[i] = keep + __shfl_xor(send, 4); }
#pragma unroll
    for (int i = 0; i < 2; ++i) { const bool hi = lane & 2; const float send = hi ? o[i] : o[i + 2], keep = hi ? o[i + 2] : o[i]; o[i] = keep + __shfl_xor(send, 2); }
    { const bool hi = lane & 1; const float send = hi ? o[0] : o[1], keep = hi ? o[1] : o[0]; o[0] = keep + __shfl_xor(send, 1); }
    return o[0];
}
__device__ __forceinline__ float attn_fin(float m, float l, float (&o)[64], int lane) {
    const float M = wave_max(m); const float c = (m == -INFINITY) ? 0.f : __expf(m - M);
    const float L = wave_sum(l * c);
#pragma unroll
    for (int d = 0; d < 64; ++d) o[d] *= c;
    const float v = reduce_scatter64(o, lane);
    return L > 0.f ? v / L : 0.f;
}
__device__ __forceinline__ int bal_t(int tt) { return tt < 2048 ? tt : 6143 - tt; }

__device__ __forceinline__ void ph_cmp_topk(Frame& F) {
    PHASE_IDS(F);
    const bf16* Z = (const bf16*)(F.ws + WS_Z); const float* KC = (const float*)(F.ws + WS_KC); const float* VC = (const float*)(F.ws + WS_VC);
    bf16* OCMP = (bf16*)(F.ws + WS_OCMP); unsigned long long* SEL = (unsigned long long*)(F.ws + WS_SEL);
    float* ps = (float*)(F.lds + F.wave * 2048);
    for (int idx = F.gw; idx < T; idx += F.ngw) {
        const int b = idx >> 12, t = bal_t(idx & 4095), row = b * SEQ + t, lane = F.lane;
        const int nvalid = t >= 31 ? ((t - 31) >> 4) + 1 : 0;
        float psum[4] = {0.f, 0.f, 0.f, 0.f};
        const float* kcb = KC + (size_t)b * 256 * 64; const float* vcb = VC + (size_t)b * 256 * 64;
#pragma unroll 1
        for (int h = 0; h < 4; ++h) {
            float q[64]; load_q<64>(Z + (size_t)row * DINP + ZAQ + 64 * h, q);
            float s[4]; float mx = -INFINITY;
#pragma unroll
            for (int k = 0; k < 4; ++k) { const int n = lane + 64 * k; float acc = 0.f;
                if (n < nvalid) { const f32x4* kp = (const f32x4*)(kcb + n * 64);
#pragma unroll
                    for (int g = 0; g < 16; ++g) { const f32x4 kv = kp[g]; acc += q[4 * g] * kv.x + q[4 * g + 1] * kv.y + q[4 * g + 2] * kv.z + q[4 * g + 3] * kv.w; }
                    s[k] = acc * 0.125f; } else s[k] = -INFINITY;
                mx = fmaxf(mx, s[k]); }
            mx = wave_max(mx);
            float e[4], es = 0.f;
#pragma unroll
            for (int k = 0; k < 4; ++k) { e[k] = (lane + 64 * k < nvalid) ? __expf(s[k] - mx) : 0.f; es += e[k]; }
            es = wave_sum(es); const float inv = es > 0.f ? 1.0f / es : 0.f;
            float o[64];
#pragma unroll
            for (int d = 0; d < 64; ++d) o[d] = 0.f;
#pragma unroll
            for (int k = 0; k < 4; ++k) { const float p = e[k] * inv; psum[k] += p; const int n = lane + 64 * k;
                if (n < nvalid) { const f32x4* vp = (const f32x4*)(vcb + n * 64);
#pragma unroll
                    for (int g = 0; g < 16; ++g) { const f32x4 vv = vp[g]; o[4 * g] += p * vv.x; o[4 * g + 1] += p * vv.y; o[4 * g + 2] += p * vv.z; o[4 * g + 3] += p * vv.w; } } }
            const float od = reduce_scatter64(o, lane);
            OCMP[(size_t)row * 256 + 64 * h + lane] = (bf16)f2bf(od);
        }
#pragma unroll
        for (int k = 0; k < 4; ++k) ps[lane + 64 * k] = psum[k];
        LDS_WAIT(); asm volatile("" ::: "memory");
        const int j = lane, cur = t >> 6; float imp = ps[4 * j];
        if (j > 0) imp += 2.f * (ps[4 * j - 1] + ps[4 * j - 2] + ps[4 * j - 3]) + ps[4 * j - 4];
        LDS_WAIT(); asm volatile("" ::: "memory");
        const bool forced = (j == 0) || (j <= cur && j > cur - 2);
        const float sc = (j > cur) ? -1.0e6f : (forced ? 1.0e6f : imp);
        int rank = 0;
#pragma unroll 8
        for (int i = 0; i < 64; ++i) { const float si = __shfl(sc, i); rank += (si > sc || (si == sc && i < j)) ? 1 : 0; }
        const unsigned long long mask = __ballot(rank < 16 && j <= cur);
        if (lane == 0) SEL[row] = mask;
    }
}
__device__ __forceinline__ float diff_comp(const bf16* Z, int b, int h, int t, int comp, size_t row, float scale, int lane) {
    float q[64]; load_q<32>(Z + row * DINP + ZBQ + 64 * h + 32 * comp, q);
    float m = -INFINITY, l = 0.f, o[64];
#pragma unroll
    for (int d = 0; d < 64; ++d) o[d] = 0.f;
    for (int kp = lane; kp <= t; kp += 64) { const bf16* kr = Z + ((size_t)b * SEQ + kp) * DINP;
        const float s = dot_qk<32>(q, kr + ZBK + 64 * h + 32 * comp) * scale; attn_upd(s, kr + ZBV + 64 * h, m, l, o); }
    return attn_fin(m, l, o, lane);
}
__device__ __forceinline__ void ph_diff(Frame& F, const Args& a, int layer) {
    PHASE_IDS(F);
    const bf16* Z = (const bf16*)(F.ws + WS_Z); bf16* AO = (bf16*)(F.ws + WS_H);
    const float* lv = a.in[5] + (size_t)layer * 128; const float* sg = a.in[6] + (size_t)layer * 64;
    const float lam_init = 0.8f - 0.6f * expf(-0.3f * (float)layer);
    float l01 = 0.f, l23 = 0.f; if (F.lane < 32) { l01 = lv[F.lane] * lv[32 + F.lane]; l23 = lv[64 + F.lane] * lv[96 + F.lane]; }
    const float lam = expf(wave_sum(l01)) - expf(wave_sum(l23)) + lam_init;
    const float scale = 0.17677669529663687f;
    for (int idx = F.gw; idx < T * 4; idx += F.ngw) {
        const int bh = idx >> 12, b = bh >> 2, h = bh & 3, t = bal_t(idx & 4095), lane = F.lane; const size_t row = (size_t)b * SEQ + t;
        const float val0 = diff_comp(Z, b, h, t, 0, row, scale, lane), val1 = diff_comp(Z, b, h, t, 1, row, scale, lane);
        const float hd = val0 - lam * val1; const float ss = wave_sum(hd * hd);
        const float y = hd * (1.0f / sqrtf(ss * (1.0f / 64.0f) + EPS)) * sg[lane] * (1.0f - lam_init);
        AO[row * DM + 256 + 64 * h + lane] = (bf16)f2bf(y);
    }
}
__device__ __forceinline__ void ph_dilated(Frame& F) {
    PHASE_IDS(F);
    const bf16* Z = (const bf16*)(F.ws + WS_Z); bf16* AO = (bf16*)(F.ws + WS_H);
    for (int idx = F.gw; idx < T * 4; idx += F.ngw) {
        const int bh = idx >> 12, b = bh >> 2, h = bh & 3, t = idx & 4095, lane = F.lane; const size_t row = (size_t)b * SEQ + t;
        float q[64]; load_q<64>(Z + row * DINP + ZDQ + 64 * h, q);
        float m = -INFINITY, l = 0.f, o[64];
#pragma unroll
        for (int d = 0; d < 64; ++d) o[d] = 0.f;
#pragma unroll 1
        for (int k = 0; k < 7; ++k) { const int i = lane + 64 * k; const int g = i / 129, j = i - g * 129; const int dil = (g == 0) ? 1 : (g == 1) ? 4 : 16; const int kp = t - j * dil;
            if (i < 387 && kp >= 0) { const bf16* kr = Z + ((size_t)b * SEQ + kp) * DINP; const float s = dot_qk<64>(q, kr + ZDK + 64 * h) * 0.125f; attn_upd(s, kr + ZDV + 64 * h, m, l, o); } }
        const float v = attn_fin(m, l, o, lane);
        AO[row * DM + 768 + 64 * h + lane] = (bf16)f2bf(v);
    }
}
__device__ __forceinline__ void ph_mlstm_scan(Frame& F) {
    PHASE_IDS(F);
    float* CLOC = (float*)(F.ws + WS_CLOC); float* NLOC = (float*)(F.ws + WS_NLOC);
    const float* ACH = (const float*)(F.ws + WS_ACH); const float* MLOC = (const float*)(F.ws + WS_MLOC); float* MIN = (float*)(F.ws + WS_MIN);
    for (int it = blockIdx.x; it < 64; it += F.G) {
        const int bh = it >> 2, qt = it & 3; const int e0 = qt * 1024 + F.tid * 2;
        float c0 = 0.f, c1 = 0.f, nst = 0.f, mst = 0.f;
        for (int c = 0; c < 64; ++c) {
            const int ci = bh * 64 + c; const float ac = ACH[ci], ml = MLOC[ci];
            float* cp = CLOC + (size_t)ci * 4096 + e0; const f32x2 cl = *(const f32x2*)cp;
            const float mn = fmaxf(ac + mst, ml), decay = __expf(ac + mst - mn), fresh = __expf(ml - mn);
            *(f32x2*)cp = (f32x2){c0, c1}; c0 = decay * c0 + fresh * cl.x; c1 = decay * c1 + fresh * cl.y;
            if (qt == 0 && F.tid < 64) { const float nl = NLOC[ci * 64 + F.tid]; NLOC[ci * 64 + F.tid] = nst; nst = decay * nst + fresh * nl; if (F.tid == 0) MIN[ci] = mst; }
            mst = mn;
        }
    }
}

__device__ __forceinline__ void ph_nsa_sw(Frame& F) {
    PHASE_IDS(F);
    const bf16* Z = (const bf16*)(F.ws + WS_Z); const bf16* AQR = (const bf16*)(F.ws + WS_AQR); const bf16* OCMP = (const bf16*)(F.ws + WS_OCMP);
    const unsigned long long* SEL = (const unsigned long long*)(F.ws + WS_SEL); bf16* AO = (bf16*)(F.ws + WS_H);
    for (int idx = F.gw; idx < T * 4; idx += F.ngw) {
        const int bh = idx >> 12, b = bh >> 2, h = bh & 3, t = bal_t(idx & 4095), lane = F.lane; const size_t row = (size_t)b * SEQ + t;
        float q[64]; load_q<64>(AQR + row * 256 + 64 * h, q);
        const unsigned long long mk = SEL[row]; unsigned mlo = __builtin_amdgcn_readfirstlane((unsigned)mk), mhi = __builtin_amdgcn_readfirstlane((unsigned)(mk >> 32));
        float m = -INFINITY, l = 0.f, o[64];
#pragma unroll
        for (int d = 0; d < 64; ++d) o[d] = 0.f;
#pragma unroll 1
        for (int j = 0; j < 64; ++j) { const unsigned bit = (j < 32) ? (mlo >> j) & 1u : (mhi >> (j - 32)) & 1u; if (!bit) continue;
            const int kp = 64 * j + lane; if (kp <= t) { const bf16* kr = Z + ((size_t)b * SEQ + kp) * DINP; const float s = dot_qk<64>(q, kr + ZKS) * 0.125f; attn_upd(s, kr + ZVS, m, l, o); } }
        const float oslc = attn_fin(m, l, o, lane);
        m = -INFINITY; l = 0.f;
#pragma unroll
        for (int d = 0; d < 64; ++d) o[d] = 0.f;
#pragma unroll 1
        for (int k = 0; k < 8; ++k) { const int kp = t - 511 + lane + 64 * k;
            if (kp >= 0) { const bf16* kr = Z + ((size_t)b * SEQ + kp) * DINP; const float s = dot_qk<64>(q, kr + ZKW) * 0.125f; attn_upd(s, kr + ZVW, m, l, o); } }
        const float owin = attn_fin(m, l, o, lane);
        const bf16* zr = Z + row * DINP + ZAG; const float g0 = sigmoidf_(bf2f(zr[h])), g1 = sigmoidf_(bf2f(zr[4 + h])), g2 = sigmoidf_(bf2f(zr[8 + h]));
        const float out = g0 * bf2f(OCMP[row * 256 + 64 * h + lane]) + g1 * oslc + g2 * owin;
        AO[row * DM + 64 * h + lane] = (bf16)f2bf(out);
    }
}
__device__ __forceinline__ void ph_mlstm_out(Frame& F, const Args& a, int layer) {
    PHASE_IDS(F);
    const bf16* Z = (const bf16*)(F.ws + WS_Z); bf16* AO = (bf16*)(F.ws + WS_H);
    const float* MQ = (const float*)(F.ws + WS_MQ); const float* MK = (const float*)(F.ws + WS_MK); const float* CIN = (const float*)(F.ws + WS_CLOC); const float* NIN = (const float*)(F.ws + WS_NLOC);
    const float* BCUM = (const float*)(F.ws + WS_BCUM); const float* IG = (const float*)(F.ws + WS_IG); const float* MIN = (const float*)(F.ws + WS_MIN);
    const float* hg = a.in[12] + (size_t)layer * 256;
    float* L = (float*)F.lds; float* QS = L; float* KS = L + 4224; float* VS = L + 8448; float* CS = L + 12672; float* SS = L + 16896;
    float* NI = L + 21120; float* BC = NI + 64; float* IGS = BC + 64; float* MT = IGS + 64; float* EI = MT + 64;
    for (int it = blockIdx.x; it < 1024; it += F.G) {
        const int bh = it >> 6, c = it & 63, b = bh >> 2, h = bh & 3; const size_t row0 = (size_t)b * SEQ + c * 64;
        __syncthreads();
        for (int i = F.tid; i < 4096; i += NTHREADS) { const int l = i >> 6, d = i & 63; const size_t g = (row0 + l) * 256 + h * 64 + d;
            QS[l * 65 + d] = MQ[g]; KS[l * 65 + d] = MK[g]; VS[l * 65 + d] = bf2f(Z[(row0 + l) * DINP + ZCV + h * 64 + d]); CS[l * 65 + d] = CIN[(size_t)it * 4096 + i]; }
        if (F.wave == 0) { const int l = F.lane; const float bc = BCUM[(row0 + l) * 4 + h], ig = IG[(row0 + l) * 4 + h], mi = MIN[it];
            NI[l] = NIN[it * 64 + l]; BC[l] = bc; IGS[l] = ig;
            float pm = ig - bc;
#pragma unroll
            for (int o = 1; o < 64; o <<= 1) { const float v = __shfl_up(pm, o); if (l >= o) pm = fmaxf(pm, v); }
            const float inter = bc + mi, mt = fmaxf(inter, bc + pm); MT[l] = mt; EI[l] = __expf(inter - mt); }
        __syncthreads();
        { const int t = F.tid >> 3, sg = (F.tid & 7) * 8; const float bt = BC[t], mt = MT[t];
#pragma unroll 1
            for (int i = 0; i < 8; ++i) { const int s = sg + i; float v = 0.f;
                if (s <= t) { float dp = 0.f;
#pragma unroll 16
                    for (int d = 0; d < 64; ++d) dp += QS[t * 65 + d] * KS[s * 65 + d];
                    v = dp * __expf(bt - BC[s] + IGS[s] - mt); }
                SS[t * 65 + s] = v; } }
        __syncthreads();
        { const int t = F.tid >> 3, vg = (F.tid & 7) * 8; float num[8]; const float ei = EI[t];
#pragma unroll
            for (int i = 0; i < 8; ++i) num[i] = 0.f;
            float nq = 0.f, ssum = 0.f;
            for (int k = 0; k < 64; ++k) { const float qv = QS[t * 65 + k]; nq += NI[k] * qv;
#pragma unroll
                for (int i = 0; i < 8; ++i) num[i] += CS[(vg + i) * 65 + k] * qv; }
#pragma unroll
            for (int i = 0; i < 8; ++i) num[i] *= ei;
            for (int s = 0; s < 64; ++s) { const float sv = SS[t * 65 + s]; ssum += sv;
#pragma unroll
                for (int i = 0; i < 8; ++i) num[i] += sv * VS[s * 65 + vg + i]; }
            const float den = ei * nq + ssum; const float dn = fmaxf(fabsf(den), __expf(-MT[t])); const float rd = 1.0f / dn;
            float sq = 0.f;
#pragma unroll
            for (int i = 0; i < 8; ++i) { num[i] *= rd; sq += num[i] * num[i]; }
            sq += __shfl_xor(sq, 1); sq += __shfl_xor(sq, 2); sq += __shfl_xor(sq, 4);
            const float rn = 1.0f / sqrtf(sq * (1.0f / 64.0f) + EPS); const size_t row = row0 + t;
            unsigned w[4];
#pragma unroll
            for (int i = 0; i < 8; i += 2) { const int ch = h * 64 + vg + i;
                const float y0 = num[i] * rn * hg[ch] * sigmoidf_(bf2f(Z[row * DINP + ZCO + ch])), y1 = num[i + 1] * rn * hg[ch + 1] * sigmoidf_(bf2f(Z[row * DINP + ZCO + ch + 1]));
                w[i >> 1] = pk2(y0, y1); }
            *(v4u*)(AO + row * DM + 512 + h * 64 + vg) = (v4u){w[0], w[1], w[2], w[3]}; }
    }
    __syncthreads();
}

namespace fa {
typedef short bf16x8 __attribute__((ext_vector_type(8)));
typedef float f32x16 __attribute__((ext_vector_type(16)));
typedef short s16x4 __attribute__((ext_vector_type(4)));
typedef __bf16 bf16x2_t __attribute__((ext_vector_type(2)));
constexpr int KP = 144, VP = 192, KT = 64 * KP, VT = 64 * VP, BUF = KT + VT, LDS_NEED = 2 * BUF;
constexpr float LOG2E = 1.4426950408889634f, LN2 = 0.6931471805599453f;
__device__ __forceinline__ int crow(int r, int hi) { return (r & 3) + 8 * (r >> 2) + 4 * hi; }
__device__ __forceinline__ unsigned cvtpk(float lo, float hi) { f32x2 v = {lo, hi}; bf16x2_t b = __builtin_convertvector(v, bf16x2_t); return __builtin_bit_cast(unsigned, b); }
__device__ __forceinline__ s16x4 vtr(LAS unsigned char* p) { return __builtin_bit_cast(s16x4, __builtin_amdgcn_ds_read_tr16_b64_v4i16((LAS s16x4*)p)); }
__device__ __forceinline__ void load_qf(const bf16* qrow, int hi, bf16x8 (&qf)[4]) {
#pragma unroll
    for (int ks = 0; ks < 4; ++ks) qf[ks] = *(const bf16x8*)(qrow + 16 * ks + 8 * hi);
}
template <int KS0, int KS, class P>
__device__ __forceinline__ void stream(const P& p, LAS unsigned char* lds, int tid, float sc, const bf16x8 (&qf)[4], float& m_, float& l_, f32x16 (&O_)[2]) {
    constexpr int NCOMP = 1; float m[1] = {m_}, l[1] = {l_}; f32x16 O[1][2] = {{O_[0], O_[1]}};
    const int lane = tid & 63, r32 = lane & 31, hi = lane >> 5, g = lane >> 4, i16 = lane & 15;
    const int srow = tid >> 3, scx = tid & 7;
    const int koff = r32 * KP + hi * 16;
    const int voff = KT + ((i16 >> 2) + 4 * hi) * VP + (16 * (g & 1) + 4 * (i16 & 3)) * 2;
    const int nt = p.ntiles();
    v4u kr = {0u, 0u, 0u, 0u}, vr = {0u, 0u, 0u, 0u};
#define FA_LOAD(it_) do { const bf16* kp_ = p.krow((it_), srow); const bf16* vp_ = p.vrow((it_), srow); \
        kr = kp_ ? *(const v4u*)(kp_ + 8 * scx) : (v4u){0u, 0u, 0u, 0u}; vr = vp_ ? *(const v4u*)(vp_ + 8 * scx) : (v4u){0u, 0u, 0u, 0u}; } while (0)
#define FA_STORE(b_) do { *(LAS v4u*)(lds + (b_) * BUF + srow * KP + scx * 16) = kr; *(LAS v4u*)(lds + (b_) * BUF + KT + srow * VP + scx * 16) = vr; } while (0)
    __syncthreads();
    if (nt > 0) { FA_LOAD(0); FA_STORE(0); if (nt > 1) FA_LOAD(1); }
    __syncthreads();
#pragma unroll 1
    for (int it = 0; it < nt; ++it) {
        LAS unsigned char* B = lds + (it & 1) * BUF;
        if (!p.wave_skip(it)) {
            const bool msk = p.need_mask(it);
#pragma unroll
            for (int c = 0; c < NCOMP; ++c) {
                f32x16 S[2];
#pragma unroll
                for (int st = 0; st < 2; ++st) {
#pragma unroll
                    for (int r = 0; r < 16; ++r) S[st][r] = 0.f;
#pragma unroll
                    for (int ks = KS0; ks < KS0 + KS; ++ks) { const bf16x8 kf = *(LAS bf16x8*)(B + koff + st * 32 * KP + ks * 32); S[st] = __builtin_amdgcn_mfma_f32_32x32x16_bf16(kf, qf[ks], S[st], 0, 0, 0); }
                }
                if (msk) {
                    int lb, ub; p.bounds(it, lb, ub); lb -= 4 * hi; ub -= 4 * hi;
#pragma unroll
                    for (int st = 0; st < 2; ++st)
#pragma unroll
                        for (int r = 0; r < 16; ++r) { const int cc = 32 * st + (r & 3) + 8 * (r >> 2); if (cc < lb || cc > ub) S[st][r] = -INFINITY; }
                }
                float tm = S[0][0];
#pragma unroll
                for (int r = 1; r < 16; ++r) tm = fmaxf(tm, S[0][r]);
#pragma unroll
                for (int r = 0; r < 16; ++r) tm = fmaxf(tm, S[1][r]);
                tm = fmaxf(tm, __shfl_xor(tm, 32));
                const float mn = fmaxf(m[c], tm * sc), ms = (mn == -INFINITY) ? 0.f : mn;
                const float alpha = __builtin_amdgcn_exp2f(m[c] - ms);
                m[c] = mn;
                float ps = 0.f;
#pragma unroll
                for (int st = 0; st < 2; ++st)
#pragma unroll
                    for (int r = 0; r < 16; ++r) { const float e = __builtin_amdgcn_exp2f(__builtin_fmaf(S[st][r], sc, -ms)); S[st][r] = e; ps += e; }
                l[c] = l[c] * alpha + ps;
                if (__any(alpha != 1.0f)) {
#pragma unroll
                    for (int dt = 0; dt < 2; ++dt)
#pragma unroll
                        for (int r = 0; r < 16; ++r) O[c][dt][r] *= alpha;
                }
#pragma unroll
                for (int st = 0; st < 2; ++st)
#pragma unroll
                    for (int s = 0; s < 2; ++s) {
                        v4u pw; pw.x = cvtpk(S[st][8 * s], S[st][8 * s + 1]); pw.y = cvtpk(S[st][8 * s + 2], S[st][8 * s + 3]); pw.z = cvtpk(S[st][8 * s + 4], S[st][8 * s + 5]); pw.w = cvtpk(S[st][8 * s + 6], S[st][8 * s + 7]);
                        const bf16x8 pf = __builtin_bit_cast(bf16x8, pw);
#pragma unroll
                        for (int dt = 0; dt < 2; ++dt) {
                            LAS unsigned char* vp = B + voff + (32 * st + 16 * s) * VP + dt * 64;
                            const s16x4 v0 = vtr(vp), v1 = vtr(vp + 8 * VP);
                            const bf16x8 vf = {v0[0], v0[1], v0[2], v0[3], v1[0], v1[1], v1[2], v1[3]};
                            O[c][dt] = __builtin_amdgcn_mfma_f32_32x32x16_bf16(vf, pf, O[c][dt], 0, 0, 0);
                        }
                    }
                if (NCOMP > 1) __builtin_amdgcn_sched_barrier(0);
            }
        }
        if (it + 1 < nt) { FA_STORE((it + 1) & 1); if (it + 2 < nt) FA_LOAD(it + 2); }
        __syncthreads();
    }
#undef FA_LOAD
#undef FA_STORE
    m_ = m[0]; l_ = l[0]; O_[0] = O[0][0]; O_[1] = O[0][1];
}
__device__ __forceinline__ float finish(float l, f32x16 (&O)[2]) {
    const float lt = l + __shfl_xor(l, 32); const float inv = lt > 0.f ? 1.0f / lt : 0.f;
#pragma unroll
    for (int dt = 0; dt < 2; ++dt)
#pragma unroll
        for (int r = 0; r < 16; ++r) O[dt][r] *= inv;
    return lt;
}
__device__ __forceinline__ void store_o(const f32x16 (&O)[2], bf16* out, int hi) {
#pragma unroll
    for (int dt = 0; dt < 2; ++dt)
#pragma unroll
        for (int rg = 0; rg < 4; ++rg) { v2u w; w.x = cvtpk(O[dt][4 * rg], O[dt][4 * rg + 1]); w.y = cvtpk(O[dt][4 * rg + 2], O[dt][4 * rg + 3]); *(v2u*)(out + 32 * dt + 8 * rg + 4 * hi) = w; }
}
}

struct DiffPol {
    const bf16* Zb; int h, t0, wq0, tq;
    __device__ __forceinline__ int ntiles() const { return (t0 + 256) >> 6; }
    __device__ __forceinline__ const bf16* krow(int it, int r) const { return Zb + (size_t)(64 * it + r) * DINP + ZBK + 64 * h; }
    __device__ __forceinline__ const bf16* vrow(int it, int r) const { return Zb + (size_t)(64 * it + r) * DINP + ZBV + 64 * h; }
    __device__ __forceinline__ bool wave_skip(int it) const { return 64 * it > wq0 + 31; }
    __device__ __forceinline__ bool need_mask(int it) const { return 64 * it + 63 > wq0; }
    __device__ __forceinline__ void bounds(int it, int& lb, int& ub) const { lb = 0; ub = tq - 64 * it; }
};
__device__ __forceinline__ void diff_item(Frame& F, const Args& a, int layer, int b, int h, int qb, float lam) {
    const bf16* Z = (const bf16*)(F.ws + WS_Z); bf16* AO = (bf16*)(F.ws + WS_H);
    const int lane = F.lane, r32 = lane & 31, hi = lane >> 5;
    DiffPol p; p.Zb = Z + (size_t)b * SEQ * DINP; p.h = h; p.t0 = 256 * qb; p.wq0 = p.t0 + 32 * F.wave; p.tq = p.wq0 + r32;
    fa::bf16x8 qf[4]; fa::load_qf(p.Zb + (size_t)p.tq * DINP + ZBQ + 64 * h, hi, qf);
    fa::f32x16 O[2][2];
#pragma unroll
    for (int c = 0; c < 2; ++c)
#pragma unroll
        for (int dt = 0; dt < 2; ++dt)
#pragma unroll
            for (int r = 0; r < 16; ++r) O[c][dt][r] = 0.f;
    { float m = -INFINITY, l = 0.f; fa::stream<0, 2, DiffPol>(p, F.lds3, F.tid, 0.17677669529663687f * fa::LOG2E, qf, m, l, O[0]); fa::finish(l, O[0]); }
    { float m = -INFINITY, l = 0.f; fa::stream<2, 2, DiffPol>(p, F.lds3, F.tid, 0.17677669529663687f * fa::LOG2E, qf, m, l, O[1]); fa::finish(l, O[1]); }
    const float lam_init = 0.8f - 0.6f * expf(-0.3f * (float)layer);
    const float* sg = a.in[6] + (size_t)layer * 64;
    float ss = 0.f;
#pragma unroll
    for (int dt = 0; dt < 2; ++dt)
#pragma unroll
        for (int r = 0; r < 16; ++r) { const float v = O[0][dt][r] - lam * O[1][dt][r]; O[0][dt][r] = v; ss += v * v; }
    ss += __shfl_xor(ss, 32);
    const float rn = (1.0f / sqrtf(ss * (1.0f / 64.0f) + EPS)) * (1.0f - lam_init);
#pragma unroll
    for (int dt = 0; dt < 2; ++dt)
#pragma unroll
        for (int r = 0; r < 16; ++r) O[0][dt][r] *= rn * sg[32 * dt + fa::crow(r, hi)];
    fa::store_o(O[0], AO + ((size_t)b * SEQ + p.tq) * DM + 256 + 64 * h, hi);
}
struct DilPol {
    const bf16* Zb; int h, dil, res, it0, nt, wi0, iq;
    __device__ __forceinline__ int ntiles() const { return nt; }
    __device__ __forceinline__ const bf16* krow(int it, int r) const { const int ik = 64 * (it0 + it) + r; return Zb + (size_t)(res + dil * ik) * DINP + ZDK + 64 * h; }
    __device__ __forceinline__ const bf16* vrow(int it, int r) const { const int ik = 64 * (it0 + it) + r; return Zb + (size_t)(res + dil * ik) * DINP + ZDV + 64 * h; }
    __device__ __forceinline__ bool wave_skip(int it) const { const int k0 = 64 * (it0 + it); return k0 > wi0 + 31 || k0 + 63 < wi0 - 128; }
    __device__ __forceinline__ bool need_mask(int) const { return true; }
    __device__ __forceinline__ void bounds(int it, int& lb, int& ub) const { ub = iq - 64 * (it0 + it); lb = ub - 128; }
};
__device__ __forceinline__ void dil_item(Frame& F, int b, int h, int g, int res, int blk) {
    const bf16* Z = (const bf16*)(F.ws + WS_Z); bf16* DP = (bf16*)(F.ws + WS_DPART); float* DL = (float*)(F.ws + WS_DLSE);
    const int lane = F.lane, r32 = lane & 31, hi = lane >> 5;
    DilPol p; p.Zb = Z + (size_t)b * SEQ * DINP; p.h = h; p.dil = (g == 0) ? 1 : (g == 1) ? 4 : 16; p.res = res;
    const int i0 = 256 * blk; const int t_lo = (i0 >> 6) - 2; p.it0 = t_lo < 0 ? 0 : t_lo; p.nt = (i0 >> 6) + 4 - p.it0;
    p.wi0 = i0 + 32 * F.wave; p.iq = p.wi0 + r32;
    const int tq = res + p.dil * p.iq; const size_t row = (size_t)b * SEQ + tq;
    fa::bf16x8 qf[4]; fa::load_qf(p.Zb + (size_t)tq * DINP + ZDQ + 64 * h, hi, qf);
    float m = -INFINITY, l = 0.f; fa::f32x16 O[2];
#pragma unroll
    for (int dt = 0; dt < 2; ++dt)
#pragma unroll
        for (int r = 0; r < 16; ++r) O[dt][r] = 0.f;
    fa::stream<0, 4, DilPol>(p, F.lds3, F.tid, 0.125f * fa::LOG2E, qf, m, l, O);
    const float lt = fa::finish(l, O);
    fa::store_o(O, DP + ((size_t)g * T + row) * 256 + 64 * h, hi);
    if (hi == 0) DL[((size_t)g * T + row) * 4 + h] = (m + __log2f(lt)) * fa::LN2;
}
__device__ __forceinline__ void dil_combine(Frame& F) {
    PHASE_IDS(F);
    const bf16* DP = (const bf16*)(F.ws + WS_DPART); const float* DL = (const float*)(F.ws + WS_DLSE); bf16* AO = (bf16*)(F.ws + WS_H);
    const int gt = F.gw * 64 + F.lane, ngt = F.ngw * 64;
    for (int i = gt; i < T * 32; i += ngt) { const int row = i >> 5, c8 = (i & 31) * 8, h = c8 >> 6;
        const float l0 = DL[(size_t)row * 4 + h], l1 = DL[((size_t)T + row) * 4 + h], l2 = DL[((size_t)2 * T + row) * 4 + h];
        const float mx = fmaxf(l0, fmaxf(l1, l2)); float w0 = __expf(l0 - mx), w1 = __expf(l1 - mx), w2 = __expf(l2 - mx); const float inv = 1.0f / (w0 + w1 + w2); w0 *= inv; w1 *= inv; w2 *= inv;
        float x0[8], x1[8], x2[8]; ld8(DP + (size_t)row * 256 + c8, x0); ld8(DP + ((size_t)T + row) * 256 + c8, x1); ld8(DP + ((size_t)2 * T + row) * 256 + c8, x2);
        v4u o; o.x = pk2(w0 * x0[0] + w1 * x1[0] + w2 * x2[0], w0 * x0[1] + w1 * x1[1] + w2 * x2[1]); o.y = pk2(w0 * x0[2] + w1 * x1[2] + w2 * x2[2], w0 * x0[3] + w1 * x1[3] + w2 * x2[3]);
        o.z = pk2(w0 * x0[4] + w1 * x1[4] + w2 * x2[4], w0 * x0[5] + w1 * x1[5] + w2 * x2[5]); o.w = pk2(w0 * x0[6] + w1 * x1[6] + w2 * x2[6], w0 * x0[7] + w1 * x1[7] + w2 * x2[7]);
        *(v4u*)(AO + (size_t)row * DM + 768 + c8) = o; }
}
__device__ __forceinline__ void ph_d_queue(Frame& F, const Args& a, int layer) {
    PHASE_IDS(F);
    unsigned* ctr = F.ctl + CW_Q + 64 * layer;
    const float* lv = a.in[5] + (size_t)layer * 128;
    const float lam_init = 0.8f - 0.6f * expf(-0.3f * (float)layer);
    float l01 = 0.f, l23 = 0.f; if (F.lane < 32) { l01 = lv[F.lane] * lv[32 + F.lane]; l23 = lv[64 + F.lane] * lv[96 + F.lane]; }
    const float lam = expf(wave_sum(l01)) - expf(wave_sum(l23)) + lam_init;
    constexpr int N_DIFF = 256, N_DIL = 768;
    for (;;) {
        __syncthreads();
        if (F.tid == 0) F.MISC[0] = __hip_atomic_fetch_add(ctr, 1u, __ATOMIC_RELAXED, __HIP_MEMORY_SCOPE_AGENT);
        __syncthreads();
        int it = (int)F.MISC[0];
        if (it >= N_DIFF + N_DIL) break;
        if (it < N_DIFF) { const int qb = 15 - (it >> 4), bh = it & 15; diff_item(F, a, layer, bh >> 2, bh & 3, qb, lam); continue; }
        it -= N_DIFF;
        { const int bh = it & 15, k = it >> 4;
          const int g = k >> 4, j = k & 15; const int res = (g == 0) ? 0 : (g == 1) ? (j & 3) : j, blk = (g == 0) ? j : (g == 1) ? (j >> 2) : 0;
          dil_item(F, bh >> 2, bh & 3, g, res, blk); }
    }
    __syncthreads();
}

constexpr int NPHASE = 9 * DEPTH + 1;
#ifndef PH_LO
#define PH_LO 0
#endif
#ifndef PH_HI
#define PH_HI NPHASE
#endif
#define IN(k) (PH_LO <= (k) && (k) < PH_HI)
#define SEAM(k) do { if (IN(k) && IN((k) + 1)) { if ((k) == PH_LO) cg::this_grid().sync(); xcd_barrier(bar); } } while (0)
template <int layer> __device__ __forceinline__ void run_layer(Frame& F, const Args& args, const XcdBarrier& bar) {
    float* XR = args.out;
    bf16* H = (bf16*)(F.ws + WS_H); bf16* Z = (bf16*)(F.ws + WS_Z);
    bf16* WIN = (bf16*)(F.ws + WS_WIN); bf16* WOUT = (bf16*)(F.ws + WS_WOUT); bf16* WGU = (bf16*)(F.ws + WS_WGU); bf16* WD = (bf16*)(F.ws + WS_WD);

        const int P = 9 * layer;
        if (IN(P + 0)) {
            convert_weights(F, args, layer);
            if (layer == 0) build_rope(F, args);
            norm_rows_bf16(F, layer == 0 ? args.in[0] : XR, args.in[1] + (size_t)layer * DM, H);
        }
        SEAM(P + 0);
        if (IN(P + 1)) {
            pg8::Gemm g{H, WIN, T, DINP, DM}; pg8::StaticOrder S; S.init(T, DINP, F.G, (int)blockIdx.x); pg8::EpiZ E{Z, DINP};
            pg8::gemm_phase<pg8::EpiZ, pg8::StaticOrder, true, true>(F.lds3, g, S, E);
        }
        SEAM(P + 1);
        if (IN(P + 2)) {
#ifndef NO_C1
 prep_mlstm(F, args, layer);
#endif
#ifndef NO_C2
 prep_compress(F, args, layer);
#endif
#ifndef NO_C3
 prep_rope(F);
#endif
 }
        SEAM(P + 2);
        if (IN(P + 3)) {
#ifndef NO_D1
 ph_mlstm_scan(F);
#endif
#ifndef NO_D2
 ph_d_queue(F, args, layer);
#endif
#ifndef NO_D3
 ph_cmp_topk(F);
#endif
 }
        SEAM(P + 3);
        if (IN(P + 4)) {
#ifndef NO_E1
 ph_nsa_sw(F);
#endif
#ifndef NO_E2
 ph_mlstm_out(F, args, layer);
#endif
 dil_combine(F);
 }
        SEAM(P + 4);
        if (IN(P + 5)) {
            pg8::Gemm g{H, WOUT, T, DM, DM}; pg8::StaticOrder S; S.init(T, DM, F.G, (int)blockIdx.x); pg8::EpiRes E{layer == 0 ? args.in[0] : XR, XR, DM};
            pg8::gemm_phase<pg8::EpiRes, pg8::StaticOrder, true, true>(F.lds3, g, S, E);
        }
        SEAM(P + 5);
        if (IN(P + 6)) norm_rows_bf16(F, XR, args.in[14] + (size_t)layer * DM, H);
        SEAM(P + 6);
        if (IN(P + 7)) {
            pg8::Gemm g{H, WGU, T, 2 * DFF, DM}; pg8::StaticOrder S; S.init(T, 2 * DFF, F.G, (int)blockIdx.x); pg8::EpiSwiGLU E{Z, DFF};
            pg8::gemm_phase<pg8::EpiSwiGLU, pg8::StaticOrder, true, true>(F.lds3, g, S, E);
        }
        SEAM(P + 7);
        if (IN(P + 8)) {
            pg8::Gemm g{Z, WD, T, DM, DFF}; pg8::StaticOrder S; S.init(T, DM, F.G, (int)blockIdx.x); pg8::EpiRes E{XR, XR, DM};
            pg8::gemm_phase<pg8::EpiRes, pg8::StaticOrder, true, true>(F.lds3, g, S, E);
        }
        SEAM(P + 8);
    }
__global__ void __launch_bounds__(NTHREADS, 2) fwd_kernel(Args args) {
    extern __shared__ __attribute__((aligned(16))) unsigned char lds[];
    Frame F;
    F.lds = lds; F.lds3 = (LAS unsigned char*)lds; F.MISC = (volatile LAS unsigned*)(F.lds3 + MISC_OFF);
    F.tid = threadIdx.x; F.lane = F.tid & 63; F.wave = __builtin_amdgcn_readfirstlane(F.tid >> 6);
    F.G = gridDim.x; F.gw = blockIdx.x * NWAVES + F.wave; F.ngw = F.G * NWAVES;
    F.ws = args.ws; F.ctl = (unsigned*)(args.ws + WS_CTL);
    for (int u = F.tid; u < (LDS_BYTES - LDSCTL_OFF) / 4; u += NTHREADS) ((LAS unsigned*)(F.lds3 + LDSCTL_OFF))[u] = 0u;
    __syncthreads();
    XcdBarrier bar = xcd_barrier_post(F.ctl + CW_BAR, F.MISC + 8);
    run_layer<0>(F, args, bar);
    run_layer<1>(F, args, bar);
    if (IN(9 * DEPTH)) norm_rows_f32_inplace(F, args.out, args.in[18]);
#undef IN
#undef SEAM
}

extern "C" void kernel_launch(void* const* d_in, const int* in_sizes, int n_in, void* d_out, int out_size, void* d_ws, size_t ws_size, hipStream_t stream) {
    static int grid = 0;
    if (grid == 0) {
        if (n_in != 19 || in_sizes[0] != T * DM || out_size != T * DM || ws_size < WS_END) { fprintf(stderr, "kernel_launch: unexpected shapes (n_in %d, in0 %d, out %d, ws %zu); nothing launched\n", n_in, n_in > 0 ? in_sizes[0] : -1, out_size, ws_size); grid = -1; return; }
        int dev = 0, cus = 0, per_cu = 0;
        if (hipGetDevice(&dev) != hipSuccess || hipDeviceGetAttribute(&cus, hipDeviceAttributeMultiprocessorCount, dev) != hipSuccess) { grid = -1; return; }
        if (hipFuncSetAttribute((const void*)fwd_kernel, hipFuncAttributeMaxDynamicSharedMemorySize, LDS_BYTES) != hipSuccess) { fprintf(stderr, "kernel_launch: hipFuncSetAttribute failed\n"); grid = -1; return; }
        if (hipOccupancyMaxActiveBlocksPerMultiprocessor(&per_cu, (const void*)fwd_kernel, NTHREADS, LDS_BYTES) != hipSuccess || per_cu < 1) { fprintf(stderr, "kernel_launch: note: occupancy query says %d blocks per CU\n", per_cu); (void)hipGetLastError(); }
        grid = cus;
    }
    if (grid < 0) return;
    if (hipMemsetAsync((char*)d_ws + WS_CTL, 0, CTL_ZERO_BYTES, stream) != hipSuccess) { fprintf(stderr, "kernel_launch: memset failed\n"); return; }
    Args a{};
    for (int i = 0; i < 19; ++i) a.in[i] = (const float*)d_in[i];
    a.out = (float*)d_out; a.ws = (unsigned char*)d_ws;
    for (int i = 0; i < 32; ++i) a.inv64[i] = 1.0f / powf(10000.0f, (float)(2 * i) / 64.0f);
    for (int i = 0; i < 16; ++i) a.inv32[i] = 1.0f / powf(10000.0f, (float)(2 * i) / 32.0f);
    void* params[] = {&a};
    const hipError_t le = hipLaunchCooperativeKernel((const void*)fwd_kernel, dim3(grid), dim3(NTHREADS), params, LDS_BYTES, stream);
    if (le != hipSuccess) fprintf(stderr, "kernel_launch: cooperative launch failed: %s (grid %d)\n", hipGetErrorName(le), grid);
}
```

```cpp
#include <hip/hip_runtime.h>
#include <hip/hip_cooperative_groups.h>
#include <cstdio>
#include <cstdint>
namespace cg = cooperative_groups;
namespace pg8 {
#define PG8_LAS __attribute__((address_space(3)))
typedef unsigned short bf16_t;
typedef short bf16x8 __attribute__((ext_vector_type(8)));
typedef float f32x4 __attribute__((ext_vector_type(4)));
typedef unsigned u32x4 __attribute__((ext_vector_type(4)));
constexpr int BM = 256, BK = 64, HALF = 128, HTB = HALF * BK * 2  , STAGE_BYTES = 8 * HTB, NXCD = 8, WGM = 8;

__host__ __device__ __forceinline__ int lds_byte(int r, int c) { const int st = (r >> 4) * 2 + (c >> 5), rr = r & 15, cc = c & 31, ob = rr * 64 + cc * 2; return st * 1024 + (ob ^ (((ob >> 9) & 1) << 5)); }
__host__ __device__ __forceinline__ void stage_rc(int b, int& R, int& C) { const int st = b / 1024, sb = b % 1024, swz = sb ^ (((sb >> 9) & 1) << 5); R = (st >> 1) * 16 + swz / 64; C = (st & 1) * 32 + (swz % 64) / 2; }
__host__ __device__ __forceinline__ int perm32(int rho) { const int n = rho >> 4, i = rho & 15; return 8 * (i >> 2) + 4 * n + (i & 3); }

struct Unit { int pm, pn; };
struct Gemm { const bf16_t* A; const bf16_t* Bt; int M, N, K; };

struct StaticOrder {
    int nM, nN, nwg, G, c;
    __host__ __device__ void init(int M, int N, int G_, int c_) { nM = M / BM; nN = N / BM; nwg = nM * nN; G = G_; c = c_; }
    __host__ __device__ bool next(int i, Unit& u) const {
        const long L = (long)i * G + c; if (L >= nwg) return false;
        int wgid = (int)L; { const int q = nwg / NXCD, r = nwg % NXCD, xcd = wgid % NXCD, off = wgid / NXCD; wgid = (xcd < r ? xcd * (q + 1) : r * (q + 1) + (xcd - r) * q) + off; }
        const int nig = WGM * nN, gid = wgid / nig, fm = gid * WGM, gsz = (nM - fm) < WGM ? (nM - fm) : WGM;
        u.pm = fm + ((wgid % nig) % gsz); u.pn = (wgid % nig) / gsz; return true;
    }
    __device__ __forceinline__ void a_ready(const Unit&) const {}
    __device__ __forceinline__ void done(const Unit&) const {}
};

__device__ __forceinline__ unsigned cvt_pk_bf16(float lo, float hi) { unsigned r; asm volatile("v_cvt_pk_bf16_f32 %0, %1, %2" : "=v"(r) : "v"(lo), "v"(hi)); return r; }
typedef float f32x2 __attribute__((ext_vector_type(2)));
struct EpiZ {
    static constexpr bool PERM = true, AFTER_DRAIN = false;
    bf16_t* O; int ldc;
    __device__ __forceinline__ void operator()(const f32x4 (&acc)[2][2][4][2], const Unit& u, int wr, int wc, int fr, int fq) const {
        const int row0 = u.pm * BM + wr * 64 + fr, col0 = u.pn * BM + wc * 32 + 8 * fq;
#pragma unroll
        for (int ai = 0; ai < 2; ++ai)
#pragma unroll
            for (int m = 0; m < 4; ++m) { bf16_t* rowp = O + (size_t)(row0 + ai * HALF + m * 16) * ldc + col0;
#pragma unroll
                for (int bj = 0; bj < 2; ++bj) { const f32x4 v0 = acc[ai][bj][m][0], v1 = acc[ai][bj][m][1];
                    u32x4 w; w.x = cvt_pk_bf16(v0[0], v0[1]); w.y = cvt_pk_bf16(v0[2], v0[3]); w.z = cvt_pk_bf16(v1[0], v1[1]); w.w = cvt_pk_bf16(v1[2], v1[3]);
                    *(u32x4*)(rowp + bj * HALF) = w; } }
    }
};
struct EpiRes {
    static constexpr bool PERM = false, AFTER_DRAIN = false;
    const float* base; float* out; int ldc;
    __device__ __forceinline__ void operator()(const f32x4 (&acc)[2][2][4][2], const Unit& u, int wr, int wc, int fr, int fq) const {
        const int row0 = u.pm * BM + wr * 64 + fr, col0 = u.pn * BM + wc * 32 + 4 * fq;
#pragma unroll
        for (int ai = 0; ai < 2; ++ai)
#pragma unroll
            for (int m = 0; m < 4; ++m) { const size_t off = (size_t)(row0 + ai * HALF + m * 16) * ldc + col0;
#pragma unroll
                for (int bj = 0; bj < 2; ++bj)
#pragma unroll
                    for (int n = 0; n < 2; ++n) { const size_t p = off + bj * HALF + n * 16; const f32x4 b = *(const f32x4*)(base + p); *(f32x4*)(out + p) = b + acc[ai][bj][m][n]; } }
    }
};
struct EpiSwiGLU {
    static constexpr bool PERM = true, AFTER_DRAIN = false;
    bf16_t* O; int ldc;
    __device__ __forceinline__ void operator()(const f32x4 (&acc)[2][2][4][2], const Unit& u, int wr, int wc, int fr, int fq) const {
        const int row0 = u.pm * BM + wr * 64 + fr, col0 = u.pn * HALF + wc * 32 + 8 * fq;
#pragma unroll
        for (int ai = 0; ai < 2; ++ai)
#pragma unroll
            for (int m = 0; m < 4; ++m) { bf16_t* rowp = O + (size_t)(row0 + ai * HALF + m * 16) * ldc + col0;
                float r[8];
#pragma unroll
                for (int n = 0; n < 2; ++n)
#pragma unroll
                    for (int j = 0; j < 4; ++j) { const float g = acc[ai][0][m][n][j], up = acc[ai][1][m][n][j]; r[4 * n + j] = g * __builtin_amdgcn_rcpf(1.0f + __expf(-g)) * up; }
                u32x4 w; w.x = cvt_pk_bf16(r[0], r[1]); w.y = cvt_pk_bf16(r[2], r[3]); w.z = cvt_pk_bf16(r[4], r[5]); w.w = cvt_pk_bf16(r[6], r[7]);
                *(u32x4*)rowp = w; }
    }
};
template <class Epi, class Sched, bool ALIGN_EPI = false, bool SP2 = false>
__device__ __forceinline__ void gemm_phase(PG8_LAS unsigned char* lds, const Gemm g, const Sched& S, const Epi& E) {
    int tid_ = threadIdx.x; asm volatile("" : "+v"(tid_));
    const int tid = tid_, wid = __builtin_amdgcn_readfirstlane(tid >> 6), lane = tid & 63, wr = wid >> 2, wc = wid & 3, fr = lane & 15, fq = lane >> 4;
    const int K = g.K, nt = K / BK;
    unsigned voffA[2], voffB[2];
#pragma unroll
    for (int i = 0; i < 2; ++i) { int R, C; stage_rc(tid * 16 + i * 8192, R, C); const int Rb = Epi::PERM ? ((R & ~31) + perm32(R & 31)) : R;
        voffA[i] = (unsigned)(R * K + C) * 2u; voffB[i] = (unsigned)(Rb * K + C) * 2u; }
    const size_t kstep = (size_t)(BK * 2);
    const size_t hstep = (size_t)HALF * K * 2;
    const size_t tstep = 2 * hstep;
    const unsigned ldsw = (unsigned)wid * 1024u;
    const int aoff = lds_byte(wr * 64 + fr, fq * 8), boff = lds_byte(wc * 32 + fr, fq * 8);
#define PG8_SA(b, h) (((b) * 2 + (h)) * HTB)
#define PG8_SB(b, h) ((4 + (b) * 2 + (h)) * HTB)
#define PG8_STAGE(bufoff, gbase, voff) do { _Pragma("unroll") for (int _i = 0; _i < 2; ++_i) \
        __builtin_amdgcn_global_load_lds((const unsigned*)((const char*)(gbase) + (voff)[_i]), (PG8_LAS unsigned*)(lds + (bufoff) + ldsw + _i * 8192), 16, 0, 0); } while (0)
#define PG8_LDA(dst, b, h) do { _Pragma("unroll") for (int m = 0; m < 4; ++m) _Pragma("unroll") for (int k = 0; k < 2; ++k) dst[m][k] = *(const PG8_LAS bf16x8*)(lds + PG8_SA(b, h) + aoff + m * 2048 + k * 1024); } while (0)
#define PG8_LDB(dst, b, h) do { _Pragma("unroll") for (int n = 0; n < 2; ++n) _Pragma("unroll") for (int k = 0; k < 2; ++k) dst[n][k] = *(const PG8_LAS bf16x8*)(lds + PG8_SB(b, h) + boff + n * 2048 + k * 1024); } while (0)
#define PG8_MMA(ai, bj, At, Bt) do { __builtin_amdgcn_s_setprio(1); _Pragma("unroll") for (int m = 0; m < 4; ++m) _Pragma("unroll") for (int n = 0; n < 2; ++n) _Pragma("unroll") for (int k = 0; k < 2; ++k) \
        acc[ai][bj][m][n] = __builtin_amdgcn_mfma_f32_16x16x32_bf16(Bt[n][k], At[m][k], acc[ai][bj][m][n], 0, 0, 0); __builtin_amdgcn_s_setprio(0); } while (0)
#define PG8_WAIT_V(n) asm volatile("s_waitcnt vmcnt(" #n ")" ::: "memory")
#define PG8_WAIT_L(n) asm volatile("s_waitcnt lgkmcnt(" #n ")" ::: "memory")
#define PG8_BAR __builtin_amdgcn_s_barrier()
#define PG8_SCHED __builtin_amdgcn_sched_barrier(0)
    Unit cur, nxt; int ui = 0;
    if (!S.next(0, cur)) return;
    f32x4 acc[2][2][4][2];
#pragma unroll
    for (int a = 0; a < 2; ++a)
#pragma unroll
        for (int b = 0; b < 2; ++b)
#pragma unroll
            for (int m = 0; m < 4; ++m)
#pragma unroll
                for (int n = 0; n < 2; ++n) acc[a][b][m][n] = (f32x4){0.f, 0.f, 0.f, 0.f};
    bf16x8 At[4][2], B0[2][2], B1[2][2];
    const char* cA = (const char*)g.A + (size_t)cur.pm * tstep; const char* cB = (const char*)g.Bt + (size_t)cur.pn * tstep;
    S.a_ready(cur);
    if constexpr (SP2) {
        PG8_STAGE(PG8_SB(0, 0), cB, voffB); PG8_STAGE(PG8_SB(0, 1), cB + hstep, voffB); PG8_STAGE(PG8_SA(0, 0), cA, voffA); PG8_STAGE(PG8_SA(0, 1), cA + hstep, voffA);
        if (wr == 1) PG8_BAR;
        PG8_WAIT_V(2); PG8_BAR;
        PG8_STAGE(PG8_SB(1, 0), cB + kstep, voffB); PG8_STAGE(PG8_SA(1, 0), cA + kstep, voffA); PG8_STAGE(PG8_SB(1, 1), cB + hstep + kstep, voffB);
        PG8_WAIT_V(6); PG8_BAR;
    } else {
        PG8_STAGE(PG8_SB(0, 0), cB, voffB); PG8_STAGE(PG8_SA(0, 0), cA, voffA); PG8_STAGE(PG8_SB(0, 1), cB + hstep, voffB); PG8_STAGE(PG8_SA(0, 1), cA + hstep, voffA);
        if (wr == 1) PG8_BAR;
        PG8_WAIT_V(4); PG8_BAR;
        PG8_STAGE(PG8_SB(1, 0), cB + kstep, voffB); PG8_STAGE(PG8_SA(1, 0), cA + kstep, voffA); PG8_STAGE(PG8_SB(1, 1), cB + hstep + kstep, voffB);
        PG8_WAIT_V(6); PG8_BAR;
    }
    for (;;) {
        const bool has_next = S.next(ui + 1, nxt);
        const char* nA = has_next ? (const char*)g.A + (size_t)nxt.pm * tstep : cA; const char* nB = has_next ? (const char*)g.Bt + (size_t)nxt.pn * tstep : cB;
        for (int t = 0; t < nt; t += 2) {
            const bool last = (t == nt - 2);
            const char* a1 = cA + (size_t)(t + 1) * kstep;
            const char* a2 = last ? nA : cA + (size_t)(t + 2) * kstep; const char* b2 = last ? nB : cB + (size_t)(t + 2) * kstep;
            const char* a3 = a2 + kstep; const char* b3 = b2 + kstep;
            if (last && has_next) S.a_ready(nxt);
            if constexpr (SP2) {
            PG8_LDB(B0, 0, 0); PG8_LDB(B1, 0, 1); PG8_SCHED; PG8_LDA(At, 0, 0); PG8_STAGE(PG8_SA(1, 1), a1 + hstep, voffA);
            PG8_WAIT_V(8); PG8_WAIT_L(0); PG8_BAR; PG8_MMA(0, 0, At, B0); PG8_MMA(0, 1, At, B1); PG8_BAR; PG8_SCHED;
            PG8_LDA(At, 0, 1); PG8_STAGE(PG8_SB(0, 0), b2, voffB); PG8_STAGE(PG8_SB(0, 1), b2 + hstep, voffB); PG8_STAGE(PG8_SA(0, 0), a2, voffA);
            PG8_WAIT_V(8); PG8_WAIT_L(0); PG8_BAR; PG8_MMA(1, 0, At, B0); PG8_MMA(1, 1, At, B1); PG8_BAR; PG8_SCHED;
            PG8_LDB(B0, 1, 0); PG8_LDB(B1, 1, 1); PG8_SCHED; PG8_LDA(At, 1, 0); PG8_STAGE(PG8_SA(0, 1), a2 + hstep, voffA);
            PG8_WAIT_V(8); PG8_WAIT_L(0); PG8_BAR; PG8_MMA(0, 0, At, B0); PG8_MMA(0, 1, At, B1); PG8_BAR; PG8_SCHED;
            PG8_LDA(At, 1, 1); PG8_STAGE(PG8_SB(1, 0), b3, voffB); PG8_STAGE(PG8_SB(1, 1), b3 + hstep, voffB); PG8_STAGE(PG8_SA(1, 0), a3, voffA);
            PG8_WAIT_V(8); PG8_WAIT_L(0); PG8_BAR; PG8_MMA(1, 0, At, B0); PG8_MMA(1, 1, At, B1); PG8_BAR; PG8_SCHED;
            } else {
            PG8_LDB(B0, 0, 0); PG8_SCHED; PG8_LDA(At, 0, 0); PG8_STAGE(PG8_SA(1, 1), a1 + hstep, voffA);
            PG8_WAIT_L(8); PG8_BAR; PG8_WAIT_L(0); PG8_MMA(0, 0, At, B0); PG8_BAR; PG8_SCHED;
            PG8_LDB(B1, 0, 1); PG8_STAGE(PG8_SB(0, 0), b2, voffB);
            PG8_BAR; PG8_WAIT_L(0); PG8_MMA(0, 1, At, B1); PG8_BAR;
            PG8_LDA(At, 0, 1); PG8_STAGE(PG8_SA(0, 0), a2, voffA);
            PG8_BAR; PG8_WAIT_L(0); PG8_MMA(1, 0, At, B0); PG8_BAR; PG8_SCHED;
            PG8_STAGE(PG8_SB(0, 1), b2 + hstep, voffB);
            PG8_WAIT_V(6); PG8_BAR; PG8_MMA(1, 1, At, B1); PG8_BAR;
            PG8_LDB(B0, 1, 0); PG8_SCHED; PG8_LDA(At, 1, 0); PG8_STAGE(PG8_SA(0, 1), a2 + hstep, voffA);
            PG8_WAIT_L(8); PG8_BAR; PG8_WAIT_L(0); PG8_MMA(0, 0, At, B0); PG8_BAR; PG8_SCHED;
            PG8_LDB(B1, 1, 1); PG8_STAGE(PG8_SB(1, 0), b3, voffB);
            PG8_BAR; PG8_WAIT_L(0); PG8_MMA(0, 1, At, B1); PG8_BAR;
            PG8_LDA(At, 1, 1); PG8_STAGE(PG8_SA(1, 0), a3, voffA);
            PG8_BAR; PG8_WAIT_L(0); PG8_MMA(1, 0, At, B0); PG8_BAR; PG8_SCHED;
            PG8_STAGE(PG8_SB(1, 1), b3 + hstep, voffB);
            PG8_WAIT_V(6); PG8_BAR; PG8_MMA(1, 1, At, B1); PG8_BAR;
            }
        }
        if constexpr (ALIGN_EPI) { if (wr == 0) PG8_BAR; }
        if constexpr (!Epi::AFTER_DRAIN) { E(acc, cur, wr, wc, fr, fq); S.done(cur); }
        if (!has_next) break;
#pragma unroll
        for (int a = 0; a < 2; ++a)
#pragma unroll
            for (int b = 0; b < 2; ++b)
#pragma unroll
                for (int m = 0; m < 4; ++m)
#pragma unroll
                    for (int n = 0; n < 2; ++n) acc[a][b][m][n] = (f32x4){0.f, 0.f, 0.f, 0.f};
        cur = nxt; cA = nA; cB = nB; ++ui;
        if constexpr (ALIGN_EPI) { if (wr == 1) PG8_BAR; }
    }
    PG8_WAIT_V(0);
    if constexpr (!ALIGN_EPI) { if (wr == 0) PG8_BAR; }
    PG8_BAR;
    if constexpr (Epi::AFTER_DRAIN) { E.fused(acc, cur, wr, wc, fr, fq, lds, wid, lane); S.done(cur); }
#undef PG8_SA
#undef PG8_SB
#undef PG8_STAGE
#undef PG8_LDA
#undef PG8_LDB
#undef PG8_MMA
#undef PG8_WAIT_V
#undef PG8_WAIT_L
#undef PG8_BAR
#undef PG8_SCHED
}
}

constexpr int NB = 4, SEQ = 4096, T = NB * SEQ, DM = 1024, DIN = 2964, DINP = 3072, DFF = 2816, DEPTH = 2;
constexpr int NWAVES = 8, NTHREADS = 512;
constexpr float EPS = 1e-6f;
constexpr int ZAQ = 0, ZKC = 256, ZVC = 320, ZKS = 384, ZVS = 448, ZKW = 512, ZVW = 576, ZBQ = 640, ZBK = 896, ZBV = 1152,
              ZCU = 1408, ZCV = 1664, ZCO = 1920, ZDQ = 2176, ZDK = 2432, ZDV = 2688, ZAG = 2944, ZCI = 2956, ZCF = 2960;
__host__ __device__ __forceinline__ int zsrc(int n) {
    if (n < 640) return n;
    if (n < 1920) return n + 12;
    if (n < 2944) return n + 20;
    if (n < 2956) return n - 2944 + 640;
    if (n < 2960) return n - 2956 + 1932;
    if (n < 2964) return n - 2960 + 1936;
    return -1;
}
constexpr size_t MiB = 1u << 20;
constexpr size_t WS_CTL = 0, CTL_ZERO_BYTES = 1 * MiB;
constexpr size_t WS_WIN = 2 * MiB, WS_WOUT = 8 * MiB, WS_WGU = 10 * MiB, WS_WD = 21 * MiB;
constexpr size_t WS_ROPE64 = 27 * MiB, WS_ROPE32 = 28 * MiB;
constexpr size_t WS_KC = 29 * MiB, WS_VC = WS_KC + 256 * 1024;
constexpr size_t WS_SEL = WS_VC + 256 * 1024;
constexpr size_t WS_BCUM = 30 * MiB, WS_IG = WS_BCUM + 256 * 1024, WS_NLOC = WS_IG + 256 * 1024;
constexpr size_t WS_ACH = WS_NLOC + 256 * 1024, WS_MLOC = WS_ACH + 4096, WS_MIN = WS_MLOC + 4096;
constexpr size_t WS_DLSE = 31 * MiB;
constexpr size_t WS_H = 32 * MiB;
constexpr size_t WS_Z = 64 * MiB;
constexpr size_t WS_AQR = 160 * MiB, WS_OCMP = 168 * MiB, WS_DPART = 176 * MiB;
constexpr size_t WS_MQ = 200 * MiB, WS_MK = 216 * MiB, WS_CLOC = 232 * MiB, WS_END = 248 * MiB;
constexpr int CW_BAR = 4096;
constexpr int CW_Q = 16384;
constexpr int RING_BYTES = 131072, LDSCTL_OFF = RING_BYTES, MISC_OFF = LDSCTL_OFF + 320, LDS_BYTES = 147456;

#define GAS __attribute__((address_space(1)))
#define LAS __attribute__((address_space(3)))
typedef unsigned short bf16;
typedef unsigned v4u __attribute__((ext_vector_type(4)));
typedef unsigned v2u __attribute__((ext_vector_type(2)));
typedef float f32x4 __attribute__((ext_vector_type(4)));
typedef float f32x2 __attribute__((ext_vector_type(2)));
#define LDS_WAIT() asm volatile("s_waitcnt lgkmcnt(0)" ::: "memory")
#define VM_WAIT() asm volatile("s_waitcnt vmcnt(0)" ::: "memory")
__device__ __forceinline__ unsigned f2bf(float f) { unsigned u = __builtin_bit_cast(unsigned, f); return (u + 0x7fffu + ((u >> 16) & 1u)) >> 16; }
__device__ __forceinline__ unsigned pk2(float lo, float hi) { return f2bf(lo) | (f2bf(hi) << 16); }
__device__ __forceinline__ float bf2f(bf16 u) { return __uint_as_float(((unsigned)u) << 16); }
__device__ __forceinline__ float bflo(unsigned w) { return __uint_as_float(w << 16); }
__device__ __forceinline__ float bfhi(unsigned w) { return __uint_as_float(w & 0xffff0000u); }
__device__ __forceinline__ float wave_sum(float v) {
#pragma unroll
    for (int o = 1; o < 64; o <<= 1) v += __shfl_xor(v, o);
    return v;
}
__device__ __forceinline__ float wave_max(float v) {
#pragma unroll
    for (int o = 1; o < 64; o <<= 1) v = fmaxf(v, __shfl_xor(v, o));
    return v;
}
__device__ __forceinline__ float sigmoidf_(float x) { return 1.0f / (1.0f + __expf(-x)); }
#define XB_TMO      128
#define XB_XCNT(j)  (256  + 64 * (j))
#define XB_XSUB(j)  (1280 + 64 * (j))
#define XB_XGEN(j)  (2304 + 64 * (j))
#define XB_TOP      3328
#define XB_TOPGEN   3392
#define XCD_BAR_WORDS 3456
#define XB_SPIN_CAP (1u << 18)

__device__ __forceinline__ unsigned xb_ld(unsigned* p)              { return __hip_atomic_load(p, __ATOMIC_RELAXED, __HIP_MEMORY_SCOPE_AGENT); }
__device__ __forceinline__ unsigned xb_add(unsigned* p, unsigned v) { return __hip_atomic_fetch_add(p, v, __ATOMIC_RELAXED, __HIP_MEMORY_SCOPE_AGENT); }
__device__ __forceinline__ unsigned xb_xcc_id() { return (unsigned)__builtin_amdgcn_s_getreg((3 << 11) | 20) & 0xFu; }
#define XB_SPIN(cond, bar) do { unsigned _sp = 0; while (cond) { __builtin_amdgcn_s_sleep(1); \
    if ((++_sp & 255u) == 0u) { if (xb_ld(&(bar)[XB_TMO])) break; if (_sp > XB_SPIN_CAP) { atomicAdd(&(bar)[XB_TMO], 1u); break; } } } } while (0)

struct XcdBarrier {
    unsigned* bar; unsigned x;
    volatile LAS unsigned* st;
};

__device__ __forceinline__ XcdBarrier xcd_barrier_post(unsigned* bar, volatile LAS unsigned* st) {
    XcdBarrier b; b.bar = bar; b.x = xb_xcc_id(); b.st = st;
    if (threadIdx.x == 0) (void)xb_add(&bar[XB_XCNT(b.x)], 1u);
    return b;
}
__device__ __forceinline__ void xcd_barrier_complete(unsigned* bar, unsigned x, unsigned& nloc, unsigned& nx) {
    const unsigned G = gridDim.x * gridDim.y * gridDim.z;
    unsigned sum, cnt, mine, sp = 0u;
    for (;;) {
        sum = 0u; cnt = 0u; mine = 0u;
#pragma unroll 1
        for (unsigned j = 0; j < 16; ++j) { const unsigned c = xb_ld(&bar[XB_XCNT(j)]); sum += c; cnt += (c > 0u) ? 1u : 0u; mine = (j == x) ? c : mine; }
        if (sum == G) break;
        __builtin_amdgcn_s_sleep(1);
        if ((++sp & 255u) == 0u) { if (xb_ld(&bar[XB_TMO])) break; if (sp > XB_SPIN_CAP) { atomicAdd(&bar[XB_TMO], 1u); break; } }
    }
    nloc = mine > 0u ? mine : 1u; nx = cnt > 0u ? cnt : 1u;
}

__device__ __forceinline__ void xcd_barrier(const XcdBarrier& b) {
    asm volatile("s_waitcnt vmcnt(0)" ::: "memory");
    __syncthreads();
    if (threadIdx.x == 0) {
        unsigned* bar = b.bar;
        __builtin_amdgcn_s_waitcnt(0);
        unsigned nloc = b.st[0], nx = b.st[1];
        if (nloc == 0u) { xcd_barrier_complete(bar, b.x, nloc, nx); b.st[0] = nloc; b.st[1] = nx; }
        const unsigned old = xb_add(&bar[XB_XSUB(b.x)], 1u);
        const unsigned gen = old / nloc;
        if (old + 1u == (gen + 1u) * nloc) {
            __builtin_amdgcn_fence(__ATOMIC_RELEASE, "agent");
            asm volatile("s_waitcnt vmcnt(0)" ::: "memory");
            const unsigned og = xb_add(&bar[XB_TOP], 1u);
            const unsigned tg = og / nx;
            if (og + 1u == (tg + 1u) * nx) xb_add(&bar[XB_TOPGEN], 1u);
            else XB_SPIN(xb_ld(&bar[XB_TOPGEN]) == tg, bar);
            __builtin_amdgcn_fence(__ATOMIC_ACQUIRE, "agent");
            xb_add(&bar[XB_XGEN(b.x)], 1u);
            asm volatile("s_waitcnt vmcnt(0)" ::: "memory");
        } else {
            XB_SPIN(xb_ld(&bar[XB_XGEN(b.x)]) == gen, bar);
            __builtin_amdgcn_fence(__ATOMIC_ACQUIRE, "agent");
            asm volatile("s_waitcnt vmcnt(0)" ::: "memory");
        }
    }
    __syncthreads();
}

struct Args { const float* in[19]; float* out; unsigned char* ws; float inv64[32]; float inv32[16]; };
struct Frame {
    unsigned char* lds;
    LAS unsigned char* lds3;
    volatile LAS unsigned* MISC;
    unsigned* ctl;
    unsigned char* ws;
    int tid, lane, wave, G, gw, ngw;
};
#define PHASE_IDS(F) do { int t_ = threadIdx.x; asm volatile("" : "+v"(t_)); (F).tid = t_; (F).lane = t_ & 63; (F).wave = __builtin_amdgcn_readfirstlane(t_ >> 6); (F).gw = blockIdx.x * NWAVES + (F).wave; } while (0)


__device__ __forceinline__ void transpose_item(const float* W, int K, int N, int srccol  , bf16* WT, int n0, int k0, float* scr, int lane) {
#pragma unroll 8
    for (int i = 0; i < 32; ++i) { const int kk = 2 * i + (lane >> 5); scr[kk * 33 + (lane & 31)] = srccol >= 0 ? W[(size_t)(k0 + kk) * N + srccol] : 0.f; }
    LDS_WAIT(); asm volatile("" ::: "memory");
    const int c = lane & 7;
#pragma unroll
    for (int j = 0; j < 4; ++j) { const int n = (lane >> 3) + 8 * j; const float* s = scr + (8 * c) * 33 + n;
        v4u o; o.x = pk2(s[0 * 33], s[1 * 33]); o.y = pk2(s[2 * 33], s[3 * 33]); o.z = pk2(s[4 * 33], s[5 * 33]); o.w = pk2(s[6 * 33], s[7 * 33]);
        *(v4u*)(WT + (size_t)(n0 + n) * K + k0 + 8 * c) = o; }
    LDS_WAIT(); asm volatile("" ::: "memory");
}
__device__ __forceinline__ void convert_weights(Frame& F, const Args& a, int layer) {
    PHASE_IDS(F);
    float* scr = (float*)(F.lds + F.wave * 16384);
    const float* w_in = a.in[2] + (size_t)layer * DM * DIN; const float* w_out = a.in[13] + (size_t)layer * DM * DM;
    const float* w_gate = a.in[15] + (size_t)layer * DM * DFF; const float* w_up = a.in[16] + (size_t)layer * DM * DFF; const float* w_down = a.in[17] + (size_t)layer * DFF * DM;
    bf16* WIN = (bf16*)(F.ws + WS_WIN); bf16* WOUT = (bf16*)(F.ws + WS_WOUT); bf16* WGU = (bf16*)(F.ws + WS_WGU); bf16* WD = (bf16*)(F.ws + WS_WD);
    constexpr int I_IN = (DM / 64) * (DINP / 32), I_OUT = (DM / 64) * (DM / 32), I_GU = (DM / 64) * (2 * DFF / 32), I_D = (DFF / 64) * (DM / 32);
    constexpr int NITEMS = I_IN + I_OUT + I_GU + I_D;
    for (int it = F.gw; it < NITEMS; it += F.ngw) {
        int r = it; const int l31 = F.lane & 31;
        if (r < I_IN) { const int nblk = DINP / 32, kb = r / nblk, nb = r % nblk; transpose_item(w_in, DM, DIN, zsrc(nb * 32 + l31), WIN, nb * 32, kb * 64, scr, F.lane); continue; } r -= I_IN;
        if (r < I_OUT) { const int nblk = DM / 32, kb = r / nblk, nb = r % nblk; transpose_item(w_out, DM, DM, nb * 32 + l31, WOUT, nb * 32, kb * 64, scr, F.lane); continue; } r -= I_OUT;
        if (r < I_GU) { const int nblk = 2 * DFF / 32, kb = r / nblk, nb = r % nblk, n0 = nb * 32, pn = n0 >> 8, w = n0 & 255;
            transpose_item(w < 128 ? w_gate : w_up, DM, DFF, 128 * pn + (w & 127) + l31, WGU, n0, kb * 64, scr, F.lane); continue; } r -= I_GU;
        { const int nblk = DM / 32, kb = r / nblk, nb = r % nblk; transpose_item(w_down, DFF, DM, nb * 32 + l31, WD, nb * 32, kb * 64, scr, F.lane); }
    }
}
__device__ __forceinline__ void sincos_d(float ang, float& c, float& s) {
    const double a = (double)ang; const double q = __builtin_rint(a * 0.63661977236758134308); const double r = a - q * 1.57079632679489661923; const double r2 = r * r;
    double sp = -1.0 / 39916800.0; sp = sp * r2 + 1.0 / 362880.0; sp = sp * r2 - 1.0 / 5040.0; sp = sp * r2 + 1.0 / 120.0; sp = sp * r2 - 1.0 / 6.0; sp = sp * r2 + 1.0; sp *= r;
    double cp = 1.0 / 479001600.0; cp = cp * r2 - 1.0 / 3628800.0; cp = cp * r2 + 1.0 / 40320.0; cp = cp * r2 - 1.0 / 720.0; cp = cp * r2 + 1.0 / 24.0; cp = cp * r2 - 0.5; cp = cp * r2 + 1.0;
    const int n = ((int)q) & 3; const double cc = (n == 0) ? cp : (n == 1) ? -sp : (n == 2) ? -cp : sp; const double ss = (n == 0) ? sp : (n == 1) ? cp : (n == 2) ? -sp : -cp;
    c = (float)cc; s = (float)ss;
}
__device__ __forceinline__ void build_rope(Frame& F, const Args& a) {
    PHASE_IDS(F);
    f32x2* R64 = (f32x2*)(F.ws + WS_ROPE64); f32x2* R32 = (f32x2*)(F.ws + WS_ROPE32);
    const int gt = F.gw * 64 + F.lane, ngt = F.ngw * 64;
    for (int i = gt; i < SEQ * 48; i += ngt) { const int pos = i / 48, j = i % 48; float c, s;
        if (j < 32) { sincos_d((float)pos * a.inv64[j], c, s); R64[pos * 32 + j] = (f32x2){c, s}; }
        else { sincos_d((float)pos * a.inv32[j - 32], c, s); R32[pos * 16 + (j - 32)] = (f32x2){c, s}; } }
}
__device__ __forceinline__ void norm_rows_bf16(Frame& F, const float* X, const float* g, bf16* H) {
    PHASE_IDS(F);
    for (int row = F.gw; row < T; row += F.ngw) {
        const f32x4* xr = (const f32x4*)(X + (size_t)row * DM) + F.lane; f32x4 v[4]; float ss = 0.f;
#pragma unroll
        for (int j = 0; j < 4; ++j) { v[j] = xr[64 * j]; ss += (v[j].x * v[j].x + v[j].y * v[j].y) + (v[j].z * v[j].z + v[j].w * v[j].w); }
        const float r = 1.0f / sqrtf(wave_sum(ss) * (1.0f / DM) + EPS);
        v2u* o = (v2u*)(H + (size_t)row * DM) + F.lane;
#pragma unroll
        for (int j = 0; j < 4; ++j) { const f32x4 gg = ((const f32x4*)g)[64 * j + F.lane]; v2u w; w.x = pk2(v[j].x * r * gg.x, v[j].y * r * gg.y); w.y = pk2(v[j].z * r * gg.z, v[j].w * r * gg.w); o[64 * j] = w; }
    }
}
__device__ __forceinline__ void norm_rows_f32_inplace(Frame& F, float* X, const float* g) {
    PHASE_IDS(F);
    for (int row = F.gw; row < T; row += F.ngw) {
        f32x4* xr = (f32x4*)(X + (size_t)row * DM) + F.lane; f32x4 v[4]; float ss = 0.f;
#pragma unroll
        for (int j = 0; j < 4; ++j) { v[j] = xr[64 * j]; ss += (v[j].x * v[j].x + v[j].y * v[j].y) + (v[j].z * v[j].z + v[j].w * v[j].w); }
        const float r = 1.0f / sqrtf(wave_sum(ss) * (1.0f / DM) + EPS);
#pragma unroll
        for (int j = 0; j < 4; ++j) { const f32x4 gg = ((const f32x4*)g)[64 * j + F.lane]; xr[64 * j] = v[j] * r * gg; }
    }
}

__device__ __forceinline__ void prep_rope(Frame& F) {
    PHASE_IDS(F);
    bf16* Z = (bf16*)(F.ws + WS_Z); bf16* AQR = (bf16*)(F.ws + WS_AQR);
    const f32x2* R64 = (const f32x2*)(F.ws + WS_ROPE64); const f32x2* R32 = (const f32x2*)(F.ws + WS_ROPE32);
    for (int row = F.gw; row < T; row += F.ngw) {
        const int pos = row & (SEQ - 1); bf16* zr = Z + (size_t)row * DINP; bf16* qr = AQR + (size_t)row * 256;
#pragma unroll 1
        for (int it = 0; it < 11; ++it) {
            const int u = 2 * it + (F.lane >> 5), p = F.lane & 31;
            int base; bool d32 = false; bf16* dst = zr;
            if (u < 4) { base = ZAQ + 64 * u; dst = qr - ZAQ; }
            else if (u == 4) base = ZKS; else if (u == 5) base = ZKW;
            else if (u < 10) { base = ZBQ + 64 * (u - 6); d32 = true; } else if (u < 14) { base = ZBK + 64 * (u - 10); d32 = true; }
            else if (u < 18) base = ZDQ + 64 * (u - 14); else base = ZDK + 64 * (u - 18);
            int c1, c2; f32x2 cs;
            if (d32) { const int comp = p >> 4, i = p & 15; c1 = base + 32 * comp + i; c2 = c1 + 16; cs = R32[pos * 16 + i]; }
            else { c1 = base + p; c2 = c1 + 32; cs = R64[pos * 32 + p]; }
            const float x1 = bf2f(zr[c1]), x2 = bf2f(zr[c2]);
            dst[c1] = (bf16)f2bf(x1 * cs.x - x2 * cs.y); dst[c2] = (bf16)f2bf(x1 * cs.y + x2 * cs.x);
        }
    }
}
__device__ __forceinline__ void prep_compress(Frame& F, const Args& a, int layer) {
    PHASE_IDS(F);
    const bf16* Z = (const bf16*)(F.ws + WS_Z);
    for (int it = F.gw; it < NB * 2 * 64; it += F.ngw) {
        const int b = it >> 7, br = (it >> 6) & 1, n0 = (it & 63) * 4;
        const float* pos = a.in[3] + ((size_t)layer * 2 + br) * 2048; const float* w = a.in[4] + ((size_t)layer * 2 + br) * 2048 * 64;
        const int zc = br ? ZVC : ZKC; float acc[4] = {0.f, 0.f, 0.f, 0.f};
        for (int l = 0; l < 32; ++l) {
#pragma unroll 4
            for (int d = 0; d < 64; ++d) { const float wv = w[(size_t)(l * 64 + d) * 64 + F.lane], pv = pos[l * 64 + d];
#pragma unroll
                for (int i = 0; i < 4; ++i) { int tok = 16 * (n0 + i) + l; tok = tok < SEQ ? tok : SEQ - 1; acc[i] += (bf2f(Z[(size_t)(b * SEQ + tok) * DINP + zc + d]) + pv) * wv; } }
        }
        bf16* O = (bf16*)(F.ws + (br ? WS_VC : WS_KC)) + (size_t)b * 256 * 64;
#pragma unroll
        for (int i = 0; i < 4; ++i) O[(n0 + i) * 64 + F.lane] = (bf16)((n0 + i < 255) ? f2bf(acc[i]) : 0u);
    }
}
__device__ __forceinline__ float log_sigmoid_(float x) { return x >= 0.f ? -log1pf(__expf(-x)) : x - log1pf(__expf(x)); }
__device__ __forceinline__ void prep_mlstm(Frame& F, const Args& a, int layer) {
    PHASE_IDS(F);
    const bf16* Z = (const bf16*)(F.ws + WS_Z);
    float* L = (float*)F.lds; float* UC = L; float* QS = L + 4224; float* KS = L + 8448; float* VS = L + 12672; float* WQ = L + 16896; float* WK = L + 21120; float* WE = L + 25344;
    const float* convw = a.in[7] + (size_t)layer * 4 * 256; const float* convb = a.in[8] + (size_t)layer * 256;
    const float* gb = a.in[11] + (size_t)layer * 8;
    float* MQ = (float*)(F.ws + WS_MQ); float* MK = (float*)(F.ws + WS_MK); float* CLOC = (float*)(F.ws + WS_CLOC); float* NLOC = (float*)(F.ws + WS_NLOC);
    float* BCUM = (float*)(F.ws + WS_BCUM); float* IG = (float*)(F.ws + WS_IG); float* ACH = (float*)(F.ws + WS_ACH); float* MLOC = (float*)(F.ws + WS_MLOC);
    for (int it = blockIdx.x; it < 1024; it += F.G) {
        const int bh = it >> 6, c = it & 63, b = bh >> 2, h = bh & 3, t0 = c * 64; const size_t row0 = (size_t)b * SEQ + t0;
        const float* wq = a.in[9] + ((size_t)layer * 4 + h) * 4096; const float* wk = a.in[10] + ((size_t)layer * 4 + h) * 4096;
        __syncthreads();
        for (int i = F.tid; i < 4096; i += NTHREADS) { const int l = i >> 6, d = i & 63, ch = h * 64 + d; float s = convb[ch];
#pragma unroll
            for (int j = 0; j < 4; ++j) { const int t = t0 + l - 3 + j; if (t >= 0) s += convw[j * 256 + ch] * bf2f(Z[((size_t)b * SEQ + t) * DINP + ZCU + ch]); }
            UC[l * 65 + d] = s * sigmoidf_(s); VS[i] = bf2f(Z[(row0 + l) * DINP + ZCV + ch]); WQ[i] = wq[i]; WK[i] = wk[i]; }
        if (F.wave == 0) { const int l = F.lane; const size_t row = row0 + l;
            const float ig = bf2f(Z[row * DINP + ZCI + h]) + gb[h]; float bc = log_sigmoid_(bf2f(Z[row * DINP + ZCF + h]) + gb[4 + h]);
#pragma unroll
            for (int o = 1; o < 64; o <<= 1) { const float v = __shfl_up(bc, o); if (l >= o) bc += v; }
            const float ach = __shfl(bc, 63); const float ge = ach - bc + ig; const float ml = wave_max(ge);
            WE[l] = __expf(ge - ml); BCUM[row * 4 + h] = bc; IG[row * 4 + h] = ig; if (l == 0) { ACH[it] = ach; MLOC[it] = ml; } }
        __syncthreads();
        { const int l = F.tid >> 3, eg = (F.tid & 7) * 8; float qa[8], ka[8];
#pragma unroll
            for (int i = 0; i < 8; ++i) { qa[i] = 0.f; ka[i] = 0.f; }
            for (int d = 0; d < 64; ++d) { const float u = UC[l * 65 + d];
#pragma unroll
                for (int i = 0; i < 8; ++i) { qa[i] += u * WQ[d * 64 + eg + i]; ka[i] += u * WK[d * 64 + eg + i]; } }
#pragma unroll
            for (int i = 0; i < 8; ++i) { ka[i] *= 0.125f; QS[l * 64 + eg + i] = qa[i]; KS[l * 64 + eg + i] = ka[i];
                MQ[(row0 + l) * 256 + h * 64 + eg + i] = qa[i]; MK[(row0 + l) * 256 + h * 64 + eg + i] = ka[i]; } }
        __syncthreads();
        { const int v = F.tid >> 3, kg = (F.tid & 7) * 8; float acc[8];
#pragma unroll
            for (int i = 0; i < 8; ++i) acc[i] = 0.f;
            for (int l = 0; l < 64; ++l) { const float wv = WE[l] * VS[l * 64 + v];
#pragma unroll
                for (int i = 0; i < 8; ++i) acc[i] += wv * KS[l * 64 + kg + i]; }
#pragma unroll
            for (int i = 0; i < 8; ++i) CLOC[(size_t)it * 4096 + v * 64 + kg + i] = acc[i];
            if (F.tid < 64) { float n = 0.f; for (int l = 0; l < 64; ++l) n += WE[l] * KS[l * 64 + F.tid]; NLOC[it * 64 + F.tid] = n; } }
    }
    __syncthreads();
}

__device__ __forceinline__ void ld8(const bf16* p, float* o) { const v4u w = *(const v4u*)p; o[0] = bflo(w.x); o[1] = bfhi(w.x); o[2] = bflo(w.y); o[3] = bfhi(w.y); o[4] = bflo(w.z); o[5] = bfhi(w.z); o[6] = bflo(w.w); o[7] = bfhi(w.w); }
template <int DK> __device__ __forceinline__ void load_q(const bf16* p, float (&q)[64]) {
#pragma unroll
    for (int g = 0; g < DK / 8; ++g) ld8(p + 8 * g, &q[8 * g]);
}
template <int DK> __device__ __forceinline__ float dot_qk(const float (&q)[64], const bf16* kp) {
    float s = 0.f;
#pragma unroll
    for (int g = 0; g < DK / 8; ++g) { float k[8]; ld8(kp + 8 * g, k);
#pragma unroll
        for (int i = 0; i < 8; ++i) s += q[8 * g + i] * k[i]; }
    return s;
}
__device__ __forceinline__ void attn_upd(float s, const bf16* vp, float& m, float& l, float (&o)[64]) {
    const float mn = fmaxf(m, s), c = __expf(m - mn), p = __expf(s - mn);
    l = l * c + p;
#pragma unroll
    for (int g = 0; g < 8; ++g) { float v[8]; ld8(vp + 8 * g, v);
#pragma unroll
        for (int i = 0; i < 8; ++i) o[8 * g + i] = o[8 * g + i] * c + p * v[i]; }
    m = mn;
}
__device__ __forceinline__ float reduce_scatter64(float (&o)[64], int lane) {
#pragma unroll
    for (int i = 0; i < 32; ++i) { const bool hi = lane & 32; const float send = hi ? o[i] : o[i + 32], keep = hi ? o[i + 32] : o[i]; o[i] = keep + __shfl_xor(send, 32); }
#pragma unroll
    for (int i = 0; i < 16; ++i) { const bool hi = lane & 16; const float send = hi ? o[i] : o[i + 16], keep = hi ? o[i + 16] : o[i]; o[i] = keep + __shfl_xor(send, 16); }
#pragma unroll
    for (int i = 0; i < 8; ++i) { const bool hi = lane & 8; const float send = hi ? o[i] : o[i + 8], keep = hi ? o[i + 8] : o[i]; o[i] = keep + __shfl_xor(send, 8); }
#pragma unroll
    for (int i = 0; i < 4; ++i) { const bool hi = lane & 4; const float send = hi ? o[i] : o[i + 4], keep = hi ? o[i + 4] : o[i]; o[i] = keep + __shfl_xor(send, 4); }
#pragma unroll
    for (int i = 0; i < 2; ++i) { const bool hi = lane & 2; const float send = hi ? o[i] : o[i + 2], keep = hi ? o[i + 2] : o[i]; o[i] = keep + __shfl_xor(send, 2); }
    { const bool hi = lane & 1; const float send = hi ? o[0] : o[1], keep = hi ? o[1] : o[0]; o[0] = keep + __shfl_xor(send, 1); }
    return o[0];
}
__device__ __forceinline__ float attn_fin(float m, float l, float (&o)[64], int lane) {
    const float M = wave_max(m); const float c = (m == -INFINITY) ? 0.f : __expf(m - M);
    const float L = wave_sum(l * c);
#pragma unroll
    for (int d = 0; d < 64; ++d) o[d] *= c;
    const float v = reduce_scatter64(o, lane);
    return L > 0.f ? v / L : 0.f;
}
__device__ __forceinline__ int bal_t(int tt) { return tt < 2048 ? tt : 6143 - tt; }

__device__ __forceinline__ void ph_cmp_topk(Frame& F) {
    PHASE_IDS(F);
    const bf16* Z = (const bf16*)(F.ws + WS_Z); const float* KC = (const float*)(F.ws + WS_KC); const float* VC = (const float*)(F.ws + WS_VC);
    bf16* OCMP = (bf16*)(F.ws + WS_OCMP); unsigned long long* SEL = (unsigned long long*)(F.ws + WS_SEL);
    float* ps = (float*)(F.lds + F.wave * 2048);
    for (int idx = F.gw; idx < T; idx += F.ngw) {
        const int b = idx >> 12, t = bal_t(idx & 4095), row = b * SEQ + t, lane = F.lane;
        const int nvalid = t >= 31 ? ((t - 31) >> 4) + 1 : 0;
        float psum[4] = {0.f, 0.f, 0.f, 0.f};
        const float* kcb = KC + (size_t)b * 256 * 64; const float* vcb = VC + (size_t)b * 256 * 64;
#pragma unroll 1
        for (int h = 0; h < 4; ++h) {
            float q[64]; load_q<64>(Z + (size_t)row * DINP + ZAQ + 64 * h, q);
            float s[4]; float mx = -INFINITY;
#pragma unroll
            for (int k = 0; k < 4; ++k) { const int n = lane + 64 * k; float acc = 0.f;
                if (n < nvalid) { const f32x4* kp = (const f32x4*)(kcb + n * 64);
#pragma unroll
                    for (int g = 0; g < 16; ++g) { const f32x4 kv = kp[g]; acc += q[4 * g] * kv.x + q[4 * g + 1] * kv.y + q[4 * g + 2] * kv.z + q[4 * g + 3] * kv.w; }
                    s[k] = acc * 0.125f; } else s[k] = -INFINITY;
                mx = fmaxf(mx, s[k]); }
            mx = wave_max(mx);
            float e[4], es = 0.f;
#pragma unroll
            for (int k = 0; k < 4; ++k) { e[k] = (lane + 64 * k < nvalid) ? __expf(s[k] - mx) : 0.f; es += e[k]; }
            es = wave_sum(es); const float inv = es > 0.f ? 1.0f / es : 0.f;
            float o[64];
#pragma unroll
            for (int d = 0; d < 64; ++d) o[d] = 0.f;
#pragma unroll
            for (int k = 0; k < 4; ++k) { const float p = e[k] * inv; psum[k] += p; const int n = lane + 64 * k;
                if (n < nvalid) { const f32x4* vp = (const f32x4*)(vcb + n * 64);
#pragma unroll
                    for (int g = 0; g < 16; ++g) { const f32x4 vv = vp[g]; o[4 * g] += p * vv.x; o[4 * g + 1] += p * vv.y; o[4 * g + 2] += p * vv.z; o[4 * g + 3] += p * vv.w; } } }
            const float od = reduce_scatter64(o, lane);
            OCMP[(size_t)row * 256 + 64 * h + lane] = (bf16)f2bf(od);
        }
#pragma unroll
        for (int k = 0; k < 4; ++k) ps[lane + 64 * k] = psum[k];
        LDS_WAIT(); asm volatile("" ::: "memory");
        const int j = lane, cur = t >> 6; float imp = ps[4 * j];
        if (j > 0) imp += 2.f * (ps[4 * j - 1] + ps[4 * j - 2] + ps[4 * j - 3]) + ps[4 * j - 4];
        LDS_WAIT(); asm volatile("" ::: "memory");
        const bool forced = (j == 0) || (j <= cur && j > cur - 2);
        const float sc = (j > cur) ? -1.0e6f : (forced ? 1.0e6f : imp);
        int rank = 0;
#pragma unroll 8
        for (int i = 0; i < 64; ++i) { const float si = __shfl(sc, i); rank += (si > sc || (si == sc && i < j)) ? 1 : 0; }
        const unsigned long long mask = __ballot(rank < 16 && j <= cur);
        if (lane == 0) SEL[row] = mask;
    }
}
__device__ __forceinline__ float diff_comp(const bf16* Z, int b, int h, int t, int comp, size_t row, float scale, int lane) {
    float q[64]; load_q<32>(Z + row * DINP + ZBQ + 64 * h + 32 * comp, q);
    float m = -INFINITY, l = 0.f, o[64];
#pragma unroll
    for (int d = 0; d < 64; ++d) o[d] = 0.f;
    for (int kp = lane; kp <= t; kp += 64) { const bf16* kr = Z + ((size_t)b * SEQ + kp) * DINP;
        const float s = dot_qk<32>(q, kr + ZBK + 64 * h + 32 * comp) * scale; attn_upd(s, kr + ZBV + 64 * h, m, l, o); }
    return attn_fin(m, l, o, lane);
}
__device__ __forceinline__ void ph_diff(Frame& F, const Args& a, int layer) {
    PHASE_IDS(F);
    const bf16* Z = (const bf16*)(F.ws + WS_Z); bf16* AO = (bf16*)(F.ws + WS_H);
    const float* lv = a.in[5] + (size_t)layer * 128; const float* sg = a.in[6] + (size_t)layer * 64;
    const float lam_init = 0.8f - 0.6f * expf(-0.3f * (float)layer);
    float l01 = 0.f, l23 = 0.f; if (F.lane < 32) { l01 = lv[F.lane] * lv[32 + F.lane]; l23 = lv[64 + F.lane] * lv[96 + F.lane]; }
    const float lam = expf(wave_sum(l01)) - expf(wave_sum(l23)) + lam_init;
    const float scale = 0.17677669529663687f;
    for (int idx = F.gw; idx < T * 4; idx += F.ngw) {
        const int bh = idx >> 12, b = bh >> 2, h = bh & 3, t = bal_t(idx & 4095), lane = F.lane; const size_t row = (size_t)b * SEQ + t;
        const float val0 = diff_comp(Z, b, h, t, 0, row, scale, lane), val1 = diff_comp(Z, b, h, t, 1, row, scale, lane);
        const float hd = val0 - lam * val1; const float ss = wave_sum(hd * hd);
        const float y = hd * (1.0f / sqrtf(ss * (1.0f / 64.0f) + EPS)) * sg[lane] * (1.0f - lam_init);
        AO[row * DM + 256 + 64 * h + lane] = (bf16)f2bf(y);
    }
}
__device__ __forceinline__ void ph_dilated(Frame& F) {
    PHASE_IDS(F);
    const bf16* Z = (const bf16*)(F.ws + WS_Z); bf16* AO = (bf16*)(F.ws + WS_H);
    for (int idx = F.gw; idx < T * 4; idx += F.ngw) {
        const int bh = idx >> 12, b = bh >> 2, h = bh & 3, t = idx & 4095, lane = F.lane; const size_t row = (size_t)b * SEQ + t;
        float q[64]; load_q<64>(Z + row * DINP + ZDQ + 64 * h, q);
        float m = -INFINITY, l = 0.f, o[64];
#pragma unroll
        for (int d = 0; d < 64; ++d) o[d] = 0.f;
#pragma unroll 1
        for (int k = 0; k < 7; ++k) { const int i = lane + 64 * k; const int g = i / 129, j = i - g * 129; const int dil = (g == 0) ? 1 : (g == 1) ? 4 : 16; const int kp = t - j * dil;
            if (i < 387 && kp >= 0) { const bf16* kr = Z + ((size_t)b * SEQ + kp) * DINP; const float s = dot_qk<64>(q, kr + ZDK + 64 * h) * 0.125f; attn_upd(s, kr + ZDV + 64 * h, m, l, o); } }
        const float v = attn_fin(m, l, o, lane);
        AO[row * DM + 768 + 64 * h + lane] = (bf16)f2bf(v);
    }
}
__device__ __forceinline__ void ph_mlstm_scan(Frame& F) {
    PHASE_IDS(F);
    float* CLOC = (float*)(F.ws + WS_CLOC); float* NLOC = (float*)(F.ws + WS_NLOC);
    const float* ACH = (const float*)(F.ws + WS_ACH); const float* MLOC = (const float*)(F.ws + WS_MLOC); float* MIN = (float*)(F.ws + WS_MIN);
    for (int it = blockIdx.x; it < 64; it += F.G) {
        const int bh = it >> 2, qt = it & 3; const int e0 = qt * 1024 + F.tid * 2;
        float c0 = 0.f, c1 = 0.f, nst = 0.f, mst = 0.f;
        for (int c = 0; c < 64; ++c) {
            const int ci = bh * 64 + c; const float ac = ACH[ci], ml = MLOC[ci];
            float* cp = CLOC + (size_t)ci * 4096 + e0; const f32x2 cl = *(const f32x2*)cp;
            const float mn = fmaxf(ac + mst, ml), decay = __expf(ac + mst - mn), fresh = __expf(ml - mn);
            *(f32x2*)cp = (f32x2){c0, c1}; c0 = decay * c0 + fresh * cl.x; c1 = decay * c1 + fresh * cl.y;
            if (qt == 0 && F.tid < 64) { const float nl = NLOC[ci * 64 + F.tid]; NLOC[ci * 64 + F.tid] = nst; nst = decay * nst + fresh * nl; if (F.tid == 0) MIN[ci] = mst; }
            mst = mn;
        }
    }
}

__device__ __forceinline__ void ph_nsa_sw(Frame& F) {
    PHASE_IDS(F);
    const bf16* Z = (const bf16*)(F.ws + WS_Z); const bf16* AQR = (const bf16*)(F.ws + WS_AQR); const bf16* OCMP = (const bf16*)(F.ws + WS_OCMP);
    const unsigned long long* SEL = (const unsigned long long*)(F.ws + WS_SEL); bf16* AO = (bf16*)(F.ws + WS_H);
    for (int idx = F.gw; idx < T * 4; idx += F.ngw) {
        const int bh = idx >> 12, b = bh >> 2, h = bh & 3, t = bal_t(idx & 4095), lane = F.lane; const size_t row = (size_t)b * SEQ + t;
        float q[64]; load_q<64>(AQR + row * 256 + 64 * h, q);
        const unsigned long long mk = SEL[row]; unsigned mlo = __builtin_amdgcn_readfirstlane((unsigned)mk), mhi = __builtin_amdgcn_readfirstlane((unsigned)(mk >> 32));
        float m = -INFINITY, l = 0.f, o[64];
#pragma unroll
        for (int d = 0; d < 64; ++d) o[d] = 0.f;
#pragma unroll 1
        for (int j = 0; j < 64; ++j) { const unsigned bit = (j < 32) ? (mlo >> j) & 1u : (mhi >> (j - 32)) & 1u; if (!bit) continue;
            const int kp = 64 * j + lane; if (kp <= t) { const bf16* kr = Z + ((size_t)b * SEQ + kp) * DINP; const float s = dot_qk<64>(q, kr + ZKS) * 0.125f; attn_upd(s, kr + ZVS, m, l, o); } }
        const float oslc = attn_fin(m, l, o, lane);
        m = -INFINITY; l = 0.f;
#pragma unroll
        for (int d = 0; d < 64; ++d) o[d] = 0.f;
#pragma unroll 1
        for (int k = 0; k < 8; ++k) { const int kp = t - 511 + lane + 64 * k;
            if (kp >= 0) { const bf16* kr = Z + ((size_t)b * SEQ + kp) * DINP; const float s = dot_qk<64>(q, kr + ZKW) * 0.125f; attn_upd(s, kr + ZVW, m, l, o); } }
        const float owin = attn_fin(m, l, o, lane);
        const bf16* zr = Z + row * DINP + ZAG; const float g0 = sigmoidf_(bf2f(zr[h])), g1 = sigmoidf_(bf2f(zr[4 + h])), g2 = sigmoidf_(bf2f(zr[8 + h]));
        const float out = g0 * bf2f(OCMP[row * 256 + 64 * h + lane]) + g1 * oslc + g2 * owin;
        AO[row * DM + 64 * h + lane] = (bf16)f2bf(out);
    }
}
__device__ __forceinline__ void ph_mlstm_out(Frame& F, const Args& a, int layer) {
    PHASE_IDS(F);
    const bf16* Z = (const bf16*)(F.ws + WS_Z); bf16* AO = (bf16*)(F.ws + WS_H);
    const float* MQ = (const float*)(F.ws + WS_MQ); const float* MK = (const float*)(F.ws + WS_MK); const float* CIN = (const float*)(F.ws + WS_CLOC); const float* NIN = (const float*)(F.ws + WS_NLOC);
    const float* BCUM = (const float*)(F.ws + WS_BCUM); const float* IG = (const float*)(F.ws + WS_IG); const float* MIN = (const float*)(F.ws + WS_MIN);
    const float* hg = a.in[12] + (size_t)layer * 256;
    float* L = (float*)F.lds; float* QS = L; float* KS = L + 4224; float* VS = L + 8448; float* CS = L + 12672; float* SS = L + 16896;
    float* NI = L + 21120; float* BC = NI + 64; float* IGS = BC + 64; float* MT = IGS + 64; float* EI = MT + 64;
    for (int it = blockIdx.x; it < 1024; it += F.G) {
        const int bh = it >> 6, c = it & 63, b = bh >> 2, h = bh & 3; const size_t row0 = (size_t)b * SEQ + c * 64;
        __syncthreads();
        for (int i = F.tid; i < 4096; i += NTHREADS) { const int l = i >> 6, d = i & 63; const size_t g = (row0 + l) * 256 + h * 64 + d;
            QS[l * 65 + d] = MQ[g]; KS[l * 65 + d] = MK[g]; VS[l * 65 + d] = bf2f(Z[(row0 + l) * DINP + ZCV + h * 64 + d]); CS[l * 65 + d] = CIN[(size_t)it * 4096 + i]; }
        if (F.wave == 0) { const int l = F.lane; const float bc = BCUM[(row0 + l) * 4 + h], ig = IG[(row0 + l) * 4 + h], mi = MIN[it];
            NI[l] = NIN[it * 64 + l]; BC[l] = bc; IGS[l] = ig;
            float pm = ig - bc;
#pragma unroll
            for (int o = 1; o < 64; o <<= 1) { const float v = __shfl_up(pm, o); if (l >= o) pm = fmaxf(pm, v); }
            const float inter = bc + mi, mt = fmaxf(inter, bc + pm); MT[l] = mt; EI[l] = __expf(inter - mt); }
        __syncthreads();
        { const int t = F.tid >> 3, sg = (F.tid & 7) * 8; const float bt = BC[t], mt = MT[t];
#pragma unroll 1
            for (int i = 0; i < 8; ++i) { const int s = sg + i; float v = 0.f;
                if (s <= t) { float dp = 0.f;
#pragma unroll 16
                    for (int d = 0; d < 64; ++d) dp += QS[t * 65 + d] * KS[s * 65 + d];
                    v = dp * __expf(bt - BC[s] + IGS[s] - mt); }
                SS[t * 65 + s] = v; } }
        __syncthreads();
        { const int t = F.tid >> 3, vg = (F.tid & 7) * 8; float num[8]; const float ei = EI[t];
#pragma unroll
            for (int i = 0; i < 8; ++i) num[i] = 0.f;
            float nq = 0.f, ssum = 0.f;
            for (int k = 0; k < 64; ++k) { const float qv = QS[t * 65 + k]; nq += NI[k] * qv;
#pragma unroll
                for (int i = 0; i < 8; ++i) num[i] += CS[(vg + i) * 65 + k] * qv; }
#pragma unroll
            for (int i = 0; i < 8; ++i) num[i] *= ei;
            for (int s = 0; s < 64; ++s) { const float sv = SS[t * 65 + s]; ssum += sv;
#pragma unroll
                for (int i = 0; i < 8; ++i) num[i] += sv * VS[s * 65 + vg + i]; }
            const float den = ei * nq + ssum; const float dn = fmaxf(fabsf(den), __expf(-MT[t])); const float rd = 1.0f / dn;
            float sq = 0.f;
#pragma unroll
            for (int i = 0; i < 8; ++i) { num[i] *= rd; sq += num[i] * num[i]; }
            sq += __shfl_xor(sq, 1); sq += __shfl_xor(sq, 2); sq += __shfl_xor(sq, 4);
            const float rn = 1.0f / sqrtf(sq * (1.0f / 64.0f) + EPS); const size_t row = row0 + t;
            unsigned w[4];
#pragma unroll
            for (int i = 0; i < 8; i += 2) { const int ch = h * 64 + vg + i;
                const float y0 = num[i] * rn * hg[ch] * sigmoidf_(bf2f(Z[row * DINP + ZCO + ch])), y1 = num[i + 1] * rn * hg[ch + 1] * sigmoidf_(bf2f(Z[row * DINP + ZCO + ch + 1]));
                w[i >> 1] = pk2(y0, y1); }
            *(v4u*)(AO + row * DM + 512 + h * 64 + vg) = (v4u){w[0], w[1], w[2], w[3]}; }
    }
    __syncthreads();
}

namespace fa {
typedef short bf16x8 __attribute__((ext_vector_type(8)));
typedef float f32x16 __attribute__((ext_vector_type(16)));
typedef short s16x4 __attribute__((ext_vector_type(4)));
typedef __bf16 bf16x2_t __attribute__((ext_vector_type(2)));
constexpr int KP = 144, VP = 192, KT = 64 * KP, VT = 64 * VP, BUF = KT + VT, LDS_NEED = 2 * BUF;
constexpr float LOG2E = 1.4426950408889634f, LN2 = 0.6931471805599453f;
__device__ __forceinline__ int crow(int r, int hi) { return (r & 3) + 8 * (r >> 2) + 4 * hi; }
__device__ __forceinline__ unsigned cvtpk(float lo, float hi) { f32x2 v = {lo, hi}; bf16x2_t b = __builtin_convertvector(v, bf16x2_t); return __builtin_bit_cast(unsigned, b); }
__device__ __forceinline__ s16x4 vtr(LAS unsigned char* p) { return __builtin_bit_cast(s16x4, __builtin_amdgcn_ds_read_tr16_b64_v4i16((LAS s16x4*)p)); }
__device__ __forceinline__ void load_qf(const bf16* qrow, int hi, bf16x8 (&qf)[4]) {
#pragma unroll
    for (int ks = 0; ks < 4; ++ks) qf[ks] = *(const bf16x8*)(qrow + 16 * ks + 8 * hi);
}
template <int KS0, int KS, class P, int MODE = 0>
__device__ __forceinline__ void stream(const P& p, LAS unsigned char* lds, int tid, float sc, const bf16x8 (&qf)[4], float& m_, float& l_, f32x16 (&O_)[2]) {
    constexpr int NCOMP = 1; float m[1] = {m_}, l[1] = {l_}; f32x16 O[1][2] = {{O_[0], O_[1]}};
    const int lane = tid & 63, r32 = lane & 31, hi = lane >> 5, g = lane >> 4, i16 = lane & 15;
    const int srow = tid >> 3, scx = tid & 7;
    const int koff = r32 * KP + hi * 16;
    const int voff = KT + ((i16 >> 2) + 4 * hi) * VP + (16 * (g & 1) + 4 * (i16 & 3)) * 2;
    const int nt = p.ntiles();
    v4u kr = {0u, 0u, 0u, 0u}, vr = {0u, 0u, 0u, 0u};
#define FA_LOAD(it_) do { const bf16* kp_ = p.krow((it_), srow); const bf16* vp_ = p.vrow((it_), srow); \
        kr = kp_ ? *(const v4u*)(kp_ + 8 * scx) : (v4u){0u, 0u, 0u, 0u}; vr = vp_ ? *(const v4u*)(vp_ + 8 * scx) : (v4u){0u, 0u, 0u, 0u}; } while (0)
#define FA_STORE(b_) do { *(LAS v4u*)(lds + (b_) * BUF + srow * KP + scx * 16) = kr; *(LAS v4u*)(lds + (b_) * BUF + KT + srow * VP + scx * 16) = vr; } while (0)
    __syncthreads();
    if (nt > 0) { FA_LOAD(0); FA_STORE(0); if (nt > 1) FA_LOAD(1); }
    __syncthreads();
#pragma unroll 1
    for (int it = 0; it < nt; ++it) {
        LAS unsigned char* B = lds + (it & 1) * BUF;
        if (!p.wave_skip(it)) {
            const bool msk = p.need_mask(it);
#pragma unroll
            for (int c = 0; c < NCOMP; ++c) {
                f32x16 S[2];
#pragma unroll
                for (int st = 0; st < 2; ++st) {
#pragma unroll
                    for (int r = 0; r < 16; ++r) S[st][r] = 0.f;
#pragma unroll
                    for (int ks = KS0; ks < KS0 + KS; ++ks) { const bf16x8 kf = *(LAS bf16x8*)(B + koff + st * 32 * KP + ks * 32); S[st] = __builtin_amdgcn_mfma_f32_32x32x16_bf16(kf, qf[ks], S[st], 0, 0, 0); }
                }
                if (msk) {
                    int lb, ub; p.bounds(it, lb, ub); lb -= 4 * hi; ub -= 4 * hi;
#pragma unroll
                    for (int st = 0; st < 2; ++st)
#pragma unroll
                        for (int r = 0; r < 16; ++r) { const int cc = 32 * st + (r & 3) + 8 * (r >> 2); if (cc < lb || cc > ub) S[st][r] = -INFINITY; }
                }
                if constexpr (MODE == 1) {
                    const float ms = (m[c] == -INFINITY) ? 0.f : m[c]; const float il = l[c] > 0.f ? 1.0f / l[c] : 0.f;
#pragma unroll
                    for (int st = 0; st < 2; ++st)
#pragma unroll
                        for (int rg = 0; rg < 4; ++rg) {
                            const float p0 = __builtin_amdgcn_exp2f(__builtin_fmaf(S[st][4 * rg], sc, -ms)) * il, p1 = __builtin_amdgcn_exp2f(__builtin_fmaf(S[st][4 * rg + 1], sc, -ms)) * il;
                            const float p2 = __builtin_amdgcn_exp2f(__builtin_fmaf(S[st][4 * rg + 2], sc, -ms)) * il, p3 = __builtin_amdgcn_exp2f(__builtin_fmaf(S[st][4 * rg + 3], sc, -ms)) * il;
                            float qa = p0, qb = p0 + 2.0f * (p1 + p2 + p3);
                            qa += __shfl_xor(qa, 1); qa += __shfl_xor(qa, 2); qb += __shfl_xor(qb, 1); qb += __shfl_xor(qb, 2);
                            const int jp = 8 * (2 * it + st) + 2 * rg + hi;
                            if ((r32 & 3) == 0) { p.impA[p.tokl * 65 + jp] = qa; if (jp < 63) p.impB[p.tokl * 65 + jp + 1] = qb; }
                        }
                } else {
                float tm = S[0][0];
#pragma unroll
                for (int r = 1; r < 16; ++r) tm = fmaxf(tm, S[0][r]);
#pragma unroll
                for (int r = 0; r < 16; ++r) tm = fmaxf(tm, S[1][r]);
                tm = fmaxf(tm, __shfl_xor(tm, 32));
                const float mn = fmaxf(m[c], tm * sc), ms = (mn == -INFINITY) ? 0.f : mn;
                const float alpha = __builtin_amdgcn_exp2f(m[c] - ms);
                m[c] = mn;
                float ps = 0.f;
#pragma unroll
                for (int st = 0; st < 2; ++st)
#pragma unroll
                    for (int r = 0; r < 16; ++r) { const float e = __builtin_amdgcn_exp2f(__builtin_fmaf(S[st][r], sc, -ms)); S[st][r] = e; ps += e; }
                l[c] = l[c] * alpha + ps;
                if (__any(alpha != 1.0f)) {
#pragma unroll
                    for (int dt = 0; dt < 2; ++dt)
#pragma unroll
                        for (int r = 0; r < 16; ++r) O[c][dt][r] *= alpha;
                }
#pragma unroll
                for (int st = 0; st < 2; ++st)
#pragma unroll
                    for (int s = 0; s < 2; ++s) {
                        v4u pw; pw.x = cvtpk(S[st][8 * s], S[st][8 * s + 1]); pw.y = cvtpk(S[st][8 * s + 2], S[st][8 * s + 3]); pw.z = cvtpk(S[st][8 * s + 4], S[st][8 * s + 5]); pw.w = cvtpk(S[st][8 * s + 6], S[st][8 * s + 7]);
                        const bf16x8 pf = __builtin_bit_cast(bf16x8, pw);
#pragma unroll
                        for (int dt = 0; dt < 2; ++dt) {
                            LAS unsigned char* vp = B + voff + (32 * st + 16 * s) * VP + dt * 64;
                            const s16x4 v0 = vtr(vp), v1 = vtr(vp + 8 * VP);
                            const bf16x8 vf = {v0[0], v0[1], v0[2], v0[3], v1[0], v1[1], v1[2], v1[3]};
                            O[c][dt] = __builtin_amdgcn_mfma_f32_32x32x16_bf16(vf, pf, O[c][dt], 0, 0, 0);
                        }
                    }
                }
                if (NCOMP > 1) __builtin_amdgcn_sched_barrier(0);
            }
        }
        if (it + 1 < nt) { FA_STORE((it + 1) & 1); if (it + 2 < nt) FA_LOAD(it + 2); }
        __syncthreads();
    }
#undef FA_LOAD
#undef FA_STORE
    m_ = m[0]; l_ = l[0]; O_[0] = O[0][0]; O_[1] = O[0][1];
}
__device__ __forceinline__ float finish(float l, f32x16 (&O)[2]) {
    const float lt = l + __shfl_xor(l, 32); const float inv = lt > 0.f ? 1.0f / lt : 0.f;
#pragma unroll
    for (int dt = 0; dt < 2; ++dt)
#pragma unroll
        for (int r = 0; r < 16; ++r) O[dt][r] *= inv;
    return lt;
}
__device__ __forceinline__ void store_o(const f32x16 (&O)[2], bf16* out, int hi) {
#pragma unroll
    for (int dt = 0; dt < 2; ++dt)
#pragma unroll
        for (int rg = 0; rg < 4; ++rg) { v2u w; w.x = cvtpk(O[dt][4 * rg], O[dt][4 * rg + 1]); w.y = cvtpk(O[dt][4 * rg + 2], O[dt][4 * rg + 3]); *(v2u*)(out + 32 * dt + 8 * rg + 4 * hi) = w; }
}
}

struct DiffPol {
    const bf16* Zb; int h, t0, wq0, tq;
    __device__ __forceinline__ int ntiles() const { return (t0 + 256) >> 6; }
    __device__ __forceinline__ const bf16* krow(int it, int r) const { return Zb + (size_t)(64 * it + r) * DINP + ZBK + 64 * h; }
    __device__ __forceinline__ const bf16* vrow(int it, int r) const { return Zb + (size_t)(64 * it + r) * DINP + ZBV + 64 * h; }
    __device__ __forceinline__ bool wave_skip(int it) const { return 64 * it > wq0 + 31; }
    __device__ __forceinline__ bool need_mask(int it) const { return 64 * it + 63 > wq0; }
    __device__ __forceinline__ void bounds(int it, int& lb, int& ub) const { lb = 0; ub = tq - 64 * it; }
};
__device__ __forceinline__ void diff_item(Frame& F, const Args& a, int layer, int b, int h, int qb, float lam) {
    PHASE_IDS(F);
    const bf16* Z = (const bf16*)(F.ws + WS_Z); bf16* AO = (bf16*)(F.ws + WS_H);
    const int lane = F.lane, r32 = lane & 31, hi = lane >> 5;
    DiffPol p; p.Zb = Z + (size_t)b * SEQ * DINP; p.h = h; p.t0 = 256 * qb; p.wq0 = p.t0 + 32 * F.wave; p.tq = p.wq0 + r32;
    fa::bf16x8 qf[4]; fa::load_qf(p.Zb + (size_t)p.tq * DINP + ZBQ + 64 * h, hi, qf);
    fa::f32x16 O[2][2];
#pragma unroll
    for (int c = 0; c < 2; ++c)
#pragma unroll
        for (int dt = 0; dt < 2; ++dt)
#pragma unroll
            for (int r = 0; r < 16; ++r) O[c][dt][r] = 0.f;
    { float m = -INFINITY, l = 0.f; fa::stream<0, 2, DiffPol>(p, F.lds3, F.tid, 0.17677669529663687f * fa::LOG2E, qf, m, l, O[0]); fa::finish(l, O[0]); }
    { float m = -INFINITY, l = 0.f; fa::stream<2, 2, DiffPol>(p, F.lds3, F.tid, 0.17677669529663687f * fa::LOG2E, qf, m, l, O[1]); fa::finish(l, O[1]); }
    const float lam_init = 0.8f - 0.6f * expf(-0.3f * (float)layer);
    const float* sg = a.in[6] + (size_t)layer * 64;
    float ss = 0.f;
#pragma unroll
    for (int dt = 0; dt < 2; ++dt)
#pragma unroll
        for (int r = 0; r < 16; ++r) { const float v = O[0][dt][r] - lam * O[1][dt][r]; O[0][dt][r] = v; ss += v * v; }
    ss += __shfl_xor(ss, 32);
    const float rn = (1.0f / sqrtf(ss * (1.0f / 64.0f) + EPS)) * (1.0f - lam_init);
#pragma unroll
    for (int dt = 0; dt < 2; ++dt)
#pragma unroll
        for (int r = 0; r < 16; ++r) O[0][dt][r] *= rn * sg[32 * dt + fa::crow(r, hi)];
    fa::store_o(O[0], AO + ((size_t)b * SEQ + p.tq) * DM + 256 + 64 * h, hi);
}
struct DilPol {
    const bf16* Zb; int h, dil, res, it0, nt, wi0, iq;
    __device__ __forceinline__ int ntiles() const { return nt; }
    __device__ __forceinline__ const bf16* krow(int it, int r) const { const int ik = 64 * (it0 + it) + r; return Zb + (size_t)(res + dil * ik) * DINP + ZDK + 64 * h; }
    __device__ __forceinline__ const bf16* vrow(int it, int r) const { const int ik = 64 * (it0 + it) + r; return Zb + (size_t)(res + dil * ik) * DINP + ZDV + 64 * h; }
    __device__ __forceinline__ bool wave_skip(int it) const { const int k0 = 64 * (it0 + it); return k0 > wi0 + 31 || k0 + 63 < wi0 - 128; }
    __device__ __forceinline__ bool need_mask(int) const { return true; }
    __device__ __forceinline__ void bounds(int it, int& lb, int& ub) const { ub = iq - 64 * (it0 + it); lb = ub - 128; }
};
__device__ __forceinline__ void dil_item(Frame& F, int b, int h, int g, int res, int blk) {
    PHASE_IDS(F);
    const bf16* Z = (const bf16*)(F.ws + WS_Z); bf16* DP = (bf16*)(F.ws + WS_DPART); float* DL = (float*)(F.ws + WS_DLSE);
    const int lane = F.lane, r32 = lane & 31, hi = lane >> 5;
    DilPol p; p.Zb = Z + (size_t)b * SEQ * DINP; p.h = h; p.dil = (g == 0) ? 1 : (g == 1) ? 4 : 16; p.res = res;
    const int i0 = 256 * blk; const int t_lo = (i0 >> 6) - 2; p.it0 = t_lo < 0 ? 0 : t_lo; p.nt = (i0 >> 6) + 4 - p.it0;
    p.wi0 = i0 + 32 * F.wave; p.iq = p.wi0 + r32;
    const int tq = res + p.dil * p.iq; const size_t row = (size_t)b * SEQ + tq;
    fa::bf16x8 qf[4]; fa::load_qf(p.Zb + (size_t)tq * DINP + ZDQ + 64 * h, hi, qf);
    float m = -INFINITY, l = 0.f; fa::f32x16 O[2];
#pragma unroll
    for (int dt = 0; dt < 2; ++dt)
#pragma unroll
        for (int r = 0; r < 16; ++r) O[dt][r] = 0.f;
    fa::stream<0, 4, DilPol>(p, F.lds3, F.tid, 0.125f * fa::LOG2E, qf, m, l, O);
    const float lt = fa::finish(l, O);
    fa::store_o(O, DP + ((size_t)g * T + row) * 256 + 64 * h, hi);
    if (hi == 0) DL[((size_t)g * T + row) * 4 + h] = (m + __log2f(lt)) * fa::LN2;
}
__device__ __forceinline__ void dil_combine(Frame& F) {
    PHASE_IDS(F);
    const bf16* DP = (const bf16*)(F.ws + WS_DPART); const float* DL = (const float*)(F.ws + WS_DLSE); bf16* AO = (bf16*)(F.ws + WS_H);
    const int gt = F.gw * 64 + F.lane, ngt = F.ngw * 64;
    for (int i = gt; i < T * 32; i += ngt) { const int row = i >> 5, c8 = (i & 31) * 8, h = c8 >> 6;
        const float l0 = DL[(size_t)row * 4 + h], l1 = DL[((size_t)T + row) * 4 + h], l2 = DL[((size_t)2 * T + row) * 4 + h];
        const float mx = fmaxf(l0, fmaxf(l1, l2)); float w0 = __expf(l0 - mx), w1 = __expf(l1 - mx), w2 = __expf(l2 - mx); const float inv = 1.0f / (w0 + w1 + w2); w0 *= inv; w1 *= inv; w2 *= inv;
        float x0[8], x1[8], x2[8]; ld8(DP + (size_t)row * 256 + c8, x0); ld8(DP + ((size_t)T + row) * 256 + c8, x1); ld8(DP + ((size_t)2 * T + row) * 256 + c8, x2);
        v4u o; o.x = pk2(w0 * x0[0] + w1 * x1[0] + w2 * x2[0], w0 * x0[1] + w1 * x1[1] + w2 * x2[1]); o.y = pk2(w0 * x0[2] + w1 * x1[2] + w2 * x2[2], w0 * x0[3] + w1 * x1[3] + w2 * x2[3]);
        o.z = pk2(w0 * x0[4] + w1 * x1[4] + w2 * x2[4], w0 * x0[5] + w1 * x1[5] + w2 * x2[5]); o.w = pk2(w0 * x0[6] + w1 * x1[6] + w2 * x2[6], w0 * x0[7] + w1 * x1[7] + w2 * x2[7]);
        *(v4u*)(AO + (size_t)row * DM + 768 + c8) = o; }
}
struct CmpPol {
    const bf16* KCb; const bf16* VCb; int nt, ubg; float* impA; float* impB; int tokl; bool nov;
    __device__ __forceinline__ int ntiles() const { return nt; }
    __device__ __forceinline__ const bf16* krow(int it, int r) const { return KCb + (size_t)(64 * it + r) * 64; }
    __device__ __forceinline__ const bf16* vrow(int it, int r) const { return nov ? nullptr : VCb + (size_t)(64 * it + r) * 64; }
    __device__ __forceinline__ bool wave_skip(int) const { return false; }
    __device__ __forceinline__ bool need_mask(int) const { return true; }
    __device__ __forceinline__ void bounds(int it, int& lb, int& ub) const { lb = 0; ub = ubg - 64 * it; }
};
struct SlcPol {
    const bf16* Zb; const unsigned char* list; int nt, t; unsigned wlo, whi, mlo, mhi;
    __device__ __forceinline__ int ntiles() const { return nt; }
    __device__ __forceinline__ const bf16* krow(int it, int r) const { const int j = list[it]; return Zb + (size_t)(64 * j + r) * DINP + ZKS; }
    __device__ __forceinline__ const bf16* vrow(int it, int r) const { const int j = list[it]; return Zb + (size_t)(64 * j + r) * DINP + ZVS; }
    __device__ __forceinline__ bool wave_skip(int it) const { const int j = list[it]; return !(((j < 32) ? (wlo >> j) : (whi >> (j - 32))) & 1u); }
    __device__ __forceinline__ bool need_mask(int) const { return true; }
    __device__ __forceinline__ void bounds(int it, int& lb, int& ub) const { const int j = list[it]; const unsigned bit = ((j < 32) ? (mlo >> j) : (mhi >> (j - 32))) & 1u; lb = 0; ub = bit ? t - 64 * j : -1; }
};
struct WinPol {
    const bf16* Zb; int jt0, nt, t;
    __device__ __forceinline__ int ntiles() const { return nt; }
    __device__ __forceinline__ const bf16* krow(int it, int r) const { return Zb + (size_t)(64 * (jt0 + it) + r) * DINP + ZKW; }
    __device__ __forceinline__ const bf16* vrow(int it, int r) const { return Zb + (size_t)(64 * (jt0 + it) + r) * DINP + ZVW; }
    __device__ __forceinline__ bool wave_skip(int) const { return false; }
    __device__ __forceinline__ bool need_mask(int) const { return true; }
    __device__ __forceinline__ void bounds(int it, int& lb, int& ub) const { ub = t - 64 * (jt0 + it); lb = ub - 511; }
};
constexpr int NSA_IMP_OFF = 45056, NSA_SEL_OFF = NSA_IMP_OFF + 2 * 64 * 65 * 4, NSA_LIST_OFF = NSA_SEL_OFF + 512;
static_assert(fa::LDS_NEED <= NSA_IMP_OFF && NSA_LIST_OFF + 64 <= RING_BYTES, "NSA LDS map");
__device__ __forceinline__ void nsa_item(Frame& F, int b, int c) {
    PHASE_IDS(F);
    const bf16* Z = (const bf16*)(F.ws + WS_Z); const bf16* AQR = (const bf16*)(F.ws + WS_AQR); bf16* AO = (bf16*)(F.ws + WS_H);
    const bf16* KCB = (const bf16*)(F.ws + WS_KC) + (size_t)b * 256 * 64; const bf16* VCB = (const bf16*)(F.ws + WS_VC) + (size_t)b * 256 * 64;
    const int lane = F.lane, r32 = lane & 31, hi = lane >> 5, tokl = 8 * F.wave + (r32 >> 2), h = r32 & 3, t = 64 * c + tokl; const size_t row = (size_t)b * SEQ + t;
    const bf16* Zb = Z + (size_t)b * SEQ * DINP;
    float* impA = (float*)(F.lds + NSA_IMP_OFF); float* impB = impA + 64 * 65;
    unsigned long long* sel = (unsigned long long*)(F.lds + NSA_SEL_OFF); unsigned char* list = F.lds + NSA_LIST_OFF;
    for (int i = F.tid; i < 2 * 64 * 65; i += NTHREADS) impA[i] = 0.f;
    const bf16* zr = Zb + (size_t)t * DINP;
    const float g0 = sigmoidf_(bf2f(zr[ZAG + h])), g1 = sigmoidf_(bf2f(zr[ZAG + 4 + h])), g2 = sigmoidf_(bf2f(zr[ZAG + 8 + h]));
    fa::f32x16 acc[2], O[2];
    {
        CmpPol cp; cp.KCb = KCB; cp.VCb = VCB; cp.nt = (4 * c + 2 + 64) >> 6; cp.ubg = t >= 31 ? ((t - 31) >> 4) : -1; cp.impA = impA; cp.impB = impB; cp.tokl = tokl; cp.nov = false;
        fa::bf16x8 qf[4]; fa::load_qf(zr + ZAQ + 64 * h, hi, qf);
        float m = -INFINITY, l = 0.f;
#pragma unroll
        for (int dt = 0; dt < 2; ++dt)
#pragma unroll
            for (int r = 0; r < 16; ++r) O[dt][r] = 0.f;
        fa::stream<0, 4, CmpPol, 0>(cp, F.lds3, F.tid, 0.125f * fa::LOG2E, qf, m, l, O);
        float lt = fa::finish(l, O);
#pragma unroll
        for (int dt = 0; dt < 2; ++dt)
#pragma unroll
            for (int r = 0; r < 16; ++r) acc[dt][r] = g0 * O[dt][r];
        cp.nov = true;
        fa::stream<0, 4, CmpPol, 1>(cp, F.lds3, F.tid, 0.125f * fa::LOG2E, qf, m, lt, O);
    }
    __syncthreads();
#pragma unroll 1
    for (int tk = 0; tk < 8; ++tk) {
        const int tl = 8 * F.wave + tk, j = lane; const float imp = impA[tl * 65 + j] + impB[tl * 65 + j];
        const bool forced = (j == 0) || (j <= c && j > c - 2);
        const float sc = (j > c) ? -1.0e6f : (forced ? 1.0e6f : imp);
        int rank = 0;
#pragma unroll 8
        for (int i = 0; i < 64; ++i) { const float si = __shfl(sc, i); rank += (si > sc || (si == sc && i < j)) ? 1 : 0; }
        const unsigned long long mask = __ballot(rank < 16 && j <= c);
        if (lane == 0) sel[tl] = mask;
    }
    __syncthreads();
    SlcPol sp; sp.Zb = Zb; sp.list = list; sp.t = t;
    { const unsigned long long mk = sel[tokl]; sp.mlo = (unsigned)mk; sp.mhi = (unsigned)(mk >> 32);
      unsigned wl = sp.mlo, wh = sp.mhi; wl |= __shfl_xor(wl, 4); wh |= __shfl_xor(wh, 4); wl |= __shfl_xor(wl, 8); wh |= __shfl_xor(wh, 8); wl |= __shfl_xor(wl, 16); wh |= __shfl_xor(wh, 16);
      sp.wlo = __builtin_amdgcn_readfirstlane(wl); sp.whi = __builtin_amdgcn_readfirstlane(wh);
      const unsigned long long mu = sel[lane]; unsigned ul = (unsigned)mu, uh = (unsigned)(mu >> 32);
#pragma unroll
      for (int o = 1; o < 64; o <<= 1) { ul |= __shfl_xor(ul, o); uh |= __shfl_xor(uh, o); }
      ul = __builtin_amdgcn_readfirstlane(ul); uh = __builtin_amdgcn_readfirstlane(uh);
      const unsigned long long un = ((unsigned long long)uh << 32) | ul;
      if ((un >> lane) & 1ull) list[__popcll(un & ((1ull << lane) - 1ull))] = (unsigned char)lane;
      sp.nt = __popcll(un); }
    fa::bf16x8 qf[4]; fa::load_qf(AQR + row * 256 + 64 * h, hi, qf);
    { float m = -INFINITY, l = 0.f;
#pragma unroll
      for (int dt = 0; dt < 2; ++dt)
#pragma unroll
          for (int r = 0; r < 16; ++r) O[dt][r] = 0.f;
      fa::stream<0, 4, SlcPol, 0>(sp, F.lds3, F.tid, 0.125f * fa::LOG2E, qf, m, l, O); fa::finish(l, O);
#pragma unroll
      for (int dt = 0; dt < 2; ++dt)
#pragma unroll
          for (int r = 0; r < 16; ++r) acc[dt][r] += g1 * O[dt][r]; }
    { WinPol wp; wp.Zb = Zb; wp.jt0 = c >= 8 ? c - 8 : 0; wp.nt = c - wp.jt0 + 1; wp.t = t;
      float m = -INFINITY, l = 0.f;
#pragma unroll
      for (int dt = 0; dt < 2; ++dt)
#pragma unroll
          for (int r = 0; r < 16; ++r) O[dt][r] = 0.f;
      fa::stream<0, 4, WinPol, 0>(wp, F.lds3, F.tid, 0.125f * fa::LOG2E, qf, m, l, O); fa::finish(l, O);
#pragma unroll
      for (int dt = 0; dt < 2; ++dt)
#pragma unroll
          for (int r = 0; r < 16; ++r) acc[dt][r] += g2 * O[dt][r]; }
    fa::store_o(acc, AO + row * DM + 64 * h, hi);
}
__device__ __forceinline__ void scan_item(Frame& F, int it) {
    PHASE_IDS(F);
    float* CLOC = (float*)(F.ws + WS_CLOC); float* NLOC = (float*)(F.ws + WS_NLOC);
    const float* ACH = (const float*)(F.ws + WS_ACH); const float* MLOC = (const float*)(F.ws + WS_MLOC); float* MIN = (float*)(F.ws + WS_MIN);
    const int bh = it >> 2, qt = it & 3; const int e0 = qt * 1024 + F.tid * 2;
    float c0 = 0.f, c1 = 0.f, nst = 0.f, mst = 0.f;
    for (int c = 0; c < 64; ++c) {
        const int ci = bh * 64 + c; const float ac = ACH[ci], ml = MLOC[ci];
        float* cp = CLOC + (size_t)ci * 4096 + e0; const f32x2 cl = *(const f32x2*)cp;
        const float mn = fmaxf(ac + mst, ml), decay = __expf(ac + mst - mn), fresh = __expf(ml - mn);
        *(f32x2*)cp = (f32x2){c0, c1}; c0 = decay * c0 + fresh * cl.x; c1 = decay * c1 + fresh * cl.y;
        if (qt == 0 && F.tid < 64) { const float nl = NLOC[ci * 64 + F.tid]; NLOC[ci * 64 + F.tid] = nst; nst = decay * nst + fresh * nl; if (F.tid == 0) MIN[ci] = mst; }
        mst = mn;
    }
}
struct QOrder { unsigned short v[64 + 256 + 256 + 768]; };
constexpr QOrder make_order() {
    QOrder o{}; int n = 0, id = 0, in = 0;
    for (int k = 0; k < 64; ++k) o.v[n++] = (unsigned short)((3 << 12) | k);
    while (id < 256 || in < 256) {
        const int cd = id < 256 ? 96 * (15 - id / 16 + 1) : -1, cn = in < 256 ? 16 * (63 - in / 4 + 18) : -1;
        if (cd >= cn) { o.v[n++] = (unsigned short)((0 << 12) | id); ++id; } else { o.v[n++] = (unsigned short)((1 << 12) | in); ++in; }
    }
    for (int k = 0; k < 768; ++k) o.v[n++] = (unsigned short)((2 << 12) | k);
    return o;
}
__device__ const QOrder g_order = make_order();
__device__ __forceinline__ void ph_d_queue(Frame& F, const Args& a, int layer) {
    PHASE_IDS(F);
    unsigned* ctr = F.ctl + CW_Q + 64 * layer;
    const float* lv = a.in[5] + (size_t)layer * 128;
    const float lam_init = 0.8f - 0.6f * expf(-0.3f * (float)layer);
    float l01 = 0.f, l23 = 0.f; if (F.lane < 32) { l01 = lv[F.lane] * lv[32 + F.lane]; l23 = lv[64 + F.lane] * lv[96 + F.lane]; }
    const float lam = expf(wave_sum(l01)) - expf(wave_sum(l23)) + lam_init;
    constexpr int NQ = 64 + 256 + 256 + 768;
    for (;;) {
        __syncthreads();
        if (F.tid == 0) F.MISC[0] = __hip_atomic_fetch_add(ctr, 1u, __ATOMIC_RELAXED, __HIP_MEMORY_SCOPE_AGENT);
        __syncthreads();
        const int qi = (int)F.MISC[0];
        if (qi >= NQ) break;
        const int e = g_order.v[qi], ty = e >> 12, id = e & 4095;
        if (ty == 3) scan_item(F, id);
        else if (ty == 0) { const int qb = 15 - (id >> 4), bh = id & 15; diff_item(F, a, layer, bh >> 2, bh & 3, qb, lam); }
        else if (ty == 1) nsa_item(F, id & 3, 63 - (id >> 2));
        else { const int bh = id & 15, k = id >> 4;
            const int g = k >> 4, j = k & 15; const int res = (g == 0) ? 0 : (g == 1) ? (j & 3) : j, blk = (g == 0) ? j : (g == 1) ? (j >> 2) : 0;
            dil_item(F, bh >> 2, bh & 3, g, res, blk); }
    }
    __syncthreads();
}

constexpr int NPHASE = 9 * DEPTH + 1;
#ifndef PH_LO
#define PH_LO 0
#endif
#ifndef PH_HI
#define PH_HI NPHASE
#endif
#define IN(k) (PH_LO <= (k) && (k) < PH_HI)
#define SEAM(k) do { if (IN(k) && IN((k) + 1)) { if ((k) == PH_LO) cg::this_grid().sync(); xcd_barrier(bar); } } while (0)
template <int layer> __device__ __forceinline__ void run_layer(Frame& F, const Args& args, const XcdBarrier& bar) {
    float* XR = args.out;
    bf16* H = (bf16*)(F.ws + WS_H); bf16* Z = (bf16*)(F.ws + WS_Z);
    bf16* WIN = (bf16*)(F.ws + WS_WIN); bf16* WOUT = (bf16*)(F.ws + WS_WOUT); bf16* WGU = (bf16*)(F.ws + WS_WGU); bf16* WD = (bf16*)(F.ws + WS_WD);

        const int P = 9 * layer;
        if (IN(P + 0)) {
            convert_weights(F, args, layer);
            if (layer == 0) build_rope(F, args);
            norm_rows_bf16(F, layer == 0 ? args.in[0] : XR, args.in[1] + (size_t)layer * DM, H);
        }
        SEAM(P + 0);
        if (IN(P + 1)) {
            pg8::Gemm g{H, WIN, T, DINP, DM}; pg8::StaticOrder S; S.init(T, DINP, F.G, (int)blockIdx.x); pg8::EpiZ E{Z, DINP};
            pg8::gemm_phase<pg8::EpiZ, pg8::StaticOrder, true, true>(F.lds3, g, S, E);
        }
        SEAM(P + 1);
        if (IN(P + 2)) {
#ifndef NO_C1
 prep_mlstm(F, args, layer);
#endif
#ifndef NO_C2
 prep_compress(F, args, layer);
#endif
#ifndef NO_C3
 prep_rope(F);
#endif
 }
        SEAM(P + 2);
        if (IN(P + 3)) {
#ifndef NO_D2
 ph_d_queue(F, args, layer);
#endif
 }
        SEAM(P + 3);
        if (IN(P + 4)) {
#ifndef NO_E2
 ph_mlstm_out(F, args, layer);
#endif
 dil_combine(F);
 }
        SEAM(P + 4);
        if (IN(P + 5)) {
            pg8::Gemm g{H, WOUT, T, DM, DM}; pg8::StaticOrder S; S.init(T, DM, F.G, (int)blockIdx.x); pg8::EpiRes E{layer == 0 ? args.in[0] : XR, XR, DM};
            pg8::gemm_phase<pg8::EpiRes, pg8::StaticOrder, true, true>(F.lds3, g, S, E);
        }
        SEAM(P + 5);
        if (IN(P + 6)) norm_rows_bf16(F, XR, args.in[14] + (size_t)layer * DM, H);
        SEAM(P + 6);
        if (IN(P + 7)) {
            pg8::Gemm g{H, WGU, T, 2 * DFF, DM}; pg8::StaticOrder S; S.init(T, 2 * DFF, F.G, (int)blockIdx.x); pg8::EpiSwiGLU E{Z, DFF};
            pg8::gemm_phase<pg8::EpiSwiGLU, pg8::StaticOrder, true, true>(F.lds3, g, S, E);
        }
        SEAM(P + 7);
        if (IN(P + 8)) {
            pg8::Gemm g{Z, WD, T, DM, DFF}; pg8::StaticOrder S; S.init(T, DM, F.G, (int)blockIdx.x); pg8::EpiRes E{XR, XR, DM};
            pg8::gemm_phase<pg8::EpiRes, pg8::StaticOrder, true, true>(F.lds3, g, S, E);
        }
        SEAM(P + 8);
    }
__global__ void __launch_bounds__(NTHREADS, 2) fwd_kernel(Args args) {
    extern __shared__ __attribute__((aligned(16))) unsigned char lds[];
    Frame F;
    F.lds = lds; F.lds3 = (LAS unsigned char*)lds; F.MISC = (volatile LAS unsigned*)(F.lds3 + MISC_OFF);
    F.tid = threadIdx.x; F.lane = F.tid & 63; F.wave = __builtin_amdgcn_readfirstlane(F.tid >> 6);
    F.G = gridDim.x; F.gw = blockIdx.x * NWAVES + F.wave; F.ngw = F.G * NWAVES;
    F.ws = args.ws; F.ctl = (unsigned*)(args.ws + WS_CTL);
    for (int u = F.tid; u < (LDS_BYTES - LDSCTL_OFF) / 4; u += NTHREADS) ((LAS unsigned*)(F.lds3 + LDSCTL_OFF))[u] = 0u;
    __syncthreads();
    XcdBarrier bar = xcd_barrier_post(F.ctl + CW_BAR, F.MISC + 8);
    run_layer<0>(F, args, bar);
    run_layer<1>(F, args, bar);
    if (IN(9 * DEPTH)) norm_rows_f32_inplace(F, args.out, args.in[18]);
#undef IN
#undef SEAM
}

extern "C" void kernel_launch(void* const* d_in, const int* in_sizes, int n_in, void* d_out, int out_size, void* d_ws, size_t ws_size, hipStream_t stream) {
    static int grid = 0;
    if (grid == 0) {
        if (n_in != 19 || in_sizes[0] != T * DM || out_size != T * DM || ws_size < WS_END) { fprintf(stderr, "kernel_launch: unexpected shapes (n_in %d, in0 %d, out %d, ws %zu); nothing launched\n", n_in, n_in > 0 ? in_sizes[0] : -1, out_size, ws_size); grid = -1; return; }
        int dev = 0, cus = 0, per_cu = 0;
        if (hipGetDevice(&dev) != hipSuccess || hipDeviceGetAttribute(&cus, hipDeviceAttributeMultiprocessorCount, dev) != hipSuccess) { grid = -1; return; }
        if (hipFuncSetAttribute((const void*)fwd_kernel, hipFuncAttributeMaxDynamicSharedMemorySize, LDS_BYTES) != hipSuccess) { fprintf(stderr, "kernel_launch: hipFuncSetAttribute failed\n"); grid = -1; return; }
        if (hipOccupancyMaxActiveBlocksPerMultiprocessor(&per_cu, (const void*)fwd_kernel, NTHREADS, LDS_BYTES) != hipSuccess || per_cu < 1) { fprintf(stderr, "kernel_launch: note: occupancy query says %d blocks per CU\n", per_cu); (void)hipGetLastError(); }
        grid = cus;
    }
    if (grid < 0) return;
    if (hipMemsetAsync((char*)d_ws + WS_CTL, 0, CTL_ZERO_BYTES, stream) != hipSuccess) { fprintf(stderr, "kernel_launch: memset failed\n"); return; }
    Args a{};
    for (int i = 0; i < 19; ++i) a.in[i] = (const float*)d_in[i];
    a.out = (float*)d_out; a.ws = (unsigned char*)d_ws;
    for (int i = 0; i < 32; ++i) a.inv64[i] = 1.0f / powf(10000.0f, (float)(2 * i) / 64.0f);
    for (int i = 0; i < 16; ++i) a.inv32[i] = 1.0f / powf(10000.0f, (float)(2 * i) / 32.0f);
    void* params[] = {&a};
    const hipError_t le = hipLaunchCooperativeKernel((const void*)fwd_kernel, dim3(grid), dim3(NTHREADS), params, LDS_BYTES, stream);
    if (le != hipSuccess) fprintf(stderr, "kernel_launch: cooperative launch failed: %s (grid %d)\n", hipGetErrorName(le), grid);
}
```

```cpp
#include <hip/hip_runtime.h>
#include <hip/hip_cooperative_groups.h>
#include <cstdio>
#include <cstdint>
namespace cg = cooperative_groups;
namespace pg8 {
#define PG8_LAS __attribute__((address_space(3)))
typedef unsigned short bf16_t;
typedef short bf16x8 __attribute__((ext_vector_type(8)));
typedef float f32x4 __attribute__((ext_vector_type(4)));
typedef unsigned u32x4 __attribute__((ext_vector_type(4)));
constexpr int BM = 256, BK = 64, HALF = 128, HTB = HALF * BK * 2  , STAGE_BYTES = 8 * HTB, NXCD = 8, WGM = 8;

__host__ __device__ __forceinline__ int lds_byte(int r, int c) { const int st = (r >> 4) * 2 + (c >> 5), rr = r & 15, cc = c & 31, ob = rr * 64 + cc * 2; return st * 1024 + (ob ^ (((ob >> 9) & 1) << 5)); }
__host__ __device__ __forceinline__ void stage_rc(int b, int& R, int& C) { const int st = b / 1024, sb = b % 1024, swz = sb ^ (((sb >> 9) & 1) << 5); R = (st >> 1) * 16 + swz / 64; C = (st & 1) * 32 + (swz % 64) / 2; }
__host__ __device__ __forceinline__ int perm32(int rho) { const int n = rho >> 4, i = rho & 15; return 8 * (i >> 2) + 4 * n + (i & 3); }

struct Unit { int pm, pn; };
struct Gemm { const bf16_t* A; const bf16_t* Bt; int M, N, K; };

struct StaticOrder {
    int nM, nN, nwg, G, c;
    __host__ __device__ void init(int M, int N, int G_, int c_) { nM = M / BM; nN = N / BM; nwg = nM * nN; G = G_; c = c_; }
    __host__ __device__ bool next(int i, Unit& u) const {
        const long L = (long)i * G + c; if (L >= nwg) return false;
        int wgid = (int)L; { const int q = nwg / NXCD, r = nwg % NXCD, xcd = wgid % NXCD, off = wgid / NXCD; wgid = (xcd < r ? xcd * (q + 1) : r * (q + 1) + (xcd - r) * q) + off; }
        const int nig = WGM * nN, gid = wgid / nig, fm = gid * WGM, gsz = (nM - fm) < WGM ? (nM - fm) : WGM;
        u.pm = fm + ((wgid % nig) % gsz); u.pn = (wgid % nig) / gsz; return true;
    }
    __device__ __forceinline__ void a_ready(const Unit&) const {}
    __device__ __forceinline__ void done(const Unit&) const {}
};

__device__ __forceinline__ unsigned cvt_pk_bf16(float lo, float hi) { unsigned r; asm volatile("v_cvt_pk_bf16_f32 %0, %1, %2" : "=v"(r) : "v"(lo), "v"(hi)); return r; }
typedef float f32x2 __attribute__((ext_vector_type(2)));
struct EpiZR {
    static constexpr bool PERM = true, AFTER_DRAIN = false;
    bf16_t* O; int ldc; const float* r64; const float* r32; bf16_t* aqr;
    __device__ __forceinline__ void operator()(const f32x4 (&acc)[2][2][4][2], const Unit& u, int wr, int wc, int fr, int fq) const {
        const int row0 = u.pm * BM + wr * 64 + fr, col0 = u.pn * BM + wc * 32 + 8 * fq;
        constexpr unsigned long long R64 = 0xFull | (1ull << 6) | (1ull << 8) | (0xFFull << 34), R32 = 0xFFull << 10;
#pragma unroll
        for (int ai = 0; ai < 2; ++ai)
#pragma unroll
            for (int m = 0; m < 4; ++m) { const int row = row0 + ai * HALF + m * 16; const int pos = row & 4095; bf16_t* rowp = O + (size_t)row * ldc + col0;
#pragma unroll
                for (int bj = 0; bj < 2; ++bj) { f32x4 v0 = acc[ai][bj][m][0], v1 = acc[ai][bj][m][1]; const int c0 = col0 + bj * HALF, seg = c0 >> 6;
                    const bool t64 = (R64 >> seg) & 1ull, t32 = (R32 >> seg) & 1ull;
                    if (t64 || t32) {
                        const float* tp = t64 ? r64 + ((size_t)pos * 32 + ((c0 & 63) >> 1)) * 2 : r32 + ((size_t)pos * 16 + ((c0 & 31) >> 1)) * 2;
                        const f32x4 ca = *(const f32x4*)tp, cb = *(const f32x4*)(tp + 4);
                        const f32x4 o0 = {v0[0] * ca[0] - v0[1] * ca[1], v0[0] * ca[1] + v0[1] * ca[0], v0[2] * ca[2] - v0[3] * ca[3], v0[2] * ca[3] + v0[3] * ca[2]};
                        const f32x4 o1 = {v1[0] * cb[0] - v1[1] * cb[1], v1[0] * cb[1] + v1[1] * cb[0], v1[2] * cb[2] - v1[3] * cb[3], v1[2] * cb[3] + v1[3] * cb[2]};
                        if (seg < 4) { u32x4 wq; wq.x = cvt_pk_bf16(o0[0], o0[1]); wq.y = cvt_pk_bf16(o0[2], o0[3]); wq.z = cvt_pk_bf16(o1[0], o1[1]); wq.w = cvt_pk_bf16(o1[2], o1[3]); *(u32x4*)(aqr + (size_t)row * 256 + c0) = wq; }
                        else { v0 = o0; v1 = o1; }
                    }
                    u32x4 w; w.x = cvt_pk_bf16(v0[0], v0[1]); w.y = cvt_pk_bf16(v0[2], v0[3]); w.z = cvt_pk_bf16(v1[0], v1[1]); w.w = cvt_pk_bf16(v1[2], v1[3]);
                    *(u32x4*)(rowp + bj * HALF) = w; } }
    }
};
struct EpiRes {
    static constexpr bool PERM = false, AFTER_DRAIN = false;
    const float* base; float* out; int ldc;
    __device__ __forceinline__ void operator()(const f32x4 (&acc)[2][2][4][2], const Unit& u, int wr, int wc, int fr, int fq) const {
        const int row0 = u.pm * BM + wr * 64 + fr, col0 = u.pn * BM + wc * 32 + 4 * fq;
#pragma unroll
        for (int ai = 0; ai < 2; ++ai)
#pragma unroll
            for (int m = 0; m < 4; ++m) { const size_t off = (size_t)(row0 + ai * HALF + m * 16) * ldc + col0;
#pragma unroll
                for (int bj = 0; bj < 2; ++bj)
#pragma unroll
                    for (int n = 0; n < 2; ++n) { const size_t p = off + bj * HALF + n * 16; const f32x4 b = *(const f32x4*)(base + p); *(f32x4*)(out + p) = b + acc[ai][bj][m][n]; } }
    }
};
struct EpiSwiGLU {
    static constexpr bool PERM = true, AFTER_DRAIN = false;
    bf16_t* O; int ldc;
    __device__ __forceinline__ void operator()(const f32x4 (&acc)[2][2][4][2], const Unit& u, int wr, int wc, int fr, int fq) const {
        const int row0 = u.pm * BM + wr * 64 + fr, col0 = u.pn * HALF + wc * 32 + 8 * fq;
#pragma unroll
        for (int ai = 0; ai < 2; ++ai)
#pragma unroll
            for (int m = 0; m < 4; ++m) { const int row = row0 + ai * HALF + m * 16; bf16_t* rowp = O + (size_t)row * ldc + col0;
                float r[8];
#pragma unroll
                for (int n = 0; n < 2; ++n)
#pragma unroll
                    for (int j = 0; j < 4; ++j) { const float g = acc[ai][0][m][n][j], up = acc[ai][1][m][n][j]; r[4 * n + j] = g * __builtin_amdgcn_rcpf(1.0f + __expf(-g)) * up; }
                u32x4 w; w.x = cvt_pk_bf16(r[0], r[1]); w.y = cvt_pk_bf16(r[2], r[3]); w.z = cvt_pk_bf16(r[4], r[5]); w.w = cvt_pk_bf16(r[6], r[7]);
                *(u32x4*)rowp = w; }
    }
};
template <class Epi, class Sched, bool ALIGN_EPI = false, bool SP2 = false>
__device__ __forceinline__ void gemm_phase(PG8_LAS unsigned char* lds, const Gemm g, const Sched& S, const Epi& E) {
    int tid_ = threadIdx.x; asm volatile("" : "+v"(tid_));
    const int tid = tid_, wid = __builtin_amdgcn_readfirstlane(tid >> 6), lane = tid & 63, wr = wid >> 2, wc = wid & 3, fr = lane & 15, fq = lane >> 4;
    const int K = g.K, nt = K / BK;
    unsigned voffA[2], voffB[2];
#pragma unroll
    for (int i = 0; i < 2; ++i) { int R, C; stage_rc(tid * 16 + i * 8192, R, C); const int Rb = Epi::PERM ? ((R & ~31) + perm32(R & 31)) : R;
        voffA[i] = (unsigned)(R * K + C) * 2u; voffB[i] = (unsigned)(Rb * K + C) * 2u; }
    const size_t kstep = (size_t)(BK * 2);
    const size_t hstep = (size_t)HALF * K * 2;
    const size_t tstep = 2 * hstep;
    const unsigned ldsw = (unsigned)wid * 1024u;
    const int aoff = lds_byte(wr * 64 + fr, fq * 8), boff = lds_byte(wc * 32 + fr, fq * 8);
#define PG8_SA(b, h) (((b) * 2 + (h)) * HTB)
#define PG8_SB(b, h) ((4 + (b) * 2 + (h)) * HTB)
#define PG8_STAGE(bufoff, gbase, voff) do { _Pragma("unroll") for (int _i = 0; _i < 2; ++_i) \
        __builtin_amdgcn_global_load_lds((const unsigned*)((const char*)(gbase) + (voff)[_i]), (PG8_LAS unsigned*)(lds + (bufoff) + ldsw + _i * 8192), 16, 0, 0); } while (0)
#define PG8_LDA(dst, b, h) do { _Pragma("unroll") for (int m = 0; m < 4; ++m) _Pragma("unroll") for (int k = 0; k < 2; ++k) dst[m][k] = *(const PG8_LAS bf16x8*)(lds + PG8_SA(b, h) + aoff + m * 2048 + k * 1024); } while (0)
#define PG8_LDB(dst, b, h) do { _Pragma("unroll") for (int n = 0; n < 2; ++n) _Pragma("unroll") for (int k = 0; k < 2; ++k) dst[n][k] = *(const PG8_LAS bf16x8*)(lds + PG8_SB(b, h) + boff + n * 2048 + k * 1024); } while (0)
#define PG8_MMA(ai, bj, At, Bt) do { __builtin_amdgcn_s_setprio(1); _Pragma("unroll") for (int m = 0; m < 4; ++m) _Pragma("unroll") for (int n = 0; n < 2; ++n) _Pragma("unroll") for (int k = 0; k < 2; ++k) \
        acc[ai][bj][m][n] = __builtin_amdgcn_mfma_f32_16x16x32_bf16(Bt[n][k], At[m][k], acc[ai][bj][m][n], 0, 0, 0); __builtin_amdgcn_s_setprio(0); } while (0)
#define PG8_WAIT_V(n) asm volatile("s_waitcnt vmcnt(" #n ")" ::: "memory")
#define PG8_WAIT_L(n) asm volatile("s_waitcnt lgkmcnt(" #n ")" ::: "memory")
#define PG8_BAR __builtin_amdgcn_s_barrier()
#define PG8_SCHED __builtin_amdgcn_sched_barrier(0)
    Unit cur, nxt; int ui = 0;
    if (!S.next(0, cur)) return;
    f32x4 acc[2][2][4][2];
#pragma unroll
    for (int a = 0; a < 2; ++a)
#pragma unroll
        for (int b = 0; b < 2; ++b)
#pragma unroll
            for (int m = 0; m < 4; ++m)
#pragma unroll
                for (int n = 0; n < 2; ++n) acc[a][b][m][n] = (f32x4){0.f, 0.f, 0.f, 0.f};
    bf16x8 At[4][2], B0[2][2], B1[2][2];
    const char* cA = (const char*)g.A + (size_t)cur.pm * tstep; const char* cB = (const char*)g.Bt + (size_t)cur.pn * tstep;
    S.a_ready(cur);
    if constexpr (SP2) {
        PG8_STAGE(PG8_SB(0, 0), cB, voffB); PG8_STAGE(PG8_SB(0, 1), cB + hstep, voffB); PG8_STAGE(PG8_SA(0, 0), cA, voffA); PG8_STAGE(PG8_SA(0, 1), cA + hstep, voffA);
        if (wr == 1) PG8_BAR;
        PG8_WAIT_V(2); PG8_BAR;
        PG8_STAGE(PG8_SB(1, 0), cB + kstep, voffB); PG8_STAGE(PG8_SA(1, 0), cA + kstep, voffA); PG8_STAGE(PG8_SB(1, 1), cB + hstep + kstep, voffB);
        PG8_WAIT_V(6); PG8_BAR;
    } else {
        PG8_STAGE(PG8_SB(0, 0), cB, voffB); PG8_STAGE(PG8_SA(0, 0), cA, voffA); PG8_STAGE(PG8_SB(0, 1), cB + hstep, voffB); PG8_STAGE(PG8_SA(0, 1), cA + hstep, voffA);
        if (wr == 1) PG8_BAR;
        PG8_WAIT_V(4); PG8_BAR;
        PG8_STAGE(PG8_SB(1, 0), cB + kstep, voffB); PG8_STAGE(PG8_SA(1, 0), cA + kstep, voffA); PG8_STAGE(PG8_SB(1, 1), cB + hstep + kstep, voffB);
        PG8_WAIT_V(6); PG8_BAR;
    }
    for (;;) {
        const bool has_next = S.next(ui + 1, nxt);
        const char* nA = has_next ? (const char*)g.A + (size_t)nxt.pm * tstep : cA; const char* nB = has_next ? (const char*)g.Bt + (size_t)nxt.pn * tstep : cB;
        for (int t = 0; t < nt; t += 2) {
            const bool last = (t == nt - 2);
            const char* a1 = cA + (size_t)(t + 1) * kstep;
            const char* a2 = last ? nA : cA + (size_t)(t + 2) * kstep; const char* b2 = last ? nB : cB + (size_t)(t + 2) * kstep;
            const char* a3 = a2 + kstep; const char* b3 = b2 + kstep;
            if (last && has_next) S.a_ready(nxt);
            if constexpr (SP2) {
            PG8_LDB(B0, 0, 0); PG8_LDB(B1, 0, 1); PG8_SCHED; PG8_LDA(At, 0, 0); PG8_STAGE(PG8_SA(1, 1), a1 + hstep, voffA);
            PG8_WAIT_V(8); PG8_WAIT_L(0); PG8_BAR; PG8_MMA(0, 0, At, B0); PG8_MMA(0, 1, At, B1); PG8_BAR; PG8_SCHED;
            PG8_LDA(At, 0, 1); PG8_STAGE(PG8_SB(0, 0), b2, voffB); PG8_STAGE(PG8_SB(0, 1), b2 + hstep, voffB); PG8_STAGE(PG8_SA(0, 0), a2, voffA);
            PG8_WAIT_V(8); PG8_WAIT_L(0); PG8_BAR; PG8_MMA(1, 0, At, B0); PG8_MMA(1, 1, At, B1); PG8_BAR; PG8_SCHED;
            PG8_LDB(B0, 1, 0); PG8_LDB(B1, 1, 1); PG8_SCHED; PG8_LDA(At, 1, 0); PG8_STAGE(PG8_SA(0, 1), a2 + hstep, voffA);
            PG8_WAIT_V(8); PG8_WAIT_L(0); PG8_BAR; PG8_MMA(0, 0, At, B0); PG8_MMA(0, 1, At, B1); PG8_BAR; PG8_SCHED;
            PG8_LDA(At, 1, 1); PG8_STAGE(PG8_SB(1, 0), b3, voffB); PG8_STAGE(PG8_SB(1, 1), b3 + hstep, voffB); PG8_STAGE(PG8_SA(1, 0), a3, voffA);
            PG8_WAIT_V(8); PG8_WAIT_L(0); PG8_BAR; PG8_MMA(1, 0, At, B0); PG8_MMA(1, 1, At, B1); PG8_BAR; PG8_SCHED;
            } else {
            PG8_LDB(B0, 0, 0); PG8_SCHED; PG8_LDA(At, 0, 0); PG8_STAGE(PG8_SA(1, 1), a1 + hstep, voffA);
            PG8_WAIT_L(8); PG8_BAR; PG8_WAIT_L(0); PG8_MMA(0, 0, At, B0); PG8_BAR; PG8_SCHED;
            PG8_LDB(B1, 0, 1); PG8_STAGE(PG8_SB(0, 0), b2, voffB);
            PG8_BAR; PG8_WAIT_L(0); PG8_MMA(0, 1, At, B1); PG8_BAR;
            PG8_LDA(At, 0, 1); PG8_STAGE(PG8_SA(0, 0), a2, voffA);
            PG8_BAR; PG8_WAIT_L(0); PG8_MMA(1, 0, At, B0); PG8_BAR; PG8_SCHED;
            PG8_STAGE(PG8_SB(0, 1), b2 + hstep, voffB);
            PG8_WAIT_V(6); PG8_BAR; PG8_MMA(1, 1, At, B1); PG8_BAR;
            PG8_LDB(B0, 1, 0); PG8_SCHED; PG8_LDA(At, 1, 0); PG8_STAGE(PG8_SA(0, 1), a2 + hstep, voffA);
            PG8_WAIT_L(8); PG8_BAR; PG8_WAIT_L(0); PG8_MMA(0, 0, At, B0); PG8_BAR; PG8_SCHED;
            PG8_LDB(B1, 1, 1); PG8_STAGE(PG8_SB(1, 0), b3, voffB);
            PG8_BAR; PG8_WAIT_L(0); PG8_MMA(0, 1, At, B1); PG8_BAR;
            PG8_LDA(At, 1, 1); PG8_STAGE(PG8_SA(1, 0), a3, voffA);
            PG8_BAR; PG8_WAIT_L(0); PG8_MMA(1, 0, At, B0); PG8_BAR; PG8_SCHED;
            PG8_STAGE(PG8_SB(1, 1), b3 + hstep, voffB);
            PG8_WAIT_V(6); PG8_BAR; PG8_MMA(1, 1, At, B1); PG8_BAR;
            }
        }
        if constexpr (ALIGN_EPI) { if (wr == 0) PG8_BAR; }
        if constexpr (!Epi::AFTER_DRAIN) { E(acc, cur, wr, wc, fr, fq); S.done(cur); }
        if (!has_next) break;
#pragma unroll
        for (int a = 0; a < 2; ++a)
#pragma unroll
            for (int b = 0; b < 2; ++b)
#pragma unroll
                for (int m = 0; m < 4; ++m)
#pragma unroll
                    for (int n = 0; n < 2; ++n) acc[a][b][m][n] = (f32x4){0.f, 0.f, 0.f, 0.f};
        cur = nxt; cA = nA; cB = nB; ++ui;
        if constexpr (ALIGN_EPI) { if (wr == 1) PG8_BAR; }
    }
    PG8_WAIT_V(0);
    if constexpr (!ALIGN_EPI) { if (wr == 0) PG8_BAR; }
    PG8_BAR;
    if constexpr (Epi::AFTER_DRAIN) { E.fused(acc, cur, wr, wc, fr, fq, lds, wid, lane); S.done(cur); }
#undef PG8_SA
#undef PG8_SB
#undef PG8_STAGE
#undef PG8_LDA
#undef PG8_LDB
#undef PG8_MMA
#undef PG8_WAIT_V
#undef PG8_WAIT_L
#undef PG8_BAR
#undef PG8_SCHED
}
}

constexpr int NB = 4, SEQ = 4096, T = NB * SEQ, DM = 1024, DIN = 2964, DINP = 3072, DFF = 2816, DEPTH = 2;
constexpr int NWAVES = 8, NTHREADS = 512;
constexpr float EPS = 1e-6f;
constexpr int ZAQ = 0, ZKC = 256, ZVC = 320, ZKS = 384, ZVS = 448, ZKW = 512, ZVW = 576, ZBQ = 640, ZBK = 896, ZBV = 1152,
              ZCU = 1408, ZCV = 1664, ZCO = 1920, ZDQ = 2176, ZDK = 2432, ZDV = 2688, ZAG = 2944, ZCI = 2956, ZCF = 2960;
__host__ __device__ __forceinline__ int pi64(int p) { return (p & 1) ? 32 + (p >> 1) : (p >> 1); }
__host__ __device__ __forceinline__ int pi32(int p) { return (p & 1) ? 16 + (p >> 1) : (p >> 1); }
__host__ __device__ __forceinline__ int zsrc(int n) {
    const int seg = n >> 6, p = n & 63;
    const bool r64 = seg < 4 || seg == 6 || seg == 8 || (seg >= 34 && seg < 42), r32 = seg >= 10 && seg < 18;
    const int q = r64 ? pi64(p) : r32 ? (p & 32) + pi32(p & 31) : p; const int m = seg * 64 + q;
    if (m < 640) return m;
    if (m < 1920) return m + 12;
    if (m < 2944) return m + 20;
    if (m < 2956) return m - 2944 + 640;
    if (m < 2960) return m - 2956 + 1932;
    if (m < 2964) return m - 2960 + 1936;
    return -1;
}
constexpr size_t MiB = 1u << 20;
constexpr size_t WS_CTL = 0, CTL_ZERO_BYTES = 1 * MiB;
constexpr size_t WS_WIN = 2 * MiB, WS_WOUT = 8 * MiB, WS_WGU = 10 * MiB, WS_WD = 21 * MiB;
constexpr size_t WS_ROPE64 = 27 * MiB, WS_ROPE32 = 28 * MiB;
constexpr size_t WS_KC = 29 * MiB, WS_VC = WS_KC + 256 * 1024;
constexpr size_t WS_SEL = WS_VC + 256 * 1024;
constexpr size_t WS_BCUM = 30 * MiB, WS_IG = WS_BCUM + 256 * 1024, WS_NLOC = WS_IG + 256 * 1024;
constexpr size_t WS_ACH = WS_NLOC + 256 * 1024, WS_MLOC = WS_ACH + 4096, WS_MIN = WS_MLOC + 4096;
constexpr size_t WS_WCT = 26 * MiB + 512 * 1024;
constexpr size_t WS_CBP = 28 * MiB + 512 * 1024;
constexpr size_t WS_DLSE = 31 * MiB;
constexpr size_t WS_H = 32 * MiB;
constexpr size_t WS_Z = 64 * MiB;
constexpr size_t WS_XB2 = 64 * MiB, WS_ACT = 96 * MiB;
constexpr size_t WS_AQR = 160 * MiB, WS_OCMP = 168 * MiB, WS_DPART = 176 * MiB;
constexpr size_t WS_MQ = 200 * MiB, WS_MK = 216 * MiB, WS_CLOC = 232 * MiB, WS_END = 248 * MiB;
constexpr int CW_BAR = 4096;
constexpr int CW_Q = 16384;
constexpr int RING_BYTES = 131072, LDSCTL_OFF = RING_BYTES, MISC_OFF = LDSCTL_OFF + 320, LDS_BYTES = 147456;

#define GAS __attribute__((address_space(1)))
#define LAS __attribute__((address_space(3)))
typedef unsigned short bf16;
typedef unsigned v4u __attribute__((ext_vector_type(4)));
typedef unsigned v2u __attribute__((ext_vector_type(2)));
typedef float f32x4 __attribute__((ext_vector_type(4)));
typedef float f32x2 __attribute__((ext_vector_type(2)));
#define LDS_WAIT() asm volatile("s_waitcnt lgkmcnt(0)" ::: "memory")
#define VM_WAIT() asm volatile("s_waitcnt vmcnt(0)" ::: "memory")
__device__ __forceinline__ unsigned f2bf(float f) { unsigned u = __builtin_bit_cast(unsigned, f); return (u + 0x7fffu + ((u >> 16) & 1u)) >> 16; }
__device__ __forceinline__ unsigned pk2(float lo, float hi) { return f2bf(lo) | (f2bf(hi) << 16); }
__device__ __forceinline__ float bf2f(bf16 u) { return __uint_as_float(((unsigned)u) << 16); }
__device__ __forceinline__ float bflo(unsigned w) { return __uint_as_float(w << 16); }
__device__ __forceinline__ float bfhi(unsigned w) { return __uint_as_float(w & 0xffff0000u); }
__device__ __forceinline__ float wave_sum(float v) {
#pragma unroll
    for (int o = 1; o < 64; o <<= 1) v += __shfl_xor(v, o);
    return v;
}
__device__ __forceinline__ float wave_max(float v) {
#pragma unroll
    for (int o = 1; o < 64; o <<= 1) v = fmaxf(v, __shfl_xor(v, o));
    return v;
}
__device__ __forceinline__ float sigmoidf_(float x) { return 1.0f / (1.0f + __expf(-x)); }
#define XB_TMO      128
#define XB_XCNT(j)  (256  + 64 * (j))
#define XB_XSUB(j)  (1280 + 64 * (j))
#define XB_XGEN(j)  (2304 + 64 * (j))
#define XB_TOP      3328
#define XB_TOPGEN   3392
#define XCD_BAR_WORDS 3456
#define XB_SPIN_CAP (1u << 18)

__device__ __forceinline__ unsigned xb_ld(unsigned* p)              { return __hip_atomic_load(p, __ATOMIC_RELAXED, __HIP_MEMORY_SCOPE_AGENT); }
__device__ __forceinline__ unsigned xb_add(unsigned* p, unsigned v) { return __hip_atomic_fetch_add(p, v, __ATOMIC_RELAXED, __HIP_MEMORY_SCOPE_AGENT); }
__device__ __forceinline__ unsigned xb_xcc_id() { return (unsigned)__builtin_amdgcn_s_getreg((3 << 11) | 20) & 0xFu; }
#define XB_SPIN(cond, bar) do { unsigned _sp = 0; while (cond) { __builtin_amdgcn_s_sleep(1); \
    if ((++_sp & 255u) == 0u) { if (xb_ld(&(bar)[XB_TMO])) break; if (_sp > XB_SPIN_CAP) { atomicAdd(&(bar)[XB_TMO], 1u); break; } } } } while (0)

struct XcdBarrier {
    unsigned* bar; unsigned x;
    volatile LAS unsigned* st;
};

__device__ __forceinline__ XcdBarrier xcd_barrier_post(unsigned* bar, volatile LAS unsigned* st) {
    XcdBarrier b; b.bar = bar; b.x = xb_xcc_id(); b.st = st;
    if (threadIdx.x == 0) (void)xb_add(&bar[XB_XCNT(b.x)], 1u);
    return b;
}
__device__ __forceinline__ void xcd_barrier_complete(unsigned* bar, unsigned x, unsigned& nloc, unsigned& nx) {
    const unsigned G = gridDim.x * gridDim.y * gridDim.z;
    unsigned sum, cnt, mine, sp = 0u;
    for (;;) {
        sum = 0u; cnt = 0u; mine = 0u;
#pragma unroll 1
        for (unsigned j = 0; j < 16; ++j) { const unsigned c = xb_ld(&bar[XB_XCNT(j)]); sum += c; cnt += (c > 0u) ? 1u : 0u; mine = (j == x) ? c : mine; }
        if (sum == G) break;
        __builtin_amdgcn_s_sleep(1);
        if ((++sp & 255u) == 0u) { if (xb_ld(&bar[XB_TMO])) break; if (sp > XB_SPIN_CAP) { atomicAdd(&bar[XB_TMO], 1u); break; } }
    }
    nloc = mine > 0u ? mine : 1u; nx = cnt > 0u ? cnt : 1u;
}

__device__ __forceinline__ void xcd_barrier(const XcdBarrier& b) {
    asm volatile("s_waitcnt vmcnt(0)" ::: "memory");
    __syncthreads();
    if (threadIdx.x == 0) {
        unsigned* bar = b.bar;
        __builtin_amdgcn_s_waitcnt(0);
        unsigned nloc = b.st[0], nx = b.st[1];
        if (nloc == 0u) { xcd_barrier_complete(bar, b.x, nloc, nx); b.st[0] = nloc; b.st[1] = nx; }
        const unsigned old = xb_add(&bar[XB_XSUB(b.x)], 1u);
        const unsigned gen = old / nloc;
        if (old + 1u == (gen + 1u) * nloc) {
            __builtin_amdgcn_fence(__ATOMIC_RELEASE, "agent");
            asm volatile("s_waitcnt vmcnt(0)" ::: "memory");
            const unsigned og = xb_add(&bar[XB_TOP], 1u);
            const unsigned tg = og / nx;
            if (og + 1u == (tg + 1u) * nx) xb_add(&bar[XB_TOPGEN], 1u);
            else XB_SPIN(xb_ld(&bar[XB_TOPGEN]) == tg, bar);
            __builtin_amdgcn_fence(__ATOMIC_ACQUIRE, "agent");
            xb_add(&bar[XB_XGEN(b.x)], 1u);
            asm volatile("s_waitcnt vmcnt(0)" ::: "memory");
        } else {
            XB_SPIN(xb_ld(&bar[XB_XGEN(b.x)]) == gen, bar);
            __builtin_amdgcn_fence(__ATOMIC_ACQUIRE, "agent");
            asm volatile("s_waitcnt vmcnt(0)" ::: "memory");
        }
    }
    __syncthreads();
}

struct Args { const float* in[19]; float* out; unsigned char* ws; float inv64[32]; float inv32[16]; };
struct Frame {
    unsigned char* lds;
    LAS unsigned char* lds3;
    volatile LAS unsigned* MISC;
    unsigned* ctl;
    unsigned char* ws;
    int tid, lane, wave, G, gw, ngw;
    unsigned long long pt0, pdt;
};
#define PHASE_IDS(F) do { int t_ = threadIdx.x; asm volatile("" : "+v"(t_)); (F).tid = t_; (F).lane = t_ & 63; (F).wave = __builtin_amdgcn_readfirstlane(t_ >> 6); (F).gw = blockIdx.x * NWAVES + (F).wave; } while (0)


__device__ __forceinline__ void transpose_item(const float* W, int K, int N, int srccol  , bf16* WT, int n0, int k0, float* scr, int lane, const float* gain = nullptr  ) {
#pragma unroll 8
    for (int i = 0; i < 32; ++i) { const int kk = 2 * i + (lane >> 5); scr[kk * 33 + (lane & 31)] = srccol >= 0 ? W[(size_t)(k0 + kk) * N + srccol] * (gain ? gain[k0 + kk] : 1.0f) : 0.f; }
    LDS_WAIT(); asm volatile("" ::: "memory");
    const int c = lane & 7;
#pragma unroll
    for (int j = 0; j < 4; ++j) { const int n = (lane >> 3) + 8 * j; const float* s = scr + (8 * c) * 33 + n;
        v4u o; o.x = pk2(s[0 * 33], s[1 * 33]); o.y = pk2(s[2 * 33], s[3 * 33]); o.z = pk2(s[4 * 33], s[5 * 33]); o.w = pk2(s[6 * 33], s[7 * 33]);
        *(v4u*)(WT + (size_t)(n0 + n) * K + k0 + 8 * c) = o; }
    LDS_WAIT(); asm volatile("" ::: "memory");
}
__device__ __forceinline__ void convert_weights(Frame& F, const Args& a, int layer) {
    PHASE_IDS(F);
    float* scr = (float*)(F.lds + F.wave * 16384);
    const float* w_in = a.in[2] + (size_t)layer * DM * DIN; const float* w_out = a.in[13] + (size_t)layer * DM * DM;
    const float* w_gate = a.in[15] + (size_t)layer * DM * DFF; const float* w_up = a.in[16] + (size_t)layer * DM * DFF; const float* w_down = a.in[17] + (size_t)layer * DFF * DM;
    bf16* WIN = (bf16*)(F.ws + WS_WIN); bf16* WOUT = (bf16*)(F.ws + WS_WOUT); bf16* WGU = (bf16*)(F.ws + WS_WGU); bf16* WD = (bf16*)(F.ws + WS_WD);
    constexpr int I_IN = (DM / 64) * (DINP / 32), I_OUT = (DM / 64) * (DM / 32), I_GU = (DM / 64) * (2 * DFF / 32), I_D = (DFF / 64) * (DM / 32);
    constexpr int I_C = 2 * (2048 / 64) * (64 / 32), I_CB = 64;
    constexpr int NITEMS = I_IN + I_OUT + I_GU + I_D + I_C + I_CB;
    const float* cmp_w = a.in[4] + (size_t)layer * 2 * 2048 * 64; const float* cmp_pos = a.in[3] + (size_t)layer * 2 * 2048; bf16* WCT = (bf16*)(F.ws + WS_WCT); float* CBP = (float*)(F.ws + WS_CBP);
    for (int it = F.gw; it < NITEMS; it += F.ngw) {
        int r = it; const int l31 = F.lane & 31;
        if (r < I_IN) { const int nblk = DINP / 32, kb = r / nblk, nb = r % nblk; transpose_item(w_in, DM, DIN, zsrc(nb * 32 + l31), WIN, nb * 32, kb * 64, scr, F.lane); continue; } r -= I_IN;
        if (r < I_OUT) { const int nblk = DM / 32, kb = r / nblk, nb = r % nblk; transpose_item(w_out, DM, DM, nb * 32 + l31, WOUT, nb * 32, kb * 64, scr, F.lane); continue; } r -= I_OUT;
        if (r < I_GU) { const int nblk = 2 * DFF / 32, kb = r / nblk, nb = r % nblk, n0 = nb * 32, pn = n0 >> 8, w = n0 & 255;
            transpose_item(w < 128 ? w_gate : w_up, DM, DFF, 128 * pn + (w & 127) + l31, WGU, n0, kb * 64, scr, F.lane); continue; } r -= I_GU;
        if (r < I_D) { const int nblk = DM / 32, kb = r / nblk, nb = r % nblk; transpose_item(w_down, DFF, DM, nb * 32 + l31, WD, nb * 32, kb * 64, scr, F.lane); continue; } r -= I_D;
        if (r < I_C) { const int br = r >> 6, q = r & 63, kb = q >> 1, nb = q & 1; transpose_item(cmp_w + (size_t)br * 2048 * 64, 2048, 64, br == 0 ? pi64(nb * 32 + l31) : nb * 32 + l31, WCT + (size_t)br * 64 * 2048, nb * 32, kb * 64, scr, F.lane); continue; } r -= I_C;
        { const int br = r >> 5, ch = r & 31; float acc = 0.f;
#pragma unroll 8
          for (int k = ch * 64; k < ch * 64 + 64; ++k) acc += cmp_pos[br * 2048 + k] * cmp_w[((size_t)br * 2048 + k) * 64 + F.lane];
          CBP[(br * 32 + ch) * 64 + F.lane] = acc; }
    }
}
__device__ __forceinline__ void sincos_d(float ang, float& c, float& s) {
    const double a = (double)ang; const double q = __builtin_rint(a * 0.63661977236758134308); const double r = a - q * 1.57079632679489661923; const double r2 = r * r;
    double sp = -1.0 / 39916800.0; sp = sp * r2 + 1.0 / 362880.0; sp = sp * r2 - 1.0 / 5040.0; sp = sp * r2 + 1.0 / 120.0; sp = sp * r2 - 1.0 / 6.0; sp = sp * r2 + 1.0; sp *= r;
    double cp = 1.0 / 479001600.0; cp = cp * r2 - 1.0 / 3628800.0; cp = cp * r2 + 1.0 / 40320.0; cp = cp * r2 - 1.0 / 720.0; cp = cp * r2 + 1.0 / 24.0; cp = cp * r2 - 0.5; cp = cp * r2 + 1.0;
    const int n = ((int)q) & 3; const double cc = (n == 0) ? cp : (n == 1) ? -sp : (n == 2) ? -cp : sp; const double ss = (n == 0) ? sp : (n == 1) ? cp : (n == 2) ? -sp : -cp;
    c = (float)cc; s = (float)ss;
}
__device__ __forceinline__ void build_rope(Frame& F, const Args& a) {
    PHASE_IDS(F);
    f32x2* R64 = (f32x2*)(F.ws + WS_ROPE64); f32x2* R32 = (f32x2*)(F.ws + WS_ROPE32);
    const int gt = F.gw * 64 + F.lane, ngt = F.ngw * 64;
    for (int i = gt; i < SEQ * 48; i += ngt) { const int pos = i / 48, j = i % 48; float c, s;
        if (j < 32) { sincos_d((float)pos * a.inv64[j], c, s); R64[pos * 32 + j] = (f32x2){c, s}; }
        else { sincos_d((float)pos * a.inv32[j - 32], c, s); R32[pos * 16 + (j - 32)] = (f32x2){c, s}; } }
}
__device__ __forceinline__ void norm_rows_bf16(Frame& F, const float* X, const float* g, bf16* H) {
    PHASE_IDS(F);
    f32x4 gg[4];
#pragma unroll
    for (int j = 0; j < 4; ++j) gg[j] = ((const f32x4*)g)[64 * j + F.lane];
    for (int row0 = F.gw * 4; row0 < T; row0 += F.ngw * 4) {
        f32x4 v[4][4];
#pragma unroll
        for (int r = 0; r < 4; ++r)
#pragma unroll
            for (int j = 0; j < 4; ++j) v[r][j] = ((const f32x4*)(X + (size_t)(row0 + r) * DM))[64 * j + F.lane];
#pragma unroll
        for (int r = 0; r < 4; ++r) { float q = 0.f;
#pragma unroll
            for (int j = 0; j < 4; ++j) q += (v[r][j].x * v[r][j].x + v[r][j].y * v[r][j].y) + (v[r][j].z * v[r][j].z + v[r][j].w * v[r][j].w);
            const float rr = 1.0f / sqrtf(wave_sum(q) * (1.0f / DM) + EPS); v2u* o = (v2u*)(H + (size_t)(row0 + r) * DM) + F.lane;
#pragma unroll
            for (int j = 0; j < 4; ++j) { v2u w; w.x = pk2(v[r][j].x * rr * gg[j].x, v[r][j].y * rr * gg[j].y); w.y = pk2(v[r][j].z * rr * gg[j].z, v[r][j].w * rr * gg[j].w); o[64 * j] = w; } }
    }
}
__device__ __forceinline__ void final_norm(Frame& F, float* X, const float* g) {
    PHASE_IDS(F);
    f32x4 gg[4];
#pragma unroll
    for (int j = 0; j < 4; ++j) gg[j] = ((const f32x4*)g)[64 * j + F.lane];
    for (int row0 = F.gw * 4; row0 < T; row0 += F.ngw * 4) {
        f32x4 v[4][4];
#pragma unroll
        for (int r = 0; r < 4; ++r)
#pragma unroll
            for (int j = 0; j < 4; ++j) v[r][j] = ((const f32x4*)(X + (size_t)(row0 + r) * DM))[64 * j + F.lane];
#pragma unroll
        for (int r = 0; r < 4; ++r) { float q = 0.f;
#pragma unroll
            for (int j = 0; j < 4; ++j) q += (v[r][j].x * v[r][j].x + v[r][j].y * v[r][j].y) + (v[r][j].z * v[r][j].z + v[r][j].w * v[r][j].w);
            const float rr = 1.0f / sqrtf(wave_sum(q) * (1.0f / DM) + EPS); f32x4* o = (f32x4*)(X + (size_t)(row0 + r) * DM) + F.lane;
#pragma unroll
            for (int j = 0; j < 4; ++j) o[64 * j] = v[r][j] * rr * gg[j]; }
    }
}

__device__ __forceinline__ void prep_compress(Frame& F, const Args& a, int layer) {
    PHASE_IDS(F);
    typedef short bf16x8 __attribute__((ext_vector_type(8)));
    const bf16* Z = (const bf16*)(F.ws + WS_Z); const bf16* WCT = (const bf16*)(F.ws + WS_WCT); const float* CBP = (const float*)(F.ws + WS_CBP);
    f32x4* red = (f32x4*)F.lds;
    const int lane = F.lane, et = F.wave & 3, kh = F.wave >> 2, r16 = lane & 15, q4 = lane >> 4;
    for (int it = blockIdx.x; it < NB * 2 * 16; it += F.G) {
        const int b = it >> 5, br = (it >> 4) & 1, n0 = (it & 15) * 16; const int zc = br ? ZVC : ZKC;
        const bf16* wrow = WCT + ((size_t)br * 64 + et * 16 + r16) * 2048 + 8 * q4;
        const int tb = 16 * (n0 + r16);
        f32x4 acc = {0.f, 0.f, 0.f, 0.f};
#pragma unroll 8
        for (int kk = kh * 32; kk < kh * 32 + 32; ++kk) {
            int tok = tb + (kk >> 1); tok = tok < SEQ ? tok : SEQ - 1;
            const bf16x8 af = *(const bf16x8*)(Z + ((size_t)b * SEQ + tok) * DINP + zc + (kk & 1) * 32 + 8 * q4);
            const bf16x8 bfr = *(const bf16x8*)(wrow + 32 * kk);
            acc = __builtin_amdgcn_mfma_f32_16x16x32_bf16(af, bfr, acc, 0, 0, 0);
        }
        __syncthreads();
        if (kh == 1) red[et * 64 + lane] = acc;
        __syncthreads();
        if (kh == 0) {
            const f32x4 o = red[et * 64 + lane]; const int e = et * 16 + r16; float bias = 0.f;
            const int es = br == 0 ? pi64(e) : e;
#pragma unroll 8
            for (int ch = 0; ch < 32; ++ch) bias += CBP[(br * 32 + ch) * 64 + es];
            bf16* O = (bf16*)(F.ws + (br ? WS_VC : WS_KC)) + (size_t)b * 256 * 64;
#pragma unroll
            for (int r = 0; r < 4; ++r) { const int n = n0 + 4 * q4 + r; O[n * 64 + e] = (bf16)((n < 255) ? f2bf(acc[r] + o[r] + bias) : 0u); }
        }
    }
    __syncthreads();
}
__device__ __forceinline__ float log_sigmoid_(float x) { return x >= 0.f ? -log1pf(__expf(-x)) : x - log1pf(__expf(x)); }
typedef float f32x16m __attribute__((ext_vector_type(16)));
__device__ __forceinline__ void mm64(f32x16m& acc, const float* ap, int as, const float* bp, int bs) {
#pragma unroll 8
    for (int kk = 0; kk < 32; ++kk) acc = __builtin_amdgcn_mfma_f32_32x32x2f32(ap[kk * as], bp[kk * bs], acc, 0, 0, 0);
}
__device__ __forceinline__ int crow32(int r, int hi) { return (r & 3) + 8 * (r >> 2) + 4 * hi; }
__device__ __forceinline__ void prep_mlstm(Frame& F, const Args& a, int layer) {
    PHASE_IDS(F);
    const bf16* Z = (const bf16*)(F.ws + WS_Z);
    float* L = (float*)F.lds; float* UC = L; float* KS = L + 4224; float* VS = L + 8448; float* WQ = L + 12672; float* WK = L + 16896; float* WE = L + 21120;
    const float* convw = a.in[7] + (size_t)layer * 4 * 256; const float* convb = a.in[8] + (size_t)layer * 256;
    const float* gb = a.in[11] + (size_t)layer * 8;
    float* MQ = (float*)(F.ws + WS_MQ); float* MK = (float*)(F.ws + WS_MK); float* CLOC = (float*)(F.ws + WS_CLOC); float* NLOC = (float*)(F.ws + WS_NLOC);
    float* BCUM = (float*)(F.ws + WS_BCUM); float* IG = (float*)(F.ws + WS_IG); float* ACH = (float*)(F.ws + WS_ACH); float* MLOC = (float*)(F.ws + WS_MLOC);
    const int lane = F.lane, r32 = lane & 31, hi = lane >> 5, w = F.wave;
    for (int it = blockIdx.x; it < 1024; it += F.G) {
        const int bh = it >> 6, c = it & 63, b = bh >> 2, h = bh & 3, t0 = c * 64; const size_t row0 = (size_t)b * SEQ + t0;
        const float* wq = a.in[9] + ((size_t)layer * 4 + h) * 4096; const float* wk = a.in[10] + ((size_t)layer * 4 + h) * 4096;
        __syncthreads();
#pragma unroll
        for (int u = 0; u < 8; ++u) { const int i = F.tid + u * NTHREADS; const int l = i >> 6, d = i & 63, ch = h * 64 + d; float s = convb[ch];
#pragma unroll
            for (int j = 0; j < 4; ++j) { const int t = t0 + l - 3 + j; if (t >= 0) s += convw[j * 256 + ch] * bf2f(Z[((size_t)b * SEQ + t) * DINP + ZCU + ch]); }
            UC[l * 65 + d] = s * sigmoidf_(s); VS[i] = bf2f(Z[(row0 + l) * DINP + ZCV + ch]); WQ[i] = wq[i]; WK[i] = wk[i]; }
        if (w == 0) { const int l = lane; const size_t row = row0 + l;
            const float ig = bf2f(Z[row * DINP + ZCI + h]) + gb[h]; float bc = log_sigmoid_(bf2f(Z[row * DINP + ZCF + h]) + gb[4 + h]);
#pragma unroll
            for (int o = 1; o < 64; o <<= 1) { const float v = __shfl_up(bc, o); if (l >= o) bc += v; }
            const float ach = __shfl(bc, 63); const float ge = ach - bc + ig; const float ml = wave_max(ge);
            WE[l] = __expf(ge - ml); BCUM[row * 4 + h] = bc; IG[row * 4 + h] = ig; if (l == 0) { ACH[it] = ach; MLOC[it] = ml; } }
        __syncthreads();
        { const int i0 = ((w >> 1) & 1) * 32, j0 = (w & 1) * 32; f32x16m acc;
#pragma unroll
            for (int r = 0; r < 16; ++r) acc[r] = 0.f;
            mm64(acc, UC + (i0 + r32) * 65 + hi, 2, (w < 4 ? WQ : WK) + hi * 64 + j0 + r32, 128);
            float* G = (w < 4 ? MQ : MK) + row0 * 256 + h * 64 + j0 + r32;
            if (w < 4) {
#pragma unroll
                for (int r = 0; r < 16; ++r) G[(size_t)(i0 + crow32(r, hi)) * 256] = acc[r];
            } else {
#pragma unroll
                for (int r = 0; r < 16; ++r) { const float v = acc[r] * 0.125f; const int l = i0 + crow32(r, hi); G[(size_t)l * 256] = v; KS[l * 64 + j0 + r32] = v; }
            } }
        __syncthreads();
        if (w < 4) { const int i0 = (w >> 1) * 32, j0 = (w & 1) * 32; f32x16m acc;
#pragma unroll
            for (int r = 0; r < 16; ++r) acc[r] = 0.f;
#pragma unroll 8
            for (int kk = 0; kk < 32; ++kk) { const int l = 2 * kk + hi; acc = __builtin_amdgcn_mfma_f32_32x32x2f32(VS[l * 64 + i0 + r32] * WE[l], KS[l * 64 + j0 + r32], acc, 0, 0, 0); }
            float* G = CLOC + (size_t)it * 4096 + j0 + r32;
#pragma unroll
            for (int r = 0; r < 16; ++r) G[(i0 + crow32(r, hi)) * 64] = acc[r];
        } else if (w == 4) { float n = 0.f;
#pragma unroll 8
            for (int l = 0; l < 64; ++l) n += WE[l] * KS[l * 64 + lane];
            NLOC[it * 64 + lane] = n; }
    }
    __syncthreads();
}

__device__ __forceinline__ void ld8(const bf16* p, float* o) { const v4u w = *(const v4u*)p; o[0] = bflo(w.x); o[1] = bfhi(w.x); o[2] = bflo(w.y); o[3] = bfhi(w.y); o[4] = bflo(w.z); o[5] = bfhi(w.z); o[6] = bflo(w.w); o[7] = bfhi(w.w); }
template <int DK> __device__ __forceinline__ void load_q(const bf16* p, float (&q)[64]) {
#pragma unroll
    for (int g = 0; g < DK / 8; ++g) ld8(p + 8 * g, &q[8 * g]);
}
template <int DK> __device__ __forceinline__ float dot_qk(const float (&q)[64], const bf16* kp) {
    float s = 0.f;
#pragma unroll
    for (int g = 0; g < DK / 8; ++g) { float k[8]; ld8(kp + 8 * g, k);
#pragma unroll
        for (int i = 0; i < 8; ++i) s += q[8 * g + i] * k[i]; }
    return s;
}
__device__ __forceinline__ void attn_upd(float s, const bf16* vp, float& m, float& l, float (&o)[64]) {
    const float mn = fmaxf(m, s), c = __expf(m - mn), p = __expf(s - mn);
    l = l * c + p;
#pragma unroll
    for (int g = 0; g < 8; ++g) { float v[8]; ld8(vp + 8 * g, v);
#pragma unroll
        for (int i = 0; i < 8; ++i) o[8 * g + i] = o[8 * g + i] * c + p * v[i]; }
    m = mn;
}
__device__ __forceinline__ float reduce_scatter64(float (&o)[64], int lane) {
#pragma unroll
    for (int i = 0; i < 32; ++i) { const bool hi = lane & 32; const float send = hi ? o[i] : o[i + 32], keep = hi ? o[i + 32] : o[i]; o[i] = keep + __shfl_xor(send, 32); }
#pragma unroll
    for (int i = 0; i < 16; ++i) { const bool hi = lane & 16; const float send = hi ? o[i] : o[i + 16], keep = hi ? o[i + 16] : o[i]; o[i] = keep + __shfl_xor(send, 16); }
#pragma unroll
    for (int i = 0; i < 8; ++i) { const bool hi = lane & 8; const float send = hi ? o[i] : o[i + 8], keep = hi ? o[i + 8] : o[i]; o[i] = keep + __shfl_xor(send, 8); }
#pragma unroll
    for (int i = 0; i < 4; ++i) { const bool hi = lane & 4; const float send = hi ? o[i] : o[i + 4], keep = hi ? o[i + 4] : o[i]; o[i] = keep + __shfl_xor(send, 4); }
#pragma unroll
    for (int i = 0; i < 2; ++i) { const bool hi = lane & 2; const float send = hi ? o[i] : o[i + 2], keep = hi ? o[i + 2] : o[i]; o[i] = keep + __shfl_xor(send, 2); }
    { const bool hi = lane & 1; const float send = hi ? o[0] : o[1], keep = hi ? o[1] : o[0]; o[0] = keep + __shfl_xor(send, 1); }
    return o[0];
}
__device__ __forceinline__ float attn_fin(float m, float l, float (&o)[64], int lane) {
    const float M = wave_max(m); const float c = (m == -INFINITY) ? 0.f : __expf(m - M);
    const float L = wave_sum(l * c);
#pragma unroll
    for (int d = 0; d < 64; ++d) o[d] *= c;
    const float v = reduce_scatter64(o, lane);
    return L > 0.f ? v / L : 0.f;
}
__device__ __forceinline__ int bal_t(int tt) { return tt < 2048 ? tt : 6143 - tt; }

__device__ __forceinline__ void ph_cmp_topk(Frame& F) {
    PHASE_IDS(F);
    const bf16* Z = (const bf16*)(F.ws + WS_Z); const float* KC = (const float*)(F.ws + WS_KC); const float* VC = (const float*)(F.ws + WS_VC);
    bf16* OCMP = (bf16*)(F.ws + WS_OCMP); unsigned long long* SEL = (unsigned long long*)(F.ws + WS_SEL);
    float* ps = (float*)(F.lds + F.wave * 2048);
    for (int idx = F.gw; idx < T; idx += F.ngw) {
        const int b = idx >> 12, t = bal_t(idx & 4095), row = b * SEQ + t, lane = F.lane;
        const int nvalid = t >= 31 ? ((t - 31) >> 4) + 1 : 0;
        float psum[4] = {0.f, 0.f, 0.f, 0.f};
        const float* kcb = KC + (size_t)b * 256 * 64; const float* vcb = VC + (size_t)b * 256 * 64;
#pragma unroll 1
        for (int h = 0; h < 4; ++h) {
            float q[64]; load_q<64>(Z + (size_t)row * DINP + ZAQ + 64 * h, q);
            float s[4]; float mx = -INFINITY;
#pragma unroll
            for (int k = 0; k < 4; ++k) { const int n = lane + 64 * k; float acc = 0.f;
                if (n < nvalid) { const f32x4* kp = (const f32x4*)(kcb + n * 64);
#pragma unroll
                    for (int g = 0; g < 16; ++g) { const f32x4 kv = kp[g]; acc += q[4 * g] * kv.x + q[4 * g + 1] * kv.y + q[4 * g + 2] * kv.z + q[4 * g + 3] * kv.w; }
                    s[k] = acc * 0.125f; } else s[k] = -INFINITY;
                mx = fmaxf(mx, s[k]); }
            mx = wave_max(mx);
            float e[4], es = 0.f;
#pragma unroll
            for (int k = 0; k < 4; ++k) { e[k] = (lane + 64 * k < nvalid) ? __expf(s[k] - mx) : 0.f; es += e[k]; }
            es = wave_sum(es); const float inv = es > 0.f ? 1.0f / es : 0.f;
            float o[64];
#pragma unroll
            for (int d = 0; d < 64; ++d) o[d] = 0.f;
#pragma unroll
            for (int k = 0; k < 4; ++k) { const float p = e[k] * inv; psum[k] += p; const int n = lane + 64 * k;
                if (n < nvalid) { const f32x4* vp = (const f32x4*)(vcb + n * 64);
#pragma unroll
                    for (int g = 0; g < 16; ++g) { const f32x4 vv = vp[g]; o[4 * g] += p * vv.x; o[4 * g + 1] += p * vv.y; o[4 * g + 2] += p * vv.z; o[4 * g + 3] += p * vv.w; } } }
            const float od = reduce_scatter64(o, lane);
            OCMP[(size_t)row * 256 + 64 * h + lane] = (bf16)f2bf(od);
        }
#pragma unroll
        for (int k = 0; k < 4; ++k) ps[lane + 64 * k] = psum[k];
        LDS_WAIT(); asm volatile("" ::: "memory");
        const int j = lane, cur = t >> 6; float imp = ps[4 * j];
        if (j > 0) imp += 2.f * (ps[4 * j - 1] + ps[4 * j - 2] + ps[4 * j - 3]) + ps[4 * j - 4];
        LDS_WAIT(); asm volatile("" ::: "memory");
        const bool forced = (j == 0) || (j <= cur && j > cur - 2);
        const float sc = (j > cur) ? -1.0e6f : (forced ? 1.0e6f : imp);
        int rank = 0;
#pragma unroll 8
        for (int i = 0; i < 64; ++i) { const float si = __shfl(sc, i); rank += (si > sc || (si == sc && i < j)) ? 1 : 0; }
        const unsigned long long mask = __ballot(rank < 16 && j <= cur);
        if (lane == 0) SEL[row] = mask;
    }
}
__device__ __forceinline__ float diff_comp(const bf16* Z, int b, int h, int t, int comp, size_t row, float scale, int lane) {
    float q[64]; load_q<32>(Z + row * DINP + ZBQ + 64 * h + 32 * comp, q);
    float m = -INFINITY, l = 0.f, o[64];
#pragma unroll
    for (int d = 0; d < 64; ++d) o[d] = 0.f;
    for (int kp = lane; kp <= t; kp += 64) { const bf16* kr = Z + ((size_t)b * SEQ + kp) * DINP;
        const float s = dot_qk<32>(q, kr + ZBK + 64 * h + 32 * comp) * scale; attn_upd(s, kr + ZBV + 64 * h, m, l, o); }
    return attn_fin(m, l, o, lane);
}
__device__ __forceinline__ void ph_diff(Frame& F, const Args& a, int layer) {
    PHASE_IDS(F);
    const bf16* Z = (const bf16*)(F.ws + WS_Z); bf16* AO = (bf16*)(F.ws + WS_H);
    const float* lv = a.in[5] + (size_t)layer * 128; const float* sg = a.in[6] + (size_t)layer * 64;
    const float lam_init = 0.8f - 0.6f * expf(-0.3f * (float)layer);
    float l01 = 0.f, l23 = 0.f; if (F.lane < 32) { l01 = lv[F.lane] * lv[32 + F.lane]; l23 = lv[64 + F.lane] * lv[96 + F.lane]; }
    const float lam = expf(wave_sum(l01)) - expf(wave_sum(l23)) + lam_init;
    const float scale = 0.17677669529663687f;
    for (int idx = F.gw; idx < T * 4; idx += F.ngw) {
        const int bh = idx >> 12, b = bh >> 2, h = bh & 3, t = bal_t(idx & 4095), lane = F.lane; const size_t row = (size_t)b * SEQ + t;
        const float val0 = diff_comp(Z, b, h, t, 0, row, scale, lane), val1 = diff_comp(Z, b, h, t, 1, row, scale, lane);
        const float hd = val0 - lam * val1; const float ss = wave_sum(hd * hd);
        const float y = hd * (1.0f / sqrtf(ss * (1.0f / 64.0f) + EPS)) * sg[lane] * (1.0f - lam_init);
        AO[row * DM + 256 + 64 * h + lane] = (bf16)f2bf(y);
    }
}
__device__ __forceinline__ void ph_dilated(Frame& F) {
    PHASE_IDS(F);
    const bf16* Z = (const bf16*)(F.ws + WS_Z); bf16* AO = (bf16*)(F.ws + WS_H);
    for (int idx = F.gw; idx < T * 4; idx += F.ngw) {
        const int bh = idx >> 12, b = bh >> 2, h = bh & 3, t = idx & 4095, lane = F.lane; const size_t row = (size_t)b * SEQ + t;
        float q[64]; load_q<64>(Z + row * DINP + ZDQ + 64 * h, q);
        float m = -INFINITY, l = 0.f, o[64];
#pragma unroll
        for (int d = 0; d < 64; ++d) o[d] = 0.f;
#pragma unroll 1
        for (int k = 0; k < 7; ++k) { const int i = lane + 64 * k; const int g = i / 129, j = i - g * 129; const int dil = (g == 0) ? 1 : (g == 1) ? 4 : 16; const int kp = t - j * dil;
            if (i < 387 && kp >= 0) { const bf16* kr = Z + ((size_t)b * SEQ + kp) * DINP; const float s = dot_qk<64>(q, kr + ZDK + 64 * h) * 0.125f; attn_upd(s, kr + ZDV + 64 * h, m, l, o); } }
        const float v = attn_fin(m, l, o, lane);
        AO[row * DM + 768 + 64 * h + lane] = (bf16)f2bf(v);
    }
}
__device__ __forceinline__ void ph_mlstm_scan(Frame& F) {
    PHASE_IDS(F);
    float* CLOC = (float*)(F.ws + WS_CLOC); float* NLOC = (float*)(F.ws + WS_NLOC);
    const float* ACH = (const float*)(F.ws + WS_ACH); const float* MLOC = (const float*)(F.ws + WS_MLOC); float* MIN = (float*)(F.ws + WS_MIN);
    for (int it = blockIdx.x; it < 64; it += F.G) {
        const int bh = it >> 2, qt = it & 3; const int e0 = qt * 1024 + F.tid * 2;
        float c0 = 0.f, c1 = 0.f, nst = 0.f, mst = 0.f;
        for (int c = 0; c < 64; ++c) {
            const int ci = bh * 64 + c; const float ac = ACH[ci], ml = MLOC[ci];
            float* cp = CLOC + (size_t)ci * 4096 + e0; const f32x2 cl = *(const f32x2*)cp;
            const float mn = fmaxf(ac + mst, ml), decay = __expf(ac + mst - mn), fresh = __expf(ml - mn);
            *(f32x2*)cp = (f32x2){c0, c1}; c0 = decay * c0 + fresh * cl.x; c1 = decay * c1 + fresh * cl.y;
            if (qt == 0 && F.tid < 64) { const float nl = NLOC[ci * 64 + F.tid]; NLOC[ci * 64 + F.tid] = nst; nst = decay * nst + fresh * nl; if (F.tid == 0) MIN[ci] = mst; }
            mst = mn;
        }
    }
}

__device__ __forceinline__ void ph_nsa_sw(Frame& F) {
    PHASE_IDS(F);
    const bf16* Z = (const bf16*)(F.ws + WS_Z); const bf16* AQR = (const bf16*)(F.ws + WS_AQR); const bf16* OCMP = (const bf16*)(F.ws + WS_OCMP);
    const unsigned long long* SEL = (const unsigned long long*)(F.ws + WS_SEL); bf16* AO = (bf16*)(F.ws + WS_H);
    for (int idx = F.gw; idx < T * 4; idx += F.ngw) {
        const int bh = idx >> 12, b = bh >> 2, h = bh & 3, t = bal_t(idx & 4095), lane = F.lane; const size_t row = (size_t)b * SEQ + t;
        float q[64]; load_q<64>(AQR + row * 256 + 64 * h, q);
        const unsigned long long mk = SEL[row]; unsigned mlo = __builtin_amdgcn_readfirstlane((unsigned)mk), mhi = __builtin_amdgcn_readfirstlane((unsigned)(mk >> 32));
        float m = -INFINITY, l = 0.f, o[64];
#pragma unroll
        for (int d = 0; d < 64; ++d) o[d] = 0.f;
#pragma unroll 1
        for (int j = 0; j < 64; ++j) { const unsigned bit = (j < 32) ? (mlo >> j) & 1u : (mhi >> (j - 32)) & 1u; if (!bit) continue;
            const int kp = 64 * j + lane; if (kp <= t) { const bf16* kr = Z + ((size_t)b * SEQ + kp) * DINP; const float s = dot_qk<64>(q, kr + ZKS) * 0.125f; attn_upd(s, kr + ZVS, m, l, o); } }
        const float oslc = attn_fin(m, l, o, lane);
        m = -INFINITY; l = 0.f;
#pragma unroll
        for (int d = 0; d < 64; ++d) o[d] = 0.f;
#pragma unroll 1
        for (int k = 0; k < 8; ++k) { const int kp = t - 511 + lane + 64 * k;
            if (kp >= 0) { const bf16* kr = Z + ((size_t)b * SEQ + kp) * DINP; const float s = dot_qk<64>(q, kr + ZKW) * 0.125f; attn_upd(s, kr + ZVW, m, l, o); } }
        const float owin = attn_fin(m, l, o, lane);
        const bf16* zr = Z + row * DINP + ZAG; const float g0 = sigmoidf_(bf2f(zr[h])), g1 = sigmoidf_(bf2f(zr[4 + h])), g2 = sigmoidf_(bf2f(zr[8 + h]));
        const float out = g0 * bf2f(OCMP[row * 256 + 64 * h + lane]) + g1 * oslc + g2 * owin;
        AO[row * DM + 64 * h + lane] = (bf16)f2bf(out);
    }
}
__device__ __forceinline__ void ph_mlstm_out(Frame& F, const Args& a, int layer) {
    PHASE_IDS(F);
    const bf16* Z = (const bf16*)(F.ws + WS_Z); bf16* AO = (bf16*)(F.ws + WS_H);
    const float* MQ = (const float*)(F.ws + WS_MQ); const float* MK = (const float*)(F.ws + WS_MK); const float* CIN = (const float*)(F.ws + WS_CLOC); const float* NIN = (const float*)(F.ws + WS_NLOC);
    const float* BCUM = (const float*)(F.ws + WS_BCUM); const float* IG = (const float*)(F.ws + WS_IG); const float* MIN = (const float*)(F.ws + WS_MIN);
    const float* hg = a.in[12] + (size_t)layer * 256;
    float* L = (float*)F.lds; float* QS = L; float* KS = L + 4224; float* CS = L + 8448; float* SS = L + 12672; float* HS = L + 16896; float* VS = L + 21120;
    float* NI = L + 25344; float* BC = NI + 64; float* IGS = BC + 64; float* MT = IGS + 64; float* EI = MT + 64; float* DEN = EI + 64;
    const int lane = F.lane, r32 = lane & 31, hi = lane >> 5, w = F.wave;
    for (int it = blockIdx.x; it < 1024; it += F.G) {
        const int bh = it >> 6, c = it & 63, b = bh >> 2, h = bh & 3; const size_t row0 = (size_t)b * SEQ + c * 64;
        __syncthreads();
#pragma unroll
        for (int u = 0; u < 8; ++u) { const int i = F.tid + u * NTHREADS; const int l = i >> 6, d = i & 63; const size_t g = (row0 + l) * 256 + h * 64 + d;
            QS[l * 65 + d] = MQ[g]; KS[l * 65 + d] = MK[g]; VS[i] = bf2f(Z[(row0 + l) * DINP + ZCV + h * 64 + d]); CS[l * 65 + d] = CIN[(size_t)it * 4096 + i]; }
        if (w == 0) { const int l = lane; const float bc = BCUM[(row0 + l) * 4 + h], ig = IG[(row0 + l) * 4 + h], mi = MIN[it];
            NI[l] = NIN[it * 64 + l]; BC[l] = bc; IGS[l] = ig;
            float pm = ig - bc;
#pragma unroll
            for (int o = 1; o < 64; o <<= 1) { const float v = __shfl_up(pm, o); if (l >= o) pm = fmaxf(pm, v); }
            const float inter = bc + mi, mt = fmaxf(inter, bc + pm); MT[l] = mt; EI[l] = __expf(inter - mt); }
        __syncthreads();
        const int i0 = ((w >> 1) & 1) * 32, j0 = (w & 1) * 32; f32x16m acc;
#pragma unroll
        for (int r = 0; r < 16; ++r) acc[r] = 0.f;
        if (w < 4) {
            if (!(i0 == 0 && j0 == 32)) mm64(acc, QS + (i0 + r32) * 65 + hi, 2, KS + (j0 + r32) * 65 + hi, 2);
            const int s_ = j0 + r32; const float bs = IGS[s_] - BC[s_];
#pragma unroll
            for (int r = 0; r < 16; ++r) { const int t = i0 + crow32(r, hi); SS[t * 65 + s_] = (s_ <= t) ? acc[r] * __expf(BC[t] + bs - MT[t]) : 0.f; }
        } else {
            mm64(acc, QS + (i0 + r32) * 65 + hi, 2, CS + (j0 + r32) * 65 + hi, 2);
#pragma unroll
            for (int r = 0; r < 16; ++r) acc[r] *= EI[i0 + crow32(r, hi)];
        }
        __syncthreads();
        if (w >= 4) {
            mm64(acc, SS + (i0 + r32) * 65 + hi, 2, VS + hi * 64 + j0 + r32, 128);
#pragma unroll
            for (int r = 0; r < 16; ++r) HS[(i0 + crow32(r, hi)) * 65 + j0 + r32] = acc[r];
        } else if (w == 0) { const int t = lane; float nq = 0.f, ssum = 0.f;
#pragma unroll 8
            for (int k = 0; k < 64; ++k) { nq += NI[k] * QS[t * 65 + k]; ssum += SS[t * 65 + k]; }
            const float den = EI[t] * nq + ssum; DEN[t] = 1.0f / fmaxf(fabsf(den), __expf(-MT[t])); }
        __syncthreads();
        { const int t = F.tid >> 3, vg = (F.tid & 7) * 8; const float rd = DEN[t]; float num[8]; float sq = 0.f;
#pragma unroll
            for (int i = 0; i < 8; ++i) { num[i] = HS[t * 65 + vg + i] * rd; sq += num[i] * num[i]; }
            sq += __shfl_xor(sq, 1); sq += __shfl_xor(sq, 2); sq += __shfl_xor(sq, 4);
            const float rn = 1.0f / sqrtf(sq * (1.0f / 64.0f) + EPS); const size_t row = row0 + t;
            float zo[8]; ld8(Z + row * DINP + ZCO + h * 64 + vg, zo);
            unsigned wv[4];
#pragma unroll
            for (int i = 0; i < 8; i += 2) { const int ch = h * 64 + vg + i; wv[i >> 1] = pk2(num[i] * rn * hg[ch] * sigmoidf_(zo[i]), num[i + 1] * rn * hg[ch + 1] * sigmoidf_(zo[i + 1])); }
            *(v4u*)(AO + row * DM + 512 + h * 64 + vg) = (v4u){wv[0], wv[1], wv[2], wv[3]}; }
    }
    __syncthreads();
}

namespace fa {
typedef short bf16x8 __attribute__((ext_vector_type(8)));
typedef float f32x16 __attribute__((ext_vector_type(16)));
typedef short s16x4 __attribute__((ext_vector_type(4)));
typedef __bf16 bf16x2_t __attribute__((ext_vector_type(2)));
constexpr int KP = 144, VP = 192, KT = 64 * KP, VT = 64 * VP, BUF = KT + VT, LDS_NEED = 2 * BUF;
constexpr float LOG2E = 1.4426950408889634f, LN2 = 0.6931471805599453f;
__device__ __forceinline__ int crow(int r, int hi) { return (r & 3) + 8 * (r >> 2) + 4 * hi; }
__device__ __forceinline__ unsigned cvtpk(float lo, float hi) { f32x2 v = {lo, hi}; bf16x2_t b = __builtin_convertvector(v, bf16x2_t); return __builtin_bit_cast(unsigned, b); }
__device__ __forceinline__ s16x4 vtr(LAS unsigned char* p) { return __builtin_bit_cast(s16x4, __builtin_amdgcn_ds_read_tr16_b64_v4i16((LAS s16x4*)p)); }
__device__ __forceinline__ void load_qf(const bf16* qrow, int hi, bf16x8 (&qf)[4]) {
#pragma unroll
    for (int ks = 0; ks < 4; ++ks) qf[ks] = *(const bf16x8*)(qrow + 16 * ks + 8 * hi);
}
template <int KS0, int KS, class P, int MODE = 0>
__device__ __forceinline__ void stream(const P& p, LAS unsigned char* lds, int tid, float sc, const bf16x8 (&qf)[4], float& m_, float& l_, f32x16 (&O_)[2]) {
    constexpr int NCOMP = 1; float m[1] = {m_}, l[1] = {l_}; f32x16 O[1][2] = {{O_[0], O_[1]}};
    const int lane = tid & 63, r32 = lane & 31, hi = lane >> 5, g = lane >> 4, i16 = lane & 15;
    const int srow = tid >> 3, scx = tid & 7;
    const int koff = r32 * KP + hi * 16;
    const int voff = KT + ((i16 >> 2) + 4 * hi) * VP + (16 * (g & 1) + 4 * (i16 & 3)) * 2;
    const int nt = p.ntiles();
    v4u kr = {0u, 0u, 0u, 0u}, vr = {0u, 0u, 0u, 0u};
#define FA_LOAD(it_) do { const bf16* kp_ = p.krow((it_), srow); const bf16* vp_ = p.vrow((it_), srow); \
        kr = kp_ ? *(const v4u*)(kp_ + 8 * scx) : (v4u){0u, 0u, 0u, 0u}; vr = vp_ ? *(const v4u*)(vp_ + 8 * scx) : (v4u){0u, 0u, 0u, 0u}; } while (0)
#define FA_STORE(b_) do { *(LAS v4u*)(lds + (b_) * BUF + srow * KP + scx * 16) = kr; *(LAS v4u*)(lds + (b_) * BUF + KT + srow * VP + scx * 16) = vr; } while (0)
    __syncthreads();
    if (nt > 0) { FA_LOAD(0); FA_STORE(0); if (nt > 1) FA_LOAD(1); }
    __syncthreads();
#pragma unroll 1
    for (int it = 0; it < nt; ++it) {
        LAS unsigned char* B = lds + (it & 1) * BUF;
        if (!p.wave_skip(it)) {
            const bool msk = p.need_mask(it);
#pragma unroll
            for (int c = 0; c < NCOMP; ++c) {
                f32x16 S[2];
#pragma unroll
                for (int st = 0; st < 2; ++st) {
#pragma unroll
                    for (int r = 0; r < 16; ++r) S[st][r] = 0.f;
#pragma unroll
                    for (int ks = KS0; ks < KS0 + KS; ++ks) { const bf16x8 kf = *(LAS bf16x8*)(B + koff + st * 32 * KP + ks * 32); S[st] = __builtin_amdgcn_mfma_f32_32x32x16_bf16(kf, qf[ks], S[st], 0, 0, 0); }
                }
                if (msk) {
                    int lb, ub; p.bounds(it, lb, ub); lb -= 4 * hi; ub -= 4 * hi;
#pragma unroll
                    for (int st = 0; st < 2; ++st)
#pragma unroll
                        for (int r = 0; r < 16; ++r) { const int cc = 32 * st + (r & 3) + 8 * (r >> 2); if (cc < lb || cc > ub) S[st][r] = -INFINITY; }
                }
                if constexpr (MODE == 1) {
                    const float ms = (m[c] == -INFINITY) ? 0.f : m[c]; const float il = l[c] > 0.f ? 1.0f / l[c] : 0.f;
#pragma unroll
                    for (int st = 0; st < 2; ++st)
#pragma unroll
                        for (int rg = 0; rg < 4; ++rg) {
                            const float p0 = __builtin_amdgcn_exp2f(__builtin_fmaf(S[st][4 * rg], sc, -ms)) * il, p1 = __builtin_amdgcn_exp2f(__builtin_fmaf(S[st][4 * rg + 1], sc, -ms)) * il;
                            const float p2 = __builtin_amdgcn_exp2f(__builtin_fmaf(S[st][4 * rg + 2], sc, -ms)) * il, p3 = __builtin_amdgcn_exp2f(__builtin_fmaf(S[st][4 * rg + 3], sc, -ms)) * il;
                            float qa = p0, qb = p0 + 2.0f * (p1 + p2 + p3);
                            qa += __shfl_xor(qa, 1); qa += __shfl_xor(qa, 2); qb += __shfl_xor(qb, 1); qb += __shfl_xor(qb, 2);
                            const int jp = 8 * (2 * it + st) + 2 * rg + hi;
                            if ((r32 & 3) == 0) { p.impA[p.tokl * 65 + jp] = qa; if (jp < 63) p.impB[p.tokl * 65 + jp + 1] = qb; }
                        }
                } else {
                float tm = S[0][0];
#pragma unroll
                for (int r = 1; r < 16; ++r) tm = fmaxf(tm, S[0][r]);
#pragma unroll
                for (int r = 0; r < 16; ++r) tm = fmaxf(tm, S[1][r]);
                tm = fmaxf(tm, __shfl_xor(tm, 32));
                const float mn = fmaxf(m[c], tm * sc), ms = (mn == -INFINITY) ? 0.f : mn;
                const float alpha = __builtin_amdgcn_exp2f(m[c] - ms);
                m[c] = mn;
                float ps = 0.f;
#pragma unroll
                for (int st = 0; st < 2; ++st)
#pragma unroll
                    for (int r = 0; r < 16; ++r) { const float e = __builtin_amdgcn_exp2f(__builtin_fmaf(S[st][r], sc, -ms)); S[st][r] = e; ps += e; }
                l[c] = l[c] * alpha + ps;
                if (__any(alpha != 1.0f)) {
#pragma unroll
                    for (int dt = 0; dt < 2; ++dt)
#pragma unroll
                        for (int r = 0; r < 16; ++r) O[c][dt][r] *= alpha;
                }
#pragma unroll
                for (int st = 0; st < 2; ++st)
#pragma unroll
                    for (int s = 0; s < 2; ++s) {
                        v4u pw; pw.x = cvtpk(S[st][8 * s], S[st][8 * s + 1]); pw.y = cvtpk(S[st][8 * s + 2], S[st][8 * s + 3]); pw.z = cvtpk(S[st][8 * s + 4], S[st][8 * s + 5]); pw.w = cvtpk(S[st][8 * s + 6], S[st][8 * s + 7]);
                        const bf16x8 pf = __builtin_bit_cast(bf16x8, pw);
#pragma unroll
                        for (int dt = 0; dt < 2; ++dt) {
                            LAS unsigned char* vp = B + voff + (32 * st + 16 * s) * VP + dt * 64;
                            const s16x4 v0 = vtr(vp), v1 = vtr(vp + 8 * VP);
                            const bf16x8 vf = {v0[0], v0[1], v0[2], v0[3], v1[0], v1[1], v1[2], v1[3]};
                            O[c][dt] = __builtin_amdgcn_mfma_f32_32x32x16_bf16(vf, pf, O[c][dt], 0, 0, 0);
                        }
                    }
                }
                if (NCOMP > 1) __builtin_amdgcn_sched_barrier(0);
            }
        }
        if (it + 1 < nt) { FA_STORE((it + 1) & 1); if (it + 2 < nt) FA_LOAD(it + 2); }
        __syncthreads();
    }
#undef FA_LOAD
#undef FA_STORE
    m_ = m[0]; l_ = l[0]; O_[0] = O[0][0]; O_[1] = O[0][1];
}
__device__ __forceinline__ float finish(float l, f32x16 (&O)[2]) {
    const float lt = l + __shfl_xor(l, 32); const float inv = lt > 0.f ? 1.0f / lt : 0.f;
#pragma unroll
    for (int dt = 0; dt < 2; ++dt)
#pragma unroll
        for (int r = 0; r < 16; ++r) O[dt][r] *= inv;
    return lt;
}
__device__ __forceinline__ void store_o(const f32x16 (&O)[2], bf16* out, int hi) {
#pragma unroll
    for (int dt = 0; dt < 2; ++dt)
#pragma unroll
        for (int rg = 0; rg < 4; ++rg) { v2u w; w.x = cvtpk(O[dt][4 * rg], O[dt][4 * rg + 1]); w.y = cvtpk(O[dt][4 * rg + 2], O[dt][4 * rg + 3]); *(v2u*)(out + 32 * dt + 8 * rg + 4 * hi) = w; }
}
}

struct DiffPol {
    const bf16* Zb; int h, t0, wq0, tq;
    __device__ __forceinline__ int ntiles() const { return (t0 + 256) >> 6; }
    __device__ __forceinline__ const bf16* krow(int it, int r) const { return Zb + (size_t)(64 * it + r) * DINP + ZBK + 64 * h; }
    __device__ __forceinline__ const bf16* vrow(int it, int r) const { return Zb + (size_t)(64 * it + r) * DINP + ZBV + 64 * h; }
    __device__ __forceinline__ bool wave_skip(int it) const { return 64 * it > wq0 + 31; }
    __device__ __forceinline__ bool need_mask(int it) const { return 64 * it + 63 > wq0; }
    __device__ __forceinline__ void bounds(int it, int& lb, int& ub) const { lb = 0; ub = tq - 64 * it; }
};
__device__ __forceinline__ void diff_item(Frame& F, const Args& a, int layer, int b, int h, int qb, float lam) {
    PHASE_IDS(F);
    const bf16* Z = (const bf16*)(F.ws + WS_Z); bf16* AO = (bf16*)(F.ws + WS_H);
    const int lane = F.lane, r32 = lane & 31, hi = lane >> 5;
    DiffPol p; p.Zb = Z + (size_t)b * SEQ * DINP; p.h = h; p.t0 = 256 * qb; p.wq0 = p.t0 + 32 * F.wave; p.tq = p.wq0 + r32;
    fa::bf16x8 qf[4]; fa::load_qf(p.Zb + (size_t)p.tq * DINP + ZBQ + 64 * h, hi, qf);
    fa::f32x16 O[2][2];
#pragma unroll
    for (int c = 0; c < 2; ++c)
#pragma unroll
        for (int dt = 0; dt < 2; ++dt)
#pragma unroll
            for (int r = 0; r < 16; ++r) O[c][dt][r] = 0.f;
    { float m = -INFINITY, l = 0.f; fa::stream<0, 2, DiffPol>(p, F.lds3, F.tid, 0.17677669529663687f * fa::LOG2E, qf, m, l, O[0]); fa::finish(l, O[0]); }
    { float m = -INFINITY, l = 0.f; fa::stream<2, 2, DiffPol>(p, F.lds3, F.tid, 0.17677669529663687f * fa::LOG2E, qf, m, l, O[1]); fa::finish(l, O[1]); }
    const float lam_init = 0.8f - 0.6f * expf(-0.3f * (float)layer);
    const float* sg = a.in[6] + (size_t)layer * 64;
    float ss = 0.f;
#pragma unroll
    for (int dt = 0; dt < 2; ++dt)
#pragma unroll
        for (int r = 0; r < 16; ++r) { const float v = O[0][dt][r] - lam * O[1][dt][r]; O[0][dt][r] = v; ss += v * v; }
    ss += __shfl_xor(ss, 32);
    const float rn = (1.0f / sqrtf(ss * (1.0f / 64.0f) + EPS)) * (1.0f - lam_init);
#pragma unroll
    for (int dt = 0; dt < 2; ++dt)
#pragma unroll
        for (int r = 0; r < 16; ++r) O[0][dt][r] *= rn * sg[32 * dt + fa::crow(r, hi)];
    fa::store_o(O[0], AO + ((size_t)b * SEQ + p.tq) * DM + 256 + 64 * h, hi);
}
struct DilPol {
    const bf16* Zb; int h, dil, res, it0, nt, wi0, iq;
    __device__ __forceinline__ int ntiles() const { return nt; }
    __device__ __forceinline__ const bf16* krow(int it, int r) const { const int ik = 64 * (it0 + it) + r; return Zb + (size_t)(res + dil * ik) * DINP + ZDK + 64 * h; }
    __device__ __forceinline__ const bf16* vrow(int it, int r) const { const int ik = 64 * (it0 + it) + r; return Zb + (size_t)(res + dil * ik) * DINP + ZDV + 64 * h; }
    __device__ __forceinline__ bool wave_skip(int it) const { const int k0 = 64 * (it0 + it); return k0 > wi0 + 31 || k0 + 63 < wi0 - 128; }
    __device__ __forceinline__ bool need_mask(int) const { return true; }
    __device__ __forceinline__ void bounds(int it, int& lb, int& ub) const { ub = iq - 64 * (it0 + it); lb = ub - 128; }
};
__device__ __forceinline__ void dil_item(Frame& F, int b, int h, int g, int res, int blk) {
    PHASE_IDS(F);
    const bf16* Z = (const bf16*)(F.ws + WS_Z); bf16* DP = (bf16*)(F.ws + WS_DPART); float* DL = (float*)(F.ws + WS_DLSE);
    const int lane = F.lane, r32 = lane & 31, hi = lane >> 5;
    DilPol p; p.Zb = Z + (size_t)b * SEQ * DINP; p.h = h; p.dil = (g == 0) ? 1 : (g == 1) ? 4 : 16; p.res = res;
    const int i0 = 256 * blk; const int t_lo = (i0 >> 6) - 2; p.it0 = t_lo < 0 ? 0 : t_lo; p.nt = (i0 >> 6) + 4 - p.it0;
    p.wi0 = i0 + 32 * F.wave; p.iq = p.wi0 + r32;
    const int tq = res + p.dil * p.iq; const size_t row = (size_t)b * SEQ + tq;
    fa::bf16x8 qf[4]; fa::load_qf(p.Zb + (size_t)tq * DINP + ZDQ + 64 * h, hi, qf);
    float m = -INFINITY, l = 0.f; fa::f32x16 O[2];
#pragma unroll
    for (int dt = 0; dt < 2; ++dt)
#pragma unroll
        for (int r = 0; r < 16; ++r) O[dt][r] = 0.f;
    fa::stream<0, 4, DilPol>(p, F.lds3, F.tid, 0.125f * fa::LOG2E, qf, m, l, O);
    const float lt = fa::finish(l, O);
    fa::store_o(O, DP + ((size_t)g * T + row) * 256 + 64 * h, hi);
    if (hi == 0) DL[((size_t)g * T + row) * 4 + h] = (m + __log2f(lt)) * fa::LN2;
}
__device__ __forceinline__ void dil_combine(Frame& F) {
    PHASE_IDS(F);
    const bf16* DP = (const bf16*)(F.ws + WS_DPART); const float* DL = (const float*)(F.ws + WS_DLSE); bf16* AO = (bf16*)(F.ws + WS_H);
    const int gt = F.gw * 64 + F.lane, ngt = F.ngw * 64;
    for (int i = gt; i < T * 32; i += ngt) { const int row = i >> 5, c8 = (i & 31) * 8, h = c8 >> 6;
        const float l0 = DL[(size_t)row * 4 + h], l1 = DL[((size_t)T + row) * 4 + h], l2 = DL[((size_t)2 * T + row) * 4 + h];
        const float mx = fmaxf(l0, fmaxf(l1, l2)); float w0 = __expf(l0 - mx), w1 = __expf(l1 - mx), w2 = __expf(l2 - mx); const float inv = 1.0f / (w0 + w1 + w2); w0 *= inv; w1 *= inv; w2 *= inv;
        float x0[8], x1[8], x2[8]; ld8(DP + (size_t)row * 256 + c8, x0); ld8(DP + ((size_t)T + row) * 256 + c8, x1); ld8(DP + ((size_t)2 * T + row) * 256 + c8, x2);
        v4u o; o.x = pk2(w0 * x0[0] + w1 * x1[0] + w2 * x2[0], w0 * x0[1] + w1 * x1[1] + w2 * x2[1]); o.y = pk2(w0 * x0[2] + w1 * x1[2] + w2 * x2[2], w0 * x0[3] + w1 * x1[3] + w2 * x2[3]);
        o.z = pk2(w0 * x0[4] + w1 * x1[4] + w2 * x2[4], w0 * x0[5] + w1 * x1[5] + w2 * x2[5]); o.w = pk2(w0 * x0[6] + w1 * x1[6] + w2 * x2[6], w0 * x0[7] + w1 * x1[7] + w2 * x2[7]);
        *(v4u*)(AO + (size_t)row * DM + 768 + c8) = o; }
}
struct CmpPol {
    const bf16* KCb; const bf16* VCb; int nt, ubg; float* impA; float* impB; int tokl; bool nov;
    __device__ __forceinline__ int ntiles() const { return nt; }
    __device__ __forceinline__ const bf16* krow(int it, int r) const { return KCb + (size_t)(64 * it + r) * 64; }
    __device__ __forceinline__ const bf16* vrow(int it, int r) const { return nov ? nullptr : VCb + (size_t)(64 * it + r) * 64; }
    __device__ __forceinline__ bool wave_skip(int) const { return false; }
    __device__ __forceinline__ bool need_mask(int) const { return true; }
    __device__ __forceinline__ void bounds(int it, int& lb, int& ub) const { lb = 0; ub = ubg - 64 * it; }
};
struct SlcPol {
    const bf16* Zb; const unsigned char* list; int nt, t; unsigned wlo, whi, mlo, mhi;
    __device__ __forceinline__ int ntiles() const { return nt; }
    __device__ __forceinline__ const bf16* krow(int it, int r) const { const int j = list[it]; return Zb + (size_t)(64 * j + r) * DINP + ZKS; }
    __device__ __forceinline__ const bf16* vrow(int it, int r) const { const int j = list[it]; return Zb + (size_t)(64 * j + r) * DINP + ZVS; }
    __device__ __forceinline__ bool wave_skip(int it) const { const int j = list[it]; return !(((j < 32) ? (wlo >> j) : (whi >> (j - 32))) & 1u); }
    __device__ __forceinline__ bool need_mask(int) const { return true; }
    __device__ __forceinline__ void bounds(int it, int& lb, int& ub) const { const int j = list[it]; const unsigned bit = ((j < 32) ? (mlo >> j) : (mhi >> (j - 32))) & 1u; lb = 0; ub = bit ? t - 64 * j : -1; }
};
struct WinPol {
    const bf16* Zb; int jt0, nt, t;
    __device__ __forceinline__ int ntiles() const { return nt; }
    __device__ __forceinline__ const bf16* krow(int it, int r) const { return Zb + (size_t)(64 * (jt0 + it) + r) * DINP + ZKW; }
    __device__ __forceinline__ const bf16* vrow(int it, int r) const { return Zb + (size_t)(64 * (jt0 + it) + r) * DINP + ZVW; }
    __device__ __forceinline__ bool wave_skip(int) const { return false; }
    __device__ __forceinline__ bool need_mask(int) const { return true; }
    __device__ __forceinline__ void bounds(int it, int& lb, int& ub) const { ub = t - 64 * (jt0 + it); lb = ub - 511; }
};
constexpr int NSA_IMP_OFF = 45056, NSA_SEL_OFF = NSA_IMP_OFF + 2 * 64 * 65 * 4, NSA_LIST_OFF = NSA_SEL_OFF + 512;
static_assert(fa::LDS_NEED <= NSA_IMP_OFF && NSA_LIST_OFF + 64 <= RING_BYTES, "NSA LDS map");
__device__ __forceinline__ void nsa_item(Frame& F, int b, int c) {
    PHASE_IDS(F);
    const bf16* Z = (const bf16*)(F.ws + WS_Z); const bf16* AQR = (const bf16*)(F.ws + WS_AQR); bf16* AO = (bf16*)(F.ws + WS_H);
    const bf16* KCB = (const bf16*)(F.ws + WS_KC) + (size_t)b * 256 * 64; const bf16* VCB = (const bf16*)(F.ws + WS_VC) + (size_t)b * 256 * 64;
    const int lane = F.lane, r32 = lane & 31, hi = lane >> 5, tokl = 8 * F.wave + (r32 >> 2), h = r32 & 3, t = 64 * c + tokl; const size_t row = (size_t)b * SEQ + t;
    const bf16* Zb = Z + (size_t)b * SEQ * DINP;
    float* impA = (float*)(F.lds + NSA_IMP_OFF); float* impB = impA + 64 * 65;
    unsigned long long* sel = (unsigned long long*)(F.lds + NSA_SEL_OFF); unsigned char* list = F.lds + NSA_LIST_OFF;
    for (int i = F.tid; i < 2 * 64 * 65; i += NTHREADS) impA[i] = 0.f;
    const bf16* zr = Zb + (size_t)t * DINP;
    const float g0 = sigmoidf_(bf2f(zr[ZAG + h])), g1 = sigmoidf_(bf2f(zr[ZAG + 4 + h])), g2 = sigmoidf_(bf2f(zr[ZAG + 8 + h]));
    fa::f32x16 acc[2], O[2];
    {
        CmpPol cp; cp.KCb = KCB; cp.VCb = VCB; cp.nt = (4 * c + 2 + 64) >> 6; cp.ubg = t >= 31 ? ((t - 31) >> 4) : -1; cp.impA = impA; cp.impB = impB; cp.tokl = tokl; cp.nov = false;
        fa::bf16x8 qf[4]; fa::load_qf(zr + ZAQ + 64 * h, hi, qf);
        float m = -INFINITY, l = 0.f;
#pragma unroll
        for (int dt = 0; dt < 2; ++dt)
#pragma unroll
            for (int r = 0; r < 16; ++r) O[dt][r] = 0.f;
        fa::stream<0, 4, CmpPol, 0>(cp, F.lds3, F.tid, 0.125f * fa::LOG2E, qf, m, l, O);
        float lt = fa::finish(l, O);
#pragma unroll
        for (int dt = 0; dt < 2; ++dt)
#pragma unroll
            for (int r = 0; r < 16; ++r) acc[dt][r] = g0 * O[dt][r];
        cp.nov = true;
        fa::stream<0, 4, CmpPol, 1>(cp, F.lds3, F.tid, 0.125f * fa::LOG2E, qf, m, lt, O);
    }
    __syncthreads();
#pragma unroll 1
    for (int tk = 0; tk < 8; ++tk) {
        const int tl = 8 * F.wave + tk, j = lane; const float imp = impA[tl * 65 + j] + impB[tl * 65 + j];
        const bool forced = (j == 0) || (j <= c && j > c - 2);
        const float sc = (j > c) ? -1.0e6f : (forced ? 1.0e6f : imp);
        int rank = 0;
#pragma unroll 8
        for (int i = 0; i < 64; ++i) { const float si = __shfl(sc, i); rank += (si > sc || (si == sc && i < j)) ? 1 : 0; }
        const unsigned long long mask = __ballot(rank < 16 && j <= c);
        if (lane == 0) sel[tl] = mask;
    }
    __syncthreads();
    SlcPol sp; sp.Zb = Zb; sp.list = list; sp.t = t;
    { const unsigned long long mk = sel[tokl]; sp.mlo = (unsigned)mk; sp.mhi = (unsigned)(mk >> 32);
      unsigned wl = sp.mlo, wh = sp.mhi; wl |= __shfl_xor(wl, 4); wh |= __shfl_xor(wh, 4); wl |= __shfl_xor(wl, 8); wh |= __shfl_xor(wh, 8); wl |= __shfl_xor(wl, 16); wh |= __shfl_xor(wh, 16);
      sp.wlo = __builtin_amdgcn_readfirstlane(wl); sp.whi = __builtin_amdgcn_readfirstlane(wh);
      const unsigned long long mu = sel[lane]; unsigned ul = (unsigned)mu, uh = (unsigned)(mu >> 32);
#pragma unroll
      for (int o = 1; o < 64; o <<= 1) { ul |= __shfl_xor(ul, o); uh |= __shfl_xor(uh, o); }
      ul = __builtin_amdgcn_readfirstlane(ul); uh = __builtin_amdgcn_readfirstlane(uh);
      const unsigned long long un = ((unsigned long long)uh << 32) | ul;
      if ((un >> lane) & 1ull) list[__popcll(un & ((1ull << lane) - 1ull))] = (unsigned char)lane;
      sp.nt = __popcll(un); }
    fa::bf16x8 qf[4]; fa::load_qf(AQR + row * 256 + 64 * h, hi, qf);
    { float m = -INFINITY, l = 0.f;
#pragma unroll
      for (int dt = 0; dt < 2; ++dt)
#pragma unroll
          for (int r = 0; r < 16; ++r) O[dt][r] = 0.f;
      fa::stream<0, 4, SlcPol, 0>(sp, F.lds3, F.tid, 0.125f * fa::LOG2E, qf, m, l, O); fa::finish(l, O);
#pragma unroll
      for (int dt = 0; dt < 2; ++dt)
#pragma unroll
          for (int r = 0; r < 16; ++r) acc[dt][r] += g1 * O[dt][r]; }
    { WinPol wp; wp.Zb = Zb; wp.jt0 = c >= 8 ? c - 8 : 0; wp.nt = c - wp.jt0 + 1; wp.t = t;
      float m = -INFINITY, l = 0.f;
#pragma unroll
      for (int dt = 0; dt < 2; ++dt)
#pragma unroll
          for (int r = 0; r < 16; ++r) O[dt][r] = 0.f;
      fa::stream<0, 4, WinPol, 0>(wp, F.lds3, F.tid, 0.125f * fa::LOG2E, qf, m, l, O); fa::finish(l, O);
#pragma unroll
      for (int dt = 0; dt < 2; ++dt)
#pragma unroll
          for (int r = 0; r < 16; ++r) acc[dt][r] += g2 * O[dt][r]; }
    fa::store_o(acc, AO + row * DM + 64 * h, hi);
}
__device__ __forceinline__ void scan_item(Frame& F, int it) {
    PHASE_IDS(F);
    float* CLOC = (float*)(F.ws + WS_CLOC); float* NLOC = (float*)(F.ws + WS_NLOC);
    const float* ACH = (const float*)(F.ws + WS_ACH); const float* MLOC = (const float*)(F.ws + WS_MLOC); float* MIN = (float*)(F.ws + WS_MIN);
    const int bh = it >> 2, qt = it & 3; const int e0 = qt * 1024 + F.tid * 2;
    float c0 = 0.f, c1 = 0.f, nst = 0.f, mst = 0.f;
#pragma unroll 1
    for (int cb = 0; cb < 64; cb += 16) {
        f32x2 cl[16]; float ac[16], ml[16], nl[16];
#pragma unroll
        for (int u = 0; u < 16; ++u) { const int ci = bh * 64 + cb + u; cl[u] = *(const f32x2*)(CLOC + (size_t)ci * 4096 + e0); ac[u] = ACH[ci]; ml[u] = MLOC[ci]; nl[u] = (qt == 0 && F.tid < 64) ? NLOC[ci * 64 + F.tid] : 0.f; }
#pragma unroll
        for (int u = 0; u < 16; ++u) { const int ci = bh * 64 + cb + u;
            const float mn = fmaxf(ac[u] + mst, ml[u]), decay = __expf(ac[u] + mst - mn), fresh = __expf(ml[u] - mn);
            *(f32x2*)(CLOC + (size_t)ci * 4096 + e0) = (f32x2){c0, c1}; c0 = decay * c0 + fresh * cl[u].x; c1 = decay * c1 + fresh * cl[u].y;
            if (qt == 0 && F.tid < 64) { NLOC[ci * 64 + F.tid] = nst; nst = decay * nst + fresh * nl[u]; if (F.tid == 0) MIN[ci] = mst; }
            mst = mn; }
    }
}
struct QOrder { unsigned short v[64 + 256 + 256 + 768]; };
constexpr QOrder make_order() {
    QOrder o{}; int n = 0, id = 0, in = 0;
    for (int k = 0; k < 64; ++k) o.v[n++] = (unsigned short)((3 << 12) | k);
    while (id < 256 || in < 256) {
        const int cd = id < 256 ? 96 * (15 - id / 16 + 1) : -1, cn = in < 256 ? 16 * (63 - in / 4 + 18) : -1;
        if (cd >= cn) { o.v[n++] = (unsigned short)((0 << 12) | id); ++id; } else { o.v[n++] = (unsigned short)((1 << 12) | in); ++in; }
    }
    for (int k = 0; k < 768; ++k) o.v[n++] = (unsigned short)((2 << 12) | k);
    return o;
}
__device__ const QOrder g_order = make_order();
__device__ __forceinline__ void ph_d_queue(Frame& F, const Args& a, int layer) {
    PHASE_IDS(F);
    unsigned* ctr = F.ctl + CW_Q + 64 * layer;
    const float* lv = a.in[5] + (size_t)layer * 128;
    const float lam_init = 0.8f - 0.6f * expf(-0.3f * (float)layer);
    float l01 = 0.f, l23 = 0.f; if (F.lane < 32) { l01 = lv[F.lane] * lv[32 + F.lane]; l23 = lv[64 + F.lane] * lv[96 + F.lane]; }
    const float lam = expf(wave_sum(l01)) - expf(wave_sum(l23)) + lam_init;
    constexpr int NQ = 64 + 256 + 256 + 768;
    for (;;) {
        __syncthreads();
        if (F.tid == 0) F.MISC[0] = __hip_atomic_fetch_add(ctr, 1u, __ATOMIC_RELAXED, __HIP_MEMORY_SCOPE_AGENT);
        __syncthreads();
        const int qi = (int)F.MISC[0];
        if (qi >= NQ) break;
        const int e = g_order.v[qi], ty = e >> 12, id = e & 4095;
        if (ty == 3) scan_item(F, id);
        else if (ty == 0) { const int qb = 15 - (id >> 4), bh = id & 15; diff_item(F, a, layer, bh >> 2, bh & 3, qb, lam); }
        else if (ty == 1) nsa_item(F, id & 3, 63 - (id >> 2));
        else { const int bh = id & 15, k = id >> 4;
            const int g = k >> 4, j = k & 15; const int res = (g == 0) ? 0 : (g == 1) ? (j & 3) : j, blk = (g == 0) ? j : (g == 1) ? (j >> 2) : 0;
            dil_item(F, bh >> 2, bh & 3, g, res, blk); }
    }
    __syncthreads();
}

constexpr int NPHASE = 9 * DEPTH + 1;
#ifndef PH_LO
#define PH_LO 0
#endif
#ifndef PH_HI
#define PH_HI NPHASE
#endif
#define IN(k) (PH_LO <= (k) && (k) < PH_HI)
#ifdef PROBE_K
#ifndef PROBE_SUB
#define PROBE_SUB 0
#endif
#ifndef PROBE_AMP
#define PROBE_AMP 10
#endif
#define PROBE_T0(k) do { if ((k) == PROBE_K) F.pt0 = __builtin_amdgcn_s_memrealtime(); } while (0)
#define PROBE_T1(k) do { if ((k) == PROBE_K) F.pdt = __builtin_amdgcn_s_memrealtime() - F.pt0; } while (0)
#define SUBP(id, call) do { if (layer == 0 && (id) == PROBE_SUB) { F.pt0 = __builtin_amdgcn_s_memrealtime(); call; __syncthreads(); F.pdt = __builtin_amdgcn_s_memrealtime() - F.pt0; } else { call; } } while (0)
#else
#define SUBP(id, call) do { call; } while (0)
#define PROBE_T0(k) do { } while (0)
#define PROBE_T1(k) do { } while (0)
#endif
#define SEAM(k) do { if (IN(k) && (k) + 1 < PH_HI) { if ((k) == PH_LO) cg::this_grid().sync(); xcd_barrier(bar); } } while (0)
template <int layer> __device__ __forceinline__ void run_layer(Frame& F, const Args& args, const XcdBarrier& bar) {
    float* XR = args.out;
    bf16* H = (bf16*)(F.ws + WS_H); bf16* Z = (bf16*)(F.ws + WS_Z);
    bf16* WIN = (bf16*)(F.ws + WS_WIN); bf16* WOUT = (bf16*)(F.ws + WS_WOUT); bf16* WGU = (bf16*)(F.ws + WS_WGU); bf16* WD = (bf16*)(F.ws + WS_WD);

        const int P = 9 * layer;
        bf16* XB2 = (bf16*)(F.ws + WS_XB2); bf16* ACT = (bf16*)(F.ws + WS_ACT);
        PROBE_T0(P + 0);
        if (IN(P + 0)) {
            convert_weights(F, args, layer);
            if (layer == 0) build_rope(F, args);
            norm_rows_bf16(F, layer == 0 ? args.in[0] : XR, args.in[1] + (size_t)layer * DM, H);
        }
        SEAM(P + 0); PROBE_T1(P + 0);
        PROBE_T0(P + 1);
        if (IN(P + 1)) {
            pg8::Gemm g{H, WIN, T, DINP, DM}; pg8::StaticOrder S; S.init(T, DINP, F.G, (int)blockIdx.x);
            pg8::EpiZR E{Z, DINP, (const float*)(F.ws + WS_ROPE64), (const float*)(F.ws + WS_ROPE32), (bf16*)(F.ws + WS_AQR)};
            pg8::gemm_phase<pg8::EpiZR, pg8::StaticOrder, true, true>(F.lds3, g, S, E);
        }
        SEAM(P + 1); PROBE_T1(P + 1);
        PROBE_T0(P + 2);
        if (IN(P + 2)) { SUBP(1, prep_mlstm(F, args, layer)); SUBP(2, prep_compress(F, args, layer)); }
        SEAM(P + 2); PROBE_T1(P + 2);
        PROBE_T0(P + 3);
        if (IN(P + 3)) ph_d_queue(F, args, layer);
        SEAM(P + 3); PROBE_T1(P + 3);
        PROBE_T0(P + 4);
        if (IN(P + 4)) { SUBP(4, ph_mlstm_out(F, args, layer)); SUBP(5, dil_combine(F)); }
        SEAM(P + 4); PROBE_T1(P + 4);
        PROBE_T0(P + 5);
        if (IN(P + 5)) {
            pg8::Gemm g{H, WOUT, T, DM, DM}; pg8::StaticOrder S; S.init(T, DM, F.G, (int)blockIdx.x); pg8::EpiRes E{layer == 0 ? args.in[0] : XR, XR, DM};
            pg8::gemm_phase<pg8::EpiRes, pg8::StaticOrder, true, true>(F.lds3, g, S, E);
        }
        SEAM(P + 5); PROBE_T1(P + 5);
        PROBE_T0(P + 6);
        if (IN(P + 6)) norm_rows_bf16(F, XR, args.in[14] + (size_t)layer * DM, XB2);
        SEAM(P + 6); PROBE_T1(P + 6);
        PROBE_T0(P + 7);
        if (IN(P + 7)) {
            pg8::Gemm g{XB2, WGU, T, 2 * DFF, DM}; pg8::StaticOrder S; S.init(T, 2 * DFF, F.G, (int)blockIdx.x); pg8::EpiSwiGLU E{ACT, DFF};
            pg8::gemm_phase<pg8::EpiSwiGLU, pg8::StaticOrder, true, true>(F.lds3, g, S, E);
        }
        SEAM(P + 7); PROBE_T1(P + 7);
        PROBE_T0(P + 8);
        if (IN(P + 8)) {
            pg8::Gemm g{ACT, WD, T, DM, DFF}; pg8::StaticOrder S; S.init(T, DM, F.G, (int)blockIdx.x); pg8::EpiRes E{XR, XR, DM};
            pg8::gemm_phase<pg8::EpiRes, pg8::StaticOrder, true, true>(F.lds3, g, S, E);
        }
        SEAM(P + 8); PROBE_T1(P + 8);
}
__global__ void __launch_bounds__(NTHREADS, 2) fwd_kernel(Args args) {
    extern __shared__ __attribute__((aligned(16))) unsigned char lds[];
    Frame F;
    F.lds = lds; F.lds3 = (LAS unsigned char*)lds; F.MISC = (volatile LAS unsigned*)(F.lds3 + MISC_OFF);
    F.tid = threadIdx.x; F.lane = F.tid & 63; F.wave = __builtin_amdgcn_readfirstlane(F.tid >> 6);
    F.G = gridDim.x; F.gw = blockIdx.x * NWAVES + F.wave; F.ngw = F.G * NWAVES;
    F.ws = args.ws; F.ctl = (unsigned*)(args.ws + WS_CTL);
    for (int u = F.tid; u < (LDS_BYTES - LDSCTL_OFF) / 4; u += NTHREADS) ((LAS unsigned*)(F.lds3 + LDSCTL_OFF))[u] = 0u;
    __syncthreads();
    XcdBarrier bar = xcd_barrier_post(F.ctl + CW_BAR, F.MISC + 8);
    run_layer<0>(F, args, bar);
    run_layer<1>(F, args, bar);
    if (IN(9 * DEPTH)) final_norm(F, args.out, args.in[18]);
#ifdef PROBE_K
    if (blockIdx.x == 0) { const unsigned long long te = __builtin_amdgcn_s_memrealtime(); while (__builtin_amdgcn_s_memrealtime() - te < (unsigned long long)PROBE_AMP * F.pdt) __builtin_amdgcn_s_sleep(32); }
#endif
#undef IN
#undef SEAM
}

extern "C" void kernel_launch(void* const* d_in, const int* in_sizes, int n_in, void* d_out, int out_size, void* d_ws, size_t ws_size, hipStream_t stream) {
    static int grid = 0;
    if (grid == 0) {
        if (n_in != 19 || in_sizes[0] != T * DM || out_size != T * DM || ws_size < WS_END) { fprintf(stderr, "kernel_launch: unexpected shapes (n_in %d, in0 %d, out %d, ws %zu); nothing launched\n", n_in, n_in > 0 ? in_sizes[0] : -1, out_size, ws_size); grid = -1; return; }
        int dev = 0, cus = 0, per_cu = 0;
        if (hipGetDevice(&dev) != hipSuccess || hipDeviceGetAttribute(&cus, hipDeviceAttributeMultiprocessorCount, dev) != hipSuccess) { grid = -1; return; }
        if (hipFuncSetAttribute((const void*)fwd_kernel, hipFuncAttributeMaxDynamicSharedMemorySize, LDS_BYTES) != hipSuccess) { fprintf(stderr, "kernel_launch: hipFuncSetAttribute failed\n"); grid = -1; return; }
        if (hipOccupancyMaxActiveBlocksPerMultiprocessor(&per_cu, (const void*)fwd_kernel, NTHREADS, LDS_BYTES) != hipSuccess || per_cu < 1) { fprintf(stderr, "kernel_launch: note: occupancy query says %d blocks per CU\n", per_cu); (void)hipGetLastError(); }
        grid = cus;
    }
    if (grid < 0) return;
    if (hipMemsetAsync((char*)d_ws + WS_CTL, 0, CTL_ZERO_BYTES, stream) != hipSuccess) { fprintf(stderr, "kernel_launch: memset failed\n"); return; }
    Args a{};
    for (int i = 0; i < 19; ++i) a.in[i] = (const float*)d_in[i];
    a.out = (float*)d_out; a.ws = (unsigned char*)d_ws;
    for (int i = 0; i < 32; ++i) a.inv64[i] = 1.0f / powf(10000.0f, (float)(2 * i) / 64.0f);
    for (int i = 0; i < 16; ++i) a.inv32[i] = 1.0f / powf(10000.0f, (float)(2 * i) / 32.0f);
    void* params[] = {&a};
    const hipError_t le = hipLaunchCooperativeKernel((const void*)fwd_kernel, dim3(grid), dim3(NTHREADS), params, LDS_BYTES, stream);
    if (le != hipSuccess) fprintf(stderr, "kernel_launch: cooperative launch failed: %s (grid %d)\n", hipGetErrorName(le), grid);
}
```

```cpp
#include <hip/hip_runtime.h>
#include <hip/hip_cooperative_groups.h>
#include <cstdio>
#include <cstdint>
namespace cg = cooperative_groups;
namespace pg8 {
#define PG8_LAS __attribute__((address_space(3)))
typedef unsigned short bf16_t;
typedef short bf16x8 __attribute__((ext_vector_type(8)));
typedef float f32x4 __attribute__((ext_vector_type(4)));
typedef unsigned u32x4 __attribute__((ext_vector_type(4)));
constexpr int BM = 256, BK = 64, HALF = 128, HTB = HALF * BK * 2  , STAGE_BYTES = 8 * HTB, NXCD = 8, WGM = 8;

__host__ __device__ __forceinline__ int lds_byte(int r, int c) { const int st = (r >> 4) * 2 + (c >> 5), rr = r & 15, cc = c & 31, ob = rr * 64 + cc * 2; return st * 1024 + (ob ^ (((ob >> 9) & 1) << 5)); }
__host__ __device__ __forceinline__ void stage_rc(int b, int& R, int& C) { const int st = b / 1024, sb = b % 1024, swz = sb ^ (((sb >> 9) & 1) << 5); R = (st >> 1) * 16 + swz / 64; C = (st & 1) * 32 + (swz % 64) / 2; }
__host__ __device__ __forceinline__ int perm32(int rho) { const int n = rho >> 4, i = rho & 15; return 8 * (i >> 2) + 4 * n + (i & 3); }

struct Unit { int pm, pn; };
struct Gemm { const bf16_t* A; const bf16_t* Bt; int M, N, K; };

struct StaticOrder {
    int nM, nN, nwg, G, c;
    __host__ __device__ void init(int M, int N, int G_, int c_) { nM = M / BM; nN = N / BM; nwg = nM * nN; G = G_; c = c_; }
    __host__ __device__ bool next(int i, Unit& u) const {
        const long L = (long)i * G + c; if (L >= nwg) return false;
        int wgid = (int)L; { const int q = nwg / NXCD, r = nwg % NXCD, xcd = wgid % NXCD, off = wgid / NXCD; wgid = (xcd < r ? xcd * (q + 1) : r * (q + 1) + (xcd - r) * q) + off; }
        const int nig = WGM * nN, gid = wgid / nig, fm = gid * WGM, gsz = (nM - fm) < WGM ? (nM - fm) : WGM;
        u.pm = fm + ((wgid % nig) % gsz); u.pn = (wgid % nig) / gsz; return true;
    }
    __device__ __forceinline__ void a_ready(const Unit&) const {}
    __device__ __forceinline__ void done(const Unit&) const {}
};

__device__ __forceinline__ unsigned cvt_pk_bf16(float lo, float hi) { unsigned r; asm volatile("v_cvt_pk_bf16_f32 %0, %1, %2" : "=v"(r) : "v"(lo), "v"(hi)); return r; }
typedef float f32x2 __attribute__((ext_vector_type(2)));
struct EpiZR {
    static constexpr bool PERM = true, AFTER_DRAIN = false;
    bf16_t* O; int ldc; const float* r64; const float* r32; bf16_t* aqr;
    __device__ __forceinline__ void operator()(const f32x4 (&acc)[2][2][4][2], const Unit& u, int wr, int wc, int fr, int fq) const {
        const int row0 = u.pm * BM + wr * 64 + fr, col0 = u.pn * BM + wc * 32 + 8 * fq;
        constexpr unsigned long long R64 = 0xFull | (1ull << 6) | (1ull << 8) | (0xFFull << 34), R32 = 0xFFull << 10;
#pragma unroll
        for (int ai = 0; ai < 2; ++ai)
#pragma unroll
            for (int m = 0; m < 4; ++m) { const int row = row0 + ai * HALF + m * 16; const int pos = row & 4095; bf16_t* rowp = O + (size_t)row * ldc + col0;
#pragma unroll
                for (int bj = 0; bj < 2; ++bj) { f32x4 v0 = acc[ai][bj][m][0], v1 = acc[ai][bj][m][1]; const int c0 = col0 + bj * HALF, seg = c0 >> 6;
                    const bool t64 = (R64 >> seg) & 1ull, t32 = (R32 >> seg) & 1ull;
                    if (t64 || t32) {
                        const float* tp = t64 ? r64 + ((size_t)pos * 32 + ((c0 & 63) >> 1)) * 2 : r32 + ((size_t)pos * 16 + ((c0 & 31) >> 1)) * 2;
                        const f32x4 ca = *(const f32x4*)tp, cb = *(const f32x4*)(tp + 4);
                        const f32x4 o0 = {v0[0] * ca[0] - v0[1] * ca[1], v0[0] * ca[1] + v0[1] * ca[0], v0[2] * ca[2] - v0[3] * ca[3], v0[2] * ca[3] + v0[3] * ca[2]};
                        const f32x4 o1 = {v1[0] * cb[0] - v1[1] * cb[1], v1[0] * cb[1] + v1[1] * cb[0], v1[2] * cb[2] - v1[3] * cb[3], v1[2] * cb[3] + v1[3] * cb[2]};
                        if (seg < 4) { u32x4 wq; wq.x = cvt_pk_bf16(o0[0], o0[1]); wq.y = cvt_pk_bf16(o0[2], o0[3]); wq.z = cvt_pk_bf16(o1[0], o1[1]); wq.w = cvt_pk_bf16(o1[2], o1[3]); *(u32x4*)(aqr + (size_t)row * 256 + c0) = wq; }
                        else { v0 = o0; v1 = o1; }
                    }
                    u32x4 w; w.x = cvt_pk_bf16(v0[0], v0[1]); w.y = cvt_pk_bf16(v0[2], v0[3]); w.z = cvt_pk_bf16(v1[0], v1[1]); w.w = cvt_pk_bf16(v1[2], v1[3]);
                    *(u32x4*)(rowp + bj * HALF) = w; } }
    }
};
struct EpiRes {
    static constexpr bool PERM = false, AFTER_DRAIN = false;
    const float* base; float* out; int ldc;
    __device__ __forceinline__ void operator()(const f32x4 (&acc)[2][2][4][2], const Unit& u, int wr, int wc, int fr, int fq) const {
        const int row0 = u.pm * BM + wr * 64 + fr, col0 = u.pn * BM + wc * 32 + 4 * fq;
#pragma unroll
        for (int ai = 0; ai < 2; ++ai)
#pragma unroll
            for (int m = 0; m < 4; ++m) { const size_t off = (size_t)(row0 + ai * HALF + m * 16) * ldc + col0;
#pragma unroll
                for (int bj = 0; bj < 2; ++bj)
#pragma unroll
                    for (int n = 0; n < 2; ++n) { const size_t p = off + bj * HALF + n * 16; const f32x4 b = *(const f32x4*)(base + p); *(f32x4*)(out + p) = b + acc[ai][bj][m][n]; } }
    }
};
struct EpiSwiGLU {
    static constexpr bool PERM = true, AFTER_DRAIN = false;
    bf16_t* O; int ldc;
    __device__ __forceinline__ void operator()(const f32x4 (&acc)[2][2][4][2], const Unit& u, int wr, int wc, int fr, int fq) const {
        const int row0 = u.pm * BM + wr * 64 + fr, col0 = u.pn * HALF + wc * 32 + 8 * fq;
#pragma unroll
        for (int ai = 0; ai < 2; ++ai)
#pragma unroll
            for (int m = 0; m < 4; ++m) { const int row = row0 + ai * HALF + m * 16; bf16_t* rowp = O + (size_t)row * ldc + col0;
                float r[8];
#pragma unroll
                for (int n = 0; n < 2; ++n)
#pragma unroll
                    for (int j = 0; j < 4; ++j) { const float g = acc[ai][0][m][n][j], up = acc[ai][1][m][n][j]; r[4 * n + j] = g * __builtin_amdgcn_rcpf(1.0f + __expf(-g)) * up; }
                u32x4 w; w.x = cvt_pk_bf16(r[0], r[1]); w.y = cvt_pk_bf16(r[2], r[3]); w.z = cvt_pk_bf16(r[4], r[5]); w.w = cvt_pk_bf16(r[6], r[7]);
                *(u32x4*)rowp = w; }
    }
};
template <class Epi, class Sched, bool ALIGN_EPI = false, bool SP2 = false>
__device__ __forceinline__ void gemm_phase(PG8_LAS unsigned char* lds, const Gemm g, const Sched& S, const Epi& E) {
    int tid_ = threadIdx.x; asm volatile("" : "+v"(tid_));
    const int tid = tid_, wid = __builtin_amdgcn_readfirstlane(tid >> 6), lane = tid & 63, wr = wid >> 2, wc = wid & 3, fr = lane & 15, fq = lane >> 4;
    const int K = g.K, nt = K / BK;
    unsigned voffA[2], voffB[2];
#pragma unroll
    for (int i = 0; i < 2; ++i) { int R, C; stage_rc(tid * 16 + i * 8192, R, C); const int Rb = Epi::PERM ? ((R & ~31) + perm32(R & 31)) : R;
        voffA[i] = (unsigned)(R * K + C) * 2u; voffB[i] = (unsigned)(Rb * K + C) * 2u; }
    const size_t kstep = (size_t)(BK * 2);
    const size_t hstep = (size_t)HALF * K * 2;
    const size_t tstep = 2 * hstep;
    const unsigned ldsw = (unsigned)wid * 1024u;
    const int aoff = lds_byte(wr * 64 + fr, fq * 8), boff = lds_byte(wc * 32 + fr, fq * 8);
#define PG8_SA(b, h) (((b) * 2 + (h)) * HTB)
#define PG8_SB(b, h) ((4 + (b) * 2 + (h)) * HTB)
#define PG8_STAGE(bufoff, gbase, voff) do { _Pragma("unroll") for (int _i = 0; _i < 2; ++_i) \
        __builtin_amdgcn_global_load_lds((const unsigned*)((const char*)(gbase) + (voff)[_i]), (PG8_LAS unsigned*)(lds + (bufoff) + ldsw + _i * 8192), 16, 0, 0); } while (0)
#define PG8_LDA(dst, b, h) do { _Pragma("unroll") for (int m = 0; m < 4; ++m) _Pragma("unroll") for (int k = 0; k < 2; ++k) dst[m][k] = *(const PG8_LAS bf16x8*)(lds + PG8_SA(b, h) + aoff + m * 2048 + k * 1024); } while (0)
#define PG8_LDB(dst, b, h) do { _Pragma("unroll") for (int n = 0; n < 2; ++n) _Pragma("unroll") for (int k = 0; k < 2; ++k) dst[n][k] = *(const PG8_LAS bf16x8*)(lds + PG8_SB(b, h) + boff + n * 2048 + k * 1024); } while (0)
#define PG8_MMA(ai, bj, At, Bt) do { __builtin_amdgcn_s_setprio(1); _Pragma("unroll") for (int m = 0; m < 4; ++m) _Pragma("unroll") for (int n = 0; n < 2; ++n) _Pragma("unroll") for (int k = 0; k < 2; ++k) \
        acc[ai][bj][m][n] = __builtin_amdgcn_mfma_f32_16x16x32_bf16(Bt[n][k], At[m][k], acc[ai][bj][m][n], 0, 0, 0); __builtin_amdgcn_s_setprio(0); } while (0)
#define PG8_WAIT_V(n) asm volatile("s_waitcnt vmcnt(" #n ")" ::: "memory")
#define PG8_WAIT_L(n) asm volatile("s_waitcnt lgkmcnt(" #n ")" ::: "memory")
#define PG8_BAR __builtin_amdgcn_s_barrier()
#define PG8_SCHED __builtin_amdgcn_sched_barrier(0)
    Unit cur, nxt; int ui = 0;
    if (!S.next(0, cur)) return;
    f32x4 acc[2][2][4][2];
#pragma unroll
    for (int a = 0; a < 2; ++a)
#pragma unroll
        for (int b = 0; b < 2; ++b)
#pragma unroll
            for (int m = 0; m < 4; ++m)
#pragma unroll
                for (int n = 0; n < 2; ++n) acc[a][b][m][n] = (f32x4){0.f, 0.f, 0.f, 0.f};
    bf16x8 At[4][2], B0[2][2], B1[2][2];
    const char* cA = (const char*)g.A + (size_t)cur.pm * tstep; const char* cB = (const char*)g.Bt + (size_t)cur.pn * tstep;
    S.a_ready(cur);
    if constexpr (SP2) {
        PG8_STAGE(PG8_SB(0, 0), cB, voffB); PG8_STAGE(PG8_SB(0, 1), cB + hstep, voffB); PG8_STAGE(PG8_SA(0, 0), cA, voffA); PG8_STAGE(PG8_SA(0, 1), cA + hstep, voffA);
        if (wr == 1) PG8_BAR;
        PG8_WAIT_V(2); PG8_BAR;
        PG8_STAGE(PG8_SB(1, 0), cB + kstep, voffB); PG8_STAGE(PG8_SA(1, 0), cA + kstep, voffA); PG8_STAGE(PG8_SB(1, 1), cB + hstep + kstep, voffB);
        PG8_WAIT_V(6); PG8_BAR;
    } else {
        PG8_STAGE(PG8_SB(0, 0), cB, voffB); PG8_STAGE(PG8_SA(0, 0), cA, voffA); PG8_STAGE(PG8_SB(0, 1), cB + hstep, voffB); PG8_STAGE(PG8_SA(0, 1), cA + hstep, voffA);
        if (wr == 1) PG8_BAR;
        PG8_WAIT_V(4); PG8_BAR;
        PG8_STAGE(PG8_SB(1, 0), cB + kstep, voffB); PG8_STAGE(PG8_SA(1, 0), cA + kstep, voffA); PG8_STAGE(PG8_SB(1, 1), cB + hstep + kstep, voffB);
        PG8_WAIT_V(6); PG8_BAR;
    }
    for (;;) {
        const bool has_next = S.next(ui + 1, nxt);
        const char* nA = has_next ? (const char*)g.A + (size_t)nxt.pm * tstep : cA; const char* nB = has_next ? (const char*)g.Bt + (size_t)nxt.pn * tstep : cB;
        for (int t = 0; t < nt; t += 2) {
            const bool last = (t == nt - 2);
            const char* a1 = cA + (size_t)(t + 1) * kstep;
            const char* a2 = last ? nA : cA + (size_t)(t + 2) * kstep; const char* b2 = last ? nB : cB + (size_t)(t + 2) * kstep;
            const char* a3 = a2 + kstep; const char* b3 = b2 + kstep;
            if (last && has_next) S.a_ready(nxt);
            if constexpr (SP2) {
            PG8_LDB(B0, 0, 0); PG8_LDB(B1, 0, 1); PG8_SCHED; PG8_LDA(At, 0, 0); PG8_STAGE(PG8_SA(1, 1), a1 + hstep, voffA);
            PG8_WAIT_V(8); PG8_WAIT_L(0); PG8_BAR; PG8_MMA(0, 0, At, B0); PG8_MMA(0, 1, At, B1); PG8_BAR; PG8_SCHED;
            PG8_LDA(At, 0, 1); PG8_STAGE(PG8_SB(0, 0), b2, voffB); PG8_STAGE(PG8_SB(0, 1), b2 + hstep, voffB); PG8_STAGE(PG8_SA(0, 0), a2, voffA);
            PG8_WAIT_V(8); PG8_WAIT_L(0); PG8_BAR; PG8_MMA(1, 0, At, B0); PG8_MMA(1, 1, At, B1); PG8_BAR; PG8_SCHED;
            PG8_LDB(B0, 1, 0); PG8_LDB(B1, 1, 1); PG8_SCHED; PG8_LDA(At, 1, 0); PG8_STAGE(PG8_SA(0, 1), a2 + hstep, voffA);
            PG8_WAIT_V(8); PG8_WAIT_L(0); PG8_BAR; PG8_MMA(0, 0, At, B0); PG8_MMA(0, 1, At, B1); PG8_BAR; PG8_SCHED;
            PG8_LDA(At, 1, 1); PG8_STAGE(PG8_SB(1, 0), b3, voffB); PG8_STAGE(PG8_SB(1, 1), b3 + hstep, voffB); PG8_STAGE(PG8_SA(1, 0), a3, voffA);
            PG8_WAIT_V(8); PG8_WAIT_L(0); PG8_BAR; PG8_MMA(1, 0, At, B0); PG8_MMA(1, 1, At, B1); PG8_BAR; PG8_SCHED;
            } else {
            PG8_LDB(B0, 0, 0); PG8_SCHED; PG8_LDA(At, 0, 0); PG8_STAGE(PG8_SA(1, 1), a1 + hstep, voffA);
            PG8_WAIT_L(8); PG8_BAR; PG8_WAIT_L(0); PG8_MMA(0, 0, At, B0); PG8_BAR; PG8_SCHED;
            PG8_LDB(B1, 0, 1); PG8_STAGE(PG8_SB(0, 0), b2, voffB);
            PG8_BAR; PG8_WAIT_L(0); PG8_MMA(0, 1, At, B1); PG8_BAR;
            PG8_LDA(At, 0, 1); PG8_STAGE(PG8_SA(0, 0), a2, voffA);
            PG8_BAR; PG8_WAIT_L(0); PG8_MMA(1, 0, At, B0); PG8_BAR; PG8_SCHED;
            PG8_STAGE(PG8_SB(0, 1), b2 + hstep, voffB);
            PG8_WAIT_V(6); PG8_BAR; PG8_MMA(1, 1, At, B1); PG8_BAR;
            PG8_LDB(B0, 1, 0); PG8_SCHED; PG8_LDA(At, 1, 0); PG8_STAGE(PG8_SA(0, 1), a2 + hstep, voffA);
            PG8_WAIT_L(8); PG8_BAR; PG8_WAIT_L(0); PG8_MMA(0, 0, At, B0); PG8_BAR; PG8_SCHED;
            PG8_LDB(B1, 1, 1); PG8_STAGE(PG8_SB(1, 0), b3, voffB);
            PG8_BAR; PG8_WAIT_L(0); PG8_MMA(0, 1, At, B1); PG8_BAR;
            PG8_LDA(At, 1, 1); PG8_STAGE(PG8_SA(1, 0), a3, voffA);
            PG8_BAR; PG8_WAIT_L(0); PG8_MMA(1, 0, At, B0); PG8_BAR; PG8_SCHED;
            PG8_STAGE(PG8_SB(1, 1), b3 + hstep, voffB);
            PG8_WAIT_V(6); PG8_BAR; PG8_MMA(1, 1, At, B1); PG8_BAR;
            }
        }
        if constexpr (ALIGN_EPI) { if (wr == 0) PG8_BAR; }
        if constexpr (!Epi::AFTER_DRAIN) { E(acc, cur, wr, wc, fr, fq); S.done(cur); }
        if (!has_next) break;
#pragma unroll
        for (int a = 0; a < 2; ++a)
#pragma unroll
            for (int b = 0; b < 2; ++b)
#pragma unroll
                for (int m = 0; m < 4; ++m)
#pragma unroll
                    for (int n = 0; n < 2; ++n) acc[a][b][m][n] = (f32x4){0.f, 0.f, 0.f, 0.f};
        cur = nxt; cA = nA; cB = nB; ++ui;
        if constexpr (ALIGN_EPI) { if (wr == 1) PG8_BAR; }
    }
    PG8_WAIT_V(0);
    if constexpr (!ALIGN_EPI) { if (wr == 0) PG8_BAR; }
    PG8_BAR;
    if constexpr (Epi::AFTER_DRAIN) { E.fused(acc, cur, wr, wc, fr, fq, lds, wid, lane); S.done(cur); }
#undef PG8_SA
#undef PG8_SB
#undef PG8_STAGE
#undef PG8_LDA
#undef PG8_LDB
#undef PG8_MMA
#undef PG8_WAIT_V
#undef PG8_WAIT_L
#undef PG8_BAR
#undef PG8_SCHED
}
}

constexpr int NB = 4, SEQ = 4096, T = NB * SEQ, DM = 1024, DIN = 2964, DINP = 3072, DFF = 2816, DEPTH = 2;
constexpr int NWAVES = 8, NTHREADS = 512;
constexpr float EPS = 1e-6f;
constexpr int ZAQ = 0, ZKC = 256, ZVC = 320, ZKS = 384, ZVS = 448, ZKW = 512, ZVW = 576, ZBQ = 640, ZBK = 896, ZBV = 1152,
              ZCU = 1408, ZCV = 1664, ZCO = 1920, ZDQ = 2176, ZDK = 2432, ZDV = 2688, ZAG = 2944, ZCI = 2956, ZCF = 2960;
__host__ __device__ __forceinline__ int pi64(int p) { return (p & 1) ? 32 + (p >> 1) : (p >> 1); }
__host__ __device__ __forceinline__ int pi32(int p) { return (p & 1) ? 16 + (p >> 1) : (p >> 1); }
__host__ __device__ __forceinline__ int zsrc(int n) {
    const int seg = n >> 6, p = n & 63;
    const bool r64 = seg < 4 || seg == 6 || seg == 8 || (seg >= 34 && seg < 42), r32 = seg >= 10 && seg < 18;
    const int q = r64 ? pi64(p) : r32 ? (p & 32) + pi32(p & 31) : p; const int m = seg * 64 + q;
    if (m < 640) return m;
    if (m < 1920) return m + 12;
    if (m < 2944) return m + 20;
    if (m < 2956) return m - 2944 + 640;
    if (m < 2960) return m - 2956 + 1932;
    if (m < 2964) return m - 2960 + 1936;
    return -1;
}
constexpr size_t MiB = 1u << 20;
constexpr size_t WS_CTL = 0, CTL_ZERO_BYTES = 1 * MiB;
constexpr size_t WS_WIN = 2 * MiB, WS_WOUT = 8 * MiB, WS_WGU = 10 * MiB, WS_WD = 21 * MiB;
constexpr size_t WS_ROPE64 = 27 * MiB, WS_ROPE32 = 28 * MiB;
constexpr size_t WS_KC = 29 * MiB, WS_VC = WS_KC + 256 * 1024;
constexpr size_t WS_SEL = WS_VC + 256 * 1024;
constexpr size_t WS_BCUM = 30 * MiB, WS_IG = WS_BCUM + 256 * 1024, WS_NLOC = WS_IG + 256 * 1024;
constexpr size_t WS_ACH = WS_NLOC + 256 * 1024, WS_MLOC = WS_ACH + 4096, WS_MIN = WS_MLOC + 4096;
constexpr size_t WS_WCT = 26 * MiB + 512 * 1024;
constexpr size_t WS_CBP = 28 * MiB + 512 * 1024;
constexpr size_t WS_DLSE = 31 * MiB;
constexpr size_t WS_H = 32 * MiB;
constexpr size_t WS_Z = 64 * MiB;
constexpr size_t WS_XB2 = 64 * MiB, WS_ACT = 96 * MiB;
constexpr size_t WS_AQR = 160 * MiB, WS_OCMP = 168 * MiB, WS_DPART = 176 * MiB;
constexpr size_t WS_MQ = 200 * MiB, WS_MK = 216 * MiB, WS_CLOC = 232 * MiB, WS_END = 248 * MiB;
constexpr int CW_BAR = 4096;
constexpr int CW_Q = 16384;
constexpr int RING_BYTES = 131072, LDSCTL_OFF = RING_BYTES, MISC_OFF = LDSCTL_OFF + 320, LDS_BYTES = 147456;

#define GAS __attribute__((address_space(1)))
#define LAS __attribute__((address_space(3)))
typedef unsigned short bf16;
typedef unsigned v4u __attribute__((ext_vector_type(4)));
typedef unsigned v2u __attribute__((ext_vector_type(2)));
typedef float f32x4 __attribute__((ext_vector_type(4)));
typedef float f32x2 __attribute__((ext_vector_type(2)));
#define LDS_WAIT() asm volatile("s_waitcnt lgkmcnt(0)" ::: "memory")
#define VM_WAIT() asm volatile("s_waitcnt vmcnt(0)" ::: "memory")
__device__ __forceinline__ unsigned f2bf(float f) { unsigned u = __builtin_bit_cast(unsigned, f); return (u + 0x7fffu + ((u >> 16) & 1u)) >> 16; }
__device__ __forceinline__ unsigned pk2(float lo, float hi) { return f2bf(lo) | (f2bf(hi) << 16); }
__device__ __forceinline__ float bf2f(bf16 u) { return __uint_as_float(((unsigned)u) << 16); }
__device__ __forceinline__ float bflo(unsigned w) { return __uint_as_float(w << 16); }
__device__ __forceinline__ float bfhi(unsigned w) { return __uint_as_float(w & 0xffff0000u); }
template <int K> __device__ __forceinline__ int sx_i(int v) {
    if constexpr (K == 1) return __builtin_amdgcn_update_dpp(v, v, 0xB1, 0xF, 0xF, false);
    else if constexpr (K == 2) return __builtin_amdgcn_update_dpp(v, v, 0x4E, 0xF, 0xF, false);
    else return __builtin_amdgcn_ds_swizzle(v, (K << 10) | 0x1f);
}
template <int K> __device__ __forceinline__ float sx(float v) { return __builtin_bit_cast(float, sx_i<K>(__builtin_bit_cast(int, v))); }
__device__ __forceinline__ void swap32(unsigned v, unsigned& a, unsigned& b) { unsigned w = v; asm volatile("" : "+v"(w)); const auto rr = __builtin_amdgcn_permlane32_swap(v, w, false, false); a = rr[0]; b = rr[1]; }
__device__ __forceinline__ float sum32(float v) { unsigned a, b; swap32(__builtin_bit_cast(unsigned, v), a, b); return __builtin_bit_cast(float, a) + __builtin_bit_cast(float, b); }
__device__ __forceinline__ float max32(float v) { unsigned a, b; swap32(__builtin_bit_cast(unsigned, v), a, b); return fmaxf(__builtin_bit_cast(float, a), __builtin_bit_cast(float, b)); }
__device__ __forceinline__ unsigned or32(unsigned v) { unsigned a, b; swap32(v, a, b); return a | b; }
__device__ __forceinline__ float lane_get(float v, int src) { return __builtin_bit_cast(float, __builtin_amdgcn_ds_bpermute(src << 2, __builtin_bit_cast(int, v))); }
__device__ __forceinline__ float wave_sum(float v) { v += sx<1>(v); v += sx<2>(v); v += sx<4>(v); v += sx<8>(v); v += sx<16>(v); return sum32(v); }
__device__ __forceinline__ float wave_max(float v) { v = fmaxf(v, sx<1>(v)); v = fmaxf(v, sx<2>(v)); v = fmaxf(v, sx<4>(v)); v = fmaxf(v, sx<8>(v)); v = fmaxf(v, sx<16>(v)); return max32(v); }
__device__ __forceinline__ float sigmoidf_(float x) { return 1.0f / (1.0f + __expf(-x)); }
#define XB_TMO      128
#define XB_XCNT(j)  (256  + 64 * (j))
#define XB_XSUB(j)  (1280 + 64 * (j))
#define XB_XGEN(j)  (2304 + 64 * (j))
#define XB_TOP      3328
#define XB_TOPGEN   3392
#define XCD_BAR_WORDS 3456
#define XB_SPIN_CAP (1u << 18)

__device__ __forceinline__ unsigned xb_ld(unsigned* p)              { return __hip_atomic_load(p, __ATOMIC_RELAXED, __HIP_MEMORY_SCOPE_AGENT); }
__device__ __forceinline__ unsigned xb_add(unsigned* p, unsigned v) { return __hip_atomic_fetch_add(p, v, __ATOMIC_RELAXED, __HIP_MEMORY_SCOPE_AGENT); }
__device__ __forceinline__ unsigned xb_xcc_id() { return (unsigned)__builtin_amdgcn_s_getreg((3 << 11) | 20) & 0xFu; }
#define XB_SPIN(cond, bar) do { unsigned _sp = 0; while (cond) { __builtin_amdgcn_s_sleep(1); \
    if ((++_sp & 255u) == 0u) { if (xb_ld(&(bar)[XB_TMO])) break; if (_sp > XB_SPIN_CAP) { atomicAdd(&(bar)[XB_TMO], 1u); break; } } } } while (0)

struct XcdBarrier {
    unsigned* bar; unsigned x;
    volatile LAS unsigned* st;
};

__device__ __forceinline__ XcdBarrier xcd_barrier_post(unsigned* bar, volatile LAS unsigned* st) {
    XcdBarrier b; b.bar = bar; b.x = xb_xcc_id(); b.st = st;
    if (threadIdx.x == 0) (void)xb_add(&bar[XB_XCNT(b.x)], 1u);
    return b;
}
__device__ __forceinline__ void xcd_barrier_complete(unsigned* bar, unsigned x, unsigned& nloc, unsigned& nx) {
    const unsigned G = gridDim.x * gridDim.y * gridDim.z;
    unsigned sum, cnt, mine, sp = 0u;
    for (;;) {
        sum = 0u; cnt = 0u; mine = 0u;
#pragma unroll 1
        for (unsigned j = 0; j < 16; ++j) { const unsigned c = xb_ld(&bar[XB_XCNT(j)]); sum += c; cnt += (c > 0u) ? 1u : 0u; mine = (j == x) ? c : mine; }
        if (sum == G) break;
        __builtin_amdgcn_s_sleep(1);
        if ((++sp & 255u) == 0u) { if (xb_ld(&bar[XB_TMO])) break; if (sp > XB_SPIN_CAP) { atomicAdd(&bar[XB_TMO], 1u); break; } }
    }
    nloc = mine > 0u ? mine : 1u; nx = cnt > 0u ? cnt : 1u;
}

__device__ __forceinline__ void xcd_barrier(const XcdBarrier& b) {
    asm volatile("s_waitcnt vmcnt(0)" ::: "memory");
    __syncthreads();
    if (threadIdx.x == 0) {
        unsigned* bar = b.bar;
        __builtin_amdgcn_s_waitcnt(0);
        unsigned nloc = b.st[0], nx = b.st[1];
        if (nloc == 0u) { xcd_barrier_complete(bar, b.x, nloc, nx); b.st[0] = nloc; b.st[1] = nx; }
        const unsigned old = xb_add(&bar[XB_XSUB(b.x)], 1u);
        const unsigned gen = old / nloc;
        if (old + 1u == (gen + 1u) * nloc) {
            __builtin_amdgcn_fence(__ATOMIC_RELEASE, "agent");
            asm volatile("s_waitcnt vmcnt(0)" ::: "memory");
            const unsigned og = xb_add(&bar[XB_TOP], 1u);
            const unsigned tg = og / nx;
            if (og + 1u == (tg + 1u) * nx) xb_add(&bar[XB_TOPGEN], 1u);
            else XB_SPIN(xb_ld(&bar[XB_TOPGEN]) == tg, bar);
            __builtin_amdgcn_fence(__ATOMIC_ACQUIRE, "agent");
            xb_add(&bar[XB_XGEN(b.x)], 1u);
            asm volatile("s_waitcnt vmcnt(0)" ::: "memory");
        } else {
            XB_SPIN(xb_ld(&bar[XB_XGEN(b.x)]) == gen, bar);
            __builtin_amdgcn_fence(__ATOMIC_ACQUIRE, "agent");
            asm volatile("s_waitcnt vmcnt(0)" ::: "memory");
        }
    }
    __syncthreads();
}

struct Args { const float* in[19]; float* out; unsigned char* ws; float inv64[32]; float inv32[16]; };
struct Frame {
    unsigned char* lds;
    LAS unsigned char* lds3;
    volatile LAS unsigned* MISC;
    unsigned* ctl;
    unsigned char* ws;
    int tid, lane, wave, G, gw, ngw;
    unsigned long long pt0, pdt;
};
#define PHASE_IDS(F) do { int t_ = threadIdx.x; asm volatile("" : "+v"(t_)); (F).tid = t_; (F).lane = t_ & 63; (F).wave = __builtin_amdgcn_readfirstlane(t_ >> 6); (F).gw = blockIdx.x * NWAVES + (F).wave; } while (0)


__device__ __forceinline__ void transpose_item(const float* W, int K, int N, int srccol  , bf16* WT, int n0, int k0, float* scr, int lane, const float* gain = nullptr  ) {
#pragma unroll 8
    for (int i = 0; i < 32; ++i) { const int kk = 2 * i + (lane >> 5); scr[kk * 33 + (lane & 31)] = srccol >= 0 ? W[(size_t)(k0 + kk) * N + srccol] * (gain ? gain[k0 + kk] : 1.0f) : 0.f; }
    LDS_WAIT(); asm volatile("" ::: "memory");
    const int c = lane & 7;
#pragma unroll
    for (int j = 0; j < 4; ++j) { const int n = (lane >> 3) + 8 * j; const float* s = scr + (8 * c) * 33 + n;
        v4u o; o.x = pk2(s[0 * 33], s[1 * 33]); o.y = pk2(s[2 * 33], s[3 * 33]); o.z = pk2(s[4 * 33], s[5 * 33]); o.w = pk2(s[6 * 33], s[7 * 33]);
        *(v4u*)(WT + (size_t)(n0 + n) * K + k0 + 8 * c) = o; }
    LDS_WAIT(); asm volatile("" ::: "memory");
}
__device__ __forceinline__ void convert_weights(Frame& F, const Args& a, int layer) {
    PHASE_IDS(F);
    float* scr = (float*)(F.lds + F.wave * 16384);
    const float* w_in = a.in[2] + (size_t)layer * DM * DIN; const float* w_out = a.in[13] + (size_t)layer * DM * DM;
    const float* w_gate = a.in[15] + (size_t)layer * DM * DFF; const float* w_up = a.in[16] + (size_t)layer * DM * DFF; const float* w_down = a.in[17] + (size_t)layer * DFF * DM;
    bf16* WIN = (bf16*)(F.ws + WS_WIN); bf16* WOUT = (bf16*)(F.ws + WS_WOUT); bf16* WGU = (bf16*)(F.ws + WS_WGU); bf16* WD = (bf16*)(F.ws + WS_WD);
    constexpr int I_IN = (DM / 64) * (DINP / 32), I_OUT = (DM / 64) * (DM / 32), I_GU = (DM / 64) * (2 * DFF / 32), I_D = (DFF / 64) * (DM / 32);
    constexpr int I_C = 2 * (2048 / 64) * (64 / 32), I_CB = 64;
    constexpr int NITEMS = I_IN + I_OUT + I_GU + I_D + I_C + I_CB;
    const float* cmp_w = a.in[4] + (size_t)layer * 2 * 2048 * 64; const float* cmp_pos = a.in[3] + (size_t)layer * 2 * 2048; bf16* WCT = (bf16*)(F.ws + WS_WCT); float* CBP = (float*)(F.ws + WS_CBP);
    for (int it = F.gw; it < NITEMS; it += F.ngw) {
        int r = it; const int l31 = F.lane & 31;
        if (r < I_IN) { const int nblk = DINP / 32, kb = r / nblk, nb = r % nblk; transpose_item(w_in, DM, DIN, zsrc(nb * 32 + l31), WIN, nb * 32, kb * 64, scr, F.lane); continue; } r -= I_IN;
        if (r < I_OUT) { const int nblk = DM / 32, kb = r / nblk, nb = r % nblk; transpose_item(w_out, DM, DM, nb * 32 + l31, WOUT, nb * 32, kb * 64, scr, F.lane); continue; } r -= I_OUT;
        if (r < I_GU) { const int nblk = 2 * DFF / 32, kb = r / nblk, nb = r % nblk, n0 = nb * 32, pn = n0 >> 8, w = n0 & 255;
            transpose_item(w < 128 ? w_gate : w_up, DM, DFF, 128 * pn + (w & 127) + l31, WGU, n0, kb * 64, scr, F.lane); continue; } r -= I_GU;
        if (r < I_D) { const int nblk = DM / 32, kb = r / nblk, nb = r % nblk; transpose_item(w_down, DFF, DM, nb * 32 + l31, WD, nb * 32, kb * 64, scr, F.lane); continue; } r -= I_D;
        if (r < I_C) { const int br = r >> 6, q = r & 63, kb = q >> 1, nb = q & 1; transpose_item(cmp_w + (size_t)br * 2048 * 64, 2048, 64, br == 0 ? pi64(nb * 32 + l31) : nb * 32 + l31, WCT + (size_t)br * 64 * 2048, nb * 32, kb * 64, scr, F.lane); continue; } r -= I_C;
        { const int br = r >> 5, ch = r & 31; float acc = 0.f;
#pragma unroll 8
          for (int k = ch * 64; k < ch * 64 + 64; ++k) acc += cmp_pos[br * 2048 + k] * cmp_w[((size_t)br * 2048 + k) * 64 + F.lane];
          CBP[(br * 32 + ch) * 64 + F.lane] = acc; }
    }
}
__device__ __forceinline__ void sincos_d(float ang, float& c, float& s) {
    const double a = (double)ang; const double q = __builtin_rint(a * 0.63661977236758134308); const double r = a - q * 1.57079632679489661923; const double r2 = r * r;
    double sp = -1.0 / 39916800.0; sp = sp * r2 + 1.0 / 362880.0; sp = sp * r2 - 1.0 / 5040.0; sp = sp * r2 + 1.0 / 120.0; sp = sp * r2 - 1.0 / 6.0; sp = sp * r2 + 1.0; sp *= r;
    double cp = 1.0 / 479001600.0; cp = cp * r2 - 1.0 / 3628800.0; cp = cp * r2 + 1.0 / 40320.0; cp = cp * r2 - 1.0 / 720.0; cp = cp * r2 + 1.0 / 24.0; cp = cp * r2 - 0.5; cp = cp * r2 + 1.0;
    const int n = ((int)q) & 3; const double cc = (n == 0) ? cp : (n == 1) ? -sp : (n == 2) ? -cp : sp; const double ss = (n == 0) ? sp : (n == 1) ? cp : (n == 2) ? -sp : -cp;
    c = (float)cc; s = (float)ss;
}
__device__ __forceinline__ void build_rope(Frame& F, const Args& a) {
    PHASE_IDS(F);
    f32x2* R64 = (f32x2*)(F.ws + WS_ROPE64); f32x2* R32 = (f32x2*)(F.ws + WS_ROPE32);
    const int gt = F.gw * 64 + F.lane, ngt = F.ngw * 64;
    for (int i = gt; i < SEQ * 48; i += ngt) { const int pos = i / 48, j = i % 48; float c, s;
        if (j < 32) { sincos_d((float)pos * a.inv64[j], c, s); R64[pos * 32 + j] = (f32x2){c, s}; }
        else { sincos_d((float)pos * a.inv32[j - 32], c, s); R32[pos * 16 + (j - 32)] = (f32x2){c, s}; } }
}
__device__ __forceinline__ void norm_rows_bf16(Frame& F, const float* X, const float* g, bf16* H) {
    PHASE_IDS(F);
    f32x4 gg[4];
#pragma unroll
    for (int j = 0; j < 4; ++j) gg[j] = ((const f32x4*)g)[64 * j + F.lane];
    for (int row0 = F.gw * 4; row0 < T; row0 += F.ngw * 4) {
        f32x4 v[4][4];
#pragma unroll
        for (int r = 0; r < 4; ++r)
#pragma unroll
            for (int j = 0; j < 4; ++j) v[r][j] = ((const f32x4*)(X + (size_t)(row0 + r) * DM))[64 * j + F.lane];
#pragma unroll
        for (int r = 0; r < 4; ++r) { float q = 0.f;
#pragma unroll
            for (int j = 0; j < 4; ++j) q += (v[r][j].x * v[r][j].x + v[r][j].y * v[r][j].y) + (v[r][j].z * v[r][j].z + v[r][j].w * v[r][j].w);
            const float rr = 1.0f / sqrtf(wave_sum(q) * (1.0f / DM) + EPS); v2u* o = (v2u*)(H + (size_t)(row0 + r) * DM) + F.lane;
#pragma unroll
            for (int j = 0; j < 4; ++j) { v2u w; w.x = pk2(v[r][j].x * rr * gg[j].x, v[r][j].y * rr * gg[j].y); w.y = pk2(v[r][j].z * rr * gg[j].z, v[r][j].w * rr * gg[j].w); o[64 * j] = w; } }
    }
}
__device__ __forceinline__ void final_norm(Frame& F, float* X, const float* g) {
    PHASE_IDS(F);
    f32x4 gg[4];
#pragma unroll
    for (int j = 0; j < 4; ++j) gg[j] = ((const f32x4*)g)[64 * j + F.lane];
    for (int row0 = F.gw * 4; row0 < T; row0 += F.ngw * 4) {
        f32x4 v[4][4];
#pragma unroll
        for (int r = 0; r < 4; ++r)
#pragma unroll
            for (int j = 0; j < 4; ++j) v[r][j] = ((const f32x4*)(X + (size_t)(row0 + r) * DM))[64 * j + F.lane];
#pragma unroll
        for (int r = 0; r < 4; ++r) { float q = 0.f;
#pragma unroll
            for (int j = 0; j < 4; ++j) q += (v[r][j].x * v[r][j].x + v[r][j].y * v[r][j].y) + (v[r][j].z * v[r][j].z + v[r][j].w * v[r][j].w);
            const float rr = 1.0f / sqrtf(wave_sum(q) * (1.0f / DM) + EPS); f32x4* o = (f32x4*)(X + (size_t)(row0 + r) * DM) + F.lane;
#pragma unroll
            for (int j = 0; j < 4; ++j) o[64 * j] = v[r][j] * rr * gg[j]; }
    }
}

__device__ __forceinline__ void prep_compress(Frame& F, const Args& a, int layer) {
    PHASE_IDS(F);
    typedef short bf16x8 __attribute__((ext_vector_type(8)));
    const bf16* Z = (const bf16*)(F.ws + WS_Z); const bf16* WCT = (const bf16*)(F.ws + WS_WCT); const float* CBP = (const float*)(F.ws + WS_CBP);
    f32x4* red = (f32x4*)F.lds;
    const int lane = F.lane, et = F.wave & 3, kh = F.wave >> 2, r16 = lane & 15, q4 = lane >> 4;
    for (int it = blockIdx.x; it < NB * 2 * 16; it += F.G) {
        const int b = it >> 5, br = (it >> 4) & 1, n0 = (it & 15) * 16; const int zc = br ? ZVC : ZKC;
        const bf16* wrow = WCT + ((size_t)br * 64 + et * 16 + r16) * 2048 + 8 * q4;
        const int tb = 16 * (n0 + r16);
        f32x4 acc = {0.f, 0.f, 0.f, 0.f};
#pragma unroll 8
        for (int kk = kh * 32; kk < kh * 32 + 32; ++kk) {
            int tok = tb + (kk >> 1); tok = tok < SEQ ? tok : SEQ - 1;
            const bf16x8 af = *(const bf16x8*)(Z + ((size_t)b * SEQ + tok) * DINP + zc + (kk & 1) * 32 + 8 * q4);
            const bf16x8 bfr = *(const bf16x8*)(wrow + 32 * kk);
            acc = __builtin_amdgcn_mfma_f32_16x16x32_bf16(af, bfr, acc, 0, 0, 0);
        }
        __syncthreads();
        if (kh == 1) red[et * 64 + lane] = acc;
        __syncthreads();
        if (kh == 0) {
            const f32x4 o = red[et * 64 + lane]; const int e = et * 16 + r16; float bias = 0.f;
            const int es = br == 0 ? pi64(e) : e;
#pragma unroll 8
            for (int ch = 0; ch < 32; ++ch) bias += CBP[(br * 32 + ch) * 64 + es];
            bf16* O = (bf16*)(F.ws + (br ? WS_VC : WS_KC)) + (size_t)b * 256 * 64;
#pragma unroll
            for (int r = 0; r < 4; ++r) { const int n = n0 + 4 * q4 + r; O[n * 64 + e] = (bf16)((n < 255) ? f2bf(acc[r] + o[r] + bias) : 0u); }
        }
    }
    __syncthreads();
}
__device__ __forceinline__ float log_sigmoid_(float x) { return x >= 0.f ? -log1pf(__expf(-x)) : x - log1pf(__expf(x)); }
typedef float f32x16m __attribute__((ext_vector_type(16)));
__device__ __forceinline__ void mm64(f32x16m& acc, const float* ap, int as, const float* bp, int bs) {
#pragma unroll 8
    for (int kk = 0; kk < 32; ++kk) acc = __builtin_amdgcn_mfma_f32_32x32x2f32(ap[kk * as], bp[kk * bs], acc, 0, 0, 0);
}
__device__ __forceinline__ int crow32(int r, int hi) { return (r & 3) + 8 * (r >> 2) + 4 * hi; }
__device__ __forceinline__ void prep_mlstm(Frame& F, const Args& a, int layer) {
    PHASE_IDS(F);
    const bf16* Z = (const bf16*)(F.ws + WS_Z);
    float* L = (float*)F.lds; float* UC = L; float* KS = L + 4224; float* VS = L + 8448; float* WQ = L + 12672; float* WK = L + 16896; float* WE = L + 21120;
    const float* convw = a.in[7] + (size_t)layer * 4 * 256; const float* convb = a.in[8] + (size_t)layer * 256;
    const float* gb = a.in[11] + (size_t)layer * 8;
    float* MQ = (float*)(F.ws + WS_MQ); float* MK = (float*)(F.ws + WS_MK); float* CLOC = (float*)(F.ws + WS_CLOC); float* NLOC = (float*)(F.ws + WS_NLOC);
    float* BCUM = (float*)(F.ws + WS_BCUM); float* IG = (float*)(F.ws + WS_IG); float* ACH = (float*)(F.ws + WS_ACH); float* MLOC = (float*)(F.ws + WS_MLOC);
    const int lane = F.lane, r32 = lane & 31, hi = lane >> 5, w = F.wave;
    for (int it = blockIdx.x; it < 1024; it += F.G) {
        const int bh = it >> 6, c = it & 63, b = bh >> 2, h = bh & 3, t0 = c * 64; const size_t row0 = (size_t)b * SEQ + t0;
        const float* wq = a.in[9] + ((size_t)layer * 4 + h) * 4096; const float* wk = a.in[10] + ((size_t)layer * 4 + h) * 4096;
        __syncthreads();
#pragma unroll
        for (int u = 0; u < 8; ++u) { const int i = F.tid + u * NTHREADS; const int l = i >> 6, d = i & 63, ch = h * 64 + d; float s = convb[ch];
#pragma unroll
            for (int j = 0; j < 4; ++j) { const int t = t0 + l - 3 + j; if (t >= 0) s += convw[j * 256 + ch] * bf2f(Z[((size_t)b * SEQ + t) * DINP + ZCU + ch]); }
            UC[l * 65 + d] = s * sigmoidf_(s); VS[i] = bf2f(Z[(row0 + l) * DINP + ZCV + ch]); WQ[i] = wq[i]; WK[i] = wk[i]; }
        if (w == 0) { const int l = lane; const size_t row = row0 + l;
            const float ig = bf2f(Z[row * DINP + ZCI + h]) + gb[h]; float bc = log_sigmoid_(bf2f(Z[row * DINP + ZCF + h]) + gb[4 + h]);
#pragma unroll
            for (int o = 1; o < 64; o <<= 1) { const float v = lane_get(bc, l - o); if (l >= o) bc += v; }
            const float ach = lane_get(bc, 63); const float ge = ach - bc + ig; const float ml = wave_max(ge);
            WE[l] = __expf(ge - ml); BCUM[row * 4 + h] = bc; IG[row * 4 + h] = ig; if (l == 0) { ACH[it] = ach; MLOC[it] = ml; } }
        __syncthreads();
        { const int i0 = ((w >> 1) & 1) * 32, j0 = (w & 1) * 32; f32x16m acc;
#pragma unroll
            for (int r = 0; r < 16; ++r) acc[r] = 0.f;
            mm64(acc, UC + (i0 + r32) * 65 + hi, 2, (w < 4 ? WQ : WK) + hi * 64 + j0 + r32, 128);
            float* G = (w < 4 ? MQ : MK) + row0 * 256 + h * 64 + j0 + r32;
            if (w < 4) {
#pragma unroll
                for (int r = 0; r < 16; ++r) G[(size_t)(i0 + crow32(r, hi)) * 256] = acc[r];
            } else {
#pragma unroll
                for (int r = 0; r < 16; ++r) { const float v = acc[r] * 0.125f; const int l = i0 + crow32(r, hi); G[(size_t)l * 256] = v; KS[l * 64 + j0 + r32] = v; }
            } }
        __syncthreads();
        if (w < 4) { const int i0 = (w >> 1) * 32, j0 = (w & 1) * 32; f32x16m acc;
#pragma unroll
            for (int r = 0; r < 16; ++r) acc[r] = 0.f;
#pragma unroll 8
            for (int kk = 0; kk < 32; ++kk) { const int l = 2 * kk + hi; acc = __builtin_amdgcn_mfma_f32_32x32x2f32(VS[l * 64 + i0 + r32] * WE[l], KS[l * 64 + j0 + r32], acc, 0, 0, 0); }
            float* G = CLOC + (size_t)it * 4096 + j0 + r32;
#pragma unroll
            for (int r = 0; r < 16; ++r) G[(i0 + crow32(r, hi)) * 64] = acc[r];
        } else if (w == 4) { float n = 0.f;
#pragma unroll 8
            for (int l = 0; l < 64; ++l) n += WE[l] * KS[l * 64 + lane];
            NLOC[it * 64 + lane] = n; }
    }
    __syncthreads();
}

__device__ __forceinline__ void ld8(const bf16* p, float* o) { const v4u w = *(const v4u*)p; o[0] = bflo(w.x); o[1] = bfhi(w.x); o[2] = bflo(w.y); o[3] = bfhi(w.y); o[4] = bflo(w.z); o[5] = bfhi(w.z); o[6] = bflo(w.w); o[7] = bfhi(w.w); }
__device__ __forceinline__ void ph_mlstm_out(Frame& F, const Args& a, int layer) {
    PHASE_IDS(F);
    const bf16* Z = (const bf16*)(F.ws + WS_Z); bf16* AO = (bf16*)(F.ws + WS_H);
    const float* MQ = (const float*)(F.ws + WS_MQ); const float* MK = (const float*)(F.ws + WS_MK); const float* CIN = (const float*)(F.ws + WS_CLOC); const float* NIN = (const float*)(F.ws + WS_NLOC);
    const float* BCUM = (const float*)(F.ws + WS_BCUM); const float* IG = (const float*)(F.ws + WS_IG); const float* MIN = (const float*)(F.ws + WS_MIN);
    const float* hg = a.in[12] + (size_t)layer * 256;
    float* L = (float*)F.lds; float* QS = L; float* KS = L + 4224; float* CS = L + 8448; float* SS = L + 12672; float* HS = L + 16896; float* VS = L + 21120;
    float* NI = L + 25344; float* BC = NI + 64; float* IGS = BC + 64; float* MT = IGS + 64; float* EI = MT + 64; float* DEN = EI + 64;
    const int lane = F.lane, r32 = lane & 31, hi = lane >> 5, w = F.wave;
    for (int it = blockIdx.x; it < 1024; it += F.G) {
        const int bh = it >> 6, c = it & 63, b = bh >> 2, h = bh & 3; const size_t row0 = (size_t)b * SEQ + c * 64;
        __syncthreads();
#pragma unroll
        for (int u = 0; u < 8; ++u) { const int i = F.tid + u * NTHREADS; const int l = i >> 6, d = i & 63; const size_t g = (row0 + l) * 256 + h * 64 + d;
            QS[l * 65 + d] = MQ[g]; KS[l * 65 + d] = MK[g]; VS[i] = bf2f(Z[(row0 + l) * DINP + ZCV + h * 64 + d]); CS[l * 65 + d] = CIN[(size_t)it * 4096 + i]; }
        if (w == 0) { const int l = lane; const float bc = BCUM[(row0 + l) * 4 + h], ig = IG[(row0 + l) * 4 + h], mi = MIN[it];
            NI[l] = NIN[it * 64 + l]; BC[l] = bc; IGS[l] = ig;
            float pm = ig - bc;
#pragma unroll
            for (int o = 1; o < 64; o <<= 1) { const float v = lane_get(pm, l - o); if (l >= o) pm = fmaxf(pm, v); }
            const float inter = bc + mi, mt = fmaxf(inter, bc + pm); MT[l] = mt; EI[l] = __expf(inter - mt); }
        __syncthreads();
        const int i0 = ((w >> 1) & 1) * 32, j0 = (w & 1) * 32; f32x16m acc;
#pragma unroll
        for (int r = 0; r < 16; ++r) acc[r] = 0.f;
        if (w < 4) {
            if (!(i0 == 0 && j0 == 32)) mm64(acc, QS + (i0 + r32) * 65 + hi, 2, KS + (j0 + r32) * 65 + hi, 2);
            const int s_ = j0 + r32; const float bs = IGS[s_] - BC[s_];
#pragma unroll
            for (int r = 0; r < 16; ++r) { const int t = i0 + crow32(r, hi); SS[t * 65 + s_] = (s_ <= t) ? acc[r] * __expf(BC[t] + bs - MT[t]) : 0.f; }
        } else {
            mm64(acc, QS + (i0 + r32) * 65 + hi, 2, CS + (j0 + r32) * 65 + hi, 2);
#pragma unroll
            for (int r = 0; r < 16; ++r) acc[r] *= EI[i0 + crow32(r, hi)];
        }
        __syncthreads();
        if (w >= 4) {
            mm64(acc, SS + (i0 + r32) * 65 + hi, 2, VS + hi * 64 + j0 + r32, 128);
#pragma unroll
            for (int r = 0; r < 16; ++r) HS[(i0 + crow32(r, hi)) * 65 + j0 + r32] = acc[r];
        } else if (w == 0) { const int t = lane; float nq = 0.f, ssum = 0.f;
#pragma unroll 8
            for (int k = 0; k < 64; ++k) { nq += NI[k] * QS[t * 65 + k]; ssum += SS[t * 65 + k]; }
            const float den = EI[t] * nq + ssum; DEN[t] = 1.0f / fmaxf(fabsf(den), __expf(-MT[t])); }
        __syncthreads();
        { const int t = F.tid >> 3, vg = (F.tid & 7) * 8; const float rd = DEN[t]; float num[8]; float sq = 0.f;
#pragma unroll
            for (int i = 0; i < 8; ++i) { num[i] = HS[t * 65 + vg + i] * rd; sq += num[i] * num[i]; }
            sq += sx<1>(sq); sq += sx<2>(sq); sq += sx<4>(sq);
            const float rn = 1.0f / sqrtf(sq * (1.0f / 64.0f) + EPS); const size_t row = row0 + t;
            float zo[8]; ld8(Z + row * DINP + ZCO + h * 64 + vg, zo);
            unsigned wv[4];
#pragma unroll
            for (int i = 0; i < 8; i += 2) { const int ch = h * 64 + vg + i; wv[i >> 1] = pk2(num[i] * rn * hg[ch] * sigmoidf_(zo[i]), num[i + 1] * rn * hg[ch + 1] * sigmoidf_(zo[i + 1])); }
            *(v4u*)(AO + row * DM + 512 + h * 64 + vg) = (v4u){wv[0], wv[1], wv[2], wv[3]}; }
    }
    __syncthreads();
}

namespace fa {
typedef short bf16x8 __attribute__((ext_vector_type(8)));
typedef float f32x16 __attribute__((ext_vector_type(16)));
typedef short s16x4 __attribute__((ext_vector_type(4)));
typedef __bf16 bf16x2_t __attribute__((ext_vector_type(2)));
constexpr int KP = 144, VP = 192, KT = 64 * KP, VT = 64 * VP, BUF = KT + VT, LDS_NEED = 2 * BUF;
constexpr float LOG2E = 1.4426950408889634f, LN2 = 0.6931471805599453f;
__device__ __forceinline__ int crow(int r, int hi) { return (r & 3) + 8 * (r >> 2) + 4 * hi; }
__device__ __forceinline__ unsigned cvtpk(float lo, float hi) { f32x2 v = {lo, hi}; bf16x2_t b = __builtin_convertvector(v, bf16x2_t); return __builtin_bit_cast(unsigned, b); }
__device__ __forceinline__ s16x4 vtr(LAS unsigned char* p) { return __builtin_bit_cast(s16x4, __builtin_amdgcn_ds_read_tr16_b64_v4i16((LAS s16x4*)p)); }
__device__ __forceinline__ void load_qf(const bf16* qrow, int hi, bf16x8 (&qf)[4]) {
#pragma unroll
    for (int ks = 0; ks < 4; ++ks) qf[ks] = *(const bf16x8*)(qrow + 16 * ks + 8 * hi);
}
template <int KS0, int KS, class P, int MODE = 0>
__device__ __forceinline__ void stream(const P& p, LAS unsigned char* lds, int tid, float sc, const bf16x8 (&qf)[4], float& m_, float& l_, f32x16 (&O_)[2]) {
    float m = m_, l = l_; f32x16 O[2] = {O_[0], O_[1]};
    const int lane = tid & 63, r32 = lane & 31, hi = lane >> 5, g = lane >> 4, i16 = lane & 15;
    const int srow = tid >> 3, scx = tid & 7;
    const int koff = r32 * KP + hi * 16;
    const int voff = KT + ((i16 >> 2) + 4 * hi) * VP + (16 * (g & 1) + 4 * (i16 & 3)) * 2;
    const int nt = p.ntiles();
    v4u kr = {0u, 0u, 0u, 0u}, vr = {0u, 0u, 0u, 0u};
#define FA_LOAD(it_) do { const bf16* kp_ = p.krow((it_), srow); const bf16* vp_ = p.vrow((it_), srow); \
        kr = kp_ ? *(const v4u*)(kp_ + 8 * scx) : (v4u){0u, 0u, 0u, 0u}; vr = vp_ ? *(const v4u*)(vp_ + 8 * scx) : (v4u){0u, 0u, 0u, 0u}; } while (0)
#define FA_STORE(boff_) do { *(LAS v4u*)(lds + (boff_) + srow * KP + scx * 16) = kr; *(LAS v4u*)(lds + (boff_) + KT + srow * VP + scx * 16) = vr; } while (0)
    __syncthreads();
    if (nt > 0) { FA_LOAD(0); FA_STORE(0); if (nt > 1) FA_LOAD(1); }
    __syncthreads();
#pragma unroll 1
    for (int it = 0; it < nt; ++it) {
        const int bc = (it & 1) * BUF;
        if (!p.wave_skip(it)) {
            f32x16 S[2];
            { bf16x8 kf[2][KS];
#pragma unroll
              for (int st = 0; st < 2; ++st)
#pragma unroll
                  for (int k = 0; k < KS; ++k) kf[st][k] = *(LAS bf16x8*)(lds + bc + koff + st * 32 * KP + (KS0 + k) * 32);
#pragma unroll
              for (int st = 0; st < 2; ++st) {
#pragma unroll
                  for (int r = 0; r < 16; ++r) S[st][r] = 0.f;
#pragma unroll
                  for (int k = 0; k < KS; ++k) S[st] = __builtin_amdgcn_mfma_f32_32x32x16_bf16(kf[st][k], qf[KS0 + k], S[st], 0, 0, 0); } }
            s16x4 vv[2][2][2][2];
            if constexpr (MODE == 0) {
#pragma unroll
                for (int st = 0; st < 2; ++st)
#pragma unroll
                    for (int s = 0; s < 2; ++s)
#pragma unroll
                        for (int dt = 0; dt < 2; ++dt) { LAS unsigned char* vp = lds + bc + voff + (32 * st + 16 * s) * VP + dt * 64; vv[st][s][dt][0] = vtr(vp); vv[st][s][dt][1] = vtr(vp + 8 * VP); }
            }
            const int mm = p.mask_mode(it);
            if (mm) {
                int lb, ub; p.bounds(it, lb, ub); lb -= 4 * hi; ub -= 4 * hi;
                if (mm == 1) {
#pragma unroll
                    for (int st = 0; st < 2; ++st)
#pragma unroll
                        for (int r = 0; r < 16; ++r) { const int cc = 32 * st + (r & 3) + 8 * (r >> 2); if (cc > ub) S[st][r] = -INFINITY; }
                } else if (mm == 2) {
#pragma unroll
                    for (int st = 0; st < 2; ++st)
#pragma unroll
                        for (int r = 0; r < 16; ++r) { const int cc = 32 * st + (r & 3) + 8 * (r >> 2); if (cc < lb) S[st][r] = -INFINITY; }
                } else {
#pragma unroll
                    for (int st = 0; st < 2; ++st)
#pragma unroll
                        for (int r = 0; r < 16; ++r) { const int cc = 32 * st + (r & 3) + 8 * (r >> 2); if (cc < lb || cc > ub) S[st][r] = -INFINITY; }
                }
            }
            const bool keep = p.lane_keep(it);
            if constexpr (MODE == 1) {
                const float ms = (m == -INFINITY) ? 0.f : m; const float il = l > 0.f ? 1.0f / l : 0.f;
#pragma unroll
                for (int st = 0; st < 2; ++st)
#pragma unroll
                    for (int rg = 0; rg < 4; ++rg) {
                        const float p0 = __builtin_amdgcn_exp2f(__builtin_fmaf(S[st][4 * rg], sc, -ms)) * il, p1 = __builtin_amdgcn_exp2f(__builtin_fmaf(S[st][4 * rg + 1], sc, -ms)) * il;
                        const float p2 = __builtin_amdgcn_exp2f(__builtin_fmaf(S[st][4 * rg + 2], sc, -ms)) * il, p3 = __builtin_amdgcn_exp2f(__builtin_fmaf(S[st][4 * rg + 3], sc, -ms)) * il;
                        float qa = p0, qb = p0 + 2.0f * (p1 + p2 + p3);
                        qa += sx<1>(qa); qa += sx<2>(qa); qb += sx<1>(qb); qb += sx<2>(qb);
                        const int jp = 8 * (2 * it + st) + 2 * rg + hi;
                        if ((r32 & 3) == 0) { p.impA[p.tokl * 65 + jp] = qa; if (jp < 63) p.impB[p.tokl * 65 + jp + 1] = qb; }
                    }
            } else {
                float tm = S[0][0];
#pragma unroll
                for (int r = 1; r < 16; ++r) tm = fmaxf(tm, S[0][r]);
#pragma unroll
                for (int r = 0; r < 16; ++r) tm = fmaxf(tm, S[1][r]);
                tm = max32(tm); if (!keep) tm = -INFINITY;
                const float mn = fmaxf(m, tm * sc), ms0 = (mn == -INFINITY) ? 0.f : mn;
                const float alpha = __builtin_amdgcn_exp2f(m - ms0); const float ms = keep ? ms0 : INFINITY;
                m = mn;
                float ps = 0.f;
#pragma unroll
                for (int st = 0; st < 2; ++st)
#pragma unroll
                    for (int r = 0; r < 16; ++r) { const float e = __builtin_amdgcn_exp2f(__builtin_fmaf(S[st][r], sc, -ms)); S[st][r] = e; ps += e; }
                l = l * alpha + ps;
                if (__any(alpha != 1.0f)) {
#pragma unroll
                    for (int dt = 0; dt < 2; ++dt)
#pragma unroll
                        for (int r = 0; r < 16; ++r) O[dt][r] *= alpha;
                }
#pragma unroll
                for (int st = 0; st < 2; ++st)
#pragma unroll
                    for (int s = 0; s < 2; ++s) {
                        v4u pw; pw.x = cvtpk(S[st][8 * s], S[st][8 * s + 1]); pw.y = cvtpk(S[st][8 * s + 2], S[st][8 * s + 3]); pw.z = cvtpk(S[st][8 * s + 4], S[st][8 * s + 5]); pw.w = cvtpk(S[st][8 * s + 6], S[st][8 * s + 7]);
                        const bf16x8 pf = __builtin_bit_cast(bf16x8, pw);
#pragma unroll
                        for (int dt = 0; dt < 2; ++dt) {
                            const s16x4 v0 = vv[st][s][dt][0], v1 = vv[st][s][dt][1];
                            const bf16x8 vf = {v0[0], v0[1], v0[2], v0[3], v1[0], v1[1], v1[2], v1[3]};
                            O[dt] = __builtin_amdgcn_mfma_f32_32x32x16_bf16(vf, pf, O[dt], 0, 0, 0);
                        }
                    }
            }
        }
        if (it + 1 < nt) { FA_STORE(((it + 1) & 1) * BUF); if (it + 2 < nt) FA_LOAD(it + 2); }
        __syncthreads();
    }
#undef FA_LOAD
#undef FA_STORE
    m_ = m; l_ = l; O_[0] = O[0]; O_[1] = O[1];
}
__device__ __forceinline__ float finish(float l, f32x16 (&O)[2]) {
    const float lt = sum32(l); const float inv = lt > 0.f ? 1.0f / lt : 0.f;
#pragma unroll
    for (int dt = 0; dt < 2; ++dt)
#pragma unroll
        for (int r = 0; r < 16; ++r) O[dt][r] *= inv;
    return lt;
}
__device__ __forceinline__ void store_o(const f32x16 (&O)[2], bf16* out, int hi) {
#pragma unroll
    for (int dt = 0; dt < 2; ++dt)
#pragma unroll
        for (int rg = 0; rg < 4; ++rg) { v2u w; w.x = cvtpk(O[dt][4 * rg], O[dt][4 * rg + 1]); w.y = cvtpk(O[dt][4 * rg + 2], O[dt][4 * rg + 3]); *(v2u*)(out + 32 * dt + 8 * rg + 4 * hi) = w; }
}
}

struct DiffPol {
    const bf16* Zb; int h, t0, wq0, tq;
    __device__ __forceinline__ int ntiles() const { return (t0 + 256) >> 6; }
    __device__ __forceinline__ const bf16* krow(int it, int r) const { return Zb + (size_t)(64 * it + r) * DINP + ZBK + 64 * h; }
    __device__ __forceinline__ const bf16* vrow(int it, int r) const { return Zb + (size_t)(64 * it + r) * DINP + ZBV + 64 * h; }
    __device__ __forceinline__ bool wave_skip(int it) const { return 64 * it > wq0 + 31; }
    __device__ __forceinline__ int mask_mode(int it) const { return 64 * it + 63 > wq0 ? 1 : 0; }
    __device__ __forceinline__ bool lane_keep(int) const { return true; }
    __device__ __forceinline__ void bounds(int it, int& lb, int& ub) const { lb = 0; ub = tq - 64 * it; }
};
__device__ __forceinline__ void diff_item(Frame& F, const Args& a, int layer, int b, int h, int qb, float lam) {
    PHASE_IDS(F);
    const bf16* Z = (const bf16*)(F.ws + WS_Z); bf16* AO = (bf16*)(F.ws + WS_H);
    const int lane = F.lane, r32 = lane & 31, hi = lane >> 5;
    DiffPol p; p.Zb = Z + (size_t)b * SEQ * DINP; p.h = h; p.t0 = 256 * qb; p.wq0 = p.t0 + 32 * F.wave; p.tq = p.wq0 + r32;
    fa::bf16x8 qf[4]; fa::load_qf(p.Zb + (size_t)p.tq * DINP + ZBQ + 64 * h, hi, qf);
    fa::f32x16 O[2][2];
#pragma unroll
    for (int c = 0; c < 2; ++c)
#pragma unroll
        for (int dt = 0; dt < 2; ++dt)
#pragma unroll
            for (int r = 0; r < 16; ++r) O[c][dt][r] = 0.f;
    { float m = -INFINITY, l = 0.f; fa::stream<0, 2, DiffPol>(p, F.lds3, F.tid, 0.17677669529663687f * fa::LOG2E, qf, m, l, O[0]); fa::finish(l, O[0]); }
    { float m = -INFINITY, l = 0.f; fa::stream<2, 2, DiffPol>(p, F.lds3, F.tid, 0.17677669529663687f * fa::LOG2E, qf, m, l, O[1]); fa::finish(l, O[1]); }
    const float lam_init = 0.8f - 0.6f * expf(-0.3f * (float)layer);
    const float* sg = a.in[6] + (size_t)layer * 64;
    float ss = 0.f;
#pragma unroll
    for (int dt = 0; dt < 2; ++dt)
#pragma unroll
        for (int r = 0; r < 16; ++r) { const float v = O[0][dt][r] - lam * O[1][dt][r]; O[0][dt][r] = v; ss += v * v; }
    ss = sum32(ss);
    const float rn = (1.0f / sqrtf(ss * (1.0f / 64.0f) + EPS)) * (1.0f - lam_init);
#pragma unroll
    for (int dt = 0; dt < 2; ++dt)
#pragma unroll
        for (int r = 0; r < 16; ++r) O[0][dt][r] *= rn * sg[32 * dt + fa::crow(r, hi)];
    fa::store_o(O[0], AO + ((size_t)b * SEQ + p.tq) * DM + 256 + 64 * h, hi);
}
struct DilPol {
    const bf16* Zb; int h, dil, res, it0, nt, wi0, iq;
    __device__ __forceinline__ int ntiles() const { return nt; }
    __device__ __forceinline__ const bf16* krow(int it, int r) const { const int ik = 64 * (it0 + it) + r; return Zb + (size_t)(res + dil * ik) * DINP + ZDK + 64 * h; }
    __device__ __forceinline__ const bf16* vrow(int it, int r) const { const int ik = 64 * (it0 + it) + r; return Zb + (size_t)(res + dil * ik) * DINP + ZDV + 64 * h; }
    __device__ __forceinline__ bool wave_skip(int it) const { const int k0 = 64 * (it0 + it); return k0 > wi0 + 31 || k0 + 63 < wi0 - 128; }
    __device__ __forceinline__ int mask_mode(int it) const { const int k0 = 64 * (it0 + it); return (k0 + 63 > wi0 ? 1 : 0) | (k0 < wi0 + 31 - 128 ? 2 : 0); }
    __device__ __forceinline__ bool lane_keep(int) const { return true; }
    __device__ __forceinline__ void bounds(int it, int& lb, int& ub) const { ub = iq - 64 * (it0 + it); lb = ub - 128; }
};
__device__ __forceinline__ void dil_item(Frame& F, int b, int h, int g, int res, int blk) {
    PHASE_IDS(F);
    const bf16* Z = (const bf16*)(F.ws + WS_Z); bf16* DP = (bf16*)(F.ws + WS_DPART); float* DL = (float*)(F.ws + WS_DLSE);
    const int lane = F.lane, r32 = lane & 31, hi = lane >> 5;
    DilPol p; p.Zb = Z + (size_t)b * SEQ * DINP; p.h = h; p.dil = (g == 0) ? 1 : (g == 1) ? 4 : 16; p.res = res;
    const int i0 = 256 * blk; const int t_lo = (i0 >> 6) - 2; p.it0 = t_lo < 0 ? 0 : t_lo; p.nt = (i0 >> 6) + 4 - p.it0;
    p.wi0 = i0 + 32 * F.wave; p.iq = p.wi0 + r32;
    const int tq = res + p.dil * p.iq; const size_t row = (size_t)b * SEQ + tq;
    fa::bf16x8 qf[4]; fa::load_qf(p.Zb + (size_t)tq * DINP + ZDQ + 64 * h, hi, qf);
    float m = -INFINITY, l = 0.f; fa::f32x16 O[2];
#pragma unroll
    for (int dt = 0; dt < 2; ++dt)
#pragma unroll
        for (int r = 0; r < 16; ++r) O[dt][r] = 0.f;
    fa::stream<0, 4, DilPol>(p, F.lds3, F.tid, 0.125f * fa::LOG2E, qf, m, l, O);
    const float lt = fa::finish(l, O);
    fa::store_o(O, DP + ((size_t)g * T + row) * 256 + 64 * h, hi);
    if (hi == 0) DL[((size_t)g * T + row) * 4 + h] = (m + __log2f(lt)) * fa::LN2;
}
__device__ __forceinline__ void dil_combine(Frame& F) {
    PHASE_IDS(F);
    const bf16* DP = (const bf16*)(F.ws + WS_DPART); const float* DL = (const float*)(F.ws + WS_DLSE); bf16* AO = (bf16*)(F.ws + WS_H);
    const int gt = F.gw * 64 + F.lane, ngt = F.ngw * 64;
    for (int i = gt; i < T * 32; i += ngt) { const int row = i >> 5, c8 = (i & 31) * 8, h = c8 >> 6;
        const float l0 = DL[(size_t)row * 4 + h], l1 = DL[((size_t)T + row) * 4 + h], l2 = DL[((size_t)2 * T + row) * 4 + h];
        const float mx = fmaxf(l0, fmaxf(l1, l2)); float w0 = __expf(l0 - mx), w1 = __expf(l1 - mx), w2 = __expf(l2 - mx); const float inv = 1.0f / (w0 + w1 + w2); w0 *= inv; w1 *= inv; w2 *= inv;
        float x0[8], x1[8], x2[8]; ld8(DP + (size_t)row * 256 + c8, x0); ld8(DP + ((size_t)T + row) * 256 + c8, x1); ld8(DP + ((size_t)2 * T + row) * 256 + c8, x2);
        v4u o; o.x = pk2(w0 * x0[0] + w1 * x1[0] + w2 * x2[0], w0 * x0[1] + w1 * x1[1] + w2 * x2[1]); o.y = pk2(w0 * x0[2] + w1 * x1[2] + w2 * x2[2], w0 * x0[3] + w1 * x1[3] + w2 * x2[3]);
        o.z = pk2(w0 * x0[4] + w1 * x1[4] + w2 * x2[4], w0 * x0[5] + w1 * x1[5] + w2 * x2[5]); o.w = pk2(w0 * x0[6] + w1 * x1[6] + w2 * x2[6], w0 * x0[7] + w1 * x1[7] + w2 * x2[7]);
        *(v4u*)(AO + (size_t)row * DM + 768 + c8) = o; }
}
struct CmpPol {
    const bf16* KCb; const bf16* VCb; int nt, ubg; float* impA; float* impB; int tokl; bool nov;
    __device__ __forceinline__ int ntiles() const { return nt; }
    __device__ __forceinline__ const bf16* krow(int it, int r) const { return KCb + (size_t)(64 * it + r) * 64; }
    __device__ __forceinline__ const bf16* vrow(int it, int r) const { return nov ? nullptr : VCb + (size_t)(64 * it + r) * 64; }
    __device__ __forceinline__ bool wave_skip(int) const { return false; }
    __device__ __forceinline__ int mask_mode(int) const { return 1; }
    __device__ __forceinline__ bool lane_keep(int) const { return true; }
    __device__ __forceinline__ void bounds(int it, int& lb, int& ub) const { lb = 0; ub = ubg - 64 * it; }
};
struct SlcPol {
    const bf16* Zb; const unsigned char* list; int nt, t, cblk; unsigned wlo, whi, mlo, mhi;
    __device__ __forceinline__ int ntiles() const { return nt; }
    __device__ __forceinline__ const bf16* krow(int it, int r) const { const int j = list[it]; return Zb + (size_t)(64 * j + r) * DINP + ZKS; }
    __device__ __forceinline__ const bf16* vrow(int it, int r) const { const int j = list[it]; return Zb + (size_t)(64 * j + r) * DINP + ZVS; }
    __device__ __forceinline__ bool wave_skip(int it) const { const int j = list[it]; return !(((j < 32) ? (wlo >> j) : (whi >> (j - 32))) & 1u); }
    __device__ __forceinline__ int mask_mode(int it) const { return (int)list[it] == cblk ? 1 : 0; }
    __device__ __forceinline__ bool lane_keep(int it) const { const int j = list[it]; return (((j < 32) ? (mlo >> j) : (mhi >> (j - 32))) & 1u) != 0u; }
    __device__ __forceinline__ void bounds(int it, int& lb, int& ub) const { const int j = list[it]; lb = 0; ub = t - 64 * j; }
};
struct WinPol {
    const bf16* Zb; int jt0, nt, t, cblk;
    __device__ __forceinline__ int ntiles() const { return nt; }
    __device__ __forceinline__ const bf16* krow(int it, int r) const { return Zb + (size_t)(64 * (jt0 + it) + r) * DINP + ZKW; }
    __device__ __forceinline__ const bf16* vrow(int it, int r) const { return Zb + (size_t)(64 * (jt0 + it) + r) * DINP + ZVW; }
    __device__ __forceinline__ bool wave_skip(int) const { return false; }
    __device__ __forceinline__ int mask_mode(int it) const { const int jt = jt0 + it; return (jt == cblk ? 1 : 0) | (jt == cblk - 8 ? 2 : 0); }
    __device__ __forceinline__ bool lane_keep(int) const { return true; }
    __device__ __forceinline__ void bounds(int it, int& lb, int& ub) const { ub = t - 64 * (jt0 + it); lb = ub - 511; }
};
constexpr int NSA_IMP_OFF = 45056, NSA_SEL_OFF = NSA_IMP_OFF + 2 * 64 * 65 * 4, NSA_LIST_OFF = NSA_SEL_OFF + 512;
static_assert(fa::LDS_NEED <= NSA_IMP_OFF && NSA_LIST_OFF + 64 <= RING_BYTES, "NSA LDS map");
__device__ __forceinline__ void nsa_item(Frame& F, int b, int c) {
    PHASE_IDS(F);
    const bf16* Z = (const bf16*)(F.ws + WS_Z); const bf16* AQR = (const bf16*)(F.ws + WS_AQR); bf16* AO = (bf16*)(F.ws + WS_H);
    const bf16* KCB = (const bf16*)(F.ws + WS_KC) + (size_t)b * 256 * 64; const bf16* VCB = (const bf16*)(F.ws + WS_VC) + (size_t)b * 256 * 64;
    const int lane = F.lane, r32 = lane & 31, hi = lane >> 5, tokl = 8 * F.wave + (r32 >> 2), h = r32 & 3, t = 64 * c + tokl; const size_t row = (size_t)b * SEQ + t;
    const bf16* Zb = Z + (size_t)b * SEQ * DINP;
    float* impA = (float*)(F.lds + NSA_IMP_OFF); float* impB = impA + 64 * 65;
    unsigned long long* sel = (unsigned long long*)(F.lds + NSA_SEL_OFF); unsigned char* list = F.lds + NSA_LIST_OFF;
    for (int i = F.tid; i < 2 * 64 * 65; i += NTHREADS) impA[i] = 0.f;
    const bf16* zr = Zb + (size_t)t * DINP;
    const float g0 = sigmoidf_(bf2f(zr[ZAG + h])), g1 = sigmoidf_(bf2f(zr[ZAG + 4 + h])), g2 = sigmoidf_(bf2f(zr[ZAG + 8 + h]));
    fa::f32x16 acc[2], O[2];
    {
        CmpPol cp; cp.KCb = KCB; cp.VCb = VCB; cp.nt = (4 * c + 2 + 64) >> 6; cp.ubg = t >= 31 ? ((t - 31) >> 4) : -1; cp.impA = impA; cp.impB = impB; cp.tokl = tokl; cp.nov = false;
        fa::bf16x8 qf[4]; fa::load_qf(zr + ZAQ + 64 * h, hi, qf);
        float m = -INFINITY, l = 0.f;
#pragma unroll
        for (int dt = 0; dt < 2; ++dt)
#pragma unroll
            for (int r = 0; r < 16; ++r) O[dt][r] = 0.f;
        fa::stream<0, 4, CmpPol, 0>(cp, F.lds3, F.tid, 0.125f * fa::LOG2E, qf, m, l, O);
        float lt = fa::finish(l, O);
#pragma unroll
        for (int dt = 0; dt < 2; ++dt)
#pragma unroll
            for (int r = 0; r < 16; ++r) acc[dt][r] = g0 * O[dt][r];
        cp.nov = true;
        fa::stream<0, 4, CmpPol, 1>(cp, F.lds3, F.tid, 0.125f * fa::LOG2E, qf, m, lt, O);
    }
    __syncthreads();
#pragma unroll 1
    for (int tk = 0; tk < 8; ++tk) {
        const int tl = 8 * F.wave + tk, j = lane; const float imp = impA[tl * 65 + j] + impB[tl * 65 + j];
        const bool forced = (j == 0) || (j <= c && j > c - 2);
        const float sc = (j > c) ? -1.0e6f : (forced ? 1.0e6f : imp);
        int rank = 0;
#pragma unroll 8
        for (int i = 0; i < 64; ++i) { const float si = lane_get(sc, i); rank += (si > sc || (si == sc && i < j)) ? 1 : 0; }
        const unsigned long long mask = __ballot(rank < 16 && j <= c);
        if (lane == 0) sel[tl] = mask;
    }
    __syncthreads();
    SlcPol sp; sp.Zb = Zb; sp.list = list; sp.t = t; sp.cblk = c;
    { const unsigned long long mk = sel[tokl]; sp.mlo = (unsigned)mk; sp.mhi = (unsigned)(mk >> 32);
      unsigned wl = sp.mlo, wh = sp.mhi; wl |= (unsigned)sx_i<4>((int)wl); wh |= (unsigned)sx_i<4>((int)wh); wl |= (unsigned)sx_i<8>((int)wl); wh |= (unsigned)sx_i<8>((int)wh); wl |= (unsigned)sx_i<16>((int)wl); wh |= (unsigned)sx_i<16>((int)wh);
      sp.wlo = __builtin_amdgcn_readfirstlane(wl); sp.whi = __builtin_amdgcn_readfirstlane(wh);
      const unsigned long long mu = sel[lane]; unsigned ul = (unsigned)mu, uh = (unsigned)(mu >> 32);
      ul |= (unsigned)sx_i<1>((int)ul); uh |= (unsigned)sx_i<1>((int)uh); ul |= (unsigned)sx_i<2>((int)ul); uh |= (unsigned)sx_i<2>((int)uh); ul |= (unsigned)sx_i<4>((int)ul); uh |= (unsigned)sx_i<4>((int)uh);
      ul |= (unsigned)sx_i<8>((int)ul); uh |= (unsigned)sx_i<8>((int)uh); ul |= (unsigned)sx_i<16>((int)ul); uh |= (unsigned)sx_i<16>((int)uh); ul = or32(ul); uh = or32(uh);
      ul = __builtin_amdgcn_readfirstlane(ul); uh = __builtin_amdgcn_readfirstlane(uh);
      const unsigned long long un = ((unsigned long long)uh << 32) | ul;
      if ((un >> lane) & 1ull) list[__popcll(un & ((1ull << lane) - 1ull))] = (unsigned char)lane;
      sp.nt = __popcll(un); }
    fa::bf16x8 qf[4]; fa::load_qf(AQR + row * 256 + 64 * h, hi, qf);
    { float m = -INFINITY, l = 0.f;
#pragma unroll
      for (int dt = 0; dt < 2; ++dt)
#pragma unroll
          for (int r = 0; r < 16; ++r) O[dt][r] = 0.f;
      fa::stream<0, 4, SlcPol, 0>(sp, F.lds3, F.tid, 0.125f * fa::LOG2E, qf, m, l, O); fa::finish(l, O);
#pragma unroll
      for (int dt = 0; dt < 2; ++dt)
#pragma unroll
          for (int r = 0; r < 16; ++r) acc[dt][r] += g1 * O[dt][r]; }
    { WinPol wp; wp.Zb = Zb; wp.jt0 = c >= 8 ? c - 8 : 0; wp.nt = c - wp.jt0 + 1; wp.t = t; wp.cblk = c;
      float m = -INFINITY, l = 0.f;
#pragma unroll
      for (int dt = 0; dt < 2; ++dt)
#pragma unroll
          for (int r = 0; r < 16; ++r) O[dt][r] = 0.f;
      fa::stream<0, 4, WinPol, 0>(wp, F.lds3, F.tid, 0.125f * fa::LOG2E, qf, m, l, O); fa::finish(l, O);
#pragma unroll
      for (int dt = 0; dt < 2; ++dt)
#pragma unroll
          for (int r = 0; r < 16; ++r) acc[dt][r] += g2 * O[dt][r]; }
    fa::store_o(acc, AO + row * DM + 64 * h, hi);
}
__device__ __forceinline__ void scan_item(Frame& F, int it) {
    PHASE_IDS(F);
    float* CLOC = (float*)(F.ws + WS_CLOC); float* NLOC = (float*)(F.ws + WS_NLOC);
    const float* ACH = (const float*)(F.ws + WS_ACH); const float* MLOC = (const float*)(F.ws + WS_MLOC); float* MIN = (float*)(F.ws + WS_MIN);
    const int bh = it >> 2, qt = it & 3; const int e0 = qt * 1024 + F.tid * 2;
    float c0 = 0.f, c1 = 0.f, nst = 0.f, mst = 0.f;
#pragma unroll 1
    for (int cb = 0; cb < 64; cb += 16) {
        f32x2 cl[16]; float ac[16], ml[16], nl[16];
#pragma unroll
        for (int u = 0; u < 16; ++u) { const int ci = bh * 64 + cb + u; cl[u] = *(const f32x2*)(CLOC + (size_t)ci * 4096 + e0); ac[u] = ACH[ci]; ml[u] = MLOC[ci]; nl[u] = (qt == 0 && F.tid < 64) ? NLOC[ci * 64 + F.tid] : 0.f; }
#pragma unroll
        for (int u = 0; u < 16; ++u) { const int ci = bh * 64 + cb + u;
            const float mn = fmaxf(ac[u] + mst, ml[u]), decay = __expf(ac[u] + mst - mn), fresh = __expf(ml[u] - mn);
            *(f32x2*)(CLOC + (size_t)ci * 4096 + e0) = (f32x2){c0, c1}; c0 = decay * c0 + fresh * cl[u].x; c1 = decay * c1 + fresh * cl[u].y;
            if (qt == 0 && F.tid < 64) { NLOC[ci * 64 + F.tid] = nst; nst = decay * nst + fresh * nl[u]; if (F.tid == 0) MIN[ci] = mst; }
            mst = mn; }
    }
}
struct QOrder { unsigned short v[64 + 256 + 256 + 768]; };
constexpr QOrder make_order() {
    QOrder o{}; int n = 0, id = 0, in = 0;
    for (int k = 0; k < 64; ++k) o.v[n++] = (unsigned short)((3 << 12) | k);
    while (id < 256 || in < 256) {
        const int cd = id < 256 ? 96 * (15 - id / 16 + 1) : -1, cn = in < 256 ? 16 * (63 - in / 4 + 18) : -1;
        if (cd >= cn) { o.v[n++] = (unsigned short)((0 << 12) | id); ++id; } else { o.v[n++] = (unsigned short)((1 << 12) | in); ++in; }
    }
    for (int k = 0; k < 768; ++k) o.v[n++] = (unsigned short)((2 << 12) | k);
    return o;
}
__device__ const QOrder g_order = make_order();
__device__ __forceinline__ void ph_d_queue(Frame& F, const Args& a, int layer) {
    PHASE_IDS(F);
    unsigned* ctr = F.ctl + CW_Q + 64 * layer;
    const float* lv = a.in[5] + (size_t)layer * 128;
    const float lam_init = 0.8f - 0.6f * expf(-0.3f * (float)layer);
    float l01 = 0.f, l23 = 0.f; if (F.lane < 32) { l01 = lv[F.lane] * lv[32 + F.lane]; l23 = lv[64 + F.lane] * lv[96 + F.lane]; }
    const float lam = expf(wave_sum(l01)) - expf(wave_sum(l23)) + lam_init;
    constexpr int NQ = 64 + 256 + 256 + 768;
    for (;;) {
        __syncthreads();
        if (F.tid == 0) F.MISC[0] = __hip_atomic_fetch_add(ctr, 1u, __ATOMIC_RELAXED, __HIP_MEMORY_SCOPE_AGENT);
        __syncthreads();
        const int qi = (int)F.MISC[0];
        if (qi >= NQ) break;
        const int e = g_order.v[qi], ty = e >> 12, id = e & 4095;
        if (ty == 3) scan_item(F, id);
        else if (ty == 0) { const int qb = 15 - (id >> 4), bh = id & 15; diff_item(F, a, layer, bh >> 2, bh & 3, qb, lam); }
        else if (ty == 1) nsa_item(F, id & 3, 63 - (id >> 2));
        else { const int bh = id & 15, k = id >> 4;
            const int g = k >> 4, j = k & 15; const int res = (g == 0) ? 0 : (g == 1) ? (j & 3) : j, blk = (g == 0) ? j : (g == 1) ? (j >> 2) : 0;
            dil_item(F, bh >> 2, bh & 3, g, res, blk); }
    }
    __syncthreads();
}

constexpr int NPHASE = 9 * DEPTH + 1;
#ifndef PH_LO
#define PH_LO 0
#endif
#ifndef PH_HI
#define PH_HI NPHASE
#endif
#define IN(k) (PH_LO <= (k) && (k) < PH_HI)
#ifdef PROBE_K
#ifndef PROBE_SUB
#define PROBE_SUB 0
#endif
#ifndef PROBE_AMP
#define PROBE_AMP 10
#endif
#define PROBE_T0(k) do { if ((k) == PROBE_K) F.pt0 = __builtin_amdgcn_s_memrealtime(); } while (0)
#define PROBE_T1(k) do { if ((k) == PROBE_K) F.pdt = __builtin_amdgcn_s_memrealtime() - F.pt0; } while (0)
#define SUBP(id, call) do { if (layer == 0 && (id) == PROBE_SUB) { F.pt0 = __builtin_amdgcn_s_memrealtime(); call; __syncthreads(); F.pdt = __builtin_amdgcn_s_memrealtime() - F.pt0; } else { call; } } while (0)
#else
#define SUBP(id, call) do { call; } while (0)
#define PROBE_T0(k) do { } while (0)
#define PROBE_T1(k) do { } while (0)
#endif
#define SEAM(k) do { if (IN(k) && (k) + 1 < PH_HI) { if ((k) == PH_LO) cg::this_grid().sync(); xcd_barrier(bar); } } while (0)
template <int layer> __device__ __forceinline__ void run_layer(Frame& F, const Args& args, const XcdBarrier& bar) {
    float* XR = args.out;
    bf16* H = (bf16*)(F.ws + WS_H); bf16* Z = (bf16*)(F.ws + WS_Z);
    bf16* WIN = (bf16*)(F.ws + WS_WIN); bf16* WOUT = (bf16*)(F.ws + WS_WOUT); bf16* WGU = (bf16*)(F.ws + WS_WGU); bf16* WD = (bf16*)(F.ws + WS_WD);

        const int P = 9 * layer;
        bf16* XB2 = (bf16*)(F.ws + WS_XB2); bf16* ACT = (bf16*)(F.ws + WS_ACT);
        PROBE_T0(P + 0);
        if (IN(P + 0)) {
            convert_weights(F, args, layer);
            if (layer == 0) build_rope(F, args);
            norm_rows_bf16(F, layer == 0 ? args.in[0] : XR, args.in[1] + (size_t)layer * DM, H);
        }
        SEAM(P + 0); PROBE_T1(P + 0);
        PROBE_T0(P + 1);
        if (IN(P + 1)) {
            pg8::Gemm g{H, WIN, T, DINP, DM}; pg8::StaticOrder S; S.init(T, DINP, F.G, (int)blockIdx.x);
            pg8::EpiZR E{Z, DINP, (const float*)(F.ws + WS_ROPE64), (const float*)(F.ws + WS_ROPE32), (bf16*)(F.ws + WS_AQR)};
            pg8::gemm_phase<pg8::EpiZR, pg8::StaticOrder, true, true>(F.lds3, g, S, E);
        }
        SEAM(P + 1); PROBE_T1(P + 1);
        PROBE_T0(P + 2);
        if (IN(P + 2)) { SUBP(1, prep_mlstm(F, args, layer)); SUBP(2, prep_compress(F, args, layer)); }
        SEAM(P + 2); PROBE_T1(P + 2);
        PROBE_T0(P + 3);
        if (IN(P + 3)) ph_d_queue(F, args, layer);
        SEAM(P + 3); PROBE_T1(P + 3);
        PROBE_T0(P + 4);
        if (IN(P + 4)) { SUBP(4, ph_mlstm_out(F, args, layer)); SUBP(5, dil_combine(F)); }
        SEAM(P + 4); PROBE_T1(P + 4);
        PROBE_T0(P + 5);
        if (IN(P + 5)) {
            pg8::Gemm g{H, WOUT, T, DM, DM}; pg8::StaticOrder S; S.init(T, DM, F.G, (int)blockIdx.x); pg8::EpiRes E{layer == 0 ? args.in[0] : XR, XR, DM};
            pg8::gemm_phase<pg8::EpiRes, pg8::StaticOrder, true, true>(F.lds3, g, S, E);
        }
        SEAM(P + 5); PROBE_T1(P + 5);
        PROBE_T0(P + 6);
        if (IN(P + 6)) norm_rows_bf16(F, XR, args.in[14] + (size_t)layer * DM, XB2);
        SEAM(P + 6); PROBE_T1(P + 6);
        PROBE_T0(P + 7);
        if (IN(P + 7)) {
            pg8::Gemm g{XB2, WGU, T, 2 * DFF, DM}; pg8::StaticOrder S; S.init(T, 2 * DFF, F.G, (int)blockIdx.x); pg8::EpiSwiGLU E{ACT, DFF};
            pg8::gemm_phase<pg8::EpiSwiGLU, pg8::StaticOrder, true, true>(F.lds3, g, S, E);
        }
        SEAM(P + 7); PROBE_T1(P + 7);
        PROBE_T0(P + 8);
        if (IN(P + 8)) {
            pg8::Gemm g{ACT, WD, T, DM, DFF}; pg8::StaticOrder S; S.init(T, DM, F.G, (int)blockIdx.x); pg8::EpiRes E{XR, XR, DM};
            pg8::gemm_phase<pg8::EpiRes, pg8::StaticOrder, true, true>(F.lds3, g, S, E);
        }
        SEAM(P + 8); PROBE_T1(P + 8);
}
__global__ void __launch_bounds__(NTHREADS, 2) fwd_kernel(Args args) {
    extern __shared__ __attribute__((aligned(16))) unsigned char lds[];
    Frame F;
    F.lds = lds; F.lds3 = (LAS unsigned char*)lds; F.MISC = (volatile LAS unsigned*)(F.lds3 + MISC_OFF);
    F.tid = threadIdx.x; F.lane = F.tid & 63; F.wave = __builtin_amdgcn_readfirstlane(F.tid >> 6);
    F.G = gridDim.x; F.gw = blockIdx.x * NWAVES + F.wave; F.ngw = F.G * NWAVES;
    F.ws = args.ws; F.ctl = (unsigned*)(args.ws + WS_CTL);
    for (int u = F.tid; u < (LDS_BYTES - LDSCTL_OFF) / 4; u += NTHREADS) ((LAS unsigned*)(F.lds3 + LDSCTL_OFF))[u] = 0u;
    __syncthreads();
    XcdBarrier bar = xcd_barrier_post(F.ctl + CW_BAR, F.MISC + 8);
    run_layer<0>(F, args, bar);
    run_layer<1>(F, args, bar);
    if (IN(9 * DEPTH)) final_norm(F, args.out, args.in[18]);
#ifdef PROBE_K
    if (blockIdx.x == 0) { const unsigned long long te = __builtin_amdgcn_s_memrealtime(); while (__builtin_amdgcn_s_memrealtime() - te < (unsigned long long)PROBE_AMP * F.pdt) __builtin_amdgcn_s_sleep(32); }
#endif
#undef IN
#undef SEAM
}

extern "C" void kernel_launch(void* const* d_in, const int* in_sizes, int n_in, void* d_out, int out_size, void* d_ws, size_t ws_size, hipStream_t stream) {
    static int grid = 0;
    if (grid == 0) {
        if (n_in != 19 || in_sizes[0] != T * DM || out_size != T * DM || ws_size < WS_END) { fprintf(stderr, "kernel_launch: unexpected shapes (n_in %d, in0 %d, out %d, ws %zu); nothing launched\n", n_in, n_in > 0 ? in_sizes[0] : -1, out_size, ws_size); grid = -1; return; }
        int dev = 0, cus = 0, per_cu = 0;
        if (hipGetDevice(&dev) != hipSuccess || hipDeviceGetAttribute(&cus, hipDeviceAttributeMultiprocessorCount, dev) != hipSuccess) { grid = -1; return; }
        if (hipFuncSetAttribute((const void*)fwd_kernel, hipFuncAttributeMaxDynamicSharedMemorySize, LDS_BYTES) != hipSuccess) { fprintf(stderr, "kernel_launch: hipFuncSetAttribute failed\n"); grid = -1; return; }
        if (hipOccupancyMaxActiveBlocksPerMultiprocessor(&per_cu, (const void*)fwd_kernel, NTHREADS, LDS_BYTES) != hipSuccess || per_cu < 1) { fprintf(stderr, "kernel_launch: note: occupancy query says %d blocks per CU\n", per_cu); (void)hipGetLastError(); }
        grid = cus;
    }
    if (grid < 0) return;
    if (hipMemsetAsync((char*)d_ws + WS_CTL, 0, CTL_ZERO_BYTES, stream) != hipSuccess) { fprintf(stderr, "kernel_launch: memset failed\n"); return; }
    Args a{};
    for (int i = 0; i < 19; ++i) a.in[i] = (const float*)d_in[i];
    a.out = (float*)d_out; a.ws = (unsigned char*)d_ws;
    for (int i = 0; i < 32; ++i) a.inv64[i] = 1.0f / powf(10000.0f, (float)(2 * i) / 64.0f);
    for (int i = 0; i < 16; ++i) a.inv32[i] = 1.0f / powf(10000.0f, (float)(2 * i) / 32.0f);
    void* params[] = {&a};
    const hipError_t le = hipLaunchCooperativeKernel((const void*)fwd_kernel, dim3(grid), dim3(NTHREADS), params, LDS_BYTES, stream);
    if (le != hipSuccess) fprintf(stderr, "kernel_launch: cooperative launch failed: %s (grid %d)\n", hipGetErrorName(le), grid);
}
```

```cpp
#include <hip/hip_runtime.h>
#include <hip/hip_cooperative_groups.h>
#include <cstdio>
#include <cstdint>
namespace cg = cooperative_groups;
namespace pg8 {
#define PG8_LAS __attribute__((address_space(3)))
typedef unsigned short bf16_t;
typedef short bf16x8 __attribute__((ext_vector_type(8)));
typedef float f32x4 __attribute__((ext_vector_type(4)));
typedef unsigned u32x4 __attribute__((ext_vector_type(4)));
constexpr int BM = 256, BK = 64, HALF = 128, HTB = HALF * BK * 2  , STAGE_BYTES = 8 * HTB, NXCD = 8, WGM = 8;

__host__ __device__ __forceinline__ int lds_byte(int r, int c) { const int st = (r >> 4) * 2 + (c >> 5), rr = r & 15, cc = c & 31, ob = rr * 64 + cc * 2; return st * 1024 + (ob ^ (((ob >> 9) & 1) << 5)); }
__host__ __device__ __forceinline__ void stage_rc(int b, int& R, int& C) { const int st = b / 1024, sb = b % 1024, swz = sb ^ (((sb >> 9) & 1) << 5); R = (st >> 1) * 16 + swz / 64; C = (st & 1) * 32 + (swz % 64) / 2; }
__host__ __device__ __forceinline__ int perm32(int rho) { const int n = rho >> 4, i = rho & 15; return 8 * (i >> 2) + 4 * n + (i & 3); }

struct Unit { int pm, pn; };
struct Gemm { const bf16_t* A; const bf16_t* Bt; int M, N, K; };

struct StaticOrder {
    int nM, nN, nwg, G, c;
    __host__ __device__ void init(int M, int N, int G_, int c_) { nM = M / BM; nN = N / BM; nwg = nM * nN; G = G_; c = c_; }
    __host__ __device__ bool next(int i, Unit& u) const {
        const long L = (long)i * G + c; if (L >= nwg) return false;
        int wgid = (int)L; { const int q = nwg / NXCD, r = nwg % NXCD, xcd = wgid % NXCD, off = wgid / NXCD; wgid = (xcd < r ? xcd * (q + 1) : r * (q + 1) + (xcd - r) * q) + off; }
        const int nig = WGM * nN, gid = wgid / nig, fm = gid * WGM, gsz = (nM - fm) < WGM ? (nM - fm) : WGM;
        u.pm = fm + ((wgid % nig) % gsz); u.pn = (wgid % nig) / gsz; return true;
    }
    __device__ __forceinline__ void a_ready(const Unit&) const {}
    __device__ __forceinline__ void done(const Unit&) const {}
};

__device__ __forceinline__ unsigned cvt_pk_bf16(float lo, float hi) { unsigned r; asm volatile("v_cvt_pk_bf16_f32 %0, %1, %2" : "=v"(r) : "v"(lo), "v"(hi)); return r; }
typedef float f32x2 __attribute__((ext_vector_type(2)));
struct EpiZR {
    static constexpr bool PERM = true, AFTER_DRAIN = false;
    bf16_t* O; int ldc; const float* r64; const float* r32; bf16_t* aqr;
    __device__ __forceinline__ void operator()(const f32x4 (&acc)[2][2][4][2], const Unit& u, int wr, int wc, int fr, int fq) const {
        const int row0 = u.pm * BM + wr * 64 + fr, col0 = u.pn * BM + wc * 32 + 8 * fq;
        constexpr unsigned long long R64 = 0xFull | (1ull << 6) | (1ull << 8) | (0xFFull << 34), R32 = 0xFFull << 10;
#pragma unroll
        for (int ai = 0; ai < 2; ++ai)
#pragma unroll
            for (int m = 0; m < 4; ++m) { const int row = row0 + ai * HALF + m * 16; const int pos = row & 4095; bf16_t* rowp = O + (size_t)row * ldc + col0;
#pragma unroll
                for (int bj = 0; bj < 2; ++bj) { f32x4 v0 = acc[ai][bj][m][0], v1 = acc[ai][bj][m][1]; const int c0 = col0 + bj * HALF, seg = c0 >> 6;
                    const bool t64 = (R64 >> seg) & 1ull, t32 = (R32 >> seg) & 1ull;
                    if (t64 || t32) {
                        const float* tp = t64 ? r64 + ((size_t)pos * 32 + ((c0 & 63) >> 1)) * 2 : r32 + ((size_t)pos * 16 + ((c0 & 31) >> 1)) * 2;
                        const f32x4 ca = *(const f32x4*)tp, cb = *(const f32x4*)(tp + 4);
                        const f32x4 o0 = {v0[0] * ca[0] - v0[1] * ca[1], v0[0] * ca[1] + v0[1] * ca[0], v0[2] * ca[2] - v0[3] * ca[3], v0[2] * ca[3] + v0[3] * ca[2]};
                        const f32x4 o1 = {v1[0] * cb[0] - v1[1] * cb[1], v1[0] * cb[1] + v1[1] * cb[0], v1[2] * cb[2] - v1[3] * cb[3], v1[2] * cb[3] + v1[3] * cb[2]};
                        if (seg < 4) { u32x4 wq; wq.x = cvt_pk_bf16(o0[0], o0[1]); wq.y = cvt_pk_bf16(o0[2], o0[3]); wq.z = cvt_pk_bf16(o1[0], o1[1]); wq.w = cvt_pk_bf16(o1[2], o1[3]); *(u32x4*)(aqr + (size_t)row * 256 + c0) = wq; }
                        else { v0 = o0; v1 = o1; }
                    }
                    u32x4 w; w.x = cvt_pk_bf16(v0[0], v0[1]); w.y = cvt_pk_bf16(v0[2], v0[3]); w.z = cvt_pk_bf16(v1[0], v1[1]); w.w = cvt_pk_bf16(v1[2], v1[3]);
                    *(u32x4*)(rowp + bj * HALF) = w; } }
    }
};
struct EpiRes {
    static constexpr bool PERM = false, AFTER_DRAIN = false;
    const float* base; float* out; int ldc;
    __device__ __forceinline__ void operator()(const f32x4 (&acc)[2][2][4][2], const Unit& u, int wr, int wc, int fr, int fq) const {
        const int row0 = u.pm * BM + wr * 64 + fr, col0 = u.pn * BM + wc * 32 + 4 * fq;
#pragma unroll
        for (int ai = 0; ai < 2; ++ai)
#pragma unroll
            for (int m = 0; m < 4; ++m) { const size_t off = (size_t)(row0 + ai * HALF + m * 16) * ldc + col0;
#pragma unroll
                for (int bj = 0; bj < 2; ++bj)
#pragma unroll
                    for (int n = 0; n < 2; ++n) { const size_t p = off + bj * HALF + n * 16; const f32x4 b = *(const f32x4*)(base + p); *(f32x4*)(out + p) = b + acc[ai][bj][m][n]; } }
    }
};
struct EpiSwiGLU {
    static constexpr bool PERM = true, AFTER_DRAIN = false;
    bf16_t* O; int ldc;
    __device__ __forceinline__ void operator()(const f32x4 (&acc)[2][2][4][2], const Unit& u, int wr, int wc, int fr, int fq) const {
        const int row0 = u.pm * BM + wr * 64 + fr, col0 = u.pn * HALF + wc * 32 + 8 * fq;
#pragma unroll
        for (int ai = 0; ai < 2; ++ai)
#pragma unroll
            for (int m = 0; m < 4; ++m) { const int row = row0 + ai * HALF + m * 16; bf16_t* rowp = O + (size_t)row * ldc + col0;
                float r[8];
#pragma unroll
                for (int n = 0; n < 2; ++n)
#pragma unroll
                    for (int j = 0; j < 4; ++j) { const float g = acc[ai][0][m][n][j], up = acc[ai][1][m][n][j]; r[4 * n + j] = g * __builtin_amdgcn_rcpf(1.0f + __expf(-g)) * up; }
                u32x4 w; w.x = cvt_pk_bf16(r[0], r[1]); w.y = cvt_pk_bf16(r[2], r[3]); w.z = cvt_pk_bf16(r[4], r[5]); w.w = cvt_pk_bf16(r[6], r[7]);
                *(u32x4*)rowp = w; }
    }
};
template <class Epi, class Sched, bool ALIGN_EPI = false, bool SP2 = false>
__device__ __forceinline__ void gemm_phase(PG8_LAS unsigned char* lds, const Gemm g, const Sched& S, const Epi& E) {
    int tid_ = threadIdx.x; asm volatile("" : "+v"(tid_));
    const int tid = tid_, wid = __builtin_amdgcn_readfirstlane(tid >> 6), lane = tid & 63, wr = wid >> 2, wc = wid & 3, fr = lane & 15, fq = lane >> 4;
    const int K = g.K, nt = K / BK;
    unsigned voffA[2], voffB[2];
#pragma unroll
    for (int i = 0; i < 2; ++i) { int R, C; stage_rc(tid * 16 + i * 8192, R, C); const int Rb = Epi::PERM ? ((R & ~31) + perm32(R & 31)) : R;
        voffA[i] = (unsigned)(R * K + C) * 2u; voffB[i] = (unsigned)(Rb * K + C) * 2u; }
    const size_t kstep = (size_t)(BK * 2);
    const size_t hstep = (size_t)HALF * K * 2;
    const size_t tstep = 2 * hstep;
    const unsigned ldsw = (unsigned)wid * 1024u;
    const int aoff = lds_byte(wr * 64 + fr, fq * 8), boff = lds_byte(wc * 32 + fr, fq * 8);
#define PG8_SA(b, h) (((b) * 2 + (h)) * HTB)
#define PG8_SB(b, h) ((4 + (b) * 2 + (h)) * HTB)
#define PG8_STAGE(bufoff, gbase, voff) do { _Pragma("unroll") for (int _i = 0; _i < 2; ++_i) \
        __builtin_amdgcn_global_load_lds((const unsigned*)((const char*)(gbase) + (voff)[_i]), (PG8_LAS unsigned*)(lds + (bufoff) + ldsw + _i * 8192), 16, 0, 0); } while (0)
#define PG8_LDA(dst, b, h) do { _Pragma("unroll") for (int m = 0; m < 4; ++m) _Pragma("unroll") for (int k = 0; k < 2; ++k) dst[m][k] = *(const PG8_LAS bf16x8*)(lds + PG8_SA(b, h) + aoff + m * 2048 + k * 1024); } while (0)
#define PG8_LDB(dst, b, h) do { _Pragma("unroll") for (int n = 0; n < 2; ++n) _Pragma("unroll") for (int k = 0; k < 2; ++k) dst[n][k] = *(const PG8_LAS bf16x8*)(lds + PG8_SB(b, h) + boff + n * 2048 + k * 1024); } while (0)
#define PG8_MMA(ai, bj, At, Bt) do { __builtin_amdgcn_s_setprio(1); _Pragma("unroll") for (int m = 0; m < 4; ++m) _Pragma("unroll") for (int n = 0; n < 2; ++n) _Pragma("unroll") for (int k = 0; k < 2; ++k) \
        acc[ai][bj][m][n] = __builtin_amdgcn_mfma_f32_16x16x32_bf16(Bt[n][k], At[m][k], acc[ai][bj][m][n], 0, 0, 0); __builtin_amdgcn_s_setprio(0); } while (0)
#define PG8_WAIT_V(n) asm volatile("s_waitcnt vmcnt(" #n ")" ::: "memory")
#define PG8_WAIT_L(n) asm volatile("s_waitcnt lgkmcnt(" #n ")" ::: "memory")
#define PG8_BAR __builtin_amdgcn_s_barrier()
#define PG8_SCHED __builtin_amdgcn_sched_barrier(0)
    Unit cur, nxt; int ui = 0;
    if (!S.next(0, cur)) return;
    f32x4 acc[2][2][4][2];
#pragma unroll
    for (int a = 0; a < 2; ++a)
#pragma unroll
        for (int b = 0; b < 2; ++b)
#pragma unroll
            for (int m = 0; m < 4; ++m)
#pragma unroll
                for (int n = 0; n < 2; ++n) acc[a][b][m][n] = (f32x4){0.f, 0.f, 0.f, 0.f};
    bf16x8 At[4][2], B0[2][2], B1[2][2];
    const char* cA = (const char*)g.A + (size_t)cur.pm * tstep; const char* cB = (const char*)g.Bt + (size_t)cur.pn * tstep;
    S.a_ready(cur);
    if constexpr (SP2) {
        PG8_STAGE(PG8_SB(0, 0), cB, voffB); PG8_STAGE(PG8_SB(0, 1), cB + hstep, voffB); PG8_STAGE(PG8_SA(0, 0), cA, voffA); PG8_STAGE(PG8_SA(0, 1), cA + hstep, voffA);
        if (wr == 1) PG8_BAR;
        PG8_WAIT_V(2); PG8_BAR;
        PG8_STAGE(PG8_SB(1, 0), cB + kstep, voffB); PG8_STAGE(PG8_SA(1, 0), cA + kstep, voffA); PG8_STAGE(PG8_SB(1, 1), cB + hstep + kstep, voffB);
        PG8_WAIT_V(6); PG8_BAR;
    } else {
        PG8_STAGE(PG8_SB(0, 0), cB, voffB); PG8_STAGE(PG8_SA(0, 0), cA, voffA); PG8_STAGE(PG8_SB(0, 1), cB + hstep, voffB); PG8_STAGE(PG8_SA(0, 1), cA + hstep, voffA);
        if (wr == 1) PG8_BAR;
        PG8_WAIT_V(4); PG8_BAR;
        PG8_STAGE(PG8_SB(1, 0), cB + kstep, voffB); PG8_STAGE(PG8_SA(1, 0), cA + kstep, voffA); PG8_STAGE(PG8_SB(1, 1), cB + hstep + kstep, voffB);
        PG8_WAIT_V(6); PG8_BAR;
    }
    for (;;) {
        const bool has_next = S.next(ui + 1, nxt);
        const char* nA = has_next ? (const char*)g.A + (size_t)nxt.pm * tstep : cA; const char* nB = has_next ? (const char*)g.Bt + (size_t)nxt.pn * tstep : cB;
        for (int t = 0; t < nt; t += 2) {
            const bool last = (t == nt - 2);
            const char* a1 = cA + (size_t)(t + 1) * kstep;
            const char* a2 = last ? nA : cA + (size_t)(t + 2) * kstep; const char* b2 = last ? nB : cB + (size_t)(t + 2) * kstep;
            const char* a3 = a2 + kstep; const char* b3 = b2 + kstep;
            if (last && has_next) S.a_ready(nxt);
            if constexpr (SP2) {
            PG8_LDB(B0, 0, 0); PG8_LDB(B1, 0, 1); PG8_SCHED; PG8_LDA(At, 0, 0); PG8_STAGE(PG8_SA(1, 1), a1 + hstep, voffA);
            PG8_WAIT_V(8); PG8_WAIT_L(0); PG8_BAR; PG8_MMA(0, 0, At, B0); PG8_MMA(0, 1, At, B1); PG8_BAR; PG8_SCHED;
            PG8_LDA(At, 0, 1); PG8_STAGE(PG8_SB(0, 0), b2, voffB); PG8_STAGE(PG8_SB(0, 1), b2 + hstep, voffB); PG8_STAGE(PG8_SA(0, 0), a2, voffA);
            PG8_WAIT_V(8); PG8_WAIT_L(0); PG8_BAR; PG8_MMA(1, 0, At, B0); PG8_MMA(1, 1, At, B1); PG8_BAR; PG8_SCHED;
            PG8_LDB(B0, 1, 0); PG8_LDB(B1, 1, 1); PG8_SCHED; PG8_LDA(At, 1, 0); PG8_STAGE(PG8_SA(0, 1), a2 + hstep, voffA);
            PG8_WAIT_V(8); PG8_WAIT_L(0); PG8_BAR; PG8_MMA(0, 0, At, B0); PG8_MMA(0, 1, At, B1); PG8_BAR; PG8_SCHED;
            PG8_LDA(At, 1, 1); PG8_STAGE(PG8_SB(1, 0), b3, voffB); PG8_STAGE(PG8_SB(1, 1), b3 + hstep, voffB); PG8_STAGE(PG8_SA(1, 0), a3, voffA);
            PG8_WAIT_V(8); PG8_WAIT_L(0); PG8_BAR; PG8_MMA(1, 0, At, B0); PG8_MMA(1, 1, At, B1); PG8_BAR; PG8_SCHED;
            } else {
            PG8_LDB(B0, 0, 0); PG8_SCHED; PG8_LDA(At, 0, 0); PG8_STAGE(PG8_SA(1, 1), a1 + hstep, voffA);
            PG8_WAIT_L(8); PG8_BAR; PG8_WAIT_L(0); PG8_MMA(0, 0, At, B0); PG8_BAR; PG8_SCHED;
            PG8_LDB(B1, 0, 1); PG8_STAGE(PG8_SB(0, 0), b2, voffB);
            PG8_BAR; PG8_WAIT_L(0); PG8_MMA(0, 1, At, B1); PG8_BAR;
            PG8_LDA(At, 0, 1); PG8_STAGE(PG8_SA(0, 0), a2, voffA);
            PG8_BAR; PG8_WAIT_L(0); PG8_MMA(1, 0, At, B0); PG8_BAR; PG8_SCHED;
            PG8_STAGE(PG8_SB(0, 1), b2 + hstep, voffB);
            PG8_WAIT_V(6); PG8_BAR; PG8_MMA(1, 1, At, B1); PG8_BAR;
            PG8_LDB(B0, 1, 0); PG8_SCHED; PG8_LDA(At, 1, 0); PG8_STAGE(PG8_SA(0, 1), a2 + hstep, voffA);
            PG8_WAIT_L(8); PG8_BAR; PG8_WAIT_L(0); PG8_MMA(0, 0, At, B0); PG8_BAR; PG8_SCHED;
            PG8_LDB(B1, 1, 1); PG8_STAGE(PG8_SB(1, 0), b3, voffB);
            PG8_BAR; PG8_WAIT_L(0); PG8_MMA(0, 1, At, B1); PG8_BAR;
            PG8_LDA(At, 1, 1); PG8_STAGE(PG8_SA(1, 0), a3, voffA);
            PG8_BAR; PG8_WAIT_L(0); PG8_MMA(1, 0, At, B0); PG8_BAR; PG8_SCHED;
            PG8_STAGE(PG8_SB(1, 1), b3 + hstep, voffB);
            PG8_WAIT_V(6); PG8_BAR; PG8_MMA(1, 1, At, B1); PG8_BAR;
            }
        }
        if constexpr (ALIGN_EPI) { if (wr == 0) PG8_BAR; }
        if constexpr (!Epi::AFTER_DRAIN) { E(acc, cur, wr, wc, fr, fq); S.done(cur); }
        if (!has_next) break;
#pragma unroll
        for (int a = 0; a < 2; ++a)
#pragma unroll
            for (int b = 0; b < 2; ++b)
#pragma unroll
                for (int m = 0; m < 4; ++m)
#pragma unroll
                    for (int n = 0; n < 2; ++n) acc[a][b][m][n] = (f32x4){0.f, 0.f, 0.f, 0.f};
        cur = nxt; cA = nA; cB = nB; ++ui;
        if constexpr (ALIGN_EPI) { if (wr == 1) PG8_BAR; }
    }
    PG8_WAIT_V(0);
    if constexpr (!ALIGN_EPI) { if (wr == 0) PG8_BAR; }
    PG8_BAR;
    if constexpr (Epi::AFTER_DRAIN) { E.fused(acc, cur, wr, wc, fr, fq, lds, wid, lane); S.done(cur); }
#undef PG8_SA
#undef PG8_SB
#undef PG8_STAGE
#undef PG8_LDA
#undef PG8_LDB
#undef PG8_MMA
#undef PG8_WAIT_V
#undef PG8_WAIT_L
#undef PG8_BAR
#undef PG8_SCHED
}
}

constexpr int NB = 4, SEQ = 4096, T = NB * SEQ, DM = 1024, DIN = 2964, DINP = 3072, DFF = 2816, DEPTH = 2;
constexpr int NWAVES = 8, NTHREADS = 512;
constexpr float EPS = 1e-6f;
constexpr int ZAQ = 0, ZKC = 256, ZVC = 320, ZKS = 384, ZVS = 448, ZKW = 512, ZVW = 576, ZBQ = 640, ZBK = 896, ZBV = 1152,
              ZCU = 1408, ZCV = 1664, ZCO = 1920, ZDQ = 2176, ZDK = 2432, ZDV = 2688, ZAG = 2944, ZCI = 2956, ZCF = 2960;
__host__ __device__ __forceinline__ int pi64(int p) { return (p & 1) ? 32 + (p >> 1) : (p >> 1); }
__host__ __device__ __forceinline__ int pi32(int p) { return (p & 1) ? 16 + (p >> 1) : (p >> 1); }
__host__ __device__ __forceinline__ int zsrc(int n) {
    const int seg = n >> 6, p = n & 63;
    const bool r64 = seg < 4 || seg == 6 || seg == 8 || (seg >= 34 && seg < 42), r32 = seg >= 10 && seg < 18;
    const int q = r64 ? pi64(p) : r32 ? (p & 32) + pi32(p & 31) : p; const int m = seg * 64 + q;
    if (m < 640) return m;
    if (m < 1920) return m + 12;
    if (m < 2944) return m + 20;
    if (m < 2956) return m - 2944 + 640;
    if (m < 2960) return m - 2956 + 1932;
    if (m < 2964) return m - 2960 + 1936;
    return -1;
}
constexpr size_t MiB = 1u << 20;
constexpr size_t WS_CTL = 0, CTL_ZERO_BYTES = 1 * MiB;
constexpr size_t WS_WIN = 2 * MiB, WS_WOUT = 8 * MiB, WS_WGU = 10 * MiB, WS_WD = 21 * MiB;
constexpr size_t WS_ROPE64 = 27 * MiB, WS_ROPE32 = 28 * MiB;
constexpr size_t WS_KC = 29 * MiB, WS_VC = WS_KC + 256 * 1024;
constexpr size_t WS_SEL = WS_VC + 256 * 1024;
constexpr size_t WS_BCUM = 30 * MiB, WS_IG = WS_BCUM + 256 * 1024, WS_NLOC = WS_IG + 256 * 1024;
constexpr size_t WS_ACH = WS_NLOC + 256 * 1024, WS_MLOC = WS_ACH + 4096, WS_MIN = WS_MLOC + 4096;
constexpr size_t WS_WCT = 26 * MiB + 512 * 1024;
constexpr size_t WS_CBP = 28 * MiB + 512 * 1024;
constexpr size_t WS_DLSE = 31 * MiB;
constexpr size_t WS_H = 32 * MiB;
constexpr size_t WS_Z = 64 * MiB;
constexpr size_t WS_XB2 = 64 * MiB, WS_ACT = 96 * MiB;
constexpr size_t WS_AQR = 160 * MiB, WS_OCMP = 168 * MiB, WS_DPART = 176 * MiB;
constexpr size_t WS_MQ = 200 * MiB, WS_MK = 216 * MiB, WS_CLOC = 232 * MiB, WS_END = 248 * MiB;
constexpr int CW_BAR = 4096;
constexpr int CW_Q = 16384;
constexpr int RING_BYTES = 131072, LDSCTL_OFF = RING_BYTES, MISC_OFF = LDSCTL_OFF + 320, LDS_BYTES = 147456;

#define GAS __attribute__((address_space(1)))
#define LAS __attribute__((address_space(3)))
typedef unsigned short bf16;
typedef unsigned v4u __attribute__((ext_vector_type(4)));
typedef unsigned v2u __attribute__((ext_vector_type(2)));
typedef float f32x4 __attribute__((ext_vector_type(4)));
typedef float f32x2 __attribute__((ext_vector_type(2)));
#define LDS_WAIT() asm volatile("s_waitcnt lgkmcnt(0)" ::: "memory")
#define VM_WAIT() asm volatile("s_waitcnt vmcnt(0)" ::: "memory")
__device__ __forceinline__ unsigned f2bf(float f) { unsigned u = __builtin_bit_cast(unsigned, f); return (u + 0x7fffu + ((u >> 16) & 1u)) >> 16; }
__device__ __forceinline__ unsigned pk2(float lo, float hi) { return f2bf(lo) | (f2bf(hi) << 16); }
__device__ __forceinline__ float bf2f(bf16 u) { return __uint_as_float(((unsigned)u) << 16); }
__device__ __forceinline__ float bflo(unsigned w) { return __uint_as_float(w << 16); }
__device__ __forceinline__ float bfhi(unsigned w) { return __uint_as_float(w & 0xffff0000u); }
template <int K> __device__ __forceinline__ int sx_i(int v) {
    if constexpr (K == 1) return __builtin_amdgcn_update_dpp(v, v, 0xB1, 0xF, 0xF, false);
    else if constexpr (K == 2) return __builtin_amdgcn_update_dpp(v, v, 0x4E, 0xF, 0xF, false);
    else return __builtin_amdgcn_ds_swizzle(v, (K << 10) | 0x1f);
}
template <int K> __device__ __forceinline__ float sx(float v) { return __builtin_bit_cast(float, sx_i<K>(__builtin_bit_cast(int, v))); }
__device__ __forceinline__ void swap32(unsigned v, unsigned& a, unsigned& b) { unsigned w = v; asm volatile("" : "+v"(w)); const auto rr = __builtin_amdgcn_permlane32_swap(v, w, false, false); a = rr[0]; b = rr[1]; }
__device__ __forceinline__ float sum32(float v) { unsigned a, b; swap32(__builtin_bit_cast(unsigned, v), a, b); return __builtin_bit_cast(float, a) + __builtin_bit_cast(float, b); }
__device__ __forceinline__ float max32(float v) { unsigned a, b; swap32(__builtin_bit_cast(unsigned, v), a, b); return fmaxf(__builtin_bit_cast(float, a), __builtin_bit_cast(float, b)); }
__device__ __forceinline__ unsigned or32(unsigned v) { unsigned a, b; swap32(v, a, b); return a | b; }
__device__ __forceinline__ float lane_get(float v, int src) { return __builtin_bit_cast(float, __builtin_amdgcn_ds_bpermute(src << 2, __builtin_bit_cast(int, v))); }
__device__ __forceinline__ float wave_sum(float v) { v += sx<1>(v); v += sx<2>(v); v += sx<4>(v); v += sx<8>(v); v += sx<16>(v); return sum32(v); }
__device__ __forceinline__ float wave_max(float v) { v = fmaxf(v, sx<1>(v)); v = fmaxf(v, sx<2>(v)); v = fmaxf(v, sx<4>(v)); v = fmaxf(v, sx<8>(v)); v = fmaxf(v, sx<16>(v)); return max32(v); }
__device__ __forceinline__ float sigmoidf_(float x) { return 1.0f / (1.0f + __expf(-x)); }
#define XB_TMO      128
#define XB_XCNT(j)  (256  + 64 * (j))
#define XB_XSUB(j)  (1280 + 64 * (j))
#define XB_XGEN(j)  (2304 + 64 * (j))
#define XB_TOP      3328
#define XB_TOPGEN   3392
#define XCD_BAR_WORDS 3456
#define XB_SPIN_CAP (1u << 18)

__device__ __forceinline__ unsigned xb_ld(unsigned* p)              { return __hip_atomic_load(p, __ATOMIC_RELAXED, __HIP_MEMORY_SCOPE_AGENT); }
__device__ __forceinline__ unsigned xb_add(unsigned* p, unsigned v) { return __hip_atomic_fetch_add(p, v, __ATOMIC_RELAXED, __HIP_MEMORY_SCOPE_AGENT); }
__device__ __forceinline__ unsigned xb_xcc_id() { return (unsigned)__builtin_amdgcn_s_getreg((3 << 11) | 20) & 0xFu; }
#define XB_SPIN(cond, bar) do { unsigned _sp = 0; while (cond) { __builtin_amdgcn_s_sleep(1); \
    if ((++_sp & 255u) == 0u) { if (xb_ld(&(bar)[XB_TMO])) break; if (_sp > XB_SPIN_CAP) { atomicAdd(&(bar)[XB_TMO], 1u); break; } } } } while (0)

struct XcdBarrier {
    unsigned* bar; unsigned x;
    volatile LAS unsigned* st;
};

__device__ __forceinline__ XcdBarrier xcd_barrier_post(unsigned* bar, volatile LAS unsigned* st) {
    XcdBarrier b; b.bar = bar; b.x = xb_xcc_id(); b.st = st;
    if (threadIdx.x == 0) (void)xb_add(&bar[XB_XCNT(b.x)], 1u);
    return b;
}
__device__ __forceinline__ void xcd_barrier_complete(unsigned* bar, unsigned x, unsigned& nloc, unsigned& nx) {
    const unsigned G = gridDim.x * gridDim.y * gridDim.z;
    unsigned sum, cnt, mine, sp = 0u;
    for (;;) {
        sum = 0u; cnt = 0u; mine = 0u;
#pragma unroll 1
        for (unsigned j = 0; j < 16; ++j) { const unsigned c = xb_ld(&bar[XB_XCNT(j)]); sum += c; cnt += (c > 0u) ? 1u : 0u; mine = (j == x) ? c : mine; }
        if (sum == G) break;
        __builtin_amdgcn_s_sleep(1);
        if ((++sp & 255u) == 0u) { if (xb_ld(&bar[XB_TMO])) break; if (sp > XB_SPIN_CAP) { atomicAdd(&bar[XB_TMO], 1u); break; } }
    }
    nloc = mine > 0u ? mine : 1u; nx = cnt > 0u ? cnt : 1u;
}

__device__ __forceinline__ void xcd_barrier(const XcdBarrier& b) {
    asm volatile("s_waitcnt vmcnt(0)" ::: "memory");
    __syncthreads();
    if (threadIdx.x == 0) {
        unsigned* bar = b.bar;
        __builtin_amdgcn_s_waitcnt(0);
        unsigned nloc = b.st[0], nx = b.st[1];
        if (nloc == 0u) { xcd_barrier_complete(bar, b.x, nloc, nx); b.st[0] = nloc; b.st[1] = nx; }
        const unsigned old = xb_add(&bar[XB_XSUB(b.x)], 1u);
        const unsigned gen = old / nloc;
        if (old + 1u == (gen + 1u) * nloc) {
            __builtin_amdgcn_fence(__ATOMIC_RELEASE, "agent");
            asm volatile("s_waitcnt vmcnt(0)" ::: "memory");
            const unsigned og = xb_add(&bar[XB_TOP], 1u);
            const unsigned tg = og / nx;
            if (og + 1u == (tg + 1u) * nx) xb_add(&bar[XB_TOPGEN], 1u);
            else XB_SPIN(xb_ld(&bar[XB_TOPGEN]) == tg, bar);
            __builtin_amdgcn_fence(__ATOMIC_ACQUIRE, "agent");
            xb_add(&bar[XB_XGEN(b.x)], 1u);
            asm volatile("s_waitcnt vmcnt(0)" ::: "memory");
        } else {
            XB_SPIN(xb_ld(&bar[XB_XGEN(b.x)]) == gen, bar);
            __builtin_amdgcn_fence(__ATOMIC_ACQUIRE, "agent");
            asm volatile("s_waitcnt vmcnt(0)" ::: "memory");
        }
    }
    __syncthreads();
}

struct Args { const float* in[19]; float* out; unsigned char* ws; float inv64[32]; float inv32[16]; };
struct Frame {
    unsigned char* lds;
    LAS unsigned char* lds3;
    volatile LAS unsigned* MISC;
    unsigned* ctl;
    unsigned char* ws;
    int tid, lane, wave, G, gw, ngw;
    unsigned long long pt0, pdt;
};
#define PHASE_IDS(F) do { int t_ = threadIdx.x; asm volatile("" : "+v"(t_)); (F).tid = t_; (F).lane = t_ & 63; (F).wave = __builtin_amdgcn_readfirstlane(t_ >> 6); (F).gw = blockIdx.x * NWAVES + (F).wave; } while (0)


__device__ __forceinline__ void transpose_item(const float* W, int K, int N, int srccol  , bf16* WT, int n0, int k0, float* scr, int lane, const float* gain = nullptr  ) {
#pragma unroll
    for (int i = 0; i < 32; ++i) { const int kk = 2 * i + (lane >> 5); scr[kk * 33 + (lane & 31)] = srccol >= 0 ? W[(size_t)(k0 + kk) * N + srccol] * (gain ? gain[k0 + kk] : 1.0f) : 0.f; }
    LDS_WAIT(); asm volatile("" ::: "memory");
    const int c = lane & 7;
#pragma unroll
    for (int j = 0; j < 4; ++j) { const int n = (lane >> 3) + 8 * j; const float* s = scr + (8 * c) * 33 + n;
        v4u o; o.x = pk2(s[0 * 33], s[1 * 33]); o.y = pk2(s[2 * 33], s[3 * 33]); o.z = pk2(s[4 * 33], s[5 * 33]); o.w = pk2(s[6 * 33], s[7 * 33]);
        *(v4u*)(WT + (size_t)(n0 + n) * K + k0 + 8 * c) = o; }
    LDS_WAIT(); asm volatile("" ::: "memory");
}
__device__ __forceinline__ void convert_weights(Frame& F, const Args& a, int layer) {
    PHASE_IDS(F);
    float* scr = (float*)(F.lds + F.wave * 16384);
    const float* w_in = a.in[2] + (size_t)layer * DM * DIN; const float* w_out = a.in[13] + (size_t)layer * DM * DM;
    const float* w_gate = a.in[15] + (size_t)layer * DM * DFF; const float* w_up = a.in[16] + (size_t)layer * DM * DFF; const float* w_down = a.in[17] + (size_t)layer * DFF * DM;
    bf16* WIN = (bf16*)(F.ws + WS_WIN); bf16* WOUT = (bf16*)(F.ws + WS_WOUT); bf16* WGU = (bf16*)(F.ws + WS_WGU); bf16* WD = (bf16*)(F.ws + WS_WD);
    constexpr int I_IN = (DM / 64) * (DINP / 32), I_OUT = (DM / 64) * (DM / 32), I_GU = (DM / 64) * (2 * DFF / 32), I_D = (DFF / 64) * (DM / 32);
    constexpr int I_C = 2 * (2048 / 64) * (64 / 32), I_CB = 64;
    constexpr int NITEMS = I_IN + I_OUT + I_GU + I_D + I_C + I_CB;
    const float* cmp_w = a.in[4] + (size_t)layer * 2 * 2048 * 64; const float* cmp_pos = a.in[3] + (size_t)layer * 2 * 2048; bf16* WCT = (bf16*)(F.ws + WS_WCT); float* CBP = (float*)(F.ws + WS_CBP);
    for (int it = F.gw; it < NITEMS; it += F.ngw) {
        int r = it; const int l31 = F.lane & 31;
        if (r < I_IN) { const int nblk = DINP / 32, kb = r / nblk, nb = r % nblk; transpose_item(w_in, DM, DIN, zsrc(nb * 32 + l31), WIN, nb * 32, kb * 64, scr, F.lane); continue; } r -= I_IN;
        if (r < I_OUT) { const int nblk = DM / 32, kb = r / nblk, nb = r % nblk; transpose_item(w_out, DM, DM, nb * 32 + l31, WOUT, nb * 32, kb * 64, scr, F.lane); continue; } r -= I_OUT;
        if (r < I_GU) { const int nblk = 2 * DFF / 32, kb = r / nblk, nb = r % nblk, n0 = nb * 32, pn = n0 >> 8, w = n0 & 255;
            transpose_item(w < 128 ? w_gate : w_up, DM, DFF, 128 * pn + (w & 127) + l31, WGU, n0, kb * 64, scr, F.lane); continue; } r -= I_GU;
        if (r < I_D) { const int nblk = DM / 32, kb = r / nblk, nb = r % nblk; transpose_item(w_down, DFF, DM, nb * 32 + l31, WD, nb * 32, kb * 64, scr, F.lane); continue; } r -= I_D;
        if (r < I_C) { const int br = r >> 6, q = r & 63, kb = q >> 1, nb = q & 1; transpose_item(cmp_w + (size_t)br * 2048 * 64, 2048, 64, br == 0 ? pi64(nb * 32 + l31) : nb * 32 + l31, WCT + (size_t)br * 64 * 2048, nb * 32, kb * 64, scr, F.lane); continue; } r -= I_C;
        { const int br = r >> 5, ch = r & 31; float acc = 0.f;
#pragma unroll 8
          for (int k = ch * 64; k < ch * 64 + 64; ++k) acc += cmp_pos[br * 2048 + k] * cmp_w[((size_t)br * 2048 + k) * 64 + F.lane];
          CBP[(br * 32 + ch) * 64 + F.lane] = acc; }
    }
}
__device__ __forceinline__ void sincos_d(float ang, float& c, float& s) {
    const double a = (double)ang; const double q = __builtin_rint(a * 0.63661977236758134308); const double r = a - q * 1.57079632679489661923; const double r2 = r * r;
    double sp = -1.0 / 39916800.0; sp = sp * r2 + 1.0 / 362880.0; sp = sp * r2 - 1.0 / 5040.0; sp = sp * r2 + 1.0 / 120.0; sp = sp * r2 - 1.0 / 6.0; sp = sp * r2 + 1.0; sp *= r;
    double cp = 1.0 / 479001600.0; cp = cp * r2 - 1.0 / 3628800.0; cp = cp * r2 + 1.0 / 40320.0; cp = cp * r2 - 1.0 / 720.0; cp = cp * r2 + 1.0 / 24.0; cp = cp * r2 - 0.5; cp = cp * r2 + 1.0;
    const int n = ((int)q) & 3; const double cc = (n == 0) ? cp : (n == 1) ? -sp : (n == 2) ? -cp : sp; const double ss = (n == 0) ? sp : (n == 1) ? cp : (n == 2) ? -sp : -cp;
    c = (float)cc; s = (float)ss;
}
__device__ __forceinline__ void build_rope(Frame& F, const Args& a) {
    PHASE_IDS(F);
    f32x2* R64 = (f32x2*)(F.ws + WS_ROPE64); f32x2* R32 = (f32x2*)(F.ws + WS_ROPE32);
    const int gt = F.gw * 64 + F.lane, ngt = F.ngw * 64;
    for (int i = gt; i < SEQ * 48; i += ngt) { const int pos = i / 48, j = i % 48; float c, s;
        if (j < 32) { sincos_d((float)pos * a.inv64[j], c, s); R64[pos * 32 + j] = (f32x2){c, s}; }
        else { sincos_d((float)pos * a.inv32[j - 32], c, s); R32[pos * 16 + (j - 32)] = (f32x2){c, s}; } }
}
__device__ __forceinline__ void norm_rows_bf16(Frame& F, const float* X, const float* g, bf16* H) {
    PHASE_IDS(F);
    f32x4 gg[4];
#pragma unroll
    for (int j = 0; j < 4; ++j) gg[j] = ((const f32x4*)g)[64 * j + F.lane];
    for (int row0 = F.gw * 4; row0 < T; row0 += F.ngw * 4) {
        f32x4 v[4][4];
#pragma unroll
        for (int r = 0; r < 4; ++r)
#pragma unroll
            for (int j = 0; j < 4; ++j) v[r][j] = ((const f32x4*)(X + (size_t)(row0 + r) * DM))[64 * j + F.lane];
#pragma unroll
        for (int r = 0; r < 4; ++r) { float q = 0.f;
#pragma unroll
            for (int j = 0; j < 4; ++j) q += (v[r][j].x * v[r][j].x + v[r][j].y * v[r][j].y) + (v[r][j].z * v[r][j].z + v[r][j].w * v[r][j].w);
            const float rr = 1.0f / sqrtf(wave_sum(q) * (1.0f / DM) + EPS); v2u* o = (v2u*)(H + (size_t)(row0 + r) * DM) + F.lane;
#pragma unroll
            for (int j = 0; j < 4; ++j) { v2u w; w.x = pk2(v[r][j].x * rr * gg[j].x, v[r][j].y * rr * gg[j].y); w.y = pk2(v[r][j].z * rr * gg[j].z, v[r][j].w * rr * gg[j].w); o[64 * j] = w; } }
    }
}
__device__ __forceinline__ void final_norm(Frame& F, float* X, const float* g) {
    PHASE_IDS(F);
    f32x4 gg[4];
#pragma unroll
    for (int j = 0; j < 4; ++j) gg[j] = ((const f32x4*)g)[64 * j + F.lane];
    for (int row0 = F.gw * 4; row0 < T; row0 += F.ngw * 4) {
        f32x4 v[4][4];
#pragma unroll
        for (int r = 0; r < 4; ++r)
#pragma unroll
            for (int j = 0; j < 4; ++j) v[r][j] = ((const f32x4*)(X + (size_t)(row0 + r) * DM))[64 * j + F.lane];
#pragma unroll
        for (int r = 0; r < 4; ++r) { float q = 0.f;
#pragma unroll
            for (int j = 0; j < 4; ++j) q += (v[r][j].x * v[r][j].x + v[r][j].y * v[r][j].y) + (v[r][j].z * v[r][j].z + v[r][j].w * v[r][j].w);
            const float rr = 1.0f / sqrtf(wave_sum(q) * (1.0f / DM) + EPS); f32x4* o = (f32x4*)(X + (size_t)(row0 + r) * DM) + F.lane;
#pragma unroll
            for (int j = 0; j < 4; ++j) o[64 * j] = v[r][j] * rr * gg[j]; }
    }
}

__device__ __forceinline__ void prep_compress(Frame& F, const Args& a, int layer) {
    PHASE_IDS(F);
    typedef short bf16x8 __attribute__((ext_vector_type(8)));
    const bf16* Z = (const bf16*)(F.ws + WS_Z); const bf16* WCT = (const bf16*)(F.ws + WS_WCT); const float* CBP = (const float*)(F.ws + WS_CBP);
    f32x4* red = (f32x4*)F.lds;
    const int lane = F.lane, et = F.wave & 3, kh = F.wave >> 2, r16 = lane & 15, q4 = lane >> 4;
    for (int it = blockIdx.x; it < NB * 2 * 16; it += F.G) {
        const int b = it >> 5, br = (it >> 4) & 1, n0 = (it & 15) * 16; const int zc = br ? ZVC : ZKC;
        const bf16* wrow = WCT + ((size_t)br * 64 + et * 16 + r16) * 2048 + 8 * q4;
        const int tb = 16 * (n0 + r16);
        f32x4 acc = {0.f, 0.f, 0.f, 0.f};
#pragma unroll 8
        for (int kk = kh * 32; kk < kh * 32 + 32; ++kk) {
            int tok = tb + (kk >> 1); tok = tok < SEQ ? tok : SEQ - 1;
            const bf16x8 af = *(const bf16x8*)(Z + ((size_t)b * SEQ + tok) * DINP + zc + (kk & 1) * 32 + 8 * q4);
            const bf16x8 bfr = *(const bf16x8*)(wrow + 32 * kk);
            acc = __builtin_amdgcn_mfma_f32_16x16x32_bf16(af, bfr, acc, 0, 0, 0);
        }
        __syncthreads();
        if (kh == 1) red[et * 64 + lane] = acc;
        __syncthreads();
        if (kh == 0) {
            const f32x4 o = red[et * 64 + lane]; const int e = et * 16 + r16; float bias = 0.f;
            const int es = br == 0 ? pi64(e) : e;
#pragma unroll 8
            for (int ch = 0; ch < 32; ++ch) bias += CBP[(br * 32 + ch) * 64 + es];
            bf16* O = (bf16*)(F.ws + (br ? WS_VC : WS_KC)) + (size_t)b * 256 * 64;
#pragma unroll
            for (int r = 0; r < 4; ++r) { const int n = n0 + 4 * q4 + r; O[n * 64 + e] = (bf16)((n < 255) ? f2bf(acc[r] + o[r] + bias) : 0u); }
        }
    }
    __syncthreads();
}
__device__ __forceinline__ float log_sigmoid_(float x) { return x >= 0.f ? -log1pf(__expf(-x)) : x - log1pf(__expf(x)); }
typedef float f32x16m __attribute__((ext_vector_type(16)));
__device__ __forceinline__ void mm64(f32x16m& acc, const float* ap, int as, const float* bp, int bs) {
#pragma unroll 8
    for (int kk = 0; kk < 32; ++kk) acc = __builtin_amdgcn_mfma_f32_32x32x2f32(ap[kk * as], bp[kk * bs], acc, 0, 0, 0);
}
__device__ __forceinline__ int crow32(int r, int hi) { return (r & 3) + 8 * (r >> 2) + 4 * hi; }
__device__ __forceinline__ void prep_mlstm(Frame& F, const Args& a, int layer) {
    PHASE_IDS(F);
    const bf16* Z = (const bf16*)(F.ws + WS_Z);
    float* L = (float*)F.lds; float* UC = L; float* KS = L + 4224; float* VS = L + 8448; float* WQ = L + 12672; float* WK = L + 16896; float* WE = L + 21120;
    const float* convw = a.in[7] + (size_t)layer * 4 * 256; const float* convb = a.in[8] + (size_t)layer * 256;
    const float* gb = a.in[11] + (size_t)layer * 8;
    float* MQ = (float*)(F.ws + WS_MQ); float* MK = (float*)(F.ws + WS_MK); float* CLOC = (float*)(F.ws + WS_CLOC); float* NLOC = (float*)(F.ws + WS_NLOC);
    float* BCUM = (float*)(F.ws + WS_BCUM); float* IG = (float*)(F.ws + WS_IG); float* ACH = (float*)(F.ws + WS_ACH); float* MLOC = (float*)(F.ws + WS_MLOC);
    const int lane = F.lane, r32 = lane & 31, hi = lane >> 5, w = F.wave, tl = F.tid >> 3, c8 = (F.tid & 7) * 8;
    v4u ur[4], vr; float gi = 0.f, gf = 0.f; int ph = -1;
#define PM_LOAD(it_) do { const int bh_ = (it_) >> 6, c_ = (it_) & 63, b_ = bh_ >> 2, h_ = bh_ & 3, t_ = c_ * 64 + tl; const bf16* zb_ = Z + (size_t)b_ * SEQ * DINP; \
        _Pragma("unroll") for (int j = 0; j < 4; ++j) { const int tt_ = t_ - 3 + j; ur[j] = tt_ >= 0 ? *(const v4u*)(zb_ + (size_t)tt_ * DINP + ZCU + h_ * 64 + c8) : (v4u){0u, 0u, 0u, 0u}; } \
        vr = *(const v4u*)(zb_ + (size_t)t_ * DINP + ZCV + h_ * 64 + c8); \
        if (w == 0) { const bf16* zr_ = zb_ + (size_t)(c_ * 64 + lane) * DINP; gi = bf2f(zr_[ZCI + h_]); gf = bf2f(zr_[ZCF + h_]); } } while (0)
    int it = blockIdx.x;
    if (it < 1024) PM_LOAD(it);
    for (; it < 1024; it += F.G) {
        const int bh = it >> 6, c = it & 63, b = bh >> 2, h = bh & 3, t0 = c * 64; const size_t row0 = (size_t)b * SEQ + t0;
        __syncthreads();
        if (h != ph) { const float* wq = a.in[9] + ((size_t)layer * 4 + h) * 4096; const float* wk = a.in[10] + ((size_t)layer * 4 + h) * 4096;
            *(f32x4*)(WQ + F.tid * 8) = *(const f32x4*)(wq + F.tid * 8); *(f32x4*)(WQ + F.tid * 8 + 4) = *(const f32x4*)(wq + F.tid * 8 + 4);
            *(f32x4*)(WK + F.tid * 8) = *(const f32x4*)(wk + F.tid * 8); *(f32x4*)(WK + F.tid * 8 + 4) = *(const f32x4*)(wk + F.tid * 8 + 4); ph = h; }
        { float u[4][8], acc[8], vv[8]; const int ch = h * 64 + c8;
#pragma unroll
          for (int j = 0; j < 4; ++j) { u[j][0] = bflo(ur[j].x); u[j][1] = bfhi(ur[j].x); u[j][2] = bflo(ur[j].y); u[j][3] = bfhi(ur[j].y); u[j][4] = bflo(ur[j].z); u[j][5] = bfhi(ur[j].z); u[j][6] = bflo(ur[j].w); u[j][7] = bfhi(ur[j].w); }
          vv[0] = bflo(vr.x); vv[1] = bfhi(vr.x); vv[2] = bflo(vr.y); vv[3] = bfhi(vr.y); vv[4] = bflo(vr.z); vv[5] = bfhi(vr.z); vv[6] = bflo(vr.w); vv[7] = bfhi(vr.w);
#pragma unroll
          for (int i = 0; i < 8; ++i) acc[i] = convb[ch + i];
#pragma unroll
          for (int j = 0; j < 4; ++j)
#pragma unroll
              for (int i = 0; i < 8; ++i) acc[i] += convw[j * 256 + ch + i] * u[j][i];
#pragma unroll
          for (int i = 0; i < 8; ++i) { UC[tl * 65 + c8 + i] = acc[i] * sigmoidf_(acc[i]); VS[tl * 64 + c8 + i] = vv[i]; } }
        if (w == 0) { const int l = lane; const size_t row = row0 + l;
            const float ig = gi + gb[h]; float bc = log_sigmoid_(gf + gb[4 + h]);
#pragma unroll
            for (int o = 1; o < 64; o <<= 1) { const float v = lane_get(bc, l - o); if (l >= o) bc += v; }
            const float ach = lane_get(bc, 63); const float ge = ach - bc + ig; const float ml = wave_max(ge);
            WE[l] = __expf(ge - ml); BCUM[row * 4 + h] = bc; IG[row * 4 + h] = ig; if (l == 0) { ACH[it] = ach; MLOC[it] = ml; } }
        if (it + F.G < 1024) PM_LOAD(it + F.G);
        __syncthreads();
        { const int i0 = ((w >> 1) & 1) * 32, j0 = (w & 1) * 32; f32x16m acc;
#pragma unroll
            for (int r = 0; r < 16; ++r) acc[r] = 0.f;
            mm64(acc, UC + (i0 + r32) * 65 + hi, 2, (w < 4 ? WQ : WK) + hi * 64 + j0 + r32, 128);
            float* G = (w < 4 ? MQ : MK) + row0 * 256 + h * 64 + j0 + r32;
            if (w < 4) {
#pragma unroll
                for (int r = 0; r < 16; ++r) G[(size_t)(i0 + crow32(r, hi)) * 256] = acc[r];
            } else {
#pragma unroll
                for (int r = 0; r < 16; ++r) { const float v = acc[r] * 0.125f; const int l = i0 + crow32(r, hi); G[(size_t)l * 256] = v; KS[l * 64 + j0 + r32] = v; }
            } }
        __syncthreads();
        if (w < 4) { const int i0 = (w >> 1) * 32, j0 = (w & 1) * 32; f32x16m acc;
#pragma unroll
            for (int r = 0; r < 16; ++r) acc[r] = 0.f;
#pragma unroll 8
            for (int kk = 0; kk < 32; ++kk) { const int l = 2 * kk + hi; acc = __builtin_amdgcn_mfma_f32_32x32x2f32(VS[l * 64 + i0 + r32] * WE[l], KS[l * 64 + j0 + r32], acc, 0, 0, 0); }
            float* G = CLOC + (size_t)it * 4096 + j0 + r32;
#pragma unroll
            for (int r = 0; r < 16; ++r) G[(i0 + crow32(r, hi)) * 64] = acc[r];
        } else if (w == 4) { float n = 0.f;
#pragma unroll 8
            for (int l = 0; l < 64; ++l) n += WE[l] * KS[l * 64 + lane];
            NLOC[it * 64 + lane] = n; }
    }
#undef PM_LOAD
    __syncthreads();
}

__device__ __forceinline__ void ld8(const bf16* p, float* o) { const v4u w = *(const v4u*)p; o[0] = bflo(w.x); o[1] = bfhi(w.x); o[2] = bflo(w.y); o[3] = bfhi(w.y); o[4] = bflo(w.z); o[5] = bfhi(w.z); o[6] = bflo(w.w); o[7] = bfhi(w.w); }
__device__ __forceinline__ void ph_mlstm_out(Frame& F, const Args& a, int layer) {
    PHASE_IDS(F);
    const bf16* Z = (const bf16*)(F.ws + WS_Z); bf16* AO = (bf16*)(F.ws + WS_H);
    const float* MQ = (const float*)(F.ws + WS_MQ); const float* MK = (const float*)(F.ws + WS_MK); const float* CIN = (const float*)(F.ws + WS_CLOC); const float* NIN = (const float*)(F.ws + WS_NLOC);
    const float* BCUM = (const float*)(F.ws + WS_BCUM); const float* IG = (const float*)(F.ws + WS_IG); const float* MIN = (const float*)(F.ws + WS_MIN);
    const float* hg = a.in[12] + (size_t)layer * 256;
    float* L = (float*)F.lds; float* QS = L; float* KS = L + 4224; float* CS = L + 8448; float* SS = L + 12672; float* HS = L + 16896; float* VS = L + 21120;
    float* NI = L + 25344; float* BC = NI + 64; float* IGS = BC + 64; float* MT = IGS + 64; float* EI = MT + 64; float* DEN = EI + 64;
    const int lane = F.lane, r32 = lane & 31, hi = lane >> 5, w = F.wave;
    const int tl = F.tid >> 3, c8 = (F.tid & 7) * 8;
    f32x4 qr[2], kr[2], cr[2]; v4u vr; float gbc = 0.f, gig = 0.f, gmi = 0.f, gni = 0.f;
#define MO_LOAD(it_) do { const int bh_ = (it_) >> 6, c_ = (it_) & 63, b_ = bh_ >> 2, h_ = bh_ & 3; const size_t r_ = (size_t)b_ * SEQ + c_ * 64 + tl; \
        const f32x4* q_ = (const f32x4*)(MQ + r_ * 256 + h_ * 64 + c8); const f32x4* k_ = (const f32x4*)(MK + r_ * 256 + h_ * 64 + c8); const f32x4* c_p = (const f32x4*)(CIN + (size_t)(it_) * 4096 + tl * 64 + c8); \
        qr[0] = q_[0]; qr[1] = q_[1]; kr[0] = k_[0]; kr[1] = k_[1]; cr[0] = c_p[0]; cr[1] = c_p[1]; vr = *(const v4u*)(Z + r_ * DINP + ZCV + h_ * 64 + c8); \
        if (w == 0) { const size_t rl_ = (size_t)b_ * SEQ + c_ * 64 + lane; gbc = BCUM[rl_ * 4 + h_]; gig = IG[rl_ * 4 + h_]; gmi = MIN[(it_)]; gni = NIN[(it_) * 64 + lane]; } } while (0)
    int it = blockIdx.x;
    if (it < 1024) MO_LOAD(it);
    for (; it < 1024; it += F.G) {
        const int bh = it >> 6, c = it & 63, b = bh >> 2, h = bh & 3; const size_t row0 = (size_t)b * SEQ + c * 64;
        __syncthreads();
        { float* q_ = QS + tl * 65 + c8; float* k_ = KS + tl * 65 + c8; float* c_ = CS + tl * 65 + c8; float* v_ = VS + tl * 64 + c8;
#pragma unroll
          for (int i = 0; i < 4; ++i) { q_[i] = qr[0][i]; q_[4 + i] = qr[1][i]; k_[i] = kr[0][i]; k_[4 + i] = kr[1][i]; c_[i] = cr[0][i]; c_[4 + i] = cr[1][i]; }
          v_[0] = bflo(vr.x); v_[1] = bfhi(vr.x); v_[2] = bflo(vr.y); v_[3] = bfhi(vr.y); v_[4] = bflo(vr.z); v_[5] = bfhi(vr.z); v_[6] = bflo(vr.w); v_[7] = bfhi(vr.w); }
        if (w == 0) { const int l = lane; const float bc = gbc, ig = gig, mi = gmi;
            NI[l] = gni; BC[l] = bc; IGS[l] = ig;
            float pm = ig - bc;
#pragma unroll
            for (int o = 1; o < 64; o <<= 1) { const float v = lane_get(pm, l - o); if (l >= o) pm = fmaxf(pm, v); }
            const float inter = bc + mi, mt = fmaxf(inter, bc + pm); MT[l] = mt; EI[l] = __expf(inter - mt); }
        if (it + F.G < 1024) MO_LOAD(it + F.G);
        __syncthreads();
        const int i0 = ((w >> 1) & 1) * 32, j0 = (w & 1) * 32; f32x16m acc;
#pragma unroll
        for (int r = 0; r < 16; ++r) acc[r] = 0.f;
        if (w < 4) {
            if (!(i0 == 0 && j0 == 32)) mm64(acc, QS + (i0 + r32) * 65 + hi, 2, KS + (j0 + r32) * 65 + hi, 2);
            const int s_ = j0 + r32; const float bs = IGS[s_] - BC[s_];
#pragma unroll
            for (int r = 0; r < 16; ++r) { const int t = i0 + crow32(r, hi); SS[t * 65 + s_] = (s_ <= t) ? acc[r] * __expf(BC[t] + bs - MT[t]) : 0.f; }
        } else {
            mm64(acc, QS + (i0 + r32) * 65 + hi, 2, CS + (j0 + r32) * 65 + hi, 2);
#pragma unroll
            for (int r = 0; r < 16; ++r) acc[r] *= EI[i0 + crow32(r, hi)];
        }
        __syncthreads();
        if (w >= 4) {
            mm64(acc, SS + (i0 + r32) * 65 + hi, 2, VS + hi * 64 + j0 + r32, 128);
#pragma unroll
            for (int r = 0; r < 16; ++r) HS[(i0 + crow32(r, hi)) * 65 + j0 + r32] = acc[r];
        } else if (w == 0) { const int t = lane; float nq = 0.f, ssum = 0.f;
#pragma unroll 8
            for (int k = 0; k < 64; ++k) { nq += NI[k] * QS[t * 65 + k]; ssum += SS[t * 65 + k]; }
            const float den = EI[t] * nq + ssum; DEN[t] = 1.0f / fmaxf(fabsf(den), __expf(-MT[t])); }
        __syncthreads();
        { const int t = F.tid >> 3, vg = (F.tid & 7) * 8; const float rd = DEN[t]; float num[8]; float sq = 0.f;
#pragma unroll
            for (int i = 0; i < 8; ++i) { num[i] = HS[t * 65 + vg + i] * rd; sq += num[i] * num[i]; }
            sq += sx<1>(sq); sq += sx<2>(sq); sq += sx<4>(sq);
            const float rn = 1.0f / sqrtf(sq * (1.0f / 64.0f) + EPS); const size_t row = row0 + t;
            float zo[8]; ld8(Z + row * DINP + ZCO + h * 64 + vg, zo);
            unsigned wv[4];
#pragma unroll
            for (int i = 0; i < 8; i += 2) { const int ch = h * 64 + vg + i; wv[i >> 1] = pk2(num[i] * rn * hg[ch] * sigmoidf_(zo[i]), num[i + 1] * rn * hg[ch + 1] * sigmoidf_(zo[i + 1])); }
            *(v4u*)(AO + row * DM + 512 + h * 64 + vg) = (v4u){wv[0], wv[1], wv[2], wv[3]}; }
    }
#undef MO_LOAD
    __syncthreads();
}

namespace fa {
typedef short bf16x8 __attribute__((ext_vector_type(8)));
typedef float f32x16 __attribute__((ext_vector_type(16)));
typedef short s16x4 __attribute__((ext_vector_type(4)));
typedef __bf16 bf16x2_t __attribute__((ext_vector_type(2)));
constexpr int KP = 144, VP = 192, KT = 64 * KP, VT = 64 * VP, BUF = KT + VT, LDS_NEED = 2 * BUF;
constexpr float LOG2E = 1.4426950408889634f, LN2 = 0.6931471805599453f;
__device__ __forceinline__ int crow(int r, int hi) { return (r & 3) + 8 * (r >> 2) + 4 * hi; }
__device__ __forceinline__ unsigned cvtpk(float lo, float hi) { f32x2 v = {lo, hi}; bf16x2_t b = __builtin_convertvector(v, bf16x2_t); return __builtin_bit_cast(unsigned, b); }
__device__ __forceinline__ s16x4 vtr(LAS unsigned char* p) { return __builtin_bit_cast(s16x4, __builtin_amdgcn_ds_read_tr16_b64_v4i16((LAS s16x4*)p)); }
__device__ __forceinline__ void load_qf(const bf16* qrow, int hi, bf16x8 (&qf)[4]) {
#pragma unroll
    for (int ks = 0; ks < 4; ++ks) qf[ks] = *(const bf16x8*)(qrow + 16 * ks + 8 * hi);
}
template <int KS0, int KS, class P, int MODE = 0>
__device__ __forceinline__ void stream(const P& p, LAS unsigned char* lds, int tid, float sc, const bf16x8 (&qf)[4], float& m_, float& l_, f32x16 (&O_)[2]) {
    float m = m_, l = l_; f32x16 O[2] = {O_[0], O_[1]};
    const int lane = tid & 63, r32 = lane & 31, hi = lane >> 5, g = lane >> 4, i16 = lane & 15;
    const int srow = tid >> 3, scx = tid & 7;
    const int koff = r32 * KP + hi * 16;
    const int voff = KT + ((i16 >> 2) + 4 * hi) * VP + (16 * (g & 1) + 4 * (i16 & 3)) * 2;
    const int nt = p.ntiles();
    v4u kr, vr;
#define FA_LOAD(it_) do { const bf16* kp_ = p.krow((it_), srow); const bf16* vp_ = p.vrow((it_), srow); kr = *(const v4u*)(kp_ + 8 * scx); vr = *(const v4u*)(vp_ + 8 * scx); } while (0)
#define FA_STORE(boff_) do { *(LAS v4u*)(lds + (boff_) + srow * KP + scx * 16) = kr; *(LAS v4u*)(lds + (boff_) + KT + srow * VP + scx * 16) = vr; } while (0)
    __syncthreads();
    if (nt > 0) { FA_LOAD(0); FA_STORE(0); if (nt > 1) FA_LOAD(1); }
    __syncthreads();
#pragma unroll 1
    for (int it = 0; it < nt; ++it) {
        const int bc = (it & 1) * BUF;
        if (!p.wave_skip(it)) {
            f32x16 S[2];
            { bf16x8 kf[2][KS];
#pragma unroll
              for (int st = 0; st < 2; ++st)
#pragma unroll
                  for (int k = 0; k < KS; ++k) kf[st][k] = *(LAS bf16x8*)(lds + bc + koff + st * 32 * KP + (KS0 + k) * 32);
#pragma unroll
              for (int st = 0; st < 2; ++st) {
#pragma unroll
                  for (int r = 0; r < 16; ++r) S[st][r] = 0.f;
#pragma unroll
                  for (int k = 0; k < KS; ++k) S[st] = __builtin_amdgcn_mfma_f32_32x32x16_bf16(kf[st][k], qf[KS0 + k], S[st], 0, 0, 0); } }
            s16x4 vv[2][2][2][2];
            if constexpr (MODE == 0) {
#pragma unroll
                for (int st = 0; st < 2; ++st)
#pragma unroll
                    for (int s = 0; s < 2; ++s)
#pragma unroll
                        for (int dt = 0; dt < 2; ++dt) { LAS unsigned char* vp = lds + bc + voff + (32 * st + 16 * s) * VP + dt * 64; vv[st][s][dt][0] = vtr(vp); vv[st][s][dt][1] = vtr(vp + 8 * VP); }
            }
            const int mm = p.mask_mode(it);
            if (mm) {
                int lb, ub; p.bounds(it, lb, ub); lb -= 4 * hi; ub -= 4 * hi;
                if (mm == 1) {
#pragma unroll
                    for (int st = 0; st < 2; ++st)
#pragma unroll
                        for (int r = 0; r < 16; ++r) { const int cc = 32 * st + (r & 3) + 8 * (r >> 2); if (cc > ub) S[st][r] = -INFINITY; }
                } else if (mm == 2) {
#pragma unroll
                    for (int st = 0; st < 2; ++st)
#pragma unroll
                        for (int r = 0; r < 16; ++r) { const int cc = 32 * st + (r & 3) + 8 * (r >> 2); if (cc < lb) S[st][r] = -INFINITY; }
                } else {
#pragma unroll
                    for (int st = 0; st < 2; ++st)
#pragma unroll
                        for (int r = 0; r < 16; ++r) { const int cc = 32 * st + (r & 3) + 8 * (r >> 2); if (cc < lb || cc > ub) S[st][r] = -INFINITY; }
                }
            }
            const bool keep = p.lane_keep(it);
            if constexpr (MODE == 1) {
                const float ms = (m == -INFINITY) ? 0.f : m; const float il = l > 0.f ? 1.0f / l : 0.f;
#pragma unroll
                for (int st = 0; st < 2; ++st)
#pragma unroll
                    for (int rg = 0; rg < 4; ++rg) {
                        const float p0 = __builtin_amdgcn_exp2f(__builtin_fmaf(S[st][4 * rg], sc, -ms)) * il, p1 = __builtin_amdgcn_exp2f(__builtin_fmaf(S[st][4 * rg + 1], sc, -ms)) * il;
                        const float p2 = __builtin_amdgcn_exp2f(__builtin_fmaf(S[st][4 * rg + 2], sc, -ms)) * il, p3 = __builtin_amdgcn_exp2f(__builtin_fmaf(S[st][4 * rg + 3], sc, -ms)) * il;
                        float qa = p0, qb = p0 + 2.0f * (p1 + p2 + p3);
                        qa += sx<1>(qa); qa += sx<2>(qa); qb += sx<1>(qb); qb += sx<2>(qb);
                        const int jp = 8 * (2 * it + st) + 2 * rg + hi;
                        if ((r32 & 3) == 0) { p.impA[p.tokl * 65 + jp] = qa; if (jp < 63) p.impB[p.tokl * 65 + jp + 1] = qb; }
                    }
            } else {
                float tm = S[0][0];
#pragma unroll
                for (int r = 1; r < 16; ++r) tm = fmaxf(tm, S[0][r]);
#pragma unroll
                for (int r = 0; r < 16; ++r) tm = fmaxf(tm, S[1][r]);
                tm = max32(tm); if (!keep) tm = -INFINITY;
                const float mn = fmaxf(m, tm * sc), ms0 = (mn == -INFINITY) ? 0.f : mn;
                const float alpha = __builtin_amdgcn_exp2f(m - ms0); const float ms = keep ? ms0 : INFINITY;
                m = mn;
                f32x2 ps2 = {0.f, 0.f}; const f32x2 sc2 = {sc, sc}, nm2 = {-ms, -ms};
#pragma unroll
                for (int st = 0; st < 2; ++st)
#pragma unroll
                    for (int r = 0; r < 16; r += 2) { f32x2 x = {S[st][r], S[st][r + 1]}; x = __builtin_elementwise_fma(x, sc2, nm2); f32x2 e = {__builtin_amdgcn_exp2f(x.x), __builtin_amdgcn_exp2f(x.y)}; S[st][r] = e.x; S[st][r + 1] = e.y; ps2 += e; }
                l = l * alpha + (ps2.x + ps2.y);
                if (__any(alpha != 1.0f)) {
#pragma unroll
                    for (int dt = 0; dt < 2; ++dt)
#pragma unroll
                        for (int r = 0; r < 16; ++r) O[dt][r] *= alpha;
                }
#pragma unroll
                for (int st = 0; st < 2; ++st)
#pragma unroll
                    for (int s = 0; s < 2; ++s) {
                        v4u pw; pw.x = cvtpk(S[st][8 * s], S[st][8 * s + 1]); pw.y = cvtpk(S[st][8 * s + 2], S[st][8 * s + 3]); pw.z = cvtpk(S[st][8 * s + 4], S[st][8 * s + 5]); pw.w = cvtpk(S[st][8 * s + 6], S[st][8 * s + 7]);
                        const bf16x8 pf = __builtin_bit_cast(bf16x8, pw);
#pragma unroll
                        for (int dt = 0; dt < 2; ++dt) {
                            const s16x4 v0 = vv[st][s][dt][0], v1 = vv[st][s][dt][1];
                            const bf16x8 vf = __builtin_shufflevector(v0, v1, 0, 1, 2, 3, 4, 5, 6, 7);
                            O[dt] = __builtin_amdgcn_mfma_f32_32x32x16_bf16(vf, pf, O[dt], 0, 0, 0);
                        }
                    }
            }
        }
        if (it + 1 < nt) { FA_STORE(((it + 1) & 1) * BUF); if (it + 2 < nt) FA_LOAD(it + 2); }
        __syncthreads();
    }
#undef FA_LOAD
#undef FA_STORE
    m_ = m; l_ = l; O_[0] = O[0]; O_[1] = O[1];
}
template <class P>
__device__ __forceinline__ void stream2(const P& p, LAS unsigned char* lds, int tid, float sc, const bf16x8 (&qf)[4], float (&m)[2], float (&l)[2], f32x16 (&O)[2][2]) {
    const int lane = tid & 63, r32 = lane & 31, hi = lane >> 5, g = lane >> 4, i16 = lane & 15;
    const int srow = tid >> 3, scx = tid & 7;
    const int koff = r32 * KP + hi * 16;
    const int voff = KT + ((i16 >> 2) + 4 * hi) * VP + (16 * (g & 1) + 4 * (i16 & 3)) * 2;
    const int nt = p.ntiles();
    v4u kr, vr;
#define FA_LOAD(it_) do { const bf16* kp_ = p.krow((it_), srow); const bf16* vp_ = p.vrow((it_), srow); kr = *(const v4u*)(kp_ + 8 * scx); vr = *(const v4u*)(vp_ + 8 * scx); } while (0)
#define FA_STORE(boff_) do { *(LAS v4u*)(lds + (boff_) + srow * KP + scx * 16) = kr; *(LAS v4u*)(lds + (boff_) + KT + srow * VP + scx * 16) = vr; } while (0)
    __syncthreads();
    if (nt > 0) { FA_LOAD(0); FA_STORE(0); if (nt > 1) FA_LOAD(1); }
    __syncthreads();
#pragma unroll 1
    for (int it = 0; it < nt; ++it) {
        const int bc = (it & 1) * BUF;
        if (!p.wave_skip(it)) {
            s16x4 vv[2][2][2][2];
#pragma unroll
            for (int st = 0; st < 2; ++st)
#pragma unroll
                for (int s = 0; s < 2; ++s)
#pragma unroll
                    for (int dt = 0; dt < 2; ++dt) { LAS unsigned char* vp = lds + bc + voff + (32 * st + 16 * s) * VP + dt * 64; vv[st][s][dt][0] = vtr(vp); vv[st][s][dt][1] = vtr(vp + 8 * VP); }
            const int mm = p.mask_mode(it); int lb, ub; p.bounds(it, lb, ub); ub -= 4 * hi;
#pragma unroll
            for (int c = 0; c < 2; ++c) {
                f32x16 S[2];
                { bf16x8 kf[2][2];
#pragma unroll
                  for (int st = 0; st < 2; ++st)
#pragma unroll
                      for (int k = 0; k < 2; ++k) kf[st][k] = *(LAS bf16x8*)(lds + bc + koff + st * 32 * KP + (2 * c + k) * 32);
#pragma unroll
                  for (int st = 0; st < 2; ++st) {
#pragma unroll
                      for (int r = 0; r < 16; ++r) S[st][r] = 0.f;
#pragma unroll
                      for (int k = 0; k < 2; ++k) S[st] = __builtin_amdgcn_mfma_f32_32x32x16_bf16(kf[st][k], qf[2 * c + k], S[st], 0, 0, 0); } }
                if (mm) {
#pragma unroll
                    for (int st = 0; st < 2; ++st)
#pragma unroll
                        for (int r = 0; r < 16; ++r) { const int cc = 32 * st + (r & 3) + 8 * (r >> 2); if (cc > ub) S[st][r] = -INFINITY; }
                }
                float tm = S[0][0];
#pragma unroll
                for (int r = 1; r < 16; ++r) tm = fmaxf(tm, S[0][r]);
#pragma unroll
                for (int r = 0; r < 16; ++r) tm = fmaxf(tm, S[1][r]);
                tm = max32(tm);
                const float mn = fmaxf(m[c], tm * sc), ms = (mn == -INFINITY) ? 0.f : mn;
                const float alpha = __builtin_amdgcn_exp2f(m[c] - ms);
                m[c] = mn;
                f32x2 ps2 = {0.f, 0.f}; const f32x2 sc2 = {sc, sc}, nm2 = {-ms, -ms};
#pragma unroll
                for (int st = 0; st < 2; ++st)
#pragma unroll
                    for (int r = 0; r < 16; r += 2) { f32x2 x = {S[st][r], S[st][r + 1]}; x = __builtin_elementwise_fma(x, sc2, nm2); f32x2 e = {__builtin_amdgcn_exp2f(x.x), __builtin_amdgcn_exp2f(x.y)}; S[st][r] = e.x; S[st][r + 1] = e.y; ps2 += e; }
                l[c] = l[c] * alpha + (ps2.x + ps2.y);
                if (__any(alpha != 1.0f)) {
#pragma unroll
                    for (int dt = 0; dt < 2; ++dt)
#pragma unroll
                        for (int r = 0; r < 16; ++r) O[c][dt][r] *= alpha;
                }
#pragma unroll
                for (int st = 0; st < 2; ++st)
#pragma unroll
                    for (int s = 0; s < 2; ++s) {
                        v4u pw; pw.x = cvtpk(S[st][8 * s], S[st][8 * s + 1]); pw.y = cvtpk(S[st][8 * s + 2], S[st][8 * s + 3]); pw.z = cvtpk(S[st][8 * s + 4], S[st][8 * s + 5]); pw.w = cvtpk(S[st][8 * s + 6], S[st][8 * s + 7]);
                        const bf16x8 pf = __builtin_bit_cast(bf16x8, pw);
#pragma unroll
                        for (int dt = 0; dt < 2; ++dt) {
                            const s16x4 v0 = vv[st][s][dt][0], v1 = vv[st][s][dt][1];
                            const bf16x8 vf = __builtin_shufflevector(v0, v1, 0, 1, 2, 3, 4, 5, 6, 7);
                            O[c][dt] = __builtin_amdgcn_mfma_f32_32x32x16_bf16(vf, pf, O[c][dt], 0, 0, 0);
                        }
                    }
                __builtin_amdgcn_sched_barrier(0);
            }
        }
        if (it + 1 < nt) { FA_STORE(((it + 1) & 1) * BUF); if (it + 2 < nt) FA_LOAD(it + 2); }
        __syncthreads();
    }
#undef FA_LOAD
#undef FA_STORE
}
__device__ __forceinline__ float finish(float l, f32x16 (&O)[2]) {
    const float lt = sum32(l); const float inv = lt > 0.f ? 1.0f / lt : 0.f;
#pragma unroll
    for (int dt = 0; dt < 2; ++dt)
#pragma unroll
        for (int r = 0; r < 16; ++r) O[dt][r] *= inv;
    return lt;
}
__device__ __forceinline__ void store_o(const f32x16 (&O)[2], bf16* out, int hi) {
#pragma unroll
    for (int dt = 0; dt < 2; ++dt)
#pragma unroll
        for (int rg = 0; rg < 4; ++rg) { v2u w; w.x = cvtpk(O[dt][4 * rg], O[dt][4 * rg + 1]); w.y = cvtpk(O[dt][4 * rg + 2], O[dt][4 * rg + 3]); *(v2u*)(out + 32 * dt + 8 * rg + 4 * hi) = w; }
}
}

struct DiffPol {
    const bf16* Zb; int h, t0, wq0, tq;
    __device__ __forceinline__ int ntiles() const { return (t0 + 256) >> 6; }
    __device__ __forceinline__ const bf16* krow(int it, int r) const { return Zb + (size_t)(64 * it + r) * DINP + ZBK + 64 * h; }
    __device__ __forceinline__ const bf16* vrow(int it, int r) const { return Zb + (size_t)(64 * it + r) * DINP + ZBV + 64 * h; }
    __device__ __forceinline__ bool wave_skip(int it) const { return 64 * it > wq0 + 31; }
    __device__ __forceinline__ int mask_mode(int it) const { return 64 * it + 63 > wq0 ? 1 : 0; }
    __device__ __forceinline__ bool lane_keep(int) const { return true; }
    __device__ __forceinline__ void bounds(int it, int& lb, int& ub) const { lb = 0; ub = tq - 64 * it; }
};
__device__ __forceinline__ void diff_item(Frame& F, const Args& a, int layer, int b, int h, int qb, float lam) {
    PHASE_IDS(F);
    const bf16* Z = (const bf16*)(F.ws + WS_Z); bf16* AO = (bf16*)(F.ws + WS_H);
    const int lane = F.lane, r32 = lane & 31, hi = lane >> 5;
    DiffPol p; p.Zb = Z + (size_t)b * SEQ * DINP; p.h = h; p.t0 = 256 * qb; p.wq0 = p.t0 + 32 * F.wave; p.tq = p.wq0 + r32;
    fa::bf16x8 qf[4]; fa::load_qf(p.Zb + (size_t)p.tq * DINP + ZBQ + 64 * h, hi, qf);
    fa::f32x16 O[2][2];
#pragma unroll
    for (int c = 0; c < 2; ++c)
#pragma unroll
        for (int dt = 0; dt < 2; ++dt)
#pragma unroll
            for (int r = 0; r < 16; ++r) O[c][dt][r] = 0.f;
    { float m[2] = {-INFINITY, -INFINITY}, l[2] = {0.f, 0.f}; fa::stream2<DiffPol>(p, F.lds3, F.tid, 0.17677669529663687f * fa::LOG2E, qf, m, l, O); fa::finish(l[0], O[0]); fa::finish(l[1], O[1]); }
    const float lam_init = 0.8f - 0.6f * expf(-0.3f * (float)layer);
    const float* sg = a.in[6] + (size_t)layer * 64;
    float ss = 0.f;
#pragma unroll
    for (int dt = 0; dt < 2; ++dt)
#pragma unroll
        for (int r = 0; r < 16; ++r) { const float v = O[0][dt][r] - lam * O[1][dt][r]; O[0][dt][r] = v; ss += v * v; }
    ss = sum32(ss);
    const float rn = (1.0f / sqrtf(ss * (1.0f / 64.0f) + EPS)) * (1.0f - lam_init);
#pragma unroll
    for (int dt = 0; dt < 2; ++dt)
#pragma unroll
        for (int r = 0; r < 16; ++r) O[0][dt][r] *= rn * sg[32 * dt + fa::crow(r, hi)];
    fa::store_o(O[0], AO + ((size_t)b * SEQ + p.tq) * DM + 256 + 64 * h, hi);
}
struct DilPol {
    const bf16* Zb; int h, dil, res, it0, nt, wi0, iq;
    __device__ __forceinline__ int ntiles() const { return nt; }
    __device__ __forceinline__ const bf16* krow(int it, int r) const { const int ik = 64 * (it0 + it) + r; return Zb + (size_t)(res + dil * ik) * DINP + ZDK + 64 * h; }
    __device__ __forceinline__ const bf16* vrow(int it, int r) const { const int ik = 64 * (it0 + it) + r; return Zb + (size_t)(res + dil * ik) * DINP + ZDV + 64 * h; }
    __device__ __forceinline__ bool wave_skip(int it) const { const int k0 = 64 * (it0 + it); return k0 > wi0 + 31 || k0 + 63 < wi0 - 128; }
    __device__ __forceinline__ int mask_mode(int it) const { const int k0 = 64 * (it0 + it); return (k0 + 63 > wi0 ? 1 : 0) | (k0 < wi0 + 31 - 128 ? 2 : 0); }
    __device__ __forceinline__ bool lane_keep(int) const { return true; }
    __device__ __forceinline__ void bounds(int it, int& lb, int& ub) const { ub = iq - 64 * (it0 + it); lb = ub - 128; }
};
__device__ __forceinline__ void dil_item(Frame& F, int b, int h, int g, int res, int blk) {
    PHASE_IDS(F);
    const bf16* Z = (const bf16*)(F.ws + WS_Z); bf16* DP = (bf16*)(F.ws + WS_DPART); float* DL = (float*)(F.ws + WS_DLSE);
    const int lane = F.lane, r32 = lane & 31, hi = lane >> 5;
    DilPol p; p.Zb = Z + (size_t)b * SEQ * DINP; p.h = h; p.dil = (g == 0) ? 1 : (g == 1) ? 4 : 16; p.res = res;
    const int i0 = 256 * blk; const int t_lo = (i0 >> 6) - 2; p.it0 = t_lo < 0 ? 0 : t_lo; p.nt = (i0 >> 6) + 4 - p.it0;
    p.wi0 = i0 + 32 * F.wave; p.iq = p.wi0 + r32;
    const int tq = res + p.dil * p.iq; const size_t row = (size_t)b * SEQ + tq;
    fa::bf16x8 qf[4]; fa::load_qf(p.Zb + (size_t)tq * DINP + ZDQ + 64 * h, hi, qf);
    float m = -INFINITY, l = 0.f; fa::f32x16 O[2];
#pragma unroll
    for (int dt = 0; dt < 2; ++dt)
#pragma unroll
        for (int r = 0; r < 16; ++r) O[dt][r] = 0.f;
    fa::stream<0, 4, DilPol>(p, F.lds3, F.tid, 0.125f * fa::LOG2E, qf, m, l, O);
    const float lt = fa::finish(l, O);
    fa::store_o(O, DP + ((size_t)g * T + row) * 256 + 64 * h, hi);
    if (hi == 0) DL[((size_t)g * T + row) * 4 + h] = (m + __log2f(lt)) * fa::LN2;
}
__device__ __forceinline__ void dil_combine(Frame& F) {
    PHASE_IDS(F);
    const bf16* DP = (const bf16*)(F.ws + WS_DPART); const float* DL = (const float*)(F.ws + WS_DLSE); bf16* AO = (bf16*)(F.ws + WS_H);
    const int gt = F.gw * 64 + F.lane, ngt = F.ngw * 64;
    for (int i = gt; i < T * 32; i += ngt) { const int row = i >> 5, c8 = (i & 31) * 8, h = c8 >> 6;
        const float l0 = DL[(size_t)row * 4 + h], l1 = DL[((size_t)T + row) * 4 + h], l2 = DL[((size_t)2 * T + row) * 4 + h];
        const float mx = fmaxf(l0, fmaxf(l1, l2)); float w0 = __expf(l0 - mx), w1 = __expf(l1 - mx), w2 = __expf(l2 - mx); const float inv = 1.0f / (w0 + w1 + w2); w0 *= inv; w1 *= inv; w2 *= inv;
        float x0[8], x1[8], x2[8]; ld8(DP + (size_t)row * 256 + c8, x0); ld8(DP + ((size_t)T + row) * 256 + c8, x1); ld8(DP + ((size_t)2 * T + row) * 256 + c8, x2);
        v4u o; o.x = pk2(w0 * x0[0] + w1 * x1[0] + w2 * x2[0], w0 * x0[1] + w1 * x1[1] + w2 * x2[1]); o.y = pk2(w0 * x0[2] + w1 * x1[2] + w2 * x2[2], w0 * x0[3] + w1 * x1[3] + w2 * x2[3]);
        o.z = pk2(w0 * x0[4] + w1 * x1[4] + w2 * x2[4], w0 * x0[5] + w1 * x1[5] + w2 * x2[5]); o.w = pk2(w0 * x0[6] + w1 * x1[6] + w2 * x2[6], w0 * x0[7] + w1 * x1[7] + w2 * x2[7]);
        *(v4u*)(AO + (size_t)row * DM + 768 + c8) = o; }
}
struct CmpPol {
    const bf16* KCb; const bf16* VCb; int nt, ubg; float* impA; float* impB; int tokl; bool nov;
    __device__ __forceinline__ int ntiles() const { return nt; }
    __device__ __forceinline__ const bf16* krow(int it, int r) const { return KCb + (size_t)(64 * it + r) * 64; }
    __device__ __forceinline__ const bf16* vrow(int it, int r) const { return VCb + (size_t)(64 * it + r) * 64; }
    __device__ __forceinline__ bool wave_skip(int) const { return false; }
    __device__ __forceinline__ int mask_mode(int) const { return 1; }
    __device__ __forceinline__ bool lane_keep(int) const { return true; }
    __device__ __forceinline__ void bounds(int it, int& lb, int& ub) const { lb = 0; ub = ubg - 64 * it; }
};
struct SlcPol {
    const bf16* Zb; const unsigned char* list; int nt, t, cblk; unsigned wlo, whi, mlo, mhi;
    __device__ __forceinline__ int ntiles() const { return nt; }
    __device__ __forceinline__ const bf16* krow(int it, int r) const { const int j = list[it]; return Zb + (size_t)(64 * j + r) * DINP + ZKS; }
    __device__ __forceinline__ const bf16* vrow(int it, int r) const { const int j = list[it]; return Zb + (size_t)(64 * j + r) * DINP + ZVS; }
    __device__ __forceinline__ bool wave_skip(int it) const { const int j = list[it]; return !(((j < 32) ? (wlo >> j) : (whi >> (j - 32))) & 1u); }
    __device__ __forceinline__ int mask_mode(int it) const { return (int)list[it] == cblk ? 1 : 0; }
    __device__ __forceinline__ bool lane_keep(int it) const { const int j = list[it]; return (((j < 32) ? (mlo >> j) : (mhi >> (j - 32))) & 1u) != 0u; }
    __device__ __forceinline__ void bounds(int it, int& lb, int& ub) const { const int j = list[it]; lb = 0; ub = t - 64 * j; }
};
struct WinPol {
    const bf16* Zb; int jt0, nt, t, cblk;
    __device__ __forceinline__ int ntiles() const { return nt; }
    __device__ __forceinline__ const bf16* krow(int it, int r) const { return Zb + (size_t)(64 * (jt0 + it) + r) * DINP + ZKW; }
    __device__ __forceinline__ const bf16* vrow(int it, int r) const { return Zb + (size_t)(64 * (jt0 + it) + r) * DINP + ZVW; }
    __device__ __forceinline__ bool wave_skip(int) const { return false; }
    __device__ __forceinline__ int mask_mode(int it) const { const int jt = jt0 + it; return (jt == cblk ? 1 : 0) | (jt == cblk - 8 ? 2 : 0); }
    __device__ __forceinline__ bool lane_keep(int) const { return true; }
    __device__ __forceinline__ void bounds(int it, int& lb, int& ub) const { ub = t - 64 * (jt0 + it); lb = ub - 511; }
};
constexpr int NSA_IMP_OFF = 45056, NSA_SEL_OFF = NSA_IMP_OFF + 2 * 64 * 65 * 4, NSA_LIST_OFF = NSA_SEL_OFF + 512;
static_assert(fa::LDS_NEED <= NSA_IMP_OFF && NSA_LIST_OFF + 64 <= RING_BYTES, "NSA LDS map");
__device__ __forceinline__ void nsa_item(Frame& F, int b, int c) {
    PHASE_IDS(F);
    const bf16* Z = (const bf16*)(F.ws + WS_Z); const bf16* AQR = (const bf16*)(F.ws + WS_AQR); bf16* AO = (bf16*)(F.ws + WS_H);
    const bf16* KCB = (const bf16*)(F.ws + WS_KC) + (size_t)b * 256 * 64; const bf16* VCB = (const bf16*)(F.ws + WS_VC) + (size_t)b * 256 * 64;
    const int lane = F.lane, r32 = lane & 31, hi = lane >> 5, tokl = 8 * F.wave + (r32 >> 2), h = r32 & 3, t = 64 * c + tokl; const size_t row = (size_t)b * SEQ + t;
    const bf16* Zb = Z + (size_t)b * SEQ * DINP;
    float* impA = (float*)(F.lds + NSA_IMP_OFF); float* impB = impA + 64 * 65;
    unsigned long long* sel = (unsigned long long*)(F.lds + NSA_SEL_OFF); unsigned char* list = F.lds + NSA_LIST_OFF;
    for (int i = F.tid; i < 2 * 64 * 65; i += NTHREADS) impA[i] = 0.f;
    const bf16* zr = Zb + (size_t)t * DINP;
    const float g0 = sigmoidf_(bf2f(zr[ZAG + h])), g1 = sigmoidf_(bf2f(zr[ZAG + 4 + h])), g2 = sigmoidf_(bf2f(zr[ZAG + 8 + h]));
    fa::f32x16 acc[2], O[2];
    {
        CmpPol cp; cp.KCb = KCB; cp.VCb = VCB; cp.nt = (4 * c + 2 + 64) >> 6; cp.ubg = t >= 31 ? ((t - 31) >> 4) : -1; cp.impA = impA; cp.impB = impB; cp.tokl = tokl; cp.nov = false;
        fa::bf16x8 qf[4]; fa::load_qf(zr + ZAQ + 64 * h, hi, qf);
        float m = -INFINITY, l = 0.f;
#pragma unroll
        for (int dt = 0; dt < 2; ++dt)
#pragma unroll
            for (int r = 0; r < 16; ++r) O[dt][r] = 0.f;
        fa::stream<0, 4, CmpPol, 0>(cp, F.lds3, F.tid, 0.125f * fa::LOG2E, qf, m, l, O);
        float lt = fa::finish(l, O);
#pragma unroll
        for (int dt = 0; dt < 2; ++dt)
#pragma unroll
            for (int r = 0; r < 16; ++r) acc[dt][r] = g0 * O[dt][r];
        cp.nov = true;
        fa::stream<0, 4, CmpPol, 1>(cp, F.lds3, F.tid, 0.125f * fa::LOG2E, qf, m, lt, O);
    }
    __syncthreads();
#pragma unroll 1
    for (int tk = 0; tk < 8; ++tk) {
        const int tl = 8 * F.wave + tk, j = lane; const float imp = impA[tl * 65 + j] + impB[tl * 65 + j];
        const bool forced = (j == 0) || (j <= c && j > c - 2);
        const float sc = (j > c) ? -1.0e6f : (forced ? 1.0e6f : imp);
        int rank = 0;
#pragma unroll 8
        for (int i = 0; i < 64; ++i) { const float si = lane_get(sc, i); rank += (si > sc || (si == sc && i < j)) ? 1 : 0; }
        const unsigned long long mask = __ballot(rank < 16 && j <= c);
        if (lane == 0) sel[tl] = mask;
    }
    __syncthreads();
    SlcPol sp; sp.Zb = Zb; sp.list = list; sp.t = t; sp.cblk = c;
    { const unsigned long long mk = sel[tokl]; sp.mlo = (unsigned)mk; sp.mhi = (unsigned)(mk >> 32);
      unsigned wl = sp.mlo, wh = sp.mhi; wl |= (unsigned)sx_i<4>((int)wl); wh |= (unsigned)sx_i<4>((int)wh); wl |= (unsigned)sx_i<8>((int)wl); wh |= (unsigned)sx_i<8>((int)wh); wl |= (unsigned)sx_i<16>((int)wl); wh |= (unsigned)sx_i<16>((int)wh);
      sp.wlo = __builtin_amdgcn_readfirstlane(wl); sp.whi = __builtin_amdgcn_readfirstlane(wh);
      const unsigned long long mu = sel[lane]; unsigned ul = (unsigned)mu, uh = (unsigned)(mu >> 32);
      ul |= (unsigned)sx_i<1>((int)ul); uh |= (unsigned)sx_i<1>((int)uh); ul |= (unsigned)sx_i<2>((int)ul); uh |= (unsigned)sx_i<2>((int)uh); ul |= (unsigned)sx_i<4>((int)ul); uh |= (unsigned)sx_i<4>((int)uh);
      ul |= (unsigned)sx_i<8>((int)ul); uh |= (unsigned)sx_i<8>((int)uh); ul |= (unsigned)sx_i<16>((int)ul); uh |= (unsigned)sx_i<16>((int)uh); ul = or32(ul); uh = or32(uh);
      ul = __builtin_amdgcn_readfirstlane(ul); uh = __builtin_amdgcn_readfirstlane(uh);
      const unsigned long long un = ((unsigned long long)uh << 32) | ul;
      if ((un >> lane) & 1ull) list[__popcll(un & ((1ull << lane) - 1ull))] = (unsigned char)lane;
      sp.nt = __popcll(un); }
    fa::bf16x8 qf[4]; fa::load_qf(AQR + row * 256 + 64 * h, hi, qf);
    { float m = -INFINITY, l = 0.f;
#pragma unroll
      for (int dt = 0; dt < 2; ++dt)
#pragma unroll
          for (int r = 0; r < 16; ++r) O[dt][r] = 0.f;
      fa::stream<0, 4, SlcPol, 0>(sp, F.lds3, F.tid, 0.125f * fa::LOG2E, qf, m, l, O); fa::finish(l, O);
#pragma unroll
      for (int dt = 0; dt < 2; ++dt)
#pragma unroll
          for (int r = 0; r < 16; ++r) acc[dt][r] += g1 * O[dt][r]; }
    { WinPol wp; wp.Zb = Zb; wp.jt0 = c >= 8 ? c - 8 : 0; wp.nt = c - wp.jt0 + 1; wp.t = t; wp.cblk = c;
      float m = -INFINITY, l = 0.f;
#pragma unroll
      for (int dt = 0; dt < 2; ++dt)
#pragma unroll
          for (int r = 0; r < 16; ++r) O[dt][r] = 0.f;
      fa::stream<0, 4, WinPol, 0>(wp, F.lds3, F.tid, 0.125f * fa::LOG2E, qf, m, l, O); fa::finish(l, O);
#pragma unroll
      for (int dt = 0; dt < 2; ++dt)
#pragma unroll
          for (int r = 0; r < 16; ++r) acc[dt][r] += g2 * O[dt][r]; }
    fa::store_o(acc, AO + row * DM + 64 * h, hi);
}
__device__ __forceinline__ void scan_item(Frame& F, int it) {
    PHASE_IDS(F);
    float* CLOC = (float*)(F.ws + WS_CLOC); float* NLOC = (float*)(F.ws + WS_NLOC);
    const float* ACH = (const float*)(F.ws + WS_ACH); const float* MLOC = (const float*)(F.ws + WS_MLOC); float* MIN = (float*)(F.ws + WS_MIN);
    const int bh = it >> 2, qt = it & 3; const int e0 = qt * 1024 + F.tid * 2;
    float c0 = 0.f, c1 = 0.f, nst = 0.f, mst = 0.f;
#pragma unroll 1
    for (int cb = 0; cb < 64; cb += 16) {
        f32x2 cl[16]; float ac[16], ml[16], nl[16];
#pragma unroll
        for (int u = 0; u < 16; ++u) { const int ci = bh * 64 + cb + u; cl[u] = *(const f32x2*)(CLOC + (size_t)ci * 4096 + e0); ac[u] = ACH[ci]; ml[u] = MLOC[ci]; nl[u] = (qt == 0 && F.tid < 64) ? NLOC[ci * 64 + F.tid] : 0.f; }
#pragma unroll
        for (int u = 0; u < 16; ++u) { const int ci = bh * 64 + cb + u;
            const float mn = fmaxf(ac[u] + mst, ml[u]), decay = __expf(ac[u] + mst - mn), fresh = __expf(ml[u] - mn);
            *(f32x2*)(CLOC + (size_t)ci * 4096 + e0) = (f32x2){c0, c1}; c0 = decay * c0 + fresh * cl[u].x; c1 = decay * c1 + fresh * cl[u].y;
            if (qt == 0 && F.tid < 64) { NLOC[ci * 64 + F.tid] = nst; nst = decay * nst + fresh * nl[u]; if (F.tid == 0) MIN[ci] = mst; }
            mst = mn; }
    }
}
struct QOrder { unsigned short v[64 + 256 + 256 + 768]; };
constexpr QOrder make_order() {
    QOrder o{}; int n = 0, id = 0, in = 0;
    for (int k = 0; k < 64; ++k) o.v[n++] = (unsigned short)((3 << 12) | k);
    while (id < 256 || in < 256) {
        const int cd = id < 256 ? 96 * (15 - id / 16 + 1) : -1, cn = in < 256 ? 16 * (63 - in / 4 + 18) : -1;
        if (cd >= cn) { o.v[n++] = (unsigned short)((0 << 12) | id); ++id; } else { o.v[n++] = (unsigned short)((1 << 12) | in); ++in; }
    }
    for (int k = 0; k < 768; ++k) o.v[n++] = (unsigned short)((2 << 12) | k);
    return o;
}
__device__ const QOrder g_order = make_order();
__device__ __forceinline__ void ph_d_queue(Frame& F, const Args& a, int layer) {
    PHASE_IDS(F);
    unsigned* ctr = F.ctl + CW_Q + 64 * layer;
    const float* lv = a.in[5] + (size_t)layer * 128;
    const float lam_init = 0.8f - 0.6f * expf(-0.3f * (float)layer);
    float l01 = 0.f, l23 = 0.f; if (F.lane < 32) { l01 = lv[F.lane] * lv[32 + F.lane]; l23 = lv[64 + F.lane] * lv[96 + F.lane]; }
    const float lam = expf(wave_sum(l01)) - expf(wave_sum(l23)) + lam_init;
    constexpr int NQ = 64 + 256 + 256 + 768;
    for (;;) {
        __syncthreads();
        if (F.tid == 0) F.MISC[0] = __hip_atomic_fetch_add(ctr, 1u, __ATOMIC_RELAXED, __HIP_MEMORY_SCOPE_AGENT);
        __syncthreads();
        const int qi = (int)F.MISC[0];
        if (qi >= NQ) break;
        const int e = g_order.v[qi], ty = e >> 12, id = e & 4095;
        if (ty == 3) scan_item(F, id);
        else if (ty == 0) { const int qb = 15 - (id >> 4), bh = id & 15; diff_item(F, a, layer, bh >> 2, bh & 3, qb, lam); }
        else if (ty == 1) nsa_item(F, id & 3, 63 - (id >> 2));
        else { const int bh = id & 15, k = id >> 4;
            const int g = k >> 4, j = k & 15; const int res = (g == 0) ? 0 : (g == 1) ? (j & 3) : j, blk = (g == 0) ? j : (g == 1) ? (j >> 2) : 0;
            dil_item(F, bh >> 2, bh & 3, g, res, blk); }
    }
    __syncthreads();
}

constexpr int NPHASE = 9 * DEPTH + 1;
#ifndef PH_LO
#define PH_LO 0
#endif
#ifndef PH_HI
#define PH_HI NPHASE
#endif
#define IN(k) (PH_LO <= (k) && (k) < PH_HI)
#ifdef PROBE_K
#ifndef PROBE_SUB
#define PROBE_SUB 0
#endif
#ifndef PROBE_AMP
#define PROBE_AMP 10
#endif
#define PROBE_T0(k) do { if ((k) == PROBE_K) F.pt0 = __builtin_amdgcn_s_memrealtime(); } while (0)
#define PROBE_T1(k) do { if ((k) == PROBE_K) F.pdt = __builtin_amdgcn_s_memrealtime() - F.pt0; } while (0)
#define SUBP(id, call) do { if (layer == 0 && (id) == PROBE_SUB) { F.pt0 = __builtin_amdgcn_s_memrealtime(); call; __syncthreads(); F.pdt = __builtin_amdgcn_s_memrealtime() - F.pt0; } else { call; } } while (0)
#else
#define SUBP(id, call) do { call; } while (0)
#define PROBE_T0(k) do { } while (0)
#define PROBE_T1(k) do { } while (0)
#endif
#define SEAM(k) do { if (IN(k) && (k) + 1 < PH_HI) { if ((k) == PH_LO && F.G == 0x7fffffff) cg::this_grid().sync();   xcd_barrier(bar); } } while (0)
template <int layer> __device__ __forceinline__ void run_layer(Frame& F, const Args& args, const XcdBarrier& bar) {
    float* XR = args.out;
    bf16* H = (bf16*)(F.ws + WS_H); bf16* Z = (bf16*)(F.ws + WS_Z);
    bf16* WIN = (bf16*)(F.ws + WS_WIN); bf16* WOUT = (bf16*)(F.ws + WS_WOUT); bf16* WGU = (bf16*)(F.ws + WS_WGU); bf16* WD = (bf16*)(F.ws + WS_WD);

        const int P = 9 * layer;
        bf16* XB2 = (bf16*)(F.ws + WS_XB2); bf16* ACT = (bf16*)(F.ws + WS_ACT);
        PROBE_T0(P + 0);
        if (IN(P + 0)) {
            convert_weights(F, args, layer);
            if (layer == 0) build_rope(F, args);
            norm_rows_bf16(F, layer == 0 ? args.in[0] : XR, args.in[1] + (size_t)layer * DM, H);
        }
        SEAM(P + 0); PROBE_T1(P + 0);
        PROBE_T0(P + 1);
        if (IN(P + 1)) {
            pg8::Gemm g{H, WIN, T, DINP, DM}; pg8::StaticOrder S; S.init(T, DINP, F.G, (int)blockIdx.x);
            pg8::EpiZR E{Z, DINP, (const float*)(F.ws + WS_ROPE64), (const float*)(F.ws + WS_ROPE32), (bf16*)(F.ws + WS_AQR)};
            pg8::gemm_phase<pg8::EpiZR, pg8::StaticOrder, true, true>(F.lds3, g, S, E);
        }
        SEAM(P + 1); PROBE_T1(P + 1);
        PROBE_T0(P + 2);
        if (IN(P + 2)) { SUBP(1, prep_mlstm(F, args, layer)); SUBP(2, prep_compress(F, args, layer)); }
        SEAM(P + 2); PROBE_T1(P + 2);
        PROBE_T0(P + 3);
        if (IN(P + 3)) ph_d_queue(F, args, layer);
        SEAM(P + 3); PROBE_T1(P + 3);
        PROBE_T0(P + 4);
        if (IN(P + 4)) { SUBP(4, ph_mlstm_out(F, args, layer)); SUBP(5, dil_combine(F)); }
        SEAM(P + 4); PROBE_T1(P + 4);
        PROBE_T0(P + 5);
        if (IN(P + 5)) {
            pg8::Gemm g{H, WOUT, T, DM, DM}; pg8::StaticOrder S; S.init(T, DM, F.G, (int)blockIdx.x); pg8::EpiRes E{layer == 0 ? args.in[0] : XR, XR, DM};
            pg8::gemm_phase<pg8::EpiRes, pg8::StaticOrder, true, true>(F.lds3, g, S, E);
        }
        SEAM(P + 5); PROBE_T1(P + 5);
        PROBE_T0(P + 6);
        if (IN(P + 6)) norm_rows_bf16(F, XR, args.in[14] + (size_t)layer * DM, XB2);
        SEAM(P + 6); PROBE_T1(P + 6);
        PROBE_T0(P + 7);
        if (IN(P + 7)) {
            pg8::Gemm g{XB2, WGU, T, 2 * DFF, DM}; pg8::StaticOrder S; S.init(T, 2 * DFF, F.G, (int)blockIdx.x); pg8::EpiSwiGLU E{ACT, DFF};
            pg8::gemm_phase<pg8::EpiSwiGLU, pg8::StaticOrder, true, true>(F.lds3, g, S, E);
        }
        SEAM(P + 7); PROBE_T1(P + 7);
        PROBE_T0(P + 8);
        if (IN(P + 8)) {
            pg8::Gemm g{ACT, WD, T, DM, DFF}; pg8::StaticOrder S; S.init(T, DM, F.G, (int)blockIdx.x); pg8::EpiRes E{XR, XR, DM};
            pg8::gemm_phase<pg8::EpiRes, pg8::StaticOrder, true, true>(F.lds3, g, S, E);
        }
        SEAM(P + 8); PROBE_T1(P + 8);
}
__global__ void __launch_bounds__(NTHREADS, 2) fwd_kernel(Args args) {
    extern __shared__ __attribute__((aligned(16))) unsigned char lds[];
    Frame F;
    F.lds = lds; F.lds3 = (LAS unsigned char*)lds; F.MISC = (volatile LAS unsigned*)(F.lds3 + MISC_OFF);
    F.tid = threadIdx.x; F.lane = F.tid & 63; F.wave = __builtin_amdgcn_readfirstlane(F.tid >> 6);
    F.G = gridDim.x; F.gw = blockIdx.x * NWAVES + F.wave; F.ngw = F.G * NWAVES;
    F.ws = args.ws; F.ctl = (unsigned*)(args.ws + WS_CTL);
    for (int u = F.tid; u < (LDS_BYTES - LDSCTL_OFF) / 4; u += NTHREADS) ((LAS unsigned*)(F.lds3 + LDSCTL_OFF))[u] = 0u;
    __syncthreads();
    XcdBarrier bar = xcd_barrier_post(F.ctl + CW_BAR, F.MISC + 8);
    run_layer<0>(F, args, bar);
    run_layer<1>(F, args, bar);
    if (IN(9 * DEPTH)) final_norm(F, args.out, args.in[18]);
#ifdef PROBE_K
    if (blockIdx.x == 0) { const unsigned long long te = __builtin_amdgcn_s_memrealtime(); while (__builtin_amdgcn_s_memrealtime() - te < (unsigned long long)PROBE_AMP * F.pdt) __builtin_amdgcn_s_sleep(32); }
#endif
#undef IN
#undef SEAM
}

extern "C" void kernel_launch(void* const* d_in, const int* in_sizes, int n_in, void* d_out, int out_size, void* d_ws, size_t ws_size, hipStream_t stream) {
    static int grid = 0;
    if (grid == 0) {
        if (n_in != 19 || in_sizes[0] != T * DM || out_size != T * DM || ws_size < WS_END) { fprintf(stderr, "kernel_launch: unexpected shapes (n_in %d, in0 %d, out %d, ws %zu); nothing launched\n", n_in, n_in > 0 ? in_sizes[0] : -1, out_size, ws_size); grid = -1; return; }
        int dev = 0, cus = 0, per_cu = 0;
        if (hipGetDevice(&dev) != hipSuccess || hipDeviceGetAttribute(&cus, hipDeviceAttributeMultiprocessorCount, dev) != hipSuccess) { grid = -1; return; }
        if (hipFuncSetAttribute((const void*)fwd_kernel, hipFuncAttributeMaxDynamicSharedMemorySize, LDS_BYTES) != hipSuccess) { fprintf(stderr, "kernel_launch: hipFuncSetAttribute failed\n"); grid = -1; return; }
        if (hipOccupancyMaxActiveBlocksPerMultiprocessor(&per_cu, (const void*)fwd_kernel, NTHREADS, LDS_BYTES) != hipSuccess || per_cu < 1) { fprintf(stderr, "kernel_launch: note: occupancy query says %d blocks per CU\n", per_cu); (void)hipGetLastError(); }
        grid = cus;
    }
    if (grid < 0) return;
    if (hipMemsetAsync((char*)d_ws + WS_CTL, 0, CTL_ZERO_BYTES, stream) != hipSuccess) { fprintf(stderr, "kernel_launch: memset failed\n"); return; }
    Args a{};
    for (int i = 0; i < 19; ++i) a.in[i] = (const float*)d_in[i];
    a.out = (float*)d_out; a.ws = (unsigned char*)d_ws;
    for (int i = 0; i < 32; ++i) a.inv64[i] = 1.0f / powf(10000.0f, (float)(2 * i) / 64.0f);
    for (int i = 0; i < 16; ++i) a.inv32[i] = 1.0f / powf(10000.0f, (float)(2 * i) / 32.0f);
    void* params[] = {&a};
    const hipError_t le = hipLaunchCooperativeKernel((const void*)fwd_kernel, dim3(grid), dim3(NTHREADS), params, LDS_BYTES, stream);
    if (le != hipSuccess) fprintf(stderr, "kernel_launch: cooperative launch failed: %s (grid %d)\n", hipGetErrorName(le), grid);
}
```

```cpp
#include <hip/hip_runtime.h>
#include <hip/hip_cooperative_groups.h>
#include <cstdio>
#include <cstdint>
namespace cg = cooperative_groups;
namespace pg8 {
#define PG8_LAS __attribute__((address_space(3)))
typedef unsigned short bf16_t;
typedef short bf16x8 __attribute__((ext_vector_type(8)));
typedef float f32x4 __attribute__((ext_vector_type(4)));
typedef unsigned u32x4 __attribute__((ext_vector_type(4)));
constexpr int BM = 256, BK = 64, HALF = 128, HTB = HALF * BK * 2  , STAGE_BYTES = 8 * HTB, NXCD = 8, WGM = 8;

__host__ __device__ __forceinline__ int lds_byte(int r, int c) { const int st = (r >> 4) * 2 + (c >> 5), rr = r & 15, cc = c & 31, ob = rr * 64 + cc * 2; return st * 1024 + (ob ^ (((ob >> 9) & 1) << 5)); }
__host__ __device__ __forceinline__ void stage_rc(int b, int& R, int& C) { const int st = b / 1024, sb = b % 1024, swz = sb ^ (((sb >> 9) & 1) << 5); R = (st >> 1) * 16 + swz / 64; C = (st & 1) * 32 + (swz % 64) / 2; }
__host__ __device__ __forceinline__ int perm32(int rho) { const int n = rho >> 4, i = rho & 15; return 8 * (i >> 2) + 4 * n + (i & 3); }

struct Unit { int pm, pn; };
struct Gemm { const bf16_t* A; const bf16_t* Bt; int M, N, K; };

struct StaticOrder {
    int nM, nN, nwg, G, c;
    __host__ __device__ void init(int M, int N, int G_, int c_) { nM = M / BM; nN = N / BM; nwg = nM * nN; G = G_; c = c_; }
    __host__ __device__ bool next(int i, Unit& u) const {
        const long L = (long)i * G + c; if (L >= nwg) return false;
        int wgid = (int)L; { const int q = nwg / NXCD, r = nwg % NXCD, xcd = wgid % NXCD, off = wgid / NXCD; wgid = (xcd < r ? xcd * (q + 1) : r * (q + 1) + (xcd - r) * q) + off; }
        const int nig = WGM * nN, gid = wgid / nig, fm = gid * WGM, gsz = (nM - fm) < WGM ? (nM - fm) : WGM;
        u.pm = fm + ((wgid % nig) % gsz); u.pn = (wgid % nig) / gsz; return true;
    }
    __device__ __forceinline__ void a_ready(const Unit&) const {}
    __device__ __forceinline__ void done(const Unit&) const {}
};

__device__ __forceinline__ unsigned cvt_pk_bf16(float lo, float hi) { unsigned r; asm volatile("v_cvt_pk_bf16_f32 %0, %1, %2" : "=v"(r) : "v"(lo), "v"(hi)); return r; }
typedef float f32x2 __attribute__((ext_vector_type(2)));
struct EpiZR {
    static constexpr bool PERM = true, AFTER_DRAIN = false;
    bf16_t* O; int ldc; const float* r64; const float* r32; bf16_t* aqr;
    __device__ __forceinline__ void operator()(const f32x4 (&acc)[2][2][4][2], const Unit& u, int wr, int wc, int fr, int fq) const {
        const int row0 = u.pm * BM + wr * 64 + fr, col0 = u.pn * BM + wc * 32 + 8 * fq;
        constexpr unsigned long long R64 = 0xFull | (1ull << 6) | (1ull << 8) | (0xFFull << 34), R32 = 0xFFull << 10;
#pragma unroll
        for (int ai = 0; ai < 2; ++ai)
#pragma unroll
            for (int m = 0; m < 4; ++m) { const int row = row0 + ai * HALF + m * 16; const int pos = row & 4095; bf16_t* rowp = O + (size_t)row * ldc + col0;
#pragma unroll
                for (int bj = 0; bj < 2; ++bj) { f32x4 v0 = acc[ai][bj][m][0], v1 = acc[ai][bj][m][1]; const int c0 = col0 + bj * HALF, seg = c0 >> 6;
                    const bool t64 = (R64 >> seg) & 1ull, t32 = (R32 >> seg) & 1ull;
                    if (t64 || t32) {
                        const float* tp = t64 ? r64 + ((size_t)pos * 32 + ((c0 & 63) >> 1)) * 2 : r32 + ((size_t)pos * 16 + ((c0 & 31) >> 1)) * 2;
                        const f32x4 ca = *(const f32x4*)tp, cb = *(const f32x4*)(tp + 4);
                        const f32x4 o0 = {v0[0] * ca[0] - v0[1] * ca[1], v0[0] * ca[1] + v0[1] * ca[0], v0[2] * ca[2] - v0[3] * ca[3], v0[2] * ca[3] + v0[3] * ca[2]};
                        const f32x4 o1 = {v1[0] * cb[0] - v1[1] * cb[1], v1[0] * cb[1] + v1[1] * cb[0], v1[2] * cb[2] - v1[3] * cb[3], v1[2] * cb[3] + v1[3] * cb[2]};
                        if (seg < 4) { u32x4 wq; wq.x = cvt_pk_bf16(o0[0], o0[1]); wq.y = cvt_pk_bf16(o0[2], o0[3]); wq.z = cvt_pk_bf16(o1[0], o1[1]); wq.w = cvt_pk_bf16(o1[2], o1[3]); *(u32x4*)(aqr + (size_t)row * 256 + c0) = wq; }
                        else { v0 = o0; v1 = o1; }
                    }
                    u32x4 w; w.x = cvt_pk_bf16(v0[0], v0[1]); w.y = cvt_pk_bf16(v0[2], v0[3]); w.z = cvt_pk_bf16(v1[0], v1[1]); w.w = cvt_pk_bf16(v1[2], v1[3]);
                    *(u32x4*)(rowp + bj * HALF) = w; } }
    }
};
struct EpiRes {
    static constexpr bool PERM = false, AFTER_DRAIN = false;
    const float* base; float* out; int ldc;
    __device__ __forceinline__ void operator()(const f32x4 (&acc)[2][2][4][2], const Unit& u, int wr, int wc, int fr, int fq) const {
        const int row0 = u.pm * BM + wr * 64 + fr, col0 = u.pn * BM + wc * 32 + 4 * fq;
#pragma unroll
        for (int ai = 0; ai < 2; ++ai)
#pragma unroll
            for (int m = 0; m < 4; ++m) { const size_t off = (size_t)(row0 + ai * HALF + m * 16) * ldc + col0;
#pragma unroll
                for (int bj = 0; bj < 2; ++bj)
#pragma unroll
                    for (int n = 0; n < 2; ++n) { const size_t p = off + bj * HALF + n * 16; const f32x4 b = *(const f32x4*)(base + p); *(f32x4*)(out + p) = b + acc[ai][bj][m][n]; } }
    }
};
struct EpiSwiGLU {
    static constexpr bool PERM = true, AFTER_DRAIN = false;
    bf16_t* O; int ldc;
    __device__ __forceinline__ void operator()(const f32x4 (&acc)[2][2][4][2], const Unit& u, int wr, int wc, int fr, int fq) const {
        const int row0 = u.pm * BM + wr * 64 + fr, col0 = u.pn * HALF + wc * 32 + 8 * fq;
#pragma unroll
        for (int ai = 0; ai < 2; ++ai)
#pragma unroll
            for (int m = 0; m < 4; ++m) { const int row = row0 + ai * HALF + m * 16; bf16_t* rowp = O + (size_t)row * ldc + col0;
                float r[8];
#pragma unroll
                for (int n = 0; n < 2; ++n)
#pragma unroll
                    for (int j = 0; j < 4; ++j) { const float g = acc[ai][0][m][n][j], up = acc[ai][1][m][n][j]; r[4 * n + j] = g * __builtin_amdgcn_rcpf(1.0f + __expf(-g)) * up; }
                u32x4 w; w.x = cvt_pk_bf16(r[0], r[1]); w.y = cvt_pk_bf16(r[2], r[3]); w.z = cvt_pk_bf16(r[4], r[5]); w.w = cvt_pk_bf16(r[6], r[7]);
                *(u32x4*)rowp = w; }
    }
};
template <class Epi, class Sched, bool ALIGN_EPI = false, bool SP2 = false>
__device__ __forceinline__ void gemm_phase(PG8_LAS unsigned char* lds, const Gemm g, const Sched& S, const Epi& E) {
    int tid_ = threadIdx.x; asm volatile("" : "+v"(tid_));
    const int tid = tid_, wid = __builtin_amdgcn_readfirstlane(tid >> 6), lane = tid & 63, wr = wid >> 2, wc = wid & 3, fr = lane & 15, fq = lane >> 4;
    const int K = g.K, nt = K / BK;
    unsigned voffA[2], voffB[2];
#pragma unroll
    for (int i = 0; i < 2; ++i) { int R, C; stage_rc(tid * 16 + i * 8192, R, C); const int Rb = Epi::PERM ? ((R & ~31) + perm32(R & 31)) : R;
        voffA[i] = (unsigned)(R * K + C) * 2u; voffB[i] = (unsigned)(Rb * K + C) * 2u; }
    const size_t kstep = (size_t)(BK * 2);
    const size_t hstep = (size_t)HALF * K * 2;
    const size_t tstep = 2 * hstep;
    const unsigned ldsw = (unsigned)wid * 1024u;
    const int aoff = lds_byte(wr * 64 + fr, fq * 8), boff = lds_byte(wc * 32 + fr, fq * 8);
#define PG8_SA(b, h) (((b) * 2 + (h)) * HTB)
#define PG8_SB(b, h) ((4 + (b) * 2 + (h)) * HTB)
#define PG8_STAGE(bufoff, gbase, voff) do { _Pragma("unroll") for (int _i = 0; _i < 2; ++_i) \
        __builtin_amdgcn_global_load_lds((const unsigned*)((const char*)(gbase) + (voff)[_i]), (PG8_LAS unsigned*)(lds + (bufoff) + ldsw + _i * 8192), 16, 0, 0); } while (0)
#define PG8_LDA(dst, b, h) do { _Pragma("unroll") for (int m = 0; m < 4; ++m) _Pragma("unroll") for (int k = 0; k < 2; ++k) dst[m][k] = *(const PG8_LAS bf16x8*)(lds + PG8_SA(b, h) + aoff + m * 2048 + k * 1024); } while (0)
#define PG8_LDB(dst, b, h) do { _Pragma("unroll") for (int n = 0; n < 2; ++n) _Pragma("unroll") for (int k = 0; k < 2; ++k) dst[n][k] = *(const PG8_LAS bf16x8*)(lds + PG8_SB(b, h) + boff + n * 2048 + k * 1024); } while (0)
#define PG8_MMA(ai, bj, At, Bt) do { __builtin_amdgcn_s_setprio(1); _Pragma("unroll") for (int m = 0; m < 4; ++m) _Pragma("unroll") for (int n = 0; n < 2; ++n) _Pragma("unroll") for (int k = 0; k < 2; ++k) \
        acc[ai][bj][m][n] = __builtin_amdgcn_mfma_f32_16x16x32_bf16(Bt[n][k], At[m][k], acc[ai][bj][m][n], 0, 0, 0); __builtin_amdgcn_s_setprio(0); } while (0)
#define PG8_WAIT_V(n) asm volatile("s_waitcnt vmcnt(" #n ")" ::: "memory")
#define PG8_WAIT_L(n) asm volatile("s_waitcnt lgkmcnt(" #n ")" ::: "memory")
#define PG8_BAR __builtin_amdgcn_s_barrier()
#define PG8_SCHED __builtin_amdgcn_sched_barrier(0)
    Unit cur, nxt; int ui = 0;
    if (!S.next(0, cur)) return;
    f32x4 acc[2][2][4][2];
#pragma unroll
    for (int a = 0; a < 2; ++a)
#pragma unroll
        for (int b = 0; b < 2; ++b)
#pragma unroll
            for (int m = 0; m < 4; ++m)
#pragma unroll
                for (int n = 0; n < 2; ++n) acc[a][b][m][n] = (f32x4){0.f, 0.f, 0.f, 0.f};
    bf16x8 At[4][2], B0[2][2], B1[2][2];
    const char* cA = (const char*)g.A + (size_t)cur.pm * tstep; const char* cB = (const char*)g.Bt + (size_t)cur.pn * tstep;
    S.a_ready(cur);
    if constexpr (SP2) {
        PG8_STAGE(PG8_SB(0, 0), cB, voffB); PG8_STAGE(PG8_SB(0, 1), cB + hstep, voffB); PG8_STAGE(PG8_SA(0, 0), cA, voffA); PG8_STAGE(PG8_SA(0, 1), cA + hstep, voffA);
        if (wr == 1) PG8_BAR;
        PG8_WAIT_V(2); PG8_BAR;
        PG8_STAGE(PG8_SB(1, 0), cB + kstep, voffB); PG8_STAGE(PG8_SA(1, 0), cA + kstep, voffA); PG8_STAGE(PG8_SB(1, 1), cB + hstep + kstep, voffB);
        PG8_WAIT_V(6); PG8_BAR;
    } else {
        PG8_STAGE(PG8_SB(0, 0), cB, voffB); PG8_STAGE(PG8_SA(0, 0), cA, voffA); PG8_STAGE(PG8_SB(0, 1), cB + hstep, voffB); PG8_STAGE(PG8_SA(0, 1), cA + hstep, voffA);
        if (wr == 1) PG8_BAR;
        PG8_WAIT_V(4); PG8_BAR;
        PG8_STAGE(PG8_SB(1, 0), cB + kstep, voffB); PG8_STAGE(PG8_SA(1, 0), cA + kstep, voffA); PG8_STAGE(PG8_SB(1, 1), cB + hstep + kstep, voffB);
        PG8_WAIT_V(6); PG8_BAR;
    }
    for (;;) {
        const bool has_next = S.next(ui + 1, nxt);
        const char* nA = has_next ? (const char*)g.A + (size_t)nxt.pm * tstep : cA; const char* nB = has_next ? (const char*)g.Bt + (size_t)nxt.pn * tstep : cB;
        for (int t = 0; t < nt; t += 2) {
            const bool last = (t == nt - 2);
            const char* a1 = cA + (size_t)(t + 1) * kstep;
            const char* a2 = last ? nA : cA + (size_t)(t + 2) * kstep; const char* b2 = last ? nB : cB + (size_t)(t + 2) * kstep;
            const char* a3 = a2 + kstep; const char* b3 = b2 + kstep;
            if (last && has_next) S.a_ready(nxt);
            if constexpr (SP2) {
            PG8_LDB(B0, 0, 0); PG8_LDB(B1, 0, 1); PG8_SCHED; PG8_LDA(At, 0, 0); PG8_STAGE(PG8_SA(1, 1), a1 + hstep, voffA);
            PG8_WAIT_V(8); PG8_WAIT_L(0); PG8_BAR; PG8_MMA(0, 0, At, B0); PG8_MMA(0, 1, At, B1); PG8_BAR; PG8_SCHED;
            PG8_LDA(At, 0, 1); PG8_STAGE(PG8_SB(0, 0), b2, voffB); PG8_STAGE(PG8_SB(0, 1), b2 + hstep, voffB); PG8_STAGE(PG8_SA(0, 0), a2, voffA);
            PG8_WAIT_V(8); PG8_WAIT_L(0); PG8_BAR; PG8_MMA(1, 0, At, B0); PG8_MMA(1, 1, At, B1); PG8_BAR; PG8_SCHED;
            PG8_LDB(B0, 1, 0); PG8_LDB(B1, 1, 1); PG8_SCHED; PG8_LDA(At, 1, 0); PG8_STAGE(PG8_SA(0, 1), a2 + hstep, voffA);
            PG8_WAIT_V(8); PG8_WAIT_L(0); PG8_BAR; PG8_MMA(0, 0, At, B0); PG8_MMA(0, 1, At, B1); PG8_BAR; PG8_SCHED;
            PG8_LDA(At, 1, 1); PG8_STAGE(PG8_SB(1, 0), b3, voffB); PG8_STAGE(PG8_SB(1, 1), b3 + hstep, voffB); PG8_STAGE(PG8_SA(1, 0), a3, voffA);
            PG8_WAIT_V(8); PG8_WAIT_L(0); PG8_BAR; PG8_MMA(1, 0, At, B0); PG8_MMA(1, 1, At, B1); PG8_BAR; PG8_SCHED;
            } else {
            PG8_LDB(B0, 0, 0); PG8_SCHED; PG8_LDA(At, 0, 0); PG8_STAGE(PG8_SA(1, 1), a1 + hstep, voffA);
            PG8_WAIT_L(8); PG8_BAR; PG8_WAIT_L(0); PG8_MMA(0, 0, At, B0); PG8_BAR; PG8_SCHED;
            PG8_LDB(B1, 0, 1); PG8_STAGE(PG8_SB(0, 0), b2, voffB);
            PG8_BAR; PG8_WAIT_L(0); PG8_MMA(0, 1, At, B1); PG8_BAR;
            PG8_LDA(At, 0, 1); PG8_STAGE(PG8_SA(0, 0), a2, voffA);
            PG8_BAR; PG8_WAIT_L(0); PG8_MMA(1, 0, At, B0); PG8_BAR; PG8_SCHED;
            PG8_STAGE(PG8_SB(0, 1), b2 + hstep, voffB);
            PG8_WAIT_V(6); PG8_BAR; PG8_MMA(1, 1, At, B1); PG8_BAR;
            PG8_LDB(B0, 1, 0); PG8_SCHED; PG8_LDA(At, 1, 0); PG8_STAGE(PG8_SA(0, 1), a2 + hstep, voffA);
            PG8_WAIT_L(8); PG8_BAR; PG8_WAIT_L(0); PG8_MMA(0, 0, At, B0); PG8_BAR; PG8_SCHED;
            PG8_LDB(B1, 1, 1); PG8_STAGE(PG8_SB(1, 0), b3, voffB);
            PG8_BAR; PG8_WAIT_L(0); PG8_MMA(0, 1, At, B1); PG8_BAR;
            PG8_LDA(At, 1, 1); PG8_STAGE(PG8_SA(1, 0), a3, voffA);
            PG8_BAR; PG8_WAIT_L(0); PG8_MMA(1, 0, At, B0); PG8_BAR; PG8_SCHED;
            PG8_STAGE(PG8_SB(1, 1), b3 + hstep, voffB);
            PG8_WAIT_V(6); PG8_BAR; PG8_MMA(1, 1, At, B1); PG8_BAR;
            }
        }
        if constexpr (ALIGN_EPI) { if (wr == 0) PG8_BAR; }
        if constexpr (!Epi::AFTER_DRAIN) { E(acc, cur, wr, wc, fr, fq); S.done(cur); }
        if (!has_next) break;
#pragma unroll
        for (int a = 0; a < 2; ++a)
#pragma unroll
            for (int b = 0; b < 2; ++b)
#pragma unroll
                for (int m = 0; m < 4; ++m)
#pragma unroll
                    for (int n = 0; n < 2; ++n) acc[a][b][m][n] = (f32x4){0.f, 0.f, 0.f, 0.f};
        cur = nxt; cA = nA; cB = nB; ++ui;
        if constexpr (ALIGN_EPI) { if (wr == 1) PG8_BAR; }
    }
    PG8_WAIT_V(0);
    if constexpr (!ALIGN_EPI) { if (wr == 0) PG8_BAR; }
    PG8_BAR;
    if constexpr (Epi::AFTER_DRAIN) { E.fused(acc, cur, wr, wc, fr, fq, lds, wid, lane); S.done(cur); }
#undef PG8_SA
#undef PG8_SB
#undef PG8_STAGE
#undef PG8_LDA
#undef PG8_LDB
#undef PG8_MMA
#undef PG8_WAIT_V
#undef PG8_WAIT_L
#undef PG8_BAR
#undef PG8_SCHED
}
}

constexpr int NB = 4, SEQ = 4096, T = NB * SEQ, DM = 1024, DIN = 2964, DINP = 3072, DFF = 2816, DEPTH = 2;
constexpr int NWAVES = 8, NTHREADS = 512;
constexpr float EPS = 1e-6f;
constexpr int ZAQ = 0, ZKC = 256, ZVC = 320, ZKS = 384, ZVS = 448, ZKW = 512, ZVW = 576, ZBQ = 640, ZBK = 896, ZBV = 1152,
              ZCU = 1408, ZCV = 1664, ZCO = 1920, ZDQ = 2176, ZDK = 2432, ZDV = 2688, ZAG = 2944, ZCI = 2956, ZCF = 2960;
__host__ __device__ __forceinline__ int pi64(int p) { return (p & 1) ? 32 + (p >> 1) : (p >> 1); }
__host__ __device__ __forceinline__ int pi32(int p) { return (p & 1) ? 16 + (p >> 1) : (p >> 1); }
__host__ __device__ __forceinline__ int zsrc(int n) {
    const int seg = n >> 6, p = n & 63;
    const bool r64 = seg < 4 || seg == 6 || seg == 8 || (seg >= 34 && seg < 42), r32 = seg >= 10 && seg < 18;
    const int q = r64 ? pi64(p) : r32 ? (p & 32) + pi32(p & 31) : p; const int m = seg * 64 + q;
    if (m < 640) return m;
    if (m < 1920) return m + 12;
    if (m < 2944) return m + 20;
    if (m < 2956) return m - 2944 + 640;
    if (m < 2960) return m - 2956 + 1932;
    if (m < 2964) return m - 2960 + 1936;
    return -1;
}
constexpr size_t MiB = 1u << 20;
constexpr size_t WS_CTL = 0, CTL_ZERO_BYTES = 1 * MiB;
constexpr size_t WS_WIN = 2 * MiB, WS_WOUT = 8 * MiB, WS_WGU = 10 * MiB, WS_WD = 21 * MiB;
constexpr size_t WS_ROPE64 = 27 * MiB, WS_ROPE32 = 28 * MiB;
constexpr size_t WS_KC = 29 * MiB, WS_VC = WS_KC + 256 * 1024;
constexpr size_t WS_SEL = WS_VC + 256 * 1024;
constexpr size_t WS_BCUM = 30 * MiB, WS_IG = WS_BCUM + 256 * 1024, WS_NLOC = WS_IG + 256 * 1024;
constexpr size_t WS_ACH = WS_NLOC + 256 * 1024, WS_MLOC = WS_ACH + 4096, WS_MIN = WS_MLOC + 4096;
constexpr size_t WS_WCT = 26 * MiB + 512 * 1024;
constexpr size_t WS_CBP = 28 * MiB + 512 * 1024;
constexpr size_t WS_DLSE = 31 * MiB;
constexpr size_t WS_H = 32 * MiB;
constexpr size_t WS_Z = 64 * MiB;
constexpr size_t WS_XB2 = 64 * MiB, WS_ACT = 96 * MiB;
constexpr size_t WS_AQR = 160 * MiB, WS_OCMP = 168 * MiB, WS_DPART = 176 * MiB;
constexpr size_t WS_MQ = 200 * MiB, WS_MK = 216 * MiB, WS_CLOC = 232 * MiB, WS_END = 248 * MiB;
constexpr int CW_BAR = 4096;
constexpr int CW_Q = 16384;
constexpr int RING_BYTES = 131072, LDSCTL_OFF = RING_BYTES, MISC_OFF = LDSCTL_OFF + 320, LDS_BYTES = 147456;

#define GAS __attribute__((address_space(1)))
#define LAS __attribute__((address_space(3)))
typedef unsigned short bf16;
typedef unsigned v4u __attribute__((ext_vector_type(4)));
typedef unsigned v2u __attribute__((ext_vector_type(2)));
typedef float f32x4 __attribute__((ext_vector_type(4)));
typedef float f32x2 __attribute__((ext_vector_type(2)));
#define LDS_WAIT() asm volatile("s_waitcnt lgkmcnt(0)" ::: "memory")
#define VM_WAIT() asm volatile("s_waitcnt vmcnt(0)" ::: "memory")
__device__ __forceinline__ unsigned f2bf(float f) { unsigned u = __builtin_bit_cast(unsigned, f); return (u + 0x7fffu + ((u >> 16) & 1u)) >> 16; }
__device__ __forceinline__ unsigned pk2(float lo, float hi) { return f2bf(lo) | (f2bf(hi) << 16); }
__device__ __forceinline__ float bf2f(bf16 u) { return __uint_as_float(((unsigned)u) << 16); }
__device__ __forceinline__ float bflo(unsigned w) { return __uint_as_float(w << 16); }
__device__ __forceinline__ float bfhi(unsigned w) { return __uint_as_float(w & 0xffff0000u); }
template <int K> __device__ __forceinline__ int sx_i(int v) {
    if constexpr (K == 1) return __builtin_amdgcn_update_dpp(v, v, 0xB1, 0xF, 0xF, false);
    else if constexpr (K == 2) return __builtin_amdgcn_update_dpp(v, v, 0x4E, 0xF, 0xF, false);
    else return __builtin_amdgcn_ds_swizzle(v, (K << 10) | 0x1f);
}
template <int K> __device__ __forceinline__ float sx(float v) { return __builtin_bit_cast(float, sx_i<K>(__builtin_bit_cast(int, v))); }
__device__ __forceinline__ void swap32(unsigned v, unsigned& a, unsigned& b) { unsigned w = v; asm volatile("" : "+v"(w)); const auto rr = __builtin_amdgcn_permlane32_swap(v, w, false, false); a = rr[0]; b = rr[1]; }
__device__ __forceinline__ float sum32(float v) { unsigned a, b; swap32(__builtin_bit_cast(unsigned, v), a, b); return __builtin_bit_cast(float, a) + __builtin_bit_cast(float, b); }
__device__ __forceinline__ float max32(float v) { unsigned a, b; swap32(__builtin_bit_cast(unsigned, v), a, b); return fmaxf(__builtin_bit_cast(float, a), __builtin_bit_cast(float, b)); }
__device__ __forceinline__ unsigned or32(unsigned v) { unsigned a, b; swap32(v, a, b); return a | b; }
__device__ __forceinline__ float lane_get(float v, int src) { return __builtin_bit_cast(float, __builtin_amdgcn_ds_bpermute(src << 2, __builtin_bit_cast(int, v))); }
__device__ __forceinline__ float wave_sum(float v) { v += sx<1>(v); v += sx<2>(v); v += sx<4>(v); v += sx<8>(v); v += sx<16>(v); return sum32(v); }
__device__ __forceinline__ float wave_max(float v) { v = fmaxf(v, sx<1>(v)); v = fmaxf(v, sx<2>(v)); v = fmaxf(v, sx<4>(v)); v = fmaxf(v, sx<8>(v)); v = fmaxf(v, sx<16>(v)); return max32(v); }
__device__ __forceinline__ float sigmoidf_(float x) { return 1.0f / (1.0f + __expf(-x)); }
#define XB_TMO      128
#define XB_XCNT(j)  (256  + 64 * (j))
#define XB_XSUB(j)  (1280 + 64 * (j))
#define XB_XGEN(j)  (2304 + 64 * (j))
#define XB_TOP      3328
#define XB_TOPGEN   3392
#define XCD_BAR_WORDS 3456
#define XB_SPIN_CAP (1u << 18)

__device__ __forceinline__ unsigned xb_ld(unsigned* p)              { return __hip_atomic_load(p, __ATOMIC_RELAXED, __HIP_MEMORY_SCOPE_AGENT); }
__device__ __forceinline__ unsigned xb_add(unsigned* p, unsigned v) { return __hip_atomic_fetch_add(p, v, __ATOMIC_RELAXED, __HIP_MEMORY_SCOPE_AGENT); }
__device__ __forceinline__ unsigned xb_xcc_id() { return (unsigned)__builtin_amdgcn_s_getreg((3 << 11) | 20) & 0xFu; }
#define XB_SPIN(cond, bar) do { unsigned _sp = 0; while (cond) { __builtin_amdgcn_s_sleep(1); \
    if ((++_sp & 255u) == 0u) { if (xb_ld(&(bar)[XB_TMO])) break; if (_sp > XB_SPIN_CAP) { atomicAdd(&(bar)[XB_TMO], 1u); break; } } } } while (0)

struct XcdBarrier {
    unsigned* bar; unsigned x;
    volatile LAS unsigned* st;
};

__device__ __forceinline__ XcdBarrier xcd_barrier_post(unsigned* bar, volatile LAS unsigned* st) {
    XcdBarrier b; b.bar = bar; b.x = xb_xcc_id(); b.st = st;
    if (threadIdx.x == 0) (void)xb_add(&bar[XB_XCNT(b.x)], 1u);
    return b;
}
__device__ __forceinline__ void xcd_barrier_complete(unsigned* bar, unsigned x, unsigned& nloc, unsigned& nx) {
    const unsigned G = gridDim.x * gridDim.y * gridDim.z;
    unsigned sum, cnt, mine, sp = 0u;
    for (;;) {
        sum = 0u; cnt = 0u; mine = 0u;
#pragma unroll 1
        for (unsigned j = 0; j < 16; ++j) { const unsigned c = xb_ld(&bar[XB_XCNT(j)]); sum += c; cnt += (c > 0u) ? 1u : 0u; mine = (j == x) ? c : mine; }
        if (sum == G) break;
        __builtin_amdgcn_s_sleep(1);
        if ((++sp & 255u) == 0u) { if (xb_ld(&bar[XB_TMO])) break; if (sp > XB_SPIN_CAP) { atomicAdd(&bar[XB_TMO], 1u); break; } }
    }
    nloc = mine > 0u ? mine : 1u; nx = cnt > 0u ? cnt : 1u;
}

__device__ __forceinline__ void xcd_barrier(const XcdBarrier& b) {
    asm volatile("s_waitcnt vmcnt(0)" ::: "memory");
    __syncthreads();
    if (threadIdx.x == 0) {
        unsigned* bar = b.bar;
        __builtin_amdgcn_s_waitcnt(0);
        unsigned nloc = b.st[0], nx = b.st[1];
        if (nloc == 0u) { xcd_barrier_complete(bar, b.x, nloc, nx); b.st[0] = nloc; b.st[1] = nx; }
        const unsigned old = xb_add(&bar[XB_XSUB(b.x)], 1u);
        const unsigned gen = old / nloc;
        if (old + 1u == (gen + 1u) * nloc) {
            __builtin_amdgcn_fence(__ATOMIC_RELEASE, "agent");
            asm volatile("s_waitcnt vmcnt(0)" ::: "memory");
            const unsigned og = xb_add(&bar[XB_TOP], 1u);
            const unsigned tg = og / nx;
            if (og + 1u == (tg + 1u) * nx) xb_add(&bar[XB_TOPGEN], 1u);
            else XB_SPIN(xb_ld(&bar[XB_TOPGEN]) == tg, bar);
            __builtin_amdgcn_fence(__ATOMIC_ACQUIRE, "agent");
            xb_add(&bar[XB_XGEN(b.x)], 1u);
            asm volatile("s_waitcnt vmcnt(0)" ::: "memory");
        } else {
            XB_SPIN(xb_ld(&bar[XB_XGEN(b.x)]) == gen, bar);
            __builtin_amdgcn_fence(__ATOMIC_ACQUIRE, "agent");
            asm volatile("s_waitcnt vmcnt(0)" ::: "memory");
        }
    }
    __syncthreads();
}

struct Args { const float* in[19]; float* out; unsigned char* ws; float inv64[32]; float inv32[16]; };
struct Frame {
    unsigned char* lds;
    LAS unsigned char* lds3;
    volatile LAS unsigned* MISC;
    unsigned* ctl;
    unsigned char* ws;
    int tid, lane, wave, G, gw, ngw;
    unsigned long long pt0, pdt;
};
#define PHASE_IDS(F) do { int t_ = threadIdx.x; asm volatile("" : "+v"(t_)); (F).tid = t_; (F).lane = t_ & 63; (F).wave = __builtin_amdgcn_readfirstlane(t_ >> 6); (F).gw = blockIdx.x * NWAVES + (F).wave; } while (0)


__device__ __forceinline__ void transpose_item(const float* W, int K, int N, int srccol  , bf16* WT, int n0, int k0, float* scr, int lane, const float* gain = nullptr  ) {
#pragma unroll
    for (int i = 0; i < 32; ++i) { const int kk = 2 * i + (lane >> 5); scr[kk * 33 + (lane & 31)] = srccol >= 0 ? W[(size_t)(k0 + kk) * N + srccol] * (gain ? gain[k0 + kk] : 1.0f) : 0.f; }
    LDS_WAIT(); asm volatile("" ::: "memory");
    const int c = lane & 7;
#pragma unroll
    for (int j = 0; j < 4; ++j) { const int n = (lane >> 3) + 8 * j; const float* s = scr + (8 * c) * 33 + n;
        v4u o; o.x = pk2(s[0 * 33], s[1 * 33]); o.y = pk2(s[2 * 33], s[3 * 33]); o.z = pk2(s[4 * 33], s[5 * 33]); o.w = pk2(s[6 * 33], s[7 * 33]);
        *(v4u*)(WT + (size_t)(n0 + n) * K + k0 + 8 * c) = o; }
    LDS_WAIT(); asm volatile("" ::: "memory");
}
template <class CMap>
__device__ __forceinline__ void convert_tile(Frame& F, const float* W, int N, int K, int k0, int scol0, bf16* WT, int n0, CMap cmap) {
    bf16* Tl = (bf16*)F.lds;
    const int t = F.tid;
    f32x4 v[8];
#pragma unroll
    for (int i = 0; i < 8; ++i) v[i] = *(const f32x4*)(W + (size_t)(k0 + 16 * i + (t >> 5)) * N + scol0 + (t & 31) * 4);
    __syncthreads();
#pragma unroll
    for (int i = 0; i < 8; ++i) { v2u w; w.x = pk2(v[i].x, v[i].y); w.y = pk2(v[i].z, v[i].w); *(v2u*)(Tl + (16 * i + (t >> 5)) * 136 + (t & 31) * 4) = w; }
    __syncthreads();
    const int n = t >> 2, kq = (t & 3) * 32, sc = cmap(n);
    const bf16* src = Tl + kq * 136 + sc; unsigned wv[16];
#pragma unroll
    for (int j = 0; j < 16; ++j) wv[j] = (unsigned)src[(2 * j) * 136] | ((unsigned)src[(2 * j + 1) * 136] << 16);
    v4u* dst = (v4u*)(WT + (size_t)(n0 + n) * K + k0 + kq);
#pragma unroll
    for (int j = 0; j < 4; ++j) dst[j] = (v4u){wv[4 * j], wv[4 * j + 1], wv[4 * j + 2], wv[4 * j + 3]};
}
__device__ __forceinline__ void convert_weights(Frame& F, const Args& a, int layer) {
    PHASE_IDS(F);
    const float* w_in = a.in[2] + (size_t)layer * DM * DIN; const float* w_out = a.in[13] + (size_t)layer * DM * DM;
    const float* w_gate = a.in[15] + (size_t)layer * DM * DFF; const float* w_up = a.in[16] + (size_t)layer * DM * DFF; const float* w_down = a.in[17] + (size_t)layer * DFF * DM;
    bf16* WIN = (bf16*)(F.ws + WS_WIN); bf16* WOUT = (bf16*)(F.ws + WS_WOUT); bf16* WGU = (bf16*)(F.ws + WS_WGU); bf16* WD = (bf16*)(F.ws + WS_WD);
    constexpr int B_IN = 8 * 23, B_OUT = 8 * 8, B_GU = 8 * 44, B_D = 22 * 8, NB_ITEMS = B_IN + B_OUT + B_GU + B_D;
    for (int it = blockIdx.x; it < NB_ITEMS; it += F.G) {
        int r = it;
        if (r < B_IN) { const int kt = r / 23, nt = r % 23, n0 = nt * 128, shift = n0 < 640 ? 0 : n0 < 1920 ? 12 : 20;
            convert_tile(F, w_in, DIN, DM, kt * 128, n0 + shift, WIN, n0, [=](int n) { return zsrc(n0 + n) - (n0 + shift); }); continue; } r -= B_IN;
        if (r < B_OUT) { const int kt = r >> 3, nt = r & 7; convert_tile(F, w_out, DM, DM, kt * 128, nt * 128, WOUT, nt * 128, [](int n) { return n; }); continue; } r -= B_OUT;
        if (r < B_GU) { const int kt = r / 44, nt = r % 44, n0 = nt * 128, pn = n0 >> 8; convert_tile(F, (n0 & 128) ? w_up : w_gate, DFF, DM, kt * 128, 128 * pn, WGU, n0, [](int n) { return n; }); continue; } r -= B_GU;
        { const int kt = r >> 3, nt = r & 7; convert_tile(F, w_down, DM, DFF, kt * 128, nt * 128, WD, nt * 128, [](int n) { return n; }); }
    }
    __syncthreads();
    float* scr = (float*)(F.lds + 40960 + F.wave * 8704);
    constexpr int I_IN = (DM / 64) * 4, I_C = 2 * (2048 / 64) * (64 / 32), I_CB = 64, NITEMS = I_IN + I_C + I_CB;
    const float* cmp_w = a.in[4] + (size_t)layer * 2 * 2048 * 64; const float* cmp_pos = a.in[3] + (size_t)layer * 2 * 2048; bf16* WCT = (bf16*)(F.ws + WS_WCT); float* CBP = (float*)(F.ws + WS_CBP);
    for (int it = F.gw; it < NITEMS; it += F.ngw) {
        int r = it; const int l31 = F.lane & 31;
        if (r < I_IN) { const int kb = r >> 2, nb = 92 + (r & 3); transpose_item(w_in, DM, DIN, zsrc(nb * 32 + l31), WIN, nb * 32, kb * 64, scr, F.lane); continue; } r -= I_IN;
        if (r < I_C) { const int br = r >> 6, q = r & 63, kb = q >> 1, nb = q & 1; transpose_item(cmp_w + (size_t)br * 2048 * 64, 2048, 64, br == 0 ? pi64(nb * 32 + l31) : nb * 32 + l31, WCT + (size_t)br * 64 * 2048, nb * 32, kb * 64, scr, F.lane); continue; } r -= I_C;
        { const int br = r >> 5, ch = r & 31; float acc = 0.f;
#pragma unroll 8
          for (int k = ch * 64; k < ch * 64 + 64; ++k) acc += cmp_pos[br * 2048 + k] * cmp_w[((size_t)br * 2048 + k) * 64 + F.lane];
          CBP[(br * 32 + ch) * 64 + F.lane] = acc; }
    }
}
__device__ __forceinline__ void sincos_d(float ang, float& c, float& s) {
    const double a = (double)ang; const double q = __builtin_rint(a * 0.63661977236758134308); const double r = a - q * 1.57079632679489661923; const double r2 = r * r;
    double sp = -1.0 / 39916800.0; sp = sp * r2 + 1.0 / 362880.0; sp = sp * r2 - 1.0 / 5040.0; sp = sp * r2 + 1.0 / 120.0; sp = sp * r2 - 1.0 / 6.0; sp = sp * r2 + 1.0; sp *= r;
    double cp = 1.0 / 479001600.0; cp = cp * r2 - 1.0 / 3628800.0; cp = cp * r2 + 1.0 / 40320.0; cp = cp * r2 - 1.0 / 720.0; cp = cp * r2 + 1.0 / 24.0; cp = cp * r2 - 0.5; cp = cp * r2 + 1.0;
    const int n = ((int)q) & 3; const double cc = (n == 0) ? cp : (n == 1) ? -sp : (n == 2) ? -cp : sp; const double ss = (n == 0) ? sp : (n == 1) ? cp : (n == 2) ? -sp : -cp;
    c = (float)cc; s = (float)ss;
}
__device__ __forceinline__ void build_rope(Frame& F, const Args& a) {
    PHASE_IDS(F);
    f32x2* R64 = (f32x2*)(F.ws + WS_ROPE64); f32x2* R32 = (f32x2*)(F.ws + WS_ROPE32);
    const int gt = F.gw * 64 + F.lane, ngt = F.ngw * 64;
    for (int i = gt; i < SEQ * 48; i += ngt) { const int pos = i / 48, j = i % 48; float c, s;
        if (j < 32) { sincos_d((float)pos * a.inv64[j], c, s); R64[pos * 32 + j] = (f32x2){c, s}; }
        else { sincos_d((float)pos * a.inv32[j - 32], c, s); R32[pos * 16 + (j - 32)] = (f32x2){c, s}; } }
}
__device__ __forceinline__ void norm_rows_bf16(Frame& F, const float* X, const float* g, bf16* H) {
    PHASE_IDS(F);
    f32x4 gg[4];
#pragma unroll
    for (int j = 0; j < 4; ++j) gg[j] = ((const f32x4*)g)[64 * j + F.lane];
    for (int row0 = F.gw * 4; row0 < T; row0 += F.ngw * 4) {
        f32x4 v[4][4];
#pragma unroll
        for (int r = 0; r < 4; ++r)
#pragma unroll
            for (int j = 0; j < 4; ++j) v[r][j] = ((const f32x4*)(X + (size_t)(row0 + r) * DM))[64 * j + F.lane];
#pragma unroll
        for (int r = 0; r < 4; ++r) { float q = 0.f;
#pragma unroll
            for (int j = 0; j < 4; ++j) q += (v[r][j].x * v[r][j].x + v[r][j].y * v[r][j].y) + (v[r][j].z * v[r][j].z + v[r][j].w * v[r][j].w);
            const float rr = 1.0f / sqrtf(wave_sum(q) * (1.0f / DM) + EPS); v2u* o = (v2u*)(H + (size_t)(row0 + r) * DM) + F.lane;
#pragma unroll
            for (int j = 0; j < 4; ++j) { v2u w; w.x = pk2(v[r][j].x * rr * gg[j].x, v[r][j].y * rr * gg[j].y); w.y = pk2(v[r][j].z * rr * gg[j].z, v[r][j].w * rr * gg[j].w); o[64 * j] = w; } }
    }
}
__device__ __forceinline__ void final_norm(Frame& F, float* X, const float* g) {
    PHASE_IDS(F);
    f32x4 gg[4];
#pragma unroll
    for (int j = 0; j < 4; ++j) gg[j] = ((const f32x4*)g)[64 * j + F.lane];
    for (int row0 = F.gw * 4; row0 < T; row0 += F.ngw * 4) {
        f32x4 v[4][4];
#pragma unroll
        for (int r = 0; r < 4; ++r)
#pragma unroll
            for (int j = 0; j < 4; ++j) v[r][j] = ((const f32x4*)(X + (size_t)(row0 + r) * DM))[64 * j + F.lane];
#pragma unroll
        for (int r = 0; r < 4; ++r) { float q = 0.f;
#pragma unroll
            for (int j = 0; j < 4; ++j) q += (v[r][j].x * v[r][j].x + v[r][j].y * v[r][j].y) + (v[r][j].z * v[r][j].z + v[r][j].w * v[r][j].w);
            const float rr = 1.0f / sqrtf(wave_sum(q) * (1.0f / DM) + EPS); f32x4* o = (f32x4*)(X + (size_t)(row0 + r) * DM) + F.lane;
#pragma unroll
            for (int j = 0; j < 4; ++j) o[64 * j] = v[r][j] * rr * gg[j]; }
    }
}

__device__ __forceinline__ void prep_compress(Frame& F, const Args& a, int layer) {
    PHASE_IDS(F);
    typedef short bf16x8 __attribute__((ext_vector_type(8)));
    const bf16* Z = (const bf16*)(F.ws + WS_Z); const bf16* WCT = (const bf16*)(F.ws + WS_WCT); const float* CBP = (const float*)(F.ws + WS_CBP);
    f32x4* red = (f32x4*)F.lds;
    const int lane = F.lane, et = F.wave & 3, kh = F.wave >> 2, r16 = lane & 15, q4 = lane >> 4;
    for (int it = blockIdx.x; it < NB * 2 * 16; it += F.G) {
        const int b = it >> 5, br = (it >> 4) & 1, n0 = (it & 15) * 16; const int zc = br ? ZVC : ZKC;
        const bf16* wrow = WCT + ((size_t)br * 64 + et * 16 + r16) * 2048 + 8 * q4;
        const int tb = 16 * (n0 + r16);
        f32x4 acc = {0.f, 0.f, 0.f, 0.f};
#pragma unroll 8
        for (int kk = kh * 32; kk < kh * 32 + 32; ++kk) {
            int tok = tb + (kk >> 1); tok = tok < SEQ ? tok : SEQ - 1;
            const bf16x8 af = *(const bf16x8*)(Z + ((size_t)b * SEQ + tok) * DINP + zc + (kk & 1) * 32 + 8 * q4);
            const bf16x8 bfr = *(const bf16x8*)(wrow + 32 * kk);
            acc = __builtin_amdgcn_mfma_f32_16x16x32_bf16(af, bfr, acc, 0, 0, 0);
        }
        __syncthreads();
        if (kh == 1) red[et * 64 + lane] = acc;
        __syncthreads();
        if (kh == 0) {
            const f32x4 o = red[et * 64 + lane]; const int e = et * 16 + r16; float bias = 0.f;
            const int es = br == 0 ? pi64(e) : e;
#pragma unroll 8
            for (int ch = 0; ch < 32; ++ch) bias += CBP[(br * 32 + ch) * 64 + es];
            bf16* O = (bf16*)(F.ws + (br ? WS_VC : WS_KC)) + (size_t)b * 256 * 64;
#pragma unroll
            for (int r = 0; r < 4; ++r) { const int n = n0 + 4 * q4 + r; O[n * 64 + e] = (bf16)((n < 255) ? f2bf(acc[r] + o[r] + bias) : 0u); }
        }
    }
    __syncthreads();
}
__device__ __forceinline__ float log_sigmoid_(float x) { return x >= 0.f ? -log1pf(__expf(-x)) : x - log1pf(__expf(x)); }
typedef float f32x16m __attribute__((ext_vector_type(16)));
__device__ __forceinline__ void mm64(f32x16m& acc, const float* ap, int as, const float* bp, int bs) {
#pragma unroll 8
    for (int kk = 0; kk < 32; ++kk) acc = __builtin_amdgcn_mfma_f32_32x32x2f32(ap[kk * as], bp[kk * bs], acc, 0, 0, 0);
}
__device__ __forceinline__ int crow32(int r, int hi) { return (r & 3) + 8 * (r >> 2) + 4 * hi; }
__device__ __forceinline__ void prep_mlstm(Frame& F, const Args& a, int layer) {
    PHASE_IDS(F);
    const bf16* Z = (const bf16*)(F.ws + WS_Z);
    float* L = (float*)F.lds; float* UC = L; float* KS = L + 4224; float* VS = L + 8448; float* WQ = L + 12672; float* WK = L + 16896; float* WE = L + 21120;
    const float* convw = a.in[7] + (size_t)layer * 4 * 256; const float* convb = a.in[8] + (size_t)layer * 256;
    const float* gb = a.in[11] + (size_t)layer * 8;
    float* MQ = (float*)(F.ws + WS_MQ); float* MK = (float*)(F.ws + WS_MK); float* CLOC = (float*)(F.ws + WS_CLOC); float* NLOC = (float*)(F.ws + WS_NLOC);
    float* BCUM = (float*)(F.ws + WS_BCUM); float* IG = (float*)(F.ws + WS_IG); float* ACH = (float*)(F.ws + WS_ACH); float* MLOC = (float*)(F.ws + WS_MLOC);
    const int lane = F.lane, r32 = lane & 31, hi = lane >> 5, w = F.wave, tl = F.tid >> 3, c8 = (F.tid & 7) * 8;
    v4u ur[4], vr; float gi = 0.f, gf = 0.f; int ph = -1;
#define PM_LOAD(it_) do { const int bh_ = (it_) >> 6, c_ = (it_) & 63, b_ = bh_ >> 2, h_ = bh_ & 3, t_ = c_ * 64 + tl; const bf16* zb_ = Z + (size_t)b_ * SEQ * DINP; \
        _Pragma("unroll") for (int j = 0; j < 4; ++j) { const int tt_ = t_ - 3 + j; ur[j] = tt_ >= 0 ? *(const v4u*)(zb_ + (size_t)tt_ * DINP + ZCU + h_ * 64 + c8) : (v4u){0u, 0u, 0u, 0u}; } \
        vr = *(const v4u*)(zb_ + (size_t)t_ * DINP + ZCV + h_ * 64 + c8); \
        if (w == 0) { const bf16* zr_ = zb_ + (size_t)(c_ * 64 + lane) * DINP; gi = bf2f(zr_[ZCI + h_]); gf = bf2f(zr_[ZCF + h_]); } } while (0)
    int it = blockIdx.x;
    if (it < 1024) PM_LOAD(it);
    for (; it < 1024; it += F.G) {
        const int bh = it >> 6, c = it & 63, b = bh >> 2, h = bh & 3, t0 = c * 64; const size_t row0 = (size_t)b * SEQ + t0;
        __syncthreads();
        if (h != ph) { const float* wq = a.in[9] + ((size_t)layer * 4 + h) * 4096; const float* wk = a.in[10] + ((size_t)layer * 4 + h) * 4096;
            *(f32x4*)(WQ + F.tid * 8) = *(const f32x4*)(wq + F.tid * 8); *(f32x4*)(WQ + F.tid * 8 + 4) = *(const f32x4*)(wq + F.tid * 8 + 4);
            *(f32x4*)(WK + F.tid * 8) = *(const f32x4*)(wk + F.tid * 8); *(f32x4*)(WK + F.tid * 8 + 4) = *(const f32x4*)(wk + F.tid * 8 + 4); ph = h; }
        { float u[4][8], acc[8], vv[8]; const int ch = h * 64 + c8;
#pragma unroll
          for (int j = 0; j < 4; ++j) { u[j][0] = bflo(ur[j].x); u[j][1] = bfhi(ur[j].x); u[j][2] = bflo(ur[j].y); u[j][3] = bfhi(ur[j].y); u[j][4] = bflo(ur[j].z); u[j][5] = bfhi(ur[j].z); u[j][6] = bflo(ur[j].w); u[j][7] = bfhi(ur[j].w); }
          vv[0] = bflo(vr.x); vv[1] = bfhi(vr.x); vv[2] = bflo(vr.y); vv[3] = bfhi(vr.y); vv[4] = bflo(vr.z); vv[5] = bfhi(vr.z); vv[6] = bflo(vr.w); vv[7] = bfhi(vr.w);
#pragma unroll
          for (int i = 0; i < 8; ++i) acc[i] = convb[ch + i];
#pragma unroll
          for (int j = 0; j < 4; ++j)
#pragma unroll
              for (int i = 0; i < 8; ++i) acc[i] += convw[j * 256 + ch + i] * u[j][i];
#pragma unroll
          for (int i = 0; i < 8; ++i) { UC[tl * 65 + c8 + i] = acc[i] * sigmoidf_(acc[i]); VS[tl * 64 + c8 + i] = vv[i]; } }
        if (w == 0) { const int l = lane; const size_t row = row0 + l;
            const float ig = gi + gb[h]; float bc = log_sigmoid_(gf + gb[4 + h]);
#pragma unroll
            for (int o = 1; o < 64; o <<= 1) { const float v = lane_get(bc, l - o); if (l >= o) bc += v; }
            const float ach = lane_get(bc, 63); const float ge = ach - bc + ig; const float ml = wave_max(ge);
            WE[l] = __expf(ge - ml); BCUM[row * 4 + h] = bc; IG[row * 4 + h] = ig; if (l == 0) { ACH[it] = ach; MLOC[it] = ml; } }
        if (it + F.G < 1024) PM_LOAD(it + F.G);
        __syncthreads();
        { const int i0 = ((w >> 1) & 1) * 32, j0 = (w & 1) * 32; f32x16m acc;
#pragma unroll
            for (int r = 0; r < 16; ++r) acc[r] = 0.f;
            mm64(acc, UC + (i0 + r32) * 65 + hi, 2, (w < 4 ? WQ : WK) + hi * 64 + j0 + r32, 128);
            float* G = (w < 4 ? MQ : MK) + row0 * 256 + h * 64 + j0 + r32;
            if (w < 4) {
#pragma unroll
                for (int r = 0; r < 16; ++r) G[(size_t)(i0 + crow32(r, hi)) * 256] = acc[r];
            } else {
#pragma unroll
                for (int r = 0; r < 16; ++r) { const float v = acc[r] * 0.125f; const int l = i0 + crow32(r, hi); G[(size_t)l * 256] = v; KS[l * 64 + j0 + r32] = v; }
            } }
        __syncthreads();
        if (w < 4) { const int i0 = (w >> 1) * 32, j0 = (w & 1) * 32; f32x16m acc;
#pragma unroll
            for (int r = 0; r < 16; ++r) acc[r] = 0.f;
#pragma unroll 8
            for (int kk = 0; kk < 32; ++kk) { const int l = 2 * kk + hi; acc = __builtin_amdgcn_mfma_f32_32x32x2f32(VS[l * 64 + i0 + r32] * WE[l], KS[l * 64 + j0 + r32], acc, 0, 0, 0); }
            float* G = CLOC + (size_t)it * 4096 + j0 + r32;
#pragma unroll
            for (int r = 0; r < 16; ++r) G[(i0 + crow32(r, hi)) * 64] = acc[r];
        } else if (w == 4) { float n = 0.f;
#pragma unroll 8
            for (int l = 0; l < 64; ++l) n += WE[l] * KS[l * 64 + lane];
            NLOC[it * 64 + lane] = n; }
    }
#undef PM_LOAD
    __syncthreads();
}

__device__ __forceinline__ void ld8(const bf16* p, float* o) { const v4u w = *(const v4u*)p; o[0] = bflo(w.x); o[1] = bfhi(w.x); o[2] = bflo(w.y); o[3] = bfhi(w.y); o[4] = bflo(w.z); o[5] = bfhi(w.z); o[6] = bflo(w.w); o[7] = bfhi(w.w); }
__device__ __forceinline__ void ph_mlstm_out(Frame& F, const Args& a, int layer) {
    PHASE_IDS(F);
    const bf16* Z = (const bf16*)(F.ws + WS_Z); bf16* AO = (bf16*)(F.ws + WS_H);
    const float* MQ = (const float*)(F.ws + WS_MQ); const float* MK = (const float*)(F.ws + WS_MK); const float* CIN = (const float*)(F.ws + WS_CLOC); const float* NIN = (const float*)(F.ws + WS_NLOC);
    const float* BCUM = (const float*)(F.ws + WS_BCUM); const float* IG = (const float*)(F.ws + WS_IG); const float* MIN = (const float*)(F.ws + WS_MIN);
    const float* hg = a.in[12] + (size_t)layer * 256;
    float* L = (float*)F.lds; float* QS = L; float* KS = L + 4224; float* CS = L + 8448; float* SS = L + 12672; float* HS = L + 16896; float* VS = L + 21120;
    float* NI = L + 25344; float* BC = NI + 64; float* IGS = BC + 64; float* MT = IGS + 64; float* EI = MT + 64; float* DEN = EI + 64;
    const int lane = F.lane, r32 = lane & 31, hi = lane >> 5, w = F.wave;
    const int tl = F.tid >> 3, c8 = (F.tid & 7) * 8;
    f32x4 qr[2], kr[2], cr[2]; v4u vr; float gbc = 0.f, gig = 0.f, gmi = 0.f, gni = 0.f;
#define MO_LOAD(it_) do { const int bh_ = (it_) >> 6, c_ = (it_) & 63, b_ = bh_ >> 2, h_ = bh_ & 3; const size_t r_ = (size_t)b_ * SEQ + c_ * 64 + tl; \
        const f32x4* q_ = (const f32x4*)(MQ + r_ * 256 + h_ * 64 + c8); const f32x4* k_ = (const f32x4*)(MK + r_ * 256 + h_ * 64 + c8); const f32x4* c_p = (const f32x4*)(CIN + (size_t)(it_) * 4096 + tl * 64 + c8); \
        qr[0] = q_[0]; qr[1] = q_[1]; kr[0] = k_[0]; kr[1] = k_[1]; cr[0] = c_p[0]; cr[1] = c_p[1]; vr = *(const v4u*)(Z + r_ * DINP + ZCV + h_ * 64 + c8); \
        if (w == 0) { const size_t rl_ = (size_t)b_ * SEQ + c_ * 64 + lane; gbc = BCUM[rl_ * 4 + h_]; gig = IG[rl_ * 4 + h_]; gmi = MIN[(it_)]; gni = NIN[(it_) * 64 + lane]; } } while (0)
    int it = blockIdx.x;
    if (it < 1024) MO_LOAD(it);
    for (; it < 1024; it += F.G) {
        const int bh = it >> 6, c = it & 63, b = bh >> 2, h = bh & 3; const size_t row0 = (size_t)b * SEQ + c * 64;
        __syncthreads();
        { float* q_ = QS + tl * 65 + c8; float* k_ = KS + tl * 65 + c8; float* c_ = CS + tl * 65 + c8; float* v_ = VS + tl * 64 + c8;
#pragma unroll
          for (int i = 0; i < 4; ++i) { q_[i] = qr[0][i]; q_[4 + i] = qr[1][i]; k_[i] = kr[0][i]; k_[4 + i] = kr[1][i]; c_[i] = cr[0][i]; c_[4 + i] = cr[1][i]; }
          v_[0] = bflo(vr.x); v_[1] = bfhi(vr.x); v_[2] = bflo(vr.y); v_[3] = bfhi(vr.y); v_[4] = bflo(vr.z); v_[5] = bfhi(vr.z); v_[6] = bflo(vr.w); v_[7] = bfhi(vr.w); }
        if (w == 0) { const int l = lane; const float bc = gbc, ig = gig, mi = gmi;
            NI[l] = gni; BC[l] = bc; IGS[l] = ig;
            float pm = ig - bc;
#pragma unroll
            for (int o = 1; o < 64; o <<= 1) { const float v = lane_get(pm, l - o); if (l >= o) pm = fmaxf(pm, v); }
            const float inter = bc + mi, mt = fmaxf(inter, bc + pm); MT[l] = mt; EI[l] = __expf(inter - mt); }
        if (it + F.G < 1024) MO_LOAD(it + F.G);
        __syncthreads();
        const int i0 = ((w >> 1) & 1) * 32, j0 = (w & 1) * 32; f32x16m acc;
#pragma unroll
        for (int r = 0; r < 16; ++r) acc[r] = 0.f;
        if (w < 4) {
            if (!(i0 == 0 && j0 == 32)) mm64(acc, QS + (i0 + r32) * 65 + hi, 2, KS + (j0 + r32) * 65 + hi, 2);
            const int s_ = j0 + r32; const float bs = IGS[s_] - BC[s_];
#pragma unroll
            for (int r = 0; r < 16; ++r) { const int t = i0 + crow32(r, hi); SS[t * 65 + s_] = (s_ <= t) ? acc[r] * __expf(BC[t] + bs - MT[t]) : 0.f; }
        } else {
            mm64(acc, QS + (i0 + r32) * 65 + hi, 2, CS + (j0 + r32) * 65 + hi, 2);
#pragma unroll
            for (int r = 0; r < 16; ++r) acc[r] *= EI[i0 + crow32(r, hi)];
        }
        __syncthreads();
        if (w >= 4) {
            mm64(acc, SS + (i0 + r32) * 65 + hi, 2, VS + hi * 64 + j0 + r32, 128);
#pragma unroll
            for (int r = 0; r < 16; ++r) HS[(i0 + crow32(r, hi)) * 65 + j0 + r32] = acc[r];
        } else if (w == 0) { const int t = lane; float nq = 0.f, ssum = 0.f;
#pragma unroll 8
            for (int k = 0; k < 64; ++k) { nq += NI[k] * QS[t * 65 + k]; ssum += SS[t * 65 + k]; }
            const float den = EI[t] * nq + ssum; DEN[t] = 1.0f / fmaxf(fabsf(den), __expf(-MT[t])); }
        __syncthreads();
        { const int t = F.tid >> 3, vg = (F.tid & 7) * 8; const float rd = DEN[t]; float num[8]; float sq = 0.f;
#pragma unroll
            for (int i = 0; i < 8; ++i) { num[i] = HS[t * 65 + vg + i] * rd; sq += num[i] * num[i]; }
            sq += sx<1>(sq); sq += sx<2>(sq); sq += sx<4>(sq);
            const float rn = 1.0f / sqrtf(sq * (1.0f / 64.0f) + EPS); const size_t row = row0 + t;
            float zo[8]; ld8(Z + row * DINP + ZCO + h * 64 + vg, zo);
            unsigned wv[4];
#pragma unroll
            for (int i = 0; i < 8; i += 2) { const int ch = h * 64 + vg + i; wv[i >> 1] = pk2(num[i] * rn * hg[ch] * sigmoidf_(zo[i]), num[i + 1] * rn * hg[ch + 1] * sigmoidf_(zo[i + 1])); }
            *(v4u*)(AO + row * DM + 512 + h * 64 + vg) = (v4u){wv[0], wv[1], wv[2], wv[3]}; }
    }
#undef MO_LOAD
    __syncthreads();
}

namespace fa {
typedef short bf16x8 __attribute__((ext_vector_type(8)));
typedef float f32x16 __attribute__((ext_vector_type(16)));
typedef short s16x4 __attribute__((ext_vector_type(4)));
typedef __bf16 bf16x2_t __attribute__((ext_vector_type(2)));
constexpr int KP = 144, VP = 192, KT = 64 * KP, VT = 64 * VP, BUF = KT + VT, LDS_NEED = 2 * BUF;
constexpr float LOG2E = 1.4426950408889634f, LN2 = 0.6931471805599453f;
__device__ __forceinline__ int crow(int r, int hi) { return (r & 3) + 8 * (r >> 2) + 4 * hi; }
__device__ __forceinline__ unsigned cvtpk(float lo, float hi) { f32x2 v = {lo, hi}; bf16x2_t b = __builtin_convertvector(v, bf16x2_t); return __builtin_bit_cast(unsigned, b); }
__device__ __forceinline__ s16x4 vtr(LAS unsigned char* p) { return __builtin_bit_cast(s16x4, __builtin_amdgcn_ds_read_tr16_b64_v4i16((LAS s16x4*)p)); }
__device__ __forceinline__ void load_qf(const bf16* qrow, int hi, bf16x8 (&qf)[4]) {
#pragma unroll
    for (int ks = 0; ks < 4; ++ks) qf[ks] = *(const bf16x8*)(qrow + 16 * ks + 8 * hi);
}
template <int KS0, int KS, class P, int MODE = 0>
__device__ __forceinline__ void stream(const P& p, LAS unsigned char* lds, int tid, float sc, const bf16x8 (&qf)[4], float& m_, float& l_, f32x16 (&O_)[2]) {
    float m = m_, l = l_; f32x16 O[2] = {O_[0], O_[1]};
    const int lane = tid & 63, r32 = lane & 31, hi = lane >> 5, g = lane >> 4, i16 = lane & 15;
    const int srow = tid >> 3, scx = tid & 7;
    const int koff = r32 * KP + hi * 16;
    const int voff = KT + ((i16 >> 2) + 4 * hi) * VP + (16 * (g & 1) + 4 * (i16 & 3)) * 2;
    const int nt = p.ntiles();
    v4u kr, vr;
#define FA_LOAD(it_) do { const bf16* kp_ = p.krow((it_), srow); const bf16* vp_ = p.vrow((it_), srow); kr = *(const v4u*)(kp_ + 8 * scx); vr = *(const v4u*)(vp_ + 8 * scx); } while (0)
#define FA_STORE(boff_) do { *(LAS v4u*)(lds + (boff_) + srow * KP + scx * 16) = kr; *(LAS v4u*)(lds + (boff_) + KT + srow * VP + scx * 16) = vr; } while (0)
    __syncthreads();
    if (nt > 0) { FA_LOAD(0); FA_STORE(0); if (nt > 1) FA_LOAD(1); }
    __syncthreads();
#pragma unroll 1
    for (int it = 0; it < nt; ++it) {
        const int bc = (it & 1) * BUF;
        if (!p.wave_skip(it)) {
            f32x16 S[2];
            { bf16x8 kf[2][KS];
#pragma unroll
              for (int st = 0; st < 2; ++st)
#pragma unroll
                  for (int k = 0; k < KS; ++k) kf[st][k] = *(LAS bf16x8*)(lds + bc + koff + st * 32 * KP + (KS0 + k) * 32);
#pragma unroll
              for (int st = 0; st < 2; ++st) {
#pragma unroll
                  for (int r = 0; r < 16; ++r) S[st][r] = 0.f;
#pragma unroll
                  for (int k = 0; k < KS; ++k) S[st] = __builtin_amdgcn_mfma_f32_32x32x16_bf16(kf[st][k], qf[KS0 + k], S[st], 0, 0, 0); } }
            s16x4 vv[2][2][2][2];
            if constexpr (MODE == 0) {
#pragma unroll
                for (int st = 0; st < 2; ++st)
#pragma unroll
                    for (int s = 0; s < 2; ++s)
#pragma unroll
                        for (int dt = 0; dt < 2; ++dt) { LAS unsigned char* vp = lds + bc + voff + (32 * st + 16 * s) * VP + dt * 64; vv[st][s][dt][0] = vtr(vp); vv[st][s][dt][1] = vtr(vp + 8 * VP); }
            }
            const int mm = p.mask_mode(it);
            if (mm) {
                int lb, ub; p.bounds(it, lb, ub); lb -= 4 * hi; ub -= 4 * hi;
                if (mm == 1) {
#pragma unroll
                    for (int st = 0; st < 2; ++st)
#pragma unroll
                        for (int r = 0; r < 16; ++r) { const int cc = 32 * st + (r & 3) + 8 * (r >> 2); if (cc > ub) S[st][r] = -INFINITY; }
                } else if (mm == 2) {
#pragma unroll
                    for (int st = 0; st < 2; ++st)
#pragma unroll
                        for (int r = 0; r < 16; ++r) { const int cc = 32 * st + (r & 3) + 8 * (r >> 2); if (cc < lb) S[st][r] = -INFINITY; }
                } else {
#pragma unroll
                    for (int st = 0; st < 2; ++st)
#pragma unroll
                        for (int r = 0; r < 16; ++r) { const int cc = 32 * st + (r & 3) + 8 * (r >> 2); if (cc < lb || cc > ub) S[st][r] = -INFINITY; }
                }
            }
            const bool keep = p.lane_keep(it);
            if constexpr (MODE == 1) {
                const float ms = (m == -INFINITY) ? 0.f : m; const float il = l > 0.f ? 1.0f / l : 0.f;
#pragma unroll
                for (int st = 0; st < 2; ++st)
#pragma unroll
                    for (int rg = 0; rg < 4; ++rg) {
                        const float p0 = __builtin_amdgcn_exp2f(__builtin_fmaf(S[st][4 * rg], sc, -ms)) * il, p1 = __builtin_amdgcn_exp2f(__builtin_fmaf(S[st][4 * rg + 1], sc, -ms)) * il;
                        const float p2 = __builtin_amdgcn_exp2f(__builtin_fmaf(S[st][4 * rg + 2], sc, -ms)) * il, p3 = __builtin_amdgcn_exp2f(__builtin_fmaf(S[st][4 * rg + 3], sc, -ms)) * il;
                        float qa = p0, qb = p0 + 2.0f * (p1 + p2 + p3);
                        qa += sx<1>(qa); qa += sx<2>(qa); qb += sx<1>(qb); qb += sx<2>(qb);
                        const int jp = 8 * (2 * it + st) + 2 * rg + hi;
                        if ((r32 & 3) == 0) { p.impA[p.tokl * 65 + jp] = qa; if (jp < 63) p.impB[p.tokl * 65 + jp + 1] = qb; }
                    }
            } else {
                float tm = S[0][0];
#pragma unroll
                for (int r = 1; r < 16; ++r) tm = fmaxf(tm, S[0][r]);
#pragma unroll
                for (int r = 0; r < 16; ++r) tm = fmaxf(tm, S[1][r]);
                tm = max32(tm); if (!keep) tm = -INFINITY;
                const float mn = fmaxf(m, tm * sc), ms0 = (mn == -INFINITY) ? 0.f : mn;
                const float alpha = __builtin_amdgcn_exp2f(m - ms0); const float ms = keep ? ms0 : INFINITY;
                m = mn;
                float ps0 = 0.f, ps1 = 0.f; const float nms = -ms;
#pragma unroll
                for (int st = 0; st < 2; ++st)
#pragma unroll
                    for (int r = 0; r < 16; ++r) { const float e = __builtin_amdgcn_exp2f(__builtin_fmaf(S[st][r], sc, nms)); S[st][r] = e; if (st) ps1 += e; else ps0 += e; }
                l = l * alpha + (ps0 + ps1);
                if (__any(alpha != 1.0f)) {
#pragma unroll
                    for (int dt = 0; dt < 2; ++dt)
#pragma unroll
                        for (int r = 0; r < 16; ++r) O[dt][r] *= alpha;
                }
#pragma unroll
                for (int st = 0; st < 2; ++st)
#pragma unroll
                    for (int s = 0; s < 2; ++s) {
                        v4u pw; pw.x = cvtpk(S[st][8 * s], S[st][8 * s + 1]); pw.y = cvtpk(S[st][8 * s + 2], S[st][8 * s + 3]); pw.z = cvtpk(S[st][8 * s + 4], S[st][8 * s + 5]); pw.w = cvtpk(S[st][8 * s + 6], S[st][8 * s + 7]);
                        const bf16x8 pf = __builtin_bit_cast(bf16x8, pw);
#pragma unroll
                        for (int dt = 0; dt < 2; ++dt) {
                            const s16x4 v0 = vv[st][s][dt][0], v1 = vv[st][s][dt][1];
                            const bf16x8 vf = __builtin_shufflevector(v0, v1, 0, 1, 2, 3, 4, 5, 6, 7);
                            O[dt] = __builtin_amdgcn_mfma_f32_32x32x16_bf16(vf, pf, O[dt], 0, 0, 0);
                        }
                    }
            }
        }
        if (it + 1 < nt) { FA_STORE(((it + 1) & 1) * BUF); if (it + 2 < nt) FA_LOAD(it + 2); }
        __syncthreads();
    }
#undef FA_LOAD
#undef FA_STORE
    m_ = m; l_ = l; O_[0] = O[0]; O_[1] = O[1];
}
template <class P>
__device__ __forceinline__ void stream2(const P& p, LAS unsigned char* lds, int tid, float sc, const bf16x8 (&qf)[4], float (&m)[2], float (&l)[2], f32x16 (&O)[2][2]) {
    const int lane = tid & 63, r32 = lane & 31, hi = lane >> 5, g = lane >> 4, i16 = lane & 15;
    const int srow = tid >> 3, scx = tid & 7;
    const int koff = r32 * KP + hi * 16;
    const int voff = KT + ((i16 >> 2) + 4 * hi) * VP + (16 * (g & 1) + 4 * (i16 & 3)) * 2;
    const int nt = p.ntiles();
    v4u kr, vr;
#define FA_LOAD(it_) do { const bf16* kp_ = p.krow((it_), srow); const bf16* vp_ = p.vrow((it_), srow); kr = *(const v4u*)(kp_ + 8 * scx); vr = *(const v4u*)(vp_ + 8 * scx); } while (0)
#define FA_STORE(boff_) do { *(LAS v4u*)(lds + (boff_) + srow * KP + scx * 16) = kr; *(LAS v4u*)(lds + (boff_) + KT + srow * VP + scx * 16) = vr; } while (0)
    __syncthreads();
    if (nt > 0) { FA_LOAD(0); FA_STORE(0); if (nt > 1) FA_LOAD(1); }
    __syncthreads();
#pragma unroll 1
    for (int it = 0; it < nt; ++it) {
        const int bc = (it & 1) * BUF;
        if (!p.wave_skip(it)) {
            s16x4 vv[2][2][2][2];
#pragma unroll
            for (int st = 0; st < 2; ++st)
#pragma unroll
                for (int s = 0; s < 2; ++s)
#pragma unroll
                    for (int dt = 0; dt < 2; ++dt) { LAS unsigned char* vp = lds + bc + voff + (32 * st + 16 * s) * VP + dt * 64; vv[st][s][dt][0] = vtr(vp); vv[st][s][dt][1] = vtr(vp + 8 * VP); }
            const int mm = p.mask_mode(it); int lb, ub; p.bounds(it, lb, ub); ub -= 4 * hi;
#pragma unroll
            for (int c = 0; c < 2; ++c) {
                f32x16 S[2];
                { bf16x8 kf[2][2];
#pragma unroll
                  for (int st = 0; st < 2; ++st)
#pragma unroll
                      for (int k = 0; k < 2; ++k) kf[st][k] = *(LAS bf16x8*)(lds + bc + koff + st * 32 * KP + (2 * c + k) * 32);
#pragma unroll
                  for (int st = 0; st < 2; ++st) {
#pragma unroll
                      for (int r = 0; r < 16; ++r) S[st][r] = 0.f;
#pragma unroll
                      for (int k = 0; k < 2; ++k) S[st] = __builtin_amdgcn_mfma_f32_32x32x16_bf16(kf[st][k], qf[2 * c + k], S[st], 0, 0, 0); } }
                if (mm) {
#pragma unroll
                    for (int st = 0; st < 2; ++st)
#pragma unroll
                        for (int r = 0; r < 16; ++r) { const int cc = 32 * st + (r & 3) + 8 * (r >> 2); if (cc > ub) S[st][r] = -INFINITY; }
                }
                float tm = S[0][0];
#pragma unroll
                for (int r = 1; r < 16; ++r) tm = fmaxf(tm, S[0][r]);
#pragma unroll
                for (int r = 0; r < 16; ++r) tm = fmaxf(tm, S[1][r]);
                tm = max32(tm);
                const float mn = fmaxf(m[c], tm * sc), ms = (mn == -INFINITY) ? 0.f : mn;
                const float alpha = __builtin_amdgcn_exp2f(m[c] - ms);
                m[c] = mn;
                float ps0 = 0.f, ps1 = 0.f; const float nms = -ms;
#pragma unroll
                for (int st = 0; st < 2; ++st)
#pragma unroll
                    for (int r = 0; r < 16; ++r) { const float e = __builtin_amdgcn_exp2f(__builtin_fmaf(S[st][r], sc, nms)); S[st][r] = e; if (st) ps1 += e; else ps0 += e; }
                l[c] = l[c] * alpha + (ps0 + ps1);
                if (__any(alpha != 1.0f)) {
#pragma unroll
                    for (int dt = 0; dt < 2; ++dt)
#pragma unroll
                        for (int r = 0; r < 16; ++r) O[c][dt][r] *= alpha;
                }
#pragma unroll
                for (int st = 0; st < 2; ++st)
#pragma unroll
                    for (int s = 0; s < 2; ++s) {
                        v4u pw; pw.x = cvtpk(S[st][8 * s], S[st][8 * s + 1]); pw.y = cvtpk(S[st][8 * s + 2], S[st][8 * s + 3]); pw.z = cvtpk(S[st][8 * s + 4], S[st][8 * s + 5]); pw.w = cvtpk(S[st][8 * s + 6], S[st][8 * s + 7]);
                        const bf16x8 pf = __builtin_bit_cast(bf16x8, pw);
#pragma unroll
                        for (int dt = 0; dt < 2; ++dt) {
                            const s16x4 v0 = vv[st][s][dt][0], v1 = vv[st][s][dt][1];
                            const bf16x8 vf = __builtin_shufflevector(v0, v1, 0, 1, 2, 3, 4, 5, 6, 7);
                            O[c][dt] = __builtin_amdgcn_mfma_f32_32x32x16_bf16(vf, pf, O[c][dt], 0, 0, 0);
                        }
                    }
                __builtin_amdgcn_sched_barrier(0);
            }
        }
        if (it + 1 < nt) { FA_STORE(((it + 1) & 1) * BUF); if (it + 2 < nt) FA_LOAD(it + 2); }
        __syncthreads();
    }
#undef FA_LOAD
#undef FA_STORE
}
__device__ __forceinline__ float finish(float l, f32x16 (&O)[2]) {
    const float lt = sum32(l); const float inv = lt > 0.f ? 1.0f / lt : 0.f;
#pragma unroll
    for (int dt = 0; dt < 2; ++dt)
#pragma unroll
        for (int r = 0; r < 16; ++r) O[dt][r] *= inv;
    return lt;
}
__device__ __forceinline__ void store_o(const f32x16 (&O)[2], bf16* out, int hi) {
#pragma unroll
    for (int dt = 0; dt < 2; ++dt)
#pragma unroll
        for (int rg = 0; rg < 4; ++rg) { v2u w; w.x = cvtpk(O[dt][4 * rg], O[dt][4 * rg + 1]); w.y = cvtpk(O[dt][4 * rg + 2], O[dt][4 * rg + 3]); *(v2u*)(out + 32 * dt + 8 * rg + 4 * hi) = w; }
}
}

struct DiffPol {
    const bf16* Zb; int h, t0, wq0, tq;
    __device__ __forceinline__ int ntiles() const { return (t0 + 256) >> 6; }
    __device__ __forceinline__ const bf16* krow(int it, int r) const { return Zb + (size_t)(64 * it + r) * DINP + ZBK + 64 * h; }
    __device__ __forceinline__ const bf16* vrow(int it, int r) const { return Zb + (size_t)(64 * it + r) * DINP + ZBV + 64 * h; }
    __device__ __forceinline__ bool wave_skip(int it) const { return 64 * it > wq0 + 31; }
    __device__ __forceinline__ int mask_mode(int it) const { return 64 * it + 63 > wq0 ? 1 : 0; }
    __device__ __forceinline__ bool lane_keep(int) const { return true; }
    __device__ __forceinline__ void bounds(int it, int& lb, int& ub) const { lb = 0; ub = tq - 64 * it; }
};
__device__ __forceinline__ void diff_item(Frame& F, const Args& a, int layer, int b, int h, int qb, float lam) {
    PHASE_IDS(F);
    const bf16* Z = (const bf16*)(F.ws + WS_Z); bf16* AO = (bf16*)(F.ws + WS_H);
    const int lane = F.lane, r32 = lane & 31, hi = lane >> 5;
    DiffPol p; p.Zb = Z + (size_t)b * SEQ * DINP; p.h = h; p.t0 = 256 * qb; p.wq0 = p.t0 + 32 * F.wave; p.tq = p.wq0 + r32;
    fa::bf16x8 qf[4]; fa::load_qf(p.Zb + (size_t)p.tq * DINP + ZBQ + 64 * h, hi, qf);
    fa::f32x16 O[2][2];
#pragma unroll
    for (int c = 0; c < 2; ++c)
#pragma unroll
        for (int dt = 0; dt < 2; ++dt)
#pragma unroll
            for (int r = 0; r < 16; ++r) O[c][dt][r] = 0.f;
    { float m[2] = {-INFINITY, -INFINITY}, l[2] = {0.f, 0.f}; fa::stream2<DiffPol>(p, F.lds3, F.tid, 0.17677669529663687f * fa::LOG2E, qf, m, l, O); fa::finish(l[0], O[0]); fa::finish(l[1], O[1]); }
    const float lam_init = 0.8f - 0.6f * expf(-0.3f * (float)layer);
    const float* sg = a.in[6] + (size_t)layer * 64;
    float ss = 0.f;
#pragma unroll
    for (int dt = 0; dt < 2; ++dt)
#pragma unroll
        for (int r = 0; r < 16; ++r) { const float v = O[0][dt][r] - lam * O[1][dt][r]; O[0][dt][r] = v; ss += v * v; }
    ss = sum32(ss);
    const float rn = (1.0f / sqrtf(ss * (1.0f / 64.0f) + EPS)) * (1.0f - lam_init);
#pragma unroll
    for (int dt = 0; dt < 2; ++dt)
#pragma unroll
        for (int r = 0; r < 16; ++r) O[0][dt][r] *= rn * sg[32 * dt + fa::crow(r, hi)];
    fa::store_o(O[0], AO + ((size_t)b * SEQ + p.tq) * DM + 256 + 64 * h, hi);
}
struct DilPol {
    const bf16* Zb; int h, dil, res, it0, nt, wi0, iq;
    __device__ __forceinline__ int ntiles() const { return nt; }
    __device__ __forceinline__ const bf16* krow(int it, int r) const { const int ik = 64 * (it0 + it) + r; return Zb + (size_t)(res + dil * ik) * DINP + ZDK + 64 * h; }
    __device__ __forceinline__ const bf16* vrow(int it, int r) const { const int ik = 64 * (it0 + it) + r; return Zb + (size_t)(res + dil * ik) * DINP + ZDV + 64 * h; }
    __device__ __forceinline__ bool wave_skip(int it) const { const int k0 = 64 * (it0 + it); return k0 > wi0 + 31 || k0 + 63 < wi0 - 128; }
    __device__ __forceinline__ int mask_mode(int it) const { const int k0 = 64 * (it0 + it); return (k0 + 63 > wi0 ? 1 : 0) | (k0 < wi0 + 31 - 128 ? 2 : 0); }
    __device__ __forceinline__ bool lane_keep(int) const { return true; }
    __device__ __forceinline__ void bounds(int it, int& lb, int& ub) const { ub = iq - 64 * (it0 + it); lb = ub - 128; }
};
__device__ __forceinline__ void dil_item(Frame& F, int b, int h, int g, int res, int blk) {
    PHASE_IDS(F);
    const bf16* Z = (const bf16*)(F.ws + WS_Z); bf16* DP = (bf16*)(F.ws + WS_DPART); float* DL = (float*)(F.ws + WS_DLSE);
    const int lane = F.lane, r32 = lane & 31, hi = lane >> 5;
    DilPol p; p.Zb = Z + (size_t)b * SEQ * DINP; p.h = h; p.dil = (g == 0) ? 1 : (g == 1) ? 4 : 16; p.res = res;
    const int i0 = 256 * blk; const int t_lo = (i0 >> 6) - 2; p.it0 = t_lo < 0 ? 0 : t_lo; p.nt = (i0 >> 6) + 4 - p.it0;
    p.wi0 = i0 + 32 * F.wave; p.iq = p.wi0 + r32;
    const int tq = res + p.dil * p.iq; const size_t row = (size_t)b * SEQ + tq;
    fa::bf16x8 qf[4]; fa::load_qf(p.Zb + (size_t)tq * DINP + ZDQ + 64 * h, hi, qf);
    float m = -INFINITY, l = 0.f; fa::f32x16 O[2];
#pragma unroll
    for (int dt = 0; dt < 2; ++dt)
#pragma unroll
        for (int r = 0; r < 16; ++r) O[dt][r] = 0.f;
    fa::stream<0, 4, DilPol>(p, F.lds3, F.tid, 0.125f * fa::LOG2E, qf, m, l, O);
    const float lt = fa::finish(l, O);
    fa::store_o(O, DP + ((size_t)g * T + row) * 256 + 64 * h, hi);
    if (hi == 0) DL[((size_t)g * T + row) * 4 + h] = (m + __log2f(lt)) * fa::LN2;
}
__device__ __forceinline__ void dil_combine(Frame& F) {
    PHASE_IDS(F);
    const bf16* DP = (const bf16*)(F.ws + WS_DPART); const float* DL = (const float*)(F.ws + WS_DLSE); bf16* AO = (bf16*)(F.ws + WS_H);
    const int gt = F.gw * 64 + F.lane, ngt = F.ngw * 64;
    for (int i = gt; i < T * 32; i += ngt) { const int row = i >> 5, c8 = (i & 31) * 8, h = c8 >> 6;
        const float l0 = DL[(size_t)row * 4 + h], l1 = DL[((size_t)T + row) * 4 + h], l2 = DL[((size_t)2 * T + row) * 4 + h];
        const float mx = fmaxf(l0, fmaxf(l1, l2)); float w0 = __expf(l0 - mx), w1 = __expf(l1 - mx), w2 = __expf(l2 - mx); const float inv = 1.0f / (w0 + w1 + w2); w0 *= inv; w1 *= inv; w2 *= inv;
        float x0[8], x1[8], x2[8]; ld8(DP + (size_t)row * 256 + c8, x0); ld8(DP + ((size_t)T + row) * 256 + c8, x1); ld8(DP + ((size_t)2 * T + row) * 256 + c8, x2);
        v4u o; o.x = pk2(w0 * x0[0] + w1 * x1[0] + w2 * x2[0], w0 * x0[1] + w1 * x1[1] + w2 * x2[1]); o.y = pk2(w0 * x0[2] + w1 * x1[2] + w2 * x2[2], w0 * x0[3] + w1 * x1[3] + w2 * x2[3]);
        o.z = pk2(w0 * x0[4] + w1 * x1[4] + w2 * x2[4], w0 * x0[5] + w1 * x1[5] + w2 * x2[5]); o.w = pk2(w0 * x0[6] + w1 * x1[6] + w2 * x2[6], w0 * x0[7] + w1 * x1[7] + w2 * x2[7]);
        *(v4u*)(AO + (size_t)row * DM + 768 + c8) = o; }
}
struct CmpPol {
    const bf16* KCb; const bf16* VCb; int nt, ubg; float* impA; float* impB; int tokl; bool nov;
    __device__ __forceinline__ int ntiles() const { return nt; }
    __device__ __forceinline__ const bf16* krow(int it, int r) const { return KCb + (size_t)(64 * it + r) * 64; }
    __device__ __forceinline__ const bf16* vrow(int it, int r) const { return VCb + (size_t)(64 * it + r) * 64; }
    __device__ __forceinline__ bool wave_skip(int) const { return false; }
    __device__ __forceinline__ int mask_mode(int) const { return 1; }
    __device__ __forceinline__ bool lane_keep(int) const { return true; }
    __device__ __forceinline__ void bounds(int it, int& lb, int& ub) const { lb = 0; ub = ubg - 64 * it; }
};
struct SlcPol {
    const bf16* Zb; const unsigned char* list; int nt, t, cblk; unsigned wlo, whi, mlo, mhi;
    __device__ __forceinline__ int ntiles() const { return nt; }
    __device__ __forceinline__ const bf16* krow(int it, int r) const { const int j = list[it]; return Zb + (size_t)(64 * j + r) * DINP + ZKS; }
    __device__ __forceinline__ const bf16* vrow(int it, int r) const { const int j = list[it]; return Zb + (size_t)(64 * j + r) * DINP + ZVS; }
    __device__ __forceinline__ bool wave_skip(int it) const { const int j = list[it]; return !(((j < 32) ? (wlo >> j) : (whi >> (j - 32))) & 1u); }
    __device__ __forceinline__ int mask_mode(int it) const { return (int)list[it] == cblk ? 1 : 0; }
    __device__ __forceinline__ bool lane_keep(int it) const { const int j = list[it]; return (((j < 32) ? (mlo >> j) : (mhi >> (j - 32))) & 1u) != 0u; }
    __device__ __forceinline__ void bounds(int it, int& lb, int& ub) const { const int j = list[it]; lb = 0; ub = t - 64 * j; }
};
struct WinPol {
    const bf16* Zb; int jt0, nt, t, cblk;
    __device__ __forceinline__ int ntiles() const { return nt; }
    __device__ __forceinline__ const bf16* krow(int it, int r) const { return Zb + (size_t)(64 * (jt0 + it) + r) * DINP + ZKW; }
    __device__ __forceinline__ const bf16* vrow(int it, int r) const { return Zb + (size_t)(64 * (jt0 + it) + r) * DINP + ZVW; }
    __device__ __forceinline__ bool wave_skip(int) const { return false; }
    __device__ __forceinline__ int mask_mode(int it) const { const int jt = jt0 + it; return (jt == cblk ? 1 : 0) | (jt == cblk - 8 ? 2 : 0); }
    __device__ __forceinline__ bool lane_keep(int) const { return true; }
    __device__ __forceinline__ void bounds(int it, int& lb, int& ub) const { ub = t - 64 * (jt0 + it); lb = ub - 511; }
};
constexpr int NSA_IMP_OFF = 45056, NSA_SEL_OFF = NSA_IMP_OFF + 2 * 64 * 65 * 4, NSA_LIST_OFF = NSA_SEL_OFF + 512;
static_assert(fa::LDS_NEED <= NSA_IMP_OFF && NSA_LIST_OFF + 64 <= RING_BYTES, "NSA LDS map");
__device__ __forceinline__ void nsa_item(Frame& F, int b, int c) {
    PHASE_IDS(F);
    const bf16* Z = (const bf16*)(F.ws + WS_Z); const bf16* AQR = (const bf16*)(F.ws + WS_AQR); bf16* AO = (bf16*)(F.ws + WS_H);
    const bf16* KCB = (const bf16*)(F.ws + WS_KC) + (size_t)b * 256 * 64; const bf16* VCB = (const bf16*)(F.ws + WS_VC) + (size_t)b * 256 * 64;
    const int lane = F.lane, r32 = lane & 31, hi = lane >> 5, tokl = 8 * F.wave + (r32 >> 2), h = r32 & 3, t = 64 * c + tokl; const size_t row = (size_t)b * SEQ + t;
    const bf16* Zb = Z + (size_t)b * SEQ * DINP;
    float* impA = (float*)(F.lds + NSA_IMP_OFF); float* impB = impA + 64 * 65;
    unsigned long long* sel = (unsigned long long*)(F.lds + NSA_SEL_OFF); unsigned char* list = F.lds + NSA_LIST_OFF;
    for (int i = F.tid; i < 2 * 64 * 65; i += NTHREADS) impA[i] = 0.f;
    const bf16* zr = Zb + (size_t)t * DINP;
    const float g0 = sigmoidf_(bf2f(zr[ZAG + h])), g1 = sigmoidf_(bf2f(zr[ZAG + 4 + h])), g2 = sigmoidf_(bf2f(zr[ZAG + 8 + h]));
    fa::f32x16 acc[2], O[2];
    {
        CmpPol cp; cp.KCb = KCB; cp.VCb = VCB; cp.nt = (4 * c + 2 + 64) >> 6; cp.ubg = t >= 31 ? ((t - 31) >> 4) : -1; cp.impA = impA; cp.impB = impB; cp.tokl = tokl; cp.nov = false;
        fa::bf16x8 qf[4]; fa::load_qf(zr + ZAQ + 64 * h, hi, qf);
        float m = -INFINITY, l = 0.f;
#pragma unroll
        for (int dt = 0; dt < 2; ++dt)
#pragma unroll
            for (int r = 0; r < 16; ++r) O[dt][r] = 0.f;
        fa::stream<0, 4, CmpPol, 0>(cp, F.lds3, F.tid, 0.125f * fa::LOG2E, qf, m, l, O);
        float lt = fa::finish(l, O);
#pragma unroll
        for (int dt = 0; dt < 2; ++dt)
#pragma unroll
            for (int r = 0; r < 16; ++r) acc[dt][r] = g0 * O[dt][r];
        cp.nov = true;
        fa::stream<0, 4, CmpPol, 1>(cp, F.lds3, F.tid, 0.125f * fa::LOG2E, qf, m, lt, O);
    }
    __syncthreads();
#pragma unroll 1
    for (int tk = 0; tk < 8; ++tk) {
        const int tl = 8 * F.wave + tk, j = lane; const float imp = impA[tl * 65 + j] + impB[tl * 65 + j];
        const bool forced = (j == 0) || (j <= c && j > c - 2);
        const float sc = (j > c) ? -1.0e6f : (forced ? 1.0e6f : imp);
        int rank = 0;
#pragma unroll 8
        for (int i = 0; i < 64; ++i) { const float si = lane_get(sc, i); rank += (si > sc || (si == sc && i < j)) ? 1 : 0; }
        const unsigned long long mask = __ballot(rank < 16 && j <= c);
        if (lane == 0) sel[tl] = mask;
    }
    __syncthreads();
    SlcPol sp; sp.Zb = Zb; sp.list = list; sp.t = t; sp.cblk = c;
    { const unsigned long long mk = sel[tokl]; sp.mlo = (unsigned)mk; sp.mhi = (unsigned)(mk >> 32);
      unsigned wl = sp.mlo, wh = sp.mhi; wl |= (unsigned)sx_i<4>((int)wl); wh |= (unsigned)sx_i<4>((int)wh); wl |= (unsigned)sx_i<8>((int)wl); wh |= (unsigned)sx_i<8>((int)wh); wl |= (unsigned)sx_i<16>((int)wl); wh |= (unsigned)sx_i<16>((int)wh);
      sp.wlo = __builtin_amdgcn_readfirstlane(wl); sp.whi = __builtin_amdgcn_readfirstlane(wh);
      const unsigned long long mu = sel[lane]; unsigned ul = (unsigned)mu, uh = (unsigned)(mu >> 32);
      ul |= (unsigned)sx_i<1>((int)ul); uh |= (unsigned)sx_i<1>((int)uh); ul |= (unsigned)sx_i<2>((int)ul); uh |= (unsigned)sx_i<2>((int)uh); ul |= (unsigned)sx_i<4>((int)ul); uh |= (unsigned)sx_i<4>((int)uh);
      ul |= (unsigned)sx_i<8>((int)ul); uh |= (unsigned)sx_i<8>((int)uh); ul |= (unsigned)sx_i<16>((int)ul); uh |= (unsigned)sx_i<16>((int)uh); ul = or32(ul); uh = or32(uh);
      ul = __builtin_amdgcn_readfirstlane(ul); uh = __builtin_amdgcn_readfirstlane(uh);
      const unsigned long long un = ((unsigned long long)uh << 32) | ul;
      if ((un >> lane) & 1ull) list[__popcll(un & ((1ull << lane) - 1ull))] = (unsigned char)lane;
      sp.nt = __popcll(un); }
    fa::bf16x8 qf[4]; fa::load_qf(AQR + row * 256 + 64 * h, hi, qf);
    { float m = -INFINITY, l = 0.f;
#pragma unroll
      for (int dt = 0; dt < 2; ++dt)
#pragma unroll
          for (int r = 0; r < 16; ++r) O[dt][r] = 0.f;
      fa::stream<0, 4, SlcPol, 0>(sp, F.lds3, F.tid, 0.125f * fa::LOG2E, qf, m, l, O); fa::finish(l, O);
#pragma unroll
      for (int dt = 0; dt < 2; ++dt)
#pragma unroll
          for (int r = 0; r < 16; ++r) acc[dt][r] += g1 * O[dt][r]; }
    { WinPol wp; wp.Zb = Zb; wp.jt0 = c >= 8 ? c - 8 : 0; wp.nt = c - wp.jt0 + 1; wp.t = t; wp.cblk = c;
      float m = -INFINITY, l = 0.f;
#pragma unroll
      for (int dt = 0; dt < 2; ++dt)
#pragma unroll
          for (int r = 0; r < 16; ++r) O[dt][r] = 0.f;
      fa::stream<0, 4, WinPol, 0>(wp, F.lds3, F.tid, 0.125f * fa::LOG2E, qf, m, l, O); fa::finish(l, O);
#pragma unroll
      for (int dt = 0; dt < 2; ++dt)
#pragma unroll
          for (int r = 0; r < 16; ++r) acc[dt][r] += g2 * O[dt][r]; }
    fa::store_o(acc, AO + row * DM + 64 * h, hi);
}
__device__ __forceinline__ void scan_item(Frame& F, int it) {
    PHASE_IDS(F);
    float* CLOC = (float*)(F.ws + WS_CLOC); float* NLOC = (float*)(F.ws + WS_NLOC);
    const float* ACH = (const float*)(F.ws + WS_ACH); const float* MLOC = (const float*)(F.ws + WS_MLOC); float* MIN = (float*)(F.ws + WS_MIN);
    const int bh = it >> 2, qt = it & 3; const int e0 = qt * 1024 + F.tid * 2;
    float c0 = 0.f, c1 = 0.f, nst = 0.f, mst = 0.f;
#pragma unroll 1
    for (int cb = 0; cb < 64; cb += 16) {
        f32x2 cl[16]; float ac[16], ml[16], nl[16];
#pragma unroll
        for (int u = 0; u < 16; ++u) { const int ci = bh * 64 + cb + u; cl[u] = *(const f32x2*)(CLOC + (size_t)ci * 4096 + e0); ac[u] = ACH[ci]; ml[u] = MLOC[ci]; nl[u] = (qt == 0 && F.tid < 64) ? NLOC[ci * 64 + F.tid] : 0.f; }
#pragma unroll
        for (int u = 0; u < 16; ++u) { const int ci = bh * 64 + cb + u;
            const float mn = fmaxf(ac[u] + mst, ml[u]), decay = __expf(ac[u] + mst - mn), fresh = __expf(ml[u] - mn);
            *(f32x2*)(CLOC + (size_t)ci * 4096 + e0) = (f32x2){c0, c1}; c0 = decay * c0 + fresh * cl[u].x; c1 = decay * c1 + fresh * cl[u].y;
            if (qt == 0 && F.tid < 64) { NLOC[ci * 64 + F.tid] = nst; nst = decay * nst + fresh * nl[u]; if (F.tid == 0) MIN[ci] = mst; }
            mst = mn; }
    }
}
struct QOrder { unsigned short v[64 + 256 + 256 + 768]; };
constexpr QOrder make_order() {
    QOrder o{}; int n = 0, id = 0, in = 0, big = 0; bool scans = false;
    while (id < 256 || in < 256) {
        if (!scans && big == 192) { for (int k = 0; k < 64; ++k) o.v[n++] = (unsigned short)((3 << 12) | k); scans = true; }
        const int cd = id < 256 ? 120 * (15 - id / 16 + 1) : -1, cn = in < 256 ? 16 * (63 - in / 4 + 18) : -1;
        if (cd >= cn) { o.v[n++] = (unsigned short)((0 << 12) | id); ++id; } else { o.v[n++] = (unsigned short)((1 << 12) | in); ++in; }
        ++big;
    }
    for (int k = 0; k < 768; ++k) o.v[n++] = (unsigned short)((2 << 12) | k);
    return o;
}
__device__ const QOrder g_order = make_order();
__device__ __forceinline__ void ph_d_queue(Frame& F, const Args& a, int layer) {
    PHASE_IDS(F);
    unsigned* ctr = F.ctl + CW_Q + 64 * layer;
    const float* lv = a.in[5] + (size_t)layer * 128;
    const float lam_init = 0.8f - 0.6f * expf(-0.3f * (float)layer);
    float l01 = 0.f, l23 = 0.f; if (F.lane < 32) { l01 = lv[F.lane] * lv[32 + F.lane]; l23 = lv[64 + F.lane] * lv[96 + F.lane]; }
    const float lam = expf(wave_sum(l01)) - expf(wave_sum(l23)) + lam_init;
    constexpr int NQ = 64 + 256 + 256 + 768;
    for (;;) {
        __syncthreads();
        if (F.tid == 0) F.MISC[0] = __hip_atomic_fetch_add(ctr, 1u, __ATOMIC_RELAXED, __HIP_MEMORY_SCOPE_AGENT);
        __syncthreads();
        const int qi = (int)F.MISC[0];
        if (qi >= NQ) break;
        const int e = g_order.v[qi], ty = e >> 12, id = e & 4095;
        if (ty == 3) scan_item(F, id);
        else if (ty == 0) { const int qb = 15 - (id >> 4), bh = id & 15; diff_item(F, a, layer, bh >> 2, bh & 3, qb, lam); }
        else if (ty == 1) nsa_item(F, id & 3, 63 - (id >> 2));
        else { const int bh = id & 15, k = id >> 4;
            const int g = k >> 4, j = k & 15; const int res = (g == 0) ? 0 : (g == 1) ? (j & 3) : j, blk = (g == 0) ? j : (g == 1) ? (j >> 2) : 0;
            dil_item(F, bh >> 2, bh & 3, g, res, blk); }
    }
    __syncthreads();
}

constexpr int NPHASE = 9 * DEPTH + 1;
#ifndef PH_LO
#define PH_LO 0
#endif
#ifndef PH_HI
#define PH_HI NPHASE
#endif
#define IN(k) (PH_LO <= (k) && (k) < PH_HI)
#ifdef PROBE_K
#ifndef PROBE_SUB
#define PROBE_SUB 0
#endif
#ifndef PROBE_AMP
#define PROBE_AMP 10
#endif
#define PROBE_T0(k) do { if ((k) == PROBE_K) F.pt0 = __builtin_amdgcn_s_memrealtime(); } while (0)
#define PROBE_T1(k) do { if ((k) == PROBE_K) F.pdt = __builtin_amdgcn_s_memrealtime() - F.pt0; } while (0)
#define SUBP(id, call) do { if (layer == 0 && (id) == PROBE_SUB) { F.pt0 = __builtin_amdgcn_s_memrealtime(); call; __syncthreads(); F.pdt = __builtin_amdgcn_s_memrealtime() - F.pt0; } else { call; } } while (0)
#else
#define SUBP(id, call) do { call; } while (0)
#define PROBE_T0(k) do { } while (0)
#define PROBE_T1(k) do { } while (0)
#endif
#define SEAM(k) do { if (IN(k) && (k) + 1 < PH_HI) { if ((k) == PH_LO && F.G == 0x7fffffff) cg::this_grid().sync();   xcd_barrier(bar); } } while (0)
template <int layer> __device__ __forceinline__ void run_layer(Frame& F, const Args& args, const XcdBarrier& bar) {
    float* XR = args.out;
    bf16* H = (bf16*)(F.ws + WS_H); bf16* Z = (bf16*)(F.ws + WS_Z);
    bf16* WIN = (bf16*)(F.ws + WS_WIN); bf16* WOUT = (bf16*)(F.ws + WS_WOUT); bf16* WGU = (bf16*)(F.ws + WS_WGU); bf16* WD = (bf16*)(F.ws + WS_WD);

        const int P = 9 * layer;
        bf16* XB2 = (bf16*)(F.ws + WS_XB2); bf16* ACT = (bf16*)(F.ws + WS_ACT);
        PROBE_T0(P + 0);
        if (IN(P + 0)) {
            convert_weights(F, args, layer);
            if (layer == 0) build_rope(F, args);
            norm_rows_bf16(F, layer == 0 ? args.in[0] : XR, args.in[1] + (size_t)layer * DM, H);
        }
        SEAM(P + 0); PROBE_T1(P + 0);
        PROBE_T0(P + 1);
        if (IN(P + 1)) {
            pg8::Gemm g{H, WIN, T, DINP, DM}; pg8::StaticOrder S; S.init(T, DINP, F.G, (int)blockIdx.x);
            pg8::EpiZR E{Z, DINP, (const float*)(F.ws + WS_ROPE64), (const float*)(F.ws + WS_ROPE32), (bf16*)(F.ws + WS_AQR)};
            pg8::gemm_phase<pg8::EpiZR, pg8::StaticOrder, true, true>(F.lds3, g, S, E);
        }
        SEAM(P + 1); PROBE_T1(P + 1);
        PROBE_T0(P + 2);
        if (IN(P + 2)) { SUBP(1, prep_mlstm(F, args, layer)); SUBP(2, prep_compress(F, args, layer)); }
        SEAM(P + 2); PROBE_T1(P + 2);
        PROBE_T0(P + 3);
        if (IN(P + 3)) ph_d_queue(F, args, layer);
        SEAM(P + 3); PROBE_T1(P + 3);
        PROBE_T0(P + 4);
        if (IN(P + 4)) { SUBP(4, ph_mlstm_out(F, args, layer)); SUBP(5, dil_combine(F)); }
        SEAM(P + 4); PROBE_T1(P + 4);
        PROBE_T0(P + 5);
        if (IN(P + 5)) {
            pg8::Gemm g{H, WOUT, T, DM, DM}; pg8::StaticOrder S; S.init(T, DM, F.G, (int)blockIdx.x); pg8::EpiRes E{layer == 0 ? args.in[0] : XR, XR, DM};
            pg8::gemm_phase<pg8::EpiRes, pg8::StaticOrder, true, true>(F.lds3, g, S, E);
        }
        SEAM(P + 5); PROBE_T1(P + 5);
        PROBE_T0(P + 6);
        if (IN(P + 6)) norm_rows_bf16(F, XR, args.in[14] + (size_t)layer * DM, XB2);
        SEAM(P + 6); PROBE_T1(P + 6);
        PROBE_T0(P + 7);
        if (IN(P + 7)) {
            pg8::Gemm g{XB2, WGU, T, 2 * DFF, DM}; pg8::StaticOrder S; S.init(T, 2 * DFF, F.G, (int)blockIdx.x); pg8::EpiSwiGLU E{ACT, DFF};
            pg8::gemm_phase<pg8::EpiSwiGLU, pg8::StaticOrder, true, true>(F.lds3, g, S, E);
        }
        SEAM(P + 7); PROBE_T1(P + 7);
        PROBE_T0(P + 8);
        if (IN(P + 8)) {
            pg8::Gemm g{ACT, WD, T, DM, DFF}; pg8::StaticOrder S; S.init(T, DM, F.G, (int)blockIdx.x); pg8::EpiRes E{XR, XR, DM};
            pg8::gemm_phase<pg8::EpiRes, pg8::StaticOrder, true, true>(F.lds3, g, S, E);
        }
        SEAM(P + 8); PROBE_T1(P + 8);
}
__global__ void __launch_bounds__(NTHREADS, 2) fwd_kernel(Args args) {
    extern __shared__ __attribute__((aligned(16))) unsigned char lds[];
    Frame F;
    F.lds = lds; F.lds3 = (LAS unsigned char*)lds; F.MISC = (volatile LAS unsigned*)(F.lds3 + MISC_OFF);
    F.tid = threadIdx.x; F.lane = F.tid & 63; F.wave = __builtin_amdgcn_readfirstlane(F.tid >> 6);
    F.G = gridDim.x; F.gw = blockIdx.x * NWAVES + F.wave; F.ngw = F.G * NWAVES;
    F.ws = args.ws; F.ctl = (unsigned*)(args.ws + WS_CTL);
    for (int u = F.tid; u < (LDS_BYTES - LDSCTL_OFF) / 4; u += NTHREADS) ((LAS unsigned*)(F.lds3 + LDSCTL_OFF))[u] = 0u;
    __syncthreads();
    XcdBarrier bar = xcd_barrier_post(F.ctl + CW_BAR, F.MISC + 8);
    run_layer<0>(F, args, bar);
    run_layer<1>(F, args, bar);
    if (IN(9 * DEPTH)) final_norm(F, args.out, args.in[18]);
#ifdef PROBE_K
    if (blockIdx.x == 0) { const unsigned long long te = __builtin_amdgcn_s_memrealtime(); while (__builtin_amdgcn_s_memrealtime() - te < (unsigned long long)PROBE_AMP * F.pdt) __builtin_amdgcn_s_sleep(32); }
#endif
#undef IN
#undef SEAM
}

extern "C" void kernel_launch(void* const* d_in, const int* in_sizes, int n_in, void* d_out, int out_size, void* d_ws, size_t ws_size, hipStream_t stream) {
    static int grid = 0;
    if (grid == 0) {
        if (n_in != 19 || in_sizes[0] != T * DM || out_size != T * DM || ws_size < WS_END) { fprintf(stderr, "kernel_launch: unexpected shapes (n_in %d, in0 %d, out %d, ws %zu); nothing launched\n", n_in, n_in > 0 ? in_sizes[0] : -1, out_size, ws_size); grid = -1; return; }
        int dev = 0, cus = 0, per_cu = 0;
        if (hipGetDevice(&dev) != hipSuccess || hipDeviceGetAttribute(&cus, hipDeviceAttributeMultiprocessorCount, dev) != hipSuccess) { grid = -1; return; }
        if (hipFuncSetAttribute((const void*)fwd_kernel, hipFuncAttributeMaxDynamicSharedMemorySize, LDS_BYTES) != hipSuccess) { fprintf(stderr, "kernel_launch: hipFuncSetAttribute failed\n"); grid = -1; return; }
        if (hipOccupancyMaxActiveBlocksPerMultiprocessor(&per_cu, (const void*)fwd_kernel, NTHREADS, LDS_BYTES) != hipSuccess || per_cu < 1) { fprintf(stderr, "kernel_launch: note: occupancy query says %d blocks per CU\n", per_cu); (void)hipGetLastError(); }
        grid = cus;
    }
    if (grid < 0) return;
    if (hipMemsetAsync((char*)d_ws + WS_CTL, 0, CTL_ZERO_BYTES, stream) != hipSuccess) { fprintf(stderr, "kernel_launch: memset failed\n"); return; }
    Args a{};
    for (int i = 0; i < 19; ++i) a.in[i] = (const float*)d_in[i];
    a.out = (float*)d_out; a.ws = (unsigned char*)d_ws;
    for (int i = 0; i < 32; ++i) a.inv64[i] = 1.0f / powf(10000.0f, (float)(2 * i) / 64.0f);
    for (int i = 0; i < 16; ++i) a.inv32[i] = 1.0f / powf(10000.0f, (float)(2 * i) / 32.0f);
    void* params[] = {&a};
    const hipError_t le = hipLaunchCooperativeKernel((const void*)fwd_kernel, dim3(grid), dim3(NTHREADS), params, LDS_BYTES, stream);
    if (le != hipSuccess) fprintf(stderr, "kernel_launch: cooperative launch failed: %s (grid %d)\n", hipGetErrorName(le), grid);
}
```

```cpp
#include <hip/hip_runtime.h>
#include <hip/hip_cooperative_groups.h>
#include <cstdio>
#include <cstdint>
namespace cg = cooperative_groups;
namespace pg8 {
#define PG8_LAS __attribute__((address_space(3)))
typedef unsigned short bf16_t;
typedef short bf16x8 __attribute__((ext_vector_type(8)));
typedef float f32x4 __attribute__((ext_vector_type(4)));
typedef unsigned u32x4 __attribute__((ext_vector_type(4)));
constexpr int BM = 256, BK = 64, HALF = 128, HTB = HALF * BK * 2  , STAGE_BYTES = 8 * HTB, NXCD = 8, WGM = 8;

__host__ __device__ __forceinline__ int lds_byte(int r, int c) { const int st = (r >> 4) * 2 + (c >> 5), rr = r & 15, cc = c & 31, ob = rr * 64 + cc * 2; return st * 1024 + (ob ^ (((ob >> 9) & 1) << 5)); }
__host__ __device__ __forceinline__ void stage_rc(int b, int& R, int& C) { const int st = b / 1024, sb = b % 1024, swz = sb ^ (((sb >> 9) & 1) << 5); R = (st >> 1) * 16 + swz / 64; C = (st & 1) * 32 + (swz % 64) / 2; }
__host__ __device__ __forceinline__ int perm32(int rho) { const int n = rho >> 4, i = rho & 15; return 8 * (i >> 2) + 4 * n + (i & 3); }

struct Unit { int pm, pn; };
struct Gemm { const bf16_t* A; const bf16_t* Bt; int M, N, K; };

struct StaticOrder {
    int nM, nN, nwg, G, c;
    __host__ __device__ void init(int M, int N, int G_, int c_) { nM = M / BM; nN = N / BM; nwg = nM * nN; G = G_; c = c_; }
    __host__ __device__ bool next(int i, Unit& u) const {
        const long L = (long)i * G + c; if (L >= nwg) return false;
        int wgid = (int)L; { const int q = nwg / NXCD, r = nwg % NXCD, xcd = wgid % NXCD, off = wgid / NXCD; wgid = (xcd < r ? xcd * (q + 1) : r * (q + 1) + (xcd - r) * q) + off; }
        const int nig = WGM * nN, gid = wgid / nig, fm = gid * WGM, gsz = (nM - fm) < WGM ? (nM - fm) : WGM;
        u.pm = fm + ((wgid % nig) % gsz); u.pn = (wgid % nig) / gsz; return true;
    }
    __device__ __forceinline__ void a_ready(const Unit&) const {}
    __device__ __forceinline__ void done(const Unit&) const {}
};

__device__ __forceinline__ unsigned cvt_pk_bf16(float lo, float hi) { unsigned r; asm volatile("v_cvt_pk_bf16_f32 %0, %1, %2" : "=v"(r) : "v"(lo), "v"(hi)); return r; }
typedef float f32x2 __attribute__((ext_vector_type(2)));
struct EpiZR {
    static constexpr bool PERM = true, AFTER_DRAIN = false;
    bf16_t* O; int ldc; const float* r64; const float* r32; bf16_t* aqr;
    __device__ __forceinline__ void operator()(const f32x4 (&acc)[2][2][4][2], const Unit& u, int wr, int wc, int fr, int fq) const {
        const int row0 = u.pm * BM + wr * 64 + fr, col0 = u.pn * BM + wc * 32 + 8 * fq;
        constexpr unsigned long long R64 = 0xFull | (1ull << 6) | (1ull << 8) | (0xFFull << 34), R32 = 0xFFull << 10;
        const int seg0 = col0 >> 6, seg1 = (col0 + HALF) >> 6;
        const bool a64 = (R64 >> seg0) & 1ull, a32 = (R32 >> seg0) & 1ull, b64 = (R64 >> seg1) & 1ull, b32 = (R32 >> seg1) & 1ull;
        const bool any64 = a64 || b64, any32 = a32 || b32;
        const int i64 = (col0 & 63) >> 1, i32 = (col0 & 31) >> 1;
#pragma unroll
        for (int ai = 0; ai < 2; ++ai)
#pragma unroll
            for (int m = 0; m < 4; ++m) { const int row = row0 + ai * HALF + m * 16; const int pos = row & 4095; bf16_t* rowp = O + (size_t)row * ldc + col0;
                f32x4 c64a = {0.f, 0.f, 0.f, 0.f}, c64b = c64a, c32a = c64a, c32b = c64a;
                if (any64) { const float* tp = r64 + ((size_t)pos * 32 + i64) * 2; c64a = *(const f32x4*)tp; c64b = *(const f32x4*)(tp + 4); }
                if (any32) { const float* tp = r32 + ((size_t)pos * 16 + i32) * 2; c32a = *(const f32x4*)tp; c32b = *(const f32x4*)(tp + 4); }
#pragma unroll
                for (int bj = 0; bj < 2; ++bj) { f32x4 v0 = acc[ai][bj][m][0], v1 = acc[ai][bj][m][1]; const int c0 = col0 + bj * HALF, seg = bj ? seg1 : seg0;
                    const bool t64 = bj ? b64 : a64, t32 = bj ? b32 : a32;
                    if (t64 || t32) {
                        const f32x4 ca = t64 ? c64a : c32a, cb = t64 ? c64b : c32b;
                        const f32x4 o0 = {v0[0] * ca[0] - v0[1] * ca[1], v0[0] * ca[1] + v0[1] * ca[0], v0[2] * ca[2] - v0[3] * ca[3], v0[2] * ca[3] + v0[3] * ca[2]};
                        const f32x4 o1 = {v1[0] * cb[0] - v1[1] * cb[1], v1[0] * cb[1] + v1[1] * cb[0], v1[2] * cb[2] - v1[3] * cb[3], v1[2] * cb[3] + v1[3] * cb[2]};
                        if (seg < 4) { u32x4 wq; wq.x = cvt_pk_bf16(o0[0], o0[1]); wq.y = cvt_pk_bf16(o0[2], o0[3]); wq.z = cvt_pk_bf16(o1[0], o1[1]); wq.w = cvt_pk_bf16(o1[2], o1[3]); *(u32x4*)(aqr + (size_t)row * 256 + c0) = wq; }
                        else { v0 = o0; v1 = o1; }
                    }
                    u32x4 w; w.x = cvt_pk_bf16(v0[0], v0[1]); w.y = cvt_pk_bf16(v0[2], v0[3]); w.z = cvt_pk_bf16(v1[0], v1[1]); w.w = cvt_pk_bf16(v1[2], v1[3]);
                    *(u32x4*)(rowp + bj * HALF) = w; } }
    }
};
struct EpiRes {
    static constexpr bool PERM = false, AFTER_DRAIN = false;
    const float* base; float* out; int ldc;
    __device__ __forceinline__ void operator()(const f32x4 (&acc)[2][2][4][2], const Unit& u, int wr, int wc, int fr, int fq) const {
        const int row0 = u.pm * BM + wr * 64 + fr, col0 = u.pn * BM + wc * 32 + 4 * fq;
#pragma unroll
        for (int ai = 0; ai < 2; ++ai)
#pragma unroll
            for (int m = 0; m < 4; ++m) { const size_t off = (size_t)(row0 + ai * HALF + m * 16) * ldc + col0;
#pragma unroll
                for (int bj = 0; bj < 2; ++bj)
#pragma unroll
                    for (int n = 0; n < 2; ++n) { const size_t p = off + bj * HALF + n * 16; const f32x4 b = *(const f32x4*)(base + p); *(f32x4*)(out + p) = b + acc[ai][bj][m][n]; } }
    }
};
struct EpiSwiGLU {
    static constexpr bool PERM = true, AFTER_DRAIN = false;
    bf16_t* O; int ldc;
    __device__ __forceinline__ void operator()(const f32x4 (&acc)[2][2][4][2], const Unit& u, int wr, int wc, int fr, int fq) const {
        const int row0 = u.pm * BM + wr * 64 + fr, col0 = u.pn * HALF + wc * 32 + 8 * fq;
#pragma unroll
        for (int ai = 0; ai < 2; ++ai)
#pragma unroll
            for (int m = 0; m < 4; ++m) { const int row = row0 + ai * HALF + m * 16; bf16_t* rowp = O + (size_t)row * ldc + col0;
                float r[8];
#pragma unroll
                for (int n = 0; n < 2; ++n)
#pragma unroll
                    for (int j = 0; j < 4; ++j) { const float g = acc[ai][0][m][n][j], up = acc[ai][1][m][n][j]; r[4 * n + j] = g * __builtin_amdgcn_rcpf(1.0f + __expf(-g)) * up; }
                u32x4 w; w.x = cvt_pk_bf16(r[0], r[1]); w.y = cvt_pk_bf16(r[2], r[3]); w.z = cvt_pk_bf16(r[4], r[5]); w.w = cvt_pk_bf16(r[6], r[7]);
                *(u32x4*)rowp = w; }
    }
};
template <class Epi, class Sched, bool ALIGN_EPI = false, bool SP2 = false>
__device__ __forceinline__ void gemm_phase(PG8_LAS unsigned char* lds, const Gemm g, const Sched& S, const Epi& E) {
    int tid_ = threadIdx.x; asm volatile("" : "+v"(tid_));
    const int tid = tid_, wid = __builtin_amdgcn_readfirstlane(tid >> 6), lane = tid & 63, wr = wid >> 2, wc = wid & 3, fr = lane & 15, fq = lane >> 4;
    const int K = g.K, nt = K / BK;
    unsigned voffA[2], voffB[2];
#pragma unroll
    for (int i = 0; i < 2; ++i) { int R, C; stage_rc(tid * 16 + i * 8192, R, C); const int Rb = Epi::PERM ? ((R & ~31) + perm32(R & 31)) : R;
        voffA[i] = (unsigned)(R * K + C) * 2u; voffB[i] = (unsigned)(Rb * K + C) * 2u; }
    const size_t kstep = (size_t)(BK * 2);
    const size_t hstep = (size_t)HALF * K * 2;
    const size_t tstep = 2 * hstep;
    const unsigned ldsw = (unsigned)wid * 1024u;
    const int aoff = lds_byte(wr * 64 + fr, fq * 8), boff = lds_byte(wc * 32 + fr, fq * 8);
#define PG8_SA(b, h) (((b) * 2 + (h)) * HTB)
#define PG8_SB(b, h) ((4 + (b) * 2 + (h)) * HTB)
#define PG8_STAGE(bufoff, gbase, voff) do { _Pragma("unroll") for (int _i = 0; _i < 2; ++_i) \
        __builtin_amdgcn_global_load_lds((const unsigned*)((const char*)(gbase) + (voff)[_i]), (PG8_LAS unsigned*)(lds + (bufoff) + ldsw + _i * 8192), 16, 0, 0); } while (0)
#define PG8_LDA(dst, b, h) do { _Pragma("unroll") for (int m = 0; m < 4; ++m) _Pragma("unroll") for (int k = 0; k < 2; ++k) dst[m][k] = *(const PG8_LAS bf16x8*)(lds + PG8_SA(b, h) + aoff + m * 2048 + k * 1024); } while (0)
#define PG8_LDB(dst, b, h) do { _Pragma("unroll") for (int n = 0; n < 2; ++n) _Pragma("unroll") for (int k = 0; k < 2; ++k) dst[n][k] = *(const PG8_LAS bf16x8*)(lds + PG8_SB(b, h) + boff + n * 2048 + k * 1024); } while (0)
#define PG8_MMA(ai, bj, At, Bt) do { __builtin_amdgcn_s_setprio(1); _Pragma("unroll") for (int m = 0; m < 4; ++m) _Pragma("unroll") for (int n = 0; n < 2; ++n) _Pragma("unroll") for (int k = 0; k < 2; ++k) \
        acc[ai][bj][m][n] = __builtin_amdgcn_mfma_f32_16x16x32_bf16(Bt[n][k], At[m][k], acc[ai][bj][m][n], 0, 0, 0); __builtin_amdgcn_s_setprio(0); } while (0)
#define PG8_WAIT_V(n) asm volatile("s_waitcnt vmcnt(" #n ")" ::: "memory")
#define PG8_WAIT_L(n) asm volatile("s_waitcnt lgkmcnt(" #n ")" ::: "memory")
#define PG8_BAR __builtin_amdgcn_s_barrier()
#define PG8_SCHED __builtin_amdgcn_sched_barrier(0)
    Unit cur, nxt; int ui = 0;
    if (!S.next(0, cur)) return;
    f32x4 acc[2][2][4][2];
#pragma unroll
    for (int a = 0; a < 2; ++a)
#pragma unroll
        for (int b = 0; b < 2; ++b)
#pragma unroll
            for (int m = 0; m < 4; ++m)
#pragma unroll
                for (int n = 0; n < 2; ++n) acc[a][b][m][n] = (f32x4){0.f, 0.f, 0.f, 0.f};
    bf16x8 At[4][2], B0[2][2], B1[2][2];
    const char* cA = (const char*)g.A + (size_t)cur.pm * tstep; const char* cB = (const char*)g.Bt + (size_t)cur.pn * tstep;
    S.a_ready(cur);
    if constexpr (SP2) {
        PG8_STAGE(PG8_SB(0, 0), cB, voffB); PG8_STAGE(PG8_SB(0, 1), cB + hstep, voffB); PG8_STAGE(PG8_SA(0, 0), cA, voffA); PG8_STAGE(PG8_SA(0, 1), cA + hstep, voffA);
        if (wr == 1) PG8_BAR;
        PG8_WAIT_V(2); PG8_BAR;
        PG8_STAGE(PG8_SB(1, 0), cB + kstep, voffB); PG8_STAGE(PG8_SA(1, 0), cA + kstep, voffA); PG8_STAGE(PG8_SB(1, 1), cB + hstep + kstep, voffB);
        PG8_WAIT_V(6); PG8_BAR;
    } else {
        PG8_STAGE(PG8_SB(0, 0), cB, voffB); PG8_STAGE(PG8_SA(0, 0), cA, voffA); PG8_STAGE(PG8_SB(0, 1), cB + hstep, voffB); PG8_STAGE(PG8_SA(0, 1), cA + hstep, voffA);
        if (wr == 1) PG8_BAR;
        PG8_WAIT_V(4); PG8_BAR;
        PG8_STAGE(PG8_SB(1, 0), cB + kstep, voffB); PG8_STAGE(PG8_SA(1, 0), cA + kstep, voffA); PG8_STAGE(PG8_SB(1, 1), cB + hstep + kstep, voffB);
        PG8_WAIT_V(6); PG8_BAR;
    }
    for (;;) {
        const bool has_next = S.next(ui + 1, nxt);
        const char* nA = has_next ? (const char*)g.A + (size_t)nxt.pm * tstep : cA; const char* nB = has_next ? (const char*)g.Bt + (size_t)nxt.pn * tstep : cB;
        for (int t = 0; t < nt; t += 2) {
            const bool last = (t == nt - 2);
            const char* a1 = cA + (size_t)(t + 1) * kstep;
            const char* a2 = last ? nA : cA + (size_t)(t + 2) * kstep; const char* b2 = last ? nB : cB + (size_t)(t + 2) * kstep;
            const char* a3 = a2 + kstep; const char* b3 = b2 + kstep;
            if (last && has_next) S.a_ready(nxt);
            if constexpr (SP2) {
            PG8_LDB(B0, 0, 0); PG8_LDB(B1, 0, 1); PG8_SCHED; PG8_LDA(At, 0, 0); PG8_STAGE(PG8_SA(1, 1), a1 + hstep, voffA);
            PG8_WAIT_V(8); PG8_WAIT_L(0); PG8_BAR; PG8_MMA(0, 0, At, B0); PG8_MMA(0, 1, At, B1); PG8_BAR; PG8_SCHED;
            PG8_LDA(At, 0, 1); PG8_STAGE(PG8_SB(0, 0), b2, voffB); PG8_STAGE(PG8_SB(0, 1), b2 + hstep, voffB); PG8_STAGE(PG8_SA(0, 0), a2, voffA);
            PG8_WAIT_V(8); PG8_WAIT_L(0); PG8_BAR; PG8_MMA(1, 0, At, B0); PG8_MMA(1, 1, At, B1); PG8_BAR; PG8_SCHED;
            PG8_LDB(B0, 1, 0); PG8_LDB(B1, 1, 1); PG8_SCHED; PG8_LDA(At, 1, 0); PG8_STAGE(PG8_SA(0, 1), a2 + hstep, voffA);
            PG8_WAIT_V(8); PG8_WAIT_L(0); PG8_BAR; PG8_MMA(0, 0, At, B0); PG8_MMA(0, 1, At, B1); PG8_BAR; PG8_SCHED;
            PG8_LDA(At, 1, 1); PG8_STAGE(PG8_SB(1, 0), b3, voffB); PG8_STAGE(PG8_SB(1, 1), b3 + hstep, voffB); PG8_STAGE(PG8_SA(1, 0), a3, voffA);
            PG8_WAIT_V(8); PG8_WAIT_L(0); PG8_BAR; PG8_MMA(1, 0, At, B0); PG8_MMA(1, 1, At, B1); PG8_BAR; PG8_SCHED;
            } else {
            PG8_LDB(B0, 0, 0); PG8_SCHED; PG8_LDA(At, 0, 0); PG8_STAGE(PG8_SA(1, 1), a1 + hstep, voffA);
            PG8_WAIT_L(8); PG8_BAR; PG8_WAIT_L(0); PG8_MMA(0, 0, At, B0); PG8_BAR; PG8_SCHED;
            PG8_LDB(B1, 0, 1); PG8_STAGE(PG8_SB(0, 0), b2, voffB);
            PG8_BAR; PG8_WAIT_L(0); PG8_MMA(0, 1, At, B1); PG8_BAR;
            PG8_LDA(At, 0, 1); PG8_STAGE(PG8_SA(0, 0), a2, voffA);
            PG8_BAR; PG8_WAIT_L(0); PG8_MMA(1, 0, At, B0); PG8_BAR; PG8_SCHED;
            PG8_STAGE(PG8_SB(0, 1), b2 + hstep, voffB);
            PG8_WAIT_V(6); PG8_BAR; PG8_MMA(1, 1, At, B1); PG8_BAR;
            PG8_LDB(B0, 1, 0); PG8_SCHED; PG8_LDA(At, 1, 0); PG8_STAGE(PG8_SA(0, 1), a2 + hstep, voffA);
            PG8_WAIT_L(8); PG8_BAR; PG8_WAIT_L(0); PG8_MMA(0, 0, At, B0); PG8_BAR; PG8_SCHED;
            PG8_LDB(B1, 1, 1); PG8_STAGE(PG8_SB(1, 0), b3, voffB);
            PG8_BAR; PG8_WAIT_L(0); PG8_MMA(0, 1, At, B1); PG8_BAR;
            PG8_LDA(At, 1, 1); PG8_STAGE(PG8_SA(1, 0), a3, voffA);
            PG8_BAR; PG8_WAIT_L(0); PG8_MMA(1, 0, At, B0); PG8_BAR; PG8_SCHED;
            PG8_STAGE(PG8_SB(1, 1), b3 + hstep, voffB);
            PG8_WAIT_V(6); PG8_BAR; PG8_MMA(1, 1, At, B1); PG8_BAR;
            }
        }
        if constexpr (ALIGN_EPI) { if (wr == 0) PG8_BAR; }
        if constexpr (!Epi::AFTER_DRAIN) { E(acc, cur, wr, wc, fr, fq); S.done(cur); }
        if (!has_next) break;
#pragma unroll
        for (int a = 0; a < 2; ++a)
#pragma unroll
            for (int b = 0; b < 2; ++b)
#pragma unroll
                for (int m = 0; m < 4; ++m)
#pragma unroll
                    for (int n = 0; n < 2; ++n) acc[a][b][m][n] = (f32x4){0.f, 0.f, 0.f, 0.f};
        cur = nxt; cA = nA; cB = nB; ++ui;
        if constexpr (ALIGN_EPI) { if (wr == 1) PG8_BAR; }
    }
    PG8_WAIT_V(0);
    if constexpr (!ALIGN_EPI) { if (wr == 0) PG8_BAR; }
    PG8_BAR;
    if constexpr (Epi::AFTER_DRAIN) { E.fused(acc, cur, wr, wc, fr, fq, lds, wid, lane); S.done(cur); }
#undef PG8_SA
#undef PG8_SB
#undef PG8_STAGE
#undef PG8_LDA
#undef PG8_LDB
#undef PG8_MMA
#undef PG8_WAIT_V
#undef PG8_WAIT_L
#undef PG8_BAR
#undef PG8_SCHED
}
}

constexpr int NB = 4, SEQ = 4096, T = NB * SEQ, DM = 1024, DIN = 2964, DINP = 3072, DFF = 2816, DEPTH = 2;
constexpr int NWAVES = 8, NTHREADS = 512;
constexpr float EPS = 1e-6f;
constexpr int ZAQ = 0, ZKC = 256, ZVC = 320, ZKS = 384, ZVS = 448, ZKW = 512, ZVW = 576, ZBQ = 640, ZBK = 896, ZBV = 1152,
              ZCU = 1408, ZCV = 1664, ZCO = 1920, ZDQ = 2176, ZDK = 2432, ZDV = 2688, ZAG = 2944, ZCI = 2956, ZCF = 2960;
__host__ __device__ __forceinline__ int pi64(int p) { return (p & 1) ? 32 + (p >> 1) : (p >> 1); }
__host__ __device__ __forceinline__ int pi32(int p) { return (p & 1) ? 16 + (p >> 1) : (p >> 1); }
__host__ __device__ __forceinline__ int zsrc(int n) {
    const int seg = n >> 6, p = n & 63;
    const bool r64 = seg < 4 || seg == 6 || seg == 8 || (seg >= 34 && seg < 42), r32 = seg >= 10 && seg < 18;
    const int q = r64 ? pi64(p) : r32 ? (p & 32) + pi32(p & 31) : p; const int m = seg * 64 + q;
    if (m < 640) return m;
    if (m < 1920) return m + 12;
    if (m < 2944) return m + 20;
    if (m < 2956) return m - 2944 + 640;
    if (m < 2960) return m - 2956 + 1932;
    if (m < 2964) return m - 2960 + 1936;
    return -1;
}
constexpr size_t MiB = 1u << 20;
constexpr size_t WS_CTL = 0, CTL_ZERO_BYTES = 1 * MiB;
constexpr size_t WS_WIN = 2 * MiB, WS_WOUT = 8 * MiB, WS_WGU = 10 * MiB, WS_WD = 21 * MiB;
constexpr size_t WS_ROPE64 = 27 * MiB, WS_ROPE32 = 28 * MiB;
constexpr size_t WS_KC = 29 * MiB, WS_VC = WS_KC + 256 * 1024;
constexpr size_t WS_SEL = WS_VC + 256 * 1024;
constexpr size_t WS_BCUM = 30 * MiB, WS_IG = WS_BCUM + 256 * 1024, WS_NLOC = WS_IG + 256 * 1024;
constexpr size_t WS_ACH = WS_NLOC + 256 * 1024, WS_MLOC = WS_ACH + 4096, WS_MIN = WS_MLOC + 4096;
constexpr size_t WS_WCT = 26 * MiB + 512 * 1024;
constexpr size_t WS_CBP = 28 * MiB + 512 * 1024;
constexpr size_t WS_DLSE = 31 * MiB;
constexpr size_t WS_H = 32 * MiB;
constexpr size_t WS_Z = 64 * MiB;
constexpr size_t WS_XB2 = 64 * MiB, WS_ACT = 96 * MiB;
constexpr size_t WS_AQR = 160 * MiB, WS_OCMP = 168 * MiB, WS_DPART = 176 * MiB;
constexpr size_t WS_MQ = 200 * MiB, WS_MK = 216 * MiB, WS_CLOC = 232 * MiB, WS_END = 248 * MiB;
constexpr int CW_BAR = 4096;
constexpr int CW_Q = 16384;
constexpr int RING_BYTES = 131072, LDSCTL_OFF = RING_BYTES, MISC_OFF = LDSCTL_OFF + 320, LDS_BYTES = 147456;

#define GAS __attribute__((address_space(1)))
#define LAS __attribute__((address_space(3)))
typedef unsigned short bf16;
typedef unsigned v4u __attribute__((ext_vector_type(4)));
typedef unsigned v2u __attribute__((ext_vector_type(2)));
typedef float f32x4 __attribute__((ext_vector_type(4)));
typedef float f32x2 __attribute__((ext_vector_type(2)));
#define LDS_WAIT() asm volatile("s_waitcnt lgkmcnt(0)" ::: "memory")
#define VM_WAIT() asm volatile("s_waitcnt vmcnt(0)" ::: "memory")
__device__ __forceinline__ unsigned f2bf(float f) { unsigned u = __builtin_bit_cast(unsigned, f); return (u + 0x7fffu + ((u >> 16) & 1u)) >> 16; }
__device__ __forceinline__ unsigned pk2(float lo, float hi) { return f2bf(lo) | (f2bf(hi) << 16); }
__device__ __forceinline__ float bf2f(bf16 u) { return __uint_as_float(((unsigned)u) << 16); }
__device__ __forceinline__ float bflo(unsigned w) { return __uint_as_float(w << 16); }
__device__ __forceinline__ float bfhi(unsigned w) { return __uint_as_float(w & 0xffff0000u); }
template <int K> __device__ __forceinline__ int sx_i(int v) {
    if constexpr (K == 1) return __builtin_amdgcn_update_dpp(v, v, 0xB1, 0xF, 0xF, false);
    else if constexpr (K == 2) return __builtin_amdgcn_update_dpp(v, v, 0x4E, 0xF, 0xF, false);
    else return __builtin_amdgcn_ds_swizzle(v, (K << 10) | 0x1f);
}
template <int K> __device__ __forceinline__ float sx(float v) { return __builtin_bit_cast(float, sx_i<K>(__builtin_bit_cast(int, v))); }
__device__ __forceinline__ void swap32(unsigned v, unsigned& a, unsigned& b) { unsigned w = v; asm volatile("" : "+v"(w)); const auto rr = __builtin_amdgcn_permlane32_swap(v, w, false, false); a = rr[0]; b = rr[1]; }
__device__ __forceinline__ float sum32(float v) { unsigned a, b; swap32(__builtin_bit_cast(unsigned, v), a, b); return __builtin_bit_cast(float, a) + __builtin_bit_cast(float, b); }
__device__ __forceinline__ float max32(float v) { unsigned a, b; swap32(__builtin_bit_cast(unsigned, v), a, b); return fmaxf(__builtin_bit_cast(float, a), __builtin_bit_cast(float, b)); }
__device__ __forceinline__ unsigned or32(unsigned v) { unsigned a, b; swap32(v, a, b); return a | b; }
__device__ __forceinline__ float lane_get(float v, int src) { return __builtin_bit_cast(float, __builtin_amdgcn_ds_bpermute(src << 2, __builtin_bit_cast(int, v))); }
__device__ __forceinline__ float wave_sum(float v) { v += sx<1>(v); v += sx<2>(v); v += sx<4>(v); v += sx<8>(v); v += sx<16>(v); return sum32(v); }
__device__ __forceinline__ float wave_max(float v) { v = fmaxf(v, sx<1>(v)); v = fmaxf(v, sx<2>(v)); v = fmaxf(v, sx<4>(v)); v = fmaxf(v, sx<8>(v)); v = fmaxf(v, sx<16>(v)); return max32(v); }
__device__ __forceinline__ float sigmoidf_(float x) { return 1.0f / (1.0f + __expf(-x)); }
#define XB_TMO      128
#define XB_XCNT(j)  (256  + 64 * (j))
#define XB_XSUB(j)  (1280 + 64 * (j))
#define XB_XGEN(j)  (2304 + 64 * (j))
#define XB_TOP      3328
#define XB_TOPGEN   3392
#define XCD_BAR_WORDS 3456
#define XB_SPIN_CAP (1u << 18)

__device__ __forceinline__ unsigned xb_ld(unsigned* p)              { return __hip_atomic_load(p, __ATOMIC_RELAXED, __HIP_MEMORY_SCOPE_AGENT); }
__device__ __forceinline__ unsigned xb_add(unsigned* p, unsigned v) { return __hip_atomic_fetch_add(p, v, __ATOMIC_RELAXED, __HIP_MEMORY_SCOPE_AGENT); }
__device__ __forceinline__ unsigned xb_xcc_id() { return (unsigned)__builtin_amdgcn_s_getreg((3 << 11) | 20) & 0xFu; }
#define XB_SPIN(cond, bar) do { unsigned _sp = 0; while (cond) { __builtin_amdgcn_s_sleep(1); \
    if ((++_sp & 255u) == 0u) { if (xb_ld(&(bar)[XB_TMO])) break; if (_sp > XB_SPIN_CAP) { atomicAdd(&(bar)[XB_TMO], 1u); break; } } } } while (0)

struct XcdBarrier {
    unsigned* bar; unsigned x;
    volatile LAS unsigned* st;
};

__device__ __forceinline__ XcdBarrier xcd_barrier_post(unsigned* bar, volatile LAS unsigned* st) {
    XcdBarrier b; b.bar = bar; b.x = xb_xcc_id(); b.st = st;
    if (threadIdx.x == 0) (void)xb_add(&bar[XB_XCNT(b.x)], 1u);
    return b;
}
__device__ __forceinline__ void xcd_barrier_complete(unsigned* bar, unsigned x, unsigned& nloc, unsigned& nx) {
    const unsigned G = gridDim.x * gridDim.y * gridDim.z;
    unsigned sum, cnt, mine, sp = 0u;
    for (;;) {
        sum = 0u; cnt = 0u; mine = 0u;
#pragma unroll 1
        for (unsigned j = 0; j < 16; ++j) { const unsigned c = xb_ld(&bar[XB_XCNT(j)]); sum += c; cnt += (c > 0u) ? 1u : 0u; mine = (j == x) ? c : mine; }
        if (sum == G) break;
        __builtin_amdgcn_s_sleep(1);
        if ((++sp & 255u) == 0u) { if (xb_ld(&bar[XB_TMO])) break; if (sp > XB_SPIN_CAP) { atomicAdd(&bar[XB_TMO], 1u); break; } }
    }
    nloc = mine > 0u ? mine : 1u; nx = cnt > 0u ? cnt : 1u;
}

__device__ __forceinline__ void xcd_barrier(const XcdBarrier& b) {
    asm volatile("s_waitcnt vmcnt(0)" ::: "memory");
    __syncthreads();
    if (threadIdx.x == 0) {
        unsigned* bar = b.bar;
        __builtin_amdgcn_s_waitcnt(0);
        unsigned nloc = b.st[0], nx = b.st[1];
        if (nloc == 0u) { xcd_barrier_complete(bar, b.x, nloc, nx); b.st[0] = nloc; b.st[1] = nx; }
        const unsigned old = xb_add(&bar[XB_XSUB(b.x)], 1u);
        const unsigned gen = old / nloc;
        if (old + 1u == (gen + 1u) * nloc) {
            __builtin_amdgcn_fence(__ATOMIC_RELEASE, "agent");
            asm volatile("s_waitcnt vmcnt(0)" ::: "memory");
            const unsigned og = xb_add(&bar[XB_TOP], 1u);
            const unsigned tg = og / nx;
            if (og + 1u == (tg + 1u) * nx) xb_add(&bar[XB_TOPGEN], 1u);
            else XB_SPIN(xb_ld(&bar[XB_TOPGEN]) == tg, bar);
            __builtin_amdgcn_fence(__ATOMIC_ACQUIRE, "agent");
            xb_add(&bar[XB_XGEN(b.x)], 1u);
            asm volatile("s_waitcnt vmcnt(0)" ::: "memory");
        } else {
            XB_SPIN(xb_ld(&bar[XB_XGEN(b.x)]) == gen, bar);
            __builtin_amdgcn_fence(__ATOMIC_ACQUIRE, "agent");
            asm volatile("s_waitcnt vmcnt(0)" ::: "memory");
        }
    }
    __syncthreads();
}

struct Args { const float* in[19]; float* out; unsigned char* ws; float inv64[32]; float inv32[16]; };
struct Frame {
    unsigned char* lds;
    LAS unsigned char* lds3;
    volatile LAS unsigned* MISC;
    unsigned* ctl;
    unsigned char* ws;
    int tid, lane, wave, G, gw, ngw;
    unsigned long long pt0, pdt;
};
#define PHASE_IDS(F) do { int t_ = threadIdx.x; asm volatile("" : "+v"(t_)); (F).tid = t_; (F).lane = t_ & 63; (F).wave = __builtin_amdgcn_readfirstlane(t_ >> 6); (F).gw = blockIdx.x * NWAVES + (F).wave; } while (0)


__device__ __forceinline__ void transpose_item(const float* W, int K, int N, int srccol  , bf16* WT, int n0, int k0, float* scr, int lane, const float* gain = nullptr  ) {
#pragma unroll
    for (int i = 0; i < 32; ++i) { const int kk = 2 * i + (lane >> 5); scr[kk * 33 + (lane & 31)] = srccol >= 0 ? W[(size_t)(k0 + kk) * N + srccol] * (gain ? gain[k0 + kk] : 1.0f) : 0.f; }
    LDS_WAIT(); asm volatile("" ::: "memory");
    const int c = lane & 7;
#pragma unroll
    for (int j = 0; j < 4; ++j) { const int n = (lane >> 3) + 8 * j; const float* s = scr + (8 * c) * 33 + n;
        v4u o; o.x = pk2(s[0 * 33], s[1 * 33]); o.y = pk2(s[2 * 33], s[3 * 33]); o.z = pk2(s[4 * 33], s[5 * 33]); o.w = pk2(s[6 * 33], s[7 * 33]);
        *(v4u*)(WT + (size_t)(n0 + n) * K + k0 + 8 * c) = o; }
    LDS_WAIT(); asm volatile("" ::: "memory");
}
template <class CMap>
__device__ __forceinline__ void convert_tile(Frame& F, const float* W, int N, int K, int k0, int scol0, bf16* WT, int n0, CMap cmap) {
    bf16* Tl = (bf16*)F.lds;
    const int t = F.tid;
    f32x4 v[8];
#pragma unroll
    for (int i = 0; i < 8; ++i) v[i] = *(const f32x4*)(W + (size_t)(k0 + 16 * i + (t >> 5)) * N + scol0 + (t & 31) * 4);
    __syncthreads();
#pragma unroll
    for (int i = 0; i < 8; ++i) { v2u w; w.x = pk2(v[i].x, v[i].y); w.y = pk2(v[i].z, v[i].w); *(v2u*)(Tl + (16 * i + (t >> 5)) * 136 + (t & 31) * 4) = w; }
    __syncthreads();
    const int n = t >> 2, kq = (t & 3) * 32, sc = cmap(n);
    const bf16* src = Tl + kq * 136 + sc; unsigned wv[16];
#pragma unroll
    for (int j = 0; j < 16; ++j) wv[j] = (unsigned)src[(2 * j) * 136] | ((unsigned)src[(2 * j + 1) * 136] << 16);
    v4u* dst = (v4u*)(WT + (size_t)(n0 + n) * K + k0 + kq);
#pragma unroll
    for (int j = 0; j < 4; ++j) dst[j] = (v4u){wv[4 * j], wv[4 * j + 1], wv[4 * j + 2], wv[4 * j + 3]};
}
__device__ __forceinline__ void convert_weights(Frame& F, const Args& a, int layer) {
    PHASE_IDS(F);
    const float* w_in = a.in[2] + (size_t)layer * DM * DIN; const float* w_out = a.in[13] + (size_t)layer * DM * DM;
    const float* w_gate = a.in[15] + (size_t)layer * DM * DFF; const float* w_up = a.in[16] + (size_t)layer * DM * DFF; const float* w_down = a.in[17] + (size_t)layer * DFF * DM;
    bf16* WIN = (bf16*)(F.ws + WS_WIN); bf16* WOUT = (bf16*)(F.ws + WS_WOUT); bf16* WGU = (bf16*)(F.ws + WS_WGU); bf16* WD = (bf16*)(F.ws + WS_WD);
    constexpr int B_IN = 8 * 23, B_OUT = 8 * 8, B_GU = 8 * 44, B_D = 22 * 8, NB_ITEMS = B_IN + B_OUT + B_GU + B_D;
    for (int it = blockIdx.x; it < NB_ITEMS; it += F.G) {
        int r = it;
        if (r < B_IN) { const int kt = r / 23, nt = r % 23, n0 = nt * 128, shift = n0 < 640 ? 0 : n0 < 1920 ? 12 : 20;
            convert_tile(F, w_in, DIN, DM, kt * 128, n0 + shift, WIN, n0, [=](int n) { return zsrc(n0 + n) - (n0 + shift); }); continue; } r -= B_IN;
        if (r < B_OUT) { const int kt = r >> 3, nt = r & 7; convert_tile(F, w_out, DM, DM, kt * 128, nt * 128, WOUT, nt * 128, [](int n) { return n; }); continue; } r -= B_OUT;
        if (r < B_GU) { const int kt = r / 44, nt = r % 44, n0 = nt * 128, pn = n0 >> 8; convert_tile(F, (n0 & 128) ? w_up : w_gate, DFF, DM, kt * 128, 128 * pn, WGU, n0, [](int n) { return n; }); continue; } r -= B_GU;
        { const int kt = r >> 3, nt = r & 7; convert_tile(F, w_down, DM, DFF, kt * 128, nt * 128, WD, nt * 128, [](int n) { return n; }); }
    }
    __syncthreads();
    float* scr = (float*)(F.lds + 40960 + F.wave * 8704);
    constexpr int I_IN = (DM / 64) * 4, I_C = 2 * (2048 / 64) * (64 / 32), I_CB = 64, NITEMS = I_IN + I_C + I_CB;
    const float* cmp_w = a.in[4] + (size_t)layer * 2 * 2048 * 64; const float* cmp_pos = a.in[3] + (size_t)layer * 2 * 2048; bf16* WCT = (bf16*)(F.ws + WS_WCT); float* CBP = (float*)(F.ws + WS_CBP);
    for (int it = F.gw; it < NITEMS; it += F.ngw) {
        int r = it; const int l31 = F.lane & 31;
        if (r < I_IN) { const int kb = r >> 2, nb = 92 + (r & 3); transpose_item(w_in, DM, DIN, zsrc(nb * 32 + l31), WIN, nb * 32, kb * 64, scr, F.lane); continue; } r -= I_IN;
        if (r < I_C) { const int br = r >> 6, q = r & 63, kb = q >> 1, nb = q & 1; transpose_item(cmp_w + (size_t)br * 2048 * 64, 2048, 64, br == 0 ? pi64(nb * 32 + l31) : nb * 32 + l31, WCT + (size_t)br * 64 * 2048, nb * 32, kb * 64, scr, F.lane); continue; } r -= I_C;
        { const int br = r >> 5, ch = r & 31; float acc = 0.f;
#pragma unroll 8
          for (int k = ch * 64; k < ch * 64 + 64; ++k) acc += cmp_pos[br * 2048 + k] * cmp_w[((size_t)br * 2048 + k) * 64 + F.lane];
          CBP[(br * 32 + ch) * 64 + F.lane] = acc; }
    }
}
__device__ __forceinline__ void sincos_d(float ang, float& c, float& s) {
    const double a = (double)ang; const double q = __builtin_rint(a * 0.63661977236758134308); const double r = a - q * 1.57079632679489661923; const double r2 = r * r;
    double sp = -1.0 / 39916800.0; sp = sp * r2 + 1.0 / 362880.0; sp = sp * r2 - 1.0 / 5040.0; sp = sp * r2 + 1.0 / 120.0; sp = sp * r2 - 1.0 / 6.0; sp = sp * r2 + 1.0; sp *= r;
    double cp = 1.0 / 479001600.0; cp = cp * r2 - 1.0 / 3628800.0; cp = cp * r2 + 1.0 / 40320.0; cp = cp * r2 - 1.0 / 720.0; cp = cp * r2 + 1.0 / 24.0; cp = cp * r2 - 0.5; cp = cp * r2 + 1.0;
    const int n = ((int)q) & 3; const double cc = (n == 0) ? cp : (n == 1) ? -sp : (n == 2) ? -cp : sp; const double ss = (n == 0) ? sp : (n == 1) ? cp : (n == 2) ? -sp : -cp;
    c = (float)cc; s = (float)ss;
}
__device__ __forceinline__ void build_rope(Frame& F, const Args& a) {
    PHASE_IDS(F);
    f32x2* R64 = (f32x2*)(F.ws + WS_ROPE64); f32x2* R32 = (f32x2*)(F.ws + WS_ROPE32);
    const int gt = F.gw * 64 + F.lane, ngt = F.ngw * 64;
    for (int i = gt; i < SEQ * 48; i += ngt) { const int pos = i / 48, j = i % 48; float c, s;
        if (j < 32) { sincos_d((float)pos * a.inv64[j], c, s); R64[pos * 32 + j] = (f32x2){c, s}; }
        else { sincos_d((float)pos * a.inv32[j - 32], c, s); R32[pos * 16 + (j - 32)] = (f32x2){c, s}; } }
}
__device__ __forceinline__ void norm_rows_bf16(Frame& F, const float* X, const float* g, bf16* H) {
    PHASE_IDS(F);
    f32x4 gg[4];
#pragma unroll
    for (int j = 0; j < 4; ++j) gg[j] = ((const f32x4*)g)[64 * j + F.lane];
    for (int row0 = F.gw * 4; row0 < T; row0 += F.ngw * 4) {
        f32x4 v[4][4];
#pragma unroll
        for (int r = 0; r < 4; ++r)
#pragma unroll
            for (int j = 0; j < 4; ++j) v[r][j] = ((const f32x4*)(X + (size_t)(row0 + r) * DM))[64 * j + F.lane];
#pragma unroll
        for (int r = 0; r < 4; ++r) { float q = 0.f;
#pragma unroll
            for (int j = 0; j < 4; ++j) q += (v[r][j].x * v[r][j].x + v[r][j].y * v[r][j].y) + (v[r][j].z * v[r][j].z + v[r][j].w * v[r][j].w);
            const float rr = 1.0f / sqrtf(wave_sum(q) * (1.0f / DM) + EPS); v2u* o = (v2u*)(H + (size_t)(row0 + r) * DM) + F.lane;
#pragma unroll
            for (int j = 0; j < 4; ++j) { v2u w; w.x = pk2(v[r][j].x * rr * gg[j].x, v[r][j].y * rr * gg[j].y); w.y = pk2(v[r][j].z * rr * gg[j].z, v[r][j].w * rr * gg[j].w); o[64 * j] = w; } }
    }
}
__device__ __forceinline__ void final_norm(Frame& F, float* X, const float* g) {
    PHASE_IDS(F);
    f32x4 gg[4];
#pragma unroll
    for (int j = 0; j < 4; ++j) gg[j] = ((const f32x4*)g)[64 * j + F.lane];
    for (int row0 = F.gw * 4; row0 < T; row0 += F.ngw * 4) {
        f32x4 v[4][4];
#pragma unroll
        for (int r = 0; r < 4; ++r)
#pragma unroll
            for (int j = 0; j < 4; ++j) v[r][j] = ((const f32x4*)(X + (size_t)(row0 + r) * DM))[64 * j + F.lane];
#pragma unroll
        for (int r = 0; r < 4; ++r) { float q = 0.f;
#pragma unroll
            for (int j = 0; j < 4; ++j) q += (v[r][j].x * v[r][j].x + v[r][j].y * v[r][j].y) + (v[r][j].z * v[r][j].z + v[r][j].w * v[r][j].w);
            const float rr = 1.0f / sqrtf(wave_sum(q) * (1.0f / DM) + EPS); f32x4* o = (f32x4*)(X + (size_t)(row0 + r) * DM) + F.lane;
#pragma unroll
            for (int j = 0; j < 4; ++j) o[64 * j] = v[r][j] * rr * gg[j]; }
    }
}

__device__ __forceinline__ void prep_compress(Frame& F, const Args& a, int layer) {
    PHASE_IDS(F);
    typedef short bf16x8 __attribute__((ext_vector_type(8)));
    const bf16* Z = (const bf16*)(F.ws + WS_Z); const bf16* WCT = (const bf16*)(F.ws + WS_WCT); const float* CBP = (const float*)(F.ws + WS_CBP);
    f32x4* red = (f32x4*)F.lds;
    const int lane = F.lane, et = F.wave & 3, kh = F.wave >> 2, r16 = lane & 15, q4 = lane >> 4;
    for (int it = blockIdx.x; it < NB * 2 * 16; it += F.G) {
        const int b = it >> 5, br = (it >> 4) & 1, n0 = (it & 15) * 16; const int zc = br ? ZVC : ZKC;
        const bf16* wrow = WCT + ((size_t)br * 64 + et * 16 + r16) * 2048 + 8 * q4;
        const int tb = 16 * (n0 + r16);
        f32x4 acc = {0.f, 0.f, 0.f, 0.f};
#pragma unroll 8
        for (int kk = kh * 32; kk < kh * 32 + 32; ++kk) {
            int tok = tb + (kk >> 1); tok = tok < SEQ ? tok : SEQ - 1;
            const bf16x8 af = *(const bf16x8*)(Z + ((size_t)b * SEQ + tok) * DINP + zc + (kk & 1) * 32 + 8 * q4);
            const bf16x8 bfr = *(const bf16x8*)(wrow + 32 * kk);
            acc = __builtin_amdgcn_mfma_f32_16x16x32_bf16(af, bfr, acc, 0, 0, 0);
        }
        __syncthreads();
        if (kh == 1) red[et * 64 + lane] = acc;
        __syncthreads();
        if (kh == 0) {
            const f32x4 o = red[et * 64 + lane]; const int e = et * 16 + r16; float bias = 0.f;
            const int es = br == 0 ? pi64(e) : e;
#pragma unroll 8
            for (int ch = 0; ch < 32; ++ch) bias += CBP[(br * 32 + ch) * 64 + es];
            bf16* O = (bf16*)(F.ws + (br ? WS_VC : WS_KC)) + (size_t)b * 256 * 64;
#pragma unroll
            for (int r = 0; r < 4; ++r) { const int n = n0 + 4 * q4 + r; O[n * 64 + e] = (bf16)((n < 255) ? f2bf(acc[r] + o[r] + bias) : 0u); }
        }
    }
    __syncthreads();
}
__device__ __forceinline__ float log_sigmoid_(float x) { return x >= 0.f ? -log1pf(__expf(-x)) : x - log1pf(__expf(x)); }
typedef float f32x16m __attribute__((ext_vector_type(16)));
__device__ __forceinline__ void mm64(f32x16m& acc, const float* ap, int as, const float* bp, int bs) {
#pragma unroll 8
    for (int kk = 0; kk < 32; ++kk) acc = __builtin_amdgcn_mfma_f32_32x32x2f32(ap[kk * as], bp[kk * bs], acc, 0, 0, 0);
}
__device__ __forceinline__ int crow32(int r, int hi) { return (r & 3) + 8 * (r >> 2) + 4 * hi; }
__device__ __forceinline__ void prep_mlstm(Frame& F, const Args& a, int layer) {
    PHASE_IDS(F);
    const bf16* Z = (const bf16*)(F.ws + WS_Z);
    float* L = (float*)F.lds; float* UC = L; float* KS = L + 4224; float* VS = L + 8448; float* WQ = L + 12672; float* WK = L + 16896; float* WE = L + 21120;
    const float* convw = a.in[7] + (size_t)layer * 4 * 256; const float* convb = a.in[8] + (size_t)layer * 256;
    const float* gb = a.in[11] + (size_t)layer * 8;
    float* MQ = (float*)(F.ws + WS_MQ); float* MK = (float*)(F.ws + WS_MK); float* CLOC = (float*)(F.ws + WS_CLOC); float* NLOC = (float*)(F.ws + WS_NLOC);
    float* BCUM = (float*)(F.ws + WS_BCUM); float* IG = (float*)(F.ws + WS_IG); float* ACH = (float*)(F.ws + WS_ACH); float* MLOC = (float*)(F.ws + WS_MLOC);
    const int lane = F.lane, r32 = lane & 31, hi = lane >> 5, w = F.wave, tl = F.tid >> 3, c8 = (F.tid & 7) * 8;
    v4u ur[4], vr; int ph = -1;
    if (w < 4) { const int itw = blockIdx.x + w * F.G;
        if (itw < 1024) { const int bh = itw >> 6, c = itw & 63, b = bh >> 2, h = bh & 3, l = lane; const size_t row = (size_t)b * SEQ + c * 64 + l; const bf16* zr = Z + row * DINP;
            const float ig = bf2f(zr[ZCI + h]) + gb[h]; float bc = log_sigmoid_(bf2f(zr[ZCF + h]) + gb[4 + h]);
#pragma unroll
            for (int o = 1; o < 64; o <<= 1) { const float v = lane_get(bc, l - o); if (l >= o) bc += v; }
            const float ach = lane_get(bc, 63); const float ge = ach - bc + ig; const float ml = wave_max(ge);
            WE[w * 64 + l] = __expf(ge - ml); BCUM[row * 4 + h] = bc; IG[row * 4 + h] = ig; if (l == 0) { ACH[itw] = ach; MLOC[itw] = ml; } } }
#define PM_LOAD(it_) do { const int bh_ = (it_) >> 6, c_ = (it_) & 63, b_ = bh_ >> 2, h_ = bh_ & 3, t_ = c_ * 64 + tl; const bf16* zb_ = Z + (size_t)b_ * SEQ * DINP; \
        _Pragma("unroll") for (int j = 0; j < 4; ++j) { const int tt_ = t_ - 3 + j; ur[j] = tt_ >= 0 ? *(const v4u*)(zb_ + (size_t)tt_ * DINP + ZCU + h_ * 64 + c8) : (v4u){0u, 0u, 0u, 0u}; } \
        vr = *(const v4u*)(zb_ + (size_t)t_ * DINP + ZCV + h_ * 64 + c8); } while (0)
    int it = blockIdx.x;
    if (it < 1024) PM_LOAD(it);
    for (int ki = 0; it < 1024; it += F.G, ++ki) {
        const int bh = it >> 6, c = it & 63, b = bh >> 2, h = bh & 3, t0 = c * 64; const size_t row0 = (size_t)b * SEQ + t0; const float* WEi = WE + ki * 64;
        __syncthreads();
        if (h != ph) { const float* wq = a.in[9] + ((size_t)layer * 4 + h) * 4096; const float* wk = a.in[10] + ((size_t)layer * 4 + h) * 4096;
            *(f32x4*)(WQ + F.tid * 8) = *(const f32x4*)(wq + F.tid * 8); *(f32x4*)(WQ + F.tid * 8 + 4) = *(const f32x4*)(wq + F.tid * 8 + 4);
            *(f32x4*)(WK + F.tid * 8) = *(const f32x4*)(wk + F.tid * 8); *(f32x4*)(WK + F.tid * 8 + 4) = *(const f32x4*)(wk + F.tid * 8 + 4); ph = h; }
        { float u[4][8], acc[8], vv[8]; const int ch = h * 64 + c8;
#pragma unroll
          for (int j = 0; j < 4; ++j) { u[j][0] = bflo(ur[j].x); u[j][1] = bfhi(ur[j].x); u[j][2] = bflo(ur[j].y); u[j][3] = bfhi(ur[j].y); u[j][4] = bflo(ur[j].z); u[j][5] = bfhi(ur[j].z); u[j][6] = bflo(ur[j].w); u[j][7] = bfhi(ur[j].w); }
          vv[0] = bflo(vr.x); vv[1] = bfhi(vr.x); vv[2] = bflo(vr.y); vv[3] = bfhi(vr.y); vv[4] = bflo(vr.z); vv[5] = bfhi(vr.z); vv[6] = bflo(vr.w); vv[7] = bfhi(vr.w);
#pragma unroll
          for (int i = 0; i < 8; ++i) acc[i] = convb[ch + i];
#pragma unroll
          for (int j = 0; j < 4; ++j)
#pragma unroll
              for (int i = 0; i < 8; ++i) acc[i] += convw[j * 256 + ch + i] * u[j][i];
#pragma unroll
          for (int i = 0; i < 8; ++i) { UC[tl * 65 + c8 + i] = acc[i] * sigmoidf_(acc[i]); VS[tl * 64 + c8 + i] = vv[i]; } }
        if (it + F.G < 1024) PM_LOAD(it + F.G);
        __syncthreads();
        { const int i0 = ((w >> 1) & 1) * 32, j0 = (w & 1) * 32; f32x16m acc;
#pragma unroll
            for (int r = 0; r < 16; ++r) acc[r] = 0.f;
            mm64(acc, UC + (i0 + r32) * 65 + hi, 2, (w < 4 ? WQ : WK) + hi * 64 + j0 + r32, 128);
            float* G = (w < 4 ? MQ : MK) + row0 * 256 + h * 64 + j0 + r32;
            if (w < 4) {
#pragma unroll
                for (int r = 0; r < 16; ++r) G[(size_t)(i0 + crow32(r, hi)) * 256] = acc[r];
            } else {
#pragma unroll
                for (int r = 0; r < 16; ++r) { const float v = acc[r] * 0.125f; const int l = i0 + crow32(r, hi); G[(size_t)l * 256] = v; KS[l * 64 + j0 + r32] = v; }
            } }
        __syncthreads();
        if (w < 4) { const int i0 = (w >> 1) * 32, j0 = (w & 1) * 32; f32x16m acc;
#pragma unroll
            for (int r = 0; r < 16; ++r) acc[r] = 0.f;
#pragma unroll 8
            for (int kk = 0; kk < 32; ++kk) { const int l = 2 * kk + hi; acc = __builtin_amdgcn_mfma_f32_32x32x2f32(VS[l * 64 + i0 + r32] * WEi[l], KS[l * 64 + j0 + r32], acc, 0, 0, 0); }
            float* G = CLOC + (size_t)it * 4096 + j0 + r32;
#pragma unroll
            for (int r = 0; r < 16; ++r) G[(i0 + crow32(r, hi)) * 64] = acc[r];
        } else if (w == 4) { float n = 0.f;
#pragma unroll 8
            for (int l = 0; l < 64; ++l) n += WEi[l] * KS[l * 64 + lane];
            NLOC[it * 64 + lane] = n; }
    }
#undef PM_LOAD
    __syncthreads();
}

__device__ __forceinline__ void ld8(const bf16* p, float* o) { const v4u w = *(const v4u*)p; o[0] = bflo(w.x); o[1] = bfhi(w.x); o[2] = bflo(w.y); o[3] = bfhi(w.y); o[4] = bflo(w.z); o[5] = bfhi(w.z); o[6] = bflo(w.w); o[7] = bfhi(w.w); }
__device__ __forceinline__ void ph_mlstm_out(Frame& F, const Args& a, int layer) {
    PHASE_IDS(F);
    const bf16* Z = (const bf16*)(F.ws + WS_Z); bf16* AO = (bf16*)(F.ws + WS_H);
    const float* MQ = (const float*)(F.ws + WS_MQ); const float* MK = (const float*)(F.ws + WS_MK); const float* CIN = (const float*)(F.ws + WS_CLOC); const float* NIN = (const float*)(F.ws + WS_NLOC);
    const float* BCUM = (const float*)(F.ws + WS_BCUM); const float* IG = (const float*)(F.ws + WS_IG); const float* MIN = (const float*)(F.ws + WS_MIN);
    const float* hg = a.in[12] + (size_t)layer * 256;
    float* L = (float*)F.lds; float* QS = L; float* KS = L + 4224; float* CS = L + 8448; float* SS = L + 12672; float* HS = L + 16896; float* VS = L + 21120;
    float* DEN = L + 25344;
    const int lane = F.lane, r32 = lane & 31, hi = lane >> 5, w = F.wave;
    const int tl = F.tid >> 3, c8 = (F.tid & 7) * 8;
    f32x4 qr[2], kr[2], cr[2]; v4u vr;
    float* G4 = DEN + 64;
    if (w < 4) { const int itw = blockIdx.x + w * F.G;
        if (itw < 1024) { const int bh = itw >> 6, c = itw & 63, b = bh >> 2, h = bh & 3, l = lane; const size_t rl = (size_t)b * SEQ + c * 64 + l;
            const float bc = BCUM[rl * 4 + h], ig = IG[rl * 4 + h], mi = MIN[itw]; float* g = G4 + 5 * 64 * w;
            g[l] = NIN[itw * 64 + l]; g[64 + l] = bc; g[128 + l] = ig;
            float pm = ig - bc;
#pragma unroll
            for (int o = 1; o < 64; o <<= 1) { const float v = lane_get(pm, l - o); if (l >= o) pm = fmaxf(pm, v); }
            const float inter = bc + mi, mt = fmaxf(inter, bc + pm); g[192 + l] = mt; g[256 + l] = __expf(inter - mt); } }
#define MO_LOAD(it_) do { const int bh_ = (it_) >> 6, c_ = (it_) & 63, b_ = bh_ >> 2, h_ = bh_ & 3; const size_t r_ = (size_t)b_ * SEQ + c_ * 64 + tl; \
        const f32x4* q_ = (const f32x4*)(MQ + r_ * 256 + h_ * 64 + c8); const f32x4* k_ = (const f32x4*)(MK + r_ * 256 + h_ * 64 + c8); const f32x4* c_p = (const f32x4*)(CIN + (size_t)(it_) * 4096 + tl * 64 + c8); \
        qr[0] = q_[0]; qr[1] = q_[1]; kr[0] = k_[0]; kr[1] = k_[1]; cr[0] = c_p[0]; cr[1] = c_p[1]; vr = *(const v4u*)(Z + r_ * DINP + ZCV + h_ * 64 + c8); } while (0)
    int it = blockIdx.x;
    if (it < 1024) MO_LOAD(it);
    for (int ki = 0; it < 1024; it += F.G, ++ki) {
        const int bh = it >> 6, c = it & 63, b = bh >> 2, h = bh & 3; const size_t row0 = (size_t)b * SEQ + c * 64;
        const float* NI = G4 + 5 * 64 * ki; const float* BC = NI + 64; const float* IGS = BC + 64; const float* MT = IGS + 64; const float* EI = MT + 64;
        __syncthreads();
        { float* q_ = QS + tl * 65 + c8; float* k_ = KS + tl * 65 + c8; float* c_ = CS + tl * 65 + c8; float* v_ = VS + tl * 64 + c8;
#pragma unroll
          for (int i = 0; i < 4; ++i) { q_[i] = qr[0][i]; q_[4 + i] = qr[1][i]; k_[i] = kr[0][i]; k_[4 + i] = kr[1][i]; c_[i] = cr[0][i]; c_[4 + i] = cr[1][i]; }
          v_[0] = bflo(vr.x); v_[1] = bfhi(vr.x); v_[2] = bflo(vr.y); v_[3] = bfhi(vr.y); v_[4] = bflo(vr.z); v_[5] = bfhi(vr.z); v_[6] = bflo(vr.w); v_[7] = bfhi(vr.w); }
        if (it + F.G < 1024) MO_LOAD(it + F.G);
        __syncthreads();
        const int i0 = ((w >> 1) & 1) * 32, j0 = (w & 1) * 32; f32x16m acc;
#pragma unroll
        for (int r = 0; r < 16; ++r) acc[r] = 0.f;
        if (w < 4) {
            if (!(i0 == 0 && j0 == 32)) mm64(acc, QS + (i0 + r32) * 65 + hi, 2, KS + (j0 + r32) * 65 + hi, 2);
            const int s_ = j0 + r32; const float bs = IGS[s_] - BC[s_];
#pragma unroll
            for (int r = 0; r < 16; ++r) { const int t = i0 + crow32(r, hi); SS[t * 65 + s_] = (s_ <= t) ? acc[r] * __expf(BC[t] + bs - MT[t]) : 0.f; }
        } else {
            mm64(acc, QS + (i0 + r32) * 65 + hi, 2, CS + (j0 + r32) * 65 + hi, 2);
#pragma unroll
            for (int r = 0; r < 16; ++r) acc[r] *= EI[i0 + crow32(r, hi)];
        }
        __syncthreads();
        if (w >= 4) {
            mm64(acc, SS + (i0 + r32) * 65 + hi, 2, VS + hi * 64 + j0 + r32, 128);
#pragma unroll
            for (int r = 0; r < 16; ++r) HS[(i0 + crow32(r, hi)) * 65 + j0 + r32] = acc[r];
        } else if (w == 0) { const int t = lane; float nq = 0.f, ssum = 0.f;
#pragma unroll 8
            for (int k = 0; k < 64; ++k) { nq += NI[k] * QS[t * 65 + k]; ssum += SS[t * 65 + k]; }
            const float den = EI[t] * nq + ssum; DEN[t] = 1.0f / fmaxf(fabsf(den), __expf(-MT[t])); }
        __syncthreads();
        { const int t = F.tid >> 3, vg = (F.tid & 7) * 8; const float rd = DEN[t]; float num[8]; float sq = 0.f;
#pragma unroll
            for (int i = 0; i < 8; ++i) { num[i] = HS[t * 65 + vg + i] * rd; sq += num[i] * num[i]; }
            sq += sx<1>(sq); sq += sx<2>(sq); sq += sx<4>(sq);
            const float rn = 1.0f / sqrtf(sq * (1.0f / 64.0f) + EPS); const size_t row = row0 + t;
            float zo[8]; ld8(Z + row * DINP + ZCO + h * 64 + vg, zo);
            unsigned wv[4];
#pragma unroll
            for (int i = 0; i < 8; i += 2) { const int ch = h * 64 + vg + i; wv[i >> 1] = pk2(num[i] * rn * hg[ch] * sigmoidf_(zo[i]), num[i + 1] * rn * hg[ch + 1] * sigmoidf_(zo[i + 1])); }
            *(v4u*)(AO + row * DM + 512 + h * 64 + vg) = (v4u){wv[0], wv[1], wv[2], wv[3]}; }
    }
#undef MO_LOAD
    __syncthreads();
}

namespace fa {
typedef short bf16x8 __attribute__((ext_vector_type(8)));
typedef float f32x16 __attribute__((ext_vector_type(16)));
typedef short s16x4 __attribute__((ext_vector_type(4)));
typedef __bf16 bf16x2_t __attribute__((ext_vector_type(2)));
constexpr int KP = 144, VP = 192, KT = 64 * KP, VT = 64 * VP, BUF = KT + VT, LDS_NEED = 2 * BUF;
constexpr float LOG2E = 1.4426950408889634f, LN2 = 0.6931471805599453f;
__device__ __forceinline__ int crow(int r, int hi) { return (r & 3) + 8 * (r >> 2) + 4 * hi; }
__device__ __forceinline__ unsigned cvtpk(float lo, float hi) { f32x2 v = {lo, hi}; bf16x2_t b = __builtin_convertvector(v, bf16x2_t); return __builtin_bit_cast(unsigned, b); }
__device__ __forceinline__ s16x4 vtr(LAS unsigned char* p) { return __builtin_bit_cast(s16x4, __builtin_amdgcn_ds_read_tr16_b64_v4i16((LAS s16x4*)p)); }
__device__ __forceinline__ void load_qf(const bf16* qrow, int hi, bf16x8 (&qf)[4]) {
#pragma unroll
    for (int ks = 0; ks < 4; ++ks) qf[ks] = *(const bf16x8*)(qrow + 16 * ks + 8 * hi);
}
template <int KS0, int KS, class P, int MODE = 0>
__device__ __forceinline__ void stream(const P& p, LAS unsigned char* lds, int tid, float sc, const bf16x8 (&qf)[4], float& m_, float& l_, f32x16 (&O_)[2]) {
    float m = m_, l = l_; f32x16 O[2] = {O_[0], O_[1]};
    const int lane = tid & 63, r32 = lane & 31, hi = lane >> 5, g = lane >> 4, i16 = lane & 15;
    const int srow = tid >> 3, scx = tid & 7;
    const int koff = r32 * KP + hi * 16;
    const int voff = KT + ((i16 >> 2) + 4 * hi) * VP + (16 * (g & 1) + 4 * (i16 & 3)) * 2;
    const int nt = p.ntiles();
    v4u kr, vr;
#define FA_LOAD(it_) do { const bf16* kp_ = p.krow((it_), srow); const bf16* vp_ = p.vrow((it_), srow); kr = *(const v4u*)(kp_ + 8 * scx); vr = *(const v4u*)(vp_ + 8 * scx); } while (0)
#define FA_STORE(boff_) do { *(LAS v4u*)(lds + (boff_) + srow * KP + scx * 16) = kr; *(LAS v4u*)(lds + (boff_) + KT + srow * VP + scx * 16) = vr; } while (0)
    __syncthreads();
    if (nt > 0) { FA_LOAD(0); FA_STORE(0); if (nt > 1) FA_LOAD(1); }
    __syncthreads();
#pragma unroll 1
    for (int it = 0; it < nt; ++it) {
        const int bc = (it & 1) * BUF;
        if (!p.wave_skip(it)) {
            f32x16 S[2];
            { bf16x8 kf[2][KS];
#pragma unroll
              for (int st = 0; st < 2; ++st)
#pragma unroll
                  for (int k = 0; k < KS; ++k) kf[st][k] = *(LAS bf16x8*)(lds + bc + koff + st * 32 * KP + (KS0 + k) * 32);
#pragma unroll
              for (int st = 0; st < 2; ++st) {
#pragma unroll
                  for (int r = 0; r < 16; ++r) S[st][r] = 0.f;
#pragma unroll
                  for (int k = 0; k < KS; ++k) S[st] = __builtin_amdgcn_mfma_f32_32x32x16_bf16(kf[st][k], qf[KS0 + k], S[st], 0, 0, 0); } }
            s16x4 vv[2][2][2][2];
            if constexpr (MODE == 0) {
#pragma unroll
                for (int st = 0; st < 2; ++st)
#pragma unroll
                    for (int s = 0; s < 2; ++s)
#pragma unroll
                        for (int dt = 0; dt < 2; ++dt) { LAS unsigned char* vp = lds + bc + voff + (32 * st + 16 * s) * VP + dt * 64; vv[st][s][dt][0] = vtr(vp); vv[st][s][dt][1] = vtr(vp + 8 * VP); }
            }
            const int mm = p.mask_mode(it);
            if (mm) {
                int lb, ub; p.bounds(it, lb, ub); lb -= 4 * hi; ub -= 4 * hi;
                asm volatile("" : "+v"(lb), "+v"(ub));
                if (mm == 1) {
#pragma unroll
                    for (int st = 0; st < 2; ++st)
#pragma unroll
                        for (int r = 0; r < 16; ++r) { const int cc = 32 * st + (r & 3) + 8 * (r >> 2); if (cc > ub) S[st][r] = -INFINITY; }
                } else if (mm == 2) {
#pragma unroll
                    for (int st = 0; st < 2; ++st)
#pragma unroll
                        for (int r = 0; r < 16; ++r) { const int cc = 32 * st + (r & 3) + 8 * (r >> 2); if (cc < lb) S[st][r] = -INFINITY; }
                } else {
#pragma unroll
                    for (int st = 0; st < 2; ++st)
#pragma unroll
                        for (int r = 0; r < 16; ++r) { const int cc = 32 * st + (r & 3) + 8 * (r >> 2); if (cc < lb || cc > ub) S[st][r] = -INFINITY; }
                }
            }
            const bool keep = p.lane_keep(it);
            if constexpr (MODE == 1) {
                const float ms = (m == -INFINITY) ? 0.f : m; const float il = l > 0.f ? 1.0f / l : 0.f;
#pragma unroll
                for (int st = 0; st < 2; ++st)
#pragma unroll
                    for (int rg = 0; rg < 4; ++rg) {
                        const float p0 = __builtin_amdgcn_exp2f(__builtin_fmaf(S[st][4 * rg], sc, -ms)) * il, p1 = __builtin_amdgcn_exp2f(__builtin_fmaf(S[st][4 * rg + 1], sc, -ms)) * il;
                        const float p2 = __builtin_amdgcn_exp2f(__builtin_fmaf(S[st][4 * rg + 2], sc, -ms)) * il, p3 = __builtin_amdgcn_exp2f(__builtin_fmaf(S[st][4 * rg + 3], sc, -ms)) * il;
                        float qa = p0, qb = p0 + 2.0f * (p1 + p2 + p3);
                        qa += sx<1>(qa); qa += sx<2>(qa); qb += sx<1>(qb); qb += sx<2>(qb);
                        const int jp = 8 * (2 * it + st) + 2 * rg + hi;
                        if ((r32 & 3) == 0) { p.impA[p.tokl * 65 + jp] = qa; if (jp < 63) p.impB[p.tokl * 65 + jp + 1] = qb; }
                    }
            } else {
                float tm = S[0][0];
#pragma unroll
                for (int r = 1; r < 16; ++r) tm = fmaxf(tm, S[0][r]);
#pragma unroll
                for (int r = 0; r < 16; ++r) tm = fmaxf(tm, S[1][r]);
                tm = max32(tm); if (!keep) tm = -INFINITY;
                const float mn = fmaxf(m, tm * sc), ms0 = (mn == -INFINITY) ? 0.f : mn;
                const float alpha = __builtin_amdgcn_exp2f(m - ms0); const float ms = keep ? ms0 : INFINITY;
                m = mn;
                float ps0 = 0.f, ps1 = 0.f; const float nms = -ms;
#pragma unroll
                for (int st = 0; st < 2; ++st)
#pragma unroll
                    for (int r = 0; r < 16; ++r) { const float e = __builtin_amdgcn_exp2f(__builtin_fmaf(S[st][r], sc, nms)); S[st][r] = e; if (st) ps1 += e; else ps0 += e; }
                l = l * alpha + (ps0 + ps1);
                if (__any(alpha != 1.0f)) {
#pragma unroll
                    for (int dt = 0; dt < 2; ++dt)
#pragma unroll
                        for (int r = 0; r < 16; ++r) O[dt][r] *= alpha;
                }
#pragma unroll
                for (int st = 0; st < 2; ++st)
#pragma unroll
                    for (int s = 0; s < 2; ++s) {
                        v4u pw; pw.x = cvtpk(S[st][8 * s], S[st][8 * s + 1]); pw.y = cvtpk(S[st][8 * s + 2], S[st][8 * s + 3]); pw.z = cvtpk(S[st][8 * s + 4], S[st][8 * s + 5]); pw.w = cvtpk(S[st][8 * s + 6], S[st][8 * s + 7]);
                        const bf16x8 pf = __builtin_bit_cast(bf16x8, pw);
#pragma unroll
                        for (int dt = 0; dt < 2; ++dt) {
                            const s16x4 v0 = vv[st][s][dt][0], v1 = vv[st][s][dt][1];
                            const bf16x8 vf = __builtin_shufflevector(v0, v1, 0, 1, 2, 3, 4, 5, 6, 7);
                            O[dt] = __builtin_amdgcn_mfma_f32_32x32x16_bf16(vf, pf, O[dt], 0, 0, 0);
                        }
                    }
            }
        }
        if (it + 1 < nt) { FA_STORE(((it + 1) & 1) * BUF); if (it + 2 < nt) FA_LOAD(it + 2); }
        __syncthreads();
    }
#undef FA_LOAD
#undef FA_STORE
    m_ = m; l_ = l; O_[0] = O[0]; O_[1] = O[1];
}
template <class P>
__device__ __forceinline__ void stream2(const P& p, LAS unsigned char* lds, int tid, float sc, const bf16x8 (&qf)[4], float (&m)[2], float (&l)[2], f32x16 (&O)[2][2]) {
    const int lane = tid & 63, r32 = lane & 31, hi = lane >> 5, g = lane >> 4, i16 = lane & 15;
    const int srow = tid >> 3, scx = tid & 7;
    const int koff = r32 * KP + hi * 16;
    const int voff = KT + ((i16 >> 2) + 4 * hi) * VP + (16 * (g & 1) + 4 * (i16 & 3)) * 2;
    const int nt = p.ntiles();
    v4u kr, vr;
#define FA_LOAD(it_) do { const bf16* kp_ = p.krow((it_), srow); const bf16* vp_ = p.vrow((it_), srow); kr = *(const v4u*)(kp_ + 8 * scx); vr = *(const v4u*)(vp_ + 8 * scx); } while (0)
#define FA_STORE(boff_) do { *(LAS v4u*)(lds + (boff_) + srow * KP + scx * 16) = kr; *(LAS v4u*)(lds + (boff_) + KT + srow * VP + scx * 16) = vr; } while (0)
    __syncthreads();
    if (nt > 0) { FA_LOAD(0); FA_STORE(0); if (nt > 1) FA_LOAD(1); }
    __syncthreads();
#pragma unroll 1
    for (int it = 0; it < nt; ++it) {
        const int bc = (it & 1) * BUF;
        if (!p.wave_skip(it)) {
            f32x16 S[2][2];
            { bf16x8 kf[2][2][2];
#pragma unroll
              for (int c = 0; c < 2; ++c)
#pragma unroll
                  for (int st = 0; st < 2; ++st)
#pragma unroll
                      for (int k = 0; k < 2; ++k) kf[c][st][k] = *(LAS bf16x8*)(lds + bc + koff + st * 32 * KP + (2 * c + k) * 32);
#pragma unroll
              for (int st = 0; st < 2; ++st)
#pragma unroll
                  for (int c = 0; c < 2; ++c) {
#pragma unroll
                      for (int r = 0; r < 16; ++r) S[c][st][r] = 0.f;
                  }
#pragma unroll
              for (int k = 0; k < 2; ++k)
#pragma unroll
                  for (int st = 0; st < 2; ++st)
#pragma unroll
                      for (int c = 0; c < 2; ++c) S[c][st] = __builtin_amdgcn_mfma_f32_32x32x16_bf16(kf[c][st][k], qf[2 * c + k], S[c][st], 0, 0, 0); }
            s16x4 vv[2][2][2][2];
#pragma unroll
            for (int st = 0; st < 2; ++st)
#pragma unroll
                for (int s = 0; s < 2; ++s)
#pragma unroll
                    for (int dt = 0; dt < 2; ++dt) { LAS unsigned char* vp = lds + bc + voff + (32 * st + 16 * s) * VP + dt * 64; vv[st][s][dt][0] = vtr(vp); vv[st][s][dt][1] = vtr(vp + 8 * VP); }
            if (p.mask_mode(it)) {
                int lb, ub; p.bounds(it, lb, ub); ub -= 4 * hi; asm volatile("" : "+v"(ub));
#pragma unroll
                for (int c = 0; c < 2; ++c)
#pragma unroll
                    for (int st = 0; st < 2; ++st)
#pragma unroll
                        for (int r = 0; r < 16; ++r) { const int cc = 32 * st + (r & 3) + 8 * (r >> 2); if (cc > ub) S[c][st][r] = -INFINITY; }
            }
            float tm[2], ms[2], alpha[2];
#pragma unroll
            for (int c = 0; c < 2; ++c) { float t_ = S[c][0][0];
#pragma unroll
                for (int r = 1; r < 16; ++r) t_ = fmaxf(t_, S[c][0][r]);
#pragma unroll
                for (int r = 0; r < 16; ++r) t_ = fmaxf(t_, S[c][1][r]);
                tm[c] = t_; }
            tm[0] = max32(tm[0]); tm[1] = max32(tm[1]);
#pragma unroll
            for (int c = 0; c < 2; ++c) { const float mn = fmaxf(m[c], tm[c] * sc); ms[c] = (mn == -INFINITY) ? 0.f : mn; alpha[c] = __builtin_amdgcn_exp2f(m[c] - ms[c]); m[c] = mn; }
            float ps[2] = {0.f, 0.f};
#pragma unroll
            for (int st = 0; st < 2; ++st)
#pragma unroll
                for (int r = 0; r < 16; ++r)
#pragma unroll
                    for (int c = 0; c < 2; ++c) { const float e = __builtin_amdgcn_exp2f(__builtin_fmaf(S[c][st][r], sc, -ms[c])); S[c][st][r] = e; ps[c] += e; }
            l[0] = l[0] * alpha[0] + ps[0]; l[1] = l[1] * alpha[1] + ps[1];
            if (__any(alpha[0] != 1.0f || alpha[1] != 1.0f)) {
#pragma unroll
                for (int c = 0; c < 2; ++c)
#pragma unroll
                    for (int dt = 0; dt < 2; ++dt)
#pragma unroll
                        for (int r = 0; r < 16; ++r) O[c][dt][r] *= alpha[c];
            }
#pragma unroll
            for (int st = 0; st < 2; ++st)
#pragma unroll
                for (int s = 0; s < 2; ++s) {
                    bf16x8 pf[2];
#pragma unroll
                    for (int c = 0; c < 2; ++c) { v4u pw; pw.x = cvtpk(S[c][st][8 * s], S[c][st][8 * s + 1]); pw.y = cvtpk(S[c][st][8 * s + 2], S[c][st][8 * s + 3]); pw.z = cvtpk(S[c][st][8 * s + 4], S[c][st][8 * s + 5]); pw.w = cvtpk(S[c][st][8 * s + 6], S[c][st][8 * s + 7]); pf[c] = __builtin_bit_cast(bf16x8, pw); }
#pragma unroll
                    for (int dt = 0; dt < 2; ++dt) {
                        const bf16x8 vf = __builtin_shufflevector(vv[st][s][dt][0], vv[st][s][dt][1], 0, 1, 2, 3, 4, 5, 6, 7);
#pragma unroll
                        for (int c = 0; c < 2; ++c) O[c][dt] = __builtin_amdgcn_mfma_f32_32x32x16_bf16(vf, pf[c], O[c][dt], 0, 0, 0);
                    }
                }
        }
        if (it + 1 < nt) { FA_STORE(((it + 1) & 1) * BUF); if (it + 2 < nt) FA_LOAD(it + 2); }
        __syncthreads();
    }
#undef FA_LOAD
#undef FA_STORE
}
__device__ __forceinline__ float finish(float l, f32x16 (&O)[2]) {
    const float lt = sum32(l); const float inv = lt > 0.f ? 1.0f / lt : 0.f;
#pragma unroll
    for (int dt = 0; dt < 2; ++dt)
#pragma unroll
        for (int r = 0; r < 16; ++r) O[dt][r] *= inv;
    return lt;
}
__device__ __forceinline__ void store_o(const f32x16 (&O)[2], bf16* out, int hi) {
#pragma unroll
    for (int dt = 0; dt < 2; ++dt)
#pragma unroll
        for (int rg = 0; rg < 4; ++rg) { v2u w; w.x = cvtpk(O[dt][4 * rg], O[dt][4 * rg + 1]); w.y = cvtpk(O[dt][4 * rg + 2], O[dt][4 * rg + 3]); *(v2u*)(out + 32 * dt + 8 * rg + 4 * hi) = w; }
}
}

struct DiffPol {
    const bf16* Zb; int h, t0, wq0, tq;
    __device__ __forceinline__ int ntiles() const { return (t0 + 256) >> 6; }
    __device__ __forceinline__ const bf16* krow(int it, int r) const { return Zb + (size_t)(64 * it + r) * DINP + ZBK + 64 * h; }
    __device__ __forceinline__ const bf16* vrow(int it, int r) const { return Zb + (size_t)(64 * it + r) * DINP + ZBV + 64 * h; }
    __device__ __forceinline__ bool wave_skip(int it) const { return 64 * it > wq0 + 31; }
    __device__ __forceinline__ int mask_mode(int it) const { return 64 * it + 63 > wq0 ? 1 : 0; }
    __device__ __forceinline__ bool lane_keep(int) const { return true; }
    __device__ __forceinline__ void bounds(int it, int& lb, int& ub) const { lb = 0; ub = tq - 64 * it; }
};
__device__ __forceinline__ void diff_item(Frame& F, const Args& a, int layer, int b, int h, int qb, float lam) {
    PHASE_IDS(F);
    const bf16* Z = (const bf16*)(F.ws + WS_Z); bf16* AO = (bf16*)(F.ws + WS_H);
    const int lane = F.lane, r32 = lane & 31, hi = lane >> 5;
    DiffPol p; p.Zb = Z + (size_t)b * SEQ * DINP; p.h = h; p.t0 = 256 * qb; p.wq0 = p.t0 + 32 * F.wave; p.tq = p.wq0 + r32;
    fa::bf16x8 qf[4]; fa::load_qf(p.Zb + (size_t)p.tq * DINP + ZBQ + 64 * h, hi, qf);
    fa::f32x16 O[2][2];
#pragma unroll
    for (int c = 0; c < 2; ++c)
#pragma unroll
        for (int dt = 0; dt < 2; ++dt)
#pragma unroll
            for (int r = 0; r < 16; ++r) O[c][dt][r] = 0.f;
    { float m[2] = {-INFINITY, -INFINITY}, l[2] = {0.f, 0.f}; fa::stream2<DiffPol>(p, F.lds3, F.tid, 0.17677669529663687f * fa::LOG2E, qf, m, l, O); fa::finish(l[0], O[0]); fa::finish(l[1], O[1]); }
    const float lam_init = 0.8f - 0.6f * expf(-0.3f * (float)layer);
    const float* sg = a.in[6] + (size_t)layer * 64;
    float ss = 0.f;
#pragma unroll
    for (int dt = 0; dt < 2; ++dt)
#pragma unroll
        for (int r = 0; r < 16; ++r) { const float v = O[0][dt][r] - lam * O[1][dt][r]; O[0][dt][r] = v; ss += v * v; }
    ss = sum32(ss);
    const float rn = (1.0f / sqrtf(ss * (1.0f / 64.0f) + EPS)) * (1.0f - lam_init);
#pragma unroll
    for (int dt = 0; dt < 2; ++dt)
#pragma unroll
        for (int r = 0; r < 16; ++r) O[0][dt][r] *= rn * sg[32 * dt + fa::crow(r, hi)];
    fa::store_o(O[0], AO + ((size_t)b * SEQ + p.tq) * DM + 256 + 64 * h, hi);
}
struct DilPol {
    const bf16* Zb; int h, dil, res, it0, nt, wi0, iq;
    __device__ __forceinline__ int ntiles() const { return nt; }
    __device__ __forceinline__ const bf16* krow(int it, int r) const { const int ik = 64 * (it0 + it) + r; return Zb + (size_t)(res + dil * ik) * DINP + ZDK + 64 * h; }
    __device__ __forceinline__ const bf16* vrow(int it, int r) const { const int ik = 64 * (it0 + it) + r; return Zb + (size_t)(res + dil * ik) * DINP + ZDV + 64 * h; }
    __device__ __forceinline__ bool wave_skip(int it) const { const int k0 = 64 * (it0 + it); return k0 > wi0 + 31 || k0 + 63 < wi0 - 128; }
    __device__ __forceinline__ int mask_mode(int it) const { const int k0 = 64 * (it0 + it); return (k0 + 63 > wi0 ? 1 : 0) | (k0 < wi0 + 31 - 128 ? 2 : 0); }
    __device__ __forceinline__ bool lane_keep(int) const { return true; }
    __device__ __forceinline__ void bounds(int it, int& lb, int& ub) const { ub = iq - 64 * (it0 + it); lb = ub - 128; }
};
__device__ __forceinline__ void dil_item(Frame& F, int b, int h, int g, int res, int blk) {
    PHASE_IDS(F);
    const bf16* Z = (const bf16*)(F.ws + WS_Z); bf16* DP = (bf16*)(F.ws + WS_DPART); float* DL = (float*)(F.ws + WS_DLSE);
    const int lane = F.lane, r32 = lane & 31, hi = lane >> 5;
    DilPol p; p.Zb = Z + (size_t)b * SEQ * DINP; p.h = h; p.dil = (g == 0) ? 1 : (g == 1) ? 4 : 16; p.res = res;
    const int i0 = 256 * blk; const int t_lo = (i0 >> 6) - 2; p.it0 = t_lo < 0 ? 0 : t_lo; p.nt = (i0 >> 6) + 4 - p.it0;
    p.wi0 = i0 + 32 * F.wave; p.iq = p.wi0 + r32;
    const int tq = res + p.dil * p.iq; const size_t row = (size_t)b * SEQ + tq;
    fa::bf16x8 qf[4]; fa::load_qf(p.Zb + (size_t)tq * DINP + ZDQ + 64 * h, hi, qf);
    float m = -INFINITY, l = 0.f; fa::f32x16 O[2];
#pragma unroll
    for (int dt = 0; dt < 2; ++dt)
#pragma unroll
        for (int r = 0; r < 16; ++r) O[dt][r] = 0.f;
    fa::stream<0, 4, DilPol>(p, F.lds3, F.tid, 0.125f * fa::LOG2E, qf, m, l, O);
    const float lt = fa::finish(l, O);
    fa::store_o(O, DP + ((size_t)g * T + row) * 256 + 64 * h, hi);
    if (hi == 0) DL[((size_t)g * T + row) * 4 + h] = (m + __log2f(lt)) * fa::LN2;
}
__device__ __forceinline__ void dil_combine(Frame& F) {
    PHASE_IDS(F);
    const bf16* DP = (const bf16*)(F.ws + WS_DPART); const float* DL = (const float*)(F.ws + WS_DLSE); bf16* AO = (bf16*)(F.ws + WS_H);
    const int gt = F.gw * 64 + F.lane, ngt = F.ngw * 64;
    for (int i = gt; i < T * 32; i += ngt) { const int row = i >> 5, c8 = (i & 31) * 8, h = c8 >> 6;
        const float l0 = DL[(size_t)row * 4 + h], l1 = DL[((size_t)T + row) * 4 + h], l2 = DL[((size_t)2 * T + row) * 4 + h];
        const float mx = fmaxf(l0, fmaxf(l1, l2)); float w0 = __expf(l0 - mx), w1 = __expf(l1 - mx), w2 = __expf(l2 - mx); const float inv = 1.0f / (w0 + w1 + w2); w0 *= inv; w1 *= inv; w2 *= inv;
        float x0[8], x1[8], x2[8]; ld8(DP + (size_t)row * 256 + c8, x0); ld8(DP + ((size_t)T + row) * 256 + c8, x1); ld8(DP + ((size_t)2 * T + row) * 256 + c8, x2);
        v4u o; o.x = pk2(w0 * x0[0] + w1 * x1[0] + w2 * x2[0], w0 * x0[1] + w1 * x1[1] + w2 * x2[1]); o.y = pk2(w0 * x0[2] + w1 * x1[2] + w2 * x2[2], w0 * x0[3] + w1 * x1[3] + w2 * x2[3]);
        o.z = pk2(w0 * x0[4] + w1 * x1[4] + w2 * x2[4], w0 * x0[5] + w1 * x1[5] + w2 * x2[5]); o.w = pk2(w0 * x0[6] + w1 * x1[6] + w2 * x2[6], w0 * x0[7] + w1 * x1[7] + w2 * x2[7]);
        *(v4u*)(AO + (size_t)row * DM + 768 + c8) = o; }
}
struct CmpPol {
    const bf16* KCb; const bf16* VCb; int nt, ubg; float* impA; float* impB; int tokl; bool nov;
    __device__ __forceinline__ int ntiles() const { return nt; }
    __device__ __forceinline__ const bf16* krow(int it, int r) const { return KCb + (size_t)(64 * it + r) * 64; }
    __device__ __forceinline__ const bf16* vrow(int it, int r) const { return VCb + (size_t)(64 * it + r) * 64; }
    __device__ __forceinline__ bool wave_skip(int) const { return false; }
    __device__ __forceinline__ int mask_mode(int) const { return 1; }
    __device__ __forceinline__ bool lane_keep(int) const { return true; }
    __device__ __forceinline__ void bounds(int it, int& lb, int& ub) const { lb = 0; ub = ubg - 64 * it; }
};
struct SlcPol {
    const bf16* Zb; const unsigned char* list; int nt, t, cblk; unsigned wlo, whi, mlo, mhi;
    __device__ __forceinline__ int ntiles() const { return nt; }
    __device__ __forceinline__ const bf16* krow(int it, int r) const { const int j = list[it]; return Zb + (size_t)(64 * j + r) * DINP + ZKS; }
    __device__ __forceinline__ const bf16* vrow(int it, int r) const { const int j = list[it]; return Zb + (size_t)(64 * j + r) * DINP + ZVS; }
    __device__ __forceinline__ bool wave_skip(int it) const { const int j = list[it]; return !(((j < 32) ? (wlo >> j) : (whi >> (j - 32))) & 1u); }
    __device__ __forceinline__ int mask_mode(int it) const { return (int)list[it] == cblk ? 1 : 0; }
    __device__ __forceinline__ bool lane_keep(int it) const { const int j = list[it]; return (((j < 32) ? (mlo >> j) : (mhi >> (j - 32))) & 1u) != 0u; }
    __device__ __forceinline__ void bounds(int it, int& lb, int& ub) const { const int j = list[it]; lb = 0; ub = t - 64 * j; }
};
struct WinPol {
    const bf16* Zb; int jt0, nt, t, cblk;
    __device__ __forceinline__ int ntiles() const { return nt; }
    __device__ __forceinline__ const bf16* krow(int it, int r) const { return Zb + (size_t)(64 * (jt0 + it) + r) * DINP + ZKW; }
    __device__ __forceinline__ const bf16* vrow(int it, int r) const { return Zb + (size_t)(64 * (jt0 + it) + r) * DINP + ZVW; }
    __device__ __forceinline__ bool wave_skip(int) const { return false; }
    __device__ __forceinline__ int mask_mode(int it) const { const int jt = jt0 + it; return (jt == cblk ? 1 : 0) | (jt == cblk - 8 ? 2 : 0); }
    __device__ __forceinline__ bool lane_keep(int) const { return true; }
    __device__ __forceinline__ void bounds(int it, int& lb, int& ub) const { ub = t - 64 * (jt0 + it); lb = ub - 511; }
};
constexpr int NSA_IMP_OFF = 45056, NSA_SEL_OFF = NSA_IMP_OFF + 2 * 64 * 65 * 4, NSA_LIST_OFF = NSA_SEL_OFF + 512;
static_assert(fa::LDS_NEED <= NSA_IMP_OFF && NSA_LIST_OFF + 64 <= RING_BYTES, "NSA LDS map");
__device__ __forceinline__ void nsa_item(Frame& F, int b, int c) {
    PHASE_IDS(F);
    const bf16* Z = (const bf16*)(F.ws + WS_Z); const bf16* AQR = (const bf16*)(F.ws + WS_AQR); bf16* AO = (bf16*)(F.ws + WS_H);
    const bf16* KCB = (const bf16*)(F.ws + WS_KC) + (size_t)b * 256 * 64; const bf16* VCB = (const bf16*)(F.ws + WS_VC) + (size_t)b * 256 * 64;
    const int lane = F.lane, r32 = lane & 31, hi = lane >> 5, tokl = 8 * F.wave + (r32 >> 2), h = r32 & 3, t = 64 * c + tokl; const size_t row = (size_t)b * SEQ + t;
    const bf16* Zb = Z + (size_t)b * SEQ * DINP;
    float* impA = (float*)(F.lds + NSA_IMP_OFF); float* impB = impA + 64 * 65;
    unsigned long long* sel = (unsigned long long*)(F.lds + NSA_SEL_OFF); unsigned char* list = F.lds + NSA_LIST_OFF;
    for (int i = F.tid; i < 2 * 64 * 65; i += NTHREADS) impA[i] = 0.f;
    const bf16* zr = Zb + (size_t)t * DINP;
    const float g0 = sigmoidf_(bf2f(zr[ZAG + h])), g1 = sigmoidf_(bf2f(zr[ZAG + 4 + h])), g2 = sigmoidf_(bf2f(zr[ZAG + 8 + h]));
    fa::f32x16 acc[2], O[2];
    {
        CmpPol cp; cp.KCb = KCB; cp.VCb = VCB; cp.nt = (4 * c + 2 + 64) >> 6; cp.ubg = t >= 31 ? ((t - 31) >> 4) : -1; cp.impA = impA; cp.impB = impB; cp.tokl = tokl; cp.nov = false;
        fa::bf16x8 qf[4]; fa::load_qf(zr + ZAQ + 64 * h, hi, qf);
        float m = -INFINITY, l = 0.f;
#pragma unroll
        for (int dt = 0; dt < 2; ++dt)
#pragma unroll
            for (int r = 0; r < 16; ++r) O[dt][r] = 0.f;
        fa::stream<0, 4, CmpPol, 0>(cp, F.lds3, F.tid, 0.125f * fa::LOG2E, qf, m, l, O);
        float lt = fa::finish(l, O);
#pragma unroll
        for (int dt = 0; dt < 2; ++dt)
#pragma unroll
            for (int r = 0; r < 16; ++r) acc[dt][r] = g0 * O[dt][r];
        cp.nov = true;
        fa::stream<0, 4, CmpPol, 1>(cp, F.lds3, F.tid, 0.125f * fa::LOG2E, qf, m, lt, O);
    }
    __syncthreads();
#pragma unroll 1
    for (int tk = 0; tk < 8; ++tk) {
        const int tl = 8 * F.wave + tk, j = lane; const float imp = impA[tl * 65 + j] + impB[tl * 65 + j];
        const bool forced = (j == 0) || (j <= c && j > c - 2);
        const float sc = (j > c) ? -1.0e6f : (forced ? 1.0e6f : imp);
        int rank = 0;
#pragma unroll 8
        for (int i = 0; i < 64; ++i) { const float si = lane_get(sc, i); rank += (si > sc || (si == sc && i < j)) ? 1 : 0; }
        const unsigned long long mask = __ballot(rank < 16 && j <= c);
        if (lane == 0) sel[tl] = mask;
    }
    __syncthreads();
    SlcPol sp; sp.Zb = Zb; sp.list = list; sp.t = t; sp.cblk = c;
    { const unsigned long long mk = sel[tokl]; sp.mlo = (unsigned)mk; sp.mhi = (unsigned)(mk >> 32);
      unsigned wl = sp.mlo, wh = sp.mhi; wl |= (unsigned)sx_i<4>((int)wl); wh |= (unsigned)sx_i<4>((int)wh); wl |= (unsigned)sx_i<8>((int)wl); wh |= (unsigned)sx_i<8>((int)wh); wl |= (unsigned)sx_i<16>((int)wl); wh |= (unsigned)sx_i<16>((int)wh);
      sp.wlo = __builtin_amdgcn_readfirstlane(wl); sp.whi = __builtin_amdgcn_readfirstlane(wh);
      const unsigned long long mu = sel[lane]; unsigned ul = (unsigned)mu, uh = (unsigned)(mu >> 32);
      ul |= (unsigned)sx_i<1>((int)ul); uh |= (unsigned)sx_i<1>((int)uh); ul |= (unsigned)sx_i<2>((int)ul); uh |= (unsigned)sx_i<2>((int)uh); ul |= (unsigned)sx_i<4>((int)ul); uh |= (unsigned)sx_i<4>((int)uh);
      ul |= (unsigned)sx_i<8>((int)ul); uh |= (unsigned)sx_i<8>((int)uh); ul |= (unsigned)sx_i<16>((int)ul); uh |= (unsigned)sx_i<16>((int)uh); ul = or32(ul); uh = or32(uh);
      ul = __builtin_amdgcn_readfirstlane(ul); uh = __builtin_amdgcn_readfirstlane(uh);
      const unsigned long long un = ((unsigned long long)uh << 32) | ul;
      if ((un >> lane) & 1ull) list[__popcll(un & ((1ull << lane) - 1ull))] = (unsigned char)lane;
      sp.nt = __popcll(un); }
    fa::bf16x8 qf[4]; fa::load_qf(AQR + row * 256 + 64 * h, hi, qf);
    { float m = -INFINITY, l = 0.f;
#pragma unroll
      for (int dt = 0; dt < 2; ++dt)
#pragma unroll
          for (int r = 0; r < 16; ++r) O[dt][r] = 0.f;
      fa::stream<0, 4, SlcPol, 0>(sp, F.lds3, F.tid, 0.125f * fa::LOG2E, qf, m, l, O); fa::finish(l, O);
#pragma unroll
      for (int dt = 0; dt < 2; ++dt)
#pragma unroll
          for (int r = 0; r < 16; ++r) acc[dt][r] += g1 * O[dt][r]; }
    { WinPol wp; wp.Zb = Zb; wp.jt0 = c >= 8 ? c - 8 : 0; wp.nt = c - wp.jt0 + 1; wp.t = t; wp.cblk = c;
      float m = -INFINITY, l = 0.f;
#pragma unroll
      for (int dt = 0; dt < 2; ++dt)
#pragma unroll
          for (int r = 0; r < 16; ++r) O[dt][r] = 0.f;
      fa::stream<0, 4, WinPol, 0>(wp, F.lds3, F.tid, 0.125f * fa::LOG2E, qf, m, l, O); fa::finish(l, O);
#pragma unroll
      for (int dt = 0; dt < 2; ++dt)
#pragma unroll
          for (int r = 0; r < 16; ++r) acc[dt][r] += g2 * O[dt][r]; }
    fa::store_o(acc, AO + row * DM + 64 * h, hi);
}
__device__ __forceinline__ void scan_item(Frame& F, int it) {
    PHASE_IDS(F);
    float* CLOC = (float*)(F.ws + WS_CLOC); float* NLOC = (float*)(F.ws + WS_NLOC);
    const float* ACH = (const float*)(F.ws + WS_ACH); const float* MLOC = (const float*)(F.ws + WS_MLOC); float* MIN = (float*)(F.ws + WS_MIN);
    const int bh = it >> 2, qt = it & 3; const int e0 = qt * 1024 + F.tid * 2;
    float c0 = 0.f, c1 = 0.f, nst = 0.f, mst = 0.f;
#pragma unroll 1
    for (int cb = 0; cb < 64; cb += 16) {
        f32x2 cl[16]; float ac[16], ml[16], nl[16];
#pragma unroll
        for (int u = 0; u < 16; ++u) { const int ci = bh * 64 + cb + u; cl[u] = *(const f32x2*)(CLOC + (size_t)ci * 4096 + e0); ac[u] = ACH[ci]; ml[u] = MLOC[ci]; nl[u] = (qt == 0 && F.tid < 64) ? NLOC[ci * 64 + F.tid] : 0.f; }
#pragma unroll
        for (int u = 0; u < 16; ++u) { const int ci = bh * 64 + cb + u;
            const float mn = fmaxf(ac[u] + mst, ml[u]), decay = __expf(ac[u] + mst - mn), fresh = __expf(ml[u] - mn);
            *(f32x2*)(CLOC + (size_t)ci * 4096 + e0) = (f32x2){c0, c1}; c0 = decay * c0 + fresh * cl[u].x; c1 = decay * c1 + fresh * cl[u].y;
            if (qt == 0 && F.tid < 64) { NLOC[ci * 64 + F.tid] = nst; nst = decay * nst + fresh * nl[u]; if (F.tid == 0) MIN[ci] = mst; }
            mst = mn; }
    }
}
struct QOrder { unsigned short v[64 + 256 + 256 + 768]; };
constexpr QOrder make_order() {
    QOrder o{}; int n = 0, id = 0, in = 0, big = 0; bool scans = false;
    while (id < 256 || in < 256) {
        if (!scans && big == 192) { for (int k = 0; k < 64; ++k) o.v[n++] = (unsigned short)((3 << 12) | k); scans = true; }
        const int cd = id < 256 ? 120 * (15 - id / 16 + 1) : -1, cn = in < 256 ? 16 * (63 - in / 4 + 18) : -1;
        if (cd >= cn) { o.v[n++] = (unsigned short)((0 << 12) | id); ++id; } else { o.v[n++] = (unsigned short)((1 << 12) | in); ++in; }
        ++big;
    }
    for (int k = 0; k < 768; ++k) o.v[n++] = (unsigned short)((2 << 12) | k);
    return o;
}
__device__ const QOrder g_order = make_order();
__device__ __forceinline__ void ph_d_queue(Frame& F, const Args& a, int layer) {
    PHASE_IDS(F);
    unsigned* ctr = F.ctl + CW_Q + 64 * layer;
    const float* lv = a.in[5] + (size_t)layer * 128;
    const float lam_init = 0.8f - 0.6f * expf(-0.3f * (float)layer);
    float l01 = 0.f, l23 = 0.f; if (F.lane < 32) { l01 = lv[F.lane] * lv[32 + F.lane]; l23 = lv[64 + F.lane] * lv[96 + F.lane]; }
    const float lam = expf(wave_sum(l01)) - expf(wave_sum(l23)) + lam_init;
    constexpr int NQ = 64 + 256 + 256 + 768;
    for (;;) {
        __syncthreads();
        if (F.tid == 0) F.MISC[0] = __hip_atomic_fetch_add(ctr, 1u, __ATOMIC_RELAXED, __HIP_MEMORY_SCOPE_AGENT);
        __syncthreads();
        const int qi = (int)F.MISC[0];
        if (qi >= NQ) break;
        const int e = g_order.v[qi], ty = e >> 12, id = e & 4095;
        if (ty == 3) scan_item(F, id);
        else if (ty == 0) { const int qb = 15 - (id >> 4), bh = id & 15; diff_item(F, a, layer, bh >> 2, bh & 3, qb, lam); }
        else if (ty == 1) nsa_item(F, id & 3, 63 - (id >> 2));
        else { const int bh = id & 15, k = id >> 4;
            const int g = k >> 4, j = k & 15; const int res = (g == 0) ? 0 : (g == 1) ? (j & 3) : j, blk = (g == 0) ? j : (g == 1) ? (j >> 2) : 0;
            dil_item(F, bh >> 2, bh & 3, g, res, blk); }
    }
    __syncthreads();
}

constexpr int NPHASE = 9 * DEPTH + 1;
#ifndef PH_LO
#define PH_LO 0
#endif
#ifndef PH_HI
#define PH_HI NPHASE
#endif
#define IN(k) (PH_LO <= (k) && (k) < PH_HI)
#ifdef PROBE_K
#ifndef PROBE_SUB
#define PROBE_SUB 0
#endif
#ifndef PROBE_AMP
#define PROBE_AMP 10
#endif
#define PROBE_T0(k) do { if ((k) == PROBE_K) F.pt0 = __builtin_amdgcn_s_memrealtime(); } while (0)
#define PROBE_T1(k) do { if ((k) == PROBE_K) F.pdt = __builtin_amdgcn_s_memrealtime() - F.pt0; } while (0)
#define SUBP(id, call) do { if (layer == 0 && (id) == PROBE_SUB) { F.pt0 = __builtin_amdgcn_s_memrealtime(); call; __syncthreads(); F.pdt = __builtin_amdgcn_s_memrealtime() - F.pt0; } else { call; } } while (0)
#else
#define SUBP(id, call) do { call; } while (0)
#define PROBE_T0(k) do { } while (0)
#define PROBE_T1(k) do { } while (0)
#endif
#define SEAM(k) do { if (IN(k) && (k) + 1 < PH_HI) { if ((k) == PH_LO && F.G == 0x7fffffff) cg::this_grid().sync();   xcd_barrier(bar); } } while (0)
template <int layer> __device__ __forceinline__ void run_layer(Frame& F, const Args& args, const XcdBarrier& bar) {
    float* XR = args.out;
    bf16* H = (bf16*)(F.ws + WS_H); bf16* Z = (bf16*)(F.ws + WS_Z);
    bf16* WIN = (bf16*)(F.ws + WS_WIN); bf16* WOUT = (bf16*)(F.ws + WS_WOUT); bf16* WGU = (bf16*)(F.ws + WS_WGU); bf16* WD = (bf16*)(F.ws + WS_WD);

        const int P = 9 * layer;
        bf16* XB2 = (bf16*)(F.ws + WS_XB2); bf16* ACT = (bf16*)(F.ws + WS_ACT);
        PROBE_T0(P + 0);
        if (IN(P + 0)) {
            convert_weights(F, args, layer);
            if (layer == 0) build_rope(F, args);
            norm_rows_bf16(F, layer == 0 ? args.in[0] : XR, args.in[1] + (size_t)layer * DM, H);
        }
        SEAM(P + 0); PROBE_T1(P + 0);
        PROBE_T0(P + 1);
        if (IN(P + 1)) {
            pg8::Gemm g{H, WIN, T, DINP, DM}; pg8::StaticOrder S; S.init(T, DINP, F.G, (int)blockIdx.x);
            pg8::EpiZR E{Z, DINP, (const float*)(F.ws + WS_ROPE64), (const float*)(F.ws + WS_ROPE32), (bf16*)(F.ws + WS_AQR)};
            pg8::gemm_phase<pg8::EpiZR, pg8::StaticOrder, true, true>(F.lds3, g, S, E);
        }
        SEAM(P + 1); PROBE_T1(P + 1);
        PROBE_T0(P + 2);
        if (IN(P + 2)) { SUBP(1, prep_mlstm(F, args, layer)); SUBP(2, prep_compress(F, args, layer)); }
        SEAM(P + 2); PROBE_T1(P + 2);
        PROBE_T0(P + 3);
        if (IN(P + 3)) ph_d_queue(F, args, layer);
        SEAM(P + 3); PROBE_T1(P + 3);
        PROBE_T0(P + 4);
        if (IN(P + 4)) { SUBP(4, ph_mlstm_out(F, args, layer)); SUBP(5, dil_combine(F)); }
        SEAM(P + 4); PROBE_T1(P + 4);
        PROBE_T0(P + 5);
        if (IN(P + 5)) {
            pg8::Gemm g{H, WOUT, T, DM, DM}; pg8::StaticOrder S; S.init(T, DM, F.G, (int)blockIdx.x); pg8::EpiRes E{layer == 0 ? args.in[0] : XR, XR, DM};
            pg8::gemm_phase<pg8::EpiRes, pg8::StaticOrder, true, true>(F.lds3, g, S, E);
        }
        SEAM(P + 5); PROBE_T1(P + 5);
        PROBE_T0(P + 6);
        if (IN(P + 6)) norm_rows_bf16(F, XR, args.in[14] + (size_t)layer * DM, XB2);
        SEAM(P + 6); PROBE_T1(P + 6);
        PROBE_T0(P + 7);
        if (IN(P + 7)) {
            pg8::Gemm g{XB2, WGU, T, 2 * DFF, DM}; pg8::StaticOrder S; S.init(T, 2 * DFF, F.G, (int)blockIdx.x); pg8::EpiSwiGLU E{ACT, DFF};
            pg8::gemm_phase<pg8::EpiSwiGLU, pg8::StaticOrder, true, true>(F.lds3, g, S, E);
        }
        SEAM(P + 7); PROBE_T1(P + 7);
        PROBE_T0(P + 8);
        if (IN(P + 8)) {
            pg8::Gemm g{ACT, WD, T, DM, DFF}; pg8::StaticOrder S; S.init(T, DM, F.G, (int)blockIdx.x); pg8::EpiRes E{XR, XR, DM};
            pg8::gemm_phase<pg8::EpiRes, pg8::StaticOrder, true, true>(F.lds3, g, S, E);
        }
        SEAM(P + 8); PROBE_T1(P + 8);
}
__global__ void __launch_bounds__(NTHREADS, 2) fwd_kernel(Args args) {
    extern __shared__ __attribute__((aligned(16))) unsigned char lds[];
    Frame F;
    F.lds = lds; F.lds3 = (LAS unsigned char*)lds; F.MISC = (volatile LAS unsigned*)(F.lds3 + MISC_OFF);
    F.tid = threadIdx.x; F.lane = F.tid & 63; F.wave = __builtin_amdgcn_readfirstlane(F.tid >> 6);
    F.G = gridDim.x; F.gw = blockIdx.x * NWAVES + F.wave; F.ngw = F.G * NWAVES;
    F.ws = args.ws; F.ctl = (unsigned*)(args.ws + WS_CTL);
    for (int u = F.tid; u < (LDS_BYTES - LDSCTL_OFF) / 4; u += NTHREADS) ((LAS unsigned*)(F.lds3 + LDSCTL_OFF))[u] = 0u;
    __syncthreads();
    XcdBarrier bar = xcd_barrier_post(F.ctl + CW_BAR, F.MISC + 8);
    run_layer<0>(F, args, bar);
    run_layer<1>(F, args, bar);
    if (IN(9 * DEPTH)) final_norm(F, args.out, args.in[18]);
#ifdef PROBE_K
    if (blockIdx.x == 0) { const unsigned long long te = __builtin_amdgcn_s_memrealtime(); while (__builtin_amdgcn_s_memrealtime() - te < (unsigned long long)PROBE_AMP * F.pdt) __builtin_amdgcn_s_sleep(32); }
#endif
#undef IN
#undef SEAM
}

extern "C" void kernel_launch(void* const* d_in, const int* in_sizes, int n_in, void* d_out, int out_size, void* d_ws, size_t ws_size, hipStream_t stream) {
    static int grid = 0;
    if (grid == 0) {
        if (n_in != 19 || in_sizes[0] != T * DM || out_size != T * DM || ws_size < WS_END) { fprintf(stderr, "kernel_launch: unexpected shapes (n_in %d, in0 %d, out %d, ws %zu); nothing launched\n", n_in, n_in > 0 ? in_sizes[0] : -1, out_size, ws_size); grid = -1; return; }
        int dev = 0, cus = 0, per_cu = 0;
        if (hipGetDevice(&dev) != hipSuccess || hipDeviceGetAttribute(&cus, hipDeviceAttributeMultiprocessorCount, dev) != hipSuccess) { grid = -1; return; }
        if (hipFuncSetAttribute((const void*)fwd_kernel, hipFuncAttributeMaxDynamicSharedMemorySize, LDS_BYTES) != hipSuccess) { fprintf(stderr, "kernel_launch: hipFuncSetAttribute failed\n"); grid = -1; return; }
        if (hipOccupancyMaxActiveBlocksPerMultiprocessor(&per_cu, (const void*)fwd_kernel, NTHREADS, LDS_BYTES) != hipSuccess || per_cu < 1) { fprintf(stderr, "kernel_launch: note: occupancy query says %d blocks per CU\n", per_cu); (void)hipGetLastError(); }
        grid = cus;
    }
    if (grid < 0) return;
    if (hipMemsetAsync((char*)d_ws + WS_CTL, 0, CTL_ZERO_BYTES, stream) != hipSuccess) { fprintf(stderr, "kernel_launch: memset failed\n"); return; }
    Args a{};
    for (int i = 0; i < 19; ++i) a.in[i] = (const float*)d_in[i];
    a.out = (float*)d_out; a.ws = (unsigned char*)d_ws;
    for (int i = 0; i < 32; ++i) a.inv64[i] = 1.0f / powf(10000.0f, (float)(2 * i) / 64.0f);
    for (int i = 0; i < 16; ++i) a.inv32[i] = 1.0f / powf(10000.0f, (float)(2 * i) / 32.0f);
    void* params[] = {&a};
    const hipError_t le = hipLaunchCooperativeKernel((const void*)fwd_kernel, dim3(grid), dim3(NTHREADS), params, LDS_BYTES, stream);
    if (le != hipSuccess) fprintf(stderr, "kernel_launch: cooperative launch failed: %s (grid %d)\n", hipGetErrorName(le), grid);
}
```

```cpp
#include <hip/hip_runtime.h>
#include <hip/hip_cooperative_groups.h>
#include <cstdio>
#include <cstdint>
namespace cg = cooperative_groups;
namespace pg8 {
#define PG8_LAS __attribute__((address_space(3)))
typedef unsigned short bf16_t;
typedef short bf16x8 __attribute__((ext_vector_type(8)));
typedef float f32x4 __attribute__((ext_vector_type(4)));
typedef unsigned u32x4 __attribute__((ext_vector_type(4)));
constexpr int BM = 256, BK = 64, HALF = 128, HTB = HALF * BK * 2  , STAGE_BYTES = 8 * HTB, NXCD = 8, WGM = 8;

__host__ __device__ __forceinline__ int lds_byte(int r, int c) { const int st = (r >> 4) * 2 + (c >> 5), rr = r & 15, cc = c & 31, ob = rr * 64 + cc * 2; return st * 1024 + (ob ^ (((ob >> 9) & 1) << 5)); }
__host__ __device__ __forceinline__ void stage_rc(int b, int& R, int& C) { const int st = b / 1024, sb = b % 1024, swz = sb ^ (((sb >> 9) & 1) << 5); R = (st >> 1) * 16 + swz / 64; C = (st & 1) * 32 + (swz % 64) / 2; }
__host__ __device__ __forceinline__ int perm32(int rho) { const int n = rho >> 4, i = rho & 15; return 8 * (i >> 2) + 4 * n + (i & 3); }

struct Unit { int pm, pn; };
struct Gemm { const bf16_t* A; const bf16_t* Bt; int M, N, K; };

struct StaticOrder {
    int nM, nN, nwg, G, c;
    __host__ __device__ void init(int M, int N, int G_, int c_) { nM = M / BM; nN = N / BM; nwg = nM * nN; G = G_; c = c_; }
    __host__ __device__ bool next(int i, Unit& u) const {
        const long L = (long)i * G + c; if (L >= nwg) return false;
        int wgid = (int)L; { const int q = nwg / NXCD, r = nwg % NXCD, xcd = wgid % NXCD, off = wgid / NXCD; wgid = (xcd < r ? xcd * (q + 1) : r * (q + 1) + (xcd - r) * q) + off; }
        const int nig = WGM * nN, gid = wgid / nig, fm = gid * WGM, gsz = (nM - fm) < WGM ? (nM - fm) : WGM;
        u.pm = fm + ((wgid % nig) % gsz); u.pn = (wgid % nig) / gsz; return true;
    }
    __device__ __forceinline__ void a_ready(const Unit&) const {}
    __device__ __forceinline__ void done(const Unit&) const {}
};

__device__ __forceinline__ unsigned cvt_pk_bf16(float lo, float hi) { unsigned r; asm volatile("v_cvt_pk_bf16_f32 %0, %1, %2" : "=v"(r) : "v"(lo), "v"(hi)); return r; }
typedef float f32x2 __attribute__((ext_vector_type(2)));
struct EpiZR {
    static constexpr bool PERM = true, AFTER_DRAIN = false;
    bf16_t* O; int ldc; const float* r64; const float* r32; bf16_t* aqr;
    __device__ __forceinline__ void operator()(const f32x4 (&acc)[2][2][4][2], const Unit& u, int wr, int wc, int fr_, int fq_) const {
        int fr = fr_, fq = fq_; asm volatile("" : "+v"(fr), "+v"(fq));
        const int row0 = u.pm * BM + wr * 64 + fr, col0 = u.pn * BM + wc * 32 + 8 * fq;
        constexpr unsigned long long R64 = 0xFull | (1ull << 6) | (1ull << 8) | (0xFFull << 34), R32 = 0xFFull << 10;
        const int seg0 = col0 >> 6, seg1 = (col0 + HALF) >> 6;
        const bool a64 = (R64 >> seg0) & 1ull, a32 = (R32 >> seg0) & 1ull, b64 = (R64 >> seg1) & 1ull, b32 = (R32 >> seg1) & 1ull;
        const bool any64 = a64 || b64, any32 = a32 || b32;
        const int i64 = (col0 & 63) >> 1, i32 = (col0 & 31) >> 1;
#pragma unroll
        for (int ai = 0; ai < 2; ++ai)
#pragma unroll
            for (int m = 0; m < 4; ++m) { const int row = row0 + ai * HALF + m * 16; const int pos = row & 4095; bf16_t* rowp = O + (size_t)row * ldc + col0;
                f32x4 c64a = {0.f, 0.f, 0.f, 0.f}, c64b = c64a, c32a = c64a, c32b = c64a;
                if (any64) { const float* tp = r64 + ((size_t)pos * 32 + i64) * 2; c64a = *(const f32x4*)tp; c64b = *(const f32x4*)(tp + 4); }
                if (any32) { const float* tp = r32 + ((size_t)pos * 16 + i32) * 2; c32a = *(const f32x4*)tp; c32b = *(const f32x4*)(tp + 4); }
#pragma unroll
                for (int bj = 0; bj < 2; ++bj) { const int c0 = col0 + bj * HALF, seg = bj ? seg1 : seg0;
                    const float qs = (seg < 4 || (seg >= 34 && seg < 38)) ? 0.125f * 1.4426950408889634f : (seg >= 10 && seg < 14) ? 0.17677669529663687f * 1.4426950408889634f : 1.0f;
                    f32x4 v0 = acc[ai][bj][m][0] * qs, v1 = acc[ai][bj][m][1] * qs;
                    const bool t64 = bj ? b64 : a64, t32 = bj ? b32 : a32;
                    if (t64 || t32) {
                        const f32x4 ca = t64 ? c64a : c32a, cb = t64 ? c64b : c32b;
                        const f32x4 o0 = {v0[0] * ca[0] - v0[1] * ca[1], v0[0] * ca[1] + v0[1] * ca[0], v0[2] * ca[2] - v0[3] * ca[3], v0[2] * ca[3] + v0[3] * ca[2]};
                        const f32x4 o1 = {v1[0] * cb[0] - v1[1] * cb[1], v1[0] * cb[1] + v1[1] * cb[0], v1[2] * cb[2] - v1[3] * cb[3], v1[2] * cb[3] + v1[3] * cb[2]};
                        if (seg < 4) { u32x4 wq; wq.x = cvt_pk_bf16(o0[0], o0[1]); wq.y = cvt_pk_bf16(o0[2], o0[3]); wq.z = cvt_pk_bf16(o1[0], o1[1]); wq.w = cvt_pk_bf16(o1[2], o1[3]); *(u32x4*)(aqr + (size_t)row * 256 + c0) = wq; }
                        else { v0 = o0; v1 = o1; }
                    }
                    u32x4 w; w.x = cvt_pk_bf16(v0[0], v0[1]); w.y = cvt_pk_bf16(v0[2], v0[3]); w.z = cvt_pk_bf16(v1[0], v1[1]); w.w = cvt_pk_bf16(v1[2], v1[3]);
                    *(u32x4*)(rowp + bj * HALF) = w; } }
    }
};
struct EpiRes {
    static constexpr bool PERM = false, AFTER_DRAIN = false;
    const float* base; float* out; int ldc;
    __device__ __forceinline__ void operator()(const f32x4 (&acc)[2][2][4][2], const Unit& u, int wr, int wc, int fr, int fq) const {
        const int row0 = u.pm * BM + wr * 64 + fr, col0 = u.pn * BM + wc * 32 + 4 * fq;
#pragma unroll
        for (int ai = 0; ai < 2; ++ai)
#pragma unroll
            for (int m = 0; m < 4; ++m) { const size_t off = (size_t)(row0 + ai * HALF + m * 16) * ldc + col0;
#pragma unroll
                for (int bj = 0; bj < 2; ++bj)
#pragma unroll
                    for (int n = 0; n < 2; ++n) { const size_t p = off + bj * HALF + n * 16; const f32x4 b = *(const f32x4*)(base + p); *(f32x4*)(out + p) = b + acc[ai][bj][m][n]; } }
    }
};
struct EpiSwiGLU {
    static constexpr bool PERM = true, AFTER_DRAIN = false;
    bf16_t* O; int ldc;
    __device__ __forceinline__ void operator()(const f32x4 (&acc)[2][2][4][2], const Unit& u, int wr, int wc, int fr, int fq) const {
        const int row0 = u.pm * BM + wr * 64 + fr, col0 = u.pn * HALF + wc * 32 + 8 * fq;
#pragma unroll
        for (int ai = 0; ai < 2; ++ai)
#pragma unroll
            for (int m = 0; m < 4; ++m) { const int row = row0 + ai * HALF + m * 16; bf16_t* rowp = O + (size_t)row * ldc + col0;
                float r[8];
#pragma unroll
                for (int n = 0; n < 2; ++n)
#pragma unroll
                    for (int j = 0; j < 4; ++j) { const float g = acc[ai][0][m][n][j], up = acc[ai][1][m][n][j]; r[4 * n + j] = g * __builtin_amdgcn_rcpf(1.0f + __expf(-g)) * up; }
                u32x4 w; w.x = cvt_pk_bf16(r[0], r[1]); w.y = cvt_pk_bf16(r[2], r[3]); w.z = cvt_pk_bf16(r[4], r[5]); w.w = cvt_pk_bf16(r[6], r[7]);
                *(u32x4*)rowp = w; }
    }
};
template <class Epi, class Sched, bool ALIGN_EPI = false, bool SP2 = false>
__device__ __forceinline__ void gemm_phase(PG8_LAS unsigned char* lds, const Gemm g, const Sched& S, const Epi& E) {
    int tid_ = threadIdx.x; asm volatile("" : "+v"(tid_));
    const int tid = tid_, wid = __builtin_amdgcn_readfirstlane(tid >> 6), lane = tid & 63, wr = wid >> 2, wc = wid & 3, fr = lane & 15, fq = lane >> 4;
    const int K = g.K, nt = K / BK;
    unsigned voffA[2], voffB[2];
#pragma unroll
    for (int i = 0; i < 2; ++i) { int R, C; stage_rc(tid * 16 + i * 8192, R, C); const int Rb = Epi::PERM ? ((R & ~31) + perm32(R & 31)) : R;
        voffA[i] = (unsigned)(R * K + C) * 2u; voffB[i] = (unsigned)(Rb * K + C) * 2u; }
    const size_t kstep = (size_t)(BK * 2);
    const size_t hstep = (size_t)HALF * K * 2;
    const size_t tstep = 2 * hstep;
    const unsigned ldsw = (unsigned)wid * 1024u;
    const int aoff = lds_byte(wr * 64 + fr, fq * 8), boff = lds_byte(wc * 32 + fr, fq * 8);
#define PG8_SA(b, h) (((b) * 2 + (h)) * HTB)
#define PG8_SB(b, h) ((4 + (b) * 2 + (h)) * HTB)
#define PG8_STAGE(bufoff, gbase, voff) do { _Pragma("unroll") for (int _i = 0; _i < 2; ++_i) \
        __builtin_amdgcn_global_load_lds((const unsigned*)((const char*)(gbase) + (voff)[_i]), (PG8_LAS unsigned*)(lds + (bufoff) + ldsw + _i * 8192), 16, 0, 0); } while (0)
#define PG8_LDA(dst, b, h) do { _Pragma("unroll") for (int m = 0; m < 4; ++m) _Pragma("unroll") for (int k = 0; k < 2; ++k) dst[m][k] = *(const PG8_LAS bf16x8*)(lds + PG8_SA(b, h) + aoff + m * 2048 + k * 1024); } while (0)
#define PG8_LDB(dst, b, h) do { _Pragma("unroll") for (int n = 0; n < 2; ++n) _Pragma("unroll") for (int k = 0; k < 2; ++k) dst[n][k] = *(const PG8_LAS bf16x8*)(lds + PG8_SB(b, h) + boff + n * 2048 + k * 1024); } while (0)
#define PG8_MMA(ai, bj, At, Bt) do { __builtin_amdgcn_s_setprio(1); _Pragma("unroll") for (int m = 0; m < 4; ++m) _Pragma("unroll") for (int n = 0; n < 2; ++n) _Pragma("unroll") for (int k = 0; k < 2; ++k) \
        acc[ai][bj][m][n] = __builtin_amdgcn_mfma_f32_16x16x32_bf16(Bt[n][k], At[m][k], acc[ai][bj][m][n], 0, 0, 0); __builtin_amdgcn_s_setprio(0); } while (0)
#define PG8_WAIT_V(n) asm volatile("s_waitcnt vmcnt(" #n ")" ::: "memory")
#define PG8_WAIT_L(n) asm volatile("s_waitcnt lgkmcnt(" #n ")" ::: "memory")
#define PG8_BAR __builtin_amdgcn_s_barrier()
#define PG8_SCHED __builtin_amdgcn_sched_barrier(0)
    Unit cur, nxt; int ui = 0;
    if (!S.next(0, cur)) return;
    f32x4 acc[2][2][4][2];
#pragma unroll
    for (int a = 0; a < 2; ++a)
#pragma unroll
        for (int b = 0; b < 2; ++b)
#pragma unroll
            for (int m = 0; m < 4; ++m)
#pragma unroll
                for (int n = 0; n < 2; ++n) acc[a][b][m][n] = (f32x4){0.f, 0.f, 0.f, 0.f};
    bf16x8 At[4][2], B0[2][2], B1[2][2];
    const char* cA = (const char*)g.A + (size_t)cur.pm * tstep; const char* cB = (const char*)g.Bt + (size_t)cur.pn * tstep;
    S.a_ready(cur);
    if constexpr (SP2) {
        PG8_STAGE(PG8_SB(0, 0), cB, voffB); PG8_STAGE(PG8_SB(0, 1), cB + hstep, voffB); PG8_STAGE(PG8_SA(0, 0), cA, voffA); PG8_STAGE(PG8_SA(0, 1), cA + hstep, voffA);
        if (wr == 1) PG8_BAR;
        PG8_WAIT_V(2); PG8_BAR;
        PG8_STAGE(PG8_SB(1, 0), cB + kstep, voffB); PG8_STAGE(PG8_SA(1, 0), cA + kstep, voffA); PG8_STAGE(PG8_SB(1, 1), cB + hstep + kstep, voffB);
        PG8_WAIT_V(6); PG8_BAR;
    } else {
        PG8_STAGE(PG8_SB(0, 0), cB, voffB); PG8_STAGE(PG8_SA(0, 0), cA, voffA); PG8_STAGE(PG8_SB(0, 1), cB + hstep, voffB); PG8_STAGE(PG8_SA(0, 1), cA + hstep, voffA);
        if (wr == 1) PG8_BAR;
        PG8_WAIT_V(4); PG8_BAR;
        PG8_STAGE(PG8_SB(1, 0), cB + kstep, voffB); PG8_STAGE(PG8_SA(1, 0), cA + kstep, voffA); PG8_STAGE(PG8_SB(1, 1), cB + hstep + kstep, voffB);
        PG8_WAIT_V(6); PG8_BAR;
    }
    for (;;) {
        const bool has_next = S.next(ui + 1, nxt);
        const char* nA = has_next ? (const char*)g.A + (size_t)nxt.pm * tstep : cA; const char* nB = has_next ? (const char*)g.Bt + (size_t)nxt.pn * tstep : cB;
        for (int t = 0; t < nt; t += 2) {
            const bool last = (t == nt - 2);
            const char* a1 = cA + (size_t)(t + 1) * kstep;
            const char* a2 = last ? nA : cA + (size_t)(t + 2) * kstep; const char* b2 = last ? nB : cB + (size_t)(t + 2) * kstep;
            const char* a3 = a2 + kstep; const char* b3 = b2 + kstep;
            if (last && has_next) S.a_ready(nxt);
            if constexpr (SP2) {
            PG8_LDB(B0, 0, 0); PG8_LDB(B1, 0, 1); PG8_SCHED; PG8_LDA(At, 0, 0); PG8_STAGE(PG8_SA(1, 1), a1 + hstep, voffA);
            PG8_WAIT_V(8); PG8_WAIT_L(0); PG8_BAR; PG8_MMA(0, 0, At, B0); PG8_MMA(0, 1, At, B1); PG8_BAR; PG8_SCHED;
            PG8_LDA(At, 0, 1); PG8_STAGE(PG8_SB(0, 0), b2, voffB); PG8_STAGE(PG8_SB(0, 1), b2 + hstep, voffB); PG8_STAGE(PG8_SA(0, 0), a2, voffA);
            PG8_WAIT_V(8); PG8_WAIT_L(0); PG8_BAR; PG8_MMA(1, 0, At, B0); PG8_MMA(1, 1, At, B1); PG8_BAR; PG8_SCHED;
            PG8_LDB(B0, 1, 0); PG8_LDB(B1, 1, 1); PG8_SCHED; PG8_LDA(At, 1, 0); PG8_STAGE(PG8_SA(0, 1), a2 + hstep, voffA);
            PG8_WAIT_V(8); PG8_WAIT_L(0); PG8_BAR; PG8_MMA(0, 0, At, B0); PG8_MMA(0, 1, At, B1); PG8_BAR; PG8_SCHED;
            PG8_LDA(At, 1, 1); PG8_STAGE(PG8_SB(1, 0), b3, voffB); PG8_STAGE(PG8_SB(1, 1), b3 + hstep, voffB); PG8_STAGE(PG8_SA(1, 0), a3, voffA);
            PG8_WAIT_V(8); PG8_WAIT_L(0); PG8_BAR; PG8_MMA(1, 0, At, B0); PG8_MMA(1, 1, At, B1); PG8_BAR; PG8_SCHED;
            } else {
            PG8_LDB(B0, 0, 0); PG8_SCHED; PG8_LDA(At, 0, 0); PG8_STAGE(PG8_SA(1, 1), a1 + hstep, voffA);
            PG8_WAIT_L(8); PG8_BAR; PG8_WAIT_L(0); PG8_MMA(0, 0, At, B0); PG8_BAR; PG8_SCHED;
            PG8_LDB(B1, 0, 1); PG8_STAGE(PG8_SB(0, 0), b2, voffB);
            PG8_BAR; PG8_WAIT_L(0); PG8_MMA(0, 1, At, B1); PG8_BAR;
            PG8_LDA(At, 0, 1); PG8_STAGE(PG8_SA(0, 0), a2, voffA);
            PG8_BAR; PG8_WAIT_L(0); PG8_MMA(1, 0, At, B0); PG8_BAR; PG8_SCHED;
            PG8_STAGE(PG8_SB(0, 1), b2 + hstep, voffB);
            PG8_WAIT_V(6); PG8_BAR; PG8_MMA(1, 1, At, B1); PG8_BAR;
            PG8_LDB(B0, 1, 0); PG8_SCHED; PG8_LDA(At, 1, 0); PG8_STAGE(PG8_SA(0, 1), a2 + hstep, voffA);
            PG8_WAIT_L(8); PG8_BAR; PG8_WAIT_L(0); PG8_MMA(0, 0, At, B0); PG8_BAR; PG8_SCHED;
            PG8_LDB(B1, 1, 1); PG8_STAGE(PG8_SB(1, 0), b3, voffB);
            PG8_BAR; PG8_WAIT_L(0); PG8_MMA(0, 1, At, B1); PG8_BAR;
            PG8_LDA(At, 1, 1); PG8_STAGE(PG8_SA(1, 0), a3, voffA);
            PG8_BAR; PG8_WAIT_L(0); PG8_MMA(1, 0, At, B0); PG8_BAR; PG8_SCHED;
            PG8_STAGE(PG8_SB(1, 1), b3 + hstep, voffB);
            PG8_WAIT_V(6); PG8_BAR; PG8_MMA(1, 1, At, B1); PG8_BAR;
            }
        }
        if constexpr (ALIGN_EPI) { if (wr == 0) PG8_BAR; }
        if constexpr (!Epi::AFTER_DRAIN) { E(acc, cur, wr, wc, fr, fq); S.done(cur); }
        if (!has_next) break;
#pragma unroll
        for (int a = 0; a < 2; ++a)
#pragma unroll
            for (int b = 0; b < 2; ++b)
#pragma unroll
                for (int m = 0; m < 4; ++m)
#pragma unroll
                    for (int n = 0; n < 2; ++n) acc[a][b][m][n] = (f32x4){0.f, 0.f, 0.f, 0.f};
        cur = nxt; cA = nA; cB = nB; ++ui;
        if constexpr (ALIGN_EPI) { if (wr == 1) PG8_BAR; }
    }
    PG8_WAIT_V(0);
    if constexpr (!ALIGN_EPI) { if (wr == 0) PG8_BAR; }
    PG8_BAR;
    if constexpr (Epi::AFTER_DRAIN) { E.fused(acc, cur, wr, wc, fr, fq, lds, wid, lane); S.done(cur); }
#undef PG8_SA
#undef PG8_SB
#undef PG8_STAGE
#undef PG8_LDA
#undef PG8_LDB
#undef PG8_MMA
#undef PG8_WAIT_V
#undef PG8_WAIT_L
#undef PG8_BAR
#undef PG8_SCHED
}
}

constexpr int NB = 4, SEQ = 4096, T = NB * SEQ, DM = 1024, DIN = 2964, DINP = 3072, DFF = 2816, DEPTH = 2;
constexpr int NWAVES = 8, NTHREADS = 512;
constexpr float EPS = 1e-6f;
constexpr int ZAQ = 0, ZKC = 256, ZVC = 320, ZKS = 384, ZVS = 448, ZKW = 512, ZVW = 576, ZBQ = 640, ZBK = 896, ZBV = 1152,
              ZCU = 1408, ZCV = 1664, ZCO = 1920, ZDQ = 2176, ZDK = 2432, ZDV = 2688, ZAG = 2944, ZCI = 2956, ZCF = 2960;
__host__ __device__ __forceinline__ int pi64(int p) { return (p & 1) ? 32 + (p >> 1) : (p >> 1); }
__host__ __device__ __forceinline__ int pi32(int p) { return (p & 1) ? 16 + (p >> 1) : (p >> 1); }
__host__ __device__ __forceinline__ int zsrc(int n) {
    const int seg = n >> 6, p = n & 63;
    const bool r64 = seg < 4 || seg == 6 || seg == 8 || (seg >= 34 && seg < 42), r32 = seg >= 10 && seg < 18;
    const int q = r64 ? pi64(p) : r32 ? (p & 32) + pi32(p & 31) : p; const int m = seg * 64 + q;
    if (m < 640) return m;
    if (m < 1920) return m + 12;
    if (m < 2944) return m + 20;
    if (m < 2956) return m - 2944 + 640;
    if (m < 2960) return m - 2956 + 1932;
    if (m < 2964) return m - 2960 + 1936;
    return -1;
}
constexpr size_t MiB = 1u << 20;
constexpr size_t WS_CTL = 0, CTL_ZERO_BYTES = 1 * MiB;
constexpr size_t WS_WIN = 2 * MiB, WS_WOUT = 8 * MiB, WS_WGU = 10 * MiB, WS_WD = 21 * MiB;
constexpr size_t WS_ROPE64 = 27 * MiB, WS_ROPE32 = 28 * MiB;
constexpr size_t WS_KC = 29 * MiB, WS_VC = WS_KC + 256 * 1024;
constexpr size_t WS_SEL = WS_VC + 256 * 1024;
constexpr size_t WS_BCUM = 30 * MiB, WS_IG = WS_BCUM + 256 * 1024, WS_NLOC = WS_IG + 256 * 1024;
constexpr size_t WS_ACH = WS_NLOC + 256 * 1024, WS_MLOC = WS_ACH + 4096, WS_MIN = WS_MLOC + 4096;
constexpr size_t WS_WCT = 26 * MiB + 512 * 1024;
constexpr size_t WS_CBP = 28 * MiB + 512 * 1024;
constexpr size_t WS_DLSE = 31 * MiB;
constexpr size_t WS_H = 32 * MiB;
constexpr size_t WS_Z = 64 * MiB;
constexpr size_t WS_XB2 = 64 * MiB, WS_ACT = 96 * MiB;
constexpr size_t WS_AQR = 160 * MiB, WS_OCMP = 168 * MiB, WS_DPART = 176 * MiB;
constexpr size_t WS_MQ = 200 * MiB, WS_MK = 216 * MiB, WS_CLOC = 232 * MiB, WS_END = 248 * MiB;
constexpr int CW_BAR = 4096;
constexpr int CW_Q = 16384;
constexpr int RING_BYTES = 131072, LDSCTL_OFF = RING_BYTES, MISC_OFF = LDSCTL_OFF + 320, LDS_BYTES = 147456;

#define GAS __attribute__((address_space(1)))
#define LAS __attribute__((address_space(3)))
typedef unsigned short bf16;
typedef unsigned v4u __attribute__((ext_vector_type(4)));
typedef unsigned v2u __attribute__((ext_vector_type(2)));
typedef float f32x4 __attribute__((ext_vector_type(4)));
typedef float f32x2 __attribute__((ext_vector_type(2)));
#define LDS_WAIT() asm volatile("s_waitcnt lgkmcnt(0)" ::: "memory")
#define VM_WAIT() asm volatile("s_waitcnt vmcnt(0)" ::: "memory")
__device__ __forceinline__ unsigned f2bf(float f) { unsigned u = __builtin_bit_cast(unsigned, f); return (u + 0x7fffu + ((u >> 16) & 1u)) >> 16; }
__device__ __forceinline__ unsigned pk2(float lo, float hi) { return f2bf(lo) | (f2bf(hi) << 16); }
__device__ __forceinline__ float bf2f(bf16 u) { return __uint_as_float(((unsigned)u) << 16); }
__device__ __forceinline__ float bflo(unsigned w) { return __uint_as_float(w << 16); }
__device__ __forceinline__ float bfhi(unsigned w) { return __uint_as_float(w & 0xffff0000u); }
template <int K> __device__ __forceinline__ int sx_i(int v) {
    if constexpr (K == 1) return __builtin_amdgcn_update_dpp(v, v, 0xB1, 0xF, 0xF, false);
    else if constexpr (K == 2) return __builtin_amdgcn_update_dpp(v, v, 0x4E, 0xF, 0xF, false);
    else return __builtin_amdgcn_ds_swizzle(v, (K << 10) | 0x1f);
}
template <int K> __device__ __forceinline__ float sx(float v) { return __builtin_bit_cast(float, sx_i<K>(__builtin_bit_cast(int, v))); }
__device__ __forceinline__ void swap32(unsigned v, unsigned& a, unsigned& b) { unsigned w = v; asm volatile("" : "+v"(w)); const auto rr = __builtin_amdgcn_permlane32_swap(v, w, false, false); a = rr[0]; b = rr[1]; }
__device__ __forceinline__ float sum32(float v) { unsigned a, b; swap32(__builtin_bit_cast(unsigned, v), a, b); return __builtin_bit_cast(float, a) + __builtin_bit_cast(float, b); }
__device__ __forceinline__ float max32(float v) { unsigned a, b; swap32(__builtin_bit_cast(unsigned, v), a, b); return fmaxf(__builtin_bit_cast(float, a), __builtin_bit_cast(float, b)); }
__device__ __forceinline__ unsigned or32(unsigned v) { unsigned a, b; swap32(v, a, b); return a | b; }
__device__ __forceinline__ float lane_get(float v, int src) { return __builtin_bit_cast(float, __builtin_amdgcn_ds_bpermute(src << 2, __builtin_bit_cast(int, v))); }
__device__ __forceinline__ float wave_sum(float v) { v += sx<1>(v); v += sx<2>(v); v += sx<4>(v); v += sx<8>(v); v += sx<16>(v); return sum32(v); }
__device__ __forceinline__ float wave_max(float v) { v = fmaxf(v, sx<1>(v)); v = fmaxf(v, sx<2>(v)); v = fmaxf(v, sx<4>(v)); v = fmaxf(v, sx<8>(v)); v = fmaxf(v, sx<16>(v)); return max32(v); }
__device__ __forceinline__ float sigmoidf_(float x) { return 1.0f / (1.0f + __expf(-x)); }
#define XB_TMO      128
#define XB_XCNT(j)  (256  + 64 * (j))
#define XB_XSUB(j)  (1280 + 64 * (j))
#define XB_XGEN(j)  (2304 + 64 * (j))
#define XB_TOP      3328
#define XB_TOPGEN   3392
#define XCD_BAR_WORDS 3456
#define XB_SPIN_CAP (1u << 18)

__device__ __forceinline__ unsigned xb_ld(unsigned* p)              { return __hip_atomic_load(p, __ATOMIC_RELAXED, __HIP_MEMORY_SCOPE_AGENT); }
__device__ __forceinline__ unsigned xb_add(unsigned* p, unsigned v) { return __hip_atomic_fetch_add(p, v, __ATOMIC_RELAXED, __HIP_MEMORY_SCOPE_AGENT); }
__device__ __forceinline__ unsigned xb_xcc_id() { return (unsigned)__builtin_amdgcn_s_getreg((3 << 11) | 20) & 0xFu; }
#define XB_SPIN(cond, bar) do { unsigned _sp = 0; while (cond) { __builtin_amdgcn_s_sleep(1); \
    if ((++_sp & 255u) == 0u) { if (xb_ld(&(bar)[XB_TMO])) break; if (_sp > XB_SPIN_CAP) { atomicAdd(&(bar)[XB_TMO], 1u); break; } } } } while (0)

struct XcdBarrier {
    unsigned* bar; unsigned x;
    volatile LAS unsigned* st;
};

__device__ __forceinline__ XcdBarrier xcd_barrier_post(unsigned* bar, volatile LAS unsigned* st) {
    XcdBarrier b; b.bar = bar; b.x = xb_xcc_id(); b.st = st;
    if (threadIdx.x == 0) (void)xb_add(&bar[XB_XCNT(b.x)], 1u);
    return b;
}
__device__ __forceinline__ void xcd_barrier_complete(unsigned* bar, unsigned x, unsigned& nloc, unsigned& nx) {
    const unsigned G = gridDim.x * gridDim.y * gridDim.z;
    unsigned sum, cnt, mine, sp = 0u;
    for (;;) {
        sum = 0u; cnt = 0u; mine = 0u;
#pragma unroll 1
        for (unsigned j = 0; j < 16; ++j) { const unsigned c = xb_ld(&bar[XB_XCNT(j)]); sum += c; cnt += (c > 0u) ? 1u : 0u; mine = (j == x) ? c : mine; }
        if (sum == G) break;
        __builtin_amdgcn_s_sleep(1);
        if ((++sp & 255u) == 0u) { if (xb_ld(&bar[XB_TMO])) break; if (sp > XB_SPIN_CAP) { atomicAdd(&bar[XB_TMO], 1u); break; } }
    }
    nloc = mine > 0u ? mine : 1u; nx = cnt > 0u ? cnt : 1u;
}

__device__ __forceinline__ void xcd_barrier(const XcdBarrier& b) {
    asm volatile("s_waitcnt vmcnt(0)" ::: "memory");
    __syncthreads();
    if (threadIdx.x == 0) {
        unsigned* bar = b.bar;
        __builtin_amdgcn_s_waitcnt(0);
        unsigned nloc = b.st[0], nx = b.st[1];
        if (nloc == 0u) { xcd_barrier_complete(bar, b.x, nloc, nx); b.st[0] = nloc; b.st[1] = nx; }
        const unsigned old = xb_add(&bar[XB_XSUB(b.x)], 1u);
        const unsigned gen = old / nloc;
        if (old + 1u == (gen + 1u) * nloc) {
            __builtin_amdgcn_fence(__ATOMIC_RELEASE, "agent");
            asm volatile("s_waitcnt vmcnt(0)" ::: "memory");
            const unsigned og = xb_add(&bar[XB_TOP], 1u);
            const unsigned tg = og / nx;
            if (og + 1u == (tg + 1u) * nx) xb_add(&bar[XB_TOPGEN], 1u);
            else XB_SPIN(xb_ld(&bar[XB_TOPGEN]) == tg, bar);
            __builtin_amdgcn_fence(__ATOMIC_ACQUIRE, "agent");
            xb_add(&bar[XB_XGEN(b.x)], 1u);
            asm volatile("s_waitcnt vmcnt(0)" ::: "memory");
        } else {
            XB_SPIN(xb_ld(&bar[XB_XGEN(b.x)]) == gen, bar);
            __builtin_amdgcn_fence(__ATOMIC_ACQUIRE, "agent");
            asm volatile("s_waitcnt vmcnt(0)" ::: "memory");
        }
    }
    __syncthreads();
}

struct Args { const float* in[19]; float* out; unsigned char* ws; float inv64[32]; float inv32[16]; };
struct Frame {
    unsigned char* lds;
    LAS unsigned char* lds3;
    volatile LAS unsigned* MISC;
    unsigned* ctl;
    unsigned char* ws;
    int tid, lane, wave, G, gw, ngw;
    unsigned long long pt0, pdt;
};
#define PHASE_IDS(F) do { int t_ = threadIdx.x; asm volatile("" : "+v"(t_)); (F).tid = t_; (F).lane = t_ & 63; (F).wave = __builtin_amdgcn_readfirstlane(t_ >> 6); (F).gw = blockIdx.x * NWAVES + (F).wave; } while (0)


__device__ __forceinline__ void transpose_item(const float* W, int K, int N, int srccol  , bf16* WT, int n0, int k0, float* scr, int lane, const float* gain = nullptr  ) {
#pragma unroll
    for (int i = 0; i < 32; ++i) { const int kk = 2 * i + (lane >> 5); scr[kk * 33 + (lane & 31)] = srccol >= 0 ? W[(size_t)(k0 + kk) * N + srccol] * (gain ? gain[k0 + kk] : 1.0f) : 0.f; }
    LDS_WAIT(); asm volatile("" ::: "memory");
    const int c = lane & 7;
#pragma unroll
    for (int j = 0; j < 4; ++j) { const int n = (lane >> 3) + 8 * j; const float* s = scr + (8 * c) * 33 + n;
        v4u o; o.x = pk2(s[0 * 33], s[1 * 33]); o.y = pk2(s[2 * 33], s[3 * 33]); o.z = pk2(s[4 * 33], s[5 * 33]); o.w = pk2(s[6 * 33], s[7 * 33]);
        *(v4u*)(WT + (size_t)(n0 + n) * K + k0 + 8 * c) = o; }
    LDS_WAIT(); asm volatile("" ::: "memory");
}
template <class CMap>
__device__ __forceinline__ void convert_tile(Frame& F, const float* W, int N, int K, int k0, int scol0, bf16* WT, int n0, CMap cmap) {
    bf16* Tl = (bf16*)F.lds;
    const int t = F.tid;
    f32x4 v[8];
#pragma unroll
    for (int i = 0; i < 8; ++i) v[i] = *(const f32x4*)(W + (size_t)(k0 + 16 * i + (t >> 5)) * N + scol0 + (t & 31) * 4);
    __syncthreads();
#pragma unroll
    for (int i = 0; i < 8; ++i) { v2u w; w.x = pk2(v[i].x, v[i].y); w.y = pk2(v[i].z, v[i].w); *(v2u*)(Tl + (16 * i + (t >> 5)) * 136 + (t & 31) * 4) = w; }
    __syncthreads();
    const int n = t >> 2, kq = (t & 3) * 32, sc = cmap(n);
    const bf16* src = Tl + kq * 136 + sc; unsigned wv[16];
#pragma unroll
    for (int j = 0; j < 16; ++j) wv[j] = (unsigned)src[(2 * j) * 136] | ((unsigned)src[(2 * j + 1) * 136] << 16);
    v4u* dst = (v4u*)(WT + (size_t)(n0 + n) * K + k0 + kq);
#pragma unroll
    for (int j = 0; j < 4; ++j) dst[j] = (v4u){wv[4 * j], wv[4 * j + 1], wv[4 * j + 2], wv[4 * j + 3]};
}
__device__ __forceinline__ void convert_weights(Frame& F, const Args& a, int layer) {
    PHASE_IDS(F);
    const float* w_in = a.in[2] + (size_t)layer * DM * DIN; const float* w_out = a.in[13] + (size_t)layer * DM * DM;
    const float* w_gate = a.in[15] + (size_t)layer * DM * DFF; const float* w_up = a.in[16] + (size_t)layer * DM * DFF; const float* w_down = a.in[17] + (size_t)layer * DFF * DM;
    bf16* WIN = (bf16*)(F.ws + WS_WIN); bf16* WOUT = (bf16*)(F.ws + WS_WOUT); bf16* WGU = (bf16*)(F.ws + WS_WGU); bf16* WD = (bf16*)(F.ws + WS_WD);
    constexpr int B_IN = 8 * 23, B_OUT = 8 * 8, B_GU = 8 * 44, B_D = 22 * 8, NB_ITEMS = B_IN + B_OUT + B_GU + B_D;
    for (int it = blockIdx.x; it < NB_ITEMS; it += F.G) {
        int r = it;
        if (r < B_IN) { const int kt = r / 23, nt = r % 23, n0 = nt * 128, shift = n0 < 640 ? 0 : n0 < 1920 ? 12 : 20;
            convert_tile(F, w_in, DIN, DM, kt * 128, n0 + shift, WIN, n0, [=](int n) { return zsrc(n0 + n) - (n0 + shift); }); continue; } r -= B_IN;
        if (r < B_OUT) { const int kt = r >> 3, nt = r & 7; convert_tile(F, w_out, DM, DM, kt * 128, nt * 128, WOUT, nt * 128, [](int n) { return n; }); continue; } r -= B_OUT;
        if (r < B_GU) { const int kt = r / 44, nt = r % 44, n0 = nt * 128, pn = n0 >> 8; convert_tile(F, (n0 & 128) ? w_up : w_gate, DFF, DM, kt * 128, 128 * pn, WGU, n0, [](int n) { return n; }); continue; } r -= B_GU;
        { const int kt = r >> 3, nt = r & 7; convert_tile(F, w_down, DM, DFF, kt * 128, nt * 128, WD, nt * 128, [](int n) { return n; }); }
    }
    __syncthreads();
    float* scr = (float*)(F.lds + 40960 + F.wave * 8704);
    constexpr int I_IN = (DM / 64) * 4, I_C = 2 * (2048 / 64) * (64 / 32), I_CB = 64, NITEMS = I_IN + I_C + I_CB;
    const float* cmp_w = a.in[4] + (size_t)layer * 2 * 2048 * 64; const float* cmp_pos = a.in[3] + (size_t)layer * 2 * 2048; bf16* WCT = (bf16*)(F.ws + WS_WCT); float* CBP = (float*)(F.ws + WS_CBP);
    for (int it = F.gw; it < NITEMS; it += F.ngw) {
        int r = it; const int l31 = F.lane & 31;
        if (r < I_IN) { const int kb = r >> 2, nb = 92 + (r & 3); transpose_item(w_in, DM, DIN, zsrc(nb * 32 + l31), WIN, nb * 32, kb * 64, scr, F.lane); continue; } r -= I_IN;
        if (r < I_C) { const int br = r >> 6, q = r & 63, kb = q >> 1, nb = q & 1; transpose_item(cmp_w + (size_t)br * 2048 * 64, 2048, 64, br == 0 ? pi64(nb * 32 + l31) : nb * 32 + l31, WCT + (size_t)br * 64 * 2048, nb * 32, kb * 64, scr, F.lane); continue; } r -= I_C;
        { const int br = r >> 5, ch = r & 31; float acc = 0.f;
#pragma unroll 8
          for (int k = ch * 64; k < ch * 64 + 64; ++k) acc += cmp_pos[br * 2048 + k] * cmp_w[((size_t)br * 2048 + k) * 64 + F.lane];
          CBP[(br * 32 + ch) * 64 + F.lane] = acc; }
    }
}
__device__ __forceinline__ void sincos_d(float ang, float& c, float& s) {
    const double a = (double)ang; const double q = __builtin_rint(a * 0.63661977236758134308); const double r = a - q * 1.57079632679489661923; const double r2 = r * r;
    double sp = -1.0 / 39916800.0; sp = sp * r2 + 1.0 / 362880.0; sp = sp * r2 - 1.0 / 5040.0; sp = sp * r2 + 1.0 / 120.0; sp = sp * r2 - 1.0 / 6.0; sp = sp * r2 + 1.0; sp *= r;
    double cp = 1.0 / 479001600.0; cp = cp * r2 - 1.0 / 3628800.0; cp = cp * r2 + 1.0 / 40320.0; cp = cp * r2 - 1.0 / 720.0; cp = cp * r2 + 1.0 / 24.0; cp = cp * r2 - 0.5; cp = cp * r2 + 1.0;
    const int n = ((int)q) & 3; const double cc = (n == 0) ? cp : (n == 1) ? -sp : (n == 2) ? -cp : sp; const double ss = (n == 0) ? sp : (n == 1) ? cp : (n == 2) ? -sp : -cp;
    c = (float)cc; s = (float)ss;
}
__device__ __forceinline__ void build_rope(Frame& F, const Args& a) {
    PHASE_IDS(F);
    f32x2* R64 = (f32x2*)(F.ws + WS_ROPE64); f32x2* R32 = (f32x2*)(F.ws + WS_ROPE32);
    const int gt = F.gw * 64 + F.lane, ngt = F.ngw * 64;
    for (int i = gt; i < SEQ * 48; i += ngt) { const int pos = i / 48, j = i % 48; float c, s;
        if (j < 32) { sincos_d((float)pos * a.inv64[j], c, s); R64[pos * 32 + j] = (f32x2){c, s}; }
        else { sincos_d((float)pos * a.inv32[j - 32], c, s); R32[pos * 16 + (j - 32)] = (f32x2){c, s}; } }
}
__device__ __forceinline__ void norm_rows_bf16(Frame& F, const float* X, const float* g, bf16* H) {
    PHASE_IDS(F);
    f32x4 gg[4];
#pragma unroll
    for (int j = 0; j < 4; ++j) gg[j] = ((const f32x4*)g)[64 * j + F.lane];
    for (int row0 = F.gw * 4; row0 < T; row0 += F.ngw * 4) {
        f32x4 v[4][4];
#pragma unroll
        for (int r = 0; r < 4; ++r)
#pragma unroll
            for (int j = 0; j < 4; ++j) v[r][j] = ((const f32x4*)(X + (size_t)(row0 + r) * DM))[64 * j + F.lane];
#pragma unroll
        for (int r = 0; r < 4; ++r) { float q = 0.f;
#pragma unroll
            for (int j = 0; j < 4; ++j) q += (v[r][j].x * v[r][j].x + v[r][j].y * v[r][j].y) + (v[r][j].z * v[r][j].z + v[r][j].w * v[r][j].w);
            const float rr = 1.0f / sqrtf(wave_sum(q) * (1.0f / DM) + EPS); v2u* o = (v2u*)(H + (size_t)(row0 + r) * DM) + F.lane;
#pragma unroll
            for (int j = 0; j < 4; ++j) { v2u w; w.x = pk2(v[r][j].x * rr * gg[j].x, v[r][j].y * rr * gg[j].y); w.y = pk2(v[r][j].z * rr * gg[j].z, v[r][j].w * rr * gg[j].w); o[64 * j] = w; } }
    }
}
__device__ __forceinline__ void final_norm(Frame& F, float* X, const float* g) {
    PHASE_IDS(F);
    f32x4 gg[4];
#pragma unroll
    for (int j = 0; j < 4; ++j) gg[j] = ((const f32x4*)g)[64 * j + F.lane];
    for (int row0 = F.gw * 4; row0 < T; row0 += F.ngw * 4) {
        f32x4 v[4][4];
#pragma unroll
        for (int r = 0; r < 4; ++r)
#pragma unroll
            for (int j = 0; j < 4; ++j) v[r][j] = ((const f32x4*)(X + (size_t)(row0 + r) * DM))[64 * j + F.lane];
#pragma unroll
        for (int r = 0; r < 4; ++r) { float q = 0.f;
#pragma unroll
            for (int j = 0; j < 4; ++j) q += (v[r][j].x * v[r][j].x + v[r][j].y * v[r][j].y) + (v[r][j].z * v[r][j].z + v[r][j].w * v[r][j].w);
            const float rr = 1.0f / sqrtf(wave_sum(q) * (1.0f / DM) + EPS); f32x4* o = (f32x4*)(X + (size_t)(row0 + r) * DM) + F.lane;
#pragma unroll
            for (int j = 0; j < 4; ++j) o[64 * j] = v[r][j] * rr * gg[j]; }
    }
}

__device__ __forceinline__ void prep_compress(Frame& F, const Args& a, int layer) {
    PHASE_IDS(F);
    typedef short bf16x8 __attribute__((ext_vector_type(8)));
    const bf16* Z = (const bf16*)(F.ws + WS_Z); const bf16* WCT = (const bf16*)(F.ws + WS_WCT); const float* CBP = (const float*)(F.ws + WS_CBP);
    f32x4* red = (f32x4*)F.lds;
    const int lane = F.lane, et = F.wave & 3, kh = F.wave >> 2, r16 = lane & 15, q4 = lane >> 4;
    for (int it = blockIdx.x; it < NB * 2 * 16; it += F.G) {
        const int b = it >> 5, br = (it >> 4) & 1, n0 = (it & 15) * 16; const int zc = br ? ZVC : ZKC;
        const bf16* wrow = WCT + ((size_t)br * 64 + et * 16 + r16) * 2048 + 8 * q4;
        const int tb = 16 * (n0 + r16);
        f32x4 acc = {0.f, 0.f, 0.f, 0.f};
#pragma unroll 8
        for (int kk = kh * 32; kk < kh * 32 + 32; ++kk) {
            int tok = tb + (kk >> 1); tok = tok < SEQ ? tok : SEQ - 1;
            const bf16x8 af = *(const bf16x8*)(Z + ((size_t)b * SEQ + tok) * DINP + zc + (kk & 1) * 32 + 8 * q4);
            const bf16x8 bfr = *(const bf16x8*)(wrow + 32 * kk);
            acc = __builtin_amdgcn_mfma_f32_16x16x32_bf16(af, bfr, acc, 0, 0, 0);
        }
        __syncthreads();
        if (kh == 1) red[et * 64 + lane] = acc;
        __syncthreads();
        if (kh == 0) {
            const f32x4 o = red[et * 64 + lane]; const int e = et * 16 + r16; float bias = 0.f;
            const int es = br == 0 ? pi64(e) : e;
#pragma unroll 8
            for (int ch = 0; ch < 32; ++ch) bias += CBP[(br * 32 + ch) * 64 + es];
            bf16* O = (bf16*)(F.ws + (br ? WS_VC : WS_KC)) + (size_t)b * 256 * 64;
#pragma unroll
            for (int r = 0; r < 4; ++r) { const int n = n0 + 4 * q4 + r; O[n * 64 + e] = (bf16)((n < 255) ? f2bf(acc[r] + o[r] + bias) : 0u); }
        }
    }
    __syncthreads();
}
__device__ __forceinline__ float log_sigmoid_(float x) { return x >= 0.f ? -log1pf(__expf(-x)) : x - log1pf(__expf(x)); }
typedef float f32x16m __attribute__((ext_vector_type(16)));
__device__ __forceinline__ void mm64(f32x16m& acc, const float* ap, int as, const float* bp, int bs) {
#pragma unroll 8
    for (int kk = 0; kk < 32; ++kk) acc = __builtin_amdgcn_mfma_f32_32x32x2f32(ap[kk * as], bp[kk * bs], acc, 0, 0, 0);
}
__device__ __forceinline__ int crow32(int r, int hi) { return (r & 3) + 8 * (r >> 2) + 4 * hi; }
__device__ __forceinline__ void prep_mlstm(Frame& F, const Args& a, int layer) {
    PHASE_IDS(F);
    const bf16* Z = (const bf16*)(F.ws + WS_Z);
    float* L = (float*)F.lds; float* UC = L; float* KS = L + 4224; float* VS = L + 8448; float* WQ = L + 12672; float* WK = L + 16896; float* WE = L + 21120;
    const float* convw = a.in[7] + (size_t)layer * 4 * 256; const float* convb = a.in[8] + (size_t)layer * 256;
    const float* gb = a.in[11] + (size_t)layer * 8;
    float* MQ = (float*)(F.ws + WS_MQ); float* MK = (float*)(F.ws + WS_MK); float* CLOC = (float*)(F.ws + WS_CLOC); float* NLOC = (float*)(F.ws + WS_NLOC);
    float* BCUM = (float*)(F.ws + WS_BCUM); float* IG = (float*)(F.ws + WS_IG); float* ACH = (float*)(F.ws + WS_ACH); float* MLOC = (float*)(F.ws + WS_MLOC);
    const int lane = F.lane, r32 = lane & 31, hi = lane >> 5, w = F.wave, tl = F.tid >> 3, c8 = (F.tid & 7) * 8;
    v4u ur[4], vr; int ph = -1;
    if (w < 4) { const int itw = blockIdx.x + w * F.G;
        if (itw < 1024) { const int bh = itw >> 6, c = itw & 63, b = bh >> 2, h = bh & 3, l = lane; const size_t row = (size_t)b * SEQ + c * 64 + l; const bf16* zr = Z + row * DINP;
            const float ig = bf2f(zr[ZCI + h]) + gb[h]; float bc = log_sigmoid_(bf2f(zr[ZCF + h]) + gb[4 + h]);
#pragma unroll
            for (int o = 1; o < 64; o <<= 1) { const float v = lane_get(bc, l - o); if (l >= o) bc += v; }
            const float ach = lane_get(bc, 63); const float ge = ach - bc + ig; const float ml = wave_max(ge);
            WE[w * 64 + l] = __expf(ge - ml); BCUM[row * 4 + h] = bc; IG[row * 4 + h] = ig; if (l == 0) { ACH[itw] = ach; MLOC[itw] = ml; } } }
#define PM_LOAD(it_) do { const int bh_ = (it_) >> 6, c_ = (it_) & 63, b_ = bh_ >> 2, h_ = bh_ & 3, t_ = c_ * 64 + tl; const bf16* zb_ = Z + (size_t)b_ * SEQ * DINP; \
        _Pragma("unroll") for (int j = 0; j < 4; ++j) { const int tt_ = t_ - 3 + j; ur[j] = tt_ >= 0 ? *(const v4u*)(zb_ + (size_t)tt_ * DINP + ZCU + h_ * 64 + c8) : (v4u){0u, 0u, 0u, 0u}; } \
        vr = *(const v4u*)(zb_ + (size_t)t_ * DINP + ZCV + h_ * 64 + c8); } while (0)
    int it = blockIdx.x;
    if (it < 1024) PM_LOAD(it);
    for (int ki = 0; it < 1024; it += F.G, ++ki) {
        const int bh = it >> 6, c = it & 63, b = bh >> 2, h = bh & 3, t0 = c * 64; const size_t row0 = (size_t)b * SEQ + t0; const float* WEi = WE + ki * 64;
        __syncthreads();
        if (h != ph) { const float* wq = a.in[9] + ((size_t)layer * 4 + h) * 4096; const float* wk = a.in[10] + ((size_t)layer * 4 + h) * 4096;
            *(f32x4*)(WQ + F.tid * 8) = *(const f32x4*)(wq + F.tid * 8); *(f32x4*)(WQ + F.tid * 8 + 4) = *(const f32x4*)(wq + F.tid * 8 + 4);
            *(f32x4*)(WK + F.tid * 8) = *(const f32x4*)(wk + F.tid * 8); *(f32x4*)(WK + F.tid * 8 + 4) = *(const f32x4*)(wk + F.tid * 8 + 4); ph = h; }
        { float u[4][8], acc[8], vv[8]; const int ch = h * 64 + c8;
#pragma unroll
          for (int j = 0; j < 4; ++j) { u[j][0] = bflo(ur[j].x); u[j][1] = bfhi(ur[j].x); u[j][2] = bflo(ur[j].y); u[j][3] = bfhi(ur[j].y); u[j][4] = bflo(ur[j].z); u[j][5] = bfhi(ur[j].z); u[j][6] = bflo(ur[j].w); u[j][7] = bfhi(ur[j].w); }
          vv[0] = bflo(vr.x); vv[1] = bfhi(vr.x); vv[2] = bflo(vr.y); vv[3] = bfhi(vr.y); vv[4] = bflo(vr.z); vv[5] = bfhi(vr.z); vv[6] = bflo(vr.w); vv[7] = bfhi(vr.w);
#pragma unroll
          for (int i = 0; i < 8; ++i) acc[i] = convb[ch + i];
#pragma unroll
          for (int j = 0; j < 4; ++j)
#pragma unroll
              for (int i = 0; i < 8; ++i) acc[i] += convw[j * 256 + ch + i] * u[j][i];
#pragma unroll
          for (int i = 0; i < 8; ++i) { UC[tl * 65 + c8 + i] = acc[i] * sigmoidf_(acc[i]); VS[tl * 64 + c8 + i] = vv[i]; } }
        if (it + F.G < 1024) PM_LOAD(it + F.G);
        __syncthreads();
        { const int i0 = ((w >> 1) & 1) * 32, j0 = (w & 1) * 32; f32x16m acc;
#pragma unroll
            for (int r = 0; r < 16; ++r) acc[r] = 0.f;
            mm64(acc, UC + (i0 + r32) * 65 + hi, 2, (w < 4 ? WQ : WK) + hi * 64 + j0 + r32, 128);
            float* G = (w < 4 ? MQ : MK) + row0 * 256 + h * 64 + j0 + r32;
            if (w < 4) {
#pragma unroll
                for (int r = 0; r < 16; ++r) G[(size_t)(i0 + crow32(r, hi)) * 256] = acc[r];
            } else {
#pragma unroll
                for (int r = 0; r < 16; ++r) { const float v = acc[r] * 0.125f; const int l = i0 + crow32(r, hi); G[(size_t)l * 256] = v; KS[l * 64 + j0 + r32] = v; }
            } }
        __syncthreads();
        if (w < 4) { const int i0 = (w >> 1) * 32, j0 = (w & 1) * 32; f32x16m acc;
#pragma unroll
            for (int r = 0; r < 16; ++r) acc[r] = 0.f;
#pragma unroll 8
            for (int kk = 0; kk < 32; ++kk) { const int l = 2 * kk + hi; acc = __builtin_amdgcn_mfma_f32_32x32x2f32(VS[l * 64 + i0 + r32] * WEi[l], KS[l * 64 + j0 + r32], acc, 0, 0, 0); }
            float* G = CLOC + (size_t)it * 4096 + j0 + r32;
#pragma unroll
            for (int r = 0; r < 16; ++r) G[(i0 + crow32(r, hi)) * 64] = acc[r];
        } else if (w == 4) { float n = 0.f;
#pragma unroll 8
            for (int l = 0; l < 64; ++l) n += WEi[l] * KS[l * 64 + lane];
            NLOC[it * 64 + lane] = n; }
    }
#undef PM_LOAD
    __syncthreads();
}

__device__ __forceinline__ void ld8(const bf16* p, float* o) { const v4u w = *(const v4u*)p; o[0] = bflo(w.x); o[1] = bfhi(w.x); o[2] = bflo(w.y); o[3] = bfhi(w.y); o[4] = bflo(w.z); o[5] = bfhi(w.z); o[6] = bflo(w.w); o[7] = bfhi(w.w); }
__device__ __forceinline__ void ph_mlstm_out(Frame& F, const Args& a, int layer) {
    PHASE_IDS(F);
    const bf16* Z = (const bf16*)(F.ws + WS_Z); bf16* AO = (bf16*)(F.ws + WS_H);
    const float* MQ = (const float*)(F.ws + WS_MQ); const float* MK = (const float*)(F.ws + WS_MK); const float* CIN = (const float*)(F.ws + WS_CLOC); const float* NIN = (const float*)(F.ws + WS_NLOC);
    const float* BCUM = (const float*)(F.ws + WS_BCUM); const float* IG = (const float*)(F.ws + WS_IG); const float* MIN = (const float*)(F.ws + WS_MIN);
    const float* hg = a.in[12] + (size_t)layer * 256;
    float* L = (float*)F.lds; float* QS = L; float* KS = L + 4224; float* CS = L + 8448; float* SS = L + 12672; float* HS = L + 16896; float* VS = L + 21120;
    float* DEN = L + 25344;
    const int lane = F.lane, r32 = lane & 31, hi = lane >> 5, w = F.wave;
    const int tl = F.tid >> 3, c8 = (F.tid & 7) * 8;
    f32x4 qr[2], kr[2], cr[2]; v4u vr;
    float* G4 = DEN + 64;
    if (w < 4) { const int itw = blockIdx.x + w * F.G;
        if (itw < 1024) { const int bh = itw >> 6, c = itw & 63, b = bh >> 2, h = bh & 3, l = lane; const size_t rl = (size_t)b * SEQ + c * 64 + l;
            const float bc = BCUM[rl * 4 + h], ig = IG[rl * 4 + h], mi = MIN[itw]; float* g = G4 + 5 * 64 * w;
            g[l] = NIN[itw * 64 + l]; g[64 + l] = bc; g[128 + l] = ig;
            float pm = ig - bc;
#pragma unroll
            for (int o = 1; o < 64; o <<= 1) { const float v = lane_get(pm, l - o); if (l >= o) pm = fmaxf(pm, v); }
            const float inter = bc + mi, mt = fmaxf(inter, bc + pm); g[192 + l] = mt; g[256 + l] = __expf(inter - mt); } }
#define MO_LOAD(it_) do { const int bh_ = (it_) >> 6, c_ = (it_) & 63, b_ = bh_ >> 2, h_ = bh_ & 3; const size_t r_ = (size_t)b_ * SEQ + c_ * 64 + tl; \
        const f32x4* q_ = (const f32x4*)(MQ + r_ * 256 + h_ * 64 + c8); const f32x4* k_ = (const f32x4*)(MK + r_ * 256 + h_ * 64 + c8); const f32x4* c_p = (const f32x4*)(CIN + (size_t)(it_) * 4096 + tl * 64 + c8); \
        qr[0] = q_[0]; qr[1] = q_[1]; kr[0] = k_[0]; kr[1] = k_[1]; cr[0] = c_p[0]; cr[1] = c_p[1]; vr = *(const v4u*)(Z + r_ * DINP + ZCV + h_ * 64 + c8); } while (0)
    int it = blockIdx.x;
    if (it < 1024) MO_LOAD(it);
    for (int ki = 0; it < 1024; it += F.G, ++ki) {
        const int bh = it >> 6, c = it & 63, b = bh >> 2, h = bh & 3; const size_t row0 = (size_t)b * SEQ + c * 64;
        const float* NI = G4 + 5 * 64 * ki; const float* BC = NI + 64; const float* IGS = BC + 64; const float* MT = IGS + 64; const float* EI = MT + 64;
        __syncthreads();
        { float* q_ = QS + tl * 65 + c8; float* k_ = KS + tl * 65 + c8; float* c_ = CS + tl * 65 + c8; float* v_ = VS + tl * 64 + c8;
#pragma unroll
          for (int i = 0; i < 4; ++i) { q_[i] = qr[0][i]; q_[4 + i] = qr[1][i]; k_[i] = kr[0][i]; k_[4 + i] = kr[1][i]; c_[i] = cr[0][i]; c_[4 + i] = cr[1][i]; }
          v_[0] = bflo(vr.x); v_[1] = bfhi(vr.x); v_[2] = bflo(vr.y); v_[3] = bfhi(vr.y); v_[4] = bflo(vr.z); v_[5] = bfhi(vr.z); v_[6] = bflo(vr.w); v_[7] = bfhi(vr.w); }
        if (it + F.G < 1024) MO_LOAD(it + F.G);
        __syncthreads();
        const int i0 = ((w >> 1) & 1) * 32, j0 = (w & 1) * 32; f32x16m acc;
#pragma unroll
        for (int r = 0; r < 16; ++r) acc[r] = 0.f;
        if (w < 4) {
            if (!(i0 == 0 && j0 == 32)) mm64(acc, QS + (i0 + r32) * 65 + hi, 2, KS + (j0 + r32) * 65 + hi, 2);
            const int s_ = j0 + r32; const float bs = IGS[s_] - BC[s_];
#pragma unroll
            for (int r = 0; r < 16; ++r) { const int t = i0 + crow32(r, hi); SS[t * 65 + s_] = (s_ <= t) ? acc[r] * __expf(BC[t] + bs - MT[t]) : 0.f; }
        } else {
            mm64(acc, QS + (i0 + r32) * 65 + hi, 2, CS + (j0 + r32) * 65 + hi, 2);
#pragma unroll
            for (int r = 0; r < 16; ++r) acc[r] *= EI[i0 + crow32(r, hi)];
        }
        __syncthreads();
        if (w >= 4) {
            mm64(acc, SS + (i0 + r32) * 65 + hi, 2, VS + hi * 64 + j0 + r32, 128);
#pragma unroll
            for (int r = 0; r < 16; ++r) HS[(i0 + crow32(r, hi)) * 65 + j0 + r32] = acc[r];
        } else if (w == 0) { const int t = lane; float nq = 0.f, ssum = 0.f;
#pragma unroll 8
            for (int k = 0; k < 64; ++k) { nq += NI[k] * QS[t * 65 + k]; ssum += SS[t * 65 + k]; }
            const float den = EI[t] * nq + ssum; DEN[t] = 1.0f / fmaxf(fabsf(den), __expf(-MT[t])); }
        __syncthreads();
        { const int t = F.tid >> 3, vg = (F.tid & 7) * 8; const float rd = DEN[t]; float num[8]; float sq = 0.f;
#pragma unroll
            for (int i = 0; i < 8; ++i) { num[i] = HS[t * 65 + vg + i] * rd; sq += num[i] * num[i]; }
            sq += sx<1>(sq); sq += sx<2>(sq); sq += sx<4>(sq);
            const float rn = 1.0f / sqrtf(sq * (1.0f / 64.0f) + EPS); const size_t row = row0 + t;
            float zo[8]; ld8(Z + row * DINP + ZCO + h * 64 + vg, zo);
            unsigned wv[4];
#pragma unroll
            for (int i = 0; i < 8; i += 2) { const int ch = h * 64 + vg + i; wv[i >> 1] = pk2(num[i] * rn * hg[ch] * sigmoidf_(zo[i]), num[i + 1] * rn * hg[ch + 1] * sigmoidf_(zo[i + 1])); }
            *(v4u*)(AO + row * DM + 512 + h * 64 + vg) = (v4u){wv[0], wv[1], wv[2], wv[3]}; }
    }
#undef MO_LOAD
    __syncthreads();
}

namespace fa {
typedef short bf16x8 __attribute__((ext_vector_type(8)));
typedef float f32x16 __attribute__((ext_vector_type(16)));
typedef short s16x4 __attribute__((ext_vector_type(4)));
typedef __bf16 bf16x2_t __attribute__((ext_vector_type(2)));
constexpr int KP = 144, VP = 192, KT = 64 * KP, VT = 64 * VP, BUF = KT + VT, LDS_NEED = 2 * BUF;
constexpr float LOG2E = 1.4426950408889634f, LN2 = 0.6931471805599453f;
__device__ __forceinline__ int crow(int r, int hi) { return (r & 3) + 8 * (r >> 2) + 4 * hi; }
__device__ __forceinline__ unsigned cvtpk(float lo, float hi) { f32x2 v = {lo, hi}; bf16x2_t b = __builtin_convertvector(v, bf16x2_t); return __builtin_bit_cast(unsigned, b); }
__device__ __forceinline__ s16x4 vtr(LAS unsigned char* p) { return __builtin_bit_cast(s16x4, __builtin_amdgcn_ds_read_tr16_b64_v4i16((LAS s16x4*)p)); }
__device__ __forceinline__ void load_qf(const bf16* qrow, int hi, bf16x8 (&qf)[4]) {
#pragma unroll
    for (int ks = 0; ks < 4; ++ks) qf[ks] = *(const bf16x8*)(qrow + 16 * ks + 8 * hi);
}
template <int KS0, int KS, class P, int MODE = 0>
__device__ __forceinline__ void stream(const P& p, LAS unsigned char* lds, int tid, const bf16x8 (&qf)[4], float& m_, float& l_, f32x16 (&O_)[2]) {
    constexpr float THR = 8.0f;
    float m = MODE == 1 ? m_ : 0.f, l = l_; f32x16 O[2] = {O_[0], O_[1]}; f32x16 negm, LS;
#pragma unroll
    for (int r = 0; r < 16; ++r) { negm[r] = 0.f; LS[r] = 0.f; }
    const int lane = tid & 63, r32 = lane & 31, hi = lane >> 5, g = lane >> 4, i16 = lane & 15;
    const int srow = tid >> 3, scx = tid & 7;
    const int koff = r32 * KP + hi * 16;
    const int voff = KT + ((i16 >> 2) + 4 * hi) * VP + (16 * (g & 1) + 4 * (i16 & 3)) * 2;
    const int nt = p.ntiles();
    v4u kr, vr;
#define FA_LOAD(it_) do { const bf16* kp_ = p.krow((it_), srow); const bf16* vp_ = p.vrow((it_), srow); kr = *(const v4u*)(kp_ + 8 * scx); vr = *(const v4u*)(vp_ + 8 * scx); } while (0)
#define FA_STORE(boff_) do { *(LAS v4u*)(lds + (boff_) + srow * KP + scx * 16) = kr; *(LAS v4u*)(lds + (boff_) + KT + srow * VP + scx * 16) = vr; } while (0)
    __syncthreads();
    if (nt > 0) { FA_LOAD(0); FA_STORE(0); if (nt > 1) FA_LOAD(1); }
    __syncthreads();
#pragma unroll 1
    for (int it = 0; it < nt; ++it) {
        const int bc = (it & 1) * BUF;
        if (!p.wave_skip(it)) {
            f32x16 S[2];
            { bf16x8 kf[2][KS];
#pragma unroll
              for (int st = 0; st < 2; ++st)
#pragma unroll
                  for (int k = 0; k < KS; ++k) kf[st][k] = *(LAS bf16x8*)(lds + bc + koff + st * 32 * KP + (KS0 + k) * 32);
              f32x16 cin;
              if constexpr (MODE == 1) {
#pragma unroll
                  for (int r = 0; r < 16; ++r) cin[r] = 0.f; }
              else if constexpr (P::HAS_KEEP || P::NO_REF_BLOCK) { const float c0_ = p.lane_keep(it) ? -m : -INFINITY;
#pragma unroll
                  for (int r = 0; r < 16; ++r) cin[r] = c0_; }
              else cin = negm;
#pragma unroll
              for (int st = 0; st < 2; ++st) {
                  S[st] = __builtin_amdgcn_mfma_f32_32x32x16_bf16(kf[st][0], qf[KS0], cin, 0, 0, 0);
#pragma unroll
                  for (int k = 1; k < KS; ++k) S[st] = __builtin_amdgcn_mfma_f32_32x32x16_bf16(kf[st][k], qf[KS0 + k], S[st], 0, 0, 0); } }
            s16x4 vv[2][2][2][2];
            if constexpr (MODE == 0) {
#pragma unroll
                for (int st = 0; st < 2; ++st)
#pragma unroll
                    for (int s = 0; s < 2; ++s)
#pragma unroll
                        for (int dt = 0; dt < 2; ++dt) { LAS unsigned char* vp = lds + bc + voff + (32 * st + 16 * s) * VP + dt * 64; vv[st][s][dt][0] = vtr(vp); vv[st][s][dt][1] = vtr(vp + 8 * VP); }
            }
            const int mm = p.mask_mode(it);
            if (mm) {
                int lb, ub; p.bounds(it, lb, ub); lb -= 4 * hi; ub -= 4 * hi;
                asm volatile("" : "+v"(lb), "+v"(ub));
                if (mm == 1) {
#pragma unroll
                    for (int st = 0; st < 2; ++st)
#pragma unroll
                        for (int r = 0; r < 16; ++r) { const int cc = 32 * st + (r & 3) + 8 * (r >> 2); if (cc > ub) S[st][r] = -INFINITY; }
                } else if (mm == 2) {
#pragma unroll
                    for (int st = 0; st < 2; ++st)
#pragma unroll
                        for (int r = 0; r < 16; ++r) { const int cc = 32 * st + (r & 3) + 8 * (r >> 2); if (cc < lb) S[st][r] = -INFINITY; }
                } else {
#pragma unroll
                    for (int st = 0; st < 2; ++st)
#pragma unroll
                        for (int r = 0; r < 16; ++r) { const int cc = 32 * st + (r & 3) + 8 * (r >> 2); if (cc < lb || cc > ub) S[st][r] = -INFINITY; }
                }
            }
            if constexpr (MODE == 1) {
                const float ms = m; const float il = l > 0.f ? 1.0f / l : 0.f;
#pragma unroll
                for (int st = 0; st < 2; ++st)
#pragma unroll
                    for (int rg = 0; rg < 4; ++rg) {
                        const float p0 = __builtin_amdgcn_exp2f(S[st][4 * rg] - ms) * il, p1 = __builtin_amdgcn_exp2f(S[st][4 * rg + 1] - ms) * il;
                        const float p2 = __builtin_amdgcn_exp2f(S[st][4 * rg + 2] - ms) * il, p3 = __builtin_amdgcn_exp2f(S[st][4 * rg + 3] - ms) * il;
                        float qa = p0, qb = p0 + 2.0f * (p1 + p2 + p3);
                        qa += sx<1>(qa); qa += sx<2>(qa); qb += sx<1>(qb); qb += sx<2>(qb);
                        const int jp = 8 * (2 * it + st) + 2 * rg + hi;
                        if ((r32 & 3) == 0) { p.impA[p.tokl * 65 + jp] = qa; if (jp < 63) p.impB[p.tokl * 65 + jp + 1] = qb; }
                    }
            } else {
                float tm = S[0][0];
#pragma unroll
                for (int r = 1; r < 16; ++r) tm = fmaxf(tm, S[0][r]);
#pragma unroll
                for (int r = 0; r < 16; ++r) tm = fmaxf(tm, S[1][r]);
                tm = max32(tm);
                if (__any(tm > THR)) {
                    const float dl = fmaxf(tm, 0.f), f = __builtin_amdgcn_exp2f(-dl); m += dl; LS[0] *= f;
#pragma unroll
                    for (int st = 0; st < 2; ++st)
#pragma unroll
                        for (int r = 0; r < 16; ++r) S[st][r] -= dl;
                    if constexpr (!(P::HAS_KEEP || P::NO_REF_BLOCK)) {
#pragma unroll
                        for (int r = 0; r < 16; ++r) negm[r] = -m; }
#pragma unroll
                    for (int dt = 0; dt < 2; ++dt)
#pragma unroll
                        for (int r = 0; r < 16; ++r) O[dt][r] *= f;
                }
#pragma unroll
                for (int st = 0; st < 2; ++st)
#pragma unroll
                    for (int r = 0; r < 16; ++r) S[st][r] = __builtin_amdgcn_exp2f(S[st][r]);
                const unsigned one2 = (tid & 31) == 0 ? 0x3F803F80u : 0u; const bf16x8 ones = __builtin_bit_cast(bf16x8, (v4u){one2, one2, one2, one2});
#pragma unroll
                for (int st = 0; st < 2; ++st)
#pragma unroll
                    for (int s = 0; s < 2; ++s) {
                        v4u pw; pw.x = cvtpk(S[st][8 * s], S[st][8 * s + 1]); pw.y = cvtpk(S[st][8 * s + 2], S[st][8 * s + 3]); pw.z = cvtpk(S[st][8 * s + 4], S[st][8 * s + 5]); pw.w = cvtpk(S[st][8 * s + 6], S[st][8 * s + 7]);
                        const bf16x8 pf = __builtin_bit_cast(bf16x8, pw);
#pragma unroll
                        for (int dt = 0; dt < 2; ++dt) {
                            const s16x4 v0 = vv[st][s][dt][0], v1 = vv[st][s][dt][1];
                            const bf16x8 vf = __builtin_shufflevector(v0, v1, 0, 1, 2, 3, 4, 5, 6, 7);
                            O[dt] = __builtin_amdgcn_mfma_f32_32x32x16_bf16(vf, pf, O[dt], 0, 0, 0);
                        }
                        LS = __builtin_amdgcn_mfma_f32_32x32x16_bf16(ones, pf, LS, 0, 0, 0);
                    }
            }
        }
        if (it + 1 < nt) { FA_STORE(((it + 1) & 1) * BUF); if (it + 2 < nt) FA_LOAD(it + 2); }
        __syncthreads();
    }
#undef FA_LOAD
#undef FA_STORE
    if constexpr (MODE == 0) l = LS[0];
    m_ = m; l_ = l; O_[0] = O[0]; O_[1] = O[1];
}
template <class P>
__device__ __forceinline__ void stream2(const P& p, LAS unsigned char* lds, int tid, const bf16x8 (&qf)[4], float (&m)[2], float (&l)[2], f32x16 (&O)[2][2]) {
    constexpr float THR = 8.0f; f32x16 negm; float mref = 0.f;
#pragma unroll
    for (int r = 0; r < 16; ++r) negm[r] = 0.f;
    const int lane = tid & 63, r32 = lane & 31, hi = lane >> 5, g = lane >> 4, i16 = lane & 15;
    const int srow = tid >> 3, scx = tid & 7;
    const int koff = r32 * KP + hi * 16;
    const int voff = KT + ((i16 >> 2) + 4 * hi) * VP + (16 * (g & 1) + 4 * (i16 & 3)) * 2;
    const int nt = p.ntiles();
    v4u kr, vr;
#define FA_LOAD(it_) do { const bf16* kp_ = p.krow((it_), srow); const bf16* vp_ = p.vrow((it_), srow); kr = *(const v4u*)(kp_ + 8 * scx); vr = *(const v4u*)(vp_ + 8 * scx); } while (0)
#define FA_STORE(boff_) do { *(LAS v4u*)(lds + (boff_) + srow * KP + scx * 16) = kr; *(LAS v4u*)(lds + (boff_) + KT + srow * VP + scx * 16) = vr; } while (0)
    __syncthreads();
    if (nt > 0) { FA_LOAD(0); FA_STORE(0); if (nt > 1) FA_LOAD(1); }
    __syncthreads();
#pragma unroll 1
    for (int it = 0; it < nt; ++it) {
        const int bc = (it & 1) * BUF;
        if (!p.wave_skip(it)) {
            f32x16 S[2][2];
            { bf16x8 kf[2][2][2];
#pragma unroll
              for (int c = 0; c < 2; ++c)
#pragma unroll
                  for (int st = 0; st < 2; ++st)
#pragma unroll
                      for (int k = 0; k < 2; ++k) kf[c][st][k] = *(LAS bf16x8*)(lds + bc + koff + st * 32 * KP + (2 * c + k) * 32);
#pragma unroll
              for (int st = 0; st < 2; ++st)
#pragma unroll
                  for (int c = 0; c < 2; ++c) S[c][st] = __builtin_amdgcn_mfma_f32_32x32x16_bf16(kf[c][st][0], qf[2 * c], negm, 0, 0, 0);
#pragma unroll
              for (int st = 0; st < 2; ++st)
#pragma unroll
                  for (int c = 0; c < 2; ++c) S[c][st] = __builtin_amdgcn_mfma_f32_32x32x16_bf16(kf[c][st][1], qf[2 * c + 1], S[c][st], 0, 0, 0); }
            s16x4 vv[2][2][2][2];
#pragma unroll
            for (int st = 0; st < 2; ++st)
#pragma unroll
                for (int s = 0; s < 2; ++s)
#pragma unroll
                    for (int dt = 0; dt < 2; ++dt) { LAS unsigned char* vp = lds + bc + voff + (32 * st + 16 * s) * VP + dt * 64; vv[st][s][dt][0] = vtr(vp); vv[st][s][dt][1] = vtr(vp + 8 * VP); }
            if (p.mask_mode(it)) {
                int lb, ub; p.bounds(it, lb, ub); ub -= 4 * hi; asm volatile("" : "+v"(ub));
#pragma unroll
                for (int c = 0; c < 2; ++c)
#pragma unroll
                    for (int st = 0; st < 2; ++st)
#pragma unroll
                        for (int r = 0; r < 16; ++r) { const int cc = 32 * st + (r & 3) + 8 * (r >> 2); if (cc > ub) S[c][st][r] = -INFINITY; }
            }
            float tm[2];
#pragma unroll
            for (int c = 0; c < 2; ++c) { float t_ = S[c][0][0];
#pragma unroll
                for (int r = 1; r < 16; ++r) t_ = fmaxf(t_, S[c][0][r]);
#pragma unroll
                for (int r = 0; r < 16; ++r) t_ = fmaxf(t_, S[c][1][r]);
                tm[c] = t_; }
            tm[0] = max32(tm[0]); tm[1] = max32(tm[1]);
            if (__any(tm[0] > THR || tm[1] > THR)) {
                const float dl = fmaxf(fmaxf(tm[0], tm[1]), 0.f), f = __builtin_amdgcn_exp2f(-dl); mref += dl; l[0] *= f; l[1] *= f;
#pragma unroll
                for (int r = 0; r < 16; ++r) negm[r] = -mref;
#pragma unroll
                for (int c = 0; c < 2; ++c) {
#pragma unroll
                    for (int st = 0; st < 2; ++st)
#pragma unroll
                        for (int r = 0; r < 16; ++r) S[c][st][r] -= dl;
#pragma unroll
                    for (int dt = 0; dt < 2; ++dt)
#pragma unroll
                        for (int r = 0; r < 16; ++r) O[c][dt][r] *= f; }
            }
            float ps[2] = {0.f, 0.f};
#pragma unroll
            for (int st = 0; st < 2; ++st)
#pragma unroll
                for (int r = 0; r < 16; ++r)
#pragma unroll
                    for (int c = 0; c < 2; ++c) { const float e = __builtin_amdgcn_exp2f(S[c][st][r]); S[c][st][r] = e; ps[c] += e; }
            l[0] += ps[0]; l[1] += ps[1];
#pragma unroll
            for (int st = 0; st < 2; ++st)
#pragma unroll
                for (int s = 0; s < 2; ++s) {
                    bf16x8 pf[2];
#pragma unroll
                    for (int c = 0; c < 2; ++c) { v4u pw; pw.x = cvtpk(S[c][st][8 * s], S[c][st][8 * s + 1]); pw.y = cvtpk(S[c][st][8 * s + 2], S[c][st][8 * s + 3]); pw.z = cvtpk(S[c][st][8 * s + 4], S[c][st][8 * s + 5]); pw.w = cvtpk(S[c][st][8 * s + 6], S[c][st][8 * s + 7]); pf[c] = __builtin_bit_cast(bf16x8, pw); }
#pragma unroll
                    for (int dt = 0; dt < 2; ++dt) {
                        const bf16x8 vf = __builtin_shufflevector(vv[st][s][dt][0], vv[st][s][dt][1], 0, 1, 2, 3, 4, 5, 6, 7);
#pragma unroll
                        for (int c = 0; c < 2; ++c) O[c][dt] = __builtin_amdgcn_mfma_f32_32x32x16_bf16(vf, pf[c], O[c][dt], 0, 0, 0);
                    }
                }
        }
        if (it + 1 < nt) { FA_STORE(((it + 1) & 1) * BUF); if (it + 2 < nt) FA_LOAD(it + 2); }
        __syncthreads();
    }
#undef FA_LOAD
#undef FA_STORE
    m[0] = mref; m[1] = mref;
}
__device__ __forceinline__ float finish(float l, f32x16 (&O)[2]) {
    const float lt = sum32(l); const float inv = lt > 0.f ? 1.0f / lt : 0.f;
#pragma unroll
    for (int dt = 0; dt < 2; ++dt)
#pragma unroll
        for (int r = 0; r < 16; ++r) O[dt][r] *= inv;
    return lt;
}
__device__ __forceinline__ void store_o(const f32x16 (&O)[2], bf16* out, int hi) {
#pragma unroll
    for (int dt = 0; dt < 2; ++dt)
#pragma unroll
        for (int rg = 0; rg < 4; ++rg) { v2u w; w.x = cvtpk(O[dt][4 * rg], O[dt][4 * rg + 1]); w.y = cvtpk(O[dt][4 * rg + 2], O[dt][4 * rg + 3]); *(v2u*)(out + 32 * dt + 8 * rg + 4 * hi) = w; }
}
}

struct DiffPol {
    static constexpr bool NO_REF_BLOCK = false;
    static constexpr bool HAS_KEEP = false;
    const bf16* Zb; int h, t0, wq0, tq;
    __device__ __forceinline__ int ntiles() const { return (t0 + 256) >> 6; }
    __device__ __forceinline__ const bf16* krow(int it, int r) const { return Zb + (size_t)(64 * it + r) * DINP + ZBK + 64 * h; }
    __device__ __forceinline__ const bf16* vrow(int it, int r) const { return Zb + (size_t)(64 * it + r) * DINP + ZBV + 64 * h; }
    __device__ __forceinline__ bool wave_skip(int it) const { return 64 * it > wq0 + 31; }
    __device__ __forceinline__ int mask_mode(int it) const { return 64 * it + 63 > wq0 ? 1 : 0; }
    __device__ __forceinline__ bool lane_keep(int) const { return true; }
    __device__ __forceinline__ void bounds(int it, int& lb, int& ub) const { lb = 0; ub = tq - 64 * it; }
};
__device__ __forceinline__ void diff_item(Frame& F, const Args& a, int layer, int b, int h, int qb, float lam) {
    PHASE_IDS(F);
    const bf16* Z = (const bf16*)(F.ws + WS_Z); bf16* AO = (bf16*)(F.ws + WS_H);
    const int lane = F.lane, r32 = lane & 31, hi = lane >> 5;
    DiffPol p; p.Zb = Z + (size_t)b * SEQ * DINP; p.h = h; p.t0 = 256 * qb; p.wq0 = p.t0 + 32 * F.wave; p.tq = p.wq0 + r32;
    fa::bf16x8 qf[4]; fa::load_qf(p.Zb + (size_t)p.tq * DINP + ZBQ + 64 * h, hi, qf);
    fa::f32x16 O[2][2];
#pragma unroll
    for (int c = 0; c < 2; ++c)
#pragma unroll
        for (int dt = 0; dt < 2; ++dt)
#pragma unroll
            for (int r = 0; r < 16; ++r) O[c][dt][r] = 0.f;
    { float m[2] = {-INFINITY, -INFINITY}, l[2] = {0.f, 0.f}; fa::stream2<DiffPol>(p, F.lds3, F.tid, qf, m, l, O); fa::finish(l[0], O[0]); fa::finish(l[1], O[1]); }
    const float lam_init = 0.8f - 0.6f * expf(-0.3f * (float)layer);
    const float* sg = a.in[6] + (size_t)layer * 64;
    float ss = 0.f;
#pragma unroll
    for (int dt = 0; dt < 2; ++dt)
#pragma unroll
        for (int r = 0; r < 16; ++r) { const float v = O[0][dt][r] - lam * O[1][dt][r]; O[0][dt][r] = v; ss += v * v; }
    ss = sum32(ss);
    const float rn = (1.0f / sqrtf(ss * (1.0f / 64.0f) + EPS)) * (1.0f - lam_init);
#pragma unroll
    for (int dt = 0; dt < 2; ++dt)
#pragma unroll
        for (int r = 0; r < 16; ++r) O[0][dt][r] *= rn * sg[32 * dt + fa::crow(r, hi)];
    fa::store_o(O[0], AO + ((size_t)b * SEQ + p.tq) * DM + 256 + 64 * h, hi);
}
struct DilPol {
    static constexpr bool NO_REF_BLOCK = false;
    static constexpr bool HAS_KEEP = false;
    const bf16* Zb; int h, dil, res, it0, nt, wi0, iq;
    __device__ __forceinline__ int ntiles() const { return nt; }
    __device__ __forceinline__ const bf16* krow(int it, int r) const { const int ik = 64 * (it0 + it) + r; return Zb + (size_t)(res + dil * ik) * DINP + ZDK + 64 * h; }
    __device__ __forceinline__ const bf16* vrow(int it, int r) const { const int ik = 64 * (it0 + it) + r; return Zb + (size_t)(res + dil * ik) * DINP + ZDV + 64 * h; }
    __device__ __forceinline__ bool wave_skip(int it) const { const int k0 = 64 * (it0 + it); return k0 > wi0 + 31 || k0 + 63 < wi0 - 128; }
    __device__ __forceinline__ int mask_mode(int it) const { const int k0 = 64 * (it0 + it); return (k0 + 63 > wi0 ? 1 : 0) | (k0 < wi0 + 31 - 128 ? 2 : 0); }
    __device__ __forceinline__ bool lane_keep(int) const { return true; }
    __device__ __forceinline__ void bounds(int it, int& lb, int& ub) const { ub = iq - 64 * (it0 + it); lb = ub - 128; }
};
__device__ __forceinline__ void dil_item(Frame& F, int b, int h, int g, int res, int blk) {
    PHASE_IDS(F);
    const bf16* Z = (const bf16*)(F.ws + WS_Z); bf16* DP = (bf16*)(F.ws + WS_DPART); float* DL = (float*)(F.ws + WS_DLSE);
    const int lane = F.lane, r32 = lane & 31, hi = lane >> 5;
    DilPol p; p.Zb = Z + (size_t)b * SEQ * DINP; p.h = h; p.dil = (g == 0) ? 1 : (g == 1) ? 4 : 16; p.res = res;
    const int i0 = 256 * blk; const int t_lo = (i0 >> 6) - 2; p.it0 = t_lo < 0 ? 0 : t_lo; p.nt = (i0 >> 6) + 4 - p.it0;
    p.wi0 = i0 + 32 * F.wave; p.iq = p.wi0 + r32;
    const int tq = res + p.dil * p.iq; const size_t row = (size_t)b * SEQ + tq;
    fa::bf16x8 qf[4]; fa::load_qf(p.Zb + (size_t)tq * DINP + ZDQ + 64 * h, hi, qf);
    float m = -INFINITY, l = 0.f; fa::f32x16 O[2];
#pragma unroll
    for (int dt = 0; dt < 2; ++dt)
#pragma unroll
        for (int r = 0; r < 16; ++r) O[dt][r] = 0.f;
    fa::stream<0, 4, DilPol>(p, F.lds3, F.tid, qf, m, l, O);
    const float lt = fa::finish(l, O);
    fa::store_o(O, DP + ((size_t)g * T + row) * 256 + 64 * h, hi);
    if (hi == 0) DL[((size_t)g * T + row) * 4 + h] = (m + __log2f(lt)) * fa::LN2;
}
__device__ __forceinline__ void dil_combine(Frame& F) {
    PHASE_IDS(F);
    const bf16* DP = (const bf16*)(F.ws + WS_DPART); const float* DL = (const float*)(F.ws + WS_DLSE); bf16* AO = (bf16*)(F.ws + WS_H);
    const int gt = F.gw * 64 + F.lane, ngt = F.ngw * 64;
    for (int i = gt; i < T * 32; i += ngt) { const int row = i >> 5, c8 = (i & 31) * 8, h = c8 >> 6;
        const float l0 = DL[(size_t)row * 4 + h], l1 = DL[((size_t)T + row) * 4 + h], l2 = DL[((size_t)2 * T + row) * 4 + h];
        const float mx = fmaxf(l0, fmaxf(l1, l2)); float w0 = __expf(l0 - mx), w1 = __expf(l1 - mx), w2 = __expf(l2 - mx); const float inv = 1.0f / (w0 + w1 + w2); w0 *= inv; w1 *= inv; w2 *= inv;
        float x0[8], x1[8], x2[8]; ld8(DP + (size_t)row * 256 + c8, x0); ld8(DP + ((size_t)T + row) * 256 + c8, x1); ld8(DP + ((size_t)2 * T + row) * 256 + c8, x2);
        v4u o; o.x = pk2(w0 * x0[0] + w1 * x1[0] + w2 * x2[0], w0 * x0[1] + w1 * x1[1] + w2 * x2[1]); o.y = pk2(w0 * x0[2] + w1 * x1[2] + w2 * x2[2], w0 * x0[3] + w1 * x1[3] + w2 * x2[3]);
        o.z = pk2(w0 * x0[4] + w1 * x1[4] + w2 * x2[4], w0 * x0[5] + w1 * x1[5] + w2 * x2[5]); o.w = pk2(w0 * x0[6] + w1 * x1[6] + w2 * x2[6], w0 * x0[7] + w1 * x1[7] + w2 * x2[7]);
        *(v4u*)(AO + (size_t)row * DM + 768 + c8) = o; }
}
struct CmpPol {
    static constexpr bool NO_REF_BLOCK = false;
    static constexpr bool HAS_KEEP = false;
    const bf16* KCb; const bf16* VCb; int nt, ubg; float* impA; float* impB; int tokl; bool nov;
    __device__ __forceinline__ int ntiles() const { return nt; }
    __device__ __forceinline__ const bf16* krow(int it, int r) const { return KCb + (size_t)(64 * it + r) * 64; }
    __device__ __forceinline__ const bf16* vrow(int it, int r) const { return VCb + (size_t)(64 * it + r) * 64; }
    __device__ __forceinline__ bool wave_skip(int) const { return false; }
    __device__ __forceinline__ int mask_mode(int) const { return 1; }
    __device__ __forceinline__ bool lane_keep(int) const { return true; }
    __device__ __forceinline__ void bounds(int it, int& lb, int& ub) const { lb = 0; ub = ubg - 64 * it; }
};
struct SlcPol {
    static constexpr bool NO_REF_BLOCK = true;
    static constexpr bool HAS_KEEP = true;
    const bf16* Zb; const unsigned char* list; int nt, t, cblk; unsigned wlo, whi, mlo, mhi;
    __device__ __forceinline__ int ntiles() const { return nt; }
    __device__ __forceinline__ const bf16* krow(int it, int r) const { const int j = list[it]; return Zb + (size_t)(64 * j + r) * DINP + ZKS; }
    __device__ __forceinline__ const bf16* vrow(int it, int r) const { const int j = list[it]; return Zb + (size_t)(64 * j + r) * DINP + ZVS; }
    __device__ __forceinline__ bool wave_skip(int it) const { const int j = list[it]; return !(((j < 32) ? (wlo >> j) : (whi >> (j - 32))) & 1u); }
    __device__ __forceinline__ int mask_mode(int it) const { return (int)list[it] == cblk ? 1 : 0; }
    __device__ __forceinline__ bool lane_keep(int it) const { const int j = list[it]; return (((j < 32) ? (mlo >> j) : (mhi >> (j - 32))) & 1u) != 0u; }
    __device__ __forceinline__ void bounds(int it, int& lb, int& ub) const { const int j = list[it]; lb = 0; ub = t - 64 * j; }
};
struct WinPol {
    static constexpr bool NO_REF_BLOCK = false;
    static constexpr bool HAS_KEEP = false;
    const bf16* Zb; int jt0, nt, t, cblk;
    __device__ __forceinline__ int ntiles() const { return nt; }
    __device__ __forceinline__ const bf16* krow(int it, int r) const { return Zb + (size_t)(64 * (jt0 + it) + r) * DINP + ZKW; }
    __device__ __forceinline__ const bf16* vrow(int it, int r) const { return Zb + (size_t)(64 * (jt0 + it) + r) * DINP + ZVW; }
    __device__ __forceinline__ bool wave_skip(int) const { return false; }
    __device__ __forceinline__ int mask_mode(int it) const { const int jt = jt0 + it; return (jt == cblk ? 1 : 0) | (jt == cblk - 8 ? 2 : 0); }
    __device__ __forceinline__ bool lane_keep(int) const { return true; }
    __device__ __forceinline__ void bounds(int it, int& lb, int& ub) const { ub = t - 64 * (jt0 + it); lb = ub - 511; }
};
constexpr int NSA_IMP_OFF = 45056, NSA_ACC_OFF = 45056  , NSA_SEL_OFF = NSA_ACC_OFF + 65536, NSA_LIST_OFF = NSA_SEL_OFF + 512;
static_assert(fa::LDS_NEED <= NSA_IMP_OFF && NSA_LIST_OFF + 64 <= RING_BYTES, "NSA LDS map");
__device__ __forceinline__ void nsa_item(Frame& F, int b, int c) {
    PHASE_IDS(F);
    const bf16* Z = (const bf16*)(F.ws + WS_Z); const bf16* AQR = (const bf16*)(F.ws + WS_AQR); bf16* AO = (bf16*)(F.ws + WS_H);
    const bf16* KCB = (const bf16*)(F.ws + WS_KC) + (size_t)b * 256 * 64; const bf16* VCB = (const bf16*)(F.ws + WS_VC) + (size_t)b * 256 * 64;
    const int lane = F.lane, r32 = lane & 31, hi = lane >> 5, tokl = 8 * F.wave + (r32 >> 2), h = r32 & 3, t = 64 * c + tokl; const size_t row = (size_t)b * SEQ + t;
    const bf16* Zb = Z + (size_t)b * SEQ * DINP;
    float* impA = (float*)(F.lds + NSA_IMP_OFF); float* impB = impA + 64 * 65;
    unsigned long long* sel = (unsigned long long*)(F.lds + NSA_SEL_OFF); unsigned char* list = F.lds + NSA_LIST_OFF;
    for (int i = F.tid; i < 2 * 64 * 65; i += NTHREADS) impA[i] = 0.f;
    const bf16* zr = Zb + (size_t)t * DINP;
    const float g0 = sigmoidf_(bf2f(zr[ZAG + h])), g1 = sigmoidf_(bf2f(zr[ZAG + 4 + h])), g2 = sigmoidf_(bf2f(zr[ZAG + 8 + h]));
    fa::f32x16 acc[2], O[2];
    {
        CmpPol cp; cp.KCb = KCB; cp.VCb = VCB; cp.nt = (4 * c + 2 + 64) >> 6; cp.ubg = t >= 31 ? ((t - 31) >> 4) : -1; cp.impA = impA; cp.impB = impB; cp.tokl = tokl; cp.nov = false;
        fa::bf16x8 qf[4]; fa::load_qf(zr + ZAQ + 64 * h, hi, qf);
        float m = -INFINITY, l = 0.f;
#pragma unroll
        for (int dt = 0; dt < 2; ++dt)
#pragma unroll
            for (int r = 0; r < 16; ++r) O[dt][r] = 0.f;
        fa::stream<0, 4, CmpPol, 0>(cp, F.lds3, F.tid, qf, m, l, O);
        float lt = fa::finish(l, O);
#pragma unroll
        for (int dt = 0; dt < 2; ++dt)
#pragma unroll
            for (int r = 0; r < 16; ++r) acc[dt][r] = g0 * O[dt][r];
        cp.nov = true;
        fa::stream<0, 4, CmpPol, 1>(cp, F.lds3, F.tid, qf, m, lt, O);
    }
    __syncthreads();
    f32x4* accl = (f32x4*)(F.lds + NSA_ACC_OFF) + F.tid;
#pragma unroll 1
    for (int tk = 0; tk < 8; ++tk) {
        const int tl = 8 * F.wave + tk, j = lane; const float imp = impA[tl * 65 + j] + impB[tl * 65 + j];
        const bool forced = (j == 0) || (j <= c && j > c - 2);
        const float sc = (j > c) ? -1.0e6f : (forced ? 1.0e6f : imp);
        int rank = 0;
#pragma unroll 8
        for (int i = 0; i < 64; ++i) { const float si = lane_get(sc, i); rank += (si > sc || (si == sc && i < j)) ? 1 : 0; }
        const unsigned long long mask = __ballot(rank < 16 && j <= c);
        if (lane == 0) sel[tl] = mask;
    }
    __syncthreads();
#pragma unroll
    for (int dt = 0; dt < 2; ++dt)
#pragma unroll
        for (int q4 = 0; q4 < 4; ++q4) accl[(dt * 4 + q4) * NTHREADS] = (f32x4){acc[dt][4 * q4], acc[dt][4 * q4 + 1], acc[dt][4 * q4 + 2], acc[dt][4 * q4 + 3]};
    SlcPol sp; sp.Zb = Zb; sp.list = list; sp.t = t; sp.cblk = c;
    { const unsigned long long mk = sel[tokl]; sp.mlo = (unsigned)mk; sp.mhi = (unsigned)(mk >> 32);
      unsigned wl = sp.mlo, wh = sp.mhi; wl |= (unsigned)sx_i<4>((int)wl); wh |= (unsigned)sx_i<4>((int)wh); wl |= (unsigned)sx_i<8>((int)wl); wh |= (unsigned)sx_i<8>((int)wh); wl |= (unsigned)sx_i<16>((int)wl); wh |= (unsigned)sx_i<16>((int)wh);
      sp.wlo = __builtin_amdgcn_readfirstlane(wl); sp.whi = __builtin_amdgcn_readfirstlane(wh);
      const unsigned long long mu = sel[lane]; unsigned ul = (unsigned)mu, uh = (unsigned)(mu >> 32);
      ul |= (unsigned)sx_i<1>((int)ul); uh |= (unsigned)sx_i<1>((int)uh); ul |= (unsigned)sx_i<2>((int)ul); uh |= (unsigned)sx_i<2>((int)uh); ul |= (unsigned)sx_i<4>((int)ul); uh |= (unsigned)sx_i<4>((int)uh);
      ul |= (unsigned)sx_i<8>((int)ul); uh |= (unsigned)sx_i<8>((int)uh); ul |= (unsigned)sx_i<16>((int)ul); uh |= (unsigned)sx_i<16>((int)uh); ul = or32(ul); uh = or32(uh);
      ul = __builtin_amdgcn_readfirstlane(ul); uh = __builtin_amdgcn_readfirstlane(uh);
      const unsigned long long un = ((unsigned long long)uh << 32) | ul;
      if ((un >> lane) & 1ull) list[__popcll(un & ((1ull << lane) - 1ull))] = (unsigned char)lane;
      sp.nt = __popcll(un); }
    fa::bf16x8 qf[4]; fa::load_qf(AQR + row * 256 + 64 * h, hi, qf);
    { float m = -INFINITY, l = 0.f;
#pragma unroll
      for (int dt = 0; dt < 2; ++dt)
#pragma unroll
          for (int r = 0; r < 16; ++r) O[dt][r] = 0.f;
      fa::stream<0, 4, SlcPol, 0>(sp, F.lds3, F.tid, qf, m, l, O); fa::finish(l, O);
#pragma unroll
      for (int dt = 0; dt < 2; ++dt)
#pragma unroll
          for (int q4 = 0; q4 < 4; ++q4) { f32x4 a4 = accl[(dt * 4 + q4) * NTHREADS]; a4[0] += g1 * O[dt][4 * q4]; a4[1] += g1 * O[dt][4 * q4 + 1]; a4[2] += g1 * O[dt][4 * q4 + 2]; a4[3] += g1 * O[dt][4 * q4 + 3]; accl[(dt * 4 + q4) * NTHREADS] = a4; } }
    { WinPol wp; wp.Zb = Zb; wp.jt0 = c >= 8 ? c - 8 : 0; wp.nt = c - wp.jt0 + 1; wp.t = t; wp.cblk = c;
      float m = -INFINITY, l = 0.f;
#pragma unroll
      for (int dt = 0; dt < 2; ++dt)
#pragma unroll
          for (int r = 0; r < 16; ++r) O[dt][r] = 0.f;
      fa::stream<0, 4, WinPol, 0>(wp, F.lds3, F.tid, qf, m, l, O); fa::finish(l, O);
#pragma unroll
      for (int dt = 0; dt < 2; ++dt)
#pragma unroll
          for (int q4 = 0; q4 < 4; ++q4) { const f32x4 a4 = accl[(dt * 4 + q4) * NTHREADS]; O[dt][4 * q4] = a4[0] + g2 * O[dt][4 * q4]; O[dt][4 * q4 + 1] = a4[1] + g2 * O[dt][4 * q4 + 1]; O[dt][4 * q4 + 2] = a4[2] + g2 * O[dt][4 * q4 + 2]; O[dt][4 * q4 + 3] = a4[3] + g2 * O[dt][4 * q4 + 3]; } }
    fa::store_o(O, AO + row * DM + 64 * h, hi);
}
__device__ __forceinline__ void scan_item(Frame& F, int it) {
    PHASE_IDS(F);
    float* CLOC = (float*)(F.ws + WS_CLOC); float* NLOC = (float*)(F.ws + WS_NLOC);
    const float* ACH = (const float*)(F.ws + WS_ACH); const float* MLOC = (const float*)(F.ws + WS_MLOC); float* MIN = (float*)(F.ws + WS_MIN);
    const int bh = it >> 2, qt = it & 3; const int e0 = qt * 1024 + F.tid * 2;
    float c0 = 0.f, c1 = 0.f, nst = 0.f, mst = 0.f;
#pragma unroll 1
    for (int cb = 0; cb < 64; cb += 16) {
        f32x2 cl[16]; float ac[16], ml[16], nl[16];
#pragma unroll
        for (int u = 0; u < 16; ++u) { const int ci = bh * 64 + cb + u; cl[u] = *(const f32x2*)(CLOC + (size_t)ci * 4096 + e0); ac[u] = ACH[ci]; ml[u] = MLOC[ci]; nl[u] = (qt == 0 && F.tid < 64) ? NLOC[ci * 64 + F.tid] : 0.f; }
#pragma unroll
        for (int u = 0; u < 16; ++u) { const int ci = bh * 64 + cb + u;
            const float mn = fmaxf(ac[u] + mst, ml[u]), decay = __expf(ac[u] + mst - mn), fresh = __expf(ml[u] - mn);
            *(f32x2*)(CLOC + (size_t)ci * 4096 + e0) = (f32x2){c0, c1}; c0 = decay * c0 + fresh * cl[u].x; c1 = decay * c1 + fresh * cl[u].y;
            if (qt == 0 && F.tid < 64) { NLOC[ci * 64 + F.tid] = nst; nst = decay * nst + fresh * nl[u]; if (F.tid == 0) MIN[ci] = mst; }
            mst = mn; }
    }
}
struct QOrder { unsigned short v[64 + 256 + 256 + 768]; };
constexpr QOrder make_order() {
    QOrder o{}; int n = 0, id = 0, in = 0, big = 0; bool scans = false;
    while (id < 256 || in < 256) {
        if (!scans && big == 192) { for (int k = 0; k < 64; ++k) o.v[n++] = (unsigned short)((3 << 12) | k); scans = true; }
        const int cd = id < 256 ? 120 * (15 - id / 16 + 1) : -1, cn = in < 256 ? 16 * (63 - in / 4 + 18) : -1;
        if (cd >= cn) { o.v[n++] = (unsigned short)((0 << 12) | id); ++id; } else { o.v[n++] = (unsigned short)((1 << 12) | in); ++in; }
        ++big;
    }
    for (int k = 0; k < 768; ++k) o.v[n++] = (unsigned short)((2 << 12) | k);
    return o;
}
__device__ const QOrder g_order = make_order();
__device__ __forceinline__ void ph_d_queue(Frame& F, const Args& a, int layer) {
    PHASE_IDS(F);
    unsigned* ctr = F.ctl + CW_Q + 64 * layer;
    const float* lv = a.in[5] + (size_t)layer * 128;
    const float lam_init = 0.8f - 0.6f * expf(-0.3f * (float)layer);
    float l01 = 0.f, l23 = 0.f; if (F.lane < 32) { l01 = lv[F.lane] * lv[32 + F.lane]; l23 = lv[64 + F.lane] * lv[96 + F.lane]; }
    const float lam = expf(wave_sum(l01)) - expf(wave_sum(l23)) + lam_init;
    constexpr int NQ = 64 + 256 + 256 + 768;
    for (;;) {
        __syncthreads();
        if (F.tid == 0) F.MISC[0] = __hip_atomic_fetch_add(ctr, 1u, __ATOMIC_RELAXED, __HIP_MEMORY_SCOPE_AGENT);
        __syncthreads();
        const int qi = (int)F.MISC[0];
        if (qi >= NQ) break;
        const int e = g_order.v[qi], ty = e >> 12, id = e & 4095;
        if (ty == 3) scan_item(F, id);
        else if (ty == 0) { const int qb = 15 - (id >> 4), bh = id & 15; diff_item(F, a, layer, bh >> 2, bh & 3, qb, lam); }
        else if (ty == 1) nsa_item(F, id & 3, 63 - (id >> 2));
        else { const int bh = id & 15, k = id >> 4;
            const int g = k >> 4, j = k & 15; const int res = (g == 0) ? 0 : (g == 1) ? (j & 3) : j, blk = (g == 0) ? j : (g == 1) ? (j >> 2) : 0;
            dil_item(F, bh >> 2, bh & 3, g, res, blk); }
    }
    __syncthreads();
}

constexpr int NPHASE = 9 * DEPTH + 1;
#ifndef PH_LO
#define PH_LO 0
#endif
#ifndef PH_HI
#define PH_HI NPHASE
#endif
#define IN(k) (PH_LO <= (k) && (k) < PH_HI)
#ifdef PROBE_K
#ifndef PROBE_SUB
#define PROBE_SUB 0
#endif
#ifndef PROBE_AMP
#define PROBE_AMP 10
#endif
#define PROBE_T0(k) do { if ((k) == PROBE_K) F.pt0 = __builtin_amdgcn_s_memrealtime(); } while (0)
#define PROBE_T1(k) do { if ((k) == PROBE_K) F.pdt = __builtin_amdgcn_s_memrealtime() - F.pt0; } while (0)
#define SUBP(id, call) do { if (layer == 0 && (id) == PROBE_SUB) { F.pt0 = __builtin_amdgcn_s_memrealtime(); call; __syncthreads(); F.pdt = __builtin_amdgcn_s_memrealtime() - F.pt0; } else { call; } } while (0)
#else
#define SUBP(id, call) do { call; } while (0)
#define PROBE_T0(k) do { } while (0)
#define PROBE_T1(k) do { } while (0)
#endif
#define SEAM(k) do { if (IN(k) && (k) + 1 < PH_HI) { if ((k) == PH_LO && F.G == 0x7fffffff) cg::this_grid().sync();   xcd_barrier(bar); } } while (0)
template <int layer> __device__ __forceinline__ void run_layer(Frame& F, const Args& args, const XcdBarrier& bar) {
    float* XR = args.out;
    bf16* H = (bf16*)(F.ws + WS_H); bf16* Z = (bf16*)(F.ws + WS_Z);
    bf16* WIN = (bf16*)(F.ws + WS_WIN); bf16* WOUT = (bf16*)(F.ws + WS_WOUT); bf16* WGU = (bf16*)(F.ws + WS_WGU); bf16* WD = (bf16*)(F.ws + WS_WD);

        const int P = 9 * layer;
        bf16* XB2 = (bf16*)(F.ws + WS_XB2); bf16* ACT = (bf16*)(F.ws + WS_ACT);
        PROBE_T0(P + 0);
        if (IN(P + 0)) {
            convert_weights(F, args, layer);
            if (layer == 0) build_rope(F, args);
            norm_rows_bf16(F, layer == 0 ? args.in[0] : XR, args.in[1] + (size_t)layer * DM, H);
        }
        SEAM(P + 0); PROBE_T1(P + 0);
        PROBE_T0(P + 1);
        if (IN(P + 1)) {
            pg8::Gemm g{H, WIN, T, DINP, DM}; pg8::StaticOrder S; S.init(T, DINP, F.G, (int)blockIdx.x);
            pg8::EpiZR E{Z, DINP, (const float*)(F.ws + WS_ROPE64), (const float*)(F.ws + WS_ROPE32), (bf16*)(F.ws + WS_AQR)};
            pg8::gemm_phase<pg8::EpiZR, pg8::StaticOrder, true, true>(F.lds3, g, S, E);
        }
        SEAM(P + 1); PROBE_T1(P + 1);
        PROBE_T0(P + 2);
        if (IN(P + 2)) { SUBP(1, prep_mlstm(F, args, layer)); SUBP(2, prep_compress(F, args, layer)); }
        SEAM(P + 2); PROBE_T1(P + 2);
        PROBE_T0(P + 3);
        if (IN(P + 3)) ph_d_queue(F, args, layer);
        SEAM(P + 3); PROBE_T1(P + 3);
        PROBE_T0(P + 4);
        if (IN(P + 4)) { SUBP(4, ph_mlstm_out(F, args, layer)); SUBP(5, dil_combine(F)); }
        SEAM(P + 4); PROBE_T1(P + 4);
        PROBE_T0(P + 5);
        if (IN(P + 5)) {
            pg8::Gemm g{H, WOUT, T, DM, DM}; pg8::StaticOrder S; S.init(T, DM, F.G, (int)blockIdx.x); pg8::EpiRes E{layer == 0 ? args.in[0] : XR, XR, DM};
            pg8::gemm_phase<pg8::EpiRes, pg8::StaticOrder, true, true>(F.lds3, g, S, E);
        }
        SEAM(P + 5); PROBE_T1(P + 5);
        PROBE_T0(P + 6);
        if (IN(P + 6)) norm_rows_bf16(F, XR, args.in[14] + (size_t)layer * DM, XB2);
        SEAM(P + 6); PROBE_T1(P + 6);
        PROBE_T0(P + 7);
        if (IN(P + 7)) {
            pg8::Gemm g{XB2, WGU, T, 2 * DFF, DM}; pg8::StaticOrder S; S.init(T, 2 * DFF, F.G, (int)blockIdx.x); pg8::EpiSwiGLU E{ACT, DFF};
            pg8::gemm_phase<pg8::EpiSwiGLU, pg8::StaticOrder, true, true>(F.lds3, g, S, E);
        }
        SEAM(P + 7); PROBE_T1(P + 7);
        PROBE_T0(P + 8);
        if (IN(P + 8)) {
            pg8::Gemm g{ACT, WD, T, DM, DFF}; pg8::StaticOrder S; S.init(T, DM, F.G, (int)blockIdx.x); pg8::EpiRes E{XR, XR, DM};
            pg8::gemm_phase<pg8::EpiRes, pg8::StaticOrder, true, true>(F.lds3, g, S, E);
        }
        SEAM(P + 8); PROBE_T1(P + 8);
}
__global__ void __launch_bounds__(NTHREADS, 2) fwd_kernel(Args args) {
    extern __shared__ __attribute__((aligned(16))) unsigned char lds[];
    Frame F;
    F.lds = lds; F.lds3 = (LAS unsigned char*)lds; F.MISC = (volatile LAS unsigned*)(F.lds3 + MISC_OFF);
    F.tid = threadIdx.x; F.lane = F.tid & 63; F.wave = __builtin_amdgcn_readfirstlane(F.tid >> 6);
    F.G = gridDim.x; F.gw = blockIdx.x * NWAVES + F.wave; F.ngw = F.G * NWAVES;
    F.ws = args.ws; F.ctl = (unsigned*)(args.ws + WS_CTL);
    for (int u = F.tid; u < (LDS_BYTES - LDSCTL_OFF) / 4; u += NTHREADS) ((LAS unsigned*)(F.lds3 + LDSCTL_OFF))[u] = 0u;
    __syncthreads();
    XcdBarrier bar = xcd_barrier_post(F.ctl + CW_BAR, F.MISC + 8);
    run_layer<0>(F, args, bar);
    run_layer<1>(F, args, bar);
    if (IN(9 * DEPTH)) final_norm(F, args.out, args.in[18]);
#ifdef PROBE_K
    if (blockIdx.x == 0) { const unsigned long long te = __builtin_amdgcn_s_memrealtime(); while (__builtin_amdgcn_s_memrealtime() - te < (unsigned long long)PROBE_AMP * F.pdt) __builtin_amdgcn_s_sleep(32); }
#endif
#undef IN
#undef SEAM
}

extern "C" void kernel_launch(void* const* d_in, const int* in_sizes, int n_in, void* d_out, int out_size, void* d_ws, size_t ws_size, hipStream_t stream) {
    static int grid = 0;
    if (grid == 0) {
        if (n_in != 19 || in_sizes[0] != T * DM || out_size != T * DM || ws_size < WS_END) { fprintf(stderr, "kernel_launch: unexpected shapes (n_in %d, in0 %d, out %d, ws %zu); nothing launched\n", n_in, n_in > 0 ? in_sizes[0] : -1, out_size, ws_size); grid = -1; return; }
        int dev = 0, cus = 0, per_cu = 0;
        if (hipGetDevice(&dev) != hipSuccess || hipDeviceGetAttribute(&cus, hipDeviceAttributeMultiprocessorCount, dev) != hipSuccess) { grid = -1; return; }
        if (hipFuncSetAttribute((const void*)fwd_kernel, hipFuncAttributeMaxDynamicSharedMemorySize, LDS_BYTES) != hipSuccess) { fprintf(stderr, "kernel_launch: hipFuncSetAttribute failed\n"); grid = -1; return; }
        if (hipOccupancyMaxActiveBlocksPerMultiprocessor(&per_cu, (const void*)fwd_kernel, NTHREADS, LDS_BYTES) != hipSuccess || per_cu < 1) { fprintf(stderr, "kernel_launch: note: occupancy query says %d blocks per CU\n", per_cu); (void)hipGetLastError(); }
        grid = cus;
    }
    if (grid < 0) return;
    if (hipMemsetAsync((char*)d_ws + WS_CTL, 0, CTL_ZERO_BYTES, stream) != hipSuccess) { fprintf(stderr, "kernel_launch: memset failed\n"); return; }
    Args a{};
    for (int i = 0; i < 19; ++i) a.in[i] = (const float*)d_in[i];
    a.out = (float*)d_out; a.ws = (unsigned char*)d_ws;
    for (int i = 0; i < 32; ++i) a.inv64[i] = 1.0f / powf(10000.0f, (float)(2 * i) / 64.0f);
    for (int i = 0; i < 16; ++i) a.inv32[i] = 1.0f / powf(10000.0f, (float)(2 * i) / 32.0f);
    void* params[] = {&a};
    const hipError_t le = hipLaunchCooperativeKernel((const void*)fwd_kernel, dim3(grid), dim3(NTHREADS), params, LDS_BYTES, stream);
    if (le != hipSuccess) fprintf(stderr, "kernel_launch: cooperative launch failed: %s (grid %d)\n", hipGetErrorName(le), grid);
}
```

```cpp
#include <hip/hip_runtime.h>
#include <hip/hip_cooperative_groups.h>
#include <cstdio>
#include <cstdint>
namespace cg = cooperative_groups;
namespace pg8 {
#define PG8_LAS __attribute__((address_space(3)))
typedef unsigned short bf16_t;
typedef short bf16x8 __attribute__((ext_vector_type(8)));
typedef float f32x4 __attribute__((ext_vector_type(4)));
typedef unsigned u32x4 __attribute__((ext_vector_type(4)));
constexpr int BM = 256, BK = 64, HALF = 128, HTB = HALF * BK * 2  , STAGE_BYTES = 8 * HTB, NXCD = 8, WGM = 8;

__host__ __device__ __forceinline__ int lds_byte(int r, int c) { const int st = (r >> 4) * 2 + (c >> 5), rr = r & 15, cc = c & 31, ob = rr * 64 + cc * 2; return st * 1024 + (ob ^ (((ob >> 9) & 1) << 5)); }
__host__ __device__ __forceinline__ void stage_rc(int b, int& R, int& C) { const int st = b / 1024, sb = b % 1024, swz = sb ^ (((sb >> 9) & 1) << 5); R = (st >> 1) * 16 + swz / 64; C = (st & 1) * 32 + (swz % 64) / 2; }
__host__ __device__ __forceinline__ int perm32(int rho) { const int n = rho >> 4, i = rho & 15; return 8 * (i >> 2) + 4 * n + (i & 3); }

struct Unit { int pm, pn; };
struct Gemm { const bf16_t* A; const bf16_t* Bt; int M, N, K; };

struct StaticOrder {
    int nM, nN, nwg, G, c;
    __host__ __device__ void init(int M, int N, int G_, int c_) { nM = M / BM; nN = N / BM; nwg = nM * nN; G = G_; c = c_; }
    __host__ __device__ bool next(int i, Unit& u) const {
        const long L = (long)i * G + c; if (L >= nwg) return false;
        int wgid = (int)L; { const int q = nwg / NXCD, r = nwg % NXCD, xcd = wgid % NXCD, off = wgid / NXCD; wgid = (xcd < r ? xcd * (q + 1) : r * (q + 1) + (xcd - r) * q) + off; }
        const int nig = WGM * nN, gid = wgid / nig, fm = gid * WGM, gsz = (nM - fm) < WGM ? (nM - fm) : WGM;
        u.pm = fm + ((wgid % nig) % gsz); u.pn = (wgid % nig) / gsz; return true;
    }
    __device__ __forceinline__ void a_ready(const Unit&) const {}
    __device__ __forceinline__ void done(const Unit&) const {}
};

__device__ __forceinline__ unsigned cvt_pk_bf16(float lo, float hi) { unsigned r; asm volatile("v_cvt_pk_bf16_f32 %0, %1, %2" : "=v"(r) : "v"(lo), "v"(hi)); return r; }
typedef float f32x2 __attribute__((ext_vector_type(2)));
struct EpiZR {
    static constexpr bool PERM = true, AFTER_DRAIN = false;
    bf16_t* O; int ldc; const float* r64; const float* r32; bf16_t* aqr;
    __device__ __forceinline__ void operator()(const f32x4 (&acc)[2][2][4][2], const Unit& u, int wr, int wc, int fr_, int fq_) const {
        int fr = fr_, fq = fq_; asm volatile("" : "+v"(fr), "+v"(fq));
        const int row0 = u.pm * BM + wr * 64 + fr, col0 = u.pn * BM + wc * 32 + 8 * fq;
        constexpr unsigned long long R64 = 0xFull | (1ull << 6) | (1ull << 8) | (0xFFull << 34), R32 = 0xFFull << 10;
        const int seg0 = col0 >> 6, seg1 = (col0 + HALF) >> 6;
        const bool a64 = (R64 >> seg0) & 1ull, a32 = (R32 >> seg0) & 1ull, b64 = (R64 >> seg1) & 1ull, b32 = (R32 >> seg1) & 1ull;
        const bool any64 = a64 || b64, any32 = a32 || b32;
        const int i64 = (col0 & 63) >> 1, i32 = (col0 & 31) >> 1;
#pragma unroll
        for (int ai = 0; ai < 2; ++ai)
#pragma unroll
            for (int m = 0; m < 4; ++m) { const int row = row0 + ai * HALF + m * 16; const int pos = row & 4095; bf16_t* rowp = O + (size_t)row * ldc + col0;
                f32x4 c64a = {0.f, 0.f, 0.f, 0.f}, c64b = c64a, c32a = c64a, c32b = c64a;
                if (any64) { const float* tp = r64 + ((size_t)pos * 32 + i64) * 2; c64a = *(const f32x4*)tp; c64b = *(const f32x4*)(tp + 4); }
                if (any32) { const float* tp = r32 + ((size_t)pos * 16 + i32) * 2; c32a = *(const f32x4*)tp; c32b = *(const f32x4*)(tp + 4); }
#pragma unroll
                for (int bj = 0; bj < 2; ++bj) { const int c0 = col0 + bj * HALF, seg = bj ? seg1 : seg0;
                    const float qs = (seg < 4 || (seg >= 34 && seg < 38)) ? 0.125f * 1.4426950408889634f : (seg >= 10 && seg < 14) ? 0.17677669529663687f * 1.4426950408889634f : 1.0f;
                    f32x4 v0 = acc[ai][bj][m][0] * qs, v1 = acc[ai][bj][m][1] * qs;
                    const bool t64 = bj ? b64 : a64, t32 = bj ? b32 : a32;
                    if (t64 || t32) {
                        const f32x4 ca = t64 ? c64a : c32a, cb = t64 ? c64b : c32b;
                        const f32x4 o0 = {v0[0] * ca[0] - v0[1] * ca[1], v0[0] * ca[1] + v0[1] * ca[0], v0[2] * ca[2] - v0[3] * ca[3], v0[2] * ca[3] + v0[3] * ca[2]};
                        const f32x4 o1 = {v1[0] * cb[0] - v1[1] * cb[1], v1[0] * cb[1] + v1[1] * cb[0], v1[2] * cb[2] - v1[3] * cb[3], v1[2] * cb[3] + v1[3] * cb[2]};
                        if (seg < 4) { u32x4 wq; wq.x = cvt_pk_bf16(o0[0], o0[1]); wq.y = cvt_pk_bf16(o0[2], o0[3]); wq.z = cvt_pk_bf16(o1[0], o1[1]); wq.w = cvt_pk_bf16(o1[2], o1[3]); *(u32x4*)(aqr + (size_t)row * 256 + c0) = wq; }
                        else { v0 = o0; v1 = o1; }
                    }
                    u32x4 w; w.x = cvt_pk_bf16(v0[0], v0[1]); w.y = cvt_pk_bf16(v0[2], v0[3]); w.z = cvt_pk_bf16(v1[0], v1[1]); w.w = cvt_pk_bf16(v1[2], v1[3]);
                    *(u32x4*)(rowp + bj * HALF) = w; } }
    }
};
struct EpiRes {
    static constexpr bool PERM = false, AFTER_DRAIN = false;
    const float* base; float* out; int ldc;
    __device__ __forceinline__ void operator()(const f32x4 (&acc)[2][2][4][2], const Unit& u, int wr, int wc, int fr, int fq) const {
        const int row0 = u.pm * BM + wr * 64 + fr, col0 = u.pn * BM + wc * 32 + 4 * fq;
#pragma unroll
        for (int ai = 0; ai < 2; ++ai)
#pragma unroll
            for (int m = 0; m < 4; ++m) { const size_t off = (size_t)(row0 + ai * HALF + m * 16) * ldc + col0;
#pragma unroll
                for (int bj = 0; bj < 2; ++bj)
#pragma unroll
                    for (int n = 0; n < 2; ++n) { const size_t p = off + bj * HALF + n * 16; const f32x4 b = *(const f32x4*)(base + p); *(f32x4*)(out + p) = b + acc[ai][bj][m][n]; } }
    }
};
struct EpiSwiGLU {
    static constexpr bool PERM = true, AFTER_DRAIN = false;
    bf16_t* O; int ldc;
    __device__ __forceinline__ void operator()(const f32x4 (&acc)[2][2][4][2], const Unit& u, int wr, int wc, int fr, int fq) const {
        const int row0 = u.pm * BM + wr * 64 + fr, col0 = u.pn * HALF + wc * 32 + 8 * fq;
#pragma unroll
        for (int ai = 0; ai < 2; ++ai)
#pragma unroll
            for (int m = 0; m < 4; ++m) { const int row = row0 + ai * HALF + m * 16; bf16_t* rowp = O + (size_t)row * ldc + col0;
                float r[8];
#pragma unroll
                for (int n = 0; n < 2; ++n)
#pragma unroll
                    for (int j = 0; j < 4; ++j) { const float g = acc[ai][0][m][n][j], up = acc[ai][1][m][n][j]; r[4 * n + j] = g * __builtin_amdgcn_rcpf(1.0f + __expf(-g)) * up; }
                u32x4 w; w.x = cvt_pk_bf16(r[0], r[1]); w.y = cvt_pk_bf16(r[2], r[3]); w.z = cvt_pk_bf16(r[4], r[5]); w.w = cvt_pk_bf16(r[6], r[7]);
                *(u32x4*)rowp = w; }
    }
};
template <class Epi, class Sched, bool ALIGN_EPI = false, bool SP2 = false>
__device__ __forceinline__ void gemm_phase(PG8_LAS unsigned char* lds, const Gemm g, const Sched& S, const Epi& E) {
    int tid_ = threadIdx.x; asm volatile("" : "+v"(tid_));
    const int tid = tid_, wid = __builtin_amdgcn_readfirstlane(tid >> 6), lane = tid & 63, wr = wid >> 2, wc = wid & 3, fr = lane & 15, fq = lane >> 4;
    const int K = g.K, nt = K / BK;
    unsigned voffA[2], voffB[2];
#pragma unroll
    for (int i = 0; i < 2; ++i) { int R, C; stage_rc(tid * 16 + i * 8192, R, C); const int Rb = Epi::PERM ? ((R & ~31) + perm32(R & 31)) : R;
        voffA[i] = (unsigned)(R * K + C) * 2u; voffB[i] = (unsigned)(Rb * K + C) * 2u; }
    const size_t kstep = (size_t)(BK * 2);
    const size_t hstep = (size_t)HALF * K * 2;
    const size_t tstep = 2 * hstep;
    const unsigned ldsw = (unsigned)wid * 1024u;
    const int aoff = lds_byte(wr * 64 + fr, fq * 8), boff = lds_byte(wc * 32 + fr, fq * 8);
#define PG8_SA(b, h) (((b) * 2 + (h)) * HTB)
#define PG8_SB(b, h) ((4 + (b) * 2 + (h)) * HTB)
#define PG8_STAGE(bufoff, gbase, voff) do { _Pragma("unroll") for (int _i = 0; _i < 2; ++_i) \
        __builtin_amdgcn_global_load_lds((const unsigned*)((const char*)(gbase) + (voff)[_i]), (PG8_LAS unsigned*)(lds + (bufoff) + ldsw + _i * 8192), 16, 0, 0); } while (0)
#define PG8_LDA(dst, b, h) do { _Pragma("unroll") for (int m = 0; m < 4; ++m) _Pragma("unroll") for (int k = 0; k < 2; ++k) dst[m][k] = *(const PG8_LAS bf16x8*)(lds + PG8_SA(b, h) + aoff + m * 2048 + k * 1024); } while (0)
#define PG8_LDB(dst, b, h) do { _Pragma("unroll") for (int n = 0; n < 2; ++n) _Pragma("unroll") for (int k = 0; k < 2; ++k) dst[n][k] = *(const PG8_LAS bf16x8*)(lds + PG8_SB(b, h) + boff + n * 2048 + k * 1024); } while (0)
#define PG8_MMA(ai, bj, At, Bt) do { __builtin_amdgcn_s_setprio(1); _Pragma("unroll") for (int m = 0; m < 4; ++m) _Pragma("unroll") for (int n = 0; n < 2; ++n) _Pragma("unroll") for (int k = 0; k < 2; ++k) \
        acc[ai][bj][m][n] = __builtin_amdgcn_mfma_f32_16x16x32_bf16(Bt[n][k], At[m][k], acc[ai][bj][m][n], 0, 0, 0); __builtin_amdgcn_s_setprio(0); } while (0)
#define PG8_WAIT_V(n) asm volatile("s_waitcnt vmcnt(" #n ")" ::: "memory")
#define PG8_WAIT_L(n) asm volatile("s_waitcnt lgkmcnt(" #n ")" ::: "memory")
#define PG8_BAR __builtin_amdgcn_s_barrier()
#define PG8_SCHED __builtin_amdgcn_sched_barrier(0)
    Unit cur, nxt; int ui = 0;
    if (!S.next(0, cur)) return;
    f32x4 acc[2][2][4][2];
#pragma unroll
    for (int a = 0; a < 2; ++a)
#pragma unroll
        for (int b = 0; b < 2; ++b)
#pragma unroll
            for (int m = 0; m < 4; ++m)
#pragma unroll
                for (int n = 0; n < 2; ++n) acc[a][b][m][n] = (f32x4){0.f, 0.f, 0.f, 0.f};
    bf16x8 At[4][2], B0[2][2], B1[2][2];
    const char* cA = (const char*)g.A + (size_t)cur.pm * tstep; const char* cB = (const char*)g.Bt + (size_t)cur.pn * tstep;
    S.a_ready(cur);
    if constexpr (SP2) {
        PG8_STAGE(PG8_SB(0, 0), cB, voffB); PG8_STAGE(PG8_SB(0, 1), cB + hstep, voffB); PG8_STAGE(PG8_SA(0, 0), cA, voffA); PG8_STAGE(PG8_SA(0, 1), cA + hstep, voffA);
        if (wr == 1) PG8_BAR;
        PG8_WAIT_V(2); PG8_BAR;
        PG8_STAGE(PG8_SB(1, 0), cB + kstep, voffB); PG8_STAGE(PG8_SA(1, 0), cA + kstep, voffA); PG8_STAGE(PG8_SB(1, 1), cB + hstep + kstep, voffB);
        PG8_WAIT_V(6); PG8_BAR;
    } else {
        PG8_STAGE(PG8_SB(0, 0), cB, voffB); PG8_STAGE(PG8_SA(0, 0), cA, voffA); PG8_STAGE(PG8_SB(0, 1), cB + hstep, voffB); PG8_STAGE(PG8_SA(0, 1), cA + hstep, voffA);
        if (wr == 1) PG8_BAR;
        PG8_WAIT_V(4); PG8_BAR;
        PG8_STAGE(PG8_SB(1, 0), cB + kstep, voffB); PG8_STAGE(PG8_SA(1, 0), cA + kstep, voffA); PG8_STAGE(PG8_SB(1, 1), cB + hstep + kstep, voffB);
        PG8_WAIT_V(6); PG8_BAR;
    }
    for (;;) {
        const bool has_next = S.next(ui + 1, nxt);
        const char* nA = has_next ? (const char*)g.A + (size_t)nxt.pm * tstep : cA; const char* nB = has_next ? (const char*)g.Bt + (size_t)nxt.pn * tstep : cB;
        for (int t = 0; t < nt; t += 2) {
            const bool last = (t == nt - 2);
            const char* a1 = cA + (size_t)(t + 1) * kstep;
            const char* a2 = last ? nA : cA + (size_t)(t + 2) * kstep; const char* b2 = last ? nB : cB + (size_t)(t + 2) * kstep;
            const char* a3 = a2 + kstep; const char* b3 = b2 + kstep;
            if (last && has_next) S.a_ready(nxt);
            if constexpr (SP2) {
            PG8_LDB(B0, 0, 0); PG8_LDB(B1, 0, 1); PG8_SCHED; PG8_LDA(At, 0, 0); PG8_STAGE(PG8_SA(1, 1), a1 + hstep, voffA);
            PG8_WAIT_V(8); PG8_WAIT_L(0); PG8_BAR; PG8_MMA(0, 0, At, B0); PG8_MMA(0, 1, At, B1); PG8_BAR; PG8_SCHED;
            PG8_LDA(At, 0, 1); PG8_STAGE(PG8_SB(0, 0), b2, voffB); PG8_STAGE(PG8_SB(0, 1), b2 + hstep, voffB); PG8_STAGE(PG8_SA(0, 0), a2, voffA);
            PG8_WAIT_V(8); PG8_WAIT_L(0); PG8_BAR; PG8_MMA(1, 0, At, B0); PG8_MMA(1, 1, At, B1); PG8_BAR; PG8_SCHED;
            PG8_LDB(B0, 1, 0); PG8_LDB(B1, 1, 1); PG8_SCHED; PG8_LDA(At, 1, 0); PG8_STAGE(PG8_SA(0, 1), a2 + hstep, voffA);
            PG8_WAIT_V(8); PG8_WAIT_L(0); PG8_BAR; PG8_MMA(0, 0, At, B0); PG8_MMA(0, 1, At, B1); PG8_BAR; PG8_SCHED;
            PG8_LDA(At, 1, 1); PG8_STAGE(PG8_SB(1, 0), b3, voffB); PG8_STAGE(PG8_SB(1, 1), b3 + hstep, voffB); PG8_STAGE(PG8_SA(1, 0), a3, voffA);
            PG8_WAIT_V(8); PG8_WAIT_L(0); PG8_BAR; PG8_MMA(1, 0, At, B0); PG8_MMA(1, 1, At, B1); PG8_BAR; PG8_SCHED;
            } else {
            PG8_LDB(B0, 0, 0); PG8_SCHED; PG8_LDA(At, 0, 0); PG8_STAGE(PG8_SA(1, 1), a1 + hstep, voffA);
            PG8_WAIT_L(8); PG8_BAR; PG8_WAIT_L(0); PG8_MMA(0, 0, At, B0); PG8_BAR; PG8_SCHED;
            PG8_LDB(B1, 0, 1); PG8_STAGE(PG8_SB(0, 0), b2, voffB);
            PG8_BAR; PG8_WAIT_L(0); PG8_MMA(0, 1, At, B1); PG8_BAR;
            PG8_LDA(At, 0, 1); PG8_STAGE(PG8_SA(0, 0), a2, voffA);
            PG8_BAR; PG8_WAIT_L(0); PG8_MMA(1, 0, At, B0); PG8_BAR; PG8_SCHED;
            PG8_STAGE(PG8_SB(0, 1), b2 + hstep, voffB);
            PG8_WAIT_V(6); PG8_BAR; PG8_MMA(1, 1, At, B1); PG8_BAR;
            PG8_LDB(B0, 1, 0); PG8_SCHED; PG8_LDA(At, 1, 0); PG8_STAGE(PG8_SA(0, 1), a2 + hstep, voffA);
            PG8_WAIT_L(8); PG8_BAR; PG8_WAIT_L(0); PG8_MMA(0, 0, At, B0); PG8_BAR; PG8_SCHED;
            PG8_LDB(B1, 1, 1); PG8_STAGE(PG8_SB(1, 0), b3, voffB);
            PG8_BAR; PG8_WAIT_L(0); PG8_MMA(0, 1, At, B1); PG8_BAR;
            PG8_LDA(At, 1, 1); PG8_STAGE(PG8_SA(1, 0), a3, voffA);
            PG8_BAR; PG8_WAIT_L(0); PG8_MMA(1, 0, At, B0); PG8_BAR; PG8_SCHED;
            PG8_STAGE(PG8_SB(1, 1), b3 + hstep, voffB);
            PG8_WAIT_V(6); PG8_BAR; PG8_MMA(1, 1, At, B1); PG8_BAR;
            }
        }
        if constexpr (ALIGN_EPI) { if (wr == 0) PG8_BAR; }
        if constexpr (!Epi::AFTER_DRAIN) { E(acc, cur, wr, wc, fr, fq); S.done(cur); }
        if (!has_next) break;
#pragma unroll
        for (int a = 0; a < 2; ++a)
#pragma unroll
            for (int b = 0; b < 2; ++b)
#pragma unroll
                for (int m = 0; m < 4; ++m)
#pragma unroll
                    for (int n = 0; n < 2; ++n) acc[a][b][m][n] = (f32x4){0.f, 0.f, 0.f, 0.f};
        cur = nxt; cA = nA; cB = nB; ++ui;
        if constexpr (ALIGN_EPI) { if (wr == 1) PG8_BAR; }
    }
    PG8_WAIT_V(0);
    if constexpr (!ALIGN_EPI) { if (wr == 0) PG8_BAR; }
    PG8_BAR;
    if constexpr (Epi::AFTER_DRAIN) { E.fused(acc, cur, wr, wc, fr, fq, lds, wid, lane); S.done(cur); }
#undef PG8_SA
#undef PG8_SB
#undef PG8_STAGE
#undef PG8_LDA
#undef PG8_LDB
#undef PG8_MMA
#undef PG8_WAIT_V
#undef PG8_WAIT_L
#undef PG8_BAR
#undef PG8_SCHED
}
}

constexpr int NB = 4, SEQ = 4096, T = NB * SEQ, DM = 1024, DIN = 2964, DINP = 3072, DFF = 2816, DEPTH = 2;
constexpr int NWAVES = 8, NTHREADS = 512;
constexpr float EPS = 1e-6f;
constexpr int ZAQ = 0, ZKC = 256, ZVC = 320, ZKS = 384, ZVS = 448, ZKW = 512, ZVW = 576, ZBQ = 640, ZBK = 896, ZBV = 1152,
              ZCU = 1408, ZCV = 1664, ZCO = 1920, ZDQ = 2176, ZDK = 2432, ZDV = 2688, ZAG = 2944, ZCI = 2956, ZCF = 2960;
__host__ __device__ __forceinline__ int pi64(int p) { return (p & 1) ? 32 + (p >> 1) : (p >> 1); }
__host__ __device__ __forceinline__ int pi32(int p) { return (p & 1) ? 16 + (p >> 1) : (p >> 1); }
__host__ __device__ __forceinline__ int zsrc(int n) {
    const int seg = n >> 6, p = n & 63;
    const bool r64 = seg < 4 || seg == 6 || seg == 8 || (seg >= 34 && seg < 42), r32 = seg >= 10 && seg < 18;
    const int q = r64 ? pi64(p) : r32 ? (p & 32) + pi32(p & 31) : p; const int m = seg * 64 + q;
    if (m < 640) return m;
    if (m < 1920) return m + 12;
    if (m < 2944) return m + 20;
    if (m < 2956) return m - 2944 + 640;
    if (m < 2960) return m - 2956 + 1932;
    if (m < 2964) return m - 2960 + 1936;
    return -1;
}
constexpr size_t MiB = 1u << 20;
constexpr size_t WS_CTL = 0, CTL_ZERO_BYTES = 1 * MiB;
constexpr size_t WS_WIN = 2 * MiB, WS_WOUT = 8 * MiB, WS_WGU = 10 * MiB, WS_WD = 21 * MiB;
constexpr size_t WS_ROPE64 = 27 * MiB, WS_ROPE32 = 28 * MiB;
constexpr size_t WS_KC = 29 * MiB, WS_VC = WS_KC + 256 * 1024;
constexpr size_t WS_SEL = WS_VC + 256 * 1024;
constexpr size_t WS_BCUM = 30 * MiB, WS_IG = WS_BCUM + 256 * 1024, WS_NLOC = WS_IG + 256 * 1024;
constexpr size_t WS_ACH = WS_NLOC + 256 * 1024, WS_MLOC = WS_ACH + 4096, WS_MIN = WS_MLOC + 4096;
constexpr size_t WS_WCT = 26 * MiB + 512 * 1024;
constexpr size_t WS_CBP = 28 * MiB + 512 * 1024;
constexpr size_t WS_DLSE = 31 * MiB;
constexpr size_t WS_H = 32 * MiB;
constexpr size_t WS_Z = 64 * MiB;
constexpr size_t WS_XB2 = 64 * MiB, WS_ACT = 96 * MiB;
constexpr size_t WS_AQR = 160 * MiB, WS_OCMP = 168 * MiB, WS_DPART = 176 * MiB;
constexpr size_t WS_MQ = 200 * MiB, WS_MK = 216 * MiB, WS_CLOC = 232 * MiB, WS_END = 248 * MiB;
constexpr int CW_BAR = 4096;
constexpr int CW_Q = 16384;
constexpr int RING_BYTES = 131072, LDSCTL_OFF = RING_BYTES, MISC_OFF = LDSCTL_OFF + 320, LDS_BYTES = 147456;

#define GAS __attribute__((address_space(1)))
#define LAS __attribute__((address_space(3)))
typedef unsigned short bf16;
typedef unsigned v4u __attribute__((ext_vector_type(4)));
typedef unsigned v2u __attribute__((ext_vector_type(2)));
typedef float f32x4 __attribute__((ext_vector_type(4)));
typedef float f32x2 __attribute__((ext_vector_type(2)));
#define LDS_WAIT() asm volatile("s_waitcnt lgkmcnt(0)" ::: "memory")
#define VM_WAIT() asm volatile("s_waitcnt vmcnt(0)" ::: "memory")
__device__ __forceinline__ unsigned f2bf(float f) { unsigned u = __builtin_bit_cast(unsigned, f); return (u + 0x7fffu + ((u >> 16) & 1u)) >> 16; }
__device__ __forceinline__ unsigned pk2(float lo, float hi) { return f2bf(lo) | (f2bf(hi) << 16); }
__device__ __forceinline__ float bf2f(bf16 u) { return __uint_as_float(((unsigned)u) << 16); }
__device__ __forceinline__ float bflo(unsigned w) { return __uint_as_float(w << 16); }
__device__ __forceinline__ float bfhi(unsigned w) { return __uint_as_float(w & 0xffff0000u); }
template <int K> __device__ __forceinline__ int sx_i(int v) {
    if constexpr (K == 1) return __builtin_amdgcn_update_dpp(v, v, 0xB1, 0xF, 0xF, false);
    else if constexpr (K == 2) return __builtin_amdgcn_update_dpp(v, v, 0x4E, 0xF, 0xF, false);
    else return __builtin_amdgcn_ds_swizzle(v, (K << 10) | 0x1f);
}
template <int K> __device__ __forceinline__ float sx(float v) { return __builtin_bit_cast(float, sx_i<K>(__builtin_bit_cast(int, v))); }
__device__ __forceinline__ void swap32(unsigned v, unsigned& a, unsigned& b) { unsigned w = v; asm volatile("" : "+v"(w)); const auto rr = __builtin_amdgcn_permlane32_swap(v, w, false, false); a = rr[0]; b = rr[1]; }
__device__ __forceinline__ float sum32(float v) { unsigned a, b; swap32(__builtin_bit_cast(unsigned, v), a, b); return __builtin_bit_cast(float, a) + __builtin_bit_cast(float, b); }
__device__ __forceinline__ float max32(float v) { unsigned a, b; swap32(__builtin_bit_cast(unsigned, v), a, b); return fmaxf(__builtin_bit_cast(float, a), __builtin_bit_cast(float, b)); }
__device__ __forceinline__ unsigned or32(unsigned v) { unsigned a, b; swap32(v, a, b); return a | b; }
__device__ __forceinline__ float lane_get(float v, int src) { return __builtin_bit_cast(float, __builtin_amdgcn_ds_bpermute(src << 2, __builtin_bit_cast(int, v))); }
__device__ __forceinline__ float wave_sum(float v) { v += sx<1>(v); v += sx<2>(v); v += sx<4>(v); v += sx<8>(v); v += sx<16>(v); return sum32(v); }
__device__ __forceinline__ float wave_max(float v) { v = fmaxf(v, sx<1>(v)); v = fmaxf(v, sx<2>(v)); v = fmaxf(v, sx<4>(v)); v = fmaxf(v, sx<8>(v)); v = fmaxf(v, sx<16>(v)); return max32(v); }
__device__ __forceinline__ float sigmoidf_(float x) { return 1.0f / (1.0f + __expf(-x)); }
#define XB_TMO      128
#define XB_XCNT(j)  (256  + 64 * (j))
#define XB_XSUB(j)  (1280 + 64 * (j))
#define XB_XGEN(j)  (2304 + 64 * (j))
#define XB_TOP      3328
#define XB_TOPGEN   3392
#define XCD_BAR_WORDS 3456
#define XB_SPIN_CAP (1u << 18)

__device__ __forceinline__ unsigned xb_ld(unsigned* p)              { return __hip_atomic_load(p, __ATOMIC_RELAXED, __HIP_MEMORY_SCOPE_AGENT); }
__device__ __forceinline__ unsigned xb_add(unsigned* p, unsigned v) { return __hip_atomic_fetch_add(p, v, __ATOMIC_RELAXED, __HIP_MEMORY_SCOPE_AGENT); }
__device__ __forceinline__ unsigned xb_xcc_id() { return (unsigned)__builtin_amdgcn_s_getreg((3 << 11) | 20) & 0xFu; }
#define XB_SPIN(cond, bar) do { unsigned _sp = 0; while (cond) { __builtin_amdgcn_s_sleep(1); \
    if ((++_sp & 255u) == 0u) { if (xb_ld(&(bar)[XB_TMO])) break; if (_sp > XB_SPIN_CAP) { atomicAdd(&(bar)[XB_TMO], 1u); break; } } } } while (0)

struct XcdBarrier {
    unsigned* bar; unsigned x;
    volatile LAS unsigned* st;
};

__device__ __forceinline__ XcdBarrier xcd_barrier_post(unsigned* bar, volatile LAS unsigned* st) {
    XcdBarrier b; b.bar = bar; b.x = xb_xcc_id(); b.st = st;
    if (threadIdx.x == 0) (void)xb_add(&bar[XB_XCNT(b.x)], 1u);
    return b;
}
__device__ __forceinline__ void xcd_barrier_complete(unsigned* bar, unsigned x, unsigned& nloc, unsigned& nx) {
    const unsigned G = gridDim.x * gridDim.y * gridDim.z;
    unsigned sum, cnt, mine, sp = 0u;
    for (;;) {
        sum = 0u; cnt = 0u; mine = 0u;
#pragma unroll 1
        for (unsigned j = 0; j < 16; ++j) { const unsigned c = xb_ld(&bar[XB_XCNT(j)]); sum += c; cnt += (c > 0u) ? 1u : 0u; mine = (j == x) ? c : mine; }
        if (sum == G) break;
        __builtin_amdgcn_s_sleep(1);
        if ((++sp & 255u) == 0u) { if (xb_ld(&bar[XB_TMO])) break; if (sp > XB_SPIN_CAP) { atomicAdd(&bar[XB_TMO], 1u); break; } }
    }
    nloc = mine > 0u ? mine : 1u; nx = cnt > 0u ? cnt : 1u;
}

__device__ __forceinline__ void xcd_barrier(const XcdBarrier& b) {
    asm volatile("s_waitcnt vmcnt(0)" ::: "memory");
    __syncthreads();
    if (threadIdx.x == 0) {
        unsigned* bar = b.bar;
        __builtin_amdgcn_s_waitcnt(0);
        unsigned nloc = b.st[0], nx = b.st[1];
        if (nloc == 0u) { xcd_barrier_complete(bar, b.x, nloc, nx); b.st[0] = nloc; b.st[1] = nx; }
        const unsigned old = xb_add(&bar[XB_XSUB(b.x)], 1u);
        const unsigned gen = old / nloc;
        if (old + 1u == (gen + 1u) * nloc) {
            __builtin_amdgcn_fence(__ATOMIC_RELEASE, "agent");
            asm volatile("s_waitcnt vmcnt(0)" ::: "memory");
            const unsigned og = xb_add(&bar[XB_TOP], 1u);
            const unsigned tg = og / nx;
            if (og + 1u == (tg + 1u) * nx) xb_add(&bar[XB_TOPGEN], 1u);
            else XB_SPIN(xb_ld(&bar[XB_TOPGEN]) == tg, bar);
            __builtin_amdgcn_fence(__ATOMIC_ACQUIRE, "agent");
            xb_add(&bar[XB_XGEN(b.x)], 1u);
            asm volatile("s_waitcnt vmcnt(0)" ::: "memory");
        } else {
            XB_SPIN(xb_ld(&bar[XB_XGEN(b.x)]) == gen, bar);
            __builtin_amdgcn_fence(__ATOMIC_ACQUIRE, "agent");
            asm volatile("s_waitcnt vmcnt(0)" ::: "memory");
        }
    }
    __syncthreads();
}

struct Args { const float* in[19]; float* out; unsigned char* ws; float inv64[32]; float inv32[16]; };
struct Frame {
    unsigned char* lds;
    LAS unsigned char* lds3;
    volatile LAS unsigned* MISC;
    unsigned* ctl;
    unsigned char* ws;
    int tid, lane, wave, G, gw, ngw;
    unsigned long long pt0, pdt;
};
#define PHASE_IDS(F) do { int t_ = threadIdx.x; asm volatile("" : "+v"(t_)); (F).tid = t_; (F).lane = t_ & 63; (F).wave = __builtin_amdgcn_readfirstlane(t_ >> 6); (F).gw = blockIdx.x * NWAVES + (F).wave; } while (0)


__device__ __forceinline__ void transpose_item(const float* W, int K, int N, int srccol  , bf16* WT, int n0, int k0, float* scr, int lane, const float* gain = nullptr  ) {
#pragma unroll
    for (int i = 0; i < 32; ++i) { const int kk = 2 * i + (lane >> 5); scr[kk * 33 + (lane & 31)] = srccol >= 0 ? W[(size_t)(k0 + kk) * N + srccol] * (gain ? gain[k0 + kk] : 1.0f) : 0.f; }
    LDS_WAIT(); asm volatile("" ::: "memory");
    const int c = lane & 7;
#pragma unroll
    for (int j = 0; j < 4; ++j) { const int n = (lane >> 3) + 8 * j; const float* s = scr + (8 * c) * 33 + n;
        v4u o; o.x = pk2(s[0 * 33], s[1 * 33]); o.y = pk2(s[2 * 33], s[3 * 33]); o.z = pk2(s[4 * 33], s[5 * 33]); o.w = pk2(s[6 * 33], s[7 * 33]);
        *(v4u*)(WT + (size_t)(n0 + n) * K + k0 + 8 * c) = o; }
    LDS_WAIT(); asm volatile("" ::: "memory");
}
template <class CMap>
__device__ __forceinline__ void convert_tile(Frame& F, const float* W, int N, int K, int k0, int scol0, bf16* WT, int n0, CMap cmap) {
    bf16* Tl = (bf16*)F.lds;
    const int t = F.tid;
    f32x4 v[8];
#pragma unroll
    for (int i = 0; i < 8; ++i) v[i] = *(const f32x4*)(W + (size_t)(k0 + 16 * i + (t >> 5)) * N + scol0 + (t & 31) * 4);
    __syncthreads();
#pragma unroll
    for (int i = 0; i < 8; ++i) { v2u w; w.x = pk2(v[i].x, v[i].y); w.y = pk2(v[i].z, v[i].w); *(v2u*)(Tl + (16 * i + (t >> 5)) * 136 + (t & 31) * 4) = w; }
    __syncthreads();
    const int n = t >> 2, kq = (t & 3) * 32, sc = cmap(n);
    const bf16* src = Tl + kq * 136 + sc; unsigned wv[16];
#pragma unroll
    for (int j = 0; j < 16; ++j) wv[j] = (unsigned)src[(2 * j) * 136] | ((unsigned)src[(2 * j + 1) * 136] << 16);
    v4u* dst = (v4u*)(WT + (size_t)(n0 + n) * K + k0 + kq);
#pragma unroll
    for (int j = 0; j < 4; ++j) dst[j] = (v4u){wv[4 * j], wv[4 * j + 1], wv[4 * j + 2], wv[4 * j + 3]};
}
__device__ __forceinline__ void convert_weights(Frame& F, const Args& a, int layer) {
    PHASE_IDS(F);
    const float* w_in = a.in[2] + (size_t)layer * DM * DIN; const float* w_out = a.in[13] + (size_t)layer * DM * DM;
    const float* w_gate = a.in[15] + (size_t)layer * DM * DFF; const float* w_up = a.in[16] + (size_t)layer * DM * DFF; const float* w_down = a.in[17] + (size_t)layer * DFF * DM;
    bf16* WIN = (bf16*)(F.ws + WS_WIN); bf16* WOUT = (bf16*)(F.ws + WS_WOUT); bf16* WGU = (bf16*)(F.ws + WS_WGU); bf16* WD = (bf16*)(F.ws + WS_WD);
    constexpr int B_IN = 8 * 23, B_OUT = 8 * 8, B_GU = 8 * 44, B_D = 22 * 8, NB_ITEMS = B_IN + B_OUT + B_GU + B_D;
    for (int it = blockIdx.x; it < NB_ITEMS; it += F.G) {
        int r = it;
        if (r < B_IN) { const int kt = r / 23, nt = r % 23, n0 = nt * 128, shift = n0 < 640 ? 0 : n0 < 1920 ? 12 : 20;
            convert_tile(F, w_in, DIN, DM, kt * 128, n0 + shift, WIN, n0, [=](int n) { return zsrc(n0 + n) - (n0 + shift); }); continue; } r -= B_IN;
        if (r < B_OUT) { const int kt = r >> 3, nt = r & 7; convert_tile(F, w_out, DM, DM, kt * 128, nt * 128, WOUT, nt * 128, [](int n) { return n; }); continue; } r -= B_OUT;
        if (r < B_GU) { const int kt = r / 44, nt = r % 44, n0 = nt * 128, pn = n0 >> 8; convert_tile(F, (n0 & 128) ? w_up : w_gate, DFF, DM, kt * 128, 128 * pn, WGU, n0, [](int n) { return n; }); continue; } r -= B_GU;
        { const int kt = r >> 3, nt = r & 7; convert_tile(F, w_down, DM, DFF, kt * 128, nt * 128, WD, nt * 128, [](int n) { return n; }); }
    }
    __syncthreads();
    float* scr = (float*)(F.lds + 40960 + F.wave * 8704);
    constexpr int I_IN = (DM / 64) * 4, I_C = 2 * (2048 / 64) * (64 / 32), I_CB = 64, NITEMS = I_IN + I_C + I_CB;
    const float* cmp_w = a.in[4] + (size_t)layer * 2 * 2048 * 64; const float* cmp_pos = a.in[3] + (size_t)layer * 2 * 2048; bf16* WCT = (bf16*)(F.ws + WS_WCT); float* CBP = (float*)(F.ws + WS_CBP);
    for (int it = F.gw; it < NITEMS; it += F.ngw) {
        int r = it; const int l31 = F.lane & 31;
        if (r < I_IN) { const int kb = r >> 2, nb = 92 + (r & 3); transpose_item(w_in, DM, DIN, zsrc(nb * 32 + l31), WIN, nb * 32, kb * 64, scr, F.lane); continue; } r -= I_IN;
        if (r < I_C) { const int br = r >> 6, q = r & 63, kb = q >> 1, nb = q & 1; transpose_item(cmp_w + (size_t)br * 2048 * 64, 2048, 64, br == 0 ? pi64(nb * 32 + l31) : nb * 32 + l31, WCT + (size_t)br * 64 * 2048, nb * 32, kb * 64, scr, F.lane); continue; } r -= I_C;
        { const int br = r >> 5, ch = r & 31; float acc = 0.f;
#pragma unroll 8
          for (int k = ch * 64; k < ch * 64 + 64; ++k) acc += cmp_pos[br * 2048 + k] * cmp_w[((size_t)br * 2048 + k) * 64 + F.lane];
          CBP[(br * 32 + ch) * 64 + F.lane] = acc; }
    }
}
__device__ __forceinline__ void sincos_d(float ang, float& c, float& s) {
    const double a = (double)ang; const double q = __builtin_rint(a * 0.63661977236758134308); const double r = a - q * 1.57079632679489661923; const double r2 = r * r;
    double sp = -1.0 / 39916800.0; sp = sp * r2 + 1.0 / 362880.0; sp = sp * r2 - 1.0 / 5040.0; sp = sp * r2 + 1.0 / 120.0; sp = sp * r2 - 1.0 / 6.0; sp = sp * r2 + 1.0; sp *= r;
    double cp = 1.0 / 479001600.0; cp = cp * r2 - 1.0 / 3628800.0; cp = cp * r2 + 1.0 / 40320.0; cp = cp * r2 - 1.0 / 720.0; cp = cp * r2 + 1.0 / 24.0; cp = cp * r2 - 0.5; cp = cp * r2 + 1.0;
    const int n = ((int)q) & 3; const double cc = (n == 0) ? cp : (n == 1) ? -sp : (n == 2) ? -cp : sp; const double ss = (n == 0) ? sp : (n == 1) ? cp : (n == 2) ? -sp : -cp;
    c = (float)cc; s = (float)ss;
}
__device__ __forceinline__ void build_rope(Frame& F, const Args& a) {
    PHASE_IDS(F);
    f32x2* R64 = (f32x2*)(F.ws + WS_ROPE64); f32x2* R32 = (f32x2*)(F.ws + WS_ROPE32);
    const int gt = F.gw * 64 + F.lane, ngt = F.ngw * 64;
    for (int i = gt; i < SEQ * 48; i += ngt) { const int pos = i / 48, j = i % 48; float c, s;
        if (j < 32) { sincos_d((float)pos * a.inv64[j], c, s); R64[pos * 32 + j] = (f32x2){c, s}; }
        else { sincos_d((float)pos * a.inv32[j - 32], c, s); R32[pos * 16 + (j - 32)] = (f32x2){c, s}; } }
}
__device__ __forceinline__ void norm_rows_bf16(Frame& F, const float* X, const float* g, bf16* H) {
    PHASE_IDS(F);
    f32x4 gg[4];
#pragma unroll
    for (int j = 0; j < 4; ++j) gg[j] = ((const f32x4*)g)[64 * j + F.lane];
    for (int row0 = F.gw * 4; row0 < T; row0 += F.ngw * 4) {
        f32x4 v[4][4];
#pragma unroll
        for (int r = 0; r < 4; ++r)
#pragma unroll
            for (int j = 0; j < 4; ++j) v[r][j] = ((const f32x4*)(X + (size_t)(row0 + r) * DM))[64 * j + F.lane];
#pragma unroll
        for (int r = 0; r < 4; ++r) { float q = 0.f;
#pragma unroll
            for (int j = 0; j < 4; ++j) q += (v[r][j].x * v[r][j].x + v[r][j].y * v[r][j].y) + (v[r][j].z * v[r][j].z + v[r][j].w * v[r][j].w);
            const float rr = 1.0f / sqrtf(wave_sum(q) * (1.0f / DM) + EPS); v2u* o = (v2u*)(H + (size_t)(row0 + r) * DM) + F.lane;
#pragma unroll
            for (int j = 0; j < 4; ++j) { v2u w; w.x = pk2(v[r][j].x * rr * gg[j].x, v[r][j].y * rr * gg[j].y); w.y = pk2(v[r][j].z * rr * gg[j].z, v[r][j].w * rr * gg[j].w); o[64 * j] = w; } }
    }
}
__device__ __forceinline__ void final_norm(Frame& F, float* X, const float* g) {
    PHASE_IDS(F);
    f32x4 gg[4];
#pragma unroll
    for (int j = 0; j < 4; ++j) gg[j] = ((const f32x4*)g)[64 * j + F.lane];
    for (int row0 = F.gw * 4; row0 < T; row0 += F.ngw * 4) {
        f32x4 v[4][4];
#pragma unroll
        for (int r = 0; r < 4; ++r)
#pragma unroll
            for (int j = 0; j < 4; ++j) v[r][j] = ((const f32x4*)(X + (size_t)(row0 + r) * DM))[64 * j + F.lane];
#pragma unroll
        for (int r = 0; r < 4; ++r) { float q = 0.f;
#pragma unroll
            for (int j = 0; j < 4; ++j) q += (v[r][j].x * v[r][j].x + v[r][j].y * v[r][j].y) + (v[r][j].z * v[r][j].z + v[r][j].w * v[r][j].w);
            const float rr = 1.0f / sqrtf(wave_sum(q) * (1.0f / DM) + EPS); f32x4* o = (f32x4*)(X + (size_t)(row0 + r) * DM) + F.lane;
#pragma unroll
            for (int j = 0; j < 4; ++j) o[64 * j] = v[r][j] * rr * gg[j]; }
    }
}

__device__ __forceinline__ void prep_compress(Frame& F, const Args& a, int layer) {
    PHASE_IDS(F);
    typedef short bf16x8 __attribute__((ext_vector_type(8)));
    const bf16* Z = (const bf16*)(F.ws + WS_Z); const bf16* WCT = (const bf16*)(F.ws + WS_WCT); const float* CBP = (const float*)(F.ws + WS_CBP);
    f32x4* red = (f32x4*)F.lds;
    const int lane = F.lane, et = F.wave & 3, kh = F.wave >> 2, r16 = lane & 15, q4 = lane >> 4;
    for (int it = blockIdx.x; it < NB * 2 * 16; it += F.G) {
        const int b = it >> 5, br = (it >> 4) & 1, n0 = (it & 15) * 16; const int zc = br ? ZVC : ZKC;
        const bf16* wrow = WCT + ((size_t)br * 64 + et * 16 + r16) * 2048 + 8 * q4;
        const int tb = 16 * (n0 + r16);
        f32x4 acc = {0.f, 0.f, 0.f, 0.f};
#pragma unroll 8
        for (int kk = kh * 32; kk < kh * 32 + 32; ++kk) {
            int tok = tb + (kk >> 1); tok = tok < SEQ ? tok : SEQ - 1;
            const bf16x8 af = *(const bf16x8*)(Z + ((size_t)b * SEQ + tok) * DINP + zc + (kk & 1) * 32 + 8 * q4);
            const bf16x8 bfr = *(const bf16x8*)(wrow + 32 * kk);
            acc = __builtin_amdgcn_mfma_f32_16x16x32_bf16(af, bfr, acc, 0, 0, 0);
        }
        __syncthreads();
        if (kh == 1) red[et * 64 + lane] = acc;
        __syncthreads();
        if (kh == 0) {
            const f32x4 o = red[et * 64 + lane]; const int e = et * 16 + r16; float bias = 0.f;
            const int es = br == 0 ? pi64(e) : e;
#pragma unroll 8
            for (int ch = 0; ch < 32; ++ch) bias += CBP[(br * 32 + ch) * 64 + es];
            bf16* O = (bf16*)(F.ws + (br ? WS_VC : WS_KC)) + (size_t)b * 256 * 64;
#pragma unroll
            for (int r = 0; r < 4; ++r) { const int n = n0 + 4 * q4 + r; O[n * 64 + e] = (bf16)((n < 255) ? f2bf(acc[r] + o[r] + bias) : 0u); }
        }
    }
    __syncthreads();
}
__device__ __forceinline__ float log_sigmoid_(float x) { return x >= 0.f ? -log1pf(__expf(-x)) : x - log1pf(__expf(x)); }
typedef float f32x16m __attribute__((ext_vector_type(16)));
__device__ __forceinline__ void mm64(f32x16m& acc, const float* ap, int as, const float* bp, int bs) {
#pragma unroll 8
    for (int kk = 0; kk < 32; ++kk) acc = __builtin_amdgcn_mfma_f32_32x32x2f32(ap[kk * as], bp[kk * bs], acc, 0, 0, 0);
}
__device__ __forceinline__ int crow32(int r, int hi) { return (r & 3) + 8 * (r >> 2) + 4 * hi; }
typedef short bf16x8m __attribute__((ext_vector_type(8)));
__device__ __forceinline__ f32x16m mmb64(const bf16* A, const bf16* Bt, int i0, int j0, int r32, int hi) {
    f32x16m acc;
#pragma unroll
    for (int r = 0; r < 16; ++r) acc[r] = 0.f;
#pragma unroll
    for (int ks = 0; ks < 4; ++ks) { const bf16x8m a = *(const bf16x8m*)(A + (i0 + r32) * 72 + ks * 16 + hi * 8), b = *(const bf16x8m*)(Bt + (j0 + r32) * 72 + ks * 16 + hi * 8);
        acc = __builtin_amdgcn_mfma_f32_32x32x16_bf16(a, b, acc, 0, 0, 0); }
    return acc;
}
__device__ __forceinline__ void prep_mlstm(Frame& F, const Args& a, int layer) {
    PHASE_IDS(F);
    const bf16* Z = (const bf16*)(F.ws + WS_Z);
    float* L = (float*)F.lds; float* KS = L; float* VS = L + 4096; float* WE = L + 8192;
    bf16* UCB = (bf16*)(L + 8448); bf16* WQT = UCB + 64 * 72; bf16* WKT = WQT + 64 * 72;
    const float* convw = a.in[7] + (size_t)layer * 4 * 256; const float* convb = a.in[8] + (size_t)layer * 256;
    const float* gb = a.in[11] + (size_t)layer * 8;
    float* MQ = (float*)(F.ws + WS_MQ); float* MK = (float*)(F.ws + WS_MK); float* CLOC = (float*)(F.ws + WS_CLOC); float* NLOC = (float*)(F.ws + WS_NLOC);
    float* BCUM = (float*)(F.ws + WS_BCUM); float* IG = (float*)(F.ws + WS_IG); float* ACH = (float*)(F.ws + WS_ACH); float* MLOC = (float*)(F.ws + WS_MLOC);
    const int lane = F.lane, r32 = lane & 31, hi = lane >> 5, w = F.wave, tl = F.tid >> 3, c8 = (F.tid & 7) * 8;
    v4u ur[4], vr; int ph = -1;
    if (w < 4) { const int itw = blockIdx.x + w * F.G;
        if (itw < 1024) { const int bh = itw >> 6, c = itw & 63, b = bh >> 2, h = bh & 3, l = lane; const size_t row = (size_t)b * SEQ + c * 64 + l; const bf16* zr = Z + row * DINP;
            const float ig = bf2f(zr[ZCI + h]) + gb[h]; float bc = log_sigmoid_(bf2f(zr[ZCF + h]) + gb[4 + h]);
#pragma unroll
            for (int o = 1; o < 64; o <<= 1) { const float v = lane_get(bc, l - o); if (l >= o) bc += v; }
            const float ach = lane_get(bc, 63); const float ge = ach - bc + ig; const float ml = wave_max(ge);
            WE[w * 64 + l] = __expf(ge - ml); BCUM[row * 4 + h] = bc; IG[row * 4 + h] = ig; if (l == 0) { ACH[itw] = ach; MLOC[itw] = ml; } } }
#define PM_LOAD(it_) do { const int bh_ = (it_) >> 6, c_ = (it_) & 63, b_ = bh_ >> 2, h_ = bh_ & 3, t_ = c_ * 64 + tl; const bf16* zb_ = Z + (size_t)b_ * SEQ * DINP; \
        _Pragma("unroll") for (int j = 0; j < 4; ++j) { const int tt_ = t_ - 3 + j; ur[j] = tt_ >= 0 ? *(const v4u*)(zb_ + (size_t)tt_ * DINP + ZCU + h_ * 64 + c8) : (v4u){0u, 0u, 0u, 0u}; } \
        vr = *(const v4u*)(zb_ + (size_t)t_ * DINP + ZCV + h_ * 64 + c8); } while (0)
    int it = blockIdx.x;
    if (it < 1024) PM_LOAD(it);
    for (int ki = 0; it < 1024; it += F.G, ++ki) {
        const int bh = it >> 6, c = it & 63, b = bh >> 2, h = bh & 3, t0 = c * 64; const size_t row0 = (size_t)b * SEQ + t0; const float* WEi = WE + ki * 64;
        __syncthreads();
        if (h != ph) { const float* wq = a.in[9] + ((size_t)layer * 4 + h) * 4096; const float* wk = a.in[10] + ((size_t)layer * 4 + h) * 4096;
            const f32x4 q0 = *(const f32x4*)(wq + F.tid * 8), q1 = *(const f32x4*)(wq + F.tid * 8 + 4), k0 = *(const f32x4*)(wk + F.tid * 8), k1 = *(const f32x4*)(wk + F.tid * 8 + 4);
            const int d = F.tid >> 3, e0 = (F.tid & 7) * 8;
#pragma unroll
            for (int i = 0; i < 4; ++i) { WQT[(e0 + i) * 72 + d] = (bf16)f2bf(q0[i]); WQT[(e0 + 4 + i) * 72 + d] = (bf16)f2bf(q1[i]); WKT[(e0 + i) * 72 + d] = (bf16)f2bf(k0[i]); WKT[(e0 + 4 + i) * 72 + d] = (bf16)f2bf(k1[i]); }
            ph = h; }
        { float u[4][8], acc[8], vv[8]; const int ch = h * 64 + c8;
#pragma unroll
          for (int j = 0; j < 4; ++j) { u[j][0] = bflo(ur[j].x); u[j][1] = bfhi(ur[j].x); u[j][2] = bflo(ur[j].y); u[j][3] = bfhi(ur[j].y); u[j][4] = bflo(ur[j].z); u[j][5] = bfhi(ur[j].z); u[j][6] = bflo(ur[j].w); u[j][7] = bfhi(ur[j].w); }
          vv[0] = bflo(vr.x); vv[1] = bfhi(vr.x); vv[2] = bflo(vr.y); vv[3] = bfhi(vr.y); vv[4] = bflo(vr.z); vv[5] = bfhi(vr.z); vv[6] = bflo(vr.w); vv[7] = bfhi(vr.w);
#pragma unroll
          for (int i = 0; i < 8; ++i) acc[i] = convb[ch + i];
#pragma unroll
          for (int j = 0; j < 4; ++j)
#pragma unroll
              for (int i = 0; i < 8; ++i) acc[i] += convw[j * 256 + ch + i] * u[j][i];
#pragma unroll
          for (int i = 0; i < 8; ++i) { acc[i] = acc[i] * sigmoidf_(acc[i]); VS[tl * 64 + c8 + i] = vv[i]; }
          *(v4u*)(UCB + tl * 72 + c8) = (v4u){pk2(acc[0], acc[1]), pk2(acc[2], acc[3]), pk2(acc[4], acc[5]), pk2(acc[6], acc[7])}; }
        if (it + F.G < 1024) PM_LOAD(it + F.G);
        __syncthreads();
        { const int i0 = ((w >> 1) & 1) * 32, j0 = (w & 1) * 32; const f32x16m acc = mmb64(UCB, w < 4 ? WQT : WKT, i0, j0, r32, hi);
            float* G = (w < 4 ? MQ : MK) + row0 * 256 + h * 64 + j0 + r32;
            if (w < 4) {
#pragma unroll
                for (int r = 0; r < 16; ++r) G[(size_t)(i0 + crow32(r, hi)) * 256] = acc[r];
            } else {
#pragma unroll
                for (int r = 0; r < 16; ++r) { const float v = acc[r] * 0.125f; const int l = i0 + crow32(r, hi); G[(size_t)l * 256] = v; KS[l * 64 + j0 + r32] = v; }
            } }
        __syncthreads();
        if (w < 4) { const int i0 = (w >> 1) * 32, j0 = (w & 1) * 32; f32x16m acc;
#pragma unroll
            for (int r = 0; r < 16; ++r) acc[r] = 0.f;
#pragma unroll 8
            for (int kk = 0; kk < 32; ++kk) { const int l = 2 * kk + hi; acc = __builtin_amdgcn_mfma_f32_32x32x2f32(VS[l * 64 + i0 + r32] * WEi[l], KS[l * 64 + j0 + r32], acc, 0, 0, 0); }
            float* G = CLOC + (size_t)it * 4096 + j0 + r32;
#pragma unroll
            for (int r = 0; r < 16; ++r) G[(i0 + crow32(r, hi)) * 64] = acc[r];
        } else if (w == 4) { float n = 0.f;
#pragma unroll 8
            for (int l = 0; l < 64; ++l) n += WEi[l] * KS[l * 64 + lane];
            NLOC[it * 64 + lane] = n; }
    }
#undef PM_LOAD
    __syncthreads();
}

__device__ __forceinline__ void ld8(const bf16* p, float* o) { const v4u w = *(const v4u*)p; o[0] = bflo(w.x); o[1] = bfhi(w.x); o[2] = bflo(w.y); o[3] = bfhi(w.y); o[4] = bflo(w.z); o[5] = bfhi(w.z); o[6] = bflo(w.w); o[7] = bfhi(w.w); }
__device__ __forceinline__ void ph_mlstm_out(Frame& F, const Args& a, int layer) {
    PHASE_IDS(F);
    const bf16* Z = (const bf16*)(F.ws + WS_Z); bf16* AO = (bf16*)(F.ws + WS_H);
    const float* MQ = (const float*)(F.ws + WS_MQ); const float* MK = (const float*)(F.ws + WS_MK); const float* CIN = (const float*)(F.ws + WS_CLOC); const float* NIN = (const float*)(F.ws + WS_NLOC);
    const float* BCUM = (const float*)(F.ws + WS_BCUM); const float* IG = (const float*)(F.ws + WS_IG); const float* MIN = (const float*)(F.ws + WS_MIN);
    const float* hg = a.in[12] + (size_t)layer * 256;
    float* L = (float*)F.lds; float* QS = L; float* SS = L + 4224; float* HS = L + 8448; float* VS = L + 12672;
    bf16* QB = (bf16*)(L + 16896); bf16* KB = QB + 64 * 72; bf16* CB = KB + 64 * 72;
    float* DEN = L + 16896 + 3 * 2304;
    const int lane = F.lane, r32 = lane & 31, hi = lane >> 5, w = F.wave;
    const int tl = F.tid >> 3, c8 = (F.tid & 7) * 8;
    f32x4 qr[2], kr[2], cr[2]; v4u vr;
    float* G4 = DEN + 64;
    if (w < 4) { const int itw = blockIdx.x + w * F.G;
        if (itw < 1024) { const int bh = itw >> 6, c = itw & 63, b = bh >> 2, h = bh & 3, l = lane; const size_t rl = (size_t)b * SEQ + c * 64 + l;
            const float bc = BCUM[rl * 4 + h], ig = IG[rl * 4 + h], mi = MIN[itw]; float* g = G4 + 5 * 64 * w;
            g[l] = NIN[itw * 64 + l]; g[64 + l] = bc; g[128 + l] = ig;
            float pm = ig - bc;
#pragma unroll
            for (int o = 1; o < 64; o <<= 1) { const float v = lane_get(pm, l - o); if (l >= o) pm = fmaxf(pm, v); }
            const float inter = bc + mi, mt = fmaxf(inter, bc + pm); g[192 + l] = mt; g[256 + l] = __expf(inter - mt); } }
#define MO_LOAD(it_) do { const int bh_ = (it_) >> 6, c_ = (it_) & 63, b_ = bh_ >> 2, h_ = bh_ & 3; const size_t r_ = (size_t)b_ * SEQ + c_ * 64 + tl; \
        const f32x4* q_ = (const f32x4*)(MQ + r_ * 256 + h_ * 64 + c8); const f32x4* k_ = (const f32x4*)(MK + r_ * 256 + h_ * 64 + c8); const f32x4* c_p = (const f32x4*)(CIN + (size_t)(it_) * 4096 + tl * 64 + c8); \
        qr[0] = q_[0]; qr[1] = q_[1]; kr[0] = k_[0]; kr[1] = k_[1]; cr[0] = c_p[0]; cr[1] = c_p[1]; vr = *(const v4u*)(Z + r_ * DINP + ZCV + h_ * 64 + c8); } while (0)
    int it = blockIdx.x;
    if (it < 1024) MO_LOAD(it);
    for (int ki = 0; it < 1024; it += F.G, ++ki) {
        const int bh = it >> 6, c = it & 63, b = bh >> 2, h = bh & 3; const size_t row0 = (size_t)b * SEQ + c * 64;
        const float* NI = G4 + 5 * 64 * ki; const float* BC = NI + 64; const float* IGS = BC + 64; const float* MT = IGS + 64; const float* EI = MT + 64;
        __syncthreads();
        { float* q_ = QS + tl * 65 + c8; float* v_ = VS + tl * 64 + c8;
#pragma unroll
          for (int i = 0; i < 4; ++i) { q_[i] = qr[0][i]; q_[4 + i] = qr[1][i]; }
          *(v4u*)(QB + tl * 72 + c8) = (v4u){pk2(qr[0][0], qr[0][1]), pk2(qr[0][2], qr[0][3]), pk2(qr[1][0], qr[1][1]), pk2(qr[1][2], qr[1][3])};
          *(v4u*)(KB + tl * 72 + c8) = (v4u){pk2(kr[0][0], kr[0][1]), pk2(kr[0][2], kr[0][3]), pk2(kr[1][0], kr[1][1]), pk2(kr[1][2], kr[1][3])};
          *(v4u*)(CB + tl * 72 + c8) = (v4u){pk2(cr[0][0], cr[0][1]), pk2(cr[0][2], cr[0][3]), pk2(cr[1][0], cr[1][1]), pk2(cr[1][2], cr[1][3])};
          v_[0] = bflo(vr.x); v_[1] = bfhi(vr.x); v_[2] = bflo(vr.y); v_[3] = bfhi(vr.y); v_[4] = bflo(vr.z); v_[5] = bfhi(vr.z); v_[6] = bflo(vr.w); v_[7] = bfhi(vr.w); }
        if (it + F.G < 1024) MO_LOAD(it + F.G);
        __syncthreads();
        const int i0 = ((w >> 1) & 1) * 32, j0 = (w & 1) * 32; f32x16m acc;
        if (w < 4) {
            acc = mmb64(QB, KB, i0, j0, r32, hi);
            const int s_ = j0 + r32; const float bs = IGS[s_] - BC[s_];
#pragma unroll
            for (int r = 0; r < 16; ++r) { const int t = i0 + crow32(r, hi); SS[t * 65 + s_] = (s_ <= t) ? acc[r] * __expf(BC[t] + bs - MT[t]) : 0.f; }
        } else {
            acc = mmb64(QB, CB, i0, j0, r32, hi);
#pragma unroll
            for (int r = 0; r < 16; ++r) acc[r] *= EI[i0 + crow32(r, hi)];
        }
        __syncthreads();
        if (w >= 4) {
            mm64(acc, SS + (i0 + r32) * 65 + hi, 2, VS + hi * 64 + j0 + r32, 128);
#pragma unroll
            for (int r = 0; r < 16; ++r) HS[(i0 + crow32(r, hi)) * 65 + j0 + r32] = acc[r];
        } else if (w == 0) { const int t = lane; float nq = 0.f, ssum = 0.f;
#pragma unroll 8
            for (int k = 0; k < 64; ++k) { nq += NI[k] * QS[t * 65 + k]; ssum += SS[t * 65 + k]; }
            const float den = EI[t] * nq + ssum; DEN[t] = 1.0f / fmaxf(fabsf(den), __expf(-MT[t])); }
        __syncthreads();
        { const int t = F.tid >> 3, vg = (F.tid & 7) * 8; const float rd = DEN[t]; float num[8]; float sq = 0.f;
#pragma unroll
            for (int i = 0; i < 8; ++i) { num[i] = HS[t * 65 + vg + i] * rd; sq += num[i] * num[i]; }
            sq += sx<1>(sq); sq += sx<2>(sq); sq += sx<4>(sq);
            const float rn = 1.0f / sqrtf(sq * (1.0f / 64.0f) + EPS); const size_t row = row0 + t;
            float zo[8]; ld8(Z + row * DINP + ZCO + h * 64 + vg, zo);
            unsigned wv[4];
#pragma unroll
            for (int i = 0; i < 8; i += 2) { const int ch = h * 64 + vg + i; wv[i >> 1] = pk2(num[i] * rn * hg[ch] * sigmoidf_(zo[i]), num[i + 1] * rn * hg[ch + 1] * sigmoidf_(zo[i + 1])); }
            *(v4u*)(AO + row * DM + 512 + h * 64 + vg) = (v4u){wv[0], wv[1], wv[2], wv[3]}; }
    }
#undef MO_LOAD
    __syncthreads();
}

namespace fa {
typedef short bf16x8 __attribute__((ext_vector_type(8)));
typedef float f32x16 __attribute__((ext_vector_type(16)));
typedef short s16x4 __attribute__((ext_vector_type(4)));
typedef __bf16 bf16x2_t __attribute__((ext_vector_type(2)));
constexpr int KP = 144, VP = 192, KT = 64 * KP, VT = 64 * VP, BUF = KT + VT, LDS_NEED = 2 * BUF;
constexpr float LOG2E = 1.4426950408889634f, LN2 = 0.6931471805599453f;
__device__ __forceinline__ int crow(int r, int hi) { return (r & 3) + 8 * (r >> 2) + 4 * hi; }
__device__ __forceinline__ unsigned cvtpk(float lo, float hi) { f32x2 v = {lo, hi}; bf16x2_t b = __builtin_convertvector(v, bf16x2_t); return __builtin_bit_cast(unsigned, b); }
__device__ __forceinline__ s16x4 vtr(LAS unsigned char* p) { return __builtin_bit_cast(s16x4, __builtin_amdgcn_ds_read_tr16_b64_v4i16((LAS s16x4*)p)); }
__device__ __forceinline__ void load_qf(const bf16* qrow, int hi, bf16x8 (&qf)[4]) {
#pragma unroll
    for (int ks = 0; ks < 4; ++ks) qf[ks] = *(const bf16x8*)(qrow + 16 * ks + 8 * hi);
}
template <int KS0, int KS, class P, int MODE = 0>
__device__ __forceinline__ void stream(const P& p, LAS unsigned char* lds, int tid, const bf16x8 (&qf)[4], float& m_, float& l_, f32x16 (&O_)[2]) {
    constexpr float THR = 8.0f;
    float m = MODE == 1 ? m_ : 0.f, l = l_; f32x16 O[2] = {O_[0], O_[1]}; f32x16 negm, LS;
#pragma unroll
    for (int r = 0; r < 16; ++r) { negm[r] = 0.f; LS[r] = 0.f; }
    const int lane = tid & 63, r32 = lane & 31, hi = lane >> 5, g = lane >> 4, i16 = lane & 15;
    const int srow = tid >> 3, scx = tid & 7;
    const int koff = r32 * KP + hi * 16;
    const int voff = KT + ((i16 >> 2) + 4 * hi) * VP + (16 * (g & 1) + 4 * (i16 & 3)) * 2;
    const int nt = p.ntiles();
    v4u kr, vr;
#define FA_LOAD(it_) do { const bf16* kp_ = p.krow((it_), srow); const bf16* vp_ = p.vrow((it_), srow); kr = *(const v4u*)(kp_ + 8 * scx); vr = *(const v4u*)(vp_ + 8 * scx); } while (0)
#define FA_STORE(boff_) do { *(LAS v4u*)(lds + (boff_) + srow * KP + scx * 16) = kr; *(LAS v4u*)(lds + (boff_) + KT + srow * VP + scx * 16) = vr; } while (0)
    __syncthreads();
    if (nt > 0) { FA_LOAD(0); FA_STORE(0); if (nt > 1) FA_LOAD(1); }
    __syncthreads();
#pragma unroll 1
    for (int it = 0; it < nt; ++it) {
        const int bc = (it & 1) * BUF;
        if (!p.wave_skip(it)) {
            f32x16 S[2];
            { bf16x8 kf[2][KS];
#pragma unroll
              for (int st = 0; st < 2; ++st)
#pragma unroll
                  for (int k = 0; k < KS; ++k) kf[st][k] = *(LAS bf16x8*)(lds + bc + koff + st * 32 * KP + (KS0 + k) * 32);
              f32x16 cin;
              if constexpr (MODE == 1) {
#pragma unroll
                  for (int r = 0; r < 16; ++r) cin[r] = 0.f; }
              else if constexpr (P::HAS_KEEP || P::NO_REF_BLOCK) { const float c0_ = p.lane_keep(it) ? -m : -INFINITY;
#pragma unroll
                  for (int r = 0; r < 16; ++r) cin[r] = c0_; }
              else cin = negm;
#pragma unroll
              for (int st = 0; st < 2; ++st) {
                  S[st] = __builtin_amdgcn_mfma_f32_32x32x16_bf16(kf[st][0], qf[KS0], cin, 0, 0, 0);
#pragma unroll
                  for (int k = 1; k < KS; ++k) S[st] = __builtin_amdgcn_mfma_f32_32x32x16_bf16(kf[st][k], qf[KS0 + k], S[st], 0, 0, 0); } }
            s16x4 vv[2][2][2][2];
            if constexpr (MODE == 0) {
#pragma unroll
                for (int st = 0; st < 2; ++st)
#pragma unroll
                    for (int s = 0; s < 2; ++s)
#pragma unroll
                        for (int dt = 0; dt < 2; ++dt) { LAS unsigned char* vp = lds + bc + voff + (32 * st + 16 * s) * VP + dt * 64; vv[st][s][dt][0] = vtr(vp); vv[st][s][dt][1] = vtr(vp + 8 * VP); }
            }
            const int mm = p.mask_mode(it);
            if (mm) {
                int lb, ub; p.bounds(it, lb, ub); lb -= 4 * hi; ub -= 4 * hi;
                asm volatile("" : "+v"(lb), "+v"(ub));
                if (mm == 1) {
#pragma unroll
                    for (int st = 0; st < 2; ++st)
#pragma unroll
                        for (int r = 0; r < 16; ++r) { const int cc = 32 * st + (r & 3) + 8 * (r >> 2); if (cc > ub) S[st][r] = -INFINITY; }
                } else if (mm == 2) {
#pragma unroll
                    for (int st = 0; st < 2; ++st)
#pragma unroll
                        for (int r = 0; r < 16; ++r) { const int cc = 32 * st + (r & 3) + 8 * (r >> 2); if (cc < lb) S[st][r] = -INFINITY; }
                } else {
#pragma unroll
                    for (int st = 0; st < 2; ++st)
#pragma unroll
                        for (int r = 0; r < 16; ++r) { const int cc = 32 * st + (r & 3) + 8 * (r >> 2); if (cc < lb || cc > ub) S[st][r] = -INFINITY; }
                }
            }
            if constexpr (MODE == 1) {
                const float ms = m; const float il = l > 0.f ? 1.0f / l : 0.f;
#pragma unroll
                for (int st = 0; st < 2; ++st)
#pragma unroll
                    for (int rg = 0; rg < 4; ++rg) {
                        const float p0 = __builtin_amdgcn_exp2f(S[st][4 * rg] - ms) * il, p1 = __builtin_amdgcn_exp2f(S[st][4 * rg + 1] - ms) * il;
                        const float p2 = __builtin_amdgcn_exp2f(S[st][4 * rg + 2] - ms) * il, p3 = __builtin_amdgcn_exp2f(S[st][4 * rg + 3] - ms) * il;
                        float qa = p0, qb = p0 + 2.0f * (p1 + p2 + p3);
                        qa += sx<1>(qa); qa += sx<2>(qa); qb += sx<1>(qb); qb += sx<2>(qb);
                        const int jp = 8 * (2 * it + st) + 2 * rg + hi;
                        if ((r32 & 3) == 0) { p.impA[p.tokl * 65 + jp] = qa; if (jp < 63) p.impB[p.tokl * 65 + jp + 1] = qb; }
                    }
            } else {
                float tm = S[0][0];
#pragma unroll
                for (int r = 1; r < 16; ++r) tm = fmaxf(tm, S[0][r]);
#pragma unroll
                for (int r = 0; r < 16; ++r) tm = fmaxf(tm, S[1][r]);
                tm = max32(tm);
                if (__any(tm > THR)) {
                    const float dl = fmaxf(tm, 0.f), f = __builtin_amdgcn_exp2f(-dl); m += dl; LS[0] *= f;
#pragma unroll
                    for (int st = 0; st < 2; ++st)
#pragma unroll
                        for (int r = 0; r < 16; ++r) S[st][r] -= dl;
                    if constexpr (!(P::HAS_KEEP || P::NO_REF_BLOCK)) {
#pragma unroll
                        for (int r = 0; r < 16; ++r) negm[r] = -m; }
#pragma unroll
                    for (int dt = 0; dt < 2; ++dt)
#pragma unroll
                        for (int r = 0; r < 16; ++r) O[dt][r] *= f;
                }
#pragma unroll
                for (int st = 0; st < 2; ++st)
#pragma unroll
                    for (int r = 0; r < 16; ++r) S[st][r] = __builtin_amdgcn_exp2f(S[st][r]);
                const unsigned one2 = (tid & 31) == 0 ? 0x3F803F80u : 0u; const bf16x8 ones = __builtin_bit_cast(bf16x8, (v4u){one2, one2, one2, one2});
#pragma unroll
                for (int st = 0; st < 2; ++st)
#pragma unroll
                    for (int s = 0; s < 2; ++s) {
                        v4u pw; pw.x = cvtpk(S[st][8 * s], S[st][8 * s + 1]); pw.y = cvtpk(S[st][8 * s + 2], S[st][8 * s + 3]); pw.z = cvtpk(S[st][8 * s + 4], S[st][8 * s + 5]); pw.w = cvtpk(S[st][8 * s + 6], S[st][8 * s + 7]);
                        const bf16x8 pf = __builtin_bit_cast(bf16x8, pw);
#pragma unroll
                        for (int dt = 0; dt < 2; ++dt) {
                            const s16x4 v0 = vv[st][s][dt][0], v1 = vv[st][s][dt][1];
                            const bf16x8 vf = __builtin_shufflevector(v0, v1, 0, 1, 2, 3, 4, 5, 6, 7);
                            O[dt] = __builtin_amdgcn_mfma_f32_32x32x16_bf16(vf, pf, O[dt], 0, 0, 0);
                        }
                        LS = __builtin_amdgcn_mfma_f32_32x32x16_bf16(ones, pf, LS, 0, 0, 0);
                    }
            }
        }
        if (it + 1 < nt) { FA_STORE(((it + 1) & 1) * BUF); if (it + 2 < nt) FA_LOAD(it + 2); }
        __syncthreads();
    }
#undef FA_LOAD
#undef FA_STORE
    if constexpr (MODE == 0) l = LS[0];
    m_ = m; l_ = l; O_[0] = O[0]; O_[1] = O[1];
}
template <class P>
__device__ __forceinline__ void stream2(const P& p, LAS unsigned char* lds, int tid, const bf16x8 (&qf)[4], float (&m)[2], float (&l)[2], f32x16 (&O)[2][2]) {
    constexpr float THR = 8.0f; f32x16 negm; float mref = 0.f;
#pragma unroll
    for (int r = 0; r < 16; ++r) negm[r] = 0.f;
    const int lane = tid & 63, r32 = lane & 31, hi = lane >> 5, g = lane >> 4, i16 = lane & 15;
    const int srow = tid >> 3, scx = tid & 7;
    const int koff = r32 * KP + hi * 16;
    const int voff = KT + ((i16 >> 2) + 4 * hi) * VP + (16 * (g & 1) + 4 * (i16 & 3)) * 2;
    const int nt = p.ntiles();
    v4u kr, vr;
#define FA_LOAD(it_) do { const bf16* kp_ = p.krow((it_), srow); const bf16* vp_ = p.vrow((it_), srow); kr = *(const v4u*)(kp_ + 8 * scx); vr = *(const v4u*)(vp_ + 8 * scx); } while (0)
#define FA_STORE(boff_) do { *(LAS v4u*)(lds + (boff_) + srow * KP + scx * 16) = kr; *(LAS v4u*)(lds + (boff_) + KT + srow * VP + scx * 16) = vr; } while (0)
    __syncthreads();
    if (nt > 0) { FA_LOAD(0); FA_STORE(0); if (nt > 1) FA_LOAD(1); }
    __syncthreads();
#pragma unroll 1
    for (int it = 0; it < nt; ++it) {
        const int bc = (it & 1) * BUF;
        if (!p.wave_skip(it)) {
            f32x16 S[2][2];
            { bf16x8 kf[2][2][2];
#pragma unroll
              for (int c = 0; c < 2; ++c)
#pragma unroll
                  for (int st = 0; st < 2; ++st)
#pragma unroll
                      for (int k = 0; k < 2; ++k) kf[c][st][k] = *(LAS bf16x8*)(lds + bc + koff + st * 32 * KP + (2 * c + k) * 32);
#pragma unroll
              for (int st = 0; st < 2; ++st)
#pragma unroll
                  for (int c = 0; c < 2; ++c) S[c][st] = __builtin_amdgcn_mfma_f32_32x32x16_bf16(kf[c][st][0], qf[2 * c], negm, 0, 0, 0);
#pragma unroll
              for (int st = 0; st < 2; ++st)
#pragma unroll
                  for (int c = 0; c < 2; ++c) S[c][st] = __builtin_amdgcn_mfma_f32_32x32x16_bf16(kf[c][st][1], qf[2 * c + 1], S[c][st], 0, 0, 0); }
            s16x4 vv[2][2][2][2];
#pragma unroll
            for (int st = 0; st < 2; ++st)
#pragma unroll
                for (int s = 0; s < 2; ++s)
#pragma unroll
                    for (int dt = 0; dt < 2; ++dt) { LAS unsigned char* vp = lds + bc + voff + (32 * st + 16 * s) * VP + dt * 64; vv[st][s][dt][0] = vtr(vp); vv[st][s][dt][1] = vtr(vp + 8 * VP); }
            if (p.mask_mode(it)) {
                int lb, ub; p.bounds(it, lb, ub); ub -= 4 * hi; asm volatile("" : "+v"(ub));
#pragma unroll
                for (int c = 0; c < 2; ++c)
#pragma unroll
                    for (int st = 0; st < 2; ++st)
#pragma unroll
                        for (int r = 0; r < 16; ++r) { const int cc = 32 * st + (r & 3) + 8 * (r >> 2); if (cc > ub) S[c][st][r] = -INFINITY; }
            }
            float tm[2];
#pragma unroll
            for (int c = 0; c < 2; ++c) { float t_ = S[c][0][0];
#pragma unroll
                for (int r = 1; r < 16; ++r) t_ = fmaxf(t_, S[c][0][r]);
#pragma unroll
                for (int r = 0; r < 16; ++r) t_ = fmaxf(t_, S[c][1][r]);
                tm[c] = t_; }
            tm[0] = max32(tm[0]); tm[1] = max32(tm[1]);
            if (__any(tm[0] > THR || tm[1] > THR)) {
                const float dl = fmaxf(fmaxf(tm[0], tm[1]), 0.f), f = __builtin_amdgcn_exp2f(-dl); mref += dl; l[0] *= f; l[1] *= f;
#pragma unroll
                for (int r = 0; r < 16; ++r) negm[r] = -mref;
#pragma unroll
                for (int c = 0; c < 2; ++c) {
#pragma unroll
                    for (int st = 0; st < 2; ++st)
#pragma unroll
                        for (int r = 0; r < 16; ++r) S[c][st][r] -= dl;
#pragma unroll
                    for (int dt = 0; dt < 2; ++dt)
#pragma unroll
                        for (int r = 0; r < 16; ++r) O[c][dt][r] *= f; }
            }
            float ps[2] = {0.f, 0.f};
#pragma unroll
            for (int st = 0; st < 2; ++st)
#pragma unroll
                for (int r = 0; r < 16; ++r)
#pragma unroll
                    for (int c = 0; c < 2; ++c) { const float e = __builtin_amdgcn_exp2f(S[c][st][r]); S[c][st][r] = e; ps[c] += e; }
            l[0] += ps[0]; l[1] += ps[1];
#pragma unroll
            for (int st = 0; st < 2; ++st)
#pragma unroll
                for (int s = 0; s < 2; ++s) {
                    bf16x8 pf[2];
#pragma unroll
                    for (int c = 0; c < 2; ++c) { v4u pw; pw.x = cvtpk(S[c][st][8 * s], S[c][st][8 * s + 1]); pw.y = cvtpk(S[c][st][8 * s + 2], S[c][st][8 * s + 3]); pw.z = cvtpk(S[c][st][8 * s + 4], S[c][st][8 * s + 5]); pw.w = cvtpk(S[c][st][8 * s + 6], S[c][st][8 * s + 7]); pf[c] = __builtin_bit_cast(bf16x8, pw); }
#pragma unroll
                    for (int dt = 0; dt < 2; ++dt) {
                        const bf16x8 vf = __builtin_shufflevector(vv[st][s][dt][0], vv[st][s][dt][1], 0, 1, 2, 3, 4, 5, 6, 7);
#pragma unroll
                        for (int c = 0; c < 2; ++c) O[c][dt] = __builtin_amdgcn_mfma_f32_32x32x16_bf16(vf, pf[c], O[c][dt], 0, 0, 0);
                    }
                }
        }
        if (it + 1 < nt) { FA_STORE(((it + 1) & 1) * BUF); if (it + 2 < nt) FA_LOAD(it + 2); }
        __syncthreads();
    }
#undef FA_LOAD
#undef FA_STORE
    m[0] = mref; m[1] = mref;
}
__device__ __forceinline__ float finish(float l, f32x16 (&O)[2]) {
    const float lt = sum32(l); const float inv = lt > 0.f ? 1.0f / lt : 0.f;
#pragma unroll
    for (int dt = 0; dt < 2; ++dt)
#pragma unroll
        for (int r = 0; r < 16; ++r) O[dt][r] *= inv;
    return lt;
}
__device__ __forceinline__ void store_o(const f32x16 (&O)[2], bf16* out, int hi) {
#pragma unroll
    for (int dt = 0; dt < 2; ++dt)
#pragma unroll
        for (int rg = 0; rg < 4; ++rg) { v2u w; w.x = cvtpk(O[dt][4 * rg], O[dt][4 * rg + 1]); w.y = cvtpk(O[dt][4 * rg + 2], O[dt][4 * rg + 3]); *(v2u*)(out + 32 * dt + 8 * rg + 4 * hi) = w; }
}
}

struct DiffPol {
    static constexpr bool NO_REF_BLOCK = false;
    static constexpr bool HAS_KEEP = false;
    const bf16* Zb; int h, t0, wq0, tq;
    __device__ __forceinline__ int ntiles() const { return (t0 + 256) >> 6; }
    __device__ __forceinline__ const bf16* krow(int it, int r) const { return Zb + (size_t)(64 * it + r) * DINP + ZBK + 64 * h; }
    __device__ __forceinline__ const bf16* vrow(int it, int r) const { return Zb + (size_t)(64 * it + r) * DINP + ZBV + 64 * h; }
    __device__ __forceinline__ bool wave_skip(int it) const { return 64 * it > wq0 + 31; }
    __device__ __forceinline__ int mask_mode(int it) const { return 64 * it + 63 > wq0 ? 1 : 0; }
    __device__ __forceinline__ bool lane_keep(int) const { return true; }
    __device__ __forceinline__ void bounds(int it, int& lb, int& ub) const { lb = 0; ub = tq - 64 * it; }
};
__device__ __forceinline__ void diff_item(Frame& F, const Args& a, int layer, int b, int h, int qb, float lam) {
    PHASE_IDS(F);
    const bf16* Z = (const bf16*)(F.ws + WS_Z); bf16* AO = (bf16*)(F.ws + WS_H);
    const int lane = F.lane, r32 = lane & 31, hi = lane >> 5;
    DiffPol p; p.Zb = Z + (size_t)b * SEQ * DINP; p.h = h; p.t0 = 256 * qb; p.wq0 = p.t0 + 32 * F.wave; p.tq = p.wq0 + r32;
    fa::bf16x8 qf[4]; fa::load_qf(p.Zb + (size_t)p.tq * DINP + ZBQ + 64 * h, hi, qf);
    fa::f32x16 O[2][2];
#pragma unroll
    for (int c = 0; c < 2; ++c)
#pragma unroll
        for (int dt = 0; dt < 2; ++dt)
#pragma unroll
            for (int r = 0; r < 16; ++r) O[c][dt][r] = 0.f;
    { float m[2] = {-INFINITY, -INFINITY}, l[2] = {0.f, 0.f}; fa::stream2<DiffPol>(p, F.lds3, F.tid, qf, m, l, O); fa::finish(l[0], O[0]); fa::finish(l[1], O[1]); }
    const float lam_init = 0.8f - 0.6f * expf(-0.3f * (float)layer);
    const float* sg = a.in[6] + (size_t)layer * 64;
    float ss = 0.f;
#pragma unroll
    for (int dt = 0; dt < 2; ++dt)
#pragma unroll
        for (int r = 0; r < 16; ++r) { const float v = O[0][dt][r] - lam * O[1][dt][r]; O[0][dt][r] = v; ss += v * v; }
    ss = sum32(ss);
    const float rn = (1.0f / sqrtf(ss * (1.0f / 64.0f) + EPS)) * (1.0f - lam_init);
#pragma unroll
    for (int dt = 0; dt < 2; ++dt)
#pragma unroll
        for (int r = 0; r < 16; ++r) O[0][dt][r] *= rn * sg[32 * dt + fa::crow(r, hi)];
    fa::store_o(O[0], AO + ((size_t)b * SEQ + p.tq) * DM + 256 + 64 * h, hi);
}
struct DilPol {
    static constexpr bool NO_REF_BLOCK = false;
    static constexpr bool HAS_KEEP = false;
    const bf16* Zb; int h, dil, res, it0, nt, wi0, iq;
    __device__ __forceinline__ int ntiles() const { return nt; }
    __device__ __forceinline__ const bf16* krow(int it, int r) const { const int ik = 64 * (it0 + it) + r; return Zb + (size_t)(res + dil * ik) * DINP + ZDK + 64 * h; }
    __device__ __forceinline__ const bf16* vrow(int it, int r) const { const int ik = 64 * (it0 + it) + r; return Zb + (size_t)(res + dil * ik) * DINP + ZDV + 64 * h; }
    __device__ __forceinline__ bool wave_skip(int it) const { const int k0 = 64 * (it0 + it); return k0 > wi0 + 31 || k0 + 63 < wi0 - 128; }
    __device__ __forceinline__ int mask_mode(int it) const { const int k0 = 64 * (it0 + it); return (k0 + 63 > wi0 ? 1 : 0) | (k0 < wi0 + 31 - 128 ? 2 : 0); }
    __device__ __forceinline__ bool lane_keep(int) const { return true; }
    __device__ __forceinline__ void bounds(int it, int& lb, int& ub) const { ub = iq - 64 * (it0 + it); lb = ub - 128; }
};
__device__ __forceinline__ void dil_item(Frame& F, int b, int h, int g, int res, int blk) {
    PHASE_IDS(F);
    const bf16* Z = (const bf16*)(F.ws + WS_Z); bf16* DP = (bf16*)(F.ws + WS_DPART); float* DL = (float*)(F.ws + WS_DLSE);
    const int lane = F.lane, r32 = lane & 31, hi = lane >> 5;
    DilPol p; p.Zb = Z + (size_t)b * SEQ * DINP; p.h = h; p.dil = (g == 0) ? 1 : (g == 1) ? 4 : 16; p.res = res;
    const int i0 = 256 * blk; const int t_lo = (i0 >> 6) - 2; p.it0 = t_lo < 0 ? 0 : t_lo; p.nt = (i0 >> 6) + 4 - p.it0;
    p.wi0 = i0 + 32 * F.wave; p.iq = p.wi0 + r32;
    const int tq = res + p.dil * p.iq; const size_t row = (size_t)b * SEQ + tq;
    fa::bf16x8 qf[4]; fa::load_qf(p.Zb + (size_t)tq * DINP + ZDQ + 64 * h, hi, qf);
    float m = -INFINITY, l = 0.f; fa::f32x16 O[2];
#pragma unroll
    for (int dt = 0; dt < 2; ++dt)
#pragma unroll
        for (int r = 0; r < 16; ++r) O[dt][r] = 0.f;
    fa::stream<0, 4, DilPol>(p, F.lds3, F.tid, qf, m, l, O);
    const float lt = fa::finish(l, O);
    fa::store_o(O, DP + ((size_t)g * T + row) * 256 + 64 * h, hi);
    if (hi == 0) DL[((size_t)g * T + row) * 4 + h] = (m + __log2f(lt)) * fa::LN2;
}
__device__ __forceinline__ void dil_combine(Frame& F) {
    PHASE_IDS(F);
    const bf16* DP = (const bf16*)(F.ws + WS_DPART); const float* DL = (const float*)(F.ws + WS_DLSE); bf16* AO = (bf16*)(F.ws + WS_H);
    const int gt = F.gw * 64 + F.lane, ngt = F.ngw * 64;
    for (int i = gt; i < T * 32; i += ngt) { const int row = i >> 5, c8 = (i & 31) * 8, h = c8 >> 6;
        const float l0 = DL[(size_t)row * 4 + h], l1 = DL[((size_t)T + row) * 4 + h], l2 = DL[((size_t)2 * T + row) * 4 + h];
        const float mx = fmaxf(l0, fmaxf(l1, l2)); float w0 = __expf(l0 - mx), w1 = __expf(l1 - mx), w2 = __expf(l2 - mx); const float inv = 1.0f / (w0 + w1 + w2); w0 *= inv; w1 *= inv; w2 *= inv;
        float x0[8], x1[8], x2[8]; ld8(DP + (size_t)row * 256 + c8, x0); ld8(DP + ((size_t)T + row) * 256 + c8, x1); ld8(DP + ((size_t)2 * T + row) * 256 + c8, x2);
        v4u o; o.x = pk2(w0 * x0[0] + w1 * x1[0] + w2 * x2[0], w0 * x0[1] + w1 * x1[1] + w2 * x2[1]); o.y = pk2(w0 * x0[2] + w1 * x1[2] + w2 * x2[2], w0 * x0[3] + w1 * x1[3] + w2 * x2[3]);
        o.z = pk2(w0 * x0[4] + w1 * x1[4] + w2 * x2[4], w0 * x0[5] + w1 * x1[5] + w2 * x2[5]); o.w = pk2(w0 * x0[6] + w1 * x1[6] + w2 * x2[6], w0 * x0[7] + w1 * x1[7] + w2 * x2[7]);
        *(v4u*)(AO + (size_t)row * DM + 768 + c8) = o; }
}
struct CmpPol {
    static constexpr bool NO_REF_BLOCK = false;
    static constexpr bool HAS_KEEP = false;
    const bf16* KCb; const bf16* VCb; int nt, ubg; float* impA; float* impB; int tokl; bool nov;
    __device__ __forceinline__ int ntiles() const { return nt; }
    __device__ __forceinline__ const bf16* krow(int it, int r) const { return KCb + (size_t)(64 * it + r) * 64; }
    __device__ __forceinline__ const bf16* vrow(int it, int r) const { return VCb + (size_t)(64 * it + r) * 64; }
    __device__ __forceinline__ bool wave_skip(int) const { return false; }
    __device__ __forceinline__ int mask_mode(int) const { return 1; }
    __device__ __forceinline__ bool lane_keep(int) const { return true; }
    __device__ __forceinline__ void bounds(int it, int& lb, int& ub) const { lb = 0; ub = ubg - 64 * it; }
};
struct SlcPol {
    static constexpr bool NO_REF_BLOCK = true;
    static constexpr bool HAS_KEEP = true;
    const bf16* Zb; const unsigned char* list; int nt, t, cblk; unsigned wlo, whi, mlo, mhi;
    __device__ __forceinline__ int ntiles() const { return nt; }
    __device__ __forceinline__ const bf16* krow(int it, int r) const { const int j = list[it]; return Zb + (size_t)(64 * j + r) * DINP + ZKS; }
    __device__ __forceinline__ const bf16* vrow(int it, int r) const { const int j = list[it]; return Zb + (size_t)(64 * j + r) * DINP + ZVS; }
    __device__ __forceinline__ bool wave_skip(int it) const { const int j = list[it]; return !(((j < 32) ? (wlo >> j) : (whi >> (j - 32))) & 1u); }
    __device__ __forceinline__ int mask_mode(int it) const { return (int)list[it] == cblk ? 1 : 0; }
    __device__ __forceinline__ bool lane_keep(int it) const { const int j = list[it]; return (((j < 32) ? (mlo >> j) : (mhi >> (j - 32))) & 1u) != 0u; }
    __device__ __forceinline__ void bounds(int it, int& lb, int& ub) const { const int j = list[it]; lb = 0; ub = t - 64 * j; }
};
struct WinPol {
    static constexpr bool NO_REF_BLOCK = false;
    static constexpr bool HAS_KEEP = false;
    const bf16* Zb; int jt0, nt, t, cblk;
    __device__ __forceinline__ int ntiles() const { return nt; }
    __device__ __forceinline__ const bf16* krow(int it, int r) const { return Zb + (size_t)(64 * (jt0 + it) + r) * DINP + ZKW; }
    __device__ __forceinline__ const bf16* vrow(int it, int r) const { return Zb + (size_t)(64 * (jt0 + it) + r) * DINP + ZVW; }
    __device__ __forceinline__ bool wave_skip(int) const { return false; }
    __device__ __forceinline__ int mask_mode(int it) const { const int jt = jt0 + it; return (jt == cblk ? 1 : 0) | (jt == cblk - 8 ? 2 : 0); }
    __device__ __forceinline__ bool lane_keep(int) const { return true; }
    __device__ __forceinline__ void bounds(int it, int& lb, int& ub) const { ub = t - 64 * (jt0 + it); lb = ub - 511; }
};
constexpr int NSA_IMP_OFF = 45056, NSA_ACC_OFF = 45056  , NSA_SEL_OFF = NSA_ACC_OFF + 65536, NSA_LIST_OFF = NSA_SEL_OFF + 512;
static_assert(fa::LDS_NEED <= NSA_IMP_OFF && NSA_LIST_OFF + 64 <= RING_BYTES, "NSA LDS map");
__device__ __forceinline__ void nsa_item(Frame& F, int b, int c) {
    PHASE_IDS(F);
    const bf16* Z = (const bf16*)(F.ws + WS_Z); const bf16* AQR = (const bf16*)(F.ws + WS_AQR); bf16* AO = (bf16*)(F.ws + WS_H);
    const bf16* KCB = (const bf16*)(F.ws + WS_KC) + (size_t)b * 256 * 64; const bf16* VCB = (const bf16*)(F.ws + WS_VC) + (size_t)b * 256 * 64;
    const int lane = F.lane, r32 = lane & 31, hi = lane >> 5, tokl = 8 * F.wave + (r32 >> 2), h = r32 & 3, t = 64 * c + tokl; const size_t row = (size_t)b * SEQ + t;
    const bf16* Zb = Z + (size_t)b * SEQ * DINP;
    float* impA = (float*)(F.lds + NSA_IMP_OFF); float* impB = impA + 64 * 65;
    unsigned long long* sel = (unsigned long long*)(F.lds + NSA_SEL_OFF); unsigned char* list = F.lds + NSA_LIST_OFF;
    for (int i = F.tid; i < 2 * 64 * 65; i += NTHREADS) impA[i] = 0.f;
    const bf16* zr = Zb + (size_t)t * DINP;
    const float g0 = sigmoidf_(bf2f(zr[ZAG + h])), g1 = sigmoidf_(bf2f(zr[ZAG + 4 + h])), g2 = sigmoidf_(bf2f(zr[ZAG + 8 + h]));
    fa::f32x16 acc[2], O[2];
    {
        CmpPol cp; cp.KCb = KCB; cp.VCb = VCB; cp.nt = (4 * c + 2 + 64) >> 6; cp.ubg = t >= 31 ? ((t - 31) >> 4) : -1; cp.impA = impA; cp.impB = impB; cp.tokl = tokl; cp.nov = false;
        fa::bf16x8 qf[4]; fa::load_qf(zr + ZAQ + 64 * h, hi, qf);
        float m = -INFINITY, l = 0.f;
#pragma unroll
        for (int dt = 0; dt < 2; ++dt)
#pragma unroll
            for (int r = 0; r < 16; ++r) O[dt][r] = 0.f;
        fa::stream<0, 4, CmpPol, 0>(cp, F.lds3, F.tid, qf, m, l, O);
        float lt = fa::finish(l, O);
#pragma unroll
        for (int dt = 0; dt < 2; ++dt)
#pragma unroll
            for (int r = 0; r < 16; ++r) acc[dt][r] = g0 * O[dt][r];
        cp.nov = true;
        fa::stream<0, 4, CmpPol, 1>(cp, F.lds3, F.tid, qf, m, lt, O);
    }
    __syncthreads();
    f32x4* accl = (f32x4*)(F.lds + NSA_ACC_OFF) + F.tid;
#pragma unroll 1
    for (int tk = 0; tk < 8; ++tk) {
        const int tl = 8 * F.wave + tk, j = lane; const float imp = impA[tl * 65 + j] + impB[tl * 65 + j];
        const bool forced = (j == 0) || (j <= c && j > c - 2);
        const float sc = (j > c) ? -1.0e6f : (forced ? 1.0e6f : imp);
        int rank = 0;
#pragma unroll 8
        for (int i = 0; i < 64; ++i) { const float si = lane_get(sc, i); rank += (si > sc || (si == sc && i < j)) ? 1 : 0; }
        const unsigned long long mask = __ballot(rank < 16 && j <= c);
        if (lane == 0) sel[tl] = mask;
    }
    __syncthreads();
#pragma unroll
    for (int dt = 0; dt < 2; ++dt)
#pragma unroll
        for (int q4 = 0; q4 < 4; ++q4) accl[(dt * 4 + q4) * NTHREADS] = (f32x4){acc[dt][4 * q4], acc[dt][4 * q4 + 1], acc[dt][4 * q4 + 2], acc[dt][4 * q4 + 3]};
    SlcPol sp; sp.Zb = Zb; sp.list = list; sp.t = t; sp.cblk = c;
    { const unsigned long long mk = sel[tokl]; sp.mlo = (unsigned)mk; sp.mhi = (unsigned)(mk >> 32);
      unsigned wl = sp.mlo, wh = sp.mhi; wl |= (unsigned)sx_i<4>((int)wl); wh |= (unsigned)sx_i<4>((int)wh); wl |= (unsigned)sx_i<8>((int)wl); wh |= (unsigned)sx_i<8>((int)wh); wl |= (unsigned)sx_i<16>((int)wl); wh |= (unsigned)sx_i<16>((int)wh);
      sp.wlo = __builtin_amdgcn_readfirstlane(wl); sp.whi = __builtin_amdgcn_readfirstlane(wh);
      const unsigned long long mu = sel[lane]; unsigned ul = (unsigned)mu, uh = (unsigned)(mu >> 32);
      ul |= (unsigned)sx_i<1>((int)ul); uh |= (unsigned)sx_i<1>((int)uh); ul |= (unsigned)sx_i<2>((int)ul); uh |= (unsigned)sx_i<2>((int)uh); ul |= (unsigned)sx_i<4>((int)ul); uh |= (unsigned)sx_i<4>((int)uh);
      ul |= (unsigned)sx_i<8>((int)ul); uh |= (unsigned)sx_i<8>((int)uh); ul |= (unsigned)sx_i<16>((int)ul); uh |= (unsigned)sx_i<16>((int)uh); ul = or32(ul); uh = or32(uh);
      ul = __builtin_amdgcn_readfirstlane(ul); uh = __builtin_amdgcn_readfirstlane(uh);
      const unsigned long long un = ((unsigned long long)uh << 32) | ul;
      if ((un >> lane) & 1ull) list[__popcll(un & ((1ull << lane) - 1ull))] = (unsigned char)lane;
      sp.nt = __popcll(un); }
    fa::bf16x8 qf[4]; fa::load_qf(AQR + row * 256 + 64 * h, hi, qf);
    { float m = -INFINITY, l = 0.f;
#pragma unroll
      for (int dt = 0; dt < 2; ++dt)
#pragma unroll
          for (int r = 0; r < 16; ++r) O[dt][r] = 0.f;
      fa::stream<0, 4, SlcPol, 0>(sp, F.lds3, F.tid, qf, m, l, O); fa::finish(l, O);
#pragma unroll
      for (int dt = 0; dt < 2; ++dt)
#pragma unroll
          for (int q4 = 0; q4 < 4; ++q4) { f32x4 a4 = accl[(dt * 4 + q4) * NTHREADS]; a4[0] += g1 * O[dt][4 * q4]; a4[1] += g1 * O[dt][4 * q4 + 1]; a4[2] += g1 * O[dt][4 * q4 + 2]; a4[3] += g1 * O[dt][4 * q4 + 3]; accl[(dt * 4 + q4) * NTHREADS] = a4; } }
    { WinPol wp; wp.Zb = Zb; wp.jt0 = c >= 8 ? c - 8 : 0; wp.nt = c - wp.jt0 + 1; wp.t = t; wp.cblk = c;
      float m = -INFINITY, l = 0.f;
#pragma unroll
      for (int dt = 0; dt < 2; ++dt)
#pragma unroll
          for (int r = 0; r < 16; ++r) O[dt][r] = 0.f;
      fa::stream<0, 4, WinPol, 0>(wp, F.lds3, F.tid, qf, m, l, O); fa::finish(l, O);
#pragma unroll
      for (int dt = 0; dt < 2; ++dt)
#pragma unroll
          for (int q4 = 0; q4 < 4; ++q4) { const f32x4 a4 = accl[(dt * 4 + q4) * NTHREADS]; O[dt][4 * q4] = a4[0] + g2 * O[dt][4 * q4]; O[dt][4 * q4 + 1] = a4[1] + g2 * O[dt][4 * q4 + 1]; O[dt][4 * q4 + 2] = a4[2] + g2 * O[dt][4 * q4 + 2]; O[dt][4 * q4 + 3] = a4[3] + g2 * O[dt][4 * q4 + 3]; } }
    fa::store_o(O, AO + row * DM + 64 * h, hi);
}
__device__ __forceinline__ void scan_item(Frame& F, int it) {
    PHASE_IDS(F);
    float* CLOC = (float*)(F.ws + WS_CLOC); float* NLOC = (float*)(F.ws + WS_NLOC);
    const float* ACH = (const float*)(F.ws + WS_ACH); const float* MLOC = (const float*)(F.ws + WS_MLOC); float* MIN = (float*)(F.ws + WS_MIN);
    const int bh = it >> 2, qt = it & 3; const int e0 = qt * 1024 + F.tid * 2;
    float c0 = 0.f, c1 = 0.f, nst = 0.f, mst = 0.f;
#pragma unroll 1
    for (int cb = 0; cb < 64; cb += 16) {
        f32x2 cl[16]; float ac[16], ml[16], nl[16];
#pragma unroll
        for (int u = 0; u < 16; ++u) { const int ci = bh * 64 + cb + u; cl[u] = *(const f32x2*)(CLOC + (size_t)ci * 4096 + e0); ac[u] = ACH[ci]; ml[u] = MLOC[ci]; nl[u] = (qt == 0 && F.tid < 64) ? NLOC[ci * 64 + F.tid] : 0.f; }
#pragma unroll
        for (int u = 0; u < 16; ++u) { const int ci = bh * 64 + cb + u;
            const float mn = fmaxf(ac[u] + mst, ml[u]), decay = __expf(ac[u] + mst - mn), fresh = __expf(ml[u] - mn);
            *(f32x2*)(CLOC + (size_t)ci * 4096 + e0) = (f32x2){c0, c1}; c0 = decay * c0 + fresh * cl[u].x; c1 = decay * c1 + fresh * cl[u].y;
            if (qt == 0 && F.tid < 64) { NLOC[ci * 64 + F.tid] = nst; nst = decay * nst + fresh * nl[u]; if (F.tid == 0) MIN[ci] = mst; }
            mst = mn; }
    }
}
struct QOrder { unsigned short v[64 + 256 + 256 + 768]; };
constexpr QOrder make_order() {
    QOrder o{}; int n = 0, id = 0, in = 0, big = 0; bool scans = false;
    while (id < 256 || in < 256) {
        if (!scans && big == 192) { for (int k = 0; k < 64; ++k) o.v[n++] = (unsigned short)((3 << 12) | k); scans = true; }
        const int cd = id < 256 ? 120 * (15 - id / 16 + 1) : -1, cn = in < 256 ? 16 * (63 - in / 4 + 18) : -1;
        if (cd >= cn) { o.v[n++] = (unsigned short)((0 << 12) | id); ++id; } else { o.v[n++] = (unsigned short)((1 << 12) | in); ++in; }
        ++big;
    }
    for (int k = 0; k < 768; ++k) o.v[n++] = (unsigned short)((2 << 12) | k);
    return o;
}
__device__ const QOrder g_order = make_order();
__device__ __forceinline__ void ph_d_queue(Frame& F, const Args& a, int layer) {
    PHASE_IDS(F);
    unsigned* ctr = F.ctl + CW_Q + 64 * layer;
    const float* lv = a.in[5] + (size_t)layer * 128;
    const float lam_init = 0.8f - 0.6f * expf(-0.3f * (float)layer);
    float l01 = 0.f, l23 = 0.f; if (F.lane < 32) { l01 = lv[F.lane] * lv[32 + F.lane]; l23 = lv[64 + F.lane] * lv[96 + F.lane]; }
    const float lam = expf(wave_sum(l01)) - expf(wave_sum(l23)) + lam_init;
    constexpr int NQ = 64 + 256 + 256 + 768;
    for (;;) {
        __syncthreads();
        if (F.tid == 0) F.MISC[0] = __hip_atomic_fetch_add(ctr, 1u, __ATOMIC_RELAXED, __HIP_MEMORY_SCOPE_AGENT);
        __syncthreads();
        const int qi = (int)F.MISC[0];
        if (qi >= NQ) break;
        const int e = g_order.v[qi], ty = e >> 12, id = e & 4095;
        if (ty == 3) scan_item(F, id);
        else if (ty == 0) { const int qb = 15 - (id >> 4), bh = id & 15; diff_item(F, a, layer, bh >> 2, bh & 3, qb, lam); }
        else if (ty == 1) nsa_item(F, id & 3, 63 - (id >> 2));
        else { const int bh = id & 15, k = id >> 4;
            const int g = k >> 4, j = k & 15; const int res = (g == 0) ? 0 : (g == 1) ? (j & 3) : j, blk = (g == 0) ? j : (g == 1) ? (j >> 2) : 0;
            dil_item(F, bh >> 2, bh & 3, g, res, blk); }
    }
    __syncthreads();
}

constexpr int NPHASE = 9 * DEPTH + 1;
#ifndef PH_LO
#define PH_LO 0
#endif
#ifndef PH_HI
#define PH_HI NPHASE
#endif
#define IN(k) (PH_LO <= (k) && (k) < PH_HI)
#ifdef PROBE_K
#ifndef PROBE_SUB
#define PROBE_SUB 0
#endif
#ifndef PROBE_AMP
#define PROBE_AMP 10
#endif
#define PROBE_T0(k) do { if ((k) == PROBE_K) F.pt0 = __builtin_amdgcn_s_memrealtime(); } while (0)
#define PROBE_T1(k) do { if ((k) == PROBE_K) F.pdt = __builtin_amdgcn_s_memrealtime() - F.pt0; } while (0)
#define SUBP(id, call) do { if (layer == 0 && (id) == PROBE_SUB) { F.pt0 = __builtin_amdgcn_s_memrealtime(); call; __syncthreads(); F.pdt = __builtin_amdgcn_s_memrealtime() - F.pt0; } else { call; } } while (0)
#else
#define SUBP(id, call) do { call; } while (0)
#define PROBE_T0(k) do { } while (0)
#define PROBE_T1(k) do { } while (0)
#endif
#define SEAM(k) do { if (IN(k) && (k) + 1 < PH_HI) { if ((k) == PH_LO && F.G == 0x7fffffff) cg::this_grid().sync();   xcd_barrier(bar); } } while (0)
template <int layer> __device__ __forceinline__ void run_layer(Frame& F, const Args& args, const XcdBarrier& bar) {
    float* XR = args.out;
    bf16* H = (bf16*)(F.ws + WS_H); bf16* Z = (bf16*)(F.ws + WS_Z);
    bf16* WIN = (bf16*)(F.ws + WS_WIN); bf16* WOUT = (bf16*)(F.ws + WS_WOUT); bf16* WGU = (bf16*)(F.ws + WS_WGU); bf16* WD = (bf16*)(F.ws + WS_WD);

        const int P = 9 * layer;
        bf16* XB2 = (bf16*)(F.ws + WS_XB2); bf16* ACT = (bf16*)(F.ws + WS_ACT);
        PROBE_T0(P + 0);
        if (IN(P + 0)) {
            convert_weights(F, args, layer);
            if (layer == 0) build_rope(F, args);
            norm_rows_bf16(F, layer == 0 ? args.in[0] : XR, args.in[1] + (size_t)layer * DM, H);
        }
        SEAM(P + 0); PROBE_T1(P + 0);
        PROBE_T0(P + 1);
        if (IN(P + 1)) {
            pg8::Gemm g{H, WIN, T, DINP, DM}; pg8::StaticOrder S; S.init(T, DINP, F.G, (int)blockIdx.x);
            pg8::EpiZR E{Z, DINP, (const float*)(F.ws + WS_ROPE64), (const float*)(F.ws + WS_ROPE32), (bf16*)(F.ws + WS_AQR)};
            pg8::gemm_phase<pg8::EpiZR, pg8::StaticOrder, true, true>(F.lds3, g, S, E);
        }
        SEAM(P + 1); PROBE_T1(P + 1);
        PROBE_T0(P + 2);
        if (IN(P + 2)) { SUBP(1, prep_mlstm(F, args, layer)); SUBP(2, prep_compress(F, args, layer)); }
        SEAM(P + 2); PROBE_T1(P + 2);
        PROBE_T0(P + 3);
        if (IN(P + 3)) ph_d_queue(F, args, layer);
        SEAM(P + 3); PROBE_T1(P + 3);
        PROBE_T0(P + 4);
        if (IN(P + 4)) { SUBP(4, ph_mlstm_out(F, args, layer)); SUBP(5, dil_combine(F)); }
        SEAM(P + 4); PROBE_T1(P + 4);
        PROBE_T0(P + 5);
        if (IN(P + 5)) {
            pg8::Gemm g{H, WOUT, T, DM, DM}; pg8::StaticOrder S; S.init(T, DM, F.G, (int)blockIdx.x); pg8::EpiRes E{layer == 0 ? args.in[0] : XR, XR, DM};
            pg8::gemm_phase<pg8::EpiRes, pg8::StaticOrder, true, true>(F.lds3, g, S, E);
        }
        SEAM(P + 5); PROBE_T1(P + 5);
        PROBE_T0(P + 6);
        if (IN(P + 6)) norm_rows_bf16(F, XR, args.in[14] + (size_t)layer * DM, XB2);
        SEAM(P + 6); PROBE_T1(P + 6);
        PROBE_T0(P + 7);
        if (IN(P + 7)) {
            pg8::Gemm g{XB2, WGU, T, 2 * DFF, DM}; pg8::StaticOrder S; S.init(T, 2 * DFF, F.G, (int)blockIdx.x); pg8::EpiSwiGLU E{ACT, DFF};
            pg8::gemm_phase<pg8::EpiSwiGLU, pg8::StaticOrder, true, true>(F.lds3, g, S, E);
        }
        SEAM(P + 7); PROBE_T1(P + 7);
        PROBE_T0(P + 8);
        if (IN(P + 8)) {
            pg8::Gemm g{ACT, WD, T, DM, DFF}; pg8::StaticOrder S; S.init(T, DM, F.G, (int)blockIdx.x); pg8::EpiRes E{XR, XR, DM};
            pg8::gemm_phase<pg8::EpiRes, pg8::StaticOrder, true, true>(F.lds3, g, S, E);
        }
        SEAM(P + 8); PROBE_T1(P + 8);
}
__global__ void __launch_bounds__(NTHREADS, 2) fwd_kernel(Args args) {
    extern __shared__ __attribute__((aligned(16))) unsigned char lds[];
    Frame F;
    F.lds = lds; F.lds3 = (LAS unsigned char*)lds; F.MISC = (volatile LAS unsigned*)(F.lds3 + MISC_OFF);
    F.tid = threadIdx.x; F.lane = F.tid & 63; F.wave = __builtin_amdgcn_readfirstlane(F.tid >> 6);
    F.G = gridDim.x; F.gw = blockIdx.x * NWAVES + F.wave; F.ngw = F.G * NWAVES;
    F.ws = args.ws; F.ctl = (unsigned*)(args.ws + WS_CTL);
    for (int u = F.tid; u < (LDS_BYTES - LDSCTL_OFF) / 4; u += NTHREADS) ((LAS unsigned*)(F.lds3 + LDSCTL_OFF))[u] = 0u;
    __syncthreads();
    XcdBarrier bar = xcd_barrier_post(F.ctl + CW_BAR, F.MISC + 8);
    run_layer<0>(F, args, bar);
    run_layer<1>(F, args, bar);
    if (IN(9 * DEPTH)) final_norm(F, args.out, args.in[18]);
#ifdef PROBE_K
    if (blockIdx.x == 0) { const unsigned long long te = __builtin_amdgcn_s_memrealtime(); while (__builtin_amdgcn_s_memrealtime() - te < (unsigned long long)PROBE_AMP * F.pdt) __builtin_amdgcn_s_sleep(32); }
#endif
#undef IN
#undef SEAM
}

extern "C" void kernel_launch(void* const* d_in, const int* in_sizes, int n_in, void* d_out, int out_size, void* d_ws, size_t ws_size, hipStream_t stream) {
    static int grid = 0;
    if (grid == 0) {
        if (n_in != 19 || in_sizes[0] != T * DM || out_size != T * DM || ws_size < WS_END) { fprintf(stderr, "kernel_launch: unexpected shapes (n_in %d, in0 %d, out %d, ws %zu); nothing launched\n", n_in, n_in > 0 ? in_sizes[0] : -1, out_size, ws_size); grid = -1; return; }
        int dev = 0, cus = 0, per_cu = 0;
        if (hipGetDevice(&dev) != hipSuccess || hipDeviceGetAttribute(&cus, hipDeviceAttributeMultiprocessorCount, dev) != hipSuccess) { grid = -1; return; }
        if (hipFuncSetAttribute((const void*)fwd_kernel, hipFuncAttributeMaxDynamicSharedMemorySize, LDS_BYTES) != hipSuccess) { fprintf(stderr, "kernel_launch: hipFuncSetAttribute failed\n"); grid = -1; return; }
        if (hipOccupancyMaxActiveBlocksPerMultiprocessor(&per_cu, (const void*)fwd_kernel, NTHREADS, LDS_BYTES) != hipSuccess || per_cu < 1) { fprintf(stderr, "kernel_launch: note: occupancy query says %d blocks per CU\n", per_cu); (void)hipGetLastError(); }
        grid = cus;
    }
    if (grid < 0) return;
    if (hipMemsetAsync((char*)d_ws + WS_CTL, 0, CTL_ZERO_BYTES, stream) != hipSuccess) { fprintf(stderr, "kernel_launch: memset failed\n"); return; }
    Args a{};
    for (int i = 0; i < 19; ++i) a.in[i] = (const float*)d_in[i];
    a.out = (float*)d_out; a.ws = (unsigned char*)d_ws;
    for (int i = 0; i < 32; ++i) a.inv64[i] = 1.0f / powf(10000.0f, (float)(2 * i) / 64.0f);
    for (int i = 0; i < 16; ++i) a.inv32[i] = 1.0f / powf(10000.0f, (float)(2 * i) / 32.0f);
    void* params[] = {&a};
    const hipError_t le = hipLaunchCooperativeKernel((const void*)fwd_kernel, dim3(grid), dim3(NTHREADS), params, LDS_BYTES, stream);
    if (le != hipSuccess) fprintf(stderr, "kernel_launch: cooperative launch failed: %s (grid %d)\n", hipGetErrorName(le), grid);
}
```

```cpp
#include <hip/hip_runtime.h>
#include <hip/hip_cooperative_groups.h>
#include <cstdio>
#include <cstdint>
namespace cg = cooperative_groups;
namespace pg8 {
#define PG8_LAS __attribute__((address_space(3)))
typedef unsigned short bf16_t;
typedef short bf16x8 __attribute__((ext_vector_type(8)));
typedef float f32x4 __attribute__((ext_vector_type(4)));
typedef unsigned u32x4 __attribute__((ext_vector_type(4)));
constexpr int BM = 256, BK = 64, HALF = 128, HTB = HALF * BK * 2  , STAGE_BYTES = 8 * HTB, NXCD = 8, WGM = 8;

__host__ __device__ __forceinline__ int lds_byte(int r, int c) { const int st = (r >> 4) * 2 + (c >> 5), rr = r & 15, cc = c & 31, ob = rr * 64 + cc * 2; return st * 1024 + (ob ^ (((ob >> 9) & 1) << 5)); }
__host__ __device__ __forceinline__ void stage_rc(int b, int& R, int& C) { const int st = b / 1024, sb = b % 1024, swz = sb ^ (((sb >> 9) & 1) << 5); R = (st >> 1) * 16 + swz / 64; C = (st & 1) * 32 + (swz % 64) / 2; }
__host__ __device__ __forceinline__ int perm32(int rho) { const int n = rho >> 4, i = rho & 15; return 8 * (i >> 2) + 4 * n + (i & 3); }

struct Unit { int pm, pn; };
struct Gemm { const bf16_t* A; const bf16_t* Bt; int M, N, K; };

struct StaticOrder {
    int nM, nN, nwg, G, c;
    __host__ __device__ void init(int M, int N, int G_, int c_) { nM = M / BM; nN = N / BM; nwg = nM * nN; G = G_; c = c_; }
    __host__ __device__ bool next(int i, Unit& u) const {
        const long L = (long)i * G + c; if (L >= nwg) return false;
        int wgid = (int)L; { const int q = nwg / NXCD, r = nwg % NXCD, xcd = wgid % NXCD, off = wgid / NXCD; wgid = (xcd < r ? xcd * (q + 1) : r * (q + 1) + (xcd - r) * q) + off; }
        const int nig = WGM * nN, gid = wgid / nig, fm = gid * WGM, gsz = (nM - fm) < WGM ? (nM - fm) : WGM;
        u.pm = fm + ((wgid % nig) % gsz); u.pn = (wgid % nig) / gsz; return true;
    }
    __device__ __forceinline__ void a_ready(const Unit&) const {}
    __device__ __forceinline__ void done(const Unit&) const {}
};

__device__ __forceinline__ unsigned cvt_pk_bf16(float lo, float hi) { unsigned r; asm volatile("v_cvt_pk_bf16_f32 %0, %1, %2" : "=v"(r) : "v"(lo), "v"(hi)); return r; }
typedef float f32x2 __attribute__((ext_vector_type(2)));
struct EpiZR {
    static constexpr bool PERM = true, AFTER_DRAIN = false;
    bf16_t* O; int ldc; const float* r64; const float* r32; bf16_t* aqr;
    __device__ __forceinline__ void operator()(const f32x4 (&acc)[2][2][4][2], const Unit& u, int wr, int wc, int fr_, int fq_) const {
        int fr = fr_, fq = fq_; asm volatile("" : "+v"(fr), "+v"(fq));
        const int row0 = u.pm * BM + wr * 64 + fr, col0 = u.pn * BM + wc * 32 + 8 * fq;
        constexpr unsigned long long R64 = 0xFull | (1ull << 6) | (1ull << 8) | (0xFFull << 34), R32 = 0xFFull << 10;
        const int seg0 = col0 >> 6, seg1 = (col0 + HALF) >> 6;
        const bool a64 = (R64 >> seg0) & 1ull, a32 = (R32 >> seg0) & 1ull, b64 = (R64 >> seg1) & 1ull, b32 = (R32 >> seg1) & 1ull;
        const bool any64 = a64 || b64, any32 = a32 || b32;
        const int i64 = (col0 & 63) >> 1, i32 = (col0 & 31) >> 1;
#pragma unroll
        for (int ai = 0; ai < 2; ++ai)
#pragma unroll
            for (int m = 0; m < 4; ++m) { const int row = row0 + ai * HALF + m * 16; const int pos = row & 4095; bf16_t* rowp = O + (size_t)row * ldc + col0;
                f32x4 c64a = {0.f, 0.f, 0.f, 0.f}, c64b = c64a, c32a = c64a, c32b = c64a;
                if (any64) { const float* tp = r64 + ((size_t)pos * 32 + i64) * 2; c64a = *(const f32x4*)tp; c64b = *(const f32x4*)(tp + 4); }
                if (any32) { const float* tp = r32 + ((size_t)pos * 16 + i32) * 2; c32a = *(const f32x4*)tp; c32b = *(const f32x4*)(tp + 4); }
#pragma unroll
                for (int bj = 0; bj < 2; ++bj) { const int c0 = col0 + bj * HALF, seg = bj ? seg1 : seg0;
                    const float qs = (seg < 4 || (seg >= 34 && seg < 38)) ? 0.125f * 1.4426950408889634f : (seg >= 10 && seg < 14) ? 0.17677669529663687f * 1.4426950408889634f : 1.0f;
                    f32x4 v0 = acc[ai][bj][m][0] * qs, v1 = acc[ai][bj][m][1] * qs;
                    const bool t64 = bj ? b64 : a64, t32 = bj ? b32 : a32;
                    if (t64 || t32) {
                        const f32x4 ca = t64 ? c64a : c32a, cb = t64 ? c64b : c32b;
                        const f32x4 o0 = {v0[0] * ca[0] - v0[1] * ca[1], v0[0] * ca[1] + v0[1] * ca[0], v0[2] * ca[2] - v0[3] * ca[3], v0[2] * ca[3] + v0[3] * ca[2]};
                        const f32x4 o1 = {v1[0] * cb[0] - v1[1] * cb[1], v1[0] * cb[1] + v1[1] * cb[0], v1[2] * cb[2] - v1[3] * cb[3], v1[2] * cb[3] + v1[3] * cb[2]};
                        if (seg < 4) { u32x4 wq; wq.x = cvt_pk_bf16(o0[0], o0[1]); wq.y = cvt_pk_bf16(o0[2], o0[3]); wq.z = cvt_pk_bf16(o1[0], o1[1]); wq.w = cvt_pk_bf16(o1[2], o1[3]); *(u32x4*)(aqr + (size_t)row * 256 + c0) = wq; }
                        else { v0 = o0; v1 = o1; }
                    }
                    u32x4 w; w.x = cvt_pk_bf16(v0[0], v0[1]); w.y = cvt_pk_bf16(v0[2], v0[3]); w.z = cvt_pk_bf16(v1[0], v1[1]); w.w = cvt_pk_bf16(v1[2], v1[3]);
                    *(u32x4*)(rowp + bj * HALF) = w; } }
    }
};
struct EpiRes {
    static constexpr bool PERM = false, AFTER_DRAIN = false;
    const float* base; float* out; int ldc;
    __device__ __forceinline__ void operator()(const f32x4 (&acc)[2][2][4][2], const Unit& u, int wr, int wc, int fr, int fq) const {
        const int row0 = u.pm * BM + wr * 64 + fr, col0 = u.pn * BM + wc * 32 + 4 * fq;
#pragma unroll
        for (int ai = 0; ai < 2; ++ai)
#pragma unroll
            for (int m = 0; m < 4; ++m) { const size_t off = (size_t)(row0 + ai * HALF + m * 16) * ldc + col0;
#pragma unroll
                for (int bj = 0; bj < 2; ++bj)
#pragma unroll
                    for (int n = 0; n < 2; ++n) { const size_t p = off + bj * HALF + n * 16; const f32x4 b = *(const f32x4*)(base + p); *(f32x4*)(out + p) = b + acc[ai][bj][m][n]; } }
    }
};
struct EpiSwiGLU {
    static constexpr bool PERM = true, AFTER_DRAIN = false;
    bf16_t* O; int ldc;
    __device__ __forceinline__ void operator()(const f32x4 (&acc)[2][2][4][2], const Unit& u, int wr, int wc, int fr, int fq) const {
        const int row0 = u.pm * BM + wr * 64 + fr, col0 = u.pn * HALF + wc * 32 + 8 * fq;
#pragma unroll
        for (int ai = 0; ai < 2; ++ai)
#pragma unroll
            for (int m = 0; m < 4; ++m) { const int row = row0 + ai * HALF + m * 16; bf16_t* rowp = O + (size_t)row * ldc + col0;
                float r[8];
#pragma unroll
                for (int n = 0; n < 2; ++n)
#pragma unroll
                    for (int j = 0; j < 4; ++j) { const float g = acc[ai][0][m][n][j], up = acc[ai][1][m][n][j]; r[4 * n + j] = g * __builtin_amdgcn_rcpf(1.0f + __expf(-g)) * up; }
                u32x4 w; w.x = cvt_pk_bf16(r[0], r[1]); w.y = cvt_pk_bf16(r[2], r[3]); w.z = cvt_pk_bf16(r[4], r[5]); w.w = cvt_pk_bf16(r[6], r[7]);
                *(u32x4*)rowp = w; }
    }
};
template <class Epi, class Sched, bool ALIGN_EPI = false, bool SP2 = false>
__device__ __forceinline__ void gemm_phase(PG8_LAS unsigned char* lds, const Gemm g, const Sched& S, const Epi& E) {
    int tid_ = threadIdx.x; asm volatile("" : "+v"(tid_));
    const int tid = tid_, wid = __builtin_amdgcn_readfirstlane(tid >> 6), lane = tid & 63, wr = wid >> 2, wc = wid & 3, fr = lane & 15, fq = lane >> 4;
    const int K = g.K, nt = K / BK;
    unsigned voffA[2], voffB[2];
#pragma unroll
    for (int i = 0; i < 2; ++i) { int R, C; stage_rc(tid * 16 + i * 8192, R, C); const int Rb = Epi::PERM ? ((R & ~31) + perm32(R & 31)) : R;
        voffA[i] = (unsigned)(R * K + C) * 2u; voffB[i] = (unsigned)(Rb * K + C) * 2u; }
    const size_t kstep = (size_t)(BK * 2);
    const size_t hstep = (size_t)HALF * K * 2;
    const size_t tstep = 2 * hstep;
    const unsigned ldsw = (unsigned)wid * 1024u;
    const int aoff = lds_byte(wr * 64 + fr, fq * 8), boff = lds_byte(wc * 32 + fr, fq * 8);
#define PG8_SA(b, h) (((b) * 2 + (h)) * HTB)
#define PG8_SB(b, h) ((4 + (b) * 2 + (h)) * HTB)
#define PG8_STAGE(bufoff, gbase, voff) do { _Pragma("unroll") for (int _i = 0; _i < 2; ++_i) \
        __builtin_amdgcn_global_load_lds((const unsigned*)((const char*)(gbase) + (voff)[_i]), (PG8_LAS unsigned*)(lds + (bufoff) + ldsw + _i * 8192), 16, 0, 0); } while (0)
#define PG8_LDA(dst, b, h) do { _Pragma("unroll") for (int m = 0; m < 4; ++m) _Pragma("unroll") for (int k = 0; k < 2; ++k) dst[m][k] = *(const PG8_LAS bf16x8*)(lds + PG8_SA(b, h) + aoff + m * 2048 + k * 1024); } while (0)
#define PG8_LDB(dst, b, h) do { _Pragma("unroll") for (int n = 0; n < 2; ++n) _Pragma("unroll") for (int k = 0; k < 2; ++k) dst[n][k] = *(const PG8_LAS bf16x8*)(lds + PG8_SB(b, h) + boff + n * 2048 + k * 1024); } while (0)
#define PG8_MMA(ai, bj, At, Bt) do { __builtin_amdgcn_s_setprio(1); _Pragma("unroll") for (int m = 0; m < 4; ++m) _Pragma("unroll") for (int n = 0; n < 2; ++n) _Pragma("unroll") for (int k = 0; k < 2; ++k) \
        acc[ai][bj][m][n] = __builtin_amdgcn_mfma_f32_16x16x32_bf16(Bt[n][k], At[m][k], acc[ai][bj][m][n], 0, 0, 0); __builtin_amdgcn_s_setprio(0); } while (0)
#define PG8_WAIT_V(n) asm volatile("s_waitcnt vmcnt(" #n ")" ::: "memory")
#define PG8_WAIT_L(n) asm volatile("s_waitcnt lgkmcnt(" #n ")" ::: "memory")
#define PG8_BAR __builtin_amdgcn_s_barrier()
#define PG8_SCHED __builtin_amdgcn_sched_barrier(0)
    Unit cur, nxt; int ui = 0;
    if (!S.next(0, cur)) return;
    f32x4 acc[2][2][4][2];
#pragma unroll
    for (int a = 0; a < 2; ++a)
#pragma unroll
        for (int b = 0; b < 2; ++b)
#pragma unroll
            for (int m = 0; m < 4; ++m)
#pragma unroll
                for (int n = 0; n < 2; ++n) acc[a][b][m][n] = (f32x4){0.f, 0.f, 0.f, 0.f};
    bf16x8 At[4][2], B0[2][2], B1[2][2];
    const char* cA = (const char*)g.A + (size_t)cur.pm * tstep; const char* cB = (const char*)g.Bt + (size_t)cur.pn * tstep;
    S.a_ready(cur);
    if constexpr (SP2) {
        PG8_STAGE(PG8_SB(0, 0), cB, voffB); PG8_STAGE(PG8_SB(0, 1), cB + hstep, voffB); PG8_STAGE(PG8_SA(0, 0), cA, voffA); PG8_STAGE(PG8_SA(0, 1), cA + hstep, voffA);
        if (wr == 1) PG8_BAR;
        PG8_WAIT_V(2); PG8_BAR;
        PG8_STAGE(PG8_SB(1, 0), cB + kstep, voffB); PG8_STAGE(PG8_SA(1, 0), cA + kstep, voffA); PG8_STAGE(PG8_SB(1, 1), cB + hstep + kstep, voffB);
        PG8_WAIT_V(6); PG8_BAR;
    } else {
        PG8_STAGE(PG8_SB(0, 0), cB, voffB); PG8_STAGE(PG8_SA(0, 0), cA, voffA); PG8_STAGE(PG8_SB(0, 1), cB + hstep, voffB); PG8_STAGE(PG8_SA(0, 1), cA + hstep, voffA);
        if (wr == 1) PG8_BAR;
        PG8_WAIT_V(4); PG8_BAR;
        PG8_STAGE(PG8_SB(1, 0), cB + kstep, voffB); PG8_STAGE(PG8_SA(1, 0), cA + kstep, voffA); PG8_STAGE(PG8_SB(1, 1), cB + hstep + kstep, voffB);
        PG8_WAIT_V(6); PG8_BAR;
    }
    for (;;) {
        const bool has_next = S.next(ui + 1, nxt);
        const char* nA = has_next ? (const char*)g.A + (size_t)nxt.pm * tstep : cA; const char* nB = has_next ? (const char*)g.Bt + (size_t)nxt.pn * tstep : cB;
        for (int t = 0; t < nt; t += 2) {
            const bool last = (t == nt - 2);
            const char* a1 = cA + (size_t)(t + 1) * kstep;
            const char* a2 = last ? nA : cA + (size_t)(t + 2) * kstep; const char* b2 = last ? nB : cB + (size_t)(t + 2) * kstep;
            const char* a3 = a2 + kstep; const char* b3 = b2 + kstep;
            if (last && has_next) S.a_ready(nxt);
            if constexpr (SP2) {
            PG8_LDB(B0, 0, 0); PG8_LDB(B1, 0, 1); PG8_SCHED; PG8_LDA(At, 0, 0); PG8_STAGE(PG8_SA(1, 1), a1 + hstep, voffA);
            PG8_WAIT_V(8); PG8_WAIT_L(0); PG8_BAR; PG8_MMA(0, 0, At, B0); PG8_MMA(0, 1, At, B1); PG8_BAR; PG8_SCHED;
            PG8_LDA(At, 0, 1); PG8_STAGE(PG8_SB(0, 0), b2, voffB); PG8_STAGE(PG8_SB(0, 1), b2 + hstep, voffB); PG8_STAGE(PG8_SA(0, 0), a2, voffA);
            PG8_WAIT_V(8); PG8_WAIT_L(0); PG8_BAR; PG8_MMA(1, 0, At, B0); PG8_MMA(1, 1, At, B1); PG8_BAR; PG8_SCHED;
            PG8_LDB(B0, 1, 0); PG8_LDB(B1, 1, 1); PG8_SCHED; PG8_LDA(At, 1, 0); PG8_STAGE(PG8_SA(0, 1), a2 + hstep, voffA);
            PG8_WAIT_V(8); PG8_WAIT_L(0); PG8_BAR; PG8_MMA(0, 0, At, B0); PG8_MMA(0, 1, At, B1); PG8_BAR; PG8_SCHED;
            PG8_LDA(At, 1, 1); PG8_STAGE(PG8_SB(1, 0), b3, voffB); PG8_STAGE(PG8_SB(1, 1), b3 + hstep, voffB); PG8_STAGE(PG8_SA(1, 0), a3, voffA);
            PG8_WAIT_V(8); PG8_WAIT_L(0); PG8_BAR; PG8_MMA(1, 0, At, B0); PG8_MMA(1, 1, At, B1); PG8_BAR; PG8_SCHED;
            } else {
            PG8_LDB(B0, 0, 0); PG8_SCHED; PG8_LDA(At, 0, 0); PG8_STAGE(PG8_SA(1, 1), a1 + hstep, voffA);
            PG8_WAIT_L(8); PG8_BAR; PG8_WAIT_L(0); PG8_MMA(0, 0, At, B0); PG8_BAR; PG8_SCHED;
            PG8_LDB(B1, 0, 1); PG8_STAGE(PG8_SB(0, 0), b2, voffB);
            PG8_BAR; PG8_WAIT_L(0); PG8_MMA(0, 1, At, B1); PG8_BAR;
            PG8_LDA(At, 0, 1); PG8_STAGE(PG8_SA(0, 0), a2, voffA);
            PG8_BAR; PG8_WAIT_L(0); PG8_MMA(1, 0, At, B0); PG8_BAR; PG8_SCHED;
            PG8_STAGE(PG8_SB(0, 1), b2 + hstep, voffB);
            PG8_WAIT_V(6); PG8_BAR; PG8_MMA(1, 1, At, B1); PG8_BAR;
            PG8_LDB(B0, 1, 0); PG8_SCHED; PG8_LDA(At, 1, 0); PG8_STAGE(PG8_SA(0, 1), a2 + hstep, voffA);
            PG8_WAIT_L(8); PG8_BAR; PG8_WAIT_L(0); PG8_MMA(0, 0, At, B0); PG8_BAR; PG8_SCHED;
            PG8_LDB(B1, 1, 1); PG8_STAGE(PG8_SB(1, 0), b3, voffB);
            PG8_BAR; PG8_WAIT_L(0); PG8_MMA(0, 1, At, B1); PG8_BAR;
            PG8_LDA(At, 1, 1); PG8_STAGE(PG8_SA(1, 0), a3, voffA);
            PG8_BAR; PG8_WAIT_L(0); PG8_MMA(1, 0, At, B0); PG8_BAR; PG8_SCHED;
            PG8_STAGE(PG8_SB(1, 1), b3 + hstep, voffB);
            PG8_WAIT_V(6); PG8_BAR; PG8_MMA(1, 1, At, B1); PG8_BAR;
            }
        }
        if constexpr (ALIGN_EPI) { if (wr == 0) PG8_BAR; }
        if constexpr (!Epi::AFTER_DRAIN) { E(acc, cur, wr, wc, fr, fq); S.done(cur); }
        if (!has_next) break;
#pragma unroll
        for (int a = 0; a < 2; ++a)
#pragma unroll
            for (int b = 0; b < 2; ++b)
#pragma unroll
                for (int m = 0; m < 4; ++m)
#pragma unroll
                    for (int n = 0; n < 2; ++n) acc[a][b][m][n] = (f32x4){0.f, 0.f, 0.f, 0.f};
        cur = nxt; cA = nA; cB = nB; ++ui;
        if constexpr (ALIGN_EPI) { if (wr == 1) PG8_BAR; }
    }
    PG8_WAIT_V(0);
    if constexpr (!ALIGN_EPI) { if (wr == 0) PG8_BAR; }
    PG8_BAR;
    if constexpr (Epi::AFTER_DRAIN) { E.fused(acc, cur, wr, wc, fr, fq, lds, wid, lane); S.done(cur); }
#undef PG8_SA
#undef PG8_SB
#undef PG8_STAGE
#undef PG8_LDA
#undef PG8_LDB
#undef PG8_MMA
#undef PG8_WAIT_V
#undef PG8_WAIT_L
#undef PG8_BAR
#undef PG8_SCHED
}
}

constexpr int NB = 4, SEQ = 4096, T = NB * SEQ, DM = 1024, DIN = 2964, DINP = 3072, DFF = 2816, DEPTH = 2;
constexpr int NWAVES = 8, NTHREADS = 512;
constexpr float EPS = 1e-6f;
constexpr int ZAQ = 0, ZKC = 256, ZVC = 320, ZKS = 384, ZVS = 448, ZKW = 512, ZVW = 576, ZBQ = 640, ZBK = 896, ZBV = 1152,
              ZCU = 1408, ZCV = 1664, ZCO = 1920, ZDQ = 2176, ZDK = 2432, ZDV = 2688, ZAG = 2944, ZCI = 2956, ZCF = 2960;
__host__ __device__ __forceinline__ int pi64(int p) { return (p & 1) ? 32 + (p >> 1) : (p >> 1); }
__host__ __device__ __forceinline__ int pi32(int p) { return (p & 1) ? 16 + (p >> 1) : (p >> 1); }
__host__ __device__ __forceinline__ int zsrc(int n) {
    const int seg = n >> 6, p = n & 63;
    const bool r64 = seg < 4 || seg == 6 || seg == 8 || (seg >= 34 && seg < 42), r32 = seg >= 10 && seg < 18;
    const int q = r64 ? pi64(p) : r32 ? (p & 32) + pi32(p & 31) : p; const int m = seg * 64 + q;
    if (m < 640) return m;
    if (m < 1920) return m + 12;
    if (m < 2944) return m + 20;
    if (m < 2956) return m - 2944 + 640;
    if (m < 2960) return m - 2956 + 1932;
    if (m < 2964) return m - 2960 + 1936;
    return -1;
}
constexpr size_t MiB = 1u << 20;
constexpr size_t WS_CTL = 0, CTL_ZERO_BYTES = 1 * MiB;
constexpr size_t WS_WIN = 2 * MiB, WS_WOUT = 8 * MiB, WS_WGU = 10 * MiB, WS_WD = 21 * MiB;
constexpr size_t WS_ROPE64 = 27 * MiB, WS_ROPE32 = 28 * MiB;
constexpr size_t WS_KC = 29 * MiB, WS_VC = WS_KC + 256 * 1024;
constexpr size_t WS_SEL = WS_VC + 256 * 1024;
constexpr size_t WS_BCUM = 30 * MiB, WS_IG = WS_BCUM + 256 * 1024, WS_NLOC = WS_IG + 256 * 1024;
constexpr size_t WS_ACH = WS_NLOC + 256 * 1024, WS_MLOC = WS_ACH + 4096, WS_MIN = WS_MLOC + 4096;
constexpr size_t WS_WCT = 26 * MiB + 512 * 1024;
constexpr size_t WS_CBP = 28 * MiB + 512 * 1024;
constexpr size_t WS_DLSE = 31 * MiB;
constexpr size_t WS_H = 32 * MiB;
constexpr size_t WS_Z = 64 * MiB;
constexpr size_t WS_XB2 = 64 * MiB, WS_ACT = 96 * MiB;
constexpr size_t WS_AQR = 160 * MiB, WS_OCMP = 168 * MiB, WS_DPART = 176 * MiB;
constexpr size_t WS_MQ = 200 * MiB, WS_MK = 216 * MiB, WS_CLOC = 232 * MiB, WS_END = 248 * MiB;
constexpr int CW_BAR = 4096;
constexpr int CW_Q = 16384;
constexpr int RING_BYTES = 131072, LDSCTL_OFF = RING_BYTES, MISC_OFF = LDSCTL_OFF + 320, LDS_BYTES = 147456;

#define GAS __attribute__((address_space(1)))
#define LAS __attribute__((address_space(3)))
typedef unsigned short bf16;
typedef unsigned v4u __attribute__((ext_vector_type(4)));
typedef unsigned v2u __attribute__((ext_vector_type(2)));
typedef float f32x4 __attribute__((ext_vector_type(4)));
typedef float f32x2 __attribute__((ext_vector_type(2)));
#define LDS_WAIT() asm volatile("s_waitcnt lgkmcnt(0)" ::: "memory")
#define VM_WAIT() asm volatile("s_waitcnt vmcnt(0)" ::: "memory")
__device__ __forceinline__ unsigned f2bf(float f) { unsigned u = __builtin_bit_cast(unsigned, f); return (u + 0x7fffu + ((u >> 16) & 1u)) >> 16; }
__device__ __forceinline__ unsigned pk2(float lo, float hi) { return f2bf(lo) | (f2bf(hi) << 16); }
__device__ __forceinline__ float bf2f(bf16 u) { return __uint_as_float(((unsigned)u) << 16); }
__device__ __forceinline__ float bflo(unsigned w) { return __uint_as_float(w << 16); }
__device__ __forceinline__ float bfhi(unsigned w) { return __uint_as_float(w & 0xffff0000u); }
template <int K> __device__ __forceinline__ int sx_i(int v) {
    if constexpr (K == 1) return __builtin_amdgcn_update_dpp(v, v, 0xB1, 0xF, 0xF, false);
    else if constexpr (K == 2) return __builtin_amdgcn_update_dpp(v, v, 0x4E, 0xF, 0xF, false);
    else return __builtin_amdgcn_ds_swizzle(v, (K << 10) | 0x1f);
}
template <int K> __device__ __forceinline__ float sx(float v) { return __builtin_bit_cast(float, sx_i<K>(__builtin_bit_cast(int, v))); }
__device__ __forceinline__ void swap32(unsigned v, unsigned& a, unsigned& b) { unsigned w = v; asm volatile("" : "+v"(w)); const auto rr = __builtin_amdgcn_permlane32_swap(v, w, false, false); a = rr[0]; b = rr[1]; }
__device__ __forceinline__ float sum32(float v) { unsigned a, b; swap32(__builtin_bit_cast(unsigned, v), a, b); return __builtin_bit_cast(float, a) + __builtin_bit_cast(float, b); }
__device__ __forceinline__ float max32(float v) { unsigned a, b; swap32(__builtin_bit_cast(unsigned, v), a, b); return fmaxf(__builtin_bit_cast(float, a), __builtin_bit_cast(float, b)); }
__device__ __forceinline__ unsigned or32(unsigned v) { unsigned a, b; swap32(v, a, b); return a | b; }
__device__ __forceinline__ float lane_get(float v, int src) { return __builtin_bit_cast(float, __builtin_amdgcn_ds_bpermute(src << 2, __builtin_bit_cast(int, v))); }
__device__ __forceinline__ float wave_sum(float v) { v += sx<1>(v); v += sx<2>(v); v += sx<4>(v); v += sx<8>(v); v += sx<16>(v); return sum32(v); }
__device__ __forceinline__ float wave_max(float v) { v = fmaxf(v, sx<1>(v)); v = fmaxf(v, sx<2>(v)); v = fmaxf(v, sx<4>(v)); v = fmaxf(v, sx<8>(v)); v = fmaxf(v, sx<16>(v)); return max32(v); }
__device__ __forceinline__ float sigmoidf_(float x) { return 1.0f / (1.0f + __expf(-x)); }
#define XB_TMO      128
#define XB_XCNT(j)  (256  + 64 * (j))
#define XB_XSUB(j)  (1280 + 64 * (j))
#define XB_XGEN(j)  (2304 + 64 * (j))
#define XB_TOP      3328
#define XB_TOPGEN   3392
#define XCD_BAR_WORDS 3456
#define XB_SPIN_CAP (1u << 18)

__device__ __forceinline__ unsigned xb_ld(unsigned* p)              { return __hip_atomic_load(p, __ATOMIC_RELAXED, __HIP_MEMORY_SCOPE_AGENT); }
__device__ __forceinline__ unsigned xb_add(unsigned* p, unsigned v) { return __hip_atomic_fetch_add(p, v, __ATOMIC_RELAXED, __HIP_MEMORY_SCOPE_AGENT); }
__device__ __forceinline__ unsigned xb_xcc_id() { return (unsigned)__builtin_amdgcn_s_getreg((3 << 11) | 20) & 0xFu; }
#define XB_SPIN(cond, bar) do { unsigned _sp = 0; while (cond) { __builtin_amdgcn_s_sleep(1); \
    if ((++_sp & 255u) == 0u) { if (xb_ld(&(bar)[XB_TMO])) break; if (_sp > XB_SPIN_CAP) { atomicAdd(&(bar)[XB_TMO], 1u); break; } } } } while (0)

struct XcdBarrier {
    unsigned* bar; unsigned x;
    volatile LAS unsigned* st;
};

__device__ __forceinline__ XcdBarrier xcd_barrier_post(unsigned* bar, volatile LAS unsigned* st) {
    XcdBarrier b; b.bar = bar; b.x = xb_xcc_id(); b.st = st;
    if (threadIdx.x == 0) (void)xb_add(&bar[XB_XCNT(b.x)], 1u);
    return b;
}
__device__ __forceinline__ void xcd_barrier_complete(unsigned* bar, unsigned x, unsigned& nloc, unsigned& nx) {
    const unsigned G = gridDim.x * gridDim.y * gridDim.z;
    unsigned sum, cnt, mine, sp = 0u;
    for (;;) {
        sum = 0u; cnt = 0u; mine = 0u;
#pragma unroll 1
        for (unsigned j = 0; j < 16; ++j) { const unsigned c = xb_ld(&bar[XB_XCNT(j)]); sum += c; cnt += (c > 0u) ? 1u : 0u; mine = (j == x) ? c : mine; }
        if (sum == G) break;
        __builtin_amdgcn_s_sleep(1);
        if ((++sp & 255u) == 0u) { if (xb_ld(&bar[XB_TMO])) break; if (sp > XB_SPIN_CAP) { atomicAdd(&bar[XB_TMO], 1u); break; } }
    }
    nloc = mine > 0u ? mine : 1u; nx = cnt > 0u ? cnt : 1u;
}

__device__ __forceinline__ void xcd_barrier(const XcdBarrier& b) {
    asm volatile("s_waitcnt vmcnt(0)" ::: "memory");
    __syncthreads();
    if (threadIdx.x == 0) {
        unsigned* bar = b.bar;
        __builtin_amdgcn_s_waitcnt(0);
        unsigned nloc = b.st[0], nx = b.st[1];
        if (nloc == 0u) { xcd_barrier_complete(bar, b.x, nloc, nx); b.st[0] = nloc; b.st[1] = nx; }
        const unsigned old = xb_add(&bar[XB_XSUB(b.x)], 1u);
        const unsigned gen = old / nloc;
        if (old + 1u == (gen + 1u) * nloc) {
            __builtin_amdgcn_fence(__ATOMIC_RELEASE, "agent");
            asm volatile("s_waitcnt vmcnt(0)" ::: "memory");
            const unsigned og = xb_add(&bar[XB_TOP], 1u);
            const unsigned tg = og / nx;
            if (og + 1u == (tg + 1u) * nx) xb_add(&bar[XB_TOPGEN], 1u);
            else XB_SPIN(xb_ld(&bar[XB_TOPGEN]) == tg, bar);
            __builtin_amdgcn_fence(__ATOMIC_ACQUIRE, "agent");
            xb_add(&bar[XB_XGEN(b.x)], 1u);
            asm volatile("s_waitcnt vmcnt(0)" ::: "memory");
        } else {
            XB_SPIN(xb_ld(&bar[XB_XGEN(b.x)]) == gen, bar);
            __builtin_amdgcn_fence(__ATOMIC_ACQUIRE, "agent");
            asm volatile("s_waitcnt vmcnt(0)" ::: "memory");
        }
    }
    __syncthreads();
}

struct Args { const float* in[19]; float* out; unsigned char* ws; float inv64[32]; float inv32[16]; };
struct Frame {
    unsigned char* lds;
    LAS unsigned char* lds3;
    volatile LAS unsigned* MISC;
    unsigned* ctl;
    unsigned char* ws;
    int tid, lane, wave, G, gw, ngw;
    unsigned long long pt0, pdt;
};
#define PHASE_IDS(F) do { int t_ = threadIdx.x; asm volatile("" : "+v"(t_)); (F).tid = t_; (F).lane = t_ & 63; (F).wave = __builtin_amdgcn_readfirstlane(t_ >> 6); (F).gw = blockIdx.x * NWAVES + (F).wave; } while (0)


__device__ __forceinline__ void transpose_item(const float* W, int K, int N, int srccol  , bf16* WT, int n0, int k0, float* scr, int lane, const float* gain = nullptr  ) {
#pragma unroll
    for (int i = 0; i < 32; ++i) { const int kk = 2 * i + (lane >> 5); scr[kk * 33 + (lane & 31)] = srccol >= 0 ? W[(size_t)(k0 + kk) * N + srccol] * (gain ? gain[k0 + kk] : 1.0f) : 0.f; }
    LDS_WAIT(); asm volatile("" ::: "memory");
    const int c = lane & 7;
#pragma unroll
    for (int j = 0; j < 4; ++j) { const int n = (lane >> 3) + 8 * j; const float* s = scr + (8 * c) * 33 + n;
        v4u o; o.x = pk2(s[0 * 33], s[1 * 33]); o.y = pk2(s[2 * 33], s[3 * 33]); o.z = pk2(s[4 * 33], s[5 * 33]); o.w = pk2(s[6 * 33], s[7 * 33]);
        *(v4u*)(WT + (size_t)(n0 + n) * K + k0 + 8 * c) = o; }
    LDS_WAIT(); asm volatile("" ::: "memory");
}
template <class CMap>
__device__ __forceinline__ void convert_tile(Frame& F, const float* W, int N, int K, int k0, int scol0, bf16* WT, int n0, CMap cmap) {
    bf16* Tl = (bf16*)F.lds;
    const int t = F.tid;
    f32x4 v[8];
#pragma unroll
    for (int i = 0; i < 8; ++i) v[i] = *(const f32x4*)(W + (size_t)(k0 + 16 * i + (t >> 5)) * N + scol0 + (t & 31) * 4);
    __syncthreads();
#pragma unroll
    for (int i = 0; i < 8; ++i) { v2u w; w.x = pk2(v[i].x, v[i].y); w.y = pk2(v[i].z, v[i].w); *(v2u*)(Tl + (16 * i + (t >> 5)) * 136 + (t & 31) * 4) = w; }
    __syncthreads();
    const int n = t >> 2, kq = (t & 3) * 32, sc = cmap(n);
    const bf16* src = Tl + kq * 136 + sc; unsigned wv[16];
#pragma unroll
    for (int j = 0; j < 16; ++j) wv[j] = (unsigned)src[(2 * j) * 136] | ((unsigned)src[(2 * j + 1) * 136] << 16);
    v4u* dst = (v4u*)(WT + (size_t)(n0 + n) * K + k0 + kq);
#pragma unroll
    for (int j = 0; j < 4; ++j) dst[j] = (v4u){wv[4 * j], wv[4 * j + 1], wv[4 * j + 2], wv[4 * j + 3]};
}
__device__ __forceinline__ void convert_weights(Frame& F, const Args& a, int layer) {
    PHASE_IDS(F);
    const float* w_in = a.in[2] + (size_t)layer * DM * DIN; const float* w_out = a.in[13] + (size_t)layer * DM * DM;
    const float* w_gate = a.in[15] + (size_t)layer * DM * DFF; const float* w_up = a.in[16] + (size_t)layer * DM * DFF; const float* w_down = a.in[17] + (size_t)layer * DFF * DM;
    bf16* WIN = (bf16*)(F.ws + WS_WIN); bf16* WOUT = (bf16*)(F.ws + WS_WOUT); bf16* WGU = (bf16*)(F.ws + WS_WGU); bf16* WD = (bf16*)(F.ws + WS_WD);
    constexpr int B_IN = 8 * 23, B_OUT = 8 * 8, B_GU = 8 * 44, B_D = 22 * 8, NB_ITEMS = B_IN + B_OUT + B_GU + B_D;
    for (int it = blockIdx.x; it < NB_ITEMS; it += F.G) {
        int r = it;
        if (r < B_IN) { const int kt = r / 23, nt = r % 23, n0 = nt * 128, shift = n0 < 640 ? 0 : n0 < 1920 ? 12 : 20;
            convert_tile(F, w_in, DIN, DM, kt * 128, n0 + shift, WIN, n0, [=](int n) { return zsrc(n0 + n) - (n0 + shift); }); continue; } r -= B_IN;
        if (r < B_OUT) { const int kt = r >> 3, nt = r & 7; convert_tile(F, w_out, DM, DM, kt * 128, nt * 128, WOUT, nt * 128, [](int n) { return n; }); continue; } r -= B_OUT;
        if (r < B_GU) { const int kt = r / 44, nt = r % 44, n0 = nt * 128, pn = n0 >> 8; convert_tile(F, (n0 & 128) ? w_up : w_gate, DFF, DM, kt * 128, 128 * pn, WGU, n0, [](int n) { return n; }); continue; } r -= B_GU;
        { const int kt = r >> 3, nt = r & 7; convert_tile(F, w_down, DM, DFF, kt * 128, nt * 128, WD, nt * 128, [](int n) { return n; }); }
    }
    __syncthreads();
    float* scr = (float*)(F.lds + 40960 + F.wave * 8704);
    constexpr int I_IN = (DM / 64) * 4, I_C = 2 * (2048 / 64) * (64 / 32), I_CB = 64, NITEMS = I_IN + I_C + I_CB;
    const float* cmp_w = a.in[4] + (size_t)layer * 2 * 2048 * 64; const float* cmp_pos = a.in[3] + (size_t)layer * 2 * 2048; bf16* WCT = (bf16*)(F.ws + WS_WCT); float* CBP = (float*)(F.ws + WS_CBP);
    for (int it = F.gw; it < NITEMS; it += F.ngw) {
        int r = it; const int l31 = F.lane & 31;
        if (r < I_IN) { const int kb = r >> 2, nb = 92 + (r & 3); transpose_item(w_in, DM, DIN, zsrc(nb * 32 + l31), WIN, nb * 32, kb * 64, scr, F.lane); continue; } r -= I_IN;
        if (r < I_C) { const int br = r >> 6, q = r & 63, kb = q >> 1, nb = q & 1; transpose_item(cmp_w + (size_t)br * 2048 * 64, 2048, 64, br == 0 ? pi64(nb * 32 + l31) : nb * 32 + l31, WCT + (size_t)br * 64 * 2048, nb * 32, kb * 64, scr, F.lane); continue; } r -= I_C;
        { const int br = r >> 5, ch = r & 31; float acc = 0.f;
#pragma unroll 8
          for (int k = ch * 64; k < ch * 64 + 64; ++k) acc += cmp_pos[br * 2048 + k] * cmp_w[((size_t)br * 2048 + k) * 64 + F.lane];
          CBP[(br * 32 + ch) * 64 + F.lane] = acc; }
    }
}
__device__ __forceinline__ void sincos_d(float ang, float& c, float& s) {
    const double a = (double)ang; const double q = __builtin_rint(a * 0.63661977236758134308); const double r = a - q * 1.57079632679489661923; const double r2 = r * r;
    double sp = -1.0 / 39916800.0; sp = sp * r2 + 1.0 / 362880.0; sp = sp * r2 - 1.0 / 5040.0; sp = sp * r2 + 1.0 / 120.0; sp = sp * r2 - 1.0 / 6.0; sp = sp * r2 + 1.0; sp *= r;
    double cp = 1.0 / 479001600.0; cp = cp * r2 - 1.0 / 3628800.0; cp = cp * r2 + 1.0 / 40320.0; cp = cp * r2 - 1.0 / 720.0; cp = cp * r2 + 1.0 / 24.0; cp = cp * r2 - 0.5; cp = cp * r2 + 1.0;
    const int n = ((int)q) & 3; const double cc = (n == 0) ? cp : (n == 1) ? -sp : (n == 2) ? -cp : sp; const double ss = (n == 0) ? sp : (n == 1) ? cp : (n == 2) ? -sp : -cp;
    c = (float)cc; s = (float)ss;
}
__device__ __forceinline__ void build_rope(Frame& F, const Args& a) {
    PHASE_IDS(F);
    f32x2* R64 = (f32x2*)(F.ws + WS_ROPE64); f32x2* R32 = (f32x2*)(F.ws + WS_ROPE32);
    const int gt = F.gw * 64 + F.lane, ngt = F.ngw * 64;
    for (int i = gt; i < SEQ * 48; i += ngt) { const int pos = i / 48, j = i % 48; float c, s;
        if (j < 32) { sincos_d((float)pos * a.inv64[j], c, s); R64[pos * 32 + j] = (f32x2){c, s}; }
        else { sincos_d((float)pos * a.inv32[j - 32], c, s); R32[pos * 16 + (j - 32)] = (f32x2){c, s}; } }
}
__device__ __forceinline__ void norm_rows_bf16(Frame& F, const float* X, const float* g, bf16* H) {
    PHASE_IDS(F);
    f32x4 gg[4];
#pragma unroll
    for (int j = 0; j < 4; ++j) gg[j] = ((const f32x4*)g)[64 * j + F.lane];
    for (int row0 = F.gw * 4; row0 < T; row0 += F.ngw * 4) {
        f32x4 v[4][4];
#pragma unroll
        for (int r = 0; r < 4; ++r)
#pragma unroll
            for (int j = 0; j < 4; ++j) v[r][j] = ((const f32x4*)(X + (size_t)(row0 + r) * DM))[64 * j + F.lane];
#pragma unroll
        for (int r = 0; r < 4; ++r) { float q = 0.f;
#pragma unroll
            for (int j = 0; j < 4; ++j) q += (v[r][j].x * v[r][j].x + v[r][j].y * v[r][j].y) + (v[r][j].z * v[r][j].z + v[r][j].w * v[r][j].w);
            const float rr = 1.0f / sqrtf(wave_sum(q) * (1.0f / DM) + EPS); v2u* o = (v2u*)(H + (size_t)(row0 + r) * DM) + F.lane;
#pragma unroll
            for (int j = 0; j < 4; ++j) { v2u w; w.x = pk2(v[r][j].x * rr * gg[j].x, v[r][j].y * rr * gg[j].y); w.y = pk2(v[r][j].z * rr * gg[j].z, v[r][j].w * rr * gg[j].w); o[64 * j] = w; } }
    }
}
__device__ __forceinline__ void final_norm(Frame& F, float* X, const float* g) {
    PHASE_IDS(F);
    f32x4 gg[4];
#pragma unroll
    for (int j = 0; j < 4; ++j) gg[j] = ((const f32x4*)g)[64 * j + F.lane];
    for (int row0 = F.gw * 4; row0 < T; row0 += F.ngw * 4) {
        f32x4 v[4][4];
#pragma unroll
        for (int r = 0; r < 4; ++r)
#pragma unroll
            for (int j = 0; j < 4; ++j) v[r][j] = ((const f32x4*)(X + (size_t)(row0 + r) * DM))[64 * j + F.lane];
#pragma unroll
        for (int r = 0; r < 4; ++r) { float q = 0.f;
#pragma unroll
            for (int j = 0; j < 4; ++j) q += (v[r][j].x * v[r][j].x + v[r][j].y * v[r][j].y) + (v[r][j].z * v[r][j].z + v[r][j].w * v[r][j].w);
            const float rr = 1.0f / sqrtf(wave_sum(q) * (1.0f / DM) + EPS); f32x4* o = (f32x4*)(X + (size_t)(row0 + r) * DM) + F.lane;
#pragma unroll
            for (int j = 0; j < 4; ++j) o[64 * j] = v[r][j] * rr * gg[j]; }
    }
}

__device__ __forceinline__ void prep_compress(Frame& F, const Args& a, int layer) {
    PHASE_IDS(F);
    typedef short bf16x8 __attribute__((ext_vector_type(8)));
    const bf16* Z = (const bf16*)(F.ws + WS_Z); const bf16* WCT = (const bf16*)(F.ws + WS_WCT); const float* CBP = (const float*)(F.ws + WS_CBP);
    f32x4* red = (f32x4*)F.lds;
    const int lane = F.lane, et = F.wave & 3, kh = F.wave >> 2, r16 = lane & 15, q4 = lane >> 4;
    for (int it = blockIdx.x; it < NB * 2 * 16; it += F.G) {
        const int b = it >> 5, br = (it >> 4) & 1, n0 = (it & 15) * 16; const int zc = br ? ZVC : ZKC;
        const bf16* wrow = WCT + ((size_t)br * 64 + et * 16 + r16) * 2048 + 8 * q4;
        const int tb = 16 * (n0 + r16);
        f32x4 acc = {0.f, 0.f, 0.f, 0.f};
#pragma unroll 8
        for (int kk = kh * 32; kk < kh * 32 + 32; ++kk) {
            int tok = tb + (kk >> 1); tok = tok < SEQ ? tok : SEQ - 1;
            const bf16x8 af = *(const bf16x8*)(Z + ((size_t)b * SEQ + tok) * DINP + zc + (kk & 1) * 32 + 8 * q4);
            const bf16x8 bfr = *(const bf16x8*)(wrow + 32 * kk);
            acc = __builtin_amdgcn_mfma_f32_16x16x32_bf16(af, bfr, acc, 0, 0, 0);
        }
        __syncthreads();
        if (kh == 1) red[et * 64 + lane] = acc;
        __syncthreads();
        if (kh == 0) {
            const f32x4 o = red[et * 64 + lane]; const int e = et * 16 + r16; float bias = 0.f;
            const int es = br == 0 ? pi64(e) : e;
#pragma unroll 8
            for (int ch = 0; ch < 32; ++ch) bias += CBP[(br * 32 + ch) * 64 + es];
            bf16* O = (bf16*)(F.ws + (br ? WS_VC : WS_KC)) + (size_t)b * 256 * 64;
#pragma unroll
            for (int r = 0; r < 4; ++r) { const int n = n0 + 4 * q4 + r; O[n * 64 + e] = (bf16)((n < 255) ? f2bf(acc[r] + o[r] + bias) : 0u); }
        }
    }
    __syncthreads();
}
__device__ __forceinline__ float log_sigmoid_(float x) { return x >= 0.f ? -log1pf(__expf(-x)) : x - log1pf(__expf(x)); }
typedef float f32x16m __attribute__((ext_vector_type(16)));
__device__ __forceinline__ void mm64(f32x16m& acc, const float* ap, int as, const float* bp, int bs) {
#pragma unroll 8
    for (int kk = 0; kk < 32; ++kk) acc = __builtin_amdgcn_mfma_f32_32x32x2f32(ap[kk * as], bp[kk * bs], acc, 0, 0, 0);
}
__device__ __forceinline__ int crow32(int r, int hi) { return (r & 3) + 8 * (r >> 2) + 4 * hi; }
typedef short bf16x8m __attribute__((ext_vector_type(8)));
__device__ __forceinline__ f32x16m mmb64(const bf16* A, const bf16* Bt, int i0, int j0, int r32, int hi) {
    f32x16m acc;
#pragma unroll
    for (int r = 0; r < 16; ++r) acc[r] = 0.f;
#pragma unroll
    for (int ks = 0; ks < 4; ++ks) { const bf16x8m a = *(const bf16x8m*)(A + (i0 + r32) * 72 + ks * 16 + hi * 8), b = *(const bf16x8m*)(Bt + (j0 + r32) * 72 + ks * 16 + hi * 8);
        acc = __builtin_amdgcn_mfma_f32_32x32x16_bf16(a, b, acc, 0, 0, 0); }
    return acc;
}
__device__ __forceinline__ void prep_mlstm(Frame& F, const Args& a, int layer) {
    PHASE_IDS(F);
    const bf16* Z = (const bf16*)(F.ws + WS_Z);
    float* L = (float*)F.lds; float* KS = L; float* VS = L + 4096; float* WE = L + 8192;
    bf16* UCB = (bf16*)(L + 8448); bf16* WQT = UCB + 64 * 72; bf16* WKT = WQT + 64 * 72; bf16* VTB = WKT + 64 * 72; bf16* KTB = VTB + 64 * 72;
    const float* convw = a.in[7] + (size_t)layer * 4 * 256; const float* convb = a.in[8] + (size_t)layer * 256;
    const float* gb = a.in[11] + (size_t)layer * 8;
    float* MQ = (float*)(F.ws + WS_MQ); float* MK = (float*)(F.ws + WS_MK); float* CLOC = (float*)(F.ws + WS_CLOC); float* NLOC = (float*)(F.ws + WS_NLOC);
    float* BCUM = (float*)(F.ws + WS_BCUM); float* IG = (float*)(F.ws + WS_IG); float* ACH = (float*)(F.ws + WS_ACH); float* MLOC = (float*)(F.ws + WS_MLOC);
    const int lane = F.lane, r32 = lane & 31, hi = lane >> 5, w = F.wave, tl = F.tid >> 3, c8 = (F.tid & 7) * 8;
    v4u ur[4], vr; int ph = -1;
    if (w < 4) { const int itw = blockIdx.x + w * F.G;
        if (itw < 1024) { const int bh = itw >> 6, c = itw & 63, b = bh >> 2, h = bh & 3, l = lane; const size_t row = (size_t)b * SEQ + c * 64 + l; const bf16* zr = Z + row * DINP;
            const float ig = bf2f(zr[ZCI + h]) + gb[h]; float bc = log_sigmoid_(bf2f(zr[ZCF + h]) + gb[4 + h]);
#pragma unroll
            for (int o = 1; o < 64; o <<= 1) { const float v = lane_get(bc, l - o); if (l >= o) bc += v; }
            const float ach = lane_get(bc, 63); const float ge = ach - bc + ig; const float ml = wave_max(ge);
            WE[w * 64 + l] = __expf(ge - ml); BCUM[row * 4 + h] = bc; IG[row * 4 + h] = ig; if (l == 0) { ACH[itw] = ach; MLOC[itw] = ml; } } }
#define PM_LOAD(it_) do { const int bh_ = (it_) >> 6, c_ = (it_) & 63, b_ = bh_ >> 2, h_ = bh_ & 3, t_ = c_ * 64 + tl; const bf16* zb_ = Z + (size_t)b_ * SEQ * DINP; \
        _Pragma("unroll") for (int j = 0; j < 4; ++j) { const int tt_ = t_ - 3 + j; ur[j] = tt_ >= 0 ? *(const v4u*)(zb_ + (size_t)tt_ * DINP + ZCU + h_ * 64 + c8) : (v4u){0u, 0u, 0u, 0u}; } \
        vr = *(const v4u*)(zb_ + (size_t)t_ * DINP + ZCV + h_ * 64 + c8); } while (0)
    int it = blockIdx.x;
    if (it < 1024) PM_LOAD(it);
    for (int ki = 0; it < 1024; it += F.G, ++ki) {
        const int bh = it >> 6, c = it & 63, b = bh >> 2, h = bh & 3, t0 = c * 64; const size_t row0 = (size_t)b * SEQ + t0; const float* WEi = WE + ki * 64;
        __syncthreads();
        if (h != ph) { const float* wq = a.in[9] + ((size_t)layer * 4 + h) * 4096; const float* wk = a.in[10] + ((size_t)layer * 4 + h) * 4096;
            const f32x4 q0 = *(const f32x4*)(wq + F.tid * 8), q1 = *(const f32x4*)(wq + F.tid * 8 + 4), k0 = *(const f32x4*)(wk + F.tid * 8), k1 = *(const f32x4*)(wk + F.tid * 8 + 4);
            const int d = F.tid >> 3, e0 = (F.tid & 7) * 8;
#pragma unroll
            for (int i = 0; i < 4; ++i) { WQT[(e0 + i) * 72 + d] = (bf16)f2bf(q0[i]); WQT[(e0 + 4 + i) * 72 + d] = (bf16)f2bf(q1[i]); WKT[(e0 + i) * 72 + d] = (bf16)f2bf(k0[i]); WKT[(e0 + 4 + i) * 72 + d] = (bf16)f2bf(k1[i]); }
            ph = h; }
        { float u[4][8], acc[8], vv[8]; const int ch = h * 64 + c8;
#pragma unroll
          for (int j = 0; j < 4; ++j) { u[j][0] = bflo(ur[j].x); u[j][1] = bfhi(ur[j].x); u[j][2] = bflo(ur[j].y); u[j][3] = bfhi(ur[j].y); u[j][4] = bflo(ur[j].z); u[j][5] = bfhi(ur[j].z); u[j][6] = bflo(ur[j].w); u[j][7] = bfhi(ur[j].w); }
          vv[0] = bflo(vr.x); vv[1] = bfhi(vr.x); vv[2] = bflo(vr.y); vv[3] = bfhi(vr.y); vv[4] = bflo(vr.z); vv[5] = bfhi(vr.z); vv[6] = bflo(vr.w); vv[7] = bfhi(vr.w);
#pragma unroll
          for (int i = 0; i < 8; ++i) acc[i] = convb[ch + i];
#pragma unroll
          for (int j = 0; j < 4; ++j)
#pragma unroll
              for (int i = 0; i < 8; ++i) acc[i] += convw[j * 256 + ch + i] * u[j][i];
          { const float we_ = WEi[tl];
#pragma unroll
            for (int i = 0; i < 8; ++i) { acc[i] = acc[i] * sigmoidf_(acc[i]); VTB[(c8 + i) * 72 + tl] = (bf16)f2bf(vv[i] * we_); } }
          *(v4u*)(UCB + tl * 72 + c8) = (v4u){pk2(acc[0], acc[1]), pk2(acc[2], acc[3]), pk2(acc[4], acc[5]), pk2(acc[6], acc[7])}; }
        if (it + F.G < 1024) PM_LOAD(it + F.G);
        __syncthreads();
        { const int i0 = ((w >> 1) & 1) * 32, j0 = (w & 1) * 32; const f32x16m acc = mmb64(UCB, w < 4 ? WQT : WKT, i0, j0, r32, hi);
            float* G = (w < 4 ? MQ : MK) + row0 * 256 + h * 64 + j0 + r32;
            if (w < 4) {
#pragma unroll
                for (int r = 0; r < 16; ++r) G[(size_t)(i0 + crow32(r, hi)) * 256] = acc[r];
            } else {
#pragma unroll
                for (int r = 0; r < 16; ++r) { const float v = acc[r] * 0.125f; const int l = i0 + crow32(r, hi); G[(size_t)l * 256] = v; KS[l * 64 + j0 + r32] = v; }
#pragma unroll
                for (int rg = 0; rg < 4; ++rg) *(v2u*)(KTB + (j0 + r32) * 72 + i0 + 8 * rg + 4 * hi) = (v2u){pk2(acc[4 * rg] * 0.125f, acc[4 * rg + 1] * 0.125f), pk2(acc[4 * rg + 2] * 0.125f, acc[4 * rg + 3] * 0.125f)};
            } }
        __syncthreads();
        if (w < 4) { const int i0 = (w >> 1) * 32, j0 = (w & 1) * 32; const f32x16m acc = mmb64(VTB, KTB, i0, j0, r32, hi);
            float* G = CLOC + (size_t)it * 4096 + j0 + r32;
#pragma unroll
            for (int r = 0; r < 16; ++r) G[(i0 + crow32(r, hi)) * 64] = acc[r];
        } else if (w == 4) { float n = 0.f;
#pragma unroll 8
            for (int l = 0; l < 64; ++l) n += WEi[l] * KS[l * 64 + lane];
            NLOC[it * 64 + lane] = n; }
    }
#undef PM_LOAD
    __syncthreads();
}

__device__ __forceinline__ void ld8(const bf16* p, float* o) { const v4u w = *(const v4u*)p; o[0] = bflo(w.x); o[1] = bfhi(w.x); o[2] = bflo(w.y); o[3] = bfhi(w.y); o[4] = bflo(w.z); o[5] = bfhi(w.z); o[6] = bflo(w.w); o[7] = bfhi(w.w); }
__device__ __forceinline__ void ph_mlstm_out(Frame& F, const Args& a, int layer) {
    PHASE_IDS(F);
    const bf16* Z = (const bf16*)(F.ws + WS_Z); bf16* AO = (bf16*)(F.ws + WS_H);
    const float* MQ = (const float*)(F.ws + WS_MQ); const float* MK = (const float*)(F.ws + WS_MK); const float* CIN = (const float*)(F.ws + WS_CLOC); const float* NIN = (const float*)(F.ws + WS_NLOC);
    const float* BCUM = (const float*)(F.ws + WS_BCUM); const float* IG = (const float*)(F.ws + WS_IG); const float* MIN = (const float*)(F.ws + WS_MIN);
    const float* hg = a.in[12] + (size_t)layer * 256;
    float* L = (float*)F.lds; float* QS = L; float* SS = L + 4224; float* HS = L + 8448; float* VS = L + 12672;
    bf16* QB = (bf16*)(L + 16896); bf16* KB = QB + 64 * 72; bf16* CB = KB + 64 * 72; bf16* SB = CB + 64 * 72; bf16* VTB = SB + 64 * 72;
    float* DEN = L + 16896 + 5 * 2304;
    const int lane = F.lane, r32 = lane & 31, hi = lane >> 5, w = F.wave;
    const int tl = F.tid >> 3, c8 = (F.tid & 7) * 8;
    f32x4 qr[2], kr[2], cr[2]; v4u vr;
    float* G4 = DEN + 64;
    if (w < 4) { const int itw = blockIdx.x + w * F.G;
        if (itw < 1024) { const int bh = itw >> 6, c = itw & 63, b = bh >> 2, h = bh & 3, l = lane; const size_t rl = (size_t)b * SEQ + c * 64 + l;
            const float bc = BCUM[rl * 4 + h], ig = IG[rl * 4 + h], mi = MIN[itw]; float* g = G4 + 5 * 64 * w;
            g[l] = NIN[itw * 64 + l]; g[64 + l] = bc; g[128 + l] = ig;
            float pm = ig - bc;
#pragma unroll
            for (int o = 1; o < 64; o <<= 1) { const float v = lane_get(pm, l - o); if (l >= o) pm = fmaxf(pm, v); }
            const float inter = bc + mi, mt = fmaxf(inter, bc + pm); g[192 + l] = mt; g[256 + l] = __expf(inter - mt); } }
#define MO_LOAD(it_) do { const int bh_ = (it_) >> 6, c_ = (it_) & 63, b_ = bh_ >> 2, h_ = bh_ & 3; const size_t r_ = (size_t)b_ * SEQ + c_ * 64 + tl; \
        const f32x4* q_ = (const f32x4*)(MQ + r_ * 256 + h_ * 64 + c8); const f32x4* k_ = (const f32x4*)(MK + r_ * 256 + h_ * 64 + c8); const f32x4* c_p = (const f32x4*)(CIN + (size_t)(it_) * 4096 + tl * 64 + c8); \
        qr[0] = q_[0]; qr[1] = q_[1]; kr[0] = k_[0]; kr[1] = k_[1]; cr[0] = c_p[0]; cr[1] = c_p[1]; vr = *(const v4u*)(Z + r_ * DINP + ZCV + h_ * 64 + c8); } while (0)
    int it = blockIdx.x;
    if (it < 1024) MO_LOAD(it);
    for (int ki = 0; it < 1024; it += F.G, ++ki) {
        const int bh = it >> 6, c = it & 63, b = bh >> 2, h = bh & 3; const size_t row0 = (size_t)b * SEQ + c * 64;
        const float* NI = G4 + 5 * 64 * ki; const float* BC = NI + 64; const float* IGS = BC + 64; const float* MT = IGS + 64; const float* EI = MT + 64;
        __syncthreads();
        { float* q_ = QS + tl * 65 + c8; float* v_ = VS + tl * 64 + c8;
#pragma unroll
          for (int i = 0; i < 4; ++i) { q_[i] = qr[0][i]; q_[4 + i] = qr[1][i]; }
          *(v4u*)(QB + tl * 72 + c8) = (v4u){pk2(qr[0][0], qr[0][1]), pk2(qr[0][2], qr[0][3]), pk2(qr[1][0], qr[1][1]), pk2(qr[1][2], qr[1][3])};
          *(v4u*)(KB + tl * 72 + c8) = (v4u){pk2(kr[0][0], kr[0][1]), pk2(kr[0][2], kr[0][3]), pk2(kr[1][0], kr[1][1]), pk2(kr[1][2], kr[1][3])};
          *(v4u*)(CB + tl * 72 + c8) = (v4u){pk2(cr[0][0], cr[0][1]), pk2(cr[0][2], cr[0][3]), pk2(cr[1][0], cr[1][1]), pk2(cr[1][2], cr[1][3])};
          (void)v_; { bf16* vt_ = VTB + c8 * 72 + tl; vt_[0] = (bf16)(vr.x & 0xffffu); vt_[72] = (bf16)(vr.x >> 16); vt_[144] = (bf16)(vr.y & 0xffffu); vt_[216] = (bf16)(vr.y >> 16); vt_[288] = (bf16)(vr.z & 0xffffu); vt_[360] = (bf16)(vr.z >> 16); vt_[432] = (bf16)(vr.w & 0xffffu); vt_[504] = (bf16)(vr.w >> 16); } }
        if (it + F.G < 1024) MO_LOAD(it + F.G);
        __syncthreads();
        const int i0 = ((w >> 1) & 1) * 32, j0 = (w & 1) * 32; f32x16m acc;
        if (w < 4) {
            acc = mmb64(QB, KB, i0, j0, r32, hi);
            const int s_ = j0 + r32; const float bs = IGS[s_] - BC[s_];
#pragma unroll
            for (int r = 0; r < 16; ++r) { const int t = i0 + crow32(r, hi); const float sv = (s_ <= t) ? acc[r] * __expf(BC[t] + bs - MT[t]) : 0.f; SS[t * 65 + s_] = sv; SB[t * 72 + s_] = (bf16)f2bf(sv); }
        } else {
            acc = mmb64(QB, CB, i0, j0, r32, hi);
#pragma unroll
            for (int r = 0; r < 16; ++r) acc[r] *= EI[i0 + crow32(r, hi)];
        }
        __syncthreads();
        if (w >= 4) {
            const f32x16m sv = mmb64(SB, VTB, i0, j0, r32, hi);
#pragma unroll
            for (int r = 0; r < 16; ++r) HS[(i0 + crow32(r, hi)) * 65 + j0 + r32] = acc[r] + sv[r];
        } else if (w == 0) { const int t = lane; float nq = 0.f, ssum = 0.f;
#pragma unroll 8
            for (int k = 0; k < 64; ++k) { nq += NI[k] * QS[t * 65 + k]; ssum += SS[t * 65 + k]; }
            const float den = EI[t] * nq + ssum; DEN[t] = 1.0f / fmaxf(fabsf(den), __expf(-MT[t])); }
        __syncthreads();
        { const int t = F.tid >> 3, vg = (F.tid & 7) * 8; const float rd = DEN[t]; float num[8]; float sq = 0.f;
#pragma unroll
            for (int i = 0; i < 8; ++i) { num[i] = HS[t * 65 + vg + i] * rd; sq += num[i] * num[i]; }
            sq += sx<1>(sq); sq += sx<2>(sq); sq += sx<4>(sq);
            const float rn = 1.0f / sqrtf(sq * (1.0f / 64.0f) + EPS); const size_t row = row0 + t;
            float zo[8]; ld8(Z + row * DINP + ZCO + h * 64 + vg, zo);
            unsigned wv[4];
#pragma unroll
            for (int i = 0; i < 8; i += 2) { const int ch = h * 64 + vg + i; wv[i >> 1] = pk2(num[i] * rn * hg[ch] * sigmoidf_(zo[i]), num[i + 1] * rn * hg[ch + 1] * sigmoidf_(zo[i + 1])); }
            *(v4u*)(AO + row * DM + 512 + h * 64 + vg) = (v4u){wv[0], wv[1], wv[2], wv[3]}; }
    }
#undef MO_LOAD
    __syncthreads();
}

namespace fa {
typedef short bf16x8 __attribute__((ext_vector_type(8)));
typedef float f32x16 __attribute__((ext_vector_type(16)));
typedef short s16x4 __attribute__((ext_vector_type(4)));
typedef __bf16 bf16x2_t __attribute__((ext_vector_type(2)));
constexpr int KP = 144, VP = 192, KT = 64 * KP, VT = 64 * VP, BUF = KT + VT, LDS_NEED = 2 * BUF;
constexpr float LOG2E = 1.4426950408889634f, LN2 = 0.6931471805599453f;
__device__ __forceinline__ int crow(int r, int hi) { return (r & 3) + 8 * (r >> 2) + 4 * hi; }
__device__ __forceinline__ unsigned cvtpk(float lo, float hi) { f32x2 v = {lo, hi}; bf16x2_t b = __builtin_convertvector(v, bf16x2_t); return __builtin_bit_cast(unsigned, b); }
__device__ __forceinline__ s16x4 vtr(LAS unsigned char* p) { return __builtin_bit_cast(s16x4, __builtin_amdgcn_ds_read_tr16_b64_v4i16((LAS s16x4*)p)); }
__device__ __forceinline__ void load_qf(const bf16* qrow, int hi, bf16x8 (&qf)[4]) {
#pragma unroll
    for (int ks = 0; ks < 4; ++ks) qf[ks] = *(const bf16x8*)(qrow + 16 * ks + 8 * hi);
}
template <int KS0, int KS, class P, int MODE = 0>
__device__ __forceinline__ void stream(const P& p, LAS unsigned char* lds, int tid, const bf16x8 (&qf)[4], float& m_, float& l_, f32x16 (&O_)[2]) {
    constexpr float THR = 8.0f;
    float m = MODE == 1 ? m_ : 0.f, l = l_; f32x16 O[2] = {O_[0], O_[1]}; f32x16 negm, LS;
#pragma unroll
    for (int r = 0; r < 16; ++r) { negm[r] = 0.f; LS[r] = 0.f; }
    const int lane = tid & 63, r32 = lane & 31, hi = lane >> 5, g = lane >> 4, i16 = lane & 15;
    const int srow = tid >> 3, scx = tid & 7;
    const int koff = r32 * KP + hi * 16;
    const int voff = KT + ((i16 >> 2) + 4 * hi) * VP + (16 * (g & 1) + 4 * (i16 & 3)) * 2;
    const int nt = p.ntiles();
    v4u kr, vr;
#define FA_LOAD(it_) do { const bf16* kp_ = p.krow((it_), srow); const bf16* vp_ = p.vrow((it_), srow); kr = *(const v4u*)(kp_ + 8 * scx); vr = *(const v4u*)(vp_ + 8 * scx); } while (0)
#define FA_STORE(boff_) do { *(LAS v4u*)(lds + (boff_) + srow * KP + scx * 16) = kr; *(LAS v4u*)(lds + (boff_) + KT + srow * VP + scx * 16) = vr; } while (0)
    __syncthreads();
    if (nt > 0) { FA_LOAD(0); FA_STORE(0); if (nt > 1) FA_LOAD(1); }
    __syncthreads();
#pragma unroll 1
    for (int it = 0; it < nt; ++it) {
        const int bc = (it & 1) * BUF;
        if (!p.wave_skip(it)) {
            f32x16 S[2];
            { bf16x8 kf[2][KS];
#pragma unroll
              for (int st = 0; st < 2; ++st)
#pragma unroll
                  for (int k = 0; k < KS; ++k) kf[st][k] = *(LAS bf16x8*)(lds + bc + koff + st * 32 * KP + (KS0 + k) * 32);
              f32x16 cin;
              if constexpr (MODE == 1) {
#pragma unroll
                  for (int r = 0; r < 16; ++r) cin[r] = 0.f; }
              else if constexpr (P::HAS_KEEP || P::NO_REF_BLOCK) { const float c0_ = p.lane_keep(it) ? -m : -INFINITY;
#pragma unroll
                  for (int r = 0; r < 16; ++r) cin[r] = c0_; }
              else cin = negm;
#pragma unroll
              for (int st = 0; st < 2; ++st) {
                  S[st] = __builtin_amdgcn_mfma_f32_32x32x16_bf16(kf[st][0], qf[KS0], cin, 0, 0, 0);
#pragma unroll
                  for (int k = 1; k < KS; ++k) S[st] = __builtin_amdgcn_mfma_f32_32x32x16_bf16(kf[st][k], qf[KS0 + k], S[st], 0, 0, 0); } }
            s16x4 vv[2][2][2][2];
            if constexpr (MODE == 0) {
#pragma unroll
                for (int st = 0; st < 2; ++st)
#pragma unroll
                    for (int s = 0; s < 2; ++s)
#pragma unroll
                        for (int dt = 0; dt < 2; ++dt) { LAS unsigned char* vp = lds + bc + voff + (32 * st + 16 * s) * VP + dt * 64; vv[st][s][dt][0] = vtr(vp); vv[st][s][dt][1] = vtr(vp + 8 * VP); }
            }
            const int mm = p.mask_mode(it);
            if (mm) {
                int lb, ub; p.bounds(it, lb, ub); lb -= 4 * hi; ub -= 4 * hi;
                asm volatile("" : "+v"(lb), "+v"(ub));
                if (mm == 1) {
#pragma unroll
                    for (int st = 0; st < 2; ++st)
#pragma unroll
                        for (int r = 0; r < 16; ++r) { const int cc = 32 * st + (r & 3) + 8 * (r >> 2); if (cc > ub) S[st][r] = -INFINITY; }
                } else if (mm == 2) {
#pragma unroll
                    for (int st = 0; st < 2; ++st)
#pragma unroll
                        for (int r = 0; r < 16; ++r) { const int cc = 32 * st + (r & 3) + 8 * (r >> 2); if (cc < lb) S[st][r] = -INFINITY; }
                } else {
#pragma unroll
                    for (int st = 0; st < 2; ++st)
#pragma unroll
                        for (int r = 0; r < 16; ++r) { const int cc = 32 * st + (r & 3) + 8 * (r >> 2); if (cc < lb || cc > ub) S[st][r] = -INFINITY; }
                }
            }
            if constexpr (MODE == 1) {
                const float ms = m; const float il = l > 0.f ? 1.0f / l : 0.f;
#pragma unroll
                for (int st = 0; st < 2; ++st)
#pragma unroll
                    for (int rg = 0; rg < 4; ++rg) {
                        const float p0 = __builtin_amdgcn_exp2f(S[st][4 * rg] - ms) * il, p1 = __builtin_amdgcn_exp2f(S[st][4 * rg + 1] - ms) * il;
                        const float p2 = __builtin_amdgcn_exp2f(S[st][4 * rg + 2] - ms) * il, p3 = __builtin_amdgcn_exp2f(S[st][4 * rg + 3] - ms) * il;
                        float qa = p0, qb = p0 + 2.0f * (p1 + p2 + p3);
                        qa += sx<1>(qa); qa += sx<2>(qa); qb += sx<1>(qb); qb += sx<2>(qb);
                        const int jp = 8 * (2 * it + st) + 2 * rg + hi;
                        if ((r32 & 3) == 0) { p.impA[p.tokl * 65 + jp] = qa; if (jp < 63) p.impB[p.tokl * 65 + jp + 1] = qb; }
                    }
            } else {
                float tm = S[0][0];
#pragma unroll
                for (int r = 1; r < 16; ++r) tm = fmaxf(tm, S[0][r]);
#pragma unroll
                for (int r = 0; r < 16; ++r) tm = fmaxf(tm, S[1][r]);
                tm = max32(tm);
                if (__any(tm > THR)) {
                    const float dl = fmaxf(tm, 0.f), f = __builtin_amdgcn_exp2f(-dl); m += dl; LS[0] *= f;
#pragma unroll
                    for (int st = 0; st < 2; ++st)
#pragma unroll
                        for (int r = 0; r < 16; ++r) S[st][r] -= dl;
                    if constexpr (!(P::HAS_KEEP || P::NO_REF_BLOCK)) {
#pragma unroll
                        for (int r = 0; r < 16; ++r) negm[r] = -m; }
#pragma unroll
                    for (int dt = 0; dt < 2; ++dt)
#pragma unroll
                        for (int r = 0; r < 16; ++r) O[dt][r] *= f;
                }
#pragma unroll
                for (int st = 0; st < 2; ++st)
#pragma unroll
                    for (int r = 0; r < 16; ++r) S[st][r] = __builtin_amdgcn_exp2f(S[st][r]);
                const unsigned one2 = (tid & 31) == 0 ? 0x3F803F80u : 0u; const bf16x8 ones = __builtin_bit_cast(bf16x8, (v4u){one2, one2, one2, one2});
#pragma unroll
                for (int st = 0; st < 2; ++st)
#pragma unroll
                    for (int s = 0; s < 2; ++s) {
                        v4u pw; pw.x = cvtpk(S[st][8 * s], S[st][8 * s + 1]); pw.y = cvtpk(S[st][8 * s + 2], S[st][8 * s + 3]); pw.z = cvtpk(S[st][8 * s + 4], S[st][8 * s + 5]); pw.w = cvtpk(S[st][8 * s + 6], S[st][8 * s + 7]);
                        const bf16x8 pf = __builtin_bit_cast(bf16x8, pw);
#pragma unroll
                        for (int dt = 0; dt < 2; ++dt) {
                            const s16x4 v0 = vv[st][s][dt][0], v1 = vv[st][s][dt][1];
                            const bf16x8 vf = __builtin_shufflevector(v0, v1, 0, 1, 2, 3, 4, 5, 6, 7);
                            O[dt] = __builtin_amdgcn_mfma_f32_32x32x16_bf16(vf, pf, O[dt], 0, 0, 0);
                        }
                        LS = __builtin_amdgcn_mfma_f32_32x32x16_bf16(ones, pf, LS, 0, 0, 0);
                    }
            }
        }
        if (it + 1 < nt) { FA_STORE(((it + 1) & 1) * BUF); if (it + 2 < nt) FA_LOAD(it + 2); }
        __syncthreads();
    }
#undef FA_LOAD
#undef FA_STORE
    if constexpr (MODE == 0) l = LS[0];
    m_ = m; l_ = l; O_[0] = O[0]; O_[1] = O[1];
}
template <class P>
__device__ __forceinline__ void stream2(const P& p, LAS unsigned char* lds, int tid, const bf16x8 (&qf)[4], float (&m)[2], float (&l)[2], f32x16 (&O)[2][2]) {
    constexpr float THR = 8.0f; f32x16 negm; float mref = 0.f;
#pragma unroll
    for (int r = 0; r < 16; ++r) negm[r] = 0.f;
    const int lane = tid & 63, r32 = lane & 31, hi = lane >> 5, g = lane >> 4, i16 = lane & 15;
    const int srow = tid >> 3, scx = tid & 7;
    const int koff = r32 * KP + hi * 16;
    const int voff = KT + ((i16 >> 2) + 4 * hi) * VP + (16 * (g & 1) + 4 * (i16 & 3)) * 2;
    const int nt = p.ntiles();
    v4u kr, vr;
#define FA_LOAD(it_) do { const bf16* kp_ = p.krow((it_), srow); const bf16* vp_ = p.vrow((it_), srow); kr = *(const v4u*)(kp_ + 8 * scx); vr = *(const v4u*)(vp_ + 8 * scx); } while (0)
#define FA_STORE(boff_) do { *(LAS v4u*)(lds + (boff_) + srow * KP + scx * 16) = kr; *(LAS v4u*)(lds + (boff_) + KT + srow * VP + scx * 16) = vr; } while (0)
    __syncthreads();
    if (nt > 0) { FA_LOAD(0); FA_STORE(0); if (nt > 1) FA_LOAD(1); }
    __syncthreads();
#pragma unroll 1
    for (int it = 0; it < nt; ++it) {
        const int bc = (it & 1) * BUF;
        if (!p.wave_skip(it)) {
            f32x16 S[2][2];
            { bf16x8 kf[2][2][2];
#pragma unroll
              for (int c = 0; c < 2; ++c)
#pragma unroll
                  for (int st = 0; st < 2; ++st)
#pragma unroll
                      for (int k = 0; k < 2; ++k) kf[c][st][k] = *(LAS bf16x8*)(lds + bc + koff + st * 32 * KP + (2 * c + k) * 32);
#pragma unroll
              for (int st = 0; st < 2; ++st)
#pragma unroll
                  for (int c = 0; c < 2; ++c) S[c][st] = __builtin_amdgcn_mfma_f32_32x32x16_bf16(kf[c][st][0], qf[2 * c], negm, 0, 0, 0);
#pragma unroll
              for (int st = 0; st < 2; ++st)
#pragma unroll
                  for (int c = 0; c < 2; ++c) S[c][st] = __builtin_amdgcn_mfma_f32_32x32x16_bf16(kf[c][st][1], qf[2 * c + 1], S[c][st], 0, 0, 0); }
            s16x4 vv[2][2][2][2];
#pragma unroll
            for (int st = 0; st < 2; ++st)
#pragma unroll
                for (int s = 0; s < 2; ++s)
#pragma unroll
                    for (int dt = 0; dt < 2; ++dt) { LAS unsigned char* vp = lds + bc + voff + (32 * st + 16 * s) * VP + dt * 64; vv[st][s][dt][0] = vtr(vp); vv[st][s][dt][1] = vtr(vp + 8 * VP); }
            if (p.mask_mode(it)) {
                int lb, ub; p.bounds(it, lb, ub); ub -= 4 * hi; asm volatile("" : "+v"(ub));
#pragma unroll
                for (int c = 0; c < 2; ++c)
#pragma unroll
                    for (int st = 0; st < 2; ++st)
#pragma unroll
                        for (int r = 0; r < 16; ++r) { const int cc = 32 * st + (r & 3) + 8 * (r >> 2); if (cc > ub) S[c][st][r] = -INFINITY; }
            }
            float tm[2];
#pragma unroll
            for (int c = 0; c < 2; ++c) { float t_ = S[c][0][0];
#pragma unroll
                for (int r = 1; r < 16; ++r) t_ = fmaxf(t_, S[c][0][r]);
#pragma unroll
                for (int r = 0; r < 16; ++r) t_ = fmaxf(t_, S[c][1][r]);
                tm[c] = t_; }
            tm[0] = max32(tm[0]); tm[1] = max32(tm[1]);
            if (__any(tm[0] > THR || tm[1] > THR)) {
                const float dl = fmaxf(fmaxf(tm[0], tm[1]), 0.f), f = __builtin_amdgcn_exp2f(-dl); mref += dl; l[0] *= f; l[1] *= f;
#pragma unroll
                for (int r = 0; r < 16; ++r) negm[r] = -mref;
#pragma unroll
                for (int c = 0; c < 2; ++c) {
#pragma unroll
                    for (int st = 0; st < 2; ++st)
#pragma unroll
                        for (int r = 0; r < 16; ++r) S[c][st][r] -= dl;
#pragma unroll
                    for (int dt = 0; dt < 2; ++dt)
#pragma unroll
                        for (int r = 0; r < 16; ++r) O[c][dt][r] *= f; }
            }
            float ps[2] = {0.f, 0.f};
#pragma unroll
            for (int st = 0; st < 2; ++st)
#pragma unroll
                for (int r = 0; r < 16; ++r)
#pragma unroll
                    for (int c = 0; c < 2; ++c) { const float e = __builtin_amdgcn_exp2f(S[c][st][r]); S[c][st][r] = e; ps[c] += e; }
            l[0] += ps[0]; l[1] += ps[1];
#pragma unroll
            for (int st = 0; st < 2; ++st)
#pragma unroll
                for (int s = 0; s < 2; ++s) {
                    bf16x8 pf[2];
#pragma unroll
                    for (int c = 0; c < 2; ++c) { v4u pw; pw.x = cvtpk(S[c][st][8 * s], S[c][st][8 * s + 1]); pw.y = cvtpk(S[c][st][8 * s + 2], S[c][st][8 * s + 3]); pw.z = cvtpk(S[c][st][8 * s + 4], S[c][st][8 * s + 5]); pw.w = cvtpk(S[c][st][8 * s + 6], S[c][st][8 * s + 7]); pf[c] = __builtin_bit_cast(bf16x8, pw); }
#pragma unroll
                    for (int dt = 0; dt < 2; ++dt) {
                        const bf16x8 vf = __builtin_shufflevector(vv[st][s][dt][0], vv[st][s][dt][1], 0, 1, 2, 3, 4, 5, 6, 7);
#pragma unroll
                        for (int c = 0; c < 2; ++c) O[c][dt] = __builtin_amdgcn_mfma_f32_32x32x16_bf16(vf, pf[c], O[c][dt], 0, 0, 0);
                    }
                }
        }
        if (it + 1 < nt) { FA_STORE(((it + 1) & 1) * BUF); if (it + 2 < nt) FA_LOAD(it + 2); }
        __syncthreads();
    }
#undef FA_LOAD
#undef FA_STORE
    m[0] = mref; m[1] = mref;
}
__device__ __forceinline__ float finish(float l, f32x16 (&O)[2]) {
    const float lt = sum32(l); const float inv = lt > 0.f ? 1.0f / lt : 0.f;
#pragma unroll
    for (int dt = 0; dt < 2; ++dt)
#pragma unroll
        for (int r = 0; r < 16; ++r) O[dt][r] *= inv;
    return lt;
}
__device__ __forceinline__ void store_o(const f32x16 (&O)[2], bf16* out, int hi) {
#pragma unroll
    for (int dt = 0; dt < 2; ++dt)
#pragma unroll
        for (int rg = 0; rg < 4; ++rg) { v2u w; w.x = cvtpk(O[dt][4 * rg], O[dt][4 * rg + 1]); w.y = cvtpk(O[dt][4 * rg + 2], O[dt][4 * rg + 3]); *(v2u*)(out + 32 * dt + 8 * rg + 4 * hi) = w; }
}
}

struct DiffPol {
    static constexpr bool NO_REF_BLOCK = false;
    static constexpr bool HAS_KEEP = false;
    const bf16* Zb; int h, t0, wq0, tq;
    __device__ __forceinline__ int ntiles() const { return (t0 + 256) >> 6; }
    __device__ __forceinline__ const bf16* krow(int it, int r) const { return Zb + (size_t)(64 * it + r) * DINP + ZBK + 64 * h; }
    __device__ __forceinline__ const bf16* vrow(int it, int r) const { return Zb + (size_t)(64 * it + r) * DINP + ZBV + 64 * h; }
    __device__ __forceinline__ bool wave_skip(int it) const { return 64 * it > wq0 + 31; }
    __device__ __forceinline__ int mask_mode(int it) const { return 64 * it + 63 > wq0 ? 1 : 0; }
    __device__ __forceinline__ bool lane_keep(int) const { return true; }
    __device__ __forceinline__ void bounds(int it, int& lb, int& ub) const { lb = 0; ub = tq - 64 * it; }
};
__device__ __forceinline__ void diff_item(Frame& F, const Args& a, int layer, int b, int h, int qb, float lam) {
    PHASE_IDS(F);
    const bf16* Z = (const bf16*)(F.ws + WS_Z); bf16* AO = (bf16*)(F.ws + WS_H);
    const int lane = F.lane, r32 = lane & 31, hi = lane >> 5;
    DiffPol p; p.Zb = Z + (size_t)b * SEQ * DINP; p.h = h; p.t0 = 256 * qb; p.wq0 = p.t0 + 32 * F.wave; p.tq = p.wq0 + r32;
    fa::bf16x8 qf[4]; fa::load_qf(p.Zb + (size_t)p.tq * DINP + ZBQ + 64 * h, hi, qf);
    fa::f32x16 O[2][2];
#pragma unroll
    for (int c = 0; c < 2; ++c)
#pragma unroll
        for (int dt = 0; dt < 2; ++dt)
#pragma unroll
            for (int r = 0; r < 16; ++r) O[c][dt][r] = 0.f;
    { float m[2] = {-INFINITY, -INFINITY}, l[2] = {0.f, 0.f}; fa::stream2<DiffPol>(p, F.lds3, F.tid, qf, m, l, O); fa::finish(l[0], O[0]); fa::finish(l[1], O[1]); }
    const float lam_init = 0.8f - 0.6f * expf(-0.3f * (float)layer);
    const float* sg = a.in[6] + (size_t)layer * 64;
    float ss = 0.f;
#pragma unroll
    for (int dt = 0; dt < 2; ++dt)
#pragma unroll
        for (int r = 0; r < 16; ++r) { const float v = O[0][dt][r] - lam * O[1][dt][r]; O[0][dt][r] = v; ss += v * v; }
    ss = sum32(ss);
    const float rn = (1.0f / sqrtf(ss * (1.0f / 64.0f) + EPS)) * (1.0f - lam_init);
#pragma unroll
    for (int dt = 0; dt < 2; ++dt)
#pragma unroll
        for (int r = 0; r < 16; ++r) O[0][dt][r] *= rn * sg[32 * dt + fa::crow(r, hi)];
    fa::store_o(O[0], AO + ((size_t)b * SEQ + p.tq) * DM + 256 + 64 * h, hi);
}
struct DilPol {
    static constexpr bool NO_REF_BLOCK = false;
    static constexpr bool HAS_KEEP = false;
    const bf16* Zb; int h, dil, res, it0, nt, wi0, iq;
    __device__ __forceinline__ int ntiles() const { return nt; }
    __device__ __forceinline__ const bf16* krow(int it, int r) const { const int ik = 64 * (it0 + it) + r; return Zb + (size_t)(res + dil * ik) * DINP + ZDK + 64 * h; }
    __device__ __forceinline__ const bf16* vrow(int it, int r) const { const int ik = 64 * (it0 + it) + r; return Zb + (size_t)(res + dil * ik) * DINP + ZDV + 64 * h; }
    __device__ __forceinline__ bool wave_skip(int it) const { const int k0 = 64 * (it0 + it); return k0 > wi0 + 31 || k0 + 63 < wi0 - 128; }
    __device__ __forceinline__ int mask_mode(int it) const { const int k0 = 64 * (it0 + it); return (k0 + 63 > wi0 ? 1 : 0) | (k0 < wi0 + 31 - 128 ? 2 : 0); }
    __device__ __forceinline__ bool lane_keep(int) const { return true; }
    __device__ __forceinline__ void bounds(int it, int& lb, int& ub) const { ub = iq - 64 * (it0 + it); lb = ub - 128; }
};
__device__ __forceinline__ void dil_item(Frame& F, int b, int h, int g, int res, int blk) {
    PHASE_IDS(F);
    const bf16* Z = (const bf16*)(F.ws + WS_Z); bf16* DP = (bf16*)(F.ws + WS_DPART); float* DL = (float*)(F.ws + WS_DLSE);
    const int lane = F.lane, r32 = lane & 31, hi = lane >> 5;
    DilPol p; p.Zb = Z + (size_t)b * SEQ * DINP; p.h = h; p.dil = (g == 0) ? 1 : (g == 1) ? 4 : 16; p.res = res;
    const int i0 = 256 * blk; const int t_lo = (i0 >> 6) - 2; p.it0 = t_lo < 0 ? 0 : t_lo; p.nt = (i0 >> 6) + 4 - p.it0;
    p.wi0 = i0 + 32 * F.wave; p.iq = p.wi0 + r32;
    const int tq = res + p.dil * p.iq; const size_t row = (size_t)b * SEQ + tq;
    fa::bf16x8 qf[4]; fa::load_qf(p.Zb + (size_t)tq * DINP + ZDQ + 64 * h, hi, qf);
    float m = -INFINITY, l = 0.f; fa::f32x16 O[2];
#pragma unroll
    for (int dt = 0; dt < 2; ++dt)
#pragma unroll
        for (int r = 0; r < 16; ++r) O[dt][r] = 0.f;
    fa::stream<0, 4, DilPol>(p, F.lds3, F.tid, qf, m, l, O);
    const float lt = fa::finish(l, O);
    fa::store_o(O, DP + ((size_t)g * T + row) * 256 + 64 * h, hi);
    if (hi == 0) DL[((size_t)g * T + row) * 4 + h] = (m + __log2f(lt)) * fa::LN2;
}
__device__ __forceinline__ void dil_combine(Frame& F) {
    PHASE_IDS(F);
    const bf16* DP = (const bf16*)(F.ws + WS_DPART); const float* DL = (const float*)(F.ws + WS_DLSE); bf16* AO = (bf16*)(F.ws + WS_H);
    const int gt = F.gw * 64 + F.lane, ngt = F.ngw * 64;
    for (int i = gt; i < T * 32; i += ngt) { const int row = i >> 5, c8 = (i & 31) * 8, h = c8 >> 6;
        const float l0 = DL[(size_t)row * 4 + h], l1 = DL[((size_t)T + row) * 4 + h], l2 = DL[((size_t)2 * T + row) * 4 + h];
        const float mx = fmaxf(l0, fmaxf(l1, l2)); float w0 = __expf(l0 - mx), w1 = __expf(l1 - mx), w2 = __expf(l2 - mx); const float inv = 1.0f / (w0 + w1 + w2); w0 *= inv; w1 *= inv; w2 *= inv;
        float x0[8], x1[8], x2[8]; ld8(DP + (size_t)row * 256 + c8, x0); ld8(DP + ((size_t)T + row) * 256 + c8, x1); ld8(DP + ((size_t)2 * T + row) * 256 + c8, x2);
        v4u o; o.x = pk2(w0 * x0[0] + w1 * x1[0] + w2 * x2[0], w0 * x0[1] + w1 * x1[1] + w2 * x2[1]); o.y = pk2(w0 * x0[2] + w1 * x1[2] + w2 * x2[2], w0 * x0[3] + w1 * x1[3] + w2 * x2[3]);
        o.z = pk2(w0 * x0[4] + w1 * x1[4] + w2 * x2[4], w0 * x0[5] + w1 * x1[5] + w2 * x2[5]); o.w = pk2(w0 * x0[6] + w1 * x1[6] + w2 * x2[6], w0 * x0[7] + w1 * x1[7] + w2 * x2[7]);
        *(v4u*)(AO + (size_t)row * DM + 768 + c8) = o; }
}
struct CmpPol {
    static constexpr bool NO_REF_BLOCK = false;
    static constexpr bool HAS_KEEP = false;
    const bf16* KCb; const bf16* VCb; int nt, ubg; float* impA; float* impB; int tokl; bool nov;
    __device__ __forceinline__ int ntiles() const { return nt; }
    __device__ __forceinline__ const bf16* krow(int it, int r) const { return KCb + (size_t)(64 * it + r) * 64; }
    __device__ __forceinline__ const bf16* vrow(int it, int r) const { return VCb + (size_t)(64 * it + r) * 64; }
    __device__ __forceinline__ bool wave_skip(int) const { return false; }
    __device__ __forceinline__ int mask_mode(int) const { return 1; }
    __device__ __forceinline__ bool lane_keep(int) const { return true; }
    __device__ __forceinline__ void bounds(int it, int& lb, int& ub) const { lb = 0; ub = ubg - 64 * it; }
};
struct SlcPol {
    static constexpr bool NO_REF_BLOCK = true;
    static constexpr bool HAS_KEEP = true;
    const bf16* Zb; const unsigned char* list; int nt, t, cblk; unsigned wlo, whi, mlo, mhi;
    __device__ __forceinline__ int ntiles() const { return nt; }
    __device__ __forceinline__ const bf16* krow(int it, int r) const { const int j = list[it]; return Zb + (size_t)(64 * j + r) * DINP + ZKS; }
    __device__ __forceinline__ const bf16* vrow(int it, int r) const { const int j = list[it]; return Zb + (size_t)(64 * j + r) * DINP + ZVS; }
    __device__ __forceinline__ bool wave_skip(int it) const { const int j = list[it]; return !(((j < 32) ? (wlo >> j) : (whi >> (j - 32))) & 1u); }
    __device__ __forceinline__ int mask_mode(int it) const { return (int)list[it] == cblk ? 1 : 0; }
    __device__ __forceinline__ bool lane_keep(int it) const { const int j = list[it]; return (((j < 32) ? (mlo >> j) : (mhi >> (j - 32))) & 1u) != 0u; }
    __device__ __forceinline__ void bounds(int it, int& lb, int& ub) const { const int j = list[it]; lb = 0; ub = t - 64 * j; }
};
struct WinPol {
    static constexpr bool NO_REF_BLOCK = false;
    static constexpr bool HAS_KEEP = false;
    const bf16* Zb; int jt0, nt, t, cblk;
    __device__ __forceinline__ int ntiles() const { return nt; }
    __device__ __forceinline__ const bf16* krow(int it, int r) const { return Zb + (size_t)(64 * (jt0 + it) + r) * DINP + ZKW; }
    __device__ __forceinline__ const bf16* vrow(int it, int r) const { return Zb + (size_t)(64 * (jt0 + it) + r) * DINP + ZVW; }
    __device__ __forceinline__ bool wave_skip(int) const { return false; }
    __device__ __forceinline__ int mask_mode(int it) const { const int jt = jt0 + it; return (jt == cblk ? 1 : 0) | (jt == cblk - 8 ? 2 : 0); }
    __device__ __forceinline__ bool lane_keep(int) const { return true; }
    __device__ __forceinline__ void bounds(int it, int& lb, int& ub) const { ub = t - 64 * (jt0 + it); lb = ub - 511; }
};
constexpr int NSA_IMP_OFF = 45056, NSA_ACC_OFF = 45056  , NSA_SEL_OFF = NSA_ACC_OFF + 65536, NSA_LIST_OFF = NSA_SEL_OFF + 512;
static_assert(fa::LDS_NEED <= NSA_IMP_OFF && NSA_LIST_OFF + 64 <= RING_BYTES, "NSA LDS map");
__device__ __forceinline__ void nsa_item(Frame& F, int b, int c) {
    PHASE_IDS(F);
    const bf16* Z = (const bf16*)(F.ws + WS_Z); const bf16* AQR = (const bf16*)(F.ws + WS_AQR); bf16* AO = (bf16*)(F.ws + WS_H);
    const bf16* KCB = (const bf16*)(F.ws + WS_KC) + (size_t)b * 256 * 64; const bf16* VCB = (const bf16*)(F.ws + WS_VC) + (size_t)b * 256 * 64;
    const int lane = F.lane, r32 = lane & 31, hi = lane >> 5, tokl = 8 * F.wave + (r32 >> 2), h = r32 & 3, t = 64 * c + tokl; const size_t row = (size_t)b * SEQ + t;
    const bf16* Zb = Z + (size_t)b * SEQ * DINP;
    float* impA = (float*)(F.lds + NSA_IMP_OFF); float* impB = impA + 64 * 65;
    unsigned long long* sel = (unsigned long long*)(F.lds + NSA_SEL_OFF); unsigned char* list = F.lds + NSA_LIST_OFF;
    for (int i = F.tid; i < 2 * 64 * 65; i += NTHREADS) impA[i] = 0.f;
    const bf16* zr = Zb + (size_t)t * DINP;
    const float g0 = sigmoidf_(bf2f(zr[ZAG + h])), g1 = sigmoidf_(bf2f(zr[ZAG + 4 + h])), g2 = sigmoidf_(bf2f(zr[ZAG + 8 + h]));
    fa::f32x16 acc[2], O[2];
    {
        CmpPol cp; cp.KCb = KCB; cp.VCb = VCB; cp.nt = (4 * c + 2 + 64) >> 6; cp.ubg = t >= 31 ? ((t - 31) >> 4) : -1; cp.impA = impA; cp.impB = impB; cp.tokl = tokl; cp.nov = false;
        fa::bf16x8 qf[4]; fa::load_qf(zr + ZAQ + 64 * h, hi, qf);
        float m = -INFINITY, l = 0.f;
#pragma unroll
        for (int dt = 0; dt < 2; ++dt)
#pragma unroll
            for (int r = 0; r < 16; ++r) O[dt][r] = 0.f;
        fa::stream<0, 4, CmpPol, 0>(cp, F.lds3, F.tid, qf, m, l, O);
        float lt = fa::finish(l, O);
#pragma unroll
        for (int dt = 0; dt < 2; ++dt)
#pragma unroll
            for (int r = 0; r < 16; ++r) acc[dt][r] = g0 * O[dt][r];
        cp.nov = true;
        fa::stream<0, 4, CmpPol, 1>(cp, F.lds3, F.tid, qf, m, lt, O);
    }
    __syncthreads();
    f32x4* accl = (f32x4*)(F.lds + NSA_ACC_OFF) + F.tid;
#pragma unroll 1
    for (int tk = 0; tk < 8; ++tk) {
        const int tl = 8 * F.wave + tk, j = lane; const float imp = impA[tl * 65 + j] + impB[tl * 65 + j];
        const bool forced = (j == 0) || (j <= c && j > c - 2);
        const float sc = (j > c) ? -1.0e6f : (forced ? 1.0e6f : imp);
        int rank = 0;
#pragma unroll 8
        for (int i = 0; i < 64; ++i) { const float si = lane_get(sc, i); rank += (si > sc || (si == sc && i < j)) ? 1 : 0; }
        const unsigned long long mask = __ballot(rank < 16 && j <= c);
        if (lane == 0) sel[tl] = mask;
    }
    __syncthreads();
#pragma unroll
    for (int dt = 0; dt < 2; ++dt)
#pragma unroll
        for (int q4 = 0; q4 < 4; ++q4) accl[(dt * 4 + q4) * NTHREADS] = (f32x4){acc[dt][4 * q4], acc[dt][4 * q4 + 1], acc[dt][4 * q4 + 2], acc[dt][4 * q4 + 3]};
    SlcPol sp; sp.Zb = Zb; sp.list = list; sp.t = t; sp.cblk = c;
    { const unsigned long long mk = sel[tokl]; sp.mlo = (unsigned)mk; sp.mhi = (unsigned)(mk >> 32);
      unsigned wl = sp.mlo, wh = sp.mhi; wl |= (unsigned)sx_i<4>((int)wl); wh |= (unsigned)sx_i<4>((int)wh); wl |= (unsigned)sx_i<8>((int)wl); wh |= (unsigned)sx_i<8>((int)wh); wl |= (unsigned)sx_i<16>((int)wl); wh |= (unsigned)sx_i<16>((int)wh);
      sp.wlo = __builtin_amdgcn_readfirstlane(wl); sp.whi = __builtin_amdgcn_readfirstlane(wh);
      const unsigned long long mu = sel[lane]; unsigned ul = (unsigned)mu, uh = (unsigned)(mu >> 32);
      ul |= (unsigned)sx_i<1>((int)ul); uh |= (unsigned)sx_i<1>((int)uh); ul |= (unsigned)sx_i<2>((int)ul); uh |= (unsigned)sx_i<2>((int)uh); ul |= (unsigned)sx_i<4>((int)ul); uh |= (unsigned)sx_i<4>((int)uh);
      ul |= (unsigned)sx_i<8>((int)ul); uh |= (unsigned)sx_i<8>((int)uh); ul |= (unsigned)sx_i<16>((int)ul); uh |= (unsigned)sx_i<16>((int)uh); ul = or32(ul); uh = or32(uh);
      ul = __builtin_amdgcn_readfirstlane(ul); uh = __builtin_amdgcn_readfirstlane(uh);
      const unsigned long long un = ((unsigned long long)uh << 32) | ul;
      if ((un >> lane) & 1ull) list[__popcll(un & ((1ull << lane) - 1ull))] = (unsigned char)lane;
      sp.nt = __popcll(un); }
    fa::bf16x8 qf[4]; fa::load_qf(AQR + row * 256 + 64 * h, hi, qf);
    { float m = -INFINITY, l = 0.f;
#pragma unroll
      for (int dt = 0; dt < 2; ++dt)
#pragma unroll
          for (int r = 0; r < 16; ++r) O[dt][r] = 0.f;
      fa::stream<0, 4, SlcPol, 0>(sp, F.lds3, F.tid, qf, m, l, O); fa::finish(l, O);
#pragma unroll
      for (int dt = 0; dt < 2; ++dt)
#pragma unroll
          for (int q4 = 0; q4 < 4; ++q4) { f32x4 a4 = accl[(dt * 4 + q4) * NTHREADS]; a4[0] += g1 * O[dt][4 * q4]; a4[1] += g1 * O[dt][4 * q4 + 1]; a4[2] += g1 * O[dt][4 * q4 + 2]; a4[3] += g1 * O[dt][4 * q4 + 3]; accl[(dt * 4 + q4) * NTHREADS] = a4; } }
    { WinPol wp; wp.Zb = Zb; wp.jt0 = c >= 8 ? c - 8 : 0; wp.nt = c - wp.jt0 + 1; wp.t = t; wp.cblk = c;
      float m = -INFINITY, l = 0.f;
#pragma unroll
      for (int dt = 0; dt < 2; ++dt)
#pragma unroll
          for (int r = 0; r < 16; ++r) O[dt][r] = 0.f;
      fa::stream<0, 4, WinPol, 0>(wp, F.lds3, F.tid, qf, m, l, O); fa::finish(l, O);
#pragma unroll
      for (int dt = 0; dt < 2; ++dt)
#pragma unroll
          for (int q4 = 0; q4 < 4; ++q4) { const f32x4 a4 = accl[(dt * 4 + q4) * NTHREADS]; O[dt][4 * q4] = a4[0] + g2 * O[dt][4 * q4]; O[dt][4 * q4 + 1] = a4[1] + g2 * O[dt][4 * q4 + 1]; O[dt][4 * q4 + 2] = a4[2] + g2 * O[dt][4 * q4 + 2]; O[dt][4 * q4 + 3] = a4[3] + g2 * O[dt][4 * q4 + 3]; } }
    fa::store_o(O, AO + row * DM + 64 * h, hi);
}
__device__ __forceinline__ void scan_item(Frame& F, int it) {
    PHASE_IDS(F);
    float* CLOC = (float*)(F.ws + WS_CLOC); float* NLOC = (float*)(F.ws + WS_NLOC);
    const float* ACH = (const float*)(F.ws + WS_ACH); const float* MLOC = (const float*)(F.ws + WS_MLOC); float* MIN = (float*)(F.ws + WS_MIN);
    const int bh = it >> 2, qt = it & 3; const int e0 = qt * 1024 + F.tid * 2;
    float c0 = 0.f, c1 = 0.f, nst = 0.f, mst = 0.f;
#pragma unroll 1
    for (int cb = 0; cb < 64; cb += 16) {
        f32x2 cl[16]; float ac[16], ml[16], nl[16];
#pragma unroll
        for (int u = 0; u < 16; ++u) { const int ci = bh * 64 + cb + u; cl[u] = *(const f32x2*)(CLOC + (size_t)ci * 4096 + e0); ac[u] = ACH[ci]; ml[u] = MLOC[ci]; nl[u] = (qt == 0 && F.tid < 64) ? NLOC[ci * 64 + F.tid] : 0.f; }
#pragma unroll
        for (int u = 0; u < 16; ++u) { const int ci = bh * 64 + cb + u;
            const float mn = fmaxf(ac[u] + mst, ml[u]), decay = __expf(ac[u] + mst - mn), fresh = __expf(ml[u] - mn);
            *(f32x2*)(CLOC + (size_t)ci * 4096 + e0) = (f32x2){c0, c1}; c0 = decay * c0 + fresh * cl[u].x; c1 = decay * c1 + fresh * cl[u].y;
            if (qt == 0 && F.tid < 64) { NLOC[ci * 64 + F.tid] = nst; nst = decay * nst + fresh * nl[u]; if (F.tid == 0) MIN[ci] = mst; }
            mst = mn; }
    }
}
struct QOrder { unsigned short v[64 + 256 + 256 + 768]; };
constexpr QOrder make_order() {
    QOrder o{}; int n = 0, id = 0, in = 0, big = 0; bool scans = false;
    while (id < 256 || in < 256) {
        if (!scans && big == 192) { for (int k = 0; k < 64; ++k) o.v[n++] = (unsigned short)((3 << 12) | k); scans = true; }
        const int cd = id < 256 ? 120 * (15 - id / 16 + 1) : -1, cn = in < 256 ? 16 * (63 - in / 4 + 18) : -1;
        if (cd >= cn) { o.v[n++] = (unsigned short)((0 << 12) | id); ++id; } else { o.v[n++] = (unsigned short)((1 << 12) | in); ++in; }
        ++big;
    }
    for (int k = 0; k < 768; ++k) o.v[n++] = (unsigned short)((2 << 12) | k);
    return o;
}
__device__ const QOrder g_order = make_order();
__device__ __forceinline__ void ph_d_queue(Frame& F, const Args& a, int layer) {
    PHASE_IDS(F);
    unsigned* ctr = F.ctl + CW_Q + 64 * layer;
    const float* lv = a.in[5] + (size_t)layer * 128;
    const float lam_init = 0.8f - 0.6f * expf(-0.3f * (float)layer);
    float l01 = 0.f, l23 = 0.f; if (F.lane < 32) { l01 = lv[F.lane] * lv[32 + F.lane]; l23 = lv[64 + F.lane] * lv[96 + F.lane]; }
    const float lam = expf(wave_sum(l01)) - expf(wave_sum(l23)) + lam_init;
    constexpr int NQ = 64 + 256 + 256 + 768;
    for (;;) {
        __syncthreads();
        if (F.tid == 0) F.MISC[0] = __hip_atomic_fetch_add(ctr, 1u, __ATOMIC_RELAXED, __HIP_MEMORY_SCOPE_AGENT);
        __syncthreads();
        const int qi = (int)F.MISC[0];
        if (qi >= NQ) break;
        const int e = g_order.v[qi], ty = e >> 12, id = e & 4095;
        if (ty == 3) scan_item(F, id);
        else if (ty == 0) { const int qb = 15 - (id >> 4), bh = id & 15; diff_item(F, a, layer, bh >> 2, bh & 3, qb, lam); }
        else if (ty == 1) nsa_item(F, id & 3, 63 - (id >> 2));
        else { const int bh = id & 15, k = id >> 4;
            const int g = k >> 4, j = k & 15; const int res = (g == 0) ? 0 : (g == 1) ? (j & 3) : j, blk = (g == 0) ? j : (g == 1) ? (j >> 2) : 0;
            dil_item(F, bh >> 2, bh & 3, g, res, blk); }
    }
    __syncthreads();
}

constexpr int NPHASE = 9 * DEPTH + 1;
#ifndef PH_LO
#define PH_LO 0
#endif
#ifndef PH_HI
#define PH_HI NPHASE
#endif
#define IN(k) (PH_LO <= (k) && (k) < PH_HI)
#ifdef PROBE_K
#ifndef PROBE_SUB
#define PROBE_SUB 0
#endif
#ifndef PROBE_AMP
#define PROBE_AMP 10
#endif
#define PROBE_T0(k) do { if ((k) == PROBE_K) F.pt0 = __builtin_amdgcn_s_memrealtime(); } while (0)
#define PROBE_T1(k) do { if ((k) == PROBE_K) F.pdt = __builtin_amdgcn_s_memrealtime() - F.pt0; } while (0)
#define SUBP(id, call) do { if (layer == 0 && (id) == PROBE_SUB) { F.pt0 = __builtin_amdgcn_s_memrealtime(); call; __syncthreads(); F.pdt = __builtin_amdgcn_s_memrealtime() - F.pt0; } else { call; } } while (0)
#else
#define SUBP(id, call) do { call; } while (0)
#define PROBE_T0(k) do { } while (0)
#define PROBE_T1(k) do { } while (0)
#endif
#define SEAM(k) do { if (IN(k) && (k) + 1 < PH_HI) { if ((k) == PH_LO && F.G == 0x7fffffff) cg::this_grid().sync();   xcd_barrier(bar); } } while (0)
template <int layer> __device__ __forceinline__ void run_layer(Frame& F, const Args& args, const XcdBarrier& bar) {
    float* XR = args.out;
    bf16* H = (bf16*)(F.ws + WS_H); bf16* Z = (bf16*)(F.ws + WS_Z);
    bf16* WIN = (bf16*)(F.ws + WS_WIN); bf16* WOUT = (bf16*)(F.ws + WS_WOUT); bf16* WGU = (bf16*)(F.ws + WS_WGU); bf16* WD = (bf16*)(F.ws + WS_WD);

        const int P = 9 * layer;
        bf16* XB2 = (bf16*)(F.ws + WS_XB2); bf16* ACT = (bf16*)(F.ws + WS_ACT);
        PROBE_T0(P + 0);
        if (IN(P + 0)) {
            convert_weights(F, args, layer);
            if (layer == 0) build_rope(F, args);
            norm_rows_bf16(F, layer == 0 ? args.in[0] : XR, args.in[1] + (size_t)layer * DM, H);
        }
        SEAM(P + 0); PROBE_T1(P + 0);
        PROBE_T0(P + 1);
        if (IN(P + 1)) {
            pg8::Gemm g{H, WIN, T, DINP, DM}; pg8::StaticOrder S; S.init(T, DINP, F.G, (int)blockIdx.x);
            pg8::EpiZR E{Z, DINP, (const float*)(F.ws + WS_ROPE64), (const float*)(F.ws + WS_ROPE32), (bf16*)(F.ws + WS_AQR)};
            pg8::gemm_phase<pg8::EpiZR, pg8::StaticOrder, true, true>(F.lds3, g, S, E);
        }
        SEAM(P + 1); PROBE_T1(P + 1);
        PROBE_T0(P + 2);
        if (IN(P + 2)) { SUBP(1, prep_mlstm(F, args, layer)); SUBP(2, prep_compress(F, args, layer)); }
        SEAM(P + 2); PROBE_T1(P + 2);
        PROBE_T0(P + 3);
        if (IN(P + 3)) ph_d_queue(F, args, layer);
        SEAM(P + 3); PROBE_T1(P + 3);
        PROBE_T0(P + 4);
        if (IN(P + 4)) { SUBP(4, ph_mlstm_out(F, args, layer)); SUBP(5, dil_combine(F)); }
        SEAM(P + 4); PROBE_T1(P + 4);
        PROBE_T0(P + 5);
        if (IN(P + 5)) {
            pg8::Gemm g{H, WOUT, T, DM, DM}; pg8::StaticOrder S; S.init(T, DM, F.G, (int)blockIdx.x); pg8::EpiRes E{layer == 0 ? args.in[0] : XR, XR, DM};
            pg8::gemm_phase<pg8::EpiRes, pg8::StaticOrder, true, true>(F.lds3, g, S, E);
        }
        SEAM(P + 5); PROBE_T1(P + 5);
        PROBE_T0(P + 6);
        if (IN(P + 6)) norm_rows_bf16(F, XR, args.in[14] + (size_t)layer * DM, XB2);
        SEAM(P + 6); PROBE_T1(P + 6);
        PROBE_T0(P + 7);
        if (IN(P + 7)) {
            pg8::Gemm g{XB2, WGU, T, 2 * DFF, DM}; pg8::StaticOrder S; S.init(T, 2 * DFF, F.G, (int)blockIdx.x); pg8::EpiSwiGLU E{ACT, DFF};
            pg8::gemm_phase<pg8::EpiSwiGLU, pg8::StaticOrder, true, true>(F.lds3, g, S, E);
        }
        SEAM(P + 7); PROBE_T1(P + 7);
        PROBE_T0(P + 8);
        if (IN(P + 8)) {
            pg8::Gemm g{ACT, WD, T, DM, DFF}; pg8::StaticOrder S; S.init(T, DM, F.G, (int)blockIdx.x); pg8::EpiRes E{XR, XR, DM};
            pg8::gemm_phase<pg8::EpiRes, pg8::StaticOrder, true, true>(F.lds3, g, S, E);
        }
        SEAM(P + 8); PROBE_T1(P + 8);
}
__global__ void __launch_bounds__(NTHREADS, 2) fwd_kernel(Args args) {
    extern __shared__ __attribute__((aligned(16))) unsigned char lds[];
    Frame F;
    F.lds = lds; F.lds3 = (LAS unsigned char*)lds; F.MISC = (volatile LAS unsigned*)(F.lds3 + MISC_OFF);
    F.tid = threadIdx.x; F.lane = F.tid & 63; F.wave = __builtin_amdgcn_readfirstlane(F.tid >> 6);
    F.G = gridDim.x; F.gw = blockIdx.x * NWAVES + F.wave; F.ngw = F.G * NWAVES;
    F.ws = args.ws; F.ctl = (unsigned*)(args.ws + WS_CTL);
    for (int u = F.tid; u < (LDS_BYTES - LDSCTL_OFF) / 4; u += NTHREADS) ((LAS unsigned*)(F.lds3 + LDSCTL_OFF))[u] = 0u;
    __syncthreads();
    XcdBarrier bar = xcd_barrier_post(F.ctl + CW_BAR, F.MISC + 8);
    run_layer<0>(F, args, bar);
    run_layer<1>(F, args, bar);
    if (IN(9 * DEPTH)) final_norm(F, args.out, args.in[18]);
#ifdef PROBE_K
    if (blockIdx.x == 0) { const unsigned long long te = __builtin_amdgcn_s_memrealtime(); while (__builtin_amdgcn_s_memrealtime() - te < (unsigned long long)PROBE_AMP * F.pdt) __builtin_amdgcn_s_sleep(32); }
#endif
#undef IN
#undef SEAM
}

extern "C" void kernel_launch(void* const* d_in, const int* in_sizes, int n_in, void* d_out, int out_size, void* d_ws, size_t ws_size, hipStream_t stream) {
    static int grid = 0;
    if (grid == 0) {
        if (n_in != 19 || in_sizes[0] != T * DM || out_size != T * DM || ws_size < WS_END) { fprintf(stderr, "kernel_launch: unexpected shapes (n_in %d, in0 %d, out %d, ws %zu); nothing launched\n", n_in, n_in > 0 ? in_sizes[0] : -1, out_size, ws_size); grid = -1; return; }
        int dev = 0, cus = 0, per_cu = 0;
        if (hipGetDevice(&dev) != hipSuccess || hipDeviceGetAttribute(&cus, hipDeviceAttributeMultiprocessorCount, dev) != hipSuccess) { grid = -1; return; }
        if (hipFuncSetAttribute((const void*)fwd_kernel, hipFuncAttributeMaxDynamicSharedMemorySize, LDS_BYTES) != hipSuccess) { fprintf(stderr, "kernel_launch: hipFuncSetAttribute failed\n"); grid = -1; return; }
        if (hipOccupancyMaxActiveBlocksPerMultiprocessor(&per_cu, (const void*)fwd_kernel, NTHREADS, LDS_BYTES) != hipSuccess || per_cu < 1) { fprintf(stderr, "kernel_launch: note: occupancy query says %d blocks per CU\n", per_cu); (void)hipGetLastError(); }
        grid = cus;
    }
    if (grid < 0) return;
    if (hipMemsetAsync((char*)d_ws + WS_CTL, 0, CTL_ZERO_BYTES, stream) != hipSuccess) { fprintf(stderr, "kernel_launch: memset failed\n"); return; }
    Args a{};
    for (int i = 0; i < 19; ++i) a.in[i] = (const float*)d_in[i];
    a.out = (float*)d_out; a.ws = (unsigned char*)d_ws;
    for (int i = 0; i < 32; ++i) a.inv64[i] = 1.0f / powf(10000.0f, (float)(2 * i) / 64.0f);
    for (int i = 0; i < 16; ++i) a.inv32[i] = 1.0f / powf(10000.0f, (float)(2 * i) / 32.0f);
    void* params[] = {&a};
    const hipError_t le = hipLaunchCooperativeKernel((const void*)fwd_kernel, dim3(grid), dim3(NTHREADS), params, LDS_BYTES, stream);
    if (le != hipSuccess) fprintf(stderr, "kernel_launch: cooperative launch failed: %s (grid %d)\n", hipGetErrorName(le), grid);
}
```
